# Optimizing an MI355X kernel written in HIP

```python
import math
import jax
import jax.numpy as jnp
from jax import lax
import numpy as np

D_MODEL = 2048
BATCH = 8
SEQ = 2048
DEPTH = 1

CTX_LEN = 256
GRID_W = 64

MLSTM_HEADS = 4
MLSTM_HEAD_DIM = 256
MLSTM_WIDTH = MLSTM_HEADS * MLSTM_HEAD_DIM
MLSTM_CHUNK = 64

HYENA_WIDTH = D_MODEL // 2
HYENA_ORDER = 2
HYENA_EMB = 33
HYENA_FILTER_HIDDEN = 64
HYENA_DECAY_TARGET = 1e-2
HYENA_SHORT_DECAY_PCT = 0.3
HYENA_LONG_DECAY_PCT = 1.5

N_EXPERTS = 32
TOP_K = 4
D_EXPERT = D_MODEL
SWIGLU_LIMIT = 7.0
SWIGLU_ALPHA = 1.702
MOE_BLOCK = 256

LN_EPS = 1e-5
DEEPNORM_ALPHA = (2.0 * DEPTH) ** 0.25
DEEPNORM_BETA = (8.0 * DEPTH) ** -0.25

IN_QK = 0
IN_V = IN_QK + MLSTM_WIDTH
IN_GATES = IN_V + MLSTM_WIDTH
IN_O = IN_GATES + 4 * MLSTM_HEADS
IN_HYENA = IN_O + MLSTM_WIDTH
IN_BRANCH_GATES = IN_HYENA + (HYENA_ORDER + 1) * HYENA_WIDTH
N_IN = IN_BRANCH_GATES + 2 * D_MODEL

kernel_name = 'hybrid_mlstm_hyena_moe_diffusion_block'

F32 = jnp.float32


def layer_norm(x, g, b):
    xf = x.astype(F32)
    mu = xf.mean(-1, keepdims=True)
    var = jnp.square(xf - mu).mean(-1, keepdims=True)
    return ((xf - mu) * lax.rsqrt(var + LN_EPS) * g.astype(F32) + b.astype(F32)).astype(x.dtype)


def grid_dwconv(u, w, b, rows, cols):
    bsz, length, ch = u.shape
    img = u.reshape(bsz, rows, cols, ch)
    out = lax.conv_general_dilated(img, w[:, :, None, :].astype(u.dtype), window_strides=(1, 1),
                                   padding=((1, 1), (1, 1)), dimension_numbers=('NHWC', 'HWIO', 'NHWC'),
                                   feature_group_count=ch)
    return out.reshape(bsz, length, ch) + b.astype(u.dtype)


def mlstm_zero_state(bsz):
    return (jnp.zeros((bsz, MLSTM_HEADS, MLSTM_HEAD_DIM, MLSTM_HEAD_DIM), F32),
            jnp.zeros((bsz, MLSTM_HEADS, MLSTM_HEAD_DIM), F32),
            jnp.zeros((bsz, MLSTM_HEADS), F32))


def mlstm_prepare(z, rows, cols, conv_w, conv_b, w_qh, w_kh):
    bsz, length, _ = z.shape
    u = jax.nn.silu(grid_dwconv(z[..., IN_QK:IN_V], conv_w, conv_b, rows, cols))
    u = u.astype(F32).reshape(bsz, length, MLSTM_HEADS, MLSTM_HEAD_DIM)
    q = jnp.einsum('blhd,hde->bhle', u, w_qh.astype(F32))
    k = jnp.einsum('blhd,hde->bhle', u, w_kh.astype(F32)) * MLSTM_HEAD_DIM ** -0.5
    v = z[..., IN_V:IN_GATES].astype(F32).reshape(bsz, length, MLSTM_HEADS, MLSTM_HEAD_DIM).transpose(0, 2, 1, 3)
    gates = z[..., IN_GATES:IN_O].astype(F32).reshape(bsz, length, 4, MLSTM_HEADS).transpose(2, 0, 3, 1)
    fwd = (q, k, v, gates[0], jax.nn.log_sigmoid(gates[1]))
    bwd = (q[:, :, ::-1], k[:, :, ::-1], v[:, :, ::-1], gates[2][..., ::-1], jax.nn.log_sigmoid(gates[3])[..., ::-1])
    return fwd, bwd


def mlstm_chunkwise(q, k, v, log_i, log_f, state):
    bsz, nh, length, dh = q.shape
    nc = length // MLSTM_CHUNK

    def chunks(a):
        return jnp.moveaxis(a.reshape(bsz, nh, nc, MLSTM_CHUNK, *a.shape[3:]), 2, 0)

    causal = jnp.tril(jnp.ones((MLSTM_CHUNK, MLSTM_CHUNK), bool))

    def step(carry, xs):
        c_mat, n_vec, m = carry
        qc, kc, vc, li, lf = xs
        b = jnp.cumsum(lf, axis=-1)
        inter = b + m[..., None]
        dmat = jnp.where(causal, b[..., :, None] - b[..., None, :] + li[..., None, :], -jnp.inf)
        m_t = jnp.maximum(inter, dmat.max(-1))
        wts = jnp.exp(dmat - m_t[..., None])
        s_inter = jnp.exp(inter - m_t)
        scores = jnp.einsum('bhtd,bhsd->bhts', qc, kc) * wts
        num = s_inter[..., None] * jnp.einsum('bhvd,bhtd->bhtv', c_mat, qc) + jnp.einsum('bhts,bhsv->bhtv', scores, vc)
        den = s_inter * jnp.einsum('bhd,bhtd->bht', n_vec, qc) + scores.sum(-1)
        h = num / jnp.maximum(jnp.abs(den), jnp.exp(-m_t))[..., None]
        b_end = b[..., -1]
        g = b_end[..., None] - b + li
        m_new = jnp.maximum(b_end + m, g.max(-1))
        decay = jnp.exp(b_end + m - m_new)
        w = jnp.exp(g - m_new[..., None])
        c_mat = decay[..., None, None] * c_mat + jnp.einsum('bhsv,bhsd->bhvd', vc * w[..., None], kc)
        n_vec = decay[..., None] * n_vec + jnp.einsum('bhs,bhsd->bhd', w, kc)
        return (c_mat, n_vec, m_new), h

    state, h = lax.scan(step, state, (chunks(q), chunks(k), chunks(v), chunks(log_i), chunks(log_f)))
    return jnp.moveaxis(h, 0, 2).reshape(bsz, nh, length, dh), state


def heads_to_tokens(h):
    bsz, nh, length, dh = h.shape
    return h.transpose(0, 2, 1, 3).reshape(bsz, length, nh * dh)


def hyena_filter_spectra(length, w_f1, b_f1, w_fh, b_fh, freq, w_fout):
    t = jnp.linspace(0.0, 1.0, length, dtype=F32)[:, None]
    bands = (HYENA_EMB - 1) // 2
    f = jnp.linspace(1e-4, bands - 1, bands, dtype=F32)[None, :]
    ang = 2.0 * math.pi * jnp.arange(length, dtype=F32)[:, None] * f / length
    z = jnp.concatenate([t, jnp.cos(ang), -jnp.sin(ang)], axis=-1)
    freq = freq.astype(F32)
    a = jnp.sin(freq[0] * (z @ w_f1.astype(F32) + b_f1.astype(F32)))
    a = jnp.sin(freq[1] * (a @ w_fh[0].astype(F32) + b_fh[0].astype(F32)))
    a = jnp.sin(freq[2] * (a @ w_fh[1].astype(F32) + b_fh[1].astype(F32)))
    h = (a @ w_fout.astype(F32)).reshape(length, HYENA_ORDER, 2, HYENA_WIDTH)
    max_decay = math.log(HYENA_DECAY_TARGET) / HYENA_SHORT_DECAY_PCT
    min_decay = math.log(HYENA_DECAY_TARGET) / HYENA_LONG_DECAY_PCT
    deltas = jnp.abs(jnp.linspace(min_decay, max_decay, HYENA_WIDTH, dtype=F32))
    h = h * jnp.exp(-t * deltas)[:, None, None, :]
    h_fwd, h_bwd = h[:, :, 0], h[:, :, 1]
    taps = jnp.concatenate([h_fwd, jnp.zeros((1, HYENA_ORDER, HYENA_WIDTH), F32), h_bwd[1:][::-1]], axis=0)
    return jnp.fft.rfft(taps, axis=0)


def hyena_operator(z, rows, cols, conv_w, conv_b, w_f1, b_f1, w_fh, b_fh, freq, w_fout, skip):
    u = grid_dwconv(z[..., IN_HYENA:IN_BRANCH_GATES], conv_w, conv_b, rows, cols).astype(F32)
    x1, x2, v = jnp.split(u, 3, axis=-1)
    length = u.shape[1]
    spec = hyena_filter_spectra(length, w_f1, b_f1, w_fh, b_fh, freq, w_fout)
    skip = skip.astype(F32)
    for n, gate in enumerate((x1, x2)):
        vf = jnp.fft.rfft(v, n=2 * length, axis=1)
        y = jnp.fft.irfft(vf * spec[None, :, n], n=2 * length, axis=1)[:, :length]
        v = gate * (y + v * skip[n])
    return v


def merge_branches(z, h_mlstm, h_hyena, w_proj_a, w_proj_h, w_out):
    o = jax.nn.sigmoid(z[..., IN_O:IN_HYENA])
    y_a = (o * h_mlstm.astype(z.dtype)) @ w_proj_a
    y_h = h_hyena.astype(z.dtype) @ w_proj_h
    g_a, g_h = jnp.split(jax.nn.sigmoid(z[..., IN_BRANCH_GATES:]), 2, axis=-1)
    return (g_a * y_a + g_h * y_h) @ w_out


def moe_ffn(h, w_router, b_router, w_gate, b_gate, w_up, b_up, w_down, b_down):
    n_tok, dm = h.shape
    logits = (h @ w_router + b_router).astype(F32)
    top_logit, top_e = lax.top_k(logits, TOP_K)
    weights = jax.nn.softmax(top_logit, axis=-1)
    tk = n_tok * TOP_K
    flat_e = top_e.reshape(tk)
    flat_t = jnp.repeat(jnp.arange(n_tok, dtype=jnp.int32), TOP_K)
    flat_w = weights.reshape(tk)
    order = jnp.argsort(flat_e)
    se, st, sw = flat_e[order], flat_t[order], flat_w[order]
    counts = jnp.bincount(flat_e, length=N_EXPERTS)
    padded = (counts + MOE_BLOCK - 1) // MOE_BLOCK * MOE_BLOCK
    start = jnp.cumsum(counts) - counts
    pend = jnp.cumsum(padded)
    pstart = pend - padded
    dest = pstart[se] + jnp.arange(tk) - start[se]
    n_blocks = -(-(tk + N_EXPERTS * (MOE_BLOCK - 1)) // MOE_BLOCK)
    rows_total = n_blocks * MOE_BLOCK
    row_tok = jnp.zeros((rows_total,), jnp.int32).at[dest].set(st)
    row_w = jnp.zeros((rows_total,), F32).at[dest].set(sw)
    block_e = jnp.minimum(jnp.searchsorted(pend, jnp.arange(n_blocks) * MOE_BLOCK, side='right'), N_EXPERTS - 1)
    xb = h[row_tok].reshape(n_blocks, MOE_BLOCK, dm)

    def expert_block(args):
        xe, e = args
        g = jnp.minimum(xe @ w_gate[e] + b_gate[e], SWIGLU_LIMIT)
        u = jnp.clip(xe @ w_up[e] + b_up[e], -SWIGLU_LIMIT, SWIGLU_LIMIT)
        act = g * jax.nn.sigmoid(SWIGLU_ALPHA * g) * (u + 1.0)
        return act @ w_down[e] + b_down[e]

    yb = lax.map(expert_block, (xb, block_e)).reshape(rows_total, dm)
    return jax.ops.segment_sum(yb * row_w[:, None].astype(yb.dtype), row_tok, num_segments=n_tok)


def setup_inputs(seed: int = 0) -> dict:
    key = jax.random.key(seed)
    ks = iter(jax.random.split(key, 48))

    def nrm(shape, scale):
        return jax.random.normal(next(ks), shape, F32) * scale

    dm, nl, nh, fh = D_MODEL, DEPTH, MLSTM_HEADS, HYENA_FILTER_HIDDEN
    b_in = nrm((nl, N_IN), 0.02)
    f_bias = jnp.linspace(3.0, 6.0, nh, dtype=F32)
    b_in = b_in.at[:, IN_GATES + nh:IN_GATES + 2 * nh].add(f_bias).at[:, IN_GATES + 3 * nh:IN_GATES + 4 * nh].add(f_bias)
    return {
        'x': nrm((BATCH, SEQ, dm), 1.0),
        'c': nrm((BATCH, dm), 1.0),
        'ctx': nrm((BATCH, CTX_LEN, dm), 1.0),
        'c_ctx': nrm((dm,), 1.0),
        'ln_in_g': 1.0 + nrm((dm,), 0.02),
        'ln_in_b': nrm((dm,), 0.02),
        'w_mod': nrm((nl, dm, 6 * dm), 0.5 * dm ** -0.5),
        'b_mod': nrm((nl, 6 * dm), 0.02),
        'w_in': nrm((nl, dm, N_IN), dm ** -0.5),
        'b_in': b_in,
        'mlstm_conv_w': nrm((nl, 3, 3, MLSTM_WIDTH), 1.0 / 3.0),
        'mlstm_conv_b': nrm((nl, MLSTM_WIDTH), 0.02),
        'w_qh': nrm((nl, nh, MLSTM_HEAD_DIM, MLSTM_HEAD_DIM), MLSTM_HEAD_DIM ** -0.5),
        'w_kh': nrm((nl, nh, MLSTM_HEAD_DIM, MLSTM_HEAD_DIM), MLSTM_HEAD_DIM ** -0.5),
        'hyena_conv_w': nrm((nl, 3, 3, (HYENA_ORDER + 1) * HYENA_WIDTH), 1.0 / 3.0),
        'hyena_conv_b': nrm((nl, (HYENA_ORDER + 1) * HYENA_WIDTH), 0.02),
        'filt_w1': nrm((nl, HYENA_EMB, fh), HYENA_EMB ** -0.5),
        'filt_b1': nrm((nl, fh), 0.1),
        'filt_wh': nrm((nl, 2, fh, fh), fh ** -0.5),
        'filt_bh': nrm((nl, 2, fh), 0.1),
        'filt_freq': 1.0 + nrm((nl, 3, fh), 0.02),
        'filt_wout': nrm((nl, fh, HYENA_ORDER * 2 * HYENA_WIDTH), 0.05 * fh ** -0.5),
        'hyena_skip': nrm((nl, HYENA_ORDER, HYENA_WIDTH), 0.5),
        'w_proj_a': nrm((nl, MLSTM_WIDTH, dm), MLSTM_WIDTH ** -0.5),
        'w_proj_h': nrm((nl, HYENA_WIDTH, dm), HYENA_WIDTH ** -0.5),
        'w_out': nrm((nl, dm, dm), DEEPNORM_BETA * dm ** -0.5),
        'ln1_g': 1.0 + nrm((nl, dm), 0.02),
        'ln1_b': nrm((nl, dm), 0.02),
        'w_router': nrm((nl, dm, N_EXPERTS), dm ** -0.5),
        'b_router': nrm((nl, N_EXPERTS), 0.01),
        'w_gate': nrm((nl, N_EXPERTS, dm, D_EXPERT), dm ** -0.5),
        'b_gate': nrm((nl, N_EXPERTS, D_EXPERT), 0.02),
        'w_up': nrm((nl, N_EXPERTS, dm, D_EXPERT), dm ** -0.5),
        'b_up': nrm((nl, N_EXPERTS, D_EXPERT), 0.02),
        'w_down': nrm((nl, N_EXPERTS, D_EXPERT, dm), DEEPNORM_BETA * D_EXPERT ** -0.5),
        'b_down': nrm((nl, N_EXPERTS, dm), 0.02),
        'ln2_g': 1.0 + nrm((nl, dm), 0.02),
        'ln2_b': nrm((nl, dm), 0.02),
    }


def reference(x, c, ctx, c_ctx, ln_in_g, ln_in_b, w_mod, b_mod, w_in, b_in, mlstm_conv_w, mlstm_conv_b,
              w_qh, w_kh, hyena_conv_w, hyena_conv_b, filt_w1, filt_b1, filt_wh, filt_bh, filt_freq, filt_wout,
              hyena_skip, w_proj_a, w_proj_h, w_out, ln1_g, ln1_b, w_router, b_router, w_gate, b_gate,
              w_up, b_up, w_down, b_down, ln2_g, ln2_b):
    bsz, seq, dm = x.shape
    rows = seq // GRID_W
    ctx_len = ctx.shape[1]
    x = layer_norm(x, ln_in_g, ln_in_b)
    xc = layer_norm(ctx, ln_in_g, ln_in_b)
    s_lat = jax.nn.silu(c)
    s_ctx = jax.nn.silu(c_ctx)[None]
    for l in range(DEPTH):
        last = l == DEPTH - 1
        sh1, sc1, g1, sh2, sc2, g2 = jnp.split((s_lat @ w_mod[l] + b_mod[l])[:, None, :], 6, axis=-1)
        csh1, csc1, cg1, csh2, csc2, cg2 = jnp.split((s_ctx @ w_mod[l] + b_mod[l])[:, None, :], 6, axis=-1)

        hx = x * (1.0 + sc1) + sh1
        hc = xc * (1.0 + csc1) + csh1
        zx = hx @ w_in[l] + b_in[l]
        n_ctx_cols = IN_O if last else N_IN
        zc = hc @ w_in[l][:, :n_ctx_cols] + b_in[l][:n_ctx_cols]
        mlstm_p = (mlstm_conv_w[l], mlstm_conv_b[l], w_qh[l], w_kh[l])
        hyena_p = (hyena_conv_w[l], hyena_conv_b[l], filt_w1[l], filt_b1[l], filt_wh[l], filt_bh[l],
                   filt_freq[l], filt_wout[l], hyena_skip[l])
        zero = mlstm_zero_state(bsz)
        ctx_fwd, ctx_bwd = mlstm_prepare(zc, 1, ctx_len, *mlstm_p)
        hcf, state_f = mlstm_chunkwise(*ctx_fwd, zero)
        hcb, state_b = mlstm_chunkwise(*ctx_bwd, zero)
        lat_fwd, lat_bwd = mlstm_prepare(zx, rows, GRID_W, *mlstm_p)
        hxf, _ = mlstm_chunkwise(*lat_fwd, state_f)
        hxb, _ = mlstm_chunkwise(*lat_bwd, state_b)
        h_mlstm_x = heads_to_tokens(hxf + hxb[:, :, ::-1])
        h_hyena_x = hyena_operator(zx, rows, GRID_W, *hyena_p)
        mix_x = merge_branches(zx, h_mlstm_x, h_hyena_x, w_proj_a[l], w_proj_h[l], w_out[l])
        x = layer_norm(DEEPNORM_ALPHA * x + g1 * mix_x, ln1_g[l], ln1_b[l])
        if not last:
            h_mlstm_c = heads_to_tokens(hcf + hcb[:, :, ::-1])
            h_hyena_c = hyena_operator(zc, 1, ctx_len, *hyena_p)
            mix_c = merge_branches(zc, h_mlstm_c, h_hyena_c, w_proj_a[l], w_proj_h[l], w_out[l])
            xc = layer_norm(DEEPNORM_ALPHA * xc + cg1 * mix_c, ln1_g[l], ln1_b[l])

        tokens = (x * (1.0 + sc2) + sh2).reshape(bsz * seq, dm)
        if not last:
            tokens = jnp.concatenate([tokens, (xc * (1.0 + csc2) + csh2).reshape(bsz * ctx_len, dm)], axis=0)
        y = moe_ffn(tokens, w_router[l], b_router[l], w_gate[l], b_gate[l], w_up[l], b_up[l], w_down[l], b_down[l])
        x = layer_norm(DEEPNORM_ALPHA * x + g2 * y[:bsz * seq].reshape(bsz, seq, dm), ln2_g[l], ln2_b[l])
        if not last:
            xc = layer_norm(DEEPNORM_ALPHA * xc + cg2 * y[bsz * seq:].reshape(bsz, ctx_len, dm), ln2_g[l], ln2_b[l])
    return x
```

```cpp
#include <hip/hip_runtime.h>
#include <cstdio>
#include <cstdint>

#define GAS __attribute__((address_space(1)))
#define LAS __attribute__((address_space(3)))
typedef unsigned short bf16_t;
typedef short bf16x8 __attribute__((ext_vector_type(8)));
typedef float f32x4 __attribute__((ext_vector_type(4)));
typedef float f32x2 __attribute__((ext_vector_type(2)));
typedef unsigned u32x4 __attribute__((ext_vector_type(4)));
typedef unsigned u32x2 __attribute__((ext_vector_type(2)));

#ifndef MK_LAUNCHES
#define MK_LAUNCHES 1
#endif

constexpr int DM = 2048, NB = 8, SEQ = 2048, CTX = 256, GW = 64;
constexpr int MTOK = NB * SEQ;
constexpr int MCTX = NB * CTX;
constexpr int MALL = MTOK + MCTX;
constexpr int NH = 4, HD = 256, MW = 1024, HW = 1024;
constexpr int N_IN = 10256;
constexpr int NEXP = 32, TOPK = 4;
constexpr float LN_EPS = 1e-5f;
constexpr float DN_ALPHA = 1.189207115002721f;
constexpr int ZN = 7424, ZC_QK = 0, ZC_V = 1024, ZC_O = 2048, ZC_GA = 3072, ZC_GH = 5120, ZC_GT = 7168;
constexpr int WIN_ROWS = 10496, WIN_HY0 = 7424;
constexpr int MAXTILES = 288;
constexpr int POSCAP = 16384;

constexpr size_t MiB = 1u << 20;
constexpr size_t WS_CTL = 0;
constexpr size_t WS_MODP = 1 * MiB;
constexpr size_t WS_MOD = 9 * MiB;
constexpr size_t WS_BINP = 10 * MiB;
constexpr size_t WS_A3 = 10 * MiB + 64 * 1024;
constexpr size_t WS_STATS = 11 * MiB;
constexpr size_t WS_TOPE = 11 * MiB + 256 * 1024;
constexpr size_t WS_TOPP = 11 * MiB + 512 * 1024;
constexpr size_t WS_TOPW = 11 * MiB + 768 * 1024;
constexpr size_t WS_RTOK = 12 * MiB;
constexpr size_t WS_RW = 14 * MiB;
constexpr size_t WS_WQK = 16 * MiB;
constexpr size_t WS_WPH = 17 * MiB;
constexpr size_t WS_WPA2 = 21 * MiB;
constexpr size_t WS_WOUT = 29 * MiB;
constexpr size_t WS_WIN = 37 * MiB;
constexpr size_t WS_WGU = 78 * MiB;
constexpr size_t WS_WD = 590 * MiB;
constexpr size_t WS_RA = 846 * MiB;
constexpr size_t WS_Z = WS_RA, WS_ZT = WS_RA + 261 * MiB, WS_ACT = WS_RA;
constexpr size_t WS_RB = 1203 * MiB;
constexpr size_t WS_HX = WS_RB, WS_U = WS_RB + 72 * MiB, WS_QKB = WS_RB + 108 * MiB, WS_AM = WS_RB + 180 * MiB, WS_HH = WS_RB + 244 * MiB, WS_MX = WS_RB + 276 * MiB, WS_YR = WS_RB;
constexpr size_t WS_RC = 1543 * MiB;
constexpr size_t WS_HTAPS = WS_RC, WS_H = WS_RC + 32 * MiB, WS_T = WS_RC;
constexpr size_t WS_R1 = 1671 * MiB;
constexpr size_t WS_TOK = 1799 * MiB;
constexpr size_t WS_END = 1863 * MiB;
constexpr int CW_TMO = 0, CW_BAR = 4096, CW_CNT = 16384;
constexpr size_t CTL_ZERO_BYTES = 1 * MiB;

constexpr int LDS_BYTES = 160 * 1024 - 2048;
constexpr int MISC_OFF = LDS_BYTES - 1024;
constexpr int NWAVES = 8, NTHR = 512;

#define LDS_WAIT() asm volatile("s_waitcnt lgkmcnt(0)" ::: "memory")
#define VM_WAIT() asm volatile("s_waitcnt vmcnt(0)" ::: "memory")
__device__ __forceinline__ unsigned f2bf(float f) { unsigned u = __builtin_bit_cast(unsigned, f); return (u + 0x7fffu + ((u >> 16) & 1u)) >> 16; }
__device__ __forceinline__ unsigned pk2(float lo, float hi) { return f2bf(lo) | (f2bf(hi) << 16); }
__device__ __forceinline__ float bf2f(unsigned b) { return __builtin_bit_cast(float, b << 16); }
__device__ __forceinline__ float bflo(unsigned w) { return __builtin_bit_cast(float, w << 16); }
__device__ __forceinline__ float bfhi(unsigned w) { return __builtin_bit_cast(float, w & 0xffff0000u); }
__device__ __forceinline__ float sigmoidf_(float x) { return 1.0f / (1.0f + __expf(-x)); }
__device__ __forceinline__ float wave_sum(float v) {
#pragma unroll
    for (int o = 1; o < 64; o <<= 1) v += __shfl_xor(v, o);
    return v;
}

#define XB_TMO      128
#define XB_XCNT(j)  (256  + 64 * (j))
#define XB_XSUB(j)  (1280 + 64 * (j))
#define XB_XGEN(j)  (2304 + 64 * (j))
#define XB_TOP      3328
#define XB_TOPGEN   3392
#define XCD_BAR_WORDS 3456
#define XB_SPIN_CAP (1u << 22)
__device__ __forceinline__ unsigned xb_ld(unsigned* p)              { return __hip_atomic_load(p, __ATOMIC_RELAXED, __HIP_MEMORY_SCOPE_AGENT); }
__device__ __forceinline__ unsigned xb_add(unsigned* p, unsigned v) { return __hip_atomic_fetch_add(p, v, __ATOMIC_RELAXED, __HIP_MEMORY_SCOPE_AGENT); }
__device__ __forceinline__ unsigned xb_xcc_id() { return (unsigned)__builtin_amdgcn_s_getreg((3 << 11) | 20) & 0xFu; }
#define XB_SPIN(cond, bar) do { unsigned _sp = 0; while (cond) { __builtin_amdgcn_s_sleep(1); \
    if ((++_sp & 255u) == 0u) { if (xb_ld(&(bar)[XB_TMO])) break; if (_sp > XB_SPIN_CAP) { atomicAdd(&(bar)[XB_TMO], 1u); break; } } } } while (0)
struct XcdBarrier { unsigned* bar; unsigned x; volatile LAS unsigned* st; };
__device__ __forceinline__ XcdBarrier xcd_barrier_post(unsigned* bar, volatile LAS unsigned* st) {
    XcdBarrier b; b.bar = bar; b.x = xb_xcc_id(); b.st = st;
    if (threadIdx.x == 0) (void)xb_add(&bar[XB_XCNT(b.x)], 1u);
    return b;
}
__device__ __forceinline__ void xcd_barrier_complete(unsigned* bar, unsigned x, unsigned& nloc, unsigned& nx) {
    const unsigned G = gridDim.x * gridDim.y * gridDim.z;
    unsigned sum, cnt, mine, sp = 0u;
    for (;;) {
        sum = 0u; cnt = 0u; mine = 0u;
#pragma unroll
        for (unsigned j = 0; j < 16; ++j) { const unsigned c = xb_ld(&bar[XB_XCNT(j)]); sum += c; cnt += (c > 0u) ? 1u : 0u; mine = (j == x) ? c : mine; }
        if (sum == G) break;
        __builtin_amdgcn_s_sleep(1);
        if ((++sp & 255u) == 0u) { if (xb_ld(&bar[XB_TMO])) break; if (sp > XB_SPIN_CAP) { atomicAdd(&bar[XB_TMO], 1u); break; } }
    }
    nloc = mine > 0u ? mine : 1u; nx = cnt > 0u ? cnt : 1u;
}
__device__ __forceinline__ void xcd_barrier(const XcdBarrier& b) {
    asm volatile("s_waitcnt vmcnt(0)" ::: "memory");
    __syncthreads();
    if (threadIdx.x == 0) {
        unsigned* bar = b.bar;
        __builtin_amdgcn_s_waitcnt(0);
        unsigned nloc = b.st[0], nx = b.st[1];
        if (nloc == 0u) { xcd_barrier_complete(bar, b.x, nloc, nx); b.st[0] = nloc; b.st[1] = nx; }
        const unsigned old = xb_add(&bar[XB_XSUB(b.x)], 1u);
        const unsigned gen = old / nloc;
        if (old + 1u == (gen + 1u) * nloc) {
            __builtin_amdgcn_fence(__ATOMIC_RELEASE, "agent");
            asm volatile("s_waitcnt vmcnt(0)" ::: "memory");
            const unsigned og = xb_add(&bar[XB_TOP], 1u);
            const unsigned tg = og / nx;
            if (og + 1u == (tg + 1u) * nx) xb_add(&bar[XB_TOPGEN], 1u);
            else XB_SPIN(xb_ld(&bar[XB_TOPGEN]) == tg, bar);
            __builtin_amdgcn_fence(__ATOMIC_ACQUIRE, "agent");
            xb_add(&bar[XB_XGEN(b.x)], 1u);
            asm volatile("s_waitcnt vmcnt(0)" ::: "memory");
        } else {
            XB_SPIN(xb_ld(&bar[XB_XGEN(b.x)]) == gen, bar);
            __builtin_amdgcn_fence(__ATOMIC_ACQUIRE, "agent");
            asm volatile("s_waitcnt vmcnt(0)" ::: "memory");
        }
    }
    __syncthreads();
}

struct Args {
    const float* in[38];
    float* out; unsigned char* ws;
    int ph_lo, ph_hi;
};
enum { I_X = 0, I_C, I_CTX, I_CCTX, I_LNG, I_LNB, I_WMOD, I_BMOD, I_WIN, I_BIN, I_MCW, I_MCB, I_WQH, I_WKH, I_HCW, I_HCB, I_FW1, I_FB1, I_FWH, I_FBH,
       I_FFREQ, I_FWOUT, I_HSKIP, I_WPA, I_WPH, I_WOUT, I_LN1G, I_LN1B, I_WR, I_BR, I_WG, I_BG, I_WU, I_BU, I_WDN, I_BDN, I_LN2G, I_LN2B };

namespace pg8 {
constexpr int BM = 256, BK = 64, HALF = 128, HTB = HALF * BK * 2, STAGE_BYTES = 8 * HTB, NXCD = 8, WGM = 8;
__host__ __device__ __forceinline__ int lds_byte(int r, int c) { const int st = (r >> 4) * 2 + (c >> 5), rr = r & 15, cc = c & 31, ob = rr * 64 + cc * 2; return st * 1024 + (ob ^ (((ob >> 9) & 1) << 5)); }
__host__ __device__ __forceinline__ void stage_rc(int b, int& R, int& C) { const int st = b / 1024, sb = b % 1024, swz = sb ^ (((sb >> 9) & 1) << 5); R = (st >> 1) * 16 + swz / 64; C = (st & 1) * 32 + (swz % 64) / 2; }
__host__ __device__ __forceinline__ int perm32(int rho) { const int n = rho >> 4, i = rho & 15; return 8 * (i >> 2) + 4 * n + (i & 3); }
struct Unit { int pm, pn, ex; };
__device__ __forceinline__ void decode_tile(int L, int nM, int nN, int& pm, int& pn) {
    const int nwg = nM * nN; int wgid = L;
    { const int q = nwg / NXCD, r = nwg % NXCD, xcd = wgid % NXCD, off = wgid / NXCD; wgid = (xcd < r ? xcd * (q + 1) : r * (q + 1) + (xcd - r) * q) + off; }
    const int nig = WGM * nN, gid = wgid / nig, fm = gid * WGM, gsz = (nM - fm) < WGM ? (nM - fm) : WGM;
    pm = fm + ((wgid % nig) % gsz); pn = (wgid % nig) / gsz;
}
__device__ __forceinline__ unsigned cvt_pk_bf16(float lo, float hi) { unsigned r; asm volatile("v_cvt_pk_bf16_f32 %0, %1, %2" : "=v"(r) : "v"(lo), "v"(hi)); return r; }

template <class Epi, class Sched>
__device__ __forceinline__ void gemm_phase(LAS unsigned char* lds, const int K, const int lda, const int ldb, const Sched& S, const Epi& E) {
    const int tid = threadIdx.x, wid = __builtin_amdgcn_readfirstlane(tid >> 6), lane = tid & 63, wr = wid >> 2, wc = wid & 3, fr = lane & 15, fq = lane >> 4;
    const int nt = K / BK;
    int RA[2], CA[2]; unsigned voffB[2];
#pragma unroll
    for (int i = 0; i < 2; ++i) { int R, C; stage_rc(tid * 16 + i * 8192, R, C); const int Rb = Epi::PERM ? ((R & ~31) + perm32(R & 31)) : R;
        RA[i] = R; CA[i] = C; voffB[i] = (unsigned)(Rb * ldb + C) * 2u; }
    const size_t kstep = (size_t)(BK * 2);
    const size_t hstepB = (size_t)HALF * ldb * 2;
    const unsigned ldsw = (unsigned)wid * 1024u;
    const int aoff = lds_byte(wr * 64 + fr, fq * 8), boff = lds_byte(wc * 32 + fr, fq * 8);
#define PG8_SA(b, h) (((b) * 2 + (h)) * HTB)
#define PG8_SB(b, h) ((4 + (b) * 2 + (h)) * HTB)
#define PG8_STAGE(bufoff, gbase, v0, v1) do { \
        __builtin_amdgcn_global_load_lds((const unsigned*)((const char*)(gbase) + (v0)), (LAS unsigned*)(lds + (bufoff) + ldsw), 16, 0, 0); \
        __builtin_amdgcn_global_load_lds((const unsigned*)((const char*)(gbase) + (v1)), (LAS unsigned*)(lds + (bufoff) + ldsw + 8192), 16, 0, 0); } while (0)
#define PG8_LDA(dst, b, h) do { _Pragma("unroll") for (int m = 0; m < 4; ++m) _Pragma("unroll") for (int k = 0; k < 2; ++k) dst[m][k] = *(const LAS bf16x8*)(lds + PG8_SA(b, h) + aoff + m * 2048 + k * 1024); } while (0)
#define PG8_LDB(dst, b, h) do { _Pragma("unroll") for (int n = 0; n < 2; ++n) _Pragma("unroll") for (int k = 0; k < 2; ++k) dst[n][k] = *(const LAS bf16x8*)(lds + PG8_SB(b, h) + boff + n * 2048 + k * 1024); } while (0)
#define PG8_MMA(ai, bj, At, Bt) do { __builtin_amdgcn_s_setprio(1); _Pragma("unroll") for (int m = 0; m < 4; ++m) _Pragma("unroll") for (int n = 0; n < 2; ++n) _Pragma("unroll") for (int k = 0; k < 2; ++k) \
        acc[ai][bj][m][n] = __builtin_amdgcn_mfma_f32_16x16x32_bf16(Bt[n][k], At[m][k], acc[ai][bj][m][n], 0, 0, 0); __builtin_amdgcn_s_setprio(0); } while (0)
#define PG8_WAIT_V(n) asm volatile("s_waitcnt vmcnt(" #n ")" ::: "memory")
#define PG8_WAIT_L(n) asm volatile("s_waitcnt lgkmcnt(" #n ")" ::: "memory")
#define PG8_BAR __builtin_amdgcn_s_barrier()
#define PG8_SCHED __builtin_amdgcn_sched_barrier(0)
#define PG8_AOFF(u, o00, o01, o10, o11) do { \
        if (Sched::GATHER) { o00 = (unsigned)(S.a_row(u, RA[0]) * lda + CA[0]) * 2u; o01 = (unsigned)(S.a_row(u, RA[1]) * lda + CA[1]) * 2u; \
                             o10 = (unsigned)(S.a_row(u, RA[0] + HALF) * lda + CA[0]) * 2u; o11 = (unsigned)(S.a_row(u, RA[1] + HALF) * lda + CA[1]) * 2u; } \
        else { o00 = (unsigned)(RA[0] * lda + CA[0]) * 2u; o01 = (unsigned)(RA[1] * lda + CA[1]) * 2u; o10 = (unsigned)((RA[0] + HALF) * lda + CA[0]) * 2u; o11 = (unsigned)((RA[1] + HALF) * lda + CA[1]) * 2u; } } while (0)
    Unit cur, nxt; int ui = 0;
    if (!S.next(0, cur)) return;
    f32x4 acc[2][2][4][2];
#pragma unroll
    for (int a = 0; a < 2; ++a)
#pragma unroll
        for (int b = 0; b < 2; ++b)
#pragma unroll
            for (int m = 0; m < 4; ++m)
#pragma unroll
                for (int n = 0; n < 2; ++n) acc[a][b][m][n] = (f32x4){0.f, 0.f, 0.f, 0.f};
    bf16x8 At[4][2], B0[2][2], B1[2][2];
    const char* cA = S.a_base(cur); const char* cB = S.b_base(cur);
    unsigned c00, c01, c10, c11; PG8_AOFF(cur, c00, c01, c10, c11);
    const unsigned vb0 = voffB[0], vb1 = voffB[1];
    PG8_STAGE(PG8_SB(0, 0), cB, vb0, vb1); PG8_STAGE(PG8_SA(0, 0), cA, c00, c01); PG8_STAGE(PG8_SB(0, 1), cB + hstepB, vb0, vb1); PG8_STAGE(PG8_SA(0, 1), cA, c10, c11);
    if (wr == 1) PG8_BAR;
    PG8_WAIT_V(4); PG8_BAR;
    PG8_STAGE(PG8_SB(1, 0), cB + kstep, vb0, vb1); PG8_STAGE(PG8_SA(1, 0), cA + kstep, c00, c01); PG8_STAGE(PG8_SB(1, 1), cB + hstepB + kstep, vb0, vb1);
    PG8_WAIT_V(6); PG8_BAR;
    for (;;) {
        const bool has_next = S.next(ui + 1, nxt);
        const char* nA = has_next ? S.a_base(nxt) : cA; const char* nB = has_next ? S.b_base(nxt) : cB;
        unsigned n00 = c00, n01 = c01, n10 = c10, n11 = c11;
        if (has_next) PG8_AOFF(nxt, n00, n01, n10, n11);
        for (int t = 0; t < nt; t += 2) {
            const bool last = (t == nt - 2);
            const char* a1 = cA + (size_t)(t + 1) * kstep;
            const char* a2 = last ? nA : cA + (size_t)(t + 2) * kstep; const char* b2 = last ? nB : cB + (size_t)(t + 2) * kstep;
            const char* a3 = a2 + kstep; const char* b3 = b2 + kstep;
            const unsigned x00 = last ? n00 : c00, x01 = last ? n01 : c01, x10 = last ? n10 : c10, x11 = last ? n11 : c11;
            PG8_LDB(B0, 0, 0); PG8_SCHED; PG8_LDA(At, 0, 0); PG8_STAGE(PG8_SA(1, 1), a1, c10, c11);
            PG8_WAIT_L(8); PG8_BAR; PG8_WAIT_L(0); PG8_MMA(0, 0, At, B0); PG8_BAR; PG8_SCHED;
            PG8_LDB(B1, 0, 1); PG8_STAGE(PG8_SB(0, 0), b2, vb0, vb1);
            PG8_BAR; PG8_WAIT_L(0); PG8_MMA(0, 1, At, B1); PG8_BAR;
            PG8_LDA(At, 0, 1); PG8_STAGE(PG8_SA(0, 0), a2, x00, x01);
            PG8_BAR; PG8_WAIT_L(0); PG8_MMA(1, 0, At, B0); PG8_BAR; PG8_SCHED;
            PG8_STAGE(PG8_SB(0, 1), b2 + hstepB, vb0, vb1);
            PG8_WAIT_V(6); PG8_BAR; PG8_MMA(1, 1, At, B1); PG8_BAR;
            PG8_LDB(B0, 1, 0); PG8_SCHED; PG8_LDA(At, 1, 0); PG8_STAGE(PG8_SA(0, 1), a2, x10, x11);
            PG8_WAIT_L(8); PG8_BAR; PG8_WAIT_L(0); PG8_MMA(0, 0, At, B0); PG8_BAR; PG8_SCHED;
            PG8_LDB(B1, 1, 1); PG8_STAGE(PG8_SB(1, 0), b3, vb0, vb1);
            PG8_BAR; PG8_WAIT_L(0); PG8_MMA(0, 1, At, B1); PG8_BAR;
            PG8_LDA(At, 1, 1); PG8_STAGE(PG8_SA(1, 0), a3, x00, x01);
            PG8_BAR; PG8_WAIT_L(0); PG8_MMA(1, 0, At, B0); PG8_BAR; PG8_SCHED;
            PG8_STAGE(PG8_SB(1, 1), b3 + hstepB, vb0, vb1);
            PG8_WAIT_V(6); PG8_BAR; PG8_MMA(1, 1, At, B1); PG8_BAR;
        }
        E(acc, cur, wr, wc, fr, fq);
        if (!has_next) break;
#pragma unroll
        for (int a = 0; a < 2; ++a)
#pragma unroll
            for (int b = 0; b < 2; ++b)
#pragma unroll
                for (int m = 0; m < 4; ++m)
#pragma unroll
                    for (int n = 0; n < 2; ++n) acc[a][b][m][n] = (f32x4){0.f, 0.f, 0.f, 0.f};
        cur = nxt; cA = nA; cB = nB; c00 = n00; c01 = n01; c10 = n10; c11 = n11; ++ui;
    }
    PG8_WAIT_V(0);
    if (wr == 0) PG8_BAR;
    PG8_BAR;
#undef PG8_SA
#undef PG8_SB
#undef PG8_STAGE
#undef PG8_LDA
#undef PG8_LDB
#undef PG8_MMA
#undef PG8_WAIT_V
#undef PG8_WAIT_L
#undef PG8_BAR
#undef PG8_SCHED
#undef PG8_AOFF
}
}
using pg8::Unit;

typedef const float* cfp_t;
typedef __attribute__((address_space(4))) const cfp_t* KargP;
__device__ __forceinline__ KargP karg_opaque(KargP p) { asm volatile("" : "+s"(p)); return p; }
struct Frame {
    LAS unsigned char* lds;
    volatile LAS unsigned* MISC;
    unsigned* ctl;
    int tid, lane, wave, G, bid;
    KargP in;
    float* out; unsigned char* ws;
};
#define WSP(T, off) ((T*)(F.ws + (off)))

__device__ __forceinline__ void transpose_item(const float* src, size_t ld, int nvalid, float scale, bf16_t* dst, int K, LAS float* scr, int lane) {
#pragma unroll 8
    for (int i = 0; i < 32; ++i) { const int kk = 2 * i + (lane >> 5); const int j = lane & 31; scr[kk * 33 + j] = (j < nvalid) ? src[(size_t)kk * ld + j] * scale : 0.f; }
    LDS_WAIT(); asm volatile("" ::: "memory");
    const int c = lane & 7;
#pragma unroll
    for (int j = 0; j < 4; ++j) { const int n = (lane >> 3) + 8 * j; const LAS float* s = scr + (8 * c) * 33 + n;
        u32x4 o; o.x = pk2(s[0 * 33], s[1 * 33]); o.y = pk2(s[2 * 33], s[3 * 33]); o.z = pk2(s[4 * 33], s[5 * 33]); o.w = pk2(s[6 * 33], s[7 * 33]);
        *(u32x4*)(dst + (size_t)n * K + 8 * c) = o; }
    LDS_WAIT(); asm volatile("" ::: "memory");
}
__device__ __forceinline__ void p0_phase(Frame& F) {
    const KargP in = karg_opaque(F.in);
    LAS float* scr = (LAS float*)(F.lds + F.wave * 16384);
    const int gw = F.bid * NWAVES + F.wave, NGW = F.G * NWAVES;
    constexpr int IT_WIN = 32 * (WIN_ROWS / 32);
    constexpr int IT_WQK = 4 * 64;
    constexpr int IT_WPA2 = 32 * 64;
    constexpr int IT_WPH = 16 * 64;
    constexpr int IT_WOUT = 32 * 64;
    constexpr int IT_WGU1 = 32 * 128, IT_WGU = NEXP * IT_WGU1;
    constexpr int IT_WD1 = 32 * 64, IT_WD = NEXP * IT_WD1;
    constexpr int NITEMS = IT_WIN + IT_WQK + IT_WPA2 + IT_WPH + IT_WOUT + IT_WGU + IT_WD;
    for (int it = gw; it < NITEMS; it += NGW) {
        int r = it;
        if (r < IT_WIN) { const int g = r % (WIN_ROWS / 32), kb = r / (WIN_ROWS / 32); const int n0 = 32 * g; int sc, nv = 32;
            if (n0 < 2048) sc = n0; else if (n0 < 3072) sc = 2064 + (n0 - 2048); else if (n0 < 7168) sc = 6160 + (n0 - 3072); else if (n0 < 7200) { sc = 2048; nv = 16; } else if (n0 < WIN_HY0) { sc = 0; nv = 0; } else sc = 3088 + (n0 - WIN_HY0);
            transpose_item(in[I_WIN] + (size_t)(64 * kb) * N_IN + sc, N_IN, nv, 1.f, WSP(bf16_t, WS_WIN) + (size_t)n0 * DM + 64 * kb, DM, scr, F.lane); continue; } r -= IT_WIN;
        if (r < IT_WQK) { const int g = r % 64, kb = r / 64; const int n0 = 32 * g, h = n0 / 512, j = (n0 % 512) / 256, e0 = n0 % 256;
            const float* src = (j ? in[I_WKH] : in[I_WQH]) + (size_t)h * 65536 + (size_t)(64 * kb) * 256 + e0;
            transpose_item(src, 256, 32, j ? 0.0625f : 1.f, WSP(bf16_t, WS_WQK) + (size_t)n0 * 256 + 64 * kb, 256, scr, F.lane); continue; } r -= IT_WQK;
        if (r < IT_WPA2) { const int g = r % 64, kb = r / 64; const int n0 = 32 * g, k0 = 64 * kb;
            transpose_item(in[I_WPA] + (size_t)(k0 % 1024) * DM + n0, DM, 32, 1.f, WSP(bf16_t, WS_WPA2) + (size_t)n0 * 2048 + k0, 2048, scr, F.lane); continue; } r -= IT_WPA2;
        if (r < IT_WPH) { const int g = r % 64, kb = r / 64; const int n0 = 32 * g, k0 = 64 * kb;
            transpose_item(in[I_WPH] + (size_t)k0 * DM + n0, DM, 32, 1.f, WSP(bf16_t, WS_WPH) + (size_t)n0 * 1024 + k0, 1024, scr, F.lane); continue; } r -= IT_WPH;
        if (r < IT_WOUT) { const int g = r % 64, kb = r / 64; const int n0 = 32 * g, k0 = 64 * kb;
            transpose_item(in[I_WOUT] + (size_t)k0 * DM + n0, DM, 32, 1.f, WSP(bf16_t, WS_WOUT) + (size_t)n0 * 2048 + k0, 2048, scr, F.lane); continue; } r -= IT_WOUT;
        if (r < IT_WGU) { const int e = r / IT_WGU1, q = r % IT_WGU1; const int g = q % 128, kb = q / 128; const int n0 = 32 * g, k0 = 64 * kb, tile = n0 / 256, within = n0 % 256;
            const float* src = (within < 128 ? in[I_WG] : in[I_WU]) + (size_t)e * DM * DM + (size_t)k0 * DM + tile * 128 + (within & 127);
            transpose_item(src, DM, 32, 1.f, WSP(bf16_t, WS_WGU) + ((size_t)e * 4096 + n0) * DM + k0, DM, scr, F.lane); continue; } r -= IT_WGU;
        { const int e = r / IT_WD1, q = r % IT_WD1; const int g = q % 64, kb = q / 64; const int n0 = 32 * g, k0 = 64 * kb;
            transpose_item(in[I_WDN] + (size_t)e * DM * DM + (size_t)k0 * DM + n0, DM, 32, 1.f, WSP(bf16_t, WS_WD) + ((size_t)e * 2048 + n0) * DM + k0, DM, scr, F.lane); }
    }
    for (int i = F.bid * NTHR + F.tid; i < WIN_ROWS; i += F.G * NTHR) { int sc = -1;
        if (i < 2048) sc = i; else if (i < 3072) sc = 2064 + (i - 2048); else if (i < 7168) sc = 6160 + (i - 3072); else if (i < 7184) sc = 2048 + (i - 7168); else if (i < WIN_HY0) sc = -1; else sc = 3088 + (i - WIN_HY0);
        WSP(float, WS_BINP)[i] = sc >= 0 ? in[I_BIN][sc] : 0.f; }
    for (int it = gw; it < 16 * 48; it += NGW) {
        const int ks = it / 48, cg = it % 48; const int col = cg * 256 + F.lane * 4;
        f32x4 a[9];
#pragma unroll
        for (int v = 0; v < 9; ++v) a[v] = (f32x4){0.f, 0.f, 0.f, 0.f};
        for (int k = ks * 128; k < ks * 128 + 128; ++k) {
            const f32x4 w = *(const f32x4*)(in[I_WMOD] + (size_t)k * 12288 + col);
#pragma unroll
            for (int v = 0; v < 9; ++v) { const float cv = (v < 8) ? in[I_C][v * DM + k] : in[I_CCTX][k]; const float s = cv * sigmoidf_(cv); a[v] += w * s; }
        }
#pragma unroll
        for (int v = 0; v < 9; ++v) *(f32x4*)(WSP(float, WS_MODP) + ((size_t)ks * 9 + v) * 12288 + col) = a[v];
    }
    for (int j = gw; j < SEQ; j += NGW) {
        const int l = F.lane;
        float zv = 0.f;
        if (l == 0) zv = (float)j / (float)(SEQ - 1);
        else if (l < 33) { const int bi = (l - 1) & 15; const float f = 1e-4f + (float)bi * ((15.0f - 1e-4f) / 15.0f); const float ang = 6.283185307179586f * (float)j * f / (float)SEQ; zv = (l < 17) ? cosf(ang) : -sinf(ang); }
        float pre = in[I_FB1][l];
        for (int i = 0; i < 33; ++i) pre += __shfl(zv, i) * in[I_FW1][i * 64 + l];
        float a = sinf(in[I_FFREQ][l] * pre);
        pre = in[I_FBH][l];
        for (int i = 0; i < 64; ++i) pre += __shfl(a, i) * in[I_FWH][i * 64 + l];
        float a2 = sinf(in[I_FFREQ][64 + l] * pre);
        pre = in[I_FBH][64 + l];
        for (int i = 0; i < 64; ++i) pre += __shfl(a2, i) * in[I_FWH][4096 + i * 64 + l];
        WSP(float, WS_A3)[j * 64 + l] = sinf(in[I_FFREQ][128 + l] * pre);
    }
}

__device__ __forceinline__ void p0b_phase(Frame& F) {
    const KargP in = karg_opaque(F.in);
    for (int i = F.bid * NTHR + F.tid; i < 9 * 12288; i += F.G * NTHR) { const int col = i % 12288; float s = in[I_BMOD][col];
        for (int ks = 0; ks < 16; ++ks) s += WSP(float, WS_MODP)[(size_t)ks * 9 * 12288 + i];
        WSP(float, WS_MOD)[i] = s; }
    LAS float* wl = (LAS float*)F.lds;
    for (int un = F.bid; un < 256; un += F.G) {
        const int ct = un >> 2, pg = un & 3;
        __syncthreads();
        for (int q = 0; q < 8; ++q) { const int idx = F.tid + 512 * q, i = idx >> 6, cc = idx & 63; wl[cc * 68 + i] = in[I_FWOUT][(size_t)i * 4096 + ct * 64 + cc]; }
        __syncthreads();
        const int j = pg * 512 + F.wave * 64 + F.lane;
        f32x4 ar[16];
#pragma unroll
        for (int q = 0; q < 16; ++q) ar[q] = *(const f32x4*)(WSP(float, WS_A3) + j * 64 + 4 * q);
        const float tj = (float)j / (float)(SEQ - 1);
        const float mind = -3.0701134573253944f, maxd = -15.350567286626972f;
        const int cbase = (ct * 64) & 1023;
#pragma unroll 1
        for (int cc = 0; cc < 64; ++cc) {
            f32x4 s = (f32x4){0.f, 0.f, 0.f, 0.f};
#pragma unroll
            for (int q = 0; q < 16; ++q) s += ar[q] * *(const LAS f32x4*)(wl + cc * 68 + 4 * q);
            const float delta = fabsf(mind + (float)(cbase + cc) * ((maxd - mind) / 1023.0f));
            const float v = ((s.x + s.y) + (s.z + s.w)) * __expf(-tj * delta);
            WSP(float, WS_HTAPS)[(size_t)(ct * 64 + cc) * SEQ + j] = v;
        }
    }
}

__device__ __forceinline__ f32x2 cmul(f32x2 a, f32x2 b) { return (f32x2){a.x * b.x - a.y * b.y, a.x * b.y + a.y * b.x}; }
__device__ __forceinline__ f32x2 cmulc(f32x2 a, f32x2 b) { return (f32x2){a.x * b.x + a.y * b.y, a.y * b.x - a.x * b.y}; }
template <bool INV> __device__ __forceinline__ void dft4(f32x2& a, f32x2& b, f32x2& c, f32x2& d) {
    const f32x2 s0 = a + c, s1 = a - c, s2 = b + d, s3 = b - d;
    const f32x2 is3 = (f32x2){-s3.y, s3.x};
    a = s0 + s2; c = s0 - s2;
    if (!INV) { b = s1 - is3; d = s1 + is3; } else { b = s1 + is3; d = s1 - is3; }
}
template <bool INV> __device__ __forceinline__ void dft16(f32x2 (&v)[16]) {
#pragma unroll
    for (int n0 = 0; n0 < 4; ++n0) dft4<INV>(v[n0], v[4 + n0], v[8 + n0], v[12 + n0]);
    const float c1 = 0.9238795325112867f, s1 = 0.3826834323650898f, r2 = 0.7071067811865476f;
    const float cs[10] = {1.f, c1, r2, s1, 0.f, -s1, -r2, -c1, -1.f, -c1};
    const float sn[10] = {0.f, s1, r2, c1, 1.f, c1, r2, s1, 0.f, -s1};
#pragma unroll
    for (int k0 = 1; k0 < 4; ++k0)
#pragma unroll
        for (int n0 = 1; n0 < 4; ++n0) { const int m = n0 * k0; const f32x2 w = (f32x2){cs[m], INV ? sn[m] : -sn[m]}; v[4 * k0 + n0] = cmul(v[4 * k0 + n0], w); }
#pragma unroll
    for (int k0 = 0; k0 < 4; ++k0) dft4<INV>(v[4 * k0], v[4 * k0 + 1], v[4 * k0 + 2], v[4 * k0 + 3]);
#pragma unroll
    for (int a = 0; a < 4; ++a)
#pragma unroll
        for (int b = a + 1; b < 4; ++b) { const f32x2 t = v[4 * a + b]; v[4 * a + b] = v[4 * b + a]; v[4 * b + a] = t; }
}
__device__ __forceinline__ int fphys(int i) { return i + (i >> 4); }
constexpr int FFT_BUF_BYTES = (4096 + 256) * 8;
struct FftTw { f32x2 wA, wB; };
__device__ __forceinline__ FftTw fft_tw(int ht) { FftTw t; float s, c; sincospif(-(float)ht / 2048.0f, &s, &c); t.wA = (f32x2){c, s}; sincospif(-(float)(ht & 15) / 128.0f, &s, &c); t.wB = (f32x2){c, s}; return t; }
__device__ __forceinline__ void fft_fwd(f32x2 (&v)[16], LAS f32x2* buf, int ht, const FftTw& tw_) {
    FftTw tw = tw_; asm volatile("" : "+v"(ht), "+v"(tw.wA.x), "+v"(tw.wA.y), "+v"(tw.wB.x), "+v"(tw.wB.y));
    dft16<false>(v);
    { f32x2 w = tw.wA;
#pragma unroll
      for (int k = 1; k < 16; ++k) { v[k] = cmul(v[k], w); w = cmul(w, tw.wA); } }
#pragma unroll
    for (int k = 0; k < 16; ++k) buf[fphys(256 * k + ht)] = v[k];
    __syncthreads();
    const int ka = ht >> 4, s = ht & 15;
#pragma unroll
    for (int b = 0; b < 16; ++b) v[b] = buf[fphys(256 * ka + 16 * b + s)];
    dft16<false>(v);
    { f32x2 w = tw.wB;
#pragma unroll
      for (int k = 1; k < 16; ++k) { v[k] = cmul(v[k], w); w = cmul(w, tw.wB); } }
#pragma unroll
    for (int k = 0; k < 16; ++k) buf[fphys(256 * ka + 16 * k + s)] = v[k];
    __syncthreads();
#pragma unroll
    for (int q = 0; q < 16; ++q) v[q] = buf[fphys(16 * ht + q)];
    dft16<false>(v);
}
__device__ __forceinline__ void fft_inv(f32x2 (&v)[16], LAS f32x2* buf, int ht, const FftTw& tw_) {
    FftTw tw = tw_; asm volatile("" : "+v"(ht), "+v"(tw.wA.x), "+v"(tw.wA.y), "+v"(tw.wB.x), "+v"(tw.wB.y));
    dft16<true>(v);
#pragma unroll
    for (int q = 0; q < 16; ++q) buf[fphys(16 * ht + q)] = v[q];
    __syncthreads();
    const int ka = ht >> 4, s = ht & 15;
#pragma unroll
    for (int k = 0; k < 16; ++k) v[k] = buf[fphys(256 * ka + 16 * k + s)];
    { f32x2 w = tw.wB;
#pragma unroll
      for (int k = 1; k < 16; ++k) { v[k] = cmulc(v[k], w); w = cmul(w, tw.wB); } }
    dft16<true>(v);
#pragma unroll
    for (int b = 0; b < 16; ++b) buf[fphys(256 * ka + 16 * b + s)] = v[b];
    __syncthreads();
#pragma unroll
    for (int k = 0; k < 16; ++k) v[k] = buf[fphys(256 * k + ht)];
    { f32x2 w = tw.wA;
#pragma unroll
      for (int k = 1; k < 16; ++k) { v[k] = cmulc(v[k], w); w = cmul(w, tw.wA); } }
    dft16<true>(v);
    __syncthreads();
}

__device__ __forceinline__ void p1_phase(Frame& F) {
    const KargP in = karg_opaque(F.in);
    const int gw = F.bid * NWAVES + F.wave, NGW = F.G * NWAVES;
    const float* mod = WSP(float, WS_MOD);
    for (int row = gw; row < MALL; row += NGW) {
        const bool lat = row < MTOK;
        const float* xr = lat ? in[I_X] + (size_t)row * DM : in[I_CTX] + (size_t)(row - MTOK) * DM;
        const float* mv = mod + (size_t)(lat ? row / SEQ : 8) * 12288;
        f32x4 v[8]; float s = 0.f;
#pragma unroll
        for (int j = 0; j < 8; ++j) { v[j] = *(const f32x4*)(xr + F.lane * 4 + 256 * j); s += (v[j].x + v[j].y) + (v[j].z + v[j].w); }
        const float mean = wave_sum(s) * (1.f / DM); float s2 = 0.f;
#pragma unroll
        for (int j = 0; j < 8; ++j) { v[j] = v[j] - mean; s2 += (v[j].x * v[j].x + v[j].y * v[j].y) + (v[j].z * v[j].z + v[j].w * v[j].w); }
        const float rstd = 1.f / sqrtf(wave_sum(s2) * (1.f / DM) + LN_EPS);
        if (lat && F.lane == 0) { WSP(float, WS_STATS)[row * 2] = mean; WSP(float, WS_STATS)[row * 2 + 1] = rstd; }
        bf16_t* orow = WSP(bf16_t, WS_HX) + (size_t)row * DM;
#pragma unroll
        for (int j = 0; j < 8; ++j) { const int c = F.lane * 4 + 256 * j;
            const f32x4 g = *(const f32x4*)(in[I_LNG] + c), b = *(const f32x4*)(in[I_LNB] + c), sh = *(const f32x4*)(mv + c), sc = *(const f32x4*)(mv + 2048 + c);
            const f32x4 y = (v[j] * rstd * g + b) * (sc + 1.0f) + sh;
            u32x2 o; o.x = pk2(y.x, y.y); o.y = pk2(y.z, y.w); *(u32x2*)(orow + c) = o; }
    }
    const int hb = F.tid >> 8, ht = F.tid & 255;
    LAS f32x2* buf = (LAS f32x2*)(F.lds + hb * FFT_BUF_BYTES);
    const FftTw tw = fft_tw(ht);
    const float* htaps = WSP(float, WS_HTAPS);
    for (int u0 = F.bid * 2; u0 < 2048; u0 += F.G * 2) {
        const int un = u0 + hb, c = un >> 1, n = un & 1;
        const float* hf = htaps + (size_t)((n * 2 + 0) * 1024 + c) * SEQ, * hbk = htaps + (size_t)((n * 2 + 1) * 1024 + c) * SEQ;
        f32x2 v[16];
#pragma unroll
        for (int a = 0; a < 16; ++a) { const int i = 256 * a + ht; float x;
            if (a < 8) x = hf[i]; else if (i == 2048) x = 0.f; else x = hbk[4096 - i];
            v[a] = (f32x2){x * (1.0f / 4096.0f), 0.f}; }
        fft_fwd(v, buf, ht, tw);
        f32x2* Hd = WSP(f32x2, WS_H) + (size_t)un * 4096;
#pragma unroll
        for (int ks = 0; ks < 16; ++ks) Hd[ks * 256 + ht] = v[ks];
        __syncthreads();
    }
}

struct SchedZ {
    static constexpr bool GATHER = false;
    int G, c; const char* hx; const char* win;
    __device__ __forceinline__ bool next(int i, Unit& u) const {
        int L = i * G + c;
        if (L < 1856) { pg8::decode_tile(L, 64, 29, u.pm, u.pn); u.ex = 0; return true; } L -= 1856;
        if (L < 768) { pg8::decode_tile(L, 12, 64, u.pm, u.pn); u.ex = 1; return true; } L -= 768;
        if (L < 72) { int pm, pn; pg8::decode_tile(L, 8, 9, pm, pn); u.pm = 64 + pm; u.pn = pn < 8 ? pn : 28; u.ex = 0; return true; }
        return false;
    }
    __device__ __forceinline__ const char* a_base(const Unit& u) const { return u.ex ? win + (size_t)(WIN_HY0 + 256 * u.pm) * DM * 2 : hx + (size_t)(256 * u.pm) * DM * 2; }
    __device__ __forceinline__ const char* b_base(const Unit& u) const { return u.ex ? hx + (size_t)(256 * u.pn) * DM * 2 : win + (size_t)(256 * u.pn) * DM * 2; }
    __device__ __forceinline__ int a_row(const Unit&, int R) const { return R; }
};
struct EpiZ {
    static constexpr bool PERM = true;
    bf16_t* Z; bf16_t* ZT; const float* bias;
    __device__ __forceinline__ void operator()(const f32x4 (&acc)[2][2][4][2], const Unit& u, int wr, int wc, int fr, int fq) const {
        if (u.ex == 0) {
            const int row0 = u.pm * 256 + wr * 64 + fr, col0 = u.pn * 256 + wc * 32 + 8 * fq;
            f32x4 bv[2][2];
#pragma unroll
            for (int bj = 0; bj < 2; ++bj)
#pragma unroll
                for (int n = 0; n < 2; ++n) bv[bj][n] = *(const f32x4*)(bias + col0 + bj * 128 + 4 * n);
#pragma unroll
            for (int ai = 0; ai < 2; ++ai)
#pragma unroll
                for (int m = 0; m < 4; ++m) { bf16_t* rowp = Z + (size_t)(row0 + ai * 128 + m * 16) * ZN + col0;
#pragma unroll
                    for (int bj = 0; bj < 2; ++bj) { const f32x4 v0 = acc[ai][bj][m][0] + bv[bj][0], v1 = acc[ai][bj][m][1] + bv[bj][1];
                        u32x4 w; w.x = pg8::cvt_pk_bf16(v0[0], v0[1]); w.y = pg8::cvt_pk_bf16(v0[2], v0[3]); w.z = pg8::cvt_pk_bf16(v1[0], v1[1]); w.w = pg8::cvt_pk_bf16(v1[2], v1[3]);
                        *(u32x4*)(rowp + bj * 128) = w; } }
        } else {
            const int ch0 = u.pm * 256 + wr * 64 + fr, b = u.pn >> 3, t0 = (u.pn & 7) * 256 + wc * 32 + 8 * fq;
#pragma unroll
            for (int ai = 0; ai < 2; ++ai)
#pragma unroll
                for (int m = 0; m < 4; ++m) { const int ch = ch0 + ai * 128 + m * 16; const float bb = bias[WIN_HY0 + ch];
                    bf16_t* rowp = ZT + ((size_t)b * 3072 + ch) * SEQ + t0;
#pragma unroll
                    for (int bj = 0; bj < 2; ++bj) { const f32x4 v0 = acc[ai][bj][m][0] + bb, v1 = acc[ai][bj][m][1] + bb;
                        u32x4 w; w.x = pg8::cvt_pk_bf16(v0[0], v0[1]); w.y = pg8::cvt_pk_bf16(v0[2], v0[3]); w.z = pg8::cvt_pk_bf16(v1[0], v1[1]); w.w = pg8::cvt_pk_bf16(v1[2], v1[3]);
                        *(u32x4*)(rowp + bj * 128) = w; } }
        }
    }
};

__device__ __forceinline__ void p3_phase(Frame& F) {
    const KargP in = karg_opaque(F.in);
    const bf16_t* Z = WSP(bf16_t, WS_Z); bf16_t* U = WSP(bf16_t, WS_U);
    const float* cw = in[I_MCW]; const float* cb = in[I_MCB];
    for (int it = F.bid * NTHR + F.tid; it < MALL * 128; it += F.G * NTHR) {
        const int row = it >> 7, c0 = (it & 127) * 8;
        float a[8];
        { const f32x4 b0 = *(const f32x4*)(cb + c0), b1 = *(const f32x4*)(cb + c0 + 4); a[0] = b0.x; a[1] = b0.y; a[2] = b0.z; a[3] = b0.w; a[4] = b1.x; a[5] = b1.y; a[6] = b1.z; a[7] = b1.w; }
        const bool lat = row < MTOK;
        int base, y, x, H, Wd;
        if (lat) { const int t = row & (SEQ - 1); base = row - t; y = t >> 6; x = t & 63; H = 32; Wd = 64; }
        else { const int t = (row - MTOK) & (CTX - 1); base = row - t; y = 0; x = t; H = 1; Wd = CTX; }
#pragma unroll
        for (int dy = -1; dy <= 1; ++dy)
#pragma unroll
            for (int dx = -1; dx <= 1; ++dx) {
                const int yy = y + dy, xx = x + dx;
                if (yy < 0 || yy >= H || xx < 0 || xx >= Wd) continue;
                const int srow = base + yy * Wd + xx;
                const u32x4 zz = *(const u32x4*)(Z + (size_t)srow * ZN + ZC_QK + c0);
                const float* wp = cw + ((dy + 1) * 3 + (dx + 1)) * MW + c0;
                const f32x4 w0 = *(const f32x4*)wp, w1 = *(const f32x4*)(wp + 4);
                a[0] += bflo(zz.x) * w0.x; a[1] += bfhi(zz.x) * w0.y; a[2] += bflo(zz.y) * w0.z; a[3] += bfhi(zz.y) * w0.w;
                a[4] += bflo(zz.z) * w1.x; a[5] += bfhi(zz.z) * w1.y; a[6] += bflo(zz.w) * w1.z; a[7] += bfhi(zz.w) * w1.w;
            }
#pragma unroll
        for (int j = 0; j < 8; ++j) a[j] = a[j] * sigmoidf_(a[j]);
        u32x4 o; o.x = pk2(a[0], a[1]); o.y = pk2(a[2], a[3]); o.z = pk2(a[4], a[5]); o.w = pk2(a[6], a[7]);
        *(u32x4*)(U + (size_t)row * MW + c0) = o;
    }
}

struct SchedQK {
    static constexpr bool GATHER = false;
    int G, c; const char* u; const char* w;
    __device__ __forceinline__ bool next(int i, Unit& un) const { const int L = i * G + c; if (L >= 72 * 8) return false; pg8::decode_tile(L, 72, 8, un.pm, un.pn); un.ex = 0; return true; }
    __device__ __forceinline__ const char* a_base(const Unit& un) const { return u + ((size_t)(256 * un.pm) * MW + (un.pn >> 1) * 256) * 2; }
    __device__ __forceinline__ const char* b_base(const Unit& un) const { return w + (size_t)(256 * un.pn) * 256 * 2; }
    __device__ __forceinline__ int a_row(const Unit&, int R) const { return R; }
};
struct EpiQK {
    static constexpr bool PERM = true;
    bf16_t* O;
    __device__ __forceinline__ void operator()(const f32x4 (&acc)[2][2][4][2], const Unit& u, int wr, int wc, int fr, int fq) const {
        const int row0 = u.pm * 256 + wr * 64 + fr, col0 = u.pn * 256 + wc * 32 + 8 * fq;
#pragma unroll
        for (int ai = 0; ai < 2; ++ai)
#pragma unroll
            for (int m = 0; m < 4; ++m) { bf16_t* rowp = O + (size_t)(row0 + ai * 128 + m * 16) * 2048 + col0;
#pragma unroll
                for (int bj = 0; bj < 2; ++bj) { const f32x4 v0 = acc[ai][bj][m][0], v1 = acc[ai][bj][m][1];
                    u32x4 w; w.x = pg8::cvt_pk_bf16(v0[0], v0[1]); w.y = pg8::cvt_pk_bf16(v0[2], v0[3]); w.z = pg8::cvt_pk_bf16(v1[0], v1[1]); w.w = pg8::cvt_pk_bf16(v1[2], v1[3]);
                    *(u32x4*)(rowp + bj * 128) = w; } }
    }
};

constexpr int ML_QS = 264, ML_VS = 72, ML_PS = 72;
constexpr int ML_Q = 0, ML_K = ML_Q + 64 * ML_QS * 2, ML_V = ML_K + 64 * ML_QS * 2, ML_C = ML_V + 64 * ML_VS * 2, ML_P = ML_C + 80 * ML_QS * 2, ML_SC = ML_P + 64 * ML_PS * 2;
constexpr int ML_SA = ML_SC, ML_SU = ML_SC + 256, ML_SSI = ML_SC + 512, ML_SWG = ML_SC + 768, ML_SEM = ML_SC + 1024, ML_SDEN = ML_SC + 1280, ML_SMISC = ML_SC + 1536, ML_END = ML_SC + 1600;
static_assert(ML_END <= MISC_OFF, "mlstm LDS");
__device__ __forceinline__ bf16x8 lds_frag(const LAS bf16_t* p) { return *(const LAS bf16x8*)p; }
__device__ __forceinline__ void mlstm_unit(Frame& F, int un) {
    const int vs = un & 3, dir = (un >> 2) & 1, h = (un >> 3) & 3, b = un >> 5;
    const bf16_t* Z = WSP(bf16_t, WS_Z); const bf16_t* QK = WSP(bf16_t, WS_QKB); bf16_t* AM = WSP(bf16_t, WS_AM);
    LAS unsigned char* lds = F.lds;
    LAS bf16_t* Qs = (LAS bf16_t*)(lds + ML_Q); LAS bf16_t* Ks = (LAS bf16_t*)(lds + ML_K); LAS bf16_t* Vs = (LAS bf16_t*)(lds + ML_V);
    LAS bf16_t* Cs = (LAS bf16_t*)(lds + ML_C); LAS bf16_t* Ps = (LAS bf16_t*)(lds + ML_P);
    LAS float* sA = (LAS float*)(lds + ML_SA); LAS float* sU = (LAS float*)(lds + ML_SU); LAS float* sSI = (LAS float*)(lds + ML_SSI);
    LAS float* sWG = (LAS float*)(lds + ML_SWG); LAS float* sEM = (LAS float*)(lds + ML_SEM); LAS float* sDEN = (LAS float*)(lds + ML_SDEN); LAS float* sMI = (LAS float*)(lds + ML_SMISC);
    const int tid = F.tid, lane = F.lane, w = F.wave, l15 = lane & 15, g4 = lane >> 4;
    __syncthreads();
    for (int i = tid; i < 80 * ML_QS / 2; i += NTHR) ((LAS unsigned*)Cs)[i] = 0u;
    if (tid < 64) { Vs[tid * ML_VS + 64] = (bf16_t)0x3F80; for (int j = 65; j < ML_VS; ++j) Vs[tid * ML_VS + j] = 0; }
    f32x4 cacc[2][5];
#pragma unroll
    for (int a = 0; a < 2; ++a)
#pragma unroll
        for (int c = 0; c < 5; ++c) cacc[a][c] = (f32x4){0.f, 0.f, 0.f, 0.f};
    float m_run = 0.f;
    u32x4 pq[4], pk[4], pv; unsigned pgate = 0u, pgate2 = 0u;
#define ML_ROW0(st) ((st) < 4 ? (MTOK + b * CTX + 64 * (dir ? 3 - (st) : (st))) : (b * SEQ + 64 * (dir ? 35 - (st) : (st) - 4)))
#define ML_LOAD(st) do { const int r0_ = ML_ROW0(st); \
        _Pragma("unroll") for (int q_ = 0; q_ < 4; ++q_) { const int p_ = tid + 512 * q_, rr_ = p_ >> 5, cc_ = (p_ & 31) * 8; \
            pq[q_] = *(const u32x4*)(QK + (size_t)(r0_ + rr_) * 2048 + h * 512 + cc_); pk[q_] = *(const u32x4*)(QK + (size_t)(r0_ + rr_) * 2048 + h * 512 + 256 + cc_); } \
        { const int rr_ = tid >> 3, cc_ = (tid & 7) * 8; pv = *(const u32x4*)(Z + (size_t)(r0_ + rr_) * ZN + ZC_V + h * 256 + vs * 64 + cc_); } \
        if (tid < 64) { const bf16_t* gp_ = Z + (size_t)(r0_ + tid) * ZN + ZC_GT + dir * 8 + h; pgate = gp_[0]; pgate2 = gp_[4]; } } while (0)
#define ML_STORE() do { \
        _Pragma("unroll") for (int q_ = 0; q_ < 4; ++q_) { const int p_ = tid + 512 * q_, rr_ = p_ >> 5, cc_ = (p_ & 31) * 8; \
            *(LAS u32x4*)(Qs + rr_ * ML_QS + cc_) = pq[q_]; *(LAS u32x4*)(Ks + rr_ * ML_QS + cc_) = pk[q_]; } \
        { const int rr_ = tid >> 3, cc_ = (tid & 7) * 8; *(LAS u32x4*)(Vs + rr_ * ML_VS + cc_) = pv; } } while (0)
    ML_LOAD(0);
    __syncthreads();
    const int tt = w & 3; const int nv = (w < 4) ? 3 : 2;
#pragma unroll 1
    for (int st = 0; st < 36; ++st) {
        ML_STORE();
        if (w == 0) {
            const float li = bf2f(pgate), zf = bf2f(pgate2);
            const float lf = fminf(zf, 0.f) - log1pf(__expf(-fabsf(zf)));
            float bcs = lf;
#pragma unroll
            for (int o = 1; o < 64; o <<= 1) { const float t = dir ? __shfl_down(bcs, o) : __shfl_up(bcs, o); const bool ok = dir ? (lane + o < 64) : (lane >= o); bcs += ok ? t : 0.f; }
            const float a = li - bcs;
            float am = a;
#pragma unroll
            for (int o = 1; o < 64; o <<= 1) { const float t = dir ? __shfl_down(am, o) : __shfl_up(am, o); const bool ok = dir ? (lane + o < 64) : (lane >= o); am = ok ? fmaxf(am, t) : am; }
            const float inter = bcs + m_run;
            const float mt = fmaxf(inter, bcs + am);
            const float b_end = __shfl(bcs, dir ? 0 : 63);
            const float gg = b_end - bcs + li;
            float gm = gg;
#pragma unroll
            for (int o = 1; o < 64; o <<= 1) gm = fmaxf(gm, __shfl_xor(gm, o));
            const float m_new = fmaxf(b_end + m_run, gm);
            sA[lane] = a; sU[lane] = bcs - mt; sSI[lane] = __expf(inter - mt); sWG[lane] = __expf(gg - m_new); sEM[lane] = __expf(-mt);
            if (lane == 0) sMI[0] = __expf(b_end + m_run - m_new);
            m_run = m_new;
        }
        const int row0 = ML_ROW0(st);
        if (st + 1 < 36) ML_LOAD(st + 1);
        __syncthreads();
        {
            f32x4 sacc[2] = {(f32x4){0.f, 0.f, 0.f, 0.f}, (f32x4){0.f, 0.f, 0.f, 0.f}};
#pragma unroll
            for (int ks = 0; ks < 8; ++ks) {
                const bf16x8 qf = lds_frag(Qs + (16 * tt + l15) * ML_QS + 32 * ks + 8 * g4);
#pragma unroll
                for (int j = 0; j < 2; ++j) { const int stl = 2 * (w >> 2) + j;
                    const bf16x8 kf = lds_frag(Ks + (16 * stl + l15) * ML_QS + 32 * ks + 8 * g4);
                    sacc[j] = __builtin_amdgcn_mfma_f32_16x16x32_bf16(kf, qf, sacc[j], 0, 0, 0); }
            }
            const int t = 16 * tt + l15; const float ut = sU[t];
#pragma unroll
            for (int j = 0; j < 2; ++j) { const int s0 = 16 * (2 * (w >> 2) + j) + 4 * g4;
                const f32x4 av = *(const LAS f32x4*)(sA + s0);
                float pvv[4];
#pragma unroll
                for (int r = 0; r < 4; ++r) { const int s = s0 + r; const bool ok = dir ? (s >= t) : (s <= t); pvv[r] = ok ? sacc[j][r] * __expf(ut + av[r]) : 0.f; }
                u32x2 o; o.x = pk2(pvv[0], pvv[1]); o.y = pk2(pvv[2], pvv[3]);
                *(LAS u32x2*)(Ps + t * ML_PS + s0) = o; }
        }
        __syncthreads();
        f32x4 nacc[3], iacc[3];
#pragma unroll
        for (int j = 0; j < 3; ++j) { nacc[j] = (f32x4){0.f, 0.f, 0.f, 0.f}; iacc[j] = (f32x4){0.f, 0.f, 0.f, 0.f}; }
#pragma unroll
        for (int ks = 0; ks < 8; ++ks) {
            const bf16x8 qf = lds_frag(Qs + (16 * tt + l15) * ML_QS + 32 * ks + 8 * g4);
#pragma unroll
            for (int j = 0; j < 3; ++j) if (j < nv) { const int vt = (w < 4) ? (j == 2 ? 4 : j) : 2 + j;
                const bf16x8 cf = lds_frag(Cs + (16 * vt + l15) * ML_QS + 32 * ks + 8 * g4);
                iacc[j] = __builtin_amdgcn_mfma_f32_16x16x32_bf16(qf, cf, iacc[j], 0, 0, 0); }
        }
#pragma unroll
        for (int ks = 0; ks < 2; ++ks) {
            const bf16x8 pf = lds_frag(Ps + (16 * tt + l15) * ML_PS + 32 * ks + 8 * g4);
#pragma unroll
            for (int j = 0; j < 3; ++j) if (j < nv) { const int vt = (w < 4) ? (j == 2 ? 4 : j) : 2 + j;
                bf16x8 vf;
#pragma unroll
                for (int e = 0; e < 8; ++e) vf[e] = (short)Vs[(32 * ks + 8 * g4 + e) * ML_VS + 16 * vt + l15];
                nacc[j] = __builtin_amdgcn_mfma_f32_16x16x32_bf16(pf, vf, nacc[j], 0, 0, 0); }
        }
        const int t0 = 16 * tt + 4 * g4;
        {
            const f32x4 si = *(const LAS f32x4*)(sSI + t0);
#pragma unroll
            for (int j = 0; j < 3; ++j) if (j < nv) nacc[j] = nacc[j] + iacc[j] * si;
            if (w < 4 && l15 == 0) *(LAS f32x4*)(sDEN + t0) = nacc[2];
        }
        {
            const float decay = sMI[0];
#pragma unroll
            for (int a = 0; a < 2; ++a)
#pragma unroll
                for (int c = 0; c < 5; ++c) cacc[a][c] = cacc[a][c] * decay;
#pragma unroll
            for (int ks = 0; ks < 2; ++ks) {
                bf16x8 kf[2];
#pragma unroll
                for (int a = 0; a < 2; ++a)
#pragma unroll
                    for (int e = 0; e < 8; ++e) kf[a][e] = (short)Ks[(32 * ks + 8 * g4 + e) * ML_QS + 16 * (2 * w + a) + l15];
                float wg[8];
#pragma unroll
                for (int e = 0; e < 8; ++e) wg[e] = sWG[32 * ks + 8 * g4 + e];
#pragma unroll
                for (int c = 0; c < 5; ++c) {
                    u32x4 vw;
                    { float x[8];
#pragma unroll
                      for (int e = 0; e < 8; ++e) x[e] = bf2f((unsigned)Vs[(32 * ks + 8 * g4 + e) * ML_VS + 16 * c + l15]) * wg[e];
                      vw.x = pk2(x[0], x[1]); vw.y = pk2(x[2], x[3]); vw.z = pk2(x[4], x[5]); vw.w = pk2(x[6], x[7]); }
                    const bf16x8 vf = __builtin_bit_cast(bf16x8, vw);
#pragma unroll
                    for (int a = 0; a < 2; ++a) cacc[a][c] = __builtin_amdgcn_mfma_f32_16x16x32_bf16(kf[a], vf, cacc[a][c], 0, 0, 0);
                }
            }
        }
        __syncthreads();
        if (st >= 4) {
            const f32x4 dn = *(const LAS f32x4*)(sDEN + t0), em = *(const LAS f32x4*)(sEM + t0);
#pragma unroll
            for (int j = 0; j < 2; ++j) { const int vt = (w < 4) ? j : 2 + j; const int col = h * 256 + vs * 64 + 16 * vt + l15;
#pragma unroll
                for (int r = 0; r < 4; ++r) { const int row = row0 + t0 + r;
                    const float hv = nacc[j][r] / fmaxf(fabsf(dn[r]), em[r]);
                    const float o = sigmoidf_(bf2f((unsigned)Z[(size_t)row * ZN + ZC_O + col]));
                    AM[(size_t)row * 2048 + dir * 1024 + col] = (bf16_t)f2bf(o * hv); } }
        }
#pragma unroll
        for (int a = 0; a < 2; ++a)
#pragma unroll
            for (int c = 0; c < 5; ++c) { u32x2 o; o.x = pk2(cacc[a][c][0], cacc[a][c][1]); o.y = pk2(cacc[a][c][2], cacc[a][c][3]);
                *(LAS u32x2*)(Cs + (16 * c + l15) * ML_QS + 16 * (2 * w + a) + 4 * g4) = o; }
        __syncthreads();
    }
#undef ML_LOAD
#undef ML_STORE
#undef ML_ROW0
}

constexpr int HY_RAW = 2 * FFT_BUF_BYTES, HY_OUT = HY_RAW + 16384, HY_END = HY_OUT + 65536;
static_assert(HY_END <= MISC_OFF, "hyena LDS");
__device__ __forceinline__ void hy_conv(const LAS bf16_t* raw, const float* cw, float bias, int c3, int ht, f32x2 (&o)[8]) {
    float w9[9];
#pragma unroll
    for (int q = 0; q < 9; ++q) w9[q] = cw[q * 3072 + c3];
    asm volatile("" : "+v"(ht));
    const int x = ht & 63;
#pragma unroll
    for (int a = 0; a < 8; ++a) { const int t = 256 * a + ht, y = t >> 6; float a0 = bias, a1 = bias;
#pragma unroll
        for (int dy = -1; dy <= 1; ++dy)
#pragma unroll
            for (int dx = -1; dx <= 1; ++dx) { const int yy = y + dy, xx = x + dx;
                if (yy >= 0 && yy < 32 && xx >= 0 && xx < 64) { const int idx = t + 64 * dy + dx; const float wv = w9[(dy + 1) * 3 + dx + 1];
                    a0 += wv * bf2f((unsigned)raw[idx]); a1 += wv * bf2f((unsigned)raw[2048 + idx]); } }
        o[a] = (f32x2){a0, a1}; asm volatile("" ::: "memory"); }
}
__device__ __forceinline__ void hyena_unit(Frame& F, int un) {
    const KargP in = karg_opaque(F.in);
    const int cg = un >> 2, bp = un & 3, c0 = cg * 8, b0 = bp * 2;
    const int hb = F.tid >> 8, ht = F.tid & 255;
    LAS f32x2* buf = (LAS f32x2*)(F.lds + hb * FFT_BUF_BYTES);
    LAS bf16_t* raw = (LAS bf16_t*)(F.lds + HY_RAW + hb * 8192);
    LAS bf16_t* outT = (LAS bf16_t*)(F.lds + HY_OUT);
    const bf16_t* ZT = WSP(bf16_t, WS_ZT); const f32x2* H = WSP(f32x2, WS_H);
    const FftTw tw = fft_tw(ht);
    __syncthreads();
#pragma unroll 1
    for (int i = 0; i < 4; ++i) {
        const int cl = 2 * i + hb, c = c0 + cl;
#define HY_LOADRAW(kind) do { _Pragma("unroll") for (int bb = 0; bb < 2; ++bb) \
            *(LAS u32x4*)(raw + bb * 2048 + ht * 8) = *(const u32x4*)(ZT + ((size_t)(b0 + bb) * 3072 + (kind) * 1024 + c) * SEQ + ht * 8); } while (0)
        HY_LOADRAW(2);
        __syncthreads();
        f32x2 vin[8], v[16];
        hy_conv(raw, in[I_HCW], in[I_HCB][2048 + c], 2048 + c, ht, vin);
#pragma unroll
        for (int a = 0; a < 8; ++a) { v[a] = vin[a]; v[8 + a] = (f32x2){0.f, 0.f}; }
        fft_fwd(v, buf, ht, tw);
        { const f32x2* Hd = H + (size_t)(c * 2 + 0) * 4096;
#pragma unroll
          for (int ks = 0; ks < 16; ++ks) v[ks] = cmul(v[ks], Hd[ks * 256 + ht]); }
        fft_inv(v, buf, ht, tw);
        HY_LOADRAW(0);
        __syncthreads();
        { f32x2 g[8]; hy_conv(raw, in[I_HCW], in[I_HCB][c], c, ht, g); const float sk = in[I_HSKIP][c];
#pragma unroll
          for (int a = 0; a < 8; ++a) vin[a] = g[a] * (v[a] + vin[a] * sk); }
#pragma unroll
        for (int a = 0; a < 8; ++a) { v[a] = vin[a]; v[8 + a] = (f32x2){0.f, 0.f}; }
        fft_fwd(v, buf, ht, tw);
        { const f32x2* Hd = H + (size_t)(c * 2 + 1) * 4096;
#pragma unroll
          for (int ks = 0; ks < 16; ++ks) v[ks] = cmul(v[ks], Hd[ks * 256 + ht]); }
        fft_inv(v, buf, ht, tw);
        HY_LOADRAW(1);
        __syncthreads();
        { f32x2 g[8]; hy_conv(raw, in[I_HCW], in[I_HCB][1024 + c], 1024 + c, ht, g); const float sk = in[I_HSKIP][1024 + c];
#pragma unroll
          for (int a = 0; a < 8; ++a) { const f32x2 o = g[a] * (v[a] + vin[a] * sk); const int t = 256 * a + ht;
              outT[(0 * 2048 + t) * 8 + cl] = (bf16_t)f2bf(o.x); outT[(1 * 2048 + t) * 8 + cl] = (bf16_t)f2bf(o.y); } }
        __syncthreads();
#undef HY_LOADRAW
    }
    bf16_t* HH = WSP(bf16_t, WS_HH);
#pragma unroll
    for (int q = 0; q < 8; ++q) { const int r = F.tid + 512 * q, bb = r >> 11, t = r & 2047;
        *(u32x4*)(HH + ((size_t)(b0 + bb) * SEQ + t) * HW + c0) = *(const LAS u32x4*)(outT + r * 8); }
    __syncthreads();
}

struct SchedP {
    static constexpr bool GATHER = false;
    int G, c; const char* a; const char* b; size_t astep, bstep;
    __device__ __forceinline__ bool next(int i, Unit& u) const { const int L = i * G + c; if (L >= 512) return false; pg8::decode_tile(L, 64, 8, u.pm, u.pn); u.ex = 0; return true; }
    __device__ __forceinline__ const char* a_base(const Unit& u) const { return a + (size_t)u.pm * astep; }
    __device__ __forceinline__ const char* b_base(const Unit& u) const { return b + (size_t)u.pn * bstep; }
    __device__ __forceinline__ int a_row(const Unit&, int R) const { return R; }
};
struct EpiMA {
    static constexpr bool PERM = true;
    float* T; const bf16_t* Z;
    __device__ __forceinline__ void operator()(const f32x4 (&acc)[2][2][4][2], const Unit& u, int wr, int wc, int fr, int fq) const {
        const int row0 = u.pm * 256 + wr * 64 + fr, col0 = u.pn * 256 + wc * 32 + 8 * fq;
#pragma unroll
        for (int ai = 0; ai < 2; ++ai)
#pragma unroll
            for (int m = 0; m < 4; ++m) { const size_t row = row0 + ai * 128 + m * 16;
#pragma unroll
                for (int bj = 0; bj < 2; ++bj) { const int c = col0 + bj * 128;
                    const u32x4 gz = *(const u32x4*)(Z + row * ZN + ZC_GA + c);
                    f32x4 g0 = (f32x4){sigmoidf_(bflo(gz.x)), sigmoidf_(bfhi(gz.x)), sigmoidf_(bflo(gz.y)), sigmoidf_(bfhi(gz.y))};
                    f32x4 g1 = (f32x4){sigmoidf_(bflo(gz.z)), sigmoidf_(bfhi(gz.z)), sigmoidf_(bflo(gz.w)), sigmoidf_(bfhi(gz.w))};
                    *(f32x4*)(T + row * DM + c) = acc[ai][bj][m][0] * g0; *(f32x4*)(T + row * DM + c + 4) = acc[ai][bj][m][1] * g1; } }
    }
};
struct EpiMB {
    static constexpr bool PERM = true;
    const float* T; const bf16_t* Z; bf16_t* MX;
    __device__ __forceinline__ void operator()(const f32x4 (&acc)[2][2][4][2], const Unit& u, int wr, int wc, int fr, int fq) const {
        const int row0 = u.pm * 256 + wr * 64 + fr, col0 = u.pn * 256 + wc * 32 + 8 * fq;
#pragma unroll
        for (int ai = 0; ai < 2; ++ai)
#pragma unroll
            for (int m = 0; m < 4; ++m) { const size_t row = row0 + ai * 128 + m * 16;
#pragma unroll
                for (int bj = 0; bj < 2; ++bj) { const int c = col0 + bj * 128;
                    const u32x4 gz = *(const u32x4*)(Z + row * ZN + ZC_GH + c);
                    const f32x4 t0 = *(const f32x4*)(T + row * DM + c), t1 = *(const f32x4*)(T + row * DM + c + 4);
                    f32x4 g0 = (f32x4){sigmoidf_(bflo(gz.x)), sigmoidf_(bfhi(gz.x)), sigmoidf_(bflo(gz.y)), sigmoidf_(bfhi(gz.y))};
                    f32x4 g1 = (f32x4){sigmoidf_(bflo(gz.z)), sigmoidf_(bfhi(gz.z)), sigmoidf_(bflo(gz.w)), sigmoidf_(bfhi(gz.w))};
                    const f32x4 v0 = t0 + acc[ai][bj][m][0] * g0, v1 = t1 + acc[ai][bj][m][1] * g1;
                    u32x4 w; w.x = pg8::cvt_pk_bf16(v0[0], v0[1]); w.y = pg8::cvt_pk_bf16(v0[2], v0[3]); w.z = pg8::cvt_pk_bf16(v1[0], v1[1]); w.w = pg8::cvt_pk_bf16(v1[2], v1[3]);
                    *(u32x4*)(MX + row * DM + c) = w; } }
    }
};
struct EpiWO {
    static constexpr bool PERM = false;
    float* R1; const float* x; const float* stats; const float* lng; const float* lnb; const float* mod;
    __device__ __forceinline__ void operator()(const f32x4 (&acc)[2][2][4][2], const Unit& u, int wr, int wc, int fr, int fq) const {
        const int row0 = u.pm * 256 + wr * 64 + fr, col0 = u.pn * 256 + wc * 32 + 4 * fq;
        const float* g1p = mod + (size_t)(u.pm >> 3) * 12288 + 4096;
#pragma unroll
        for (int ai = 0; ai < 2; ++ai)
#pragma unroll
            for (int m = 0; m < 4; ++m) { const size_t row = row0 + ai * 128 + m * 16; const float mean = stats[row * 2], rstd = stats[row * 2 + 1];
#pragma unroll
                for (int bj = 0; bj < 2; ++bj)
#pragma unroll
                    for (int n = 0; n < 2; ++n) { const int c = col0 + bj * 128 + n * 16;
                        const f32x4 xv = *(const f32x4*)(x + row * DM + c), g = *(const f32x4*)(lng + c), bb = *(const f32x4*)(lnb + c), g1 = *(const f32x4*)(g1p + c);
                        *(f32x4*)(R1 + row * DM + c) = ((xv - mean) * rstd * g + bb) * DN_ALPHA + g1 * acc[ai][bj][m][n]; } }
    }
};

__device__ __forceinline__ void p8_phase(Frame& F) {
    const KargP in = karg_opaque(F.in);
    const int gw = F.bid * NWAVES + F.wave, NGW = F.G * NWAVES, lane = F.lane, l15 = lane & 15, g4 = lane >> 4;
    const float* R1 = WSP(float, WS_R1); bf16_t* TOK = WSP(bf16_t, WS_TOK); const float* mod = WSP(float, WS_MOD);
    LAS float* lg = (LAS float*)(F.lds + F.wave * 4096);
    LAS int* te = (LAS int*)(F.lds + F.wave * 4096 + 2304); LAS float* tw = (LAS float*)(F.lds + F.wave * 4096 + 2304 + 256);
    const float* wr = in[I_WR];
    for (int tile = gw; tile < MTOK / 16; tile += NGW) {
        const int bsel = (tile * 16) / SEQ; const float* mv = mod + (size_t)bsel * 12288;
        float my_mean = 0.f, my_rstd = 0.f;
        for (int rr = 0; rr < 16; ++rr) {
            const int row = tile * 16 + rr; const float* xr = R1 + (size_t)row * DM;
            f32x4 v[8]; float s = 0.f;
#pragma unroll
            for (int j = 0; j < 8; ++j) { v[j] = *(const f32x4*)(xr + lane * 4 + 256 * j); s += (v[j].x + v[j].y) + (v[j].z + v[j].w); }
            const float mean = wave_sum(s) * (1.f / DM); float s2 = 0.f;
#pragma unroll
            for (int j = 0; j < 8; ++j) { const f32x4 d = v[j] - mean; s2 += (d.x * d.x + d.y * d.y) + (d.z * d.z + d.w * d.w); }
            const float rstd = 1.f / sqrtf(wave_sum(s2) * (1.f / DM) + LN_EPS);
            if (l15 == rr) { my_mean = mean; my_rstd = rstd; }
            bf16_t* orow = TOK + (size_t)row * DM;
#pragma unroll
            for (int j = 0; j < 8; ++j) { const int c = lane * 4 + 256 * j;
                const f32x4 g = *(const f32x4*)(in[I_LN1G] + c), bb = *(const f32x4*)(in[I_LN1B] + c), sh = *(const f32x4*)(mv + 6144 + c), sc = *(const f32x4*)(mv + 8192 + c);
                const f32x4 y = ((v[j] - mean) * rstd * g + bb) * (sc + 1.0f) + sh;
                u32x2 o; o.x = pk2(y.x, y.y); o.y = pk2(y.z, y.w); *(u32x2*)(orow + c) = o; }
        }
        f32x4 acc0 = (f32x4){0.f, 0.f, 0.f, 0.f}, acc1 = (f32x4){0.f, 0.f, 0.f, 0.f};
        const float* rowp = R1 + (size_t)(tile * 16 + l15) * DM + 512 * g4;
#pragma unroll 2
        for (int s = 0; s < 512; s += 4) { const int d = 512 * g4 + s;
            const f32x4 r4 = *(const f32x4*)(rowp + s);
            const f32x4 g = *(const f32x4*)(in[I_LN1G] + d), bb = *(const f32x4*)(in[I_LN1B] + d), sh = *(const f32x4*)(mv + 6144 + d), sc = *(const f32x4*)(mv + 8192 + d);
            const f32x4 tk = ((r4 - my_mean) * my_rstd * g + bb) * (sc + 1.0f) + sh;
#pragma unroll
            for (int j = 0; j < 4; ++j) { const float w0 = wr[(d + j) * 32 + l15], w1 = wr[(d + j) * 32 + 16 + l15];
                acc0 = __builtin_amdgcn_mfma_f32_16x16x4f32(tk[j], w0, acc0, 0, 0, 0); acc1 = __builtin_amdgcn_mfma_f32_16x16x4f32(tk[j], w1, acc1, 0, 0, 0); }
        }
        { const float b0 = in[I_BR][l15], b1 = in[I_BR][16 + l15];
#pragma unroll
          for (int r = 0; r < 4; ++r) { lg[(4 * g4 + r) * 33 + l15] = acc0[r] + b0; lg[(4 * g4 + r) * 33 + 16 + l15] = acc1[r] + b1; } }
        LDS_WAIT(); asm volatile("" ::: "memory");
        if (lane < 16) {
            unsigned chosen = 0u; float lv[4]; int le[4];
            for (int k = 0; k < 4; ++k) { float best = -3.4e38f; int be = 0;
                for (int e = 0; e < 32; ++e) { const float v = lg[lane * 33 + e]; if (!((chosen >> e) & 1u) && v > best) { best = v; be = e; } }
                chosen |= 1u << be; lv[k] = best; le[k] = be; }
            float ex[4], sum = 0.f;
            for (int k = 0; k < 4; ++k) { ex[k] = __expf(lv[k] - lv[0]); sum += ex[k]; }
            for (int k = 0; k < 4; ++k) { te[lane * 4 + k] = le[k]; tw[lane * 4 + k] = ex[k] / sum; }
        }
        LDS_WAIT(); asm volatile("" ::: "memory");
        { const int e = te[lane]; const float wv = tw[lane]; const int token = tile * 16 + (lane >> 2);
          const int pos = (int)__hip_atomic_fetch_add(F.ctl + CW_CNT + 64 * e, 1u, __ATOMIC_RELAXED, __HIP_MEMORY_SCOPE_AGENT);
          WSP(int, WS_TOPE)[token * 4 + (lane & 3)] = e; WSP(int, WS_TOPP)[token * 4 + (lane & 3)] = pos; WSP(float, WS_TOPW)[token * 4 + (lane & 3)] = wv;
          WSP(int, WS_RTOK)[e * POSCAP + pos] = token; WSP(float, WS_RW)[e * POSCAP + pos] = wv; }
        LDS_WAIT(); asm volatile("" ::: "memory");
    }
}

constexpr int MOE_TBL = 131072;
__device__ __forceinline__ void moe_table(Frame& F) {
    LAS int* tst = (LAS int*)(F.lds + MOE_TBL); LAS int* cn = (LAS int*)(F.lds + MOE_TBL + 256);
    __syncthreads();
    if (F.tid == 0) { int acc = 0; for (int e = 0; e < NEXP; ++e) { const int c = (int)__hip_atomic_load(F.ctl + CW_CNT + 64 * e, __ATOMIC_RELAXED, __HIP_MEMORY_SCOPE_AGENT); cn[e] = c; tst[e] = acc; acc += (c + 255) >> 8; } tst[NEXP] = acc; }
    __syncthreads();
}
template <bool GU> struct SchedMoE {
    static constexpr bool GATHER = GU;
    int G, c, NT; const LAS int* tst; const LAS int* cn; const int* rtok; const char* a; const char* b;
    __device__ __forceinline__ bool next(int i, Unit& u) const {
        const int nwg = __builtin_amdgcn_readfirstlane(tst[NEXP]) * NT; const int L = i * G + c; if (L >= nwg) return false;
        int wg; { const int q = nwg / 8, r = nwg % 8, xcd = L % 8, off = L / 8; wg = (xcd < r ? xcd * (q + 1) : r * (q + 1) + (xcd - r) * q) + off; }
        int e = 0;
#pragma unroll 1
        for (int k = 1; k < NEXP; ++k) { const int s = __builtin_amdgcn_readfirstlane(tst[k]); if (wg >= s * NT) e = k; }
        const int ts = __builtin_amdgcn_readfirstlane(tst[e]), ts1 = __builtin_amdgcn_readfirstlane(tst[e + 1]);
        const int rem = wg - ts * NT, ne = ts1 - ts;
        u.pm = ts + rem % ne; u.pn = rem / ne; u.ex = e; return true;
    }
    __device__ __forceinline__ const char* a_base(const Unit& u) const { return GU ? a : a + (size_t)u.pm * 256 * DM * 2; }
    __device__ __forceinline__ const char* b_base(const Unit& u) const { return b + ((size_t)u.ex * (GU ? 4096 : 2048) + 256 * u.pn) * DM * 2; }
    __device__ __forceinline__ int a_row(const Unit& u, int R) const { const int pos = (u.pm - tst[u.ex]) * 256 + R; return pos < cn[u.ex] ? rtok[u.ex * POSCAP + pos] : 0; }
};
struct EpiGU {
    static constexpr bool PERM = true;
    bf16_t* ACT; const float* bg; const float* bu;
    __device__ __forceinline__ void operator()(const f32x4 (&acc)[2][2][4][2], const Unit& u, int wr, int wc, int fr, int fq) const {
        const int row0 = u.pm * 256 + wr * 64 + fr, col0 = u.pn * 128 + wc * 32 + 8 * fq;
        const float* bgp = bg + (size_t)u.ex * DM + col0; const float* bup = bu + (size_t)u.ex * DM + col0;
        const f32x4 g0 = *(const f32x4*)bgp, g1 = *(const f32x4*)(bgp + 4), u0 = *(const f32x4*)bup, u1 = *(const f32x4*)(bup + 4);
#pragma unroll
        for (int ai = 0; ai < 2; ++ai)
#pragma unroll
            for (int m = 0; m < 4; ++m) { const size_t row = row0 + ai * 128 + m * 16;
                float o[8];
#pragma unroll
                for (int n = 0; n < 2; ++n)
#pragma unroll
                    for (int j = 0; j < 4; ++j) { const float gv = fminf(acc[ai][0][m][n][j] + (n ? g1[j] : g0[j]), 7.0f);
                        const float uv = fminf(fmaxf(acc[ai][1][m][n][j] + (n ? u1[j] : u0[j]), -7.0f), 7.0f);
                        o[n * 4 + j] = gv * sigmoidf_(1.702f * gv) * (uv + 1.0f); }
                u32x4 w; w.x = pg8::cvt_pk_bf16(o[0], o[1]); w.y = pg8::cvt_pk_bf16(o[2], o[3]); w.z = pg8::cvt_pk_bf16(o[4], o[5]); w.w = pg8::cvt_pk_bf16(o[6], o[7]);
                *(u32x4*)(ACT + row * DM + col0) = w; }
    }
};
struct EpiDN {
    static constexpr bool PERM = true;
    bf16_t* YR; const float* bd; const float* rw; const LAS int* tst; const LAS int* cn;
    __device__ __forceinline__ void operator()(const f32x4 (&acc)[2][2][4][2], const Unit& u, int wr, int wc, int fr, int fq) const {
        const int r0 = wr * 64 + fr, col0 = u.pn * 256 + wc * 32 + 8 * fq; const int e = u.ex, pbase = (u.pm - tst[e]) * 256, cnt = cn[e];
#pragma unroll
        for (int bj = 0; bj < 2; ++bj) {
            const f32x4 bv0 = *(const f32x4*)(bd + (size_t)e * DM + col0 + bj * 128), bv1 = *(const f32x4*)(bd + (size_t)e * DM + col0 + bj * 128 + 4);
#pragma unroll
            for (int ai = 0; ai < 2; ++ai)
#pragma unroll
                for (int m = 0; m < 4; ++m) { const int r = r0 + ai * 128 + m * 16; const int pos = pbase + r; const float wv = pos < cnt ? rw[e * POSCAP + pos] : 0.f;
                    bf16_t* rowp = YR + ((size_t)u.pm * 256 + r) * DM + col0;
                    const f32x4 v0 = (acc[ai][bj][m][0] + bv0) * wv, v1 = (acc[ai][bj][m][1] + bv1) * wv;
                    u32x4 w; w.x = pg8::cvt_pk_bf16(v0[0], v0[1]); w.y = pg8::cvt_pk_bf16(v0[2], v0[3]); w.z = pg8::cvt_pk_bf16(v1[0], v1[1]); w.w = pg8::cvt_pk_bf16(v1[2], v1[3]);
                    *(u32x4*)(rowp + bj * 128) = w; }
            asm volatile("" ::: "memory");
        }
    }
};

__device__ __forceinline__ void p11_phase(Frame& F) {
    const KargP in = karg_opaque(F.in);
    const int gw = F.bid * NWAVES + F.wave, NGW = F.G * NWAVES, lane = F.lane;
    const LAS int* tst = (const LAS int*)(F.lds + MOE_TBL);
    const float* R1 = WSP(float, WS_R1); const bf16_t* YR = WSP(bf16_t, WS_YR); const float* mod = WSP(float, WS_MOD);
    for (int row = gw; row < MTOK; row += NGW) {
        int dest[4];
#pragma unroll
        for (int k = 0; k < 4; ++k) { const int e = __builtin_amdgcn_readfirstlane(WSP(int, WS_TOPE)[row * 4 + k]), pos = __builtin_amdgcn_readfirstlane(WSP(int, WS_TOPP)[row * 4 + k]); dest[k] = __builtin_amdgcn_readfirstlane(tst[e]) * 256 + pos; }
        const float* mv = mod + (size_t)(row / SEQ) * 12288;
        const float* xr = R1 + (size_t)row * DM;
        f32x4 v[8]; float s = 0.f;
#pragma unroll
        for (int j = 0; j < 8; ++j) { v[j] = *(const f32x4*)(xr + lane * 4 + 256 * j); s += (v[j].x + v[j].y) + (v[j].z + v[j].w); }
        float mean = wave_sum(s) * (1.f / DM); float s2 = 0.f;
#pragma unroll
        for (int j = 0; j < 8; ++j) { v[j] = v[j] - mean; s2 += (v[j].x * v[j].x + v[j].y * v[j].y) + (v[j].z * v[j].z + v[j].w * v[j].w); }
        float rstd = 1.f / sqrtf(wave_sum(s2) * (1.f / DM) + LN_EPS);
        s = 0.f;
#pragma unroll
        for (int j = 0; j < 8; ++j) { const int c = lane * 4 + 256 * j;
            const f32x4 g = *(const f32x4*)(in[I_LN1G] + c), bb = *(const f32x4*)(in[I_LN1B] + c), g2 = *(const f32x4*)(mv + 10240 + c);
            f32x4 y = (f32x4){0.f, 0.f, 0.f, 0.f};
#pragma unroll
            for (int k = 0; k < 4; ++k) { const u32x2 yy = *(const u32x2*)(YR + (size_t)dest[k] * DM + c); y += (f32x4){bflo(yy.x), bfhi(yy.x), bflo(yy.y), bfhi(yy.y)}; }
            v[j] = (v[j] * rstd * g + bb) * DN_ALPHA + g2 * y;
            s += (v[j].x + v[j].y) + (v[j].z + v[j].w); }
        mean = wave_sum(s) * (1.f / DM); s2 = 0.f;
#pragma unroll
        for (int j = 0; j < 8; ++j) { v[j] = v[j] - mean; s2 += (v[j].x * v[j].x + v[j].y * v[j].y) + (v[j].z * v[j].z + v[j].w * v[j].w); }
        rstd = 1.f / sqrtf(wave_sum(s2) * (1.f / DM) + LN_EPS);
        float* orow = F.out + (size_t)row * DM;
#pragma unroll
        for (int j = 0; j < 8; ++j) { const int c = lane * 4 + 256 * j;
            const f32x4 g = *(const f32x4*)(in[I_LN2G] + c), bb = *(const f32x4*)(in[I_LN2B] + c);
            *(f32x4*)(orow + c) = v[j] * rstd * g + bb; }
    }
}

constexpr int NPHASE = 13;
__global__ void __launch_bounds__(NTHR, 2) mk_fwd(Args args) {
    extern __shared__ __attribute__((aligned(16))) unsigned char lds_raw[];
    Frame F;
    F.lds = (LAS unsigned char*)lds_raw;
    F.MISC = (volatile LAS unsigned*)(F.lds + MISC_OFF);
    F.tid = threadIdx.x; F.lane = F.tid & 63; F.wave = __builtin_amdgcn_readfirstlane(F.tid >> 6);
    F.G = gridDim.x; F.bid = blockIdx.x;
    F.in = (KargP)__builtin_amdgcn_kernarg_segment_ptr(); F.out = args.out; F.ws = args.ws; F.ctl = (unsigned*)(args.ws + WS_CTL);
    for (int u = F.tid; u < (LDS_BYTES - MISC_OFF) / 4; u += NTHR) ((LAS unsigned*)(F.lds + MISC_OFF))[u] = 0u;
    __syncthreads();
    XcdBarrier bar; bar.bar = F.ctl + CW_BAR; bar.x = 0; bar.st = nullptr;
    if (MK_LAUNCHES == 1) bar = xcd_barrier_post(F.ctl + CW_BAR, F.MISC + 8);
    const int lo = args.ph_lo, hi = args.ph_hi;
#ifndef PH_MASK
#define PH_MASK 0xFFFF
#endif
#define IN(k) (((PH_MASK >> (k)) & 1) && lo <= (k) && (k) < hi)
#define SEAM(k) do { if (IN(k) && IN((k) + 1)) xcd_barrier(bar); } while (0)
    if (IN(0)) p0_phase(F);
    SEAM(0);
    if (IN(1)) p0b_phase(F);
    SEAM(1);
    if (IN(2)) p1_phase(F);
    SEAM(2);
    if (IN(3)) {
        SchedZ S{F.G, F.bid, (const char*)WSP(bf16_t, WS_HX), (const char*)WSP(bf16_t, WS_WIN)};
        EpiZ E{WSP(bf16_t, WS_Z), WSP(bf16_t, WS_ZT), WSP(float, WS_BINP)};
        pg8::gemm_phase<EpiZ, SchedZ>(F.lds, DM, DM, DM, S, E);
    }
    SEAM(3);
    if (IN(4)) p3_phase(F);
    SEAM(4);
    if (IN(5)) {
        SchedQK S{F.G, F.bid, (const char*)WSP(bf16_t, WS_U), (const char*)WSP(bf16_t, WS_WQK)};
        EpiQK E{WSP(bf16_t, WS_QKB)};
        pg8::gemm_phase<EpiQK, SchedQK>(F.lds, 256, MW, 256, S, E);
    }
    SEAM(5);
    if (IN(6)) {
#ifndef NO_ML
        for (int un = F.bid; un < 256; un += F.G) mlstm_unit(F, un);
#endif
#ifndef NO_HY
        for (int un = F.bid; un < 512; un += F.G) hyena_unit(F, un);
#endif
    }
    SEAM(6);
    if (IN(7)) {
        { SchedP S{F.G, F.bid, (const char*)WSP(bf16_t, WS_AM), (const char*)WSP(bf16_t, WS_WPA2), (size_t)256 * 2048 * 2, (size_t)256 * 2048 * 2};
          EpiMA E{WSP(float, WS_T), WSP(bf16_t, WS_Z)};
          pg8::gemm_phase<EpiMA, SchedP>(F.lds, 2048, 2048, 2048, S, E); }
        VM_WAIT(); __syncthreads();
        { SchedP S{F.G, F.bid, (const char*)WSP(bf16_t, WS_HH), (const char*)WSP(bf16_t, WS_WPH), (size_t)256 * 1024 * 2, (size_t)256 * 1024 * 2};
          EpiMB E{WSP(float, WS_T), WSP(bf16_t, WS_Z), WSP(bf16_t, WS_MX)};
          pg8::gemm_phase<EpiMB, SchedP>(F.lds, 1024, 1024, 1024, S, E); }
    }
    SEAM(7);
    if (IN(8)) {
        SchedP S{F.G, F.bid, (const char*)WSP(bf16_t, WS_MX), (const char*)WSP(bf16_t, WS_WOUT), (size_t)256 * 2048 * 2, (size_t)256 * 2048 * 2};
        const KargP in = karg_opaque(F.in); EpiWO E{WSP(float, WS_R1), in[I_X], WSP(float, WS_STATS), in[I_LNG], in[I_LNB], WSP(float, WS_MOD)};
        pg8::gemm_phase<EpiWO, SchedP>(F.lds, 2048, 2048, 2048, S, E);
    }
    SEAM(8);
    if (IN(9)) p8_phase(F);
    SEAM(9);
    if (IN(10)) {
        moe_table(F);
        SchedMoE<true> S{F.G, F.bid, 16, (const LAS int*)(F.lds + MOE_TBL), (const LAS int*)(F.lds + MOE_TBL + 256), WSP(int, WS_RTOK), (const char*)WSP(bf16_t, WS_TOK), (const char*)WSP(bf16_t, WS_WGU)};
        const KargP in = karg_opaque(F.in); EpiGU E{WSP(bf16_t, WS_ACT), in[I_BG], in[I_BU]};
        pg8::gemm_phase<EpiGU, SchedMoE<true>>(F.lds, DM, DM, DM, S, E);
    }
    SEAM(10);
    if (IN(11)) {
        moe_table(F);
        SchedMoE<false> S{F.G, F.bid, 8, (const LAS int*)(F.lds + MOE_TBL), (const LAS int*)(F.lds + MOE_TBL + 256), WSP(int, WS_RTOK), (const char*)WSP(bf16_t, WS_ACT), (const char*)WSP(bf16_t, WS_WD)};
        const KargP in = karg_opaque(F.in); EpiDN E{WSP(bf16_t, WS_YR), in[I_BDN], WSP(float, WS_RW), (const LAS int*)(F.lds + MOE_TBL), (const LAS int*)(F.lds + MOE_TBL + 256)};
        pg8::gemm_phase<EpiDN, SchedMoE<false>>(F.lds, DM, DM, DM, S, E);
    }
    SEAM(11);
    if (IN(12)) { moe_table(F); p11_phase(F); }
#undef IN
#undef SEAM
}

extern "C" void kernel_launch(void* const* d_in, const int* in_sizes, int n_in, void* d_out, int out_size, void* d_ws, size_t ws_size, hipStream_t stream) {
    static int grid = 0;
    if (grid == 0) {
        if (n_in != 38 || out_size != MTOK * DM || ws_size < WS_END) { fprintf(stderr, "kernel_launch: unexpected shapes: n_in %d out %d ws %zu (need %zu)\n", n_in, out_size, ws_size, (size_t)WS_END); grid = -1; return; }
        int dev = 0, cus = 0, per_cu = 0;
        if (hipGetDevice(&dev) != hipSuccess || hipDeviceGetAttribute(&cus, hipDeviceAttributeMultiprocessorCount, dev) != hipSuccess) { grid = -1; return; }
        if (hipFuncSetAttribute((const void*)mk_fwd, hipFuncAttributeMaxDynamicSharedMemorySize, LDS_BYTES) != hipSuccess) { fprintf(stderr, "kernel_launch: hipFuncSetAttribute failed\n"); grid = -1; return; }
        if (hipOccupancyMaxActiveBlocksPerMultiprocessor(&per_cu, (const void*)mk_fwd, NTHR, LDS_BYTES) != hipSuccess || per_cu < 1) fprintf(stderr, "kernel_launch: occupancy query says %d\n", per_cu);
        (void)hipGetLastError();
        grid = cus;
    }
    if (grid < 0) return;
    (void)hipMemsetAsync((char*)d_ws + WS_CTL, 0, CTL_ZERO_BYTES, stream);
    Args a{};
    for (int i = 0; i < 38; ++i) a.in[i] = (const float*)d_in[i];
    a.out = (float*)d_out; a.ws = (unsigned char*)d_ws;
#if MK_LAUNCHES == 1
    a.ph_lo = 0; a.ph_hi = NPHASE;
    hipLaunchKernelGGL(mk_fwd, dim3(grid), dim3(NTHR), LDS_BYTES, stream, a);
#else
    for (int p = 0; p < NPHASE; ++p) { a.ph_lo = p; a.ph_hi = p + 1; hipLaunchKernelGGL(mk_fwd, dim3(grid), dim3(NTHR), LDS_BYTES, stream, a); }
#endif
}
```

```cpp
#include <hip/hip_runtime.h>
#include <cstdio>
#include <cstdint>

#define GAS __attribute__((address_space(1)))
#define LAS __attribute__((address_space(3)))
typedef unsigned short bf16_t;
typedef short bf16x8 __attribute__((ext_vector_type(8)));
typedef float f32x4 __attribute__((ext_vector_type(4)));
typedef float f32x2 __attribute__((ext_vector_type(2)));
typedef unsigned u32x4 __attribute__((ext_vector_type(4)));
typedef unsigned u32x2 __attribute__((ext_vector_type(2)));

#ifndef MK_LAUNCHES
#define MK_LAUNCHES 1
#endif

constexpr int DM = 2048, NB = 8, SEQ = 2048, CTX = 256, GW = 64;
constexpr int MTOK = NB * SEQ;
constexpr int MCTX = NB * CTX;
constexpr int MALL = MTOK + MCTX;
constexpr int NH = 4, HD = 256, MW = 1024, HW = 1024;
constexpr int N_IN = 10256;
constexpr int NEXP = 32, TOPK = 4;
constexpr float LN_EPS = 1e-5f;
constexpr float DN_ALPHA = 1.189207115002721f;
constexpr int ZN = 7424, ZC_QK = 0, ZC_V = 1024, ZC_O = 2048, ZC_GA = 3072, ZC_GH = 5120, ZC_GT = 7168;
constexpr int WIN_ROWS = 10496, WIN_HY0 = 7424;
constexpr int MAXTILES = 288;
constexpr int POSCAP = 16384;

constexpr size_t MiB = 1u << 20;
constexpr size_t WS_CTL = 0;
constexpr size_t WS_MODP = 1 * MiB;
constexpr size_t WS_MOD = 9 * MiB;
constexpr size_t WS_BINP = 10 * MiB;
constexpr size_t WS_A3 = 10 * MiB + 64 * 1024;
constexpr size_t WS_STATS = 11 * MiB;
constexpr size_t WS_TOPE = 11 * MiB + 256 * 1024;
constexpr size_t WS_TOPP = 11 * MiB + 512 * 1024;
constexpr size_t WS_TOPW = 11 * MiB + 768 * 1024;
constexpr size_t WS_RTOK = 12 * MiB;
constexpr size_t WS_RW = 14 * MiB;
constexpr size_t WS_WQK = 16 * MiB;
constexpr size_t WS_WPH = 17 * MiB;
constexpr size_t WS_WPA2 = 21 * MiB;
constexpr size_t WS_WOUT = 29 * MiB;
constexpr size_t WS_WIN = 37 * MiB;
constexpr size_t WS_WGU = 78 * MiB;
constexpr size_t WS_WD = 590 * MiB;
constexpr size_t WS_RA = 846 * MiB;
constexpr size_t WS_Z = WS_RA, WS_ZT = WS_RA + 261 * MiB, WS_ACT = WS_RA;
constexpr size_t WS_RB = 1203 * MiB;
constexpr size_t WS_HX = WS_RB, WS_U = WS_RB + 72 * MiB, WS_QKB = WS_RB + 108 * MiB, WS_AM = WS_RB + 180 * MiB, WS_HH = WS_RB + 244 * MiB, WS_MX = WS_RB + 276 * MiB, WS_YR = WS_RB;
constexpr size_t WS_RC = 1543 * MiB;
constexpr size_t WS_HTAPS = WS_RC, WS_H = WS_RC + 32 * MiB, WS_T = WS_RC;
constexpr size_t WS_R1 = 1671 * MiB;
constexpr size_t WS_TOK = 1799 * MiB;
constexpr size_t WS_END = 1863 * MiB;
constexpr int CW_TMO = 0, CW_BAR = 4096, CW_CNT = 16384;
constexpr size_t CTL_ZERO_BYTES = 1 * MiB;

constexpr int LDS_BYTES = 160 * 1024 - 2048;
constexpr int MISC_OFF = LDS_BYTES - 1024;
constexpr int NWAVES = 8, NTHR = 512;

#define LDS_WAIT() asm volatile("s_waitcnt lgkmcnt(0)" ::: "memory")
#define VM_WAIT() asm volatile("s_waitcnt vmcnt(0)" ::: "memory")
__device__ __forceinline__ unsigned f2bf(float f) { unsigned u = __builtin_bit_cast(unsigned, f); return (u + 0x7fffu + ((u >> 16) & 1u)) >> 16; }
__device__ __forceinline__ unsigned pk2(float lo, float hi) { return f2bf(lo) | (f2bf(hi) << 16); }
__device__ __forceinline__ unsigned pk4_fp8(float a, float b, float c, float d) { int w = 0; w = __builtin_amdgcn_cvt_pk_fp8_f32(a, b, w, false); w = __builtin_amdgcn_cvt_pk_fp8_f32(c, d, w, true); return (unsigned)w; }
__device__ __forceinline__ float bf2f(unsigned b) { return __builtin_bit_cast(float, b << 16); }
__device__ __forceinline__ float bflo(unsigned w) { return __builtin_bit_cast(float, w << 16); }
__device__ __forceinline__ float bfhi(unsigned w) { return __builtin_bit_cast(float, w & 0xffff0000u); }
__device__ __forceinline__ float sigmoidf_(float x) { return 1.0f / (1.0f + __expf(-x)); }
__device__ __forceinline__ float wave_sum(float v) {
#pragma unroll
    for (int o = 1; o < 64; o <<= 1) v += __shfl_xor(v, o);
    return v;
}

#define XB_TMO      128
#define XB_XCNT(j)  (256  + 64 * (j))
#define XB_XSUB(j)  (1280 + 64 * (j))
#define XB_XGEN(j)  (2304 + 64 * (j))
#define XB_TOP      3328
#define XB_TOPGEN   3392
#define XCD_BAR_WORDS 3456
#define XB_SPIN_CAP (1u << 22)
__device__ __forceinline__ unsigned xb_ld(unsigned* p)              { return __hip_atomic_load(p, __ATOMIC_RELAXED, __HIP_MEMORY_SCOPE_AGENT); }
__device__ __forceinline__ unsigned xb_add(unsigned* p, unsigned v) { return __hip_atomic_fetch_add(p, v, __ATOMIC_RELAXED, __HIP_MEMORY_SCOPE_AGENT); }
__device__ __forceinline__ unsigned xb_xcc_id() { return (unsigned)__builtin_amdgcn_s_getreg((3 << 11) | 20) & 0xFu; }
#define XB_SPIN(cond, bar) do { unsigned _sp = 0; while (cond) { __builtin_amdgcn_s_sleep(1); \
    if ((++_sp & 255u) == 0u) { if (xb_ld(&(bar)[XB_TMO])) break; if (_sp > XB_SPIN_CAP) { atomicAdd(&(bar)[XB_TMO], 1u); break; } } } } while (0)
struct XcdBarrier { unsigned* bar; unsigned x; volatile LAS unsigned* st; };
__device__ __forceinline__ XcdBarrier xcd_barrier_post(unsigned* bar, volatile LAS unsigned* st) {
    XcdBarrier b; b.bar = bar; b.x = xb_xcc_id(); b.st = st;
    if (threadIdx.x == 0) (void)xb_add(&bar[XB_XCNT(b.x)], 1u);
    return b;
}
__device__ __forceinline__ void xcd_barrier_complete(unsigned* bar, unsigned x, unsigned& nloc, unsigned& nx) {
    const unsigned G = gridDim.x * gridDim.y * gridDim.z;
    unsigned sum, cnt, mine, sp = 0u;
    for (;;) {
        sum = 0u; cnt = 0u; mine = 0u;
#pragma unroll
        for (unsigned j = 0; j < 16; ++j) { const unsigned c = xb_ld(&bar[XB_XCNT(j)]); sum += c; cnt += (c > 0u) ? 1u : 0u; mine = (j == x) ? c : mine; }
        if (sum == G) break;
        __builtin_amdgcn_s_sleep(1);
        if ((++sp & 255u) == 0u) { if (xb_ld(&bar[XB_TMO])) break; if (sp > XB_SPIN_CAP) { atomicAdd(&bar[XB_TMO], 1u); break; } }
    }
    nloc = mine > 0u ? mine : 1u; nx = cnt > 0u ? cnt : 1u;
}
__device__ __forceinline__ void xcd_barrier(const XcdBarrier& b) {
    asm volatile("s_waitcnt vmcnt(0)" ::: "memory");
    __syncthreads();
    if (threadIdx.x == 0) {
        unsigned* bar = b.bar;
        __builtin_amdgcn_s_waitcnt(0);
        unsigned nloc = b.st[0], nx = b.st[1];
        if (nloc == 0u) { xcd_barrier_complete(bar, b.x, nloc, nx); b.st[0] = nloc; b.st[1] = nx; }
        const unsigned old = xb_add(&bar[XB_XSUB(b.x)], 1u);
        const unsigned gen = old / nloc;
        if (old + 1u == (gen + 1u) * nloc) {
            __builtin_amdgcn_fence(__ATOMIC_RELEASE, "agent");
            asm volatile("s_waitcnt vmcnt(0)" ::: "memory");
            const unsigned og = xb_add(&bar[XB_TOP], 1u);
            const unsigned tg = og / nx;
            if (og + 1u == (tg + 1u) * nx) xb_add(&bar[XB_TOPGEN], 1u);
            else XB_SPIN(xb_ld(&bar[XB_TOPGEN]) == tg, bar);
            __builtin_amdgcn_fence(__ATOMIC_ACQUIRE, "agent");
            xb_add(&bar[XB_XGEN(b.x)], 1u);
            asm volatile("s_waitcnt vmcnt(0)" ::: "memory");
        } else {
            XB_SPIN(xb_ld(&bar[XB_XGEN(b.x)]) == gen, bar);
            __builtin_amdgcn_fence(__ATOMIC_ACQUIRE, "agent");
            asm volatile("s_waitcnt vmcnt(0)" ::: "memory");
        }
    }
    __syncthreads();
}

struct Args {
    const float* in[38];
    float* out; unsigned char* ws;
    int ph_lo, ph_hi;
};
enum { I_X = 0, I_C, I_CTX, I_CCTX, I_LNG, I_LNB, I_WMOD, I_BMOD, I_WIN, I_BIN, I_MCW, I_MCB, I_WQH, I_WKH, I_HCW, I_HCB, I_FW1, I_FB1, I_FWH, I_FBH,
       I_FFREQ, I_FWOUT, I_HSKIP, I_WPA, I_WPH, I_WOUT, I_LN1G, I_LN1B, I_WR, I_BR, I_WG, I_BG, I_WU, I_BU, I_WDN, I_BDN, I_LN2G, I_LN2B };

namespace pg8 {
constexpr int BM = 256, BK = 64, HALF = 128, HTB = HALF * BK * 2, STAGE_BYTES = 8 * HTB, NXCD = 8, WGM = 8;
__host__ __device__ __forceinline__ int lds_byte(int r, int c) { const int st = (r >> 4) * 2 + (c >> 5), rr = r & 15, cc = c & 31, ob = rr * 64 + cc * 2; return st * 1024 + (ob ^ (((ob >> 9) & 1) << 5)); }
__host__ __device__ __forceinline__ void stage_rc(int b, int& R, int& C) { const int st = b / 1024, sb = b % 1024, swz = sb ^ (((sb >> 9) & 1) << 5); R = (st >> 1) * 16 + swz / 64; C = (st & 1) * 32 + (swz % 64) / 2; }
__host__ __device__ __forceinline__ int perm32(int rho) { const int n = rho >> 4, i = rho & 15; return 8 * (i >> 2) + 4 * n + (i & 3); }
struct Unit { int pm, pn, ex; };
__device__ __forceinline__ void decode_tile(int L, int nM, int nN, int& pm, int& pn) {
    const int nwg = nM * nN; int wgid = L;
    { const int q = nwg / NXCD, r = nwg % NXCD, xcd = wgid % NXCD, off = wgid / NXCD; wgid = (xcd < r ? xcd * (q + 1) : r * (q + 1) + (xcd - r) * q) + off; }
    const int nig = WGM * nN, gid = wgid / nig, fm = gid * WGM, gsz = (nM - fm) < WGM ? (nM - fm) : WGM;
    pm = fm + ((wgid % nig) % gsz); pn = (wgid % nig) / gsz;
}
__device__ __forceinline__ unsigned cvt_pk_bf16(float lo, float hi) { unsigned r; asm volatile("v_cvt_pk_bf16_f32 %0, %1, %2" : "=v"(r) : "v"(lo), "v"(hi)); return r; }

typedef int i32x8 __attribute__((ext_vector_type(8)));
template <class Epi, class Sched, bool F8 = false>
__device__ __forceinline__ void gemm_phase(LAS unsigned char* lds, const int nt, const int pitchA, const int pitchB, const Sched& S, const Epi& E, const int wscale = 0x7F7F7F7F, const int ascale = 0x7F7F7F7F) {
    const int tid = threadIdx.x, wid = __builtin_amdgcn_readfirstlane(tid >> 6), lane = tid & 63, wr = wid >> 2, wc = wid & 3, fr = lane & 15, fq = lane >> 4;
    int RA[2], CA[2]; unsigned voffB[2];
#pragma unroll
    for (int i = 0; i < 2; ++i) { int R, C; stage_rc(tid * 16 + i * 8192, R, C); const int Rb = Epi::PERM ? ((R & ~31) + perm32(R & 31)) : R;
        RA[i] = R; CA[i] = C; voffB[i] = (unsigned)(Rb * pitchB + C * 2); }
    const size_t kstep = (size_t)(BK * 2);
    const size_t hstepB = (size_t)HALF * pitchB;
    const unsigned ldsw = (unsigned)wid * 1024u;
    const int aoff = lds_byte(wr * 64 + fr, fq * 8), boff = lds_byte(wc * 32 + fr, fq * 8);
#define PG8_SA(b, h) (((b) * 2 + (h)) * HTB)
#define PG8_SB(b, h) ((4 + (b) * 2 + (h)) * HTB)
#define PG8_STAGE(bufoff, gbase, v0, v1) do { \
        __builtin_amdgcn_global_load_lds((const unsigned*)((const char*)(gbase) + (v0)), (LAS unsigned*)(lds + (bufoff) + ldsw), 16, 0, 0); \
        __builtin_amdgcn_global_load_lds((const unsigned*)((const char*)(gbase) + (v1)), (LAS unsigned*)(lds + (bufoff) + ldsw + 8192), 16, 0, 0); } while (0)
#define PG8_LD8(off) __builtin_bit_cast(i32x8, __builtin_shufflevector(*(const LAS u32x4*)(lds + (off)), *(const LAS u32x4*)(lds + (off) + 1024), 0, 1, 2, 3, 4, 5, 6, 7))
#define PG8_LDA(dst, b, h) do { _Pragma("unroll") for (int m = 0; m < 4; ++m) { if (F8) dst##8[m] = PG8_LD8(PG8_SA(b, h) + aoff + m * 2048); else { _Pragma("unroll") for (int k = 0; k < 2; ++k) dst[m][k] = *(const LAS bf16x8*)(lds + PG8_SA(b, h) + aoff + m * 2048 + k * 1024); } } } while (0)
#define PG8_LDB(dst, b, h) do { _Pragma("unroll") for (int n = 0; n < 2; ++n) { if (F8) dst##8[n] = PG8_LD8(PG8_SB(b, h) + boff + n * 2048); else { _Pragma("unroll") for (int k = 0; k < 2; ++k) dst[n][k] = *(const LAS bf16x8*)(lds + PG8_SB(b, h) + boff + n * 2048 + k * 1024); } } } while (0)
#define PG8_CAT(x) __builtin_shufflevector(__builtin_bit_cast(u32x4, x[0]), __builtin_bit_cast(u32x4, x[1]), 0, 1, 2, 3, 4, 5, 6, 7)
#define PG8_MMA(ai, bj, At, Bt) do { __builtin_amdgcn_s_setprio(1); _Pragma("unroll") for (int m = 0; m < 4; ++m) _Pragma("unroll") for (int n = 0; n < 2; ++n) { \
        if (F8) { asm volatile("v_mfma_scale_f32_16x16x128_f8f6f4 %0, %1, %2, %0, %3, %4 op_sel_hi:[0,0,0]" : "+v"(acc[ai][bj][m][n]) : "v"(Bt##8[n]), "v"(At##8[m]), "v"(wscale), "v"(ascale)); } \
        else { _Pragma("unroll") for (int k = 0; k < 2; ++k) acc[ai][bj][m][n] = __builtin_amdgcn_mfma_f32_16x16x32_bf16(Bt[n][k], At[m][k], acc[ai][bj][m][n], 0, 0, 0); } } __builtin_amdgcn_s_setprio(0); } while (0)
#define PG8_WAIT_V(n) asm volatile("s_waitcnt vmcnt(" #n ")" ::: "memory")
#define PG8_WAIT_L(n) asm volatile("s_waitcnt lgkmcnt(" #n ")" ::: "memory")
#define PG8_BAR __builtin_amdgcn_s_barrier()
#define PG8_SCHED __builtin_amdgcn_sched_barrier(0)
#define PG8_AOFF(u, o00, o01, o10, o11) do { \
        if (Sched::GATHER) { o00 = (unsigned)(S.a_row(u, RA[0]) * pitchA + CA[0] * 2); o01 = (unsigned)(S.a_row(u, RA[1]) * pitchA + CA[1] * 2); \
                             o10 = (unsigned)(S.a_row(u, RA[0] + HALF) * pitchA + CA[0] * 2); o11 = (unsigned)(S.a_row(u, RA[1] + HALF) * pitchA + CA[1] * 2); } \
        else { o00 = (unsigned)(RA[0] * pitchA + CA[0] * 2); o01 = (unsigned)(RA[1] * pitchA + CA[1] * 2); o10 = (unsigned)((RA[0] + HALF) * pitchA + CA[0] * 2); o11 = (unsigned)((RA[1] + HALF) * pitchA + CA[1] * 2); } } while (0)
    Unit cur, nxt; int ui = 0;
    if (!S.next(0, cur)) return;
    f32x4 acc[2][2][4][2];
#pragma unroll
    for (int a = 0; a < 2; ++a)
#pragma unroll
        for (int b = 0; b < 2; ++b)
#pragma unroll
            for (int m = 0; m < 4; ++m)
#pragma unroll
                for (int n = 0; n < 2; ++n) acc[a][b][m][n] = (f32x4){0.f, 0.f, 0.f, 0.f};
    bf16x8 At[4][2], B0[2][2], B1[2][2]; i32x8 At8[4], B08[2], B18[2];
    const char* cA = S.a_base(cur); const char* cB = S.b_base(cur);
    unsigned c00, c01, c10, c11; PG8_AOFF(cur, c00, c01, c10, c11);
    const unsigned vb0 = voffB[0], vb1 = voffB[1];
    PG8_STAGE(PG8_SB(0, 0), cB, vb0, vb1); PG8_STAGE(PG8_SA(0, 0), cA, c00, c01); PG8_STAGE(PG8_SB(0, 1), cB + hstepB, vb0, vb1); PG8_STAGE(PG8_SA(0, 1), cA, c10, c11);
    if (wr == 1) PG8_BAR;
    PG8_WAIT_V(4); PG8_BAR;
    PG8_STAGE(PG8_SB(1, 0), cB + kstep, vb0, vb1); PG8_STAGE(PG8_SA(1, 0), cA + kstep, c00, c01); PG8_STAGE(PG8_SB(1, 1), cB + hstepB + kstep, vb0, vb1);
    PG8_WAIT_V(6); PG8_BAR;
    for (;;) {
        const bool has_next = S.next(ui + 1, nxt);
        const char* nA = has_next ? S.a_base(nxt) : cA; const char* nB = has_next ? S.b_base(nxt) : cB;
        unsigned n00 = c00, n01 = c01, n10 = c10, n11 = c11;
        if (has_next) PG8_AOFF(nxt, n00, n01, n10, n11);
        for (int t = 0; t < nt; t += 2) {
            const bool last = (t == nt - 2);
            const char* a1 = cA + (size_t)(t + 1) * kstep;
            const char* a2 = last ? nA : cA + (size_t)(t + 2) * kstep; const char* b2 = last ? nB : cB + (size_t)(t + 2) * kstep;
            const char* a3 = a2 + kstep; const char* b3 = b2 + kstep;
            const unsigned x00 = last ? n00 : c00, x01 = last ? n01 : c01, x10 = last ? n10 : c10, x11 = last ? n11 : c11;
            PG8_LDB(B0, 0, 0); PG8_SCHED; PG8_LDA(At, 0, 0); PG8_STAGE(PG8_SA(1, 1), a1, c10, c11);
            PG8_WAIT_L(8); PG8_BAR; PG8_WAIT_L(0); PG8_MMA(0, 0, At, B0); PG8_BAR; PG8_SCHED;
            PG8_LDB(B1, 0, 1); PG8_STAGE(PG8_SB(0, 0), b2, vb0, vb1);
            PG8_BAR; PG8_WAIT_L(0); PG8_MMA(0, 1, At, B1); PG8_BAR;
            PG8_LDA(At, 0, 1); PG8_STAGE(PG8_SA(0, 0), a2, x00, x01);
            PG8_BAR; PG8_WAIT_L(0); PG8_MMA(1, 0, At, B0); PG8_BAR; PG8_SCHED;
            PG8_STAGE(PG8_SB(0, 1), b2 + hstepB, vb0, vb1);
            PG8_WAIT_V(6); PG8_BAR; PG8_MMA(1, 1, At, B1); PG8_BAR;
            PG8_LDB(B0, 1, 0); PG8_SCHED; PG8_LDA(At, 1, 0); PG8_STAGE(PG8_SA(0, 1), a2, x10, x11);
            PG8_WAIT_L(8); PG8_BAR; PG8_WAIT_L(0); PG8_MMA(0, 0, At, B0); PG8_BAR; PG8_SCHED;
            PG8_LDB(B1, 1, 1); PG8_STAGE(PG8_SB(1, 0), b3, vb0, vb1);
            PG8_BAR; PG8_WAIT_L(0); PG8_MMA(0, 1, At, B1); PG8_BAR;
            PG8_LDA(At, 1, 1); PG8_STAGE(PG8_SA(1, 0), a3, x00, x01);
            PG8_BAR; PG8_WAIT_L(0); PG8_MMA(1, 0, At, B0); PG8_BAR; PG8_SCHED;
            PG8_STAGE(PG8_SB(1, 1), b3 + hstepB, vb0, vb1);
            PG8_WAIT_V(6); PG8_BAR; PG8_MMA(1, 1, At, B1); PG8_BAR;
        }
        if (F8) asm volatile("s_nop 15\n\ts_nop 15" ::: "memory");
        E(acc, cur, wr, wc, fr, fq);
        if (!has_next) break;
#pragma unroll
        for (int a = 0; a < 2; ++a)
#pragma unroll
            for (int b = 0; b < 2; ++b)
#pragma unroll
                for (int m = 0; m < 4; ++m)
#pragma unroll
                    for (int n = 0; n < 2; ++n) acc[a][b][m][n] = (f32x4){0.f, 0.f, 0.f, 0.f};
        cur = nxt; cA = nA; cB = nB; c00 = n00; c01 = n01; c10 = n10; c11 = n11; ++ui;
    }
    PG8_WAIT_V(0);
    if (wr == 0) PG8_BAR;
    PG8_BAR;
#undef PG8_SA
#undef PG8_SB
#undef PG8_STAGE
#undef PG8_LDA
#undef PG8_LDB
#undef PG8_MMA
#undef PG8_WAIT_V
#undef PG8_WAIT_L
#undef PG8_BAR
#undef PG8_SCHED
#undef PG8_AOFF
#undef PG8_CAT
#undef PG8_LD8
}
}
using pg8::Unit;

typedef const float* cfp_t;
typedef __attribute__((address_space(4))) const cfp_t* KargP;
__device__ __forceinline__ KargP karg_opaque(KargP p) { asm volatile("" : "+s"(p)); return p; }
struct Frame {
    LAS unsigned char* lds;
    volatile LAS unsigned* MISC;
    unsigned* ctl;
    int tid, lane, wave, G, bid;
    KargP in;
    float* out; unsigned char* ws;
};
#define WSP(T, off) ((T*)(F.ws + (off)))

__device__ __forceinline__ void transpose_item(const float* src, size_t ld, int nvalid, float scale, bf16_t* dst, int K, LAS float* scr, int lane) {
#pragma unroll 8
    for (int i = 0; i < 32; ++i) { const int kk = 2 * i + (lane >> 5); const int j = lane & 31; scr[kk * 33 + j] = (j < nvalid) ? src[(size_t)kk * ld + j] * scale : 0.f; }
    LDS_WAIT(); asm volatile("" ::: "memory");
    const int c = lane & 7;
#pragma unroll
    for (int j = 0; j < 4; ++j) { const int n = (lane >> 3) + 8 * j; const LAS float* s = scr + (8 * c) * 33 + n;
        u32x4 o; o.x = pk2(s[0 * 33], s[1 * 33]); o.y = pk2(s[2 * 33], s[3 * 33]); o.z = pk2(s[4 * 33], s[5 * 33]); o.w = pk2(s[6 * 33], s[7 * 33]);
        *(u32x4*)(dst + (size_t)n * K + 8 * c) = o; }
    LDS_WAIT(); asm volatile("" ::: "memory");
}
__device__ __forceinline__ void transpose_item_f8(const float* src, size_t ld, float scale, unsigned char* dst, int K, LAS float* scr, int lane) {
#pragma unroll 8
    for (int i = 0; i < 32; ++i) { const int kk = 2 * i + (lane >> 5); const int j = lane & 31; scr[kk * 33 + j] = src[(size_t)kk * ld + j] * scale; }
    LDS_WAIT(); asm volatile("" ::: "memory");
    const int c = lane & 3;
#pragma unroll
    for (int j = 0; j < 2; ++j) { const int n = (lane >> 2) + 16 * j; const LAS float* s = scr + (16 * c) * 33 + n;
        u32x4 o; o.x = pk4_fp8(s[0 * 33], s[1 * 33], s[2 * 33], s[3 * 33]); o.y = pk4_fp8(s[4 * 33], s[5 * 33], s[6 * 33], s[7 * 33]);
        o.z = pk4_fp8(s[8 * 33], s[9 * 33], s[10 * 33], s[11 * 33]); o.w = pk4_fp8(s[12 * 33], s[13 * 33], s[14 * 33], s[15 * 33]);
        *(u32x4*)(dst + (size_t)n * K + 16 * c) = o; }
    LDS_WAIT(); asm volatile("" ::: "memory");
}
__device__ __forceinline__ void p0_phase(Frame& F) {
    const KargP in = karg_opaque(F.in);
    LAS float* scr = (LAS float*)(F.lds + F.wave * 16384);
    const int gw = F.bid * NWAVES + F.wave, NGW = F.G * NWAVES;
    constexpr int IT_WIN = 32 * (WIN_ROWS / 32);
    constexpr int IT_WQK = 4 * 64;
    constexpr int IT_WPA2 = 32 * 64;
    constexpr int IT_WPH = 16 * 64;
    constexpr int IT_WOUT = 32 * 64;
    constexpr int IT_WGU1 = 32 * 128, IT_WGU = NEXP * IT_WGU1;
    constexpr int IT_WD1 = 32 * 64, IT_WD = NEXP * IT_WD1;
    constexpr int NITEMS = IT_WIN + IT_WQK + IT_WPA2 + IT_WPH + IT_WOUT + IT_WGU + IT_WD;
    for (int it = gw; it < NITEMS; it += NGW) {
        int r = it;
        if (r < IT_WIN) { const int g = r % (WIN_ROWS / 32), kb = r / (WIN_ROWS / 32); const int n0 = 32 * g; int sc, nv = 32;
            if (n0 < 2048) sc = n0; else if (n0 < 3072) sc = 2064 + (n0 - 2048); else if (n0 < 7168) sc = 6160 + (n0 - 3072); else if (n0 < 7200) { sc = 2048; nv = 16; } else if (n0 < WIN_HY0) { sc = 0; nv = 0; } else sc = 3088 + (n0 - WIN_HY0);
            transpose_item(in[I_WIN] + (size_t)(64 * kb) * N_IN + sc, N_IN, nv, 1.f, WSP(bf16_t, WS_WIN) + (size_t)n0 * DM + 64 * kb, DM, scr, F.lane); continue; } r -= IT_WIN;
        if (r < IT_WQK) { const int g = r % 64, kb = r / 64; const int n0 = 32 * g, h = n0 / 512, j = (n0 % 512) / 256, e0 = n0 % 256;
            const float* src = (j ? in[I_WKH] : in[I_WQH]) + (size_t)h * 65536 + (size_t)(64 * kb) * 256 + e0;
            transpose_item(src, 256, 32, j ? 0.0625f : 1.f, WSP(bf16_t, WS_WQK) + (size_t)n0 * 256 + 64 * kb, 256, scr, F.lane); continue; } r -= IT_WQK;
        if (r < IT_WPA2) { const int g = r % 64, kb = r / 64; const int n0 = 32 * g, k0 = 64 * kb;
            transpose_item(in[I_WPA] + (size_t)(k0 % 1024) * DM + n0, DM, 32, 1.f, WSP(bf16_t, WS_WPA2) + (size_t)n0 * 2048 + k0, 2048, scr, F.lane); continue; } r -= IT_WPA2;
        if (r < IT_WPH) { const int g = r % 64, kb = r / 64; const int n0 = 32 * g, k0 = 64 * kb;
            transpose_item(in[I_WPH] + (size_t)k0 * DM + n0, DM, 32, 1.f, WSP(bf16_t, WS_WPH) + (size_t)n0 * 1024 + k0, 1024, scr, F.lane); continue; } r -= IT_WPH;
        if (r < IT_WOUT) { const int g = r % 64, kb = r / 64; const int n0 = 32 * g, k0 = 64 * kb;
            transpose_item(in[I_WOUT] + (size_t)k0 * DM + n0, DM, 32, 1.f, WSP(bf16_t, WS_WOUT) + (size_t)n0 * 2048 + k0, 2048, scr, F.lane); continue; } r -= IT_WOUT;
        if (r < IT_WGU) { const int e = r / IT_WGU1, q = r % IT_WGU1; const int g = q % 128, kb = q / 128; const int n0 = 32 * g, k0 = 64 * kb, tile = n0 / 256, within = n0 % 256;
            const float* src = (within < 128 ? in[I_WG] : in[I_WU]) + (size_t)e * DM * DM + (size_t)k0 * DM + tile * 128 + (within & 127);
            transpose_item_f8(src, DM, 32.f, WSP(unsigned char, WS_WGU) + ((size_t)e * 4096 + n0) * DM + k0, DM, scr, F.lane); continue; } r -= IT_WGU;
        { const int e = r / IT_WD1, q = r % IT_WD1; const int g = q % 64, kb = q / 64; const int n0 = 32 * g, k0 = 64 * kb;
            transpose_item_f8(in[I_WDN] + (size_t)e * DM * DM + (size_t)k0 * DM + n0, DM, 64.f, WSP(unsigned char, WS_WD) + ((size_t)e * 2048 + n0) * DM + k0, DM, scr, F.lane); }
    }
    for (int i = F.bid * NTHR + F.tid; i < WIN_ROWS; i += F.G * NTHR) { int sc = -1;
        if (i < 2048) sc = i; else if (i < 3072) sc = 2064 + (i - 2048); else if (i < 7168) sc = 6160 + (i - 3072); else if (i < 7184) sc = 2048 + (i - 7168); else if (i < WIN_HY0) sc = -1; else sc = 3088 + (i - WIN_HY0);
        WSP(float, WS_BINP)[i] = sc >= 0 ? in[I_BIN][sc] : 0.f; }
    for (int it = gw; it < 16 * 48; it += NGW) {
        const int ks = it / 48, cg = it % 48; const int col = cg * 256 + F.lane * 4;
        f32x4 a[9];
#pragma unroll
        for (int v = 0; v < 9; ++v) a[v] = (f32x4){0.f, 0.f, 0.f, 0.f};
        for (int k = ks * 128; k < ks * 128 + 128; ++k) {
            const f32x4 w = *(const f32x4*)(in[I_WMOD] + (size_t)k * 12288 + col);
#pragma unroll
            for (int v = 0; v < 9; ++v) { const float cv = (v < 8) ? in[I_C][v * DM + k] : in[I_CCTX][k]; const float s = cv * sigmoidf_(cv); a[v] += w * s; }
        }
#pragma unroll
        for (int v = 0; v < 9; ++v) *(f32x4*)(WSP(float, WS_MODP) + ((size_t)ks * 9 + v) * 12288 + col) = a[v];
    }
    for (int j = gw; j < SEQ; j += NGW) {
        const int l = F.lane;
        float zv = 0.f;
        if (l == 0) zv = (float)j / (float)(SEQ - 1);
        else if (l < 33) { const int bi = (l - 1) & 15; const float f = 1e-4f + (float)bi * ((15.0f - 1e-4f) / 15.0f); const float ang = 6.283185307179586f * (float)j * f / (float)SEQ; zv = (l < 17) ? cosf(ang) : -sinf(ang); }
        float pre = in[I_FB1][l];
        for (int i = 0; i < 33; ++i) pre += __shfl(zv, i) * in[I_FW1][i * 64 + l];
        float a = sinf(in[I_FFREQ][l] * pre);
        pre = in[I_FBH][l];
        for (int i = 0; i < 64; ++i) pre += __shfl(a, i) * in[I_FWH][i * 64 + l];
        float a2 = sinf(in[I_FFREQ][64 + l] * pre);
        pre = in[I_FBH][64 + l];
        for (int i = 0; i < 64; ++i) pre += __shfl(a2, i) * in[I_FWH][4096 + i * 64 + l];
        WSP(float, WS_A3)[j * 64 + l] = sinf(in[I_FFREQ][128 + l] * pre);
    }
}

__device__ __forceinline__ void p0b_phase(Frame& F) {
    const KargP in = karg_opaque(F.in);
    for (int i = F.bid * NTHR + F.tid; i < 9 * 12288; i += F.G * NTHR) { const int col = i % 12288; float s = in[I_BMOD][col];
        for (int ks = 0; ks < 16; ++ks) s += WSP(float, WS_MODP)[(size_t)ks * 9 * 12288 + i];
        WSP(float, WS_MOD)[i] = s; }
    LAS float* wl = (LAS float*)F.lds;
    for (int un = F.bid; un < 256; un += F.G) {
        const int ct = un >> 2, pg = un & 3;
        __syncthreads();
        for (int q = 0; q < 8; ++q) { const int idx = F.tid + 512 * q, i = idx >> 6, cc = idx & 63; wl[cc * 68 + i] = in[I_FWOUT][(size_t)i * 4096 + ct * 64 + cc]; }
        __syncthreads();
        const int j = pg * 512 + F.wave * 64 + F.lane;
        f32x4 ar[16];
#pragma unroll
        for (int q = 0; q < 16; ++q) ar[q] = *(const f32x4*)(WSP(float, WS_A3) + j * 64 + 4 * q);
        const float tj = (float)j / (float)(SEQ - 1);
        const float mind = -3.0701134573253944f, maxd = -15.350567286626972f;
        const int cbase = (ct * 64) & 1023;
#pragma unroll 1
        for (int cc = 0; cc < 64; ++cc) {
            f32x4 s = (f32x4){0.f, 0.f, 0.f, 0.f};
#pragma unroll
            for (int q = 0; q < 16; ++q) s += ar[q] * *(const LAS f32x4*)(wl + cc * 68 + 4 * q);
            const float delta = fabsf(mind + (float)(cbase + cc) * ((maxd - mind) / 1023.0f));
            const float v = ((s.x + s.y) + (s.z + s.w)) * __expf(-tj * delta);
            WSP(float, WS_HTAPS)[(size_t)(ct * 64 + cc) * SEQ + j] = v;
        }
    }
}

__device__ __forceinline__ f32x2 cmul(f32x2 a, f32x2 b) { return (f32x2){a.x * b.x - a.y * b.y, a.x * b.y + a.y * b.x}; }
__device__ __forceinline__ f32x2 cmulc(f32x2 a, f32x2 b) { return (f32x2){a.x * b.x + a.y * b.y, a.y * b.x - a.x * b.y}; }
template <bool INV> __device__ __forceinline__ void dft4(f32x2& a, f32x2& b, f32x2& c, f32x2& d) {
    const f32x2 s0 = a + c, s1 = a - c, s2 = b + d, s3 = b - d;
    const f32x2 is3 = (f32x2){-s3.y, s3.x};
    a = s0 + s2; c = s0 - s2;
    if (!INV) { b = s1 - is3; d = s1 + is3; } else { b = s1 + is3; d = s1 - is3; }
}
template <bool INV> __device__ __forceinline__ void dft16(f32x2 (&v)[16]) {
#pragma unroll
    for (int n0 = 0; n0 < 4; ++n0) dft4<INV>(v[n0], v[4 + n0], v[8 + n0], v[12 + n0]);
    const float c1 = 0.9238795325112867f, s1 = 0.3826834323650898f, r2 = 0.7071067811865476f;
    const float cs[10] = {1.f, c1, r2, s1, 0.f, -s1, -r2, -c1, -1.f, -c1};
    const float sn[10] = {0.f, s1, r2, c1, 1.f, c1, r2, s1, 0.f, -s1};
#pragma unroll
    for (int k0 = 1; k0 < 4; ++k0)
#pragma unroll
        for (int n0 = 1; n0 < 4; ++n0) { const int m = n0 * k0; const f32x2 w = (f32x2){cs[m], INV ? sn[m] : -sn[m]}; v[4 * k0 + n0] = cmul(v[4 * k0 + n0], w); }
#pragma unroll
    for (int k0 = 0; k0 < 4; ++k0) dft4<INV>(v[4 * k0], v[4 * k0 + 1], v[4 * k0 + 2], v[4 * k0 + 3]);
#pragma unroll
    for (int a = 0; a < 4; ++a)
#pragma unroll
        for (int b = a + 1; b < 4; ++b) { const f32x2 t = v[4 * a + b]; v[4 * a + b] = v[4 * b + a]; v[4 * b + a] = t; }
}
__device__ __forceinline__ int fphys(int i) { return i + (i >> 4); }
constexpr int FFT_BUF_BYTES = (4096 + 256) * 8;
struct FftTw { f32x2 wA, wB; };
__device__ __forceinline__ FftTw fft_tw(int ht) { FftTw t; float s, c; sincospif(-(float)ht / 2048.0f, &s, &c); t.wA = (f32x2){c, s}; sincospif(-(float)(ht & 15) / 128.0f, &s, &c); t.wB = (f32x2){c, s}; return t; }
__device__ __forceinline__ void fft_fwd(f32x2 (&v)[16], LAS f32x2* buf, int ht, const FftTw& tw_) {
    FftTw tw = tw_; asm volatile("" : "+v"(ht), "+v"(tw.wA.x), "+v"(tw.wA.y), "+v"(tw.wB.x), "+v"(tw.wB.y));
    dft16<false>(v);
    { f32x2 w = tw.wA;
#pragma unroll
      for (int k = 1; k < 16; ++k) { v[k] = cmul(v[k], w); w = cmul(w, tw.wA); } }
#pragma unroll
    for (int k = 0; k < 16; ++k) buf[fphys(256 * k + ht)] = v[k];
    __syncthreads();
    const int ka = ht >> 4, s = ht & 15;
#pragma unroll
    for (int b = 0; b < 16; ++b) v[b] = buf[fphys(256 * ka + 16 * b + s)];
    dft16<false>(v);
    { f32x2 w = tw.wB;
#pragma unroll
      for (int k = 1; k < 16; ++k) { v[k] = cmul(v[k], w); w = cmul(w, tw.wB); } }
#pragma unroll
    for (int k = 0; k < 16; ++k) buf[fphys(256 * ka + 16 * k + s)] = v[k];
    __syncthreads();
#pragma unroll
    for (int q = 0; q < 16; ++q) v[q] = buf[fphys(16 * ht + q)];
    dft16<false>(v);
}
__device__ __forceinline__ void fft_inv(f32x2 (&v)[16], LAS f32x2* buf, int ht, const FftTw& tw_) {
    FftTw tw = tw_; asm volatile("" : "+v"(ht), "+v"(tw.wA.x), "+v"(tw.wA.y), "+v"(tw.wB.x), "+v"(tw.wB.y));
    dft16<true>(v);
#pragma unroll
    for (int q = 0; q < 16; ++q) buf[fphys(16 * ht + q)] = v[q];
    __syncthreads();
    const int ka = ht >> 4, s = ht & 15;
#pragma unroll
    for (int k = 0; k < 16; ++k) v[k] = buf[fphys(256 * ka + 16 * k + s)];
    { f32x2 w = tw.wB;
#pragma unroll
      for (int k = 1; k < 16; ++k) { v[k] = cmulc(v[k], w); w = cmul(w, tw.wB); } }
    dft16<true>(v);
#pragma unroll
    for (int b = 0; b < 16; ++b) buf[fphys(256 * ka + 16 * b + s)] = v[b];
    __syncthreads();
#pragma unroll
    for (int k = 0; k < 16; ++k) v[k] = buf[fphys(256 * k + ht)];
    { f32x2 w = tw.wA;
#pragma unroll
      for (int k = 1; k < 16; ++k) { v[k] = cmulc(v[k], w); w = cmul(w, tw.wA); } }
    dft16<true>(v);
    __syncthreads();
}

__device__ __forceinline__ void p1_phase(Frame& F) {
    const KargP in = karg_opaque(F.in);
    const int gw = F.bid * NWAVES + F.wave, NGW = F.G * NWAVES;
    const float* mod = WSP(float, WS_MOD);
    for (int row = gw; row < MALL; row += NGW) {
        const bool lat = row < MTOK;
        const float* xr = lat ? in[I_X] + (size_t)row * DM : in[I_CTX] + (size_t)(row - MTOK) * DM;
        const float* mv = mod + (size_t)(lat ? row / SEQ : 8) * 12288;
        f32x4 v[8]; float s = 0.f;
#pragma unroll
        for (int j = 0; j < 8; ++j) { v[j] = *(const f32x4*)(xr + F.lane * 4 + 256 * j); s += (v[j].x + v[j].y) + (v[j].z + v[j].w); }
        const float mean = wave_sum(s) * (1.f / DM); float s2 = 0.f;
#pragma unroll
        for (int j = 0; j < 8; ++j) { v[j] = v[j] - mean; s2 += (v[j].x * v[j].x + v[j].y * v[j].y) + (v[j].z * v[j].z + v[j].w * v[j].w); }
        const float rstd = 1.f / sqrtf(wave_sum(s2) * (1.f / DM) + LN_EPS);
        if (lat && F.lane == 0) { WSP(float, WS_STATS)[row * 2] = mean; WSP(float, WS_STATS)[row * 2 + 1] = rstd; }
        bf16_t* orow = WSP(bf16_t, WS_HX) + (size_t)row * DM;
#pragma unroll
        for (int j = 0; j < 8; ++j) { const int c = F.lane * 4 + 256 * j;
            const f32x4 g = *(const f32x4*)(in[I_LNG] + c), b = *(const f32x4*)(in[I_LNB] + c), sh = *(const f32x4*)(mv + c), sc = *(const f32x4*)(mv + 2048 + c);
            const f32x4 y = (v[j] * rstd * g + b) * (sc + 1.0f) + sh;
            u32x2 o; o.x = pk2(y.x, y.y); o.y = pk2(y.z, y.w); *(u32x2*)(orow + c) = o; }
    }
    const int hb = F.tid >> 8, ht = F.tid & 255;
    LAS f32x2* buf = (LAS f32x2*)(F.lds + hb * FFT_BUF_BYTES);
    const FftTw tw = fft_tw(ht);
    const float* htaps = WSP(float, WS_HTAPS);
    for (int u0 = F.bid * 2; u0 < 2048; u0 += F.G * 2) {
        const int un = u0 + hb, c = un >> 1, n = un & 1;
        const float* hf = htaps + (size_t)((n * 2 + 0) * 1024 + c) * SEQ, * hbk = htaps + (size_t)((n * 2 + 1) * 1024 + c) * SEQ;
        f32x2 v[16];
#pragma unroll
        for (int a = 0; a < 16; ++a) { const int i = 256 * a + ht; float x;
            if (a < 8) x = hf[i]; else if (i == 2048) x = 0.f; else x = hbk[4096 - i];
            v[a] = (f32x2){x * (1.0f / 4096.0f), 0.f}; }
        fft_fwd(v, buf, ht, tw);
        f32x2* Hd = WSP(f32x2, WS_H) + (size_t)un * 4096;
#pragma unroll
        for (int ks = 0; ks < 16; ++ks) Hd[ks * 256 + ht] = v[ks];
        __syncthreads();
    }
}

struct SchedZ {
    static constexpr bool GATHER = false;
    int G, c; const char* hx; const char* win;
    __device__ __forceinline__ bool next(int i, Unit& u) const {
        int L = i * G + c;
        if (L < 1856) { pg8::decode_tile(L, 64, 29, u.pm, u.pn); u.ex = 0; return true; } L -= 1856;
        if (L < 768) { pg8::decode_tile(L, 12, 64, u.pm, u.pn); u.ex = 1; return true; } L -= 768;
        if (L < 72) { int pm, pn; pg8::decode_tile(L, 8, 9, pm, pn); u.pm = 64 + pm; u.pn = pn < 8 ? pn : 28; u.ex = 0; return true; }
        return false;
    }
    __device__ __forceinline__ const char* a_base(const Unit& u) const { return u.ex ? win + (size_t)(WIN_HY0 + 256 * u.pm) * DM * 2 : hx + (size_t)(256 * u.pm) * DM * 2; }
    __device__ __forceinline__ const char* b_base(const Unit& u) const { return u.ex ? hx + (size_t)(256 * u.pn) * DM * 2 : win + (size_t)(256 * u.pn) * DM * 2; }
    __device__ __forceinline__ int a_row(const Unit&, int R) const { return R; }
};
struct EpiZ {
    static constexpr bool PERM = true;
    bf16_t* Z; bf16_t* ZT; const float* bias;
    __device__ __forceinline__ void operator()(const f32x4 (&acc)[2][2][4][2], const Unit& u, int wr, int wc, int fr, int fq) const {
        if (u.ex == 0) {
            const int row0 = u.pm * 256 + wr * 64 + fr, col0 = u.pn * 256 + wc * 32 + 8 * fq;
            f32x4 bv[2][2];
#pragma unroll
            for (int bj = 0; bj < 2; ++bj)
#pragma unroll
                for (int n = 0; n < 2; ++n) bv[bj][n] = *(const f32x4*)(bias + col0 + bj * 128 + 4 * n);
#pragma unroll
            for (int ai = 0; ai < 2; ++ai)
#pragma unroll
                for (int m = 0; m < 4; ++m) { bf16_t* rowp = Z + (size_t)(row0 + ai * 128 + m * 16) * ZN + col0;
#pragma unroll
                    for (int bj = 0; bj < 2; ++bj) { const f32x4 v0 = acc[ai][bj][m][0] + bv[bj][0], v1 = acc[ai][bj][m][1] + bv[bj][1];
                        u32x4 w; w.x = pg8::cvt_pk_bf16(v0[0], v0[1]); w.y = pg8::cvt_pk_bf16(v0[2], v0[3]); w.z = pg8::cvt_pk_bf16(v1[0], v1[1]); w.w = pg8::cvt_pk_bf16(v1[2], v1[3]);
                        *(u32x4*)(rowp + bj * 128) = w; } }
        } else {
            const int ch0 = u.pm * 256 + wr * 64 + fr, b = u.pn >> 3, t0 = (u.pn & 7) * 256 + wc * 32 + 8 * fq;
#pragma unroll
            for (int ai = 0; ai < 2; ++ai)
#pragma unroll
                for (int m = 0; m < 4; ++m) { const int ch = ch0 + ai * 128 + m * 16; const float bb = bias[WIN_HY0 + ch];
                    bf16_t* rowp = ZT + ((size_t)b * 3072 + ch) * SEQ + t0;
#pragma unroll
                    for (int bj = 0; bj < 2; ++bj) { const f32x4 v0 = acc[ai][bj][m][0] + bb, v1 = acc[ai][bj][m][1] + bb;
                        u32x4 w; w.x = pg8::cvt_pk_bf16(v0[0], v0[1]); w.y = pg8::cvt_pk_bf16(v0[2], v0[3]); w.z = pg8::cvt_pk_bf16(v1[0], v1[1]); w.w = pg8::cvt_pk_bf16(v1[2], v1[3]);
                        *(u32x4*)(rowp + bj * 128) = w; } }
        }
    }
};

__device__ __forceinline__ void p3_phase(Frame& F) {
    const KargP in = karg_opaque(F.in);
    const bf16_t* Z = WSP(bf16_t, WS_Z); bf16_t* U = WSP(bf16_t, WS_U);
    const float* cw = in[I_MCW]; const float* cb = in[I_MCB];
    for (int it = F.bid * NTHR + F.tid; it < MALL * 128; it += F.G * NTHR) {
        const int row = it >> 7, c0 = (it & 127) * 8;
        float a[8];
        { const f32x4 b0 = *(const f32x4*)(cb + c0), b1 = *(const f32x4*)(cb + c0 + 4); a[0] = b0.x; a[1] = b0.y; a[2] = b0.z; a[3] = b0.w; a[4] = b1.x; a[5] = b1.y; a[6] = b1.z; a[7] = b1.w; }
        const bool lat = row < MTOK;
        int base, y, x, H, Wd;
        if (lat) { const int t = row & (SEQ - 1); base = row - t; y = t >> 6; x = t & 63; H = 32; Wd = 64; }
        else { const int t = (row - MTOK) & (CTX - 1); base = row - t; y = 0; x = t; H = 1; Wd = CTX; }
#pragma unroll
        for (int dy = -1; dy <= 1; ++dy)
#pragma unroll
            for (int dx = -1; dx <= 1; ++dx) {
                const int yy = y + dy, xx = x + dx;
                if (yy < 0 || yy >= H || xx < 0 || xx >= Wd) continue;
                const int srow = base + yy * Wd + xx;
                const u32x4 zz = *(const u32x4*)(Z + (size_t)srow * ZN + ZC_QK + c0);
                const float* wp = cw + ((dy + 1) * 3 + (dx + 1)) * MW + c0;
                const f32x4 w0 = *(const f32x4*)wp, w1 = *(const f32x4*)(wp + 4);
                a[0] += bflo(zz.x) * w0.x; a[1] += bfhi(zz.x) * w0.y; a[2] += bflo(zz.y) * w0.z; a[3] += bfhi(zz.y) * w0.w;
                a[4] += bflo(zz.z) * w1.x; a[5] += bfhi(zz.z) * w1.y; a[6] += bflo(zz.w) * w1.z; a[7] += bfhi(zz.w) * w1.w;
            }
#pragma unroll
        for (int j = 0; j < 8; ++j) a[j] = a[j] * sigmoidf_(a[j]);
        u32x4 o; o.x = pk2(a[0], a[1]); o.y = pk2(a[2], a[3]); o.z = pk2(a[4], a[5]); o.w = pk2(a[6], a[7]);
        *(u32x4*)(U + (size_t)row * MW + c0) = o;
    }
}

struct SchedQK {
    static constexpr bool GATHER = false;
    int G, c; const char* u; const char* w;
    __device__ __forceinline__ bool next(int i, Unit& un) const { const int L = i * G + c; if (L >= 72 * 8) return false; pg8::decode_tile(L, 72, 8, un.pm, un.pn); un.ex = 0; return true; }
    __device__ __forceinline__ const char* a_base(const Unit& un) const { return u + ((size_t)(256 * un.pm) * MW + (un.pn >> 1) * 256) * 2; }
    __device__ __forceinline__ const char* b_base(const Unit& un) const { return w + (size_t)(256 * un.pn) * 256 * 2; }
    __device__ __forceinline__ int a_row(const Unit&, int R) const { return R; }
};
struct EpiQK {
    static constexpr bool PERM = true;
    bf16_t* O;
    __device__ __forceinline__ void operator()(const f32x4 (&acc)[2][2][4][2], const Unit& u, int wr, int wc, int fr, int fq) const {
        const int row0 = u.pm * 256 + wr * 64 + fr, col0 = u.pn * 256 + wc * 32 + 8 * fq;
#pragma unroll
        for (int ai = 0; ai < 2; ++ai)
#pragma unroll
            for (int m = 0; m < 4; ++m) { bf16_t* rowp = O + (size_t)(row0 + ai * 128 + m * 16) * 2048 + col0;
#pragma unroll
                for (int bj = 0; bj < 2; ++bj) { const f32x4 v0 = acc[ai][bj][m][0], v1 = acc[ai][bj][m][1];
                    u32x4 w; w.x = pg8::cvt_pk_bf16(v0[0], v0[1]); w.y = pg8::cvt_pk_bf16(v0[2], v0[3]); w.z = pg8::cvt_pk_bf16(v1[0], v1[1]); w.w = pg8::cvt_pk_bf16(v1[2], v1[3]);
                    *(u32x4*)(rowp + bj * 128) = w; } }
    }
};

constexpr int ML_QS = 264, ML_VS = 72, ML_PS = 72;
constexpr int ML_Q = 0, ML_K = ML_Q + 64 * ML_QS * 2, ML_V = ML_K + 64 * ML_QS * 2, ML_C = ML_V + 64 * ML_VS * 2, ML_P = ML_C + 80 * ML_QS * 2, ML_SC = ML_P + 64 * ML_PS * 2;
constexpr int ML_SA = ML_SC, ML_SU = ML_SC + 256, ML_SSI = ML_SC + 512, ML_SWG = ML_SC + 768, ML_SEM = ML_SC + 1024, ML_SDEN = ML_SC + 1280, ML_SMISC = ML_SC + 1536, ML_END = ML_SC + 1600;
static_assert(ML_END <= MISC_OFF, "mlstm LDS");
__device__ __forceinline__ bf16x8 lds_frag(const LAS bf16_t* p) { return *(const LAS bf16x8*)p; }
__device__ __forceinline__ void mlstm_unit(Frame& F, int un) {
    const int vs = un & 3, dir = (un >> 2) & 1, h = (un >> 3) & 3, b = un >> 5;
    const bf16_t* Z = WSP(bf16_t, WS_Z); const bf16_t* QK = WSP(bf16_t, WS_QKB); bf16_t* AM = WSP(bf16_t, WS_AM);
    LAS unsigned char* lds = F.lds;
    LAS bf16_t* Qs = (LAS bf16_t*)(lds + ML_Q); LAS bf16_t* Ks = (LAS bf16_t*)(lds + ML_K); LAS bf16_t* Vs = (LAS bf16_t*)(lds + ML_V);
    LAS bf16_t* Cs = (LAS bf16_t*)(lds + ML_C); LAS bf16_t* Ps = (LAS bf16_t*)(lds + ML_P);
    LAS float* sA = (LAS float*)(lds + ML_SA); LAS float* sU = (LAS float*)(lds + ML_SU); LAS float* sSI = (LAS float*)(lds + ML_SSI);
    LAS float* sWG = (LAS float*)(lds + ML_SWG); LAS float* sEM = (LAS float*)(lds + ML_SEM); LAS float* sDEN = (LAS float*)(lds + ML_SDEN); LAS float* sMI = (LAS float*)(lds + ML_SMISC);
    const int tid = F.tid, lane = F.lane, w = F.wave, l15 = lane & 15, g4 = lane >> 4;
    __syncthreads();
    for (int i = tid; i < 80 * ML_QS / 2; i += NTHR) ((LAS unsigned*)Cs)[i] = 0u;
    if (tid < 64) { Vs[tid * ML_VS + 64] = (bf16_t)0x3F80; for (int j = 65; j < ML_VS; ++j) Vs[tid * ML_VS + j] = 0; }
    f32x4 cacc[2][5];
#pragma unroll
    for (int a = 0; a < 2; ++a)
#pragma unroll
        for (int c = 0; c < 5; ++c) cacc[a][c] = (f32x4){0.f, 0.f, 0.f, 0.f};
    float m_run = 0.f;
    u32x4 pq[4], pk[4], pv; unsigned pgate = 0u, pgate2 = 0u;
#define ML_ROW0(st) ((st) < 4 ? (MTOK + b * CTX + 64 * (dir ? 3 - (st) : (st))) : (b * SEQ + 64 * (dir ? 35 - (st) : (st) - 4)))
#define ML_LOAD(st) do { const int r0_ = ML_ROW0(st); \
        _Pragma("unroll") for (int q_ = 0; q_ < 4; ++q_) { const int p_ = tid + 512 * q_, rr_ = p_ >> 5, cc_ = (p_ & 31) * 8; \
            pq[q_] = *(const u32x4*)(QK + (size_t)(r0_ + rr_) * 2048 + h * 512 + cc_); pk[q_] = *(const u32x4*)(QK + (size_t)(r0_ + rr_) * 2048 + h * 512 + 256 + cc_); } \
        { const int rr_ = tid >> 3, cc_ = (tid & 7) * 8; pv = *(const u32x4*)(Z + (size_t)(r0_ + rr_) * ZN + ZC_V + h * 256 + vs * 64 + cc_); } \
        if (tid < 64) { const bf16_t* gp_ = Z + (size_t)(r0_ + tid) * ZN + ZC_GT + dir * 8 + h; pgate = gp_[0]; pgate2 = gp_[4]; } } while (0)
#define ML_STORE() do { \
        _Pragma("unroll") for (int q_ = 0; q_ < 4; ++q_) { const int p_ = tid + 512 * q_, rr_ = p_ >> 5, cc_ = (p_ & 31) * 8; \
            *(LAS u32x4*)(Qs + rr_ * ML_QS + cc_) = pq[q_]; *(LAS u32x4*)(Ks + rr_ * ML_QS + cc_) = pk[q_]; } \
        { const int rr_ = tid >> 3, cc_ = (tid & 7) * 8; *(LAS u32x4*)(Vs + rr_ * ML_VS + cc_) = pv; } } while (0)
    ML_LOAD(0);
    __syncthreads();
    const int tt = w & 3; const int nv = (w < 4) ? 3 : 2;
#pragma unroll 1
    for (int st = 0; st < 36; ++st) {
        ML_STORE();
        if (w == 0) {
            const float li = bf2f(pgate), zf = bf2f(pgate2);
            const float lf = fminf(zf, 0.f) - log1pf(__expf(-fabsf(zf)));
            float bcs = lf;
#pragma unroll
            for (int o = 1; o < 64; o <<= 1) { const float t = dir ? __shfl_down(bcs, o) : __shfl_up(bcs, o); const bool ok = dir ? (lane + o < 64) : (lane >= o); bcs += ok ? t : 0.f; }
            const float a = li - bcs;
            float am = a;
#pragma unroll
            for (int o = 1; o < 64; o <<= 1) { const float t = dir ? __shfl_down(am, o) : __shfl_up(am, o); const bool ok = dir ? (lane + o < 64) : (lane >= o); am = ok ? fmaxf(am, t) : am; }
            const float inter = bcs + m_run;
            const float mt = fmaxf(inter, bcs + am);
            const float b_end = __shfl(bcs, dir ? 0 : 63);
            const float gg = b_end - bcs + li;
            float gm = gg;
#pragma unroll
            for (int o = 1; o < 64; o <<= 1) gm = fmaxf(gm, __shfl_xor(gm, o));
            const float m_new = fmaxf(b_end + m_run, gm);
            sA[lane] = a; sU[lane] = bcs - mt; sSI[lane] = __expf(inter - mt); sWG[lane] = __expf(gg - m_new); sEM[lane] = __expf(-mt);
            if (lane == 0) sMI[0] = __expf(b_end + m_run - m_new);
            m_run = m_new;
        }
        const int row0 = ML_ROW0(st);
        if (st + 1 < 36) ML_LOAD(st + 1);
        __syncthreads();
        {
            f32x4 sacc[2] = {(f32x4){0.f, 0.f, 0.f, 0.f}, (f32x4){0.f, 0.f, 0.f, 0.f}};
#pragma unroll
            for (int ks = 0; ks < 8; ++ks) {
                const bf16x8 qf = lds_frag(Qs + (16 * tt + l15) * ML_QS + 32 * ks + 8 * g4);
#pragma unroll
                for (int j = 0; j < 2; ++j) { const int stl = 2 * (w >> 2) + j;
                    const bf16x8 kf = lds_frag(Ks + (16 * stl + l15) * ML_QS + 32 * ks + 8 * g4);
                    sacc[j] = __builtin_amdgcn_mfma_f32_16x16x32_bf16(kf, qf, sacc[j], 0, 0, 0); }
            }
            const int t = 16 * tt + l15; const float ut = sU[t];
#pragma unroll
            for (int j = 0; j < 2; ++j) { const int s0 = 16 * (2 * (w >> 2) + j) + 4 * g4;
                const f32x4 av = *(const LAS f32x4*)(sA + s0);
                float pvv[4];
#pragma unroll
                for (int r = 0; r < 4; ++r) { const int s = s0 + r; const bool ok = dir ? (s >= t) : (s <= t); pvv[r] = ok ? sacc[j][r] * __expf(ut + av[r]) : 0.f; }
                u32x2 o; o.x = pk2(pvv[0], pvv[1]); o.y = pk2(pvv[2], pvv[3]);
                *(LAS u32x2*)(Ps + t * ML_PS + s0) = o; }
        }
        __syncthreads();
        f32x4 nacc[3], iacc[3];
#pragma unroll
        for (int j = 0; j < 3; ++j) { nacc[j] = (f32x4){0.f, 0.f, 0.f, 0.f}; iacc[j] = (f32x4){0.f, 0.f, 0.f, 0.f}; }
#pragma unroll
        for (int ks = 0; ks < 8; ++ks) {
            const bf16x8 qf = lds_frag(Qs + (16 * tt + l15) * ML_QS + 32 * ks + 8 * g4);
#pragma unroll
            for (int j = 0; j < 3; ++j) if (j < nv) { const int vt = (w < 4) ? (j == 2 ? 4 : j) : 2 + j;
                const bf16x8 cf = lds_frag(Cs + (16 * vt + l15) * ML_QS + 32 * ks + 8 * g4);
                iacc[j] = __builtin_amdgcn_mfma_f32_16x16x32_bf16(qf, cf, iacc[j], 0, 0, 0); }
        }
#pragma unroll
        for (int ks = 0; ks < 2; ++ks) {
            const bf16x8 pf = lds_frag(Ps + (16 * tt + l15) * ML_PS + 32 * ks + 8 * g4);
#pragma unroll
            for (int j = 0; j < 3; ++j) if (j < nv) { const int vt = (w < 4) ? (j == 2 ? 4 : j) : 2 + j;
                bf16x8 vf;
#pragma unroll
                for (int e = 0; e < 8; ++e) vf[e] = (short)Vs[(32 * ks + 8 * g4 + e) * ML_VS + 16 * vt + l15];
                nacc[j] = __builtin_amdgcn_mfma_f32_16x16x32_bf16(pf, vf, nacc[j], 0, 0, 0); }
        }
        const int t0 = 16 * tt + 4 * g4;
        {
            const f32x4 si = *(const LAS f32x4*)(sSI + t0);
#pragma unroll
            for (int j = 0; j < 3; ++j) if (j < nv) nacc[j] = nacc[j] + iacc[j] * si;
            if (w < 4 && l15 == 0) *(LAS f32x4*)(sDEN + t0) = nacc[2];
        }
        {
            const float decay = sMI[0];
#pragma unroll
            for (int a = 0; a < 2; ++a)
#pragma unroll
                for (int c = 0; c < 5; ++c) cacc[a][c] = cacc[a][c] * decay;
#pragma unroll
            for (int ks = 0; ks < 2; ++ks) {
                bf16x8 kf[2];
#pragma unroll
                for (int a = 0; a < 2; ++a)
#pragma unroll
                    for (int e = 0; e < 8; ++e) kf[a][e] = (short)Ks[(32 * ks + 8 * g4 + e) * ML_QS + 16 * (2 * w + a) + l15];
                float wg[8];
#pragma unroll
                for (int e = 0; e < 8; ++e) wg[e] = sWG[32 * ks + 8 * g4 + e];
#pragma unroll
                for (int c = 0; c < 5; ++c) {
                    u32x4 vw;
                    { float x[8];
#pragma unroll
                      for (int e = 0; e < 8; ++e) x[e] = bf2f((unsigned)Vs[(32 * ks + 8 * g4 + e) * ML_VS + 16 * c + l15]) * wg[e];
                      vw.x = pk2(x[0], x[1]); vw.y = pk2(x[2], x[3]); vw.z = pk2(x[4], x[5]); vw.w = pk2(x[6], x[7]); }
                    const bf16x8 vf = __builtin_bit_cast(bf16x8, vw);
#pragma unroll
                    for (int a = 0; a < 2; ++a) cacc[a][c] = __builtin_amdgcn_mfma_f32_16x16x32_bf16(kf[a], vf, cacc[a][c], 0, 0, 0);
                }
            }
        }
        __syncthreads();
        if (st >= 4) {
            const f32x4 dn = *(const LAS f32x4*)(sDEN + t0), em = *(const LAS f32x4*)(sEM + t0);
#pragma unroll
            for (int j = 0; j < 2; ++j) { const int vt = (w < 4) ? j : 2 + j; const int col = h * 256 + vs * 64 + 16 * vt + l15;
#pragma unroll
                for (int r = 0; r < 4; ++r) { const int row = row0 + t0 + r;
                    const float hv = nacc[j][r] / fmaxf(fabsf(dn[r]), em[r]);
                    const float o = sigmoidf_(bf2f((unsigned)Z[(size_t)row * ZN + ZC_O + col]));
                    AM[(size_t)row * 2048 + dir * 1024 + col] = (bf16_t)f2bf(o * hv); } }
        }
#pragma unroll
        for (int a = 0; a < 2; ++a)
#pragma unroll
            for (int c = 0; c < 5; ++c) { u32x2 o; o.x = pk2(cacc[a][c][0], cacc[a][c][1]); o.y = pk2(cacc[a][c][2], cacc[a][c][3]);
                *(LAS u32x2*)(Cs + (16 * c + l15) * ML_QS + 16 * (2 * w + a) + 4 * g4) = o; }
        __syncthreads();
    }
#undef ML_LOAD
#undef ML_STORE
#undef ML_ROW0
}

constexpr int HY_RAW = 2 * FFT_BUF_BYTES, HY_OUT = HY_RAW + 16384, HY_END = HY_OUT + 65536;
static_assert(HY_END <= MISC_OFF, "hyena LDS");
__device__ __forceinline__ void hy_conv(const LAS bf16_t* raw, const float* cw, float bias, int c3, int ht, f32x2 (&o)[8]) {
    float w9[9];
#pragma unroll
    for (int q = 0; q < 9; ++q) w9[q] = cw[q * 3072 + c3];
    asm volatile("" : "+v"(ht));
    const int x = ht & 63;
#pragma unroll
    for (int a = 0; a < 8; ++a) { const int t = 256 * a + ht, y = t >> 6; float a0 = bias, a1 = bias;
#pragma unroll
        for (int dy = -1; dy <= 1; ++dy)
#pragma unroll
            for (int dx = -1; dx <= 1; ++dx) { const int yy = y + dy, xx = x + dx;
                if (yy >= 0 && yy < 32 && xx >= 0 && xx < 64) { const int idx = t + 64 * dy + dx; const float wv = w9[(dy + 1) * 3 + dx + 1];
                    a0 += wv * bf2f((unsigned)raw[idx]); a1 += wv * bf2f((unsigned)raw[2048 + idx]); } }
        o[a] = (f32x2){a0, a1}; asm volatile("" ::: "memory"); }
}
__device__ __forceinline__ void hyena_unit(Frame& F, int un) {
    const KargP in = karg_opaque(F.in);
    const int cg = un >> 2, bp = un & 3, c0 = cg * 8, b0 = bp * 2;
    const int hb = F.tid >> 8, ht = F.tid & 255;
    LAS f32x2* buf = (LAS f32x2*)(F.lds + hb * FFT_BUF_BYTES);
    LAS bf16_t* raw = (LAS bf16_t*)(F.lds + HY_RAW + hb * 8192);
    LAS bf16_t* outT = (LAS bf16_t*)(F.lds + HY_OUT);
    const bf16_t* ZT = WSP(bf16_t, WS_ZT); const f32x2* H = WSP(f32x2, WS_H);
    const FftTw tw = fft_tw(ht);
    __syncthreads();
#pragma unroll 1
    for (int i = 0; i < 4; ++i) {
        const int cl = 2 * i + hb, c = c0 + cl;
#define HY_LOADRAW(kind) do { _Pragma("unroll") for (int bb = 0; bb < 2; ++bb) \
            *(LAS u32x4*)(raw + bb * 2048 + ht * 8) = *(const u32x4*)(ZT + ((size_t)(b0 + bb) * 3072 + (kind) * 1024 + c) * SEQ + ht * 8); } while (0)
        HY_LOADRAW(2);
        __syncthreads();
        f32x2 vin[8], v[16];
        hy_conv(raw, in[I_HCW], in[I_HCB][2048 + c], 2048 + c, ht, vin);
#pragma unroll
        for (int a = 0; a < 8; ++a) { v[a] = vin[a]; v[8 + a] = (f32x2){0.f, 0.f}; }
        fft_fwd(v, buf, ht, tw);
        { const f32x2* Hd = H + (size_t)(c * 2 + 0) * 4096;
#pragma unroll
          for (int ks = 0; ks < 16; ++ks) v[ks] = cmul(v[ks], Hd[ks * 256 + ht]); }
        fft_inv(v, buf, ht, tw);
        HY_LOADRAW(0);
        __syncthreads();
        { f32x2 g[8]; hy_conv(raw, in[I_HCW], in[I_HCB][c], c, ht, g); const float sk = in[I_HSKIP][c];
#pragma unroll
          for (int a = 0; a < 8; ++a) vin[a] = g[a] * (v[a] + vin[a] * sk); }
#pragma unroll
        for (int a = 0; a < 8; ++a) { v[a] = vin[a]; v[8 + a] = (f32x2){0.f, 0.f}; }
        fft_fwd(v, buf, ht, tw);
        { const f32x2* Hd = H + (size_t)(c * 2 + 1) * 4096;
#pragma unroll
          for (int ks = 0; ks < 16; ++ks) v[ks] = cmul(v[ks], Hd[ks * 256 + ht]); }
        fft_inv(v, buf, ht, tw);
        HY_LOADRAW(1);
        __syncthreads();
        { f32x2 g[8]; hy_conv(raw, in[I_HCW], in[I_HCB][1024 + c], 1024 + c, ht, g); const float sk = in[I_HSKIP][1024 + c];
#pragma unroll
          for (int a = 0; a < 8; ++a) { const f32x2 o = g[a] * (v[a] + vin[a] * sk); const int t = 256 * a + ht;
              outT[(0 * 2048 + t) * 8 + cl] = (bf16_t)f2bf(o.x); outT[(1 * 2048 + t) * 8 + cl] = (bf16_t)f2bf(o.y); } }
        __syncthreads();
#undef HY_LOADRAW
    }
    bf16_t* HH = WSP(bf16_t, WS_HH);
#pragma unroll
    for (int q = 0; q < 8; ++q) { const int r = F.tid + 512 * q, bb = r >> 11, t = r & 2047;
        *(u32x4*)(HH + ((size_t)(b0 + bb) * SEQ + t) * HW + c0) = *(const LAS u32x4*)(outT + r * 8); }
    __syncthreads();
}

struct SchedP {
    static constexpr bool GATHER = false;
    int G, c; const char* a; const char* b; size_t astep, bstep;
    __device__ __forceinline__ bool next(int i, Unit& u) const { const int L = i * G + c; if (L >= 512) return false; pg8::decode_tile(L, 64, 8, u.pm, u.pn); u.ex = 0; return true; }
    __device__ __forceinline__ const char* a_base(const Unit& u) const { return a + (size_t)u.pm * astep; }
    __device__ __forceinline__ const char* b_base(const Unit& u) const { return b + (size_t)u.pn * bstep; }
    __device__ __forceinline__ int a_row(const Unit&, int R) const { return R; }
};
struct EpiMA {
    static constexpr bool PERM = true;
    float* T; const bf16_t* Z;
    __device__ __forceinline__ void operator()(const f32x4 (&acc)[2][2][4][2], const Unit& u, int wr, int wc, int fr, int fq) const {
        const int row0 = u.pm * 256 + wr * 64 + fr, col0 = u.pn * 256 + wc * 32 + 8 * fq;
#pragma unroll
        for (int ai = 0; ai < 2; ++ai)
#pragma unroll
            for (int m = 0; m < 4; ++m) { const size_t row = row0 + ai * 128 + m * 16;
#pragma unroll
                for (int bj = 0; bj < 2; ++bj) { const int c = col0 + bj * 128;
                    const u32x4 gz = *(const u32x4*)(Z + row * ZN + ZC_GA + c);
                    f32x4 g0 = (f32x4){sigmoidf_(bflo(gz.x)), sigmoidf_(bfhi(gz.x)), sigmoidf_(bflo(gz.y)), sigmoidf_(bfhi(gz.y))};
                    f32x4 g1 = (f32x4){sigmoidf_(bflo(gz.z)), sigmoidf_(bfhi(gz.z)), sigmoidf_(bflo(gz.w)), sigmoidf_(bfhi(gz.w))};
                    *(f32x4*)(T + row * DM + c) = acc[ai][bj][m][0] * g0; *(f32x4*)(T + row * DM + c + 4) = acc[ai][bj][m][1] * g1; } }
    }
};
struct EpiMB {
    static constexpr bool PERM = true;
    const float* T; const bf16_t* Z; bf16_t* MX;
    __device__ __forceinline__ void operator()(const f32x4 (&acc)[2][2][4][2], const Unit& u, int wr, int wc, int fr, int fq) const {
        const int row0 = u.pm * 256 + wr * 64 + fr, col0 = u.pn * 256 + wc * 32 + 8 * fq;
#pragma unroll
        for (int ai = 0; ai < 2; ++ai)
#pragma unroll
            for (int m = 0; m < 4; ++m) { const size_t row = row0 + ai * 128 + m * 16;
#pragma unroll
                for (int bj = 0; bj < 2; ++bj) { const int c = col0 + bj * 128;
                    const u32x4 gz = *(const u32x4*)(Z + row * ZN + ZC_GH + c);
                    const f32x4 t0 = *(const f32x4*)(T + row * DM + c), t1 = *(const f32x4*)(T + row * DM + c + 4);
                    f32x4 g0 = (f32x4){sigmoidf_(bflo(gz.x)), sigmoidf_(bfhi(gz.x)), sigmoidf_(bflo(gz.y)), sigmoidf_(bfhi(gz.y))};
                    f32x4 g1 = (f32x4){sigmoidf_(bflo(gz.z)), sigmoidf_(bfhi(gz.z)), sigmoidf_(bflo(gz.w)), sigmoidf_(bfhi(gz.w))};
                    const f32x4 v0 = t0 + acc[ai][bj][m][0] * g0, v1 = t1 + acc[ai][bj][m][1] * g1;
                    u32x4 w; w.x = pg8::cvt_pk_bf16(v0[0], v0[1]); w.y = pg8::cvt_pk_bf16(v0[2], v0[3]); w.z = pg8::cvt_pk_bf16(v1[0], v1[1]); w.w = pg8::cvt_pk_bf16(v1[2], v1[3]);
                    *(u32x4*)(MX + row * DM + c) = w; } }
    }
};
struct EpiWO {
    static constexpr bool PERM = false;
    float* R1; const float* x; const float* stats; const float* lng; const float* lnb; const float* mod;
    __device__ __forceinline__ void operator()(const f32x4 (&acc)[2][2][4][2], const Unit& u, int wr, int wc, int fr, int fq) const {
        const int row0 = u.pm * 256 + wr * 64 + fr, col0 = u.pn * 256 + wc * 32 + 4 * fq;
        const float* g1p = mod + (size_t)(u.pm >> 3) * 12288 + 4096;
#pragma unroll
        for (int ai = 0; ai < 2; ++ai)
#pragma unroll
            for (int m = 0; m < 4; ++m) { const size_t row = row0 + ai * 128 + m * 16; const float mean = stats[row * 2], rstd = stats[row * 2 + 1];
#pragma unroll
                for (int bj = 0; bj < 2; ++bj)
#pragma unroll
                    for (int n = 0; n < 2; ++n) { const int c = col0 + bj * 128 + n * 16;
                        const f32x4 xv = *(const f32x4*)(x + row * DM + c), g = *(const f32x4*)(lng + c), bb = *(const f32x4*)(lnb + c), g1 = *(const f32x4*)(g1p + c);
                        *(f32x4*)(R1 + row * DM + c) = ((xv - mean) * rstd * g + bb) * DN_ALPHA + g1 * acc[ai][bj][m][n]; } }
    }
};

__device__ __forceinline__ void p8_phase(Frame& F) {
    const KargP in = karg_opaque(F.in);
    const int gw = F.bid * NWAVES + F.wave, NGW = F.G * NWAVES, lane = F.lane, l15 = lane & 15, g4 = lane >> 4;
    const float* R1 = WSP(float, WS_R1); unsigned char* TOK = WSP(unsigned char, WS_TOK); const float* mod = WSP(float, WS_MOD);
    LAS float* lg = (LAS float*)(F.lds + F.wave * 4096);
    LAS int* te = (LAS int*)(F.lds + F.wave * 4096 + 2304); LAS float* tw = (LAS float*)(F.lds + F.wave * 4096 + 2304 + 256);
    const float* wr = in[I_WR];
    for (int tile = gw; tile < MTOK / 16; tile += NGW) {
        const int bsel = (tile * 16) / SEQ; const float* mv = mod + (size_t)bsel * 12288;
        float my_mean = 0.f, my_rstd = 0.f;
        for (int rr = 0; rr < 16; ++rr) {
            const int row = tile * 16 + rr; const float* xr = R1 + (size_t)row * DM;
            f32x4 v[8]; float s = 0.f;
#pragma unroll
            for (int j = 0; j < 8; ++j) { v[j] = *(const f32x4*)(xr + lane * 4 + 256 * j); s += (v[j].x + v[j].y) + (v[j].z + v[j].w); }
            const float mean = wave_sum(s) * (1.f / DM); float s2 = 0.f;
#pragma unroll
            for (int j = 0; j < 8; ++j) { const f32x4 d = v[j] - mean; s2 += (d.x * d.x + d.y * d.y) + (d.z * d.z + d.w * d.w); }
            const float rstd = 1.f / sqrtf(wave_sum(s2) * (1.f / DM) + LN_EPS);
            if (l15 == rr) { my_mean = mean; my_rstd = rstd; }
            unsigned char* orow = TOK + (size_t)row * DM;
#pragma unroll
            for (int j = 0; j < 8; ++j) { const int c = lane * 4 + 256 * j;
                const f32x4 g = *(const f32x4*)(in[I_LN1G] + c), bb = *(const f32x4*)(in[I_LN1B] + c), sh = *(const f32x4*)(mv + 6144 + c), sc = *(const f32x4*)(mv + 8192 + c);
                const f32x4 y = ((v[j] - mean) * rstd * g + bb) * (sc + 1.0f) + sh;
                *(unsigned*)(orow + c) = pk4_fp8(y.x, y.y, y.z, y.w); }
        }
        f32x4 acc0 = (f32x4){0.f, 0.f, 0.f, 0.f}, acc1 = (f32x4){0.f, 0.f, 0.f, 0.f};
        const float* rowp = R1 + (size_t)(tile * 16 + l15) * DM + 512 * g4;
#pragma unroll 2
        for (int s = 0; s < 512; s += 4) { const int d = 512 * g4 + s;
            const f32x4 r4 = *(const f32x4*)(rowp + s);
            const f32x4 g = *(const f32x4*)(in[I_LN1G] + d), bb = *(const f32x4*)(in[I_LN1B] + d), sh = *(const f32x4*)(mv + 6144 + d), sc = *(const f32x4*)(mv + 8192 + d);
            const f32x4 tk = ((r4 - my_mean) * my_rstd * g + bb) * (sc + 1.0f) + sh;
#pragma unroll
            for (int j = 0; j < 4; ++j) { const float w0 = wr[(d + j) * 32 + l15], w1 = wr[(d + j) * 32 + 16 + l15];
                acc0 = __builtin_amdgcn_mfma_f32_16x16x4f32(tk[j], w0, acc0, 0, 0, 0); acc1 = __builtin_amdgcn_mfma_f32_16x16x4f32(tk[j], w1, acc1, 0, 0, 0); }
        }
        { const float b0 = in[I_BR][l15], b1 = in[I_BR][16 + l15];
#pragma unroll
          for (int r = 0; r < 4; ++r) { lg[(4 * g4 + r) * 33 + l15] = acc0[r] + b0; lg[(4 * g4 + r) * 33 + 16 + l15] = acc1[r] + b1; } }
        LDS_WAIT(); asm volatile("" ::: "memory");
        if (lane < 16) {
            unsigned chosen = 0u; float lv[4]; int le[4];
            for (int k = 0; k < 4; ++k) { float best = -3.4e38f; int be = 0;
                for (int e = 0; e < 32; ++e) { const float v = lg[lane * 33 + e]; if (!((chosen >> e) & 1u) && v > best) { best = v; be = e; } }
                chosen |= 1u << be; lv[k] = best; le[k] = be; }
            float ex[4], sum = 0.f;
            for (int k = 0; k < 4; ++k) { ex[k] = __expf(lv[k] - lv[0]); sum += ex[k]; }
            for (int k = 0; k < 4; ++k) { te[lane * 4 + k] = le[k]; tw[lane * 4 + k] = ex[k] / sum; }
        }
        LDS_WAIT(); asm volatile("" ::: "memory");
        { const int e = te[lane]; const float wv = tw[lane]; const int token = tile * 16 + (lane >> 2);
          const int pos = (int)__hip_atomic_fetch_add(F.ctl + CW_CNT + 64 * e, 1u, __ATOMIC_RELAXED, __HIP_MEMORY_SCOPE_AGENT);
          WSP(int, WS_TOPE)[token * 4 + (lane & 3)] = e; WSP(int, WS_TOPP)[token * 4 + (lane & 3)] = pos; WSP(float, WS_TOPW)[token * 4 + (lane & 3)] = wv;
          WSP(int, WS_RTOK)[e * POSCAP + pos] = token; WSP(float, WS_RW)[e * POSCAP + pos] = wv; }
        LDS_WAIT(); asm volatile("" ::: "memory");
    }
}

constexpr int MOE_TBL = 131072;
__device__ __forceinline__ void moe_table(Frame& F) {
    LAS int* tst = (LAS int*)(F.lds + MOE_TBL); LAS int* cn = (LAS int*)(F.lds + MOE_TBL + 256);
    __syncthreads();
    if (F.tid == 0) { int acc = 0; for (int e = 0; e < NEXP; ++e) { const int c = (int)__hip_atomic_load(F.ctl + CW_CNT + 64 * e, __ATOMIC_RELAXED, __HIP_MEMORY_SCOPE_AGENT); cn[e] = c; tst[e] = acc; acc += (c + 255) >> 8; } tst[NEXP] = acc; }
    __syncthreads();
}
template <bool GU> struct SchedMoE {
    static constexpr bool GATHER = GU;
    int G, c, NT; const LAS int* tst; const LAS int* cn; const int* rtok; const char* a; const char* b;
    __device__ __forceinline__ bool next(int i, Unit& u) const {
        const int nwg = __builtin_amdgcn_readfirstlane(tst[NEXP]) * NT; const int L = i * G + c; if (L >= nwg) return false;
        int wg; { const int q = nwg / 8, r = nwg % 8, xcd = L % 8, off = L / 8; wg = (xcd < r ? xcd * (q + 1) : r * (q + 1) + (xcd - r) * q) + off; }
        int e = 0;
#pragma unroll 1
        for (int k = 1; k < NEXP; ++k) { const int s = __builtin_amdgcn_readfirstlane(tst[k]); if (wg >= s * NT) e = k; }
        const int ts = __builtin_amdgcn_readfirstlane(tst[e]), ts1 = __builtin_amdgcn_readfirstlane(tst[e + 1]);
        const int rem = wg - ts * NT, ne = ts1 - ts;
        u.pm = ts + rem % ne; u.pn = rem / ne; u.ex = e; return true;
    }
    __device__ __forceinline__ const char* a_base(const Unit& u) const { return GU ? a : a + (size_t)u.pm * 256 * DM; }
    __device__ __forceinline__ const char* b_base(const Unit& u) const { return b + ((size_t)u.ex * (GU ? 4096 : 2048) + 256 * u.pn) * DM; }
    __device__ __forceinline__ int a_row(const Unit& u, int R) const { const int pos = (u.pm - tst[u.ex]) * 256 + R; return pos < cn[u.ex] ? rtok[u.ex * POSCAP + pos] : 0; }
};
struct EpiGU {
    static constexpr bool PERM = true;
    unsigned char* ACT; const float* bg; const float* bu;
    __device__ __forceinline__ void operator()(const f32x4 (&acc)[2][2][4][2], const Unit& u, int wr, int wc, int fr, int fq) const {
        const int row0 = u.pm * 256 + wr * 64 + fr, col0 = u.pn * 128 + wc * 32 + 8 * fq;
        const float* bgp = bg + (size_t)u.ex * DM + col0; const float* bup = bu + (size_t)u.ex * DM + col0;
        const f32x4 g0 = *(const f32x4*)bgp, g1 = *(const f32x4*)(bgp + 4), u0 = *(const f32x4*)bup, u1 = *(const f32x4*)(bup + 4);
#pragma unroll
        for (int ai = 0; ai < 2; ++ai)
#pragma unroll
            for (int m = 0; m < 4; ++m) { const size_t row = row0 + ai * 128 + m * 16;
                float o[8];
#pragma unroll
                for (int n = 0; n < 2; ++n)
#pragma unroll
                    for (int j = 0; j < 4; ++j) { const float gv = fminf(acc[ai][0][m][n][j] + (n ? g1[j] : g0[j]), 7.0f);
                        const float uv = fminf(fmaxf(acc[ai][1][m][n][j] + (n ? u1[j] : u0[j]), -7.0f), 7.0f);
                        o[n * 4 + j] = 4.0f * gv * sigmoidf_(1.702f * gv) * (uv + 1.0f); }
                u32x2 w; w.x = pk4_fp8(o[0], o[1], o[2], o[3]); w.y = pk4_fp8(o[4], o[5], o[6], o[7]);
                *(u32x2*)(ACT + row * DM + col0) = w; }
    }
};
struct EpiDN {
    static constexpr bool PERM = true;
    bf16_t* YR; const float* bd;
    __device__ __forceinline__ void operator()(const f32x4 (&acc)[2][2][4][2], const Unit& u, int wr, int wc, int fr, int fq) const {
        const int r0 = wr * 64 + fr, col0 = u.pn * 256 + wc * 32 + 8 * fq;
        const float* bp = bd + (size_t)u.ex * DM + col0;
        bf16_t* base = YR + ((size_t)u.pm * 256 + r0) * DM + col0;
#pragma unroll
        for (int bj = 0; bj < 2; ++bj) {
            const f32x4 bv0 = *(const f32x4*)(bp + bj * 128), bv1 = *(const f32x4*)(bp + bj * 128 + 4);
#pragma unroll
            for (int ai = 0; ai < 2; ++ai)
#pragma unroll
                for (int m = 0; m < 4; ++m) {
                    const f32x4 v0 = acc[ai][bj][m][0] + bv0, v1 = acc[ai][bj][m][1] + bv1;
                    u32x4 w; w.x = pg8::cvt_pk_bf16(v0[0], v0[1]); w.y = pg8::cvt_pk_bf16(v0[2], v0[3]); w.z = pg8::cvt_pk_bf16(v1[0], v1[1]); w.w = pg8::cvt_pk_bf16(v1[2], v1[3]);
                    *(u32x4*)(base + (size_t)(ai * 128 + m * 16) * DM + bj * 128) = w; }
        }
    }
};

__device__ __forceinline__ void p11_phase(Frame& F) {
    const KargP in = karg_opaque(F.in);
    const int gw = F.bid * NWAVES + F.wave, NGW = F.G * NWAVES, lane = F.lane;
    const LAS int* tst = (const LAS int*)(F.lds + MOE_TBL);
    const float* R1 = WSP(float, WS_R1); const bf16_t* YR = WSP(bf16_t, WS_YR); const float* mod = WSP(float, WS_MOD);
    for (int row = gw; row < MTOK; row += NGW) {
        int dest[4]; float wk[4];
#pragma unroll
        for (int k = 0; k < 4; ++k) { wk[k] = __builtin_bit_cast(float, __builtin_amdgcn_readfirstlane(__builtin_bit_cast(int, WSP(float, WS_TOPW)[row * 4 + k]))); const int e = __builtin_amdgcn_readfirstlane(WSP(int, WS_TOPE)[row * 4 + k]), pos = __builtin_amdgcn_readfirstlane(WSP(int, WS_TOPP)[row * 4 + k]); dest[k] = __builtin_amdgcn_readfirstlane(tst[e]) * 256 + pos; }
        const float* mv = mod + (size_t)(row / SEQ) * 12288;
        const float* xr = R1 + (size_t)row * DM;
        f32x4 v[8]; float s = 0.f;
#pragma unroll
        for (int j = 0; j < 8; ++j) { v[j] = *(const f32x4*)(xr + lane * 4 + 256 * j); s += (v[j].x + v[j].y) + (v[j].z + v[j].w); }
        float mean = wave_sum(s) * (1.f / DM); float s2 = 0.f;
#pragma unroll
        for (int j = 0; j < 8; ++j) { v[j] = v[j] - mean; s2 += (v[j].x * v[j].x + v[j].y * v[j].y) + (v[j].z * v[j].z + v[j].w * v[j].w); }
        float rstd = 1.f / sqrtf(wave_sum(s2) * (1.f / DM) + LN_EPS);
        s = 0.f;
#pragma unroll
        for (int j = 0; j < 8; ++j) { const int c = lane * 4 + 256 * j;
            const f32x4 g = *(const f32x4*)(in[I_LN1G] + c), bb = *(const f32x4*)(in[I_LN1B] + c), g2 = *(const f32x4*)(mv + 10240 + c);
            f32x4 y = (f32x4){0.f, 0.f, 0.f, 0.f};
#pragma unroll
            for (int k = 0; k < 4; ++k) { const u32x2 yy = *(const u32x2*)(YR + (size_t)dest[k] * DM + c); y += (f32x4){bflo(yy.x), bfhi(yy.x), bflo(yy.y), bfhi(yy.y)} * wk[k]; }
            v[j] = (v[j] * rstd * g + bb) * DN_ALPHA + g2 * y;
            s += (v[j].x + v[j].y) + (v[j].z + v[j].w); }
        mean = wave_sum(s) * (1.f / DM); s2 = 0.f;
#pragma unroll
        for (int j = 0; j < 8; ++j) { v[j] = v[j] - mean; s2 += (v[j].x * v[j].x + v[j].y * v[j].y) + (v[j].z * v[j].z + v[j].w * v[j].w); }
        rstd = 1.f / sqrtf(wave_sum(s2) * (1.f / DM) + LN_EPS);
        float* orow = F.out + (size_t)row * DM;
#pragma unroll
        for (int j = 0; j < 8; ++j) { const int c = lane * 4 + 256 * j;
            const f32x4 g = *(const f32x4*)(in[I_LN2G] + c), bb = *(const f32x4*)(in[I_LN2B] + c);
            *(f32x4*)(orow + c) = v[j] * rstd * g + bb; }
    }
}

constexpr int NPHASE = 13;
__global__ void __launch_bounds__(NTHR, 2) mk_fwd(Args args) {
    extern __shared__ __attribute__((aligned(16))) unsigned char lds_raw[];
    Frame F;
    F.lds = (LAS unsigned char*)lds_raw;
    F.MISC = (volatile LAS unsigned*)(F.lds + MISC_OFF);
    F.tid = threadIdx.x; F.lane = F.tid & 63; F.wave = __builtin_amdgcn_readfirstlane(F.tid >> 6);
    F.G = gridDim.x; F.bid = blockIdx.x;
    F.in = (KargP)__builtin_amdgcn_kernarg_segment_ptr(); F.out = args.out; F.ws = args.ws; F.ctl = (unsigned*)(args.ws + WS_CTL);
    for (int u = F.tid; u < (LDS_BYTES - MISC_OFF) / 4; u += NTHR) ((LAS unsigned*)(F.lds + MISC_OFF))[u] = 0u;
    __syncthreads();
    XcdBarrier bar; bar.bar = F.ctl + CW_BAR; bar.x = 0; bar.st = nullptr;
    if (MK_LAUNCHES == 1) bar = xcd_barrier_post(F.ctl + CW_BAR, F.MISC + 8);
    const int lo = args.ph_lo, hi = args.ph_hi;
#ifndef PH_MASK
#define PH_MASK 0xFFFF
#endif
#define IN(k) (((PH_MASK >> (k)) & 1) && lo <= (k) && (k) < hi)
#define SEAM(k) do { if (IN(k) && IN((k) + 1)) xcd_barrier(bar); } while (0)
#ifndef DUP_MASK
#define DUP_MASK 0
#endif
#define REP(k) for (int rep_ = 0; rep_ < (((DUP_MASK >> (k)) & 1) ? 2 : 1); ++rep_)
    if (IN(0)) REP(0) p0_phase(F);
    SEAM(0);
    if (IN(1)) p0b_phase(F);
    SEAM(1);
    if (IN(2)) p1_phase(F);
    SEAM(2);
    if (IN(3)) REP(3) {
        SchedZ S{F.G, F.bid, (const char*)WSP(bf16_t, WS_HX), (const char*)WSP(bf16_t, WS_WIN)};
        EpiZ E{WSP(bf16_t, WS_Z), WSP(bf16_t, WS_ZT), WSP(float, WS_BINP)};
        pg8::gemm_phase<EpiZ, SchedZ>(F.lds, DM / 64, DM * 2, DM * 2, S, E);
    }
    SEAM(3);
    if (IN(4)) p3_phase(F);
    SEAM(4);
    if (IN(5)) {
        SchedQK S{F.G, F.bid, (const char*)WSP(bf16_t, WS_U), (const char*)WSP(bf16_t, WS_WQK)};
        EpiQK E{WSP(bf16_t, WS_QKB)};
        pg8::gemm_phase<EpiQK, SchedQK>(F.lds, 256 / 64, MW * 2, 256 * 2, S, E);
    }
    SEAM(5);
    if (IN(6)) REP(6) {
#ifndef DUP_ML
#define DUP_ML 1
#endif
#ifndef DUP_HY
#define DUP_HY 1
#endif
        for (int un = F.bid; un < 256 * DUP_ML; un += F.G) mlstm_unit(F, un & 255);
        for (int un = F.bid; un < 512 * DUP_HY; un += F.G) hyena_unit(F, un & 511);
    }
    SEAM(6);
    if (IN(7)) REP(7) {
        { SchedP S{F.G, F.bid, (const char*)WSP(bf16_t, WS_AM), (const char*)WSP(bf16_t, WS_WPA2), (size_t)256 * 2048 * 2, (size_t)256 * 2048 * 2};
          EpiMA E{WSP(float, WS_T), WSP(bf16_t, WS_Z)};
          pg8::gemm_phase<EpiMA, SchedP>(F.lds, 2048 / 64, 2048 * 2, 2048 * 2, S, E); }
        VM_WAIT(); __syncthreads();
        { SchedP S{F.G, F.bid, (const char*)WSP(bf16_t, WS_HH), (const char*)WSP(bf16_t, WS_WPH), (size_t)256 * 1024 * 2, (size_t)256 * 1024 * 2};
          EpiMB E{WSP(float, WS_T), WSP(bf16_t, WS_Z), WSP(bf16_t, WS_MX)};
          pg8::gemm_phase<EpiMB, SchedP>(F.lds, 1024 / 64, 1024 * 2, 1024 * 2, S, E); }
    }
    SEAM(7);
    if (IN(8)) {
        SchedP S{F.G, F.bid, (const char*)WSP(bf16_t, WS_MX), (const char*)WSP(bf16_t, WS_WOUT), (size_t)256 * 2048 * 2, (size_t)256 * 2048 * 2};
        const KargP in = karg_opaque(F.in); EpiWO E{WSP(float, WS_R1), in[I_X], WSP(float, WS_STATS), in[I_LNG], in[I_LNB], WSP(float, WS_MOD)};
        pg8::gemm_phase<EpiWO, SchedP>(F.lds, 2048 / 64, 2048 * 2, 2048 * 2, S, E);
    }
    SEAM(8);
    if (IN(9)) p8_phase(F);
    SEAM(9);
    if (IN(10)) REP(10) {
        moe_table(F);
        SchedMoE<true> S{F.G, F.bid, 16, (const LAS int*)(F.lds + MOE_TBL), (const LAS int*)(F.lds + MOE_TBL + 256), WSP(int, WS_RTOK), (const char*)WSP(bf16_t, WS_TOK), (const char*)WSP(bf16_t, WS_WGU)};
        const KargP in = karg_opaque(F.in); EpiGU E{WSP(unsigned char, WS_ACT), in[I_BG], in[I_BU]};
        pg8::gemm_phase<EpiGU, SchedMoE<true>, true>(F.lds, DM / 128, DM, DM, S, E, 0x7A7A7A7A, 0x7F7F7F7F);
    }
    SEAM(10);
    if (IN(11)) REP(11) {
        moe_table(F);
        SchedMoE<false> S{F.G, F.bid, 8, (const LAS int*)(F.lds + MOE_TBL), (const LAS int*)(F.lds + MOE_TBL + 256), WSP(int, WS_RTOK), (const char*)WSP(bf16_t, WS_ACT), (const char*)WSP(bf16_t, WS_WD)};
        const KargP in = karg_opaque(F.in); EpiDN E{WSP(bf16_t, WS_YR), in[I_BDN]};
        pg8::gemm_phase<EpiDN, SchedMoE<false>, true>(F.lds, DM / 128, DM, DM, S, E, 0x79797979, 0x7D7D7D7D);
    }
    SEAM(11);
    if (IN(12)) { moe_table(F); p11_phase(F); }
#undef IN
#undef SEAM
}

extern "C" void kernel_launch(void* const* d_in, const int* in_sizes, int n_in, void* d_out, int out_size, void* d_ws, size_t ws_size, hipStream_t stream) {
    static int grid = 0;
    if (grid == 0) {
        if (n_in != 38 || out_size != MTOK * DM || ws_size < WS_END) { fprintf(stderr, "kernel_launch: unexpected shapes: n_in %d out %d ws %zu (need %zu)\n", n_in, out_size, ws_size, (size_t)WS_END); grid = -1; return; }
        int dev = 0, cus = 0, per_cu = 0;
        if (hipGetDevice(&dev) != hipSuccess || hipDeviceGetAttribute(&cus, hipDeviceAttributeMultiprocessorCount, dev) != hipSuccess) { grid = -1; return; }
        if (hipFuncSetAttribute((const void*)mk_fwd, hipFuncAttributeMaxDynamicSharedMemorySize, LDS_BYTES) != hipSuccess) { fprintf(stderr, "kernel_launch: hipFuncSetAttribute failed\n"); grid = -1; return; }
        if (hipOccupancyMaxActiveBlocksPerMultiprocessor(&per_cu, (const void*)mk_fwd, NTHR, LDS_BYTES) != hipSuccess || per_cu < 1) fprintf(stderr, "kernel_launch: occupancy query says %d\n", per_cu);
        (void)hipGetLastError();
        grid = cus;
    }
    if (grid < 0) return;
    (void)hipMemsetAsync((char*)d_ws + WS_CTL, 0, CTL_ZERO_BYTES, stream);
    Args a{};
    for (int i = 0; i < 38; ++i) a.in[i] = (const float*)d_in[i];
    a.out = (float*)d_out; a.ws = (unsigned char*)d_ws;
#if MK_LAUNCHES == 1
    a.ph_lo = 0; a.ph_hi = NPHASE;
    hipLaunchKernelGGL(mk_fwd, dim3(grid), dim3(NTHR), LDS_BYTES, stream, a);
#else
    for (int p = 0; p < NPHASE; ++p) { a.ph_lo = p; a.ph_hi = p + 1; hipLaunchKernelGGL(mk_fwd, dim3(grid), dim3(NTHR), LDS_BYTES, stream, a); }
#endif
}
```

```cpp
#include <hip/hip_runtime.h>
#include <cstdio>
#include <cstdint>

#define GAS __attribute__((address_space(1)))
#define LAS __attribute__((address_space(3)))
typedef unsigned short bf16_t;
typedef short bf16x8 __attribute__((ext_vector_type(8)));
typedef float f32x4 __attribute__((ext_vector_type(4)));
typedef float f32x2 __attribute__((ext_vector_type(2)));
typedef unsigned u32x4 __attribute__((ext_vector_type(4)));
typedef unsigned u32x2 __attribute__((ext_vector_type(2)));

#ifndef MK_LAUNCHES
#define MK_LAUNCHES 1
#endif

constexpr int DM = 2048, NB = 8, SEQ = 2048, CTX = 256, GW = 64;
constexpr int MTOK = NB * SEQ;
constexpr int MCTX = NB * CTX;
constexpr int MALL = MTOK + MCTX;
constexpr int NH = 4, HD = 256, MW = 1024, HW = 1024;
constexpr int N_IN = 10256;
constexpr int NEXP = 32, TOPK = 4;
constexpr float LN_EPS = 1e-5f;
constexpr float DN_ALPHA = 1.189207115002721f;
constexpr int ZN = 7424, ZC_QK = 0, ZC_V = 1024, ZC_O = 2048, ZC_GA = 3072, ZC_GH = 5120, ZC_GT = 7168;
constexpr int WIN_ROWS = 10496, WIN_HY0 = 7424;
constexpr int MAXTILES = 288;
constexpr int POSCAP = 16384;

constexpr size_t MiB = 1u << 20;
constexpr size_t WS_CTL = 0;
constexpr size_t WS_MODP = 1 * MiB;
constexpr size_t WS_MOD = 9 * MiB;
constexpr size_t WS_BINP = 10 * MiB;
constexpr size_t WS_A3 = 10 * MiB + 64 * 1024;
constexpr size_t WS_STATS = 11 * MiB;
constexpr size_t WS_TOPE = 11 * MiB + 256 * 1024;
constexpr size_t WS_TOPP = 11 * MiB + 512 * 1024;
constexpr size_t WS_TOPW = 11 * MiB + 768 * 1024;
constexpr size_t WS_RTOK = 12 * MiB;
constexpr size_t WS_RW = 14 * MiB;
constexpr size_t WS_WQK = 16 * MiB;
constexpr size_t WS_WPH = 17 * MiB;
constexpr size_t WS_WPA2 = 21 * MiB;
constexpr size_t WS_WOUT = 29 * MiB;
constexpr size_t WS_WIN = 37 * MiB;
constexpr size_t WS_WGU = 78 * MiB;
constexpr size_t WS_WD = 590 * MiB;
constexpr size_t WS_RA = 846 * MiB;
constexpr size_t WS_Z = WS_RA, WS_ZT = WS_RA + 261 * MiB, WS_ACT = WS_RA;
constexpr size_t WS_RB = 1203 * MiB;
constexpr size_t WS_HX = WS_RB, WS_U = WS_RB + 72 * MiB, WS_QKB = WS_RB + 108 * MiB, WS_AM = WS_RB + 180 * MiB, WS_HH = WS_RB + 244 * MiB, WS_MX = WS_RB + 276 * MiB, WS_YR = WS_RB;
constexpr size_t WS_RC = 1543 * MiB;
constexpr size_t WS_HTAPS = WS_RC, WS_H = WS_RC + 32 * MiB, WS_T = WS_RC;
constexpr size_t WS_R1 = 1671 * MiB;
constexpr size_t WS_TOK = 1799 * MiB;
constexpr size_t WS_END = 1863 * MiB;
constexpr int CW_TMO = 0, CW_BAR = 4096, CW_CNT = 16384;
constexpr size_t CTL_ZERO_BYTES = 1 * MiB;

constexpr int LDS_BYTES = 160 * 1024 - 2048;
constexpr int MISC_OFF = LDS_BYTES - 1024;
constexpr int NWAVES = 8, NTHR = 512;

#define LDS_WAIT() asm volatile("s_waitcnt lgkmcnt(0)" ::: "memory")
#define VM_WAIT() asm volatile("s_waitcnt vmcnt(0)" ::: "memory")
__device__ __forceinline__ unsigned f2bf(float f) { unsigned u = __builtin_bit_cast(unsigned, f); return (u + 0x7fffu + ((u >> 16) & 1u)) >> 16; }
__device__ __forceinline__ unsigned pk2(float lo, float hi) { return f2bf(lo) | (f2bf(hi) << 16); }
__device__ __forceinline__ unsigned pk4_fp8(float a, float b, float c, float d) { int w = 0; w = __builtin_amdgcn_cvt_pk_fp8_f32(a, b, w, false); w = __builtin_amdgcn_cvt_pk_fp8_f32(c, d, w, true); return (unsigned)w; }
__device__ __forceinline__ float bf2f(unsigned b) { return __builtin_bit_cast(float, b << 16); }
__device__ __forceinline__ float bflo(unsigned w) { return __builtin_bit_cast(float, w << 16); }
__device__ __forceinline__ float bfhi(unsigned w) { return __builtin_bit_cast(float, w & 0xffff0000u); }
__device__ __forceinline__ float sigmoidf_(float x) { return 1.0f / (1.0f + __expf(-x)); }
__device__ __forceinline__ float wave_sum(float v) {
#pragma unroll
    for (int o = 1; o < 64; o <<= 1) v += __shfl_xor(v, o);
    return v;
}

#define XB_TMO      128
#define XB_XCNT(j)  (256  + 64 * (j))
#define XB_XSUB(j)  (1280 + 64 * (j))
#define XB_XGEN(j)  (2304 + 64 * (j))
#define XB_TOP      3328
#define XB_TOPGEN   3392
#define XCD_BAR_WORDS 3456
#define XB_SPIN_CAP (1u << 22)
__device__ __forceinline__ unsigned xb_ld(unsigned* p)              { return __hip_atomic_load(p, __ATOMIC_RELAXED, __HIP_MEMORY_SCOPE_AGENT); }
__device__ __forceinline__ unsigned xb_add(unsigned* p, unsigned v) { return __hip_atomic_fetch_add(p, v, __ATOMIC_RELAXED, __HIP_MEMORY_SCOPE_AGENT); }
__device__ __forceinline__ unsigned xb_xcc_id() { return (unsigned)__builtin_amdgcn_s_getreg((3 << 11) | 20) & 0xFu; }
#define XB_SPIN(cond, bar) do { unsigned _sp = 0; while (cond) { __builtin_amdgcn_s_sleep(1); \
    if ((++_sp & 255u) == 0u) { if (xb_ld(&(bar)[XB_TMO])) break; if (_sp > XB_SPIN_CAP) { atomicAdd(&(bar)[XB_TMO], 1u); break; } } } } while (0)
struct XcdBarrier { unsigned* bar; unsigned x; volatile LAS unsigned* st; };
__device__ __forceinline__ XcdBarrier xcd_barrier_post(unsigned* bar, volatile LAS unsigned* st) {
    XcdBarrier b; b.bar = bar; b.x = xb_xcc_id(); b.st = st;
    if (threadIdx.x == 0) (void)xb_add(&bar[XB_XCNT(b.x)], 1u);
    return b;
}
__device__ __forceinline__ void xcd_barrier_complete(unsigned* bar, unsigned x, unsigned& nloc, unsigned& nx) {
    const unsigned G = gridDim.x * gridDim.y * gridDim.z;
    unsigned sum, cnt, mine, sp = 0u;
    for (;;) {
        sum = 0u; cnt = 0u; mine = 0u;
#pragma unroll
        for (unsigned j = 0; j < 16; ++j) { const unsigned c = xb_ld(&bar[XB_XCNT(j)]); sum += c; cnt += (c > 0u) ? 1u : 0u; mine = (j == x) ? c : mine; }
        if (sum == G) break;
        __builtin_amdgcn_s_sleep(1);
        if ((++sp & 255u) == 0u) { if (xb_ld(&bar[XB_TMO])) break; if (sp > XB_SPIN_CAP) { atomicAdd(&bar[XB_TMO], 1u); break; } }
    }
    nloc = mine > 0u ? mine : 1u; nx = cnt > 0u ? cnt : 1u;
}
__device__ __forceinline__ void xcd_barrier(const XcdBarrier& b) {
    asm volatile("s_waitcnt vmcnt(0)" ::: "memory");
    __syncthreads();
    if (threadIdx.x == 0) {
        unsigned* bar = b.bar;
        __builtin_amdgcn_s_waitcnt(0);
        unsigned nloc = b.st[0], nx = b.st[1];
        if (nloc == 0u) { xcd_barrier_complete(bar, b.x, nloc, nx); b.st[0] = nloc; b.st[1] = nx; }
        const unsigned old = xb_add(&bar[XB_XSUB(b.x)], 1u);
        const unsigned gen = old / nloc;
        if (old + 1u == (gen + 1u) * nloc) {
            __builtin_amdgcn_fence(__ATOMIC_RELEASE, "agent");
            asm volatile("s_waitcnt vmcnt(0)" ::: "memory");
            const unsigned og = xb_add(&bar[XB_TOP], 1u);
            const unsigned tg = og / nx;
            if (og + 1u == (tg + 1u) * nx) xb_add(&bar[XB_TOPGEN], 1u);
            else XB_SPIN(xb_ld(&bar[XB_TOPGEN]) == tg, bar);
            __builtin_amdgcn_fence(__ATOMIC_ACQUIRE, "agent");
            xb_add(&bar[XB_XGEN(b.x)], 1u);
            asm volatile("s_waitcnt vmcnt(0)" ::: "memory");
        } else {
            XB_SPIN(xb_ld(&bar[XB_XGEN(b.x)]) == gen, bar);
            __builtin_amdgcn_fence(__ATOMIC_ACQUIRE, "agent");
            asm volatile("s_waitcnt vmcnt(0)" ::: "memory");
        }
    }
    __syncthreads();
}

struct Args {
    const float* in[38];
    float* out; unsigned char* ws;
    int ph_lo, ph_hi;
};
enum { I_X = 0, I_C, I_CTX, I_CCTX, I_LNG, I_LNB, I_WMOD, I_BMOD, I_WIN, I_BIN, I_MCW, I_MCB, I_WQH, I_WKH, I_HCW, I_HCB, I_FW1, I_FB1, I_FWH, I_FBH,
       I_FFREQ, I_FWOUT, I_HSKIP, I_WPA, I_WPH, I_WOUT, I_LN1G, I_LN1B, I_WR, I_BR, I_WG, I_BG, I_WU, I_BU, I_WDN, I_BDN, I_LN2G, I_LN2B };

namespace pg8 {
constexpr int BM = 256, BK = 64, HALF = 128, HTB = HALF * BK * 2, STAGE_BYTES = 8 * HTB, NXCD = 8, WGM = 8;
__host__ __device__ __forceinline__ int lds_byte(int r, int c) { const int st = (r >> 4) * 2 + (c >> 5), rr = r & 15, cc = c & 31, ob = rr * 64 + cc * 2; return st * 1024 + (ob ^ (((ob >> 9) & 1) << 5)); }
__host__ __device__ __forceinline__ void stage_rc(int b, int& R, int& C) { const int st = b / 1024, sb = b % 1024, swz = sb ^ (((sb >> 9) & 1) << 5); R = (st >> 1) * 16 + swz / 64; C = (st & 1) * 32 + (swz % 64) / 2; }
__host__ __device__ __forceinline__ int perm32(int rho) { const int n = rho >> 4, i = rho & 15; return 8 * (i >> 2) + 4 * n + (i & 3); }
struct Unit { int pm, pn, ex; };
__device__ __forceinline__ void decode_tile(int L, int nM, int nN, int& pm, int& pn) {
    const int nwg = nM * nN; int wgid = L;
    { const int q = nwg / NXCD, r = nwg % NXCD, xcd = wgid % NXCD, off = wgid / NXCD; wgid = (xcd < r ? xcd * (q + 1) : r * (q + 1) + (xcd - r) * q) + off; }
    const int nig = WGM * nN, gid = wgid / nig, fm = gid * WGM, gsz = (nM - fm) < WGM ? (nM - fm) : WGM;
    pm = fm + ((wgid % nig) % gsz); pn = (wgid % nig) / gsz;
}
__device__ __forceinline__ unsigned cvt_pk_bf16(float lo, float hi) { unsigned r; asm volatile("v_cvt_pk_bf16_f32 %0, %1, %2" : "=v"(r) : "v"(lo), "v"(hi)); return r; }

typedef int i32x8 __attribute__((ext_vector_type(8)));
template <class Epi, class Sched, bool F8 = false>
__device__ __forceinline__ void gemm_phase(LAS unsigned char* lds, const int nt, const int pitchA, const int pitchB, const Sched& S, const Epi& E, const int wscale = 0x7F7F7F7F, const int ascale = 0x7F7F7F7F) {
    const int tid = threadIdx.x, wid = __builtin_amdgcn_readfirstlane(tid >> 6), lane = tid & 63, wr = wid >> 2, wc = wid & 3, fr = lane & 15, fq = lane >> 4;
    int RA[2], CA[2]; unsigned voffB[2];
#pragma unroll
    for (int i = 0; i < 2; ++i) { int R, C; stage_rc(tid * 16 + i * 8192, R, C); const int Rb = Epi::PERM ? ((R & ~31) + perm32(R & 31)) : R;
        RA[i] = R; CA[i] = C; voffB[i] = (unsigned)(Rb * pitchB + C * 2); }
    const size_t kstep = (size_t)(BK * 2);
    const size_t hstepB = (size_t)HALF * pitchB;
    const unsigned ldsw = (unsigned)wid * 1024u;
    const int aoff = lds_byte(wr * 64 + fr, fq * 8), boff = lds_byte(wc * 32 + fr, fq * 8);
#define PG8_SA(b, h) (((b) * 2 + (h)) * HTB)
#define PG8_SB(b, h) ((4 + (b) * 2 + (h)) * HTB)
#define PG8_STAGE(bufoff, gbase, v0, v1) do { \
        __builtin_amdgcn_global_load_lds((const unsigned*)((const char*)(gbase) + (v0)), (LAS unsigned*)(lds + (bufoff) + ldsw), 16, 0, 0); \
        __builtin_amdgcn_global_load_lds((const unsigned*)((const char*)(gbase) + (v1)), (LAS unsigned*)(lds + (bufoff) + ldsw + 8192), 16, 0, 0); } while (0)
#define PG8_LD8(off) __builtin_bit_cast(i32x8, __builtin_shufflevector(*(const LAS u32x4*)(lds + (off)), *(const LAS u32x4*)(lds + (off) + 1024), 0, 1, 2, 3, 4, 5, 6, 7))
#define PG8_LDA(dst, b, h) do { _Pragma("unroll") for (int m = 0; m < 4; ++m) { if (F8) dst##8[m] = PG8_LD8(PG8_SA(b, h) + aoff + m * 2048); else { _Pragma("unroll") for (int k = 0; k < 2; ++k) dst[m][k] = *(const LAS bf16x8*)(lds + PG8_SA(b, h) + aoff + m * 2048 + k * 1024); } } } while (0)
#define PG8_LDB(dst, b, h) do { _Pragma("unroll") for (int n = 0; n < 2; ++n) { if (F8) dst##8[n] = PG8_LD8(PG8_SB(b, h) + boff + n * 2048); else { _Pragma("unroll") for (int k = 0; k < 2; ++k) dst[n][k] = *(const LAS bf16x8*)(lds + PG8_SB(b, h) + boff + n * 2048 + k * 1024); } } } while (0)
#define PG8_CAT(x) __builtin_shufflevector(__builtin_bit_cast(u32x4, x[0]), __builtin_bit_cast(u32x4, x[1]), 0, 1, 2, 3, 4, 5, 6, 7)
#define PG8_MMA(ai, bj, At, Bt) do { __builtin_amdgcn_s_setprio(1); _Pragma("unroll") for (int m = 0; m < 4; ++m) _Pragma("unroll") for (int n = 0; n < 2; ++n) { \
        if (F8) { asm volatile("v_mfma_scale_f32_16x16x128_f8f6f4 %0, %1, %2, %0, %3, %4 op_sel_hi:[0,0,0]" : "+v"(acc[ai][bj][m][n]) : "v"(Bt##8[n]), "v"(At##8[m]), "v"(wscale), "v"(ascale)); } \
        else { _Pragma("unroll") for (int k = 0; k < 2; ++k) acc[ai][bj][m][n] = __builtin_amdgcn_mfma_f32_16x16x32_bf16(Bt[n][k], At[m][k], acc[ai][bj][m][n], 0, 0, 0); } } __builtin_amdgcn_s_setprio(0); } while (0)
#define PG8_WAIT_V(n) asm volatile("s_waitcnt vmcnt(" #n ")" ::: "memory")
#define PG8_WAIT_L(n) asm volatile("s_waitcnt lgkmcnt(" #n ")" ::: "memory")
#define PG8_BAR __builtin_amdgcn_s_barrier()
#define PG8_SCHED __builtin_amdgcn_sched_barrier(0)
#define PG8_AOFF(u, o00, o01, o10, o11) do { \
        if (Sched::GATHER) { o00 = (unsigned)(S.a_row(u, RA[0]) * pitchA + CA[0] * 2); o01 = (unsigned)(S.a_row(u, RA[1]) * pitchA + CA[1] * 2); \
                             o10 = (unsigned)(S.a_row(u, RA[0] + HALF) * pitchA + CA[0] * 2); o11 = (unsigned)(S.a_row(u, RA[1] + HALF) * pitchA + CA[1] * 2); } \
        else { o00 = (unsigned)(RA[0] * pitchA + CA[0] * 2); o01 = (unsigned)(RA[1] * pitchA + CA[1] * 2); o10 = (unsigned)((RA[0] + HALF) * pitchA + CA[0] * 2); o11 = (unsigned)((RA[1] + HALF) * pitchA + CA[1] * 2); } } while (0)
    Unit cur, nxt; int ui = 0;
    if (!S.next(0, cur)) return;
    f32x4 acc[2][2][4][2];
#pragma unroll
    for (int a = 0; a < 2; ++a)
#pragma unroll
        for (int b = 0; b < 2; ++b)
#pragma unroll
            for (int m = 0; m < 4; ++m)
#pragma unroll
                for (int n = 0; n < 2; ++n) acc[a][b][m][n] = (f32x4){0.f, 0.f, 0.f, 0.f};
    bf16x8 At[4][2], B0[2][2], B1[2][2]; i32x8 At8[4], B08[2], B18[2];
    const char* cA = S.a_base(cur); const char* cB = S.b_base(cur);
    unsigned c00, c01, c10, c11; PG8_AOFF(cur, c00, c01, c10, c11);
    const unsigned vb0 = voffB[0], vb1 = voffB[1];
    PG8_STAGE(PG8_SB(0, 0), cB, vb0, vb1); PG8_STAGE(PG8_SA(0, 0), cA, c00, c01); PG8_STAGE(PG8_SB(0, 1), cB + hstepB, vb0, vb1); PG8_STAGE(PG8_SA(0, 1), cA, c10, c11);
    if (wr == 1) PG8_BAR;
    PG8_WAIT_V(4); PG8_BAR;
    PG8_STAGE(PG8_SB(1, 0), cB + kstep, vb0, vb1); PG8_STAGE(PG8_SA(1, 0), cA + kstep, c00, c01); PG8_STAGE(PG8_SB(1, 1), cB + hstepB + kstep, vb0, vb1);
    PG8_WAIT_V(6); PG8_BAR;
    for (;;) {
        const bool has_next = S.next(ui + 1, nxt);
        const char* nA = has_next ? S.a_base(nxt) : cA; const char* nB = has_next ? S.b_base(nxt) : cB;
        unsigned n00 = c00, n01 = c01, n10 = c10, n11 = c11;
        if (has_next) PG8_AOFF(nxt, n00, n01, n10, n11);
        for (int t = 0; t < nt; t += 2) {
            const bool last = (t == nt - 2);
            const char* a1 = cA + (size_t)(t + 1) * kstep;
            const char* a2 = last ? nA : cA + (size_t)(t + 2) * kstep; const char* b2 = last ? nB : cB + (size_t)(t + 2) * kstep;
            const char* a3 = a2 + kstep; const char* b3 = b2 + kstep;
            const unsigned x00 = last ? n00 : c00, x01 = last ? n01 : c01, x10 = last ? n10 : c10, x11 = last ? n11 : c11;
            PG8_LDB(B0, 0, 0); PG8_SCHED; PG8_LDA(At, 0, 0); PG8_STAGE(PG8_SA(1, 1), a1, c10, c11);
            PG8_WAIT_L(8); PG8_BAR; PG8_WAIT_L(0); PG8_MMA(0, 0, At, B0); PG8_BAR; PG8_SCHED;
            PG8_LDB(B1, 0, 1); PG8_STAGE(PG8_SB(0, 0), b2, vb0, vb1);
            PG8_BAR; PG8_WAIT_L(0); PG8_MMA(0, 1, At, B1); PG8_BAR;
            PG8_LDA(At, 0, 1); PG8_STAGE(PG8_SA(0, 0), a2, x00, x01);
            PG8_BAR; PG8_WAIT_L(0); PG8_MMA(1, 0, At, B0); PG8_BAR; PG8_SCHED;
            PG8_STAGE(PG8_SB(0, 1), b2 + hstepB, vb0, vb1);
            PG8_WAIT_V(6); PG8_BAR; PG8_MMA(1, 1, At, B1); PG8_BAR;
            PG8_LDB(B0, 1, 0); PG8_SCHED; PG8_LDA(At, 1, 0); PG8_STAGE(PG8_SA(0, 1), a2, x10, x11);
            PG8_WAIT_L(8); PG8_BAR; PG8_WAIT_L(0); PG8_MMA(0, 0, At, B0); PG8_BAR; PG8_SCHED;
            PG8_LDB(B1, 1, 1); PG8_STAGE(PG8_SB(1, 0), b3, vb0, vb1);
            PG8_BAR; PG8_WAIT_L(0); PG8_MMA(0, 1, At, B1); PG8_BAR;
            PG8_LDA(At, 1, 1); PG8_STAGE(PG8_SA(1, 0), a3, x00, x01);
            PG8_BAR; PG8_WAIT_L(0); PG8_MMA(1, 0, At, B0); PG8_BAR; PG8_SCHED;
            PG8_STAGE(PG8_SB(1, 1), b3 + hstepB, vb0, vb1);
            PG8_WAIT_V(6); PG8_BAR; PG8_MMA(1, 1, At, B1); PG8_BAR;
        }
        if (F8) asm volatile("s_nop 15\n\ts_nop 15" ::: "memory");
        E(acc, cur, wr, wc, fr, fq);
        if (!has_next) break;
#pragma unroll
        for (int a = 0; a < 2; ++a)
#pragma unroll
            for (int b = 0; b < 2; ++b)
#pragma unroll
                for (int m = 0; m < 4; ++m)
#pragma unroll
                    for (int n = 0; n < 2; ++n) acc[a][b][m][n] = (f32x4){0.f, 0.f, 0.f, 0.f};
        cur = nxt; cA = nA; cB = nB; c00 = n00; c01 = n01; c10 = n10; c11 = n11; ++ui;
    }
    PG8_WAIT_V(0);
    if (wr == 0) PG8_BAR;
    PG8_BAR;
#undef PG8_SA
#undef PG8_SB
#undef PG8_STAGE
#undef PG8_LDA
#undef PG8_LDB
#undef PG8_MMA
#undef PG8_WAIT_V
#undef PG8_WAIT_L
#undef PG8_BAR
#undef PG8_SCHED
#undef PG8_AOFF
#undef PG8_CAT
#undef PG8_LD8
}
}
using pg8::Unit;

typedef const float* cfp_t;
typedef __attribute__((address_space(4))) const cfp_t* KargP;
__device__ __forceinline__ KargP karg_opaque(KargP p) { asm volatile("" : "+s"(p)); return p; }
struct Frame {
    LAS unsigned char* lds;
    volatile LAS unsigned* MISC;
    unsigned* ctl;
    int tid, lane, wave, G, bid;
    KargP in;
    float* out; unsigned char* ws;
};
#define WSP(T, off) ((T*)(F.ws + (off)))

__device__ __forceinline__ void transpose_item(const float* src, size_t ld, int nvalid, float scale, bf16_t* dst, int K, LAS float* scr, int lane) {
#pragma unroll 8
    for (int i = 0; i < 32; ++i) { const int kk = 2 * i + (lane >> 5); const int j = lane & 31; scr[kk * 33 + j] = (j < nvalid) ? src[(size_t)kk * ld + j] * scale : 0.f; }
    LDS_WAIT(); asm volatile("" ::: "memory");
    const int c = lane & 7;
#pragma unroll
    for (int j = 0; j < 4; ++j) { const int n = (lane >> 3) + 8 * j; const LAS float* s = scr + (8 * c) * 33 + n;
        u32x4 o; o.x = pk2(s[0 * 33], s[1 * 33]); o.y = pk2(s[2 * 33], s[3 * 33]); o.z = pk2(s[4 * 33], s[5 * 33]); o.w = pk2(s[6 * 33], s[7 * 33]);
        *(u32x4*)(dst + (size_t)n * K + 8 * c) = o; }
    LDS_WAIT(); asm volatile("" ::: "memory");
}
struct CvItem { const float* src; unsigned char* dst; float scale; int rstep; };
__device__ __forceinline__ CvItem cv_decode(KargP in, unsigned char* ws, int it) {
    CvItem c;
    if (it < NEXP * 256) { const int e = it >> 8, q = it & 255, up = q & 1, g = (q >> 1) & 7, kb = q >> 4;
        c.src = (up ? in[I_WU] : in[I_WG]) + (size_t)e * DM * DM + (size_t)(128 * kb) * DM + 256 * g;
        c.dst = ws + WS_WGU + ((size_t)e * 4096 + 512 * g + up * 128) * DM + 128 * kb; c.scale = 32.f; c.rstep = 256; }
    else { const int r2 = it - NEXP * 256; const int e = r2 >> 7, q = r2 & 127, g = q & 7, kb = q >> 3;
        c.src = in[I_WDN] + (size_t)e * DM * DM + (size_t)(128 * kb) * DM + 256 * g;
        c.dst = ws + WS_WD + ((size_t)e * 2048 + 256 * g) * DM + 128 * kb; c.scale = 64.f; c.rstep = 128; }
    return c;
}
#define CV_LOAD(v, c) do { _Pragma("unroll") for (int i_ = 0; i_ < 16; ++i_) v[i_] = *(const f32x4*)((c).src + (size_t)(16 * w + i_) * DM + 4 * lane); } while (0)
#define CV_PROC(v, c) do { \
        _Pragma("unroll") for (int j_ = 0; j_ < 4; ++j_) { u32x4 o_; const float s_ = (c).scale; \
            o_.x = pk4_fp8(v[0][j_] * s_, v[1][j_] * s_, v[2][j_] * s_, v[3][j_] * s_);     o_.y = pk4_fp8(v[4][j_] * s_, v[5][j_] * s_, v[6][j_] * s_, v[7][j_] * s_); \
            o_.z = pk4_fp8(v[8][j_] * s_, v[9][j_] * s_, v[10][j_] * s_, v[11][j_] * s_);   o_.w = pk4_fp8(v[12][j_] * s_, v[13][j_] * s_, v[14][j_] * s_, v[15][j_] * s_); \
            *(LAS u32x4*)(tile + (4 * lane + j_) * 144 + 16 * w) = o_; } \
        __syncthreads(); \
        _Pragma("unroll") for (int q_ = 0; q_ < 4; ++q_) { const int idx_ = tid + 512 * q_, row_ = idx_ >> 3, piece_ = idx_ & 7; \
            *(u32x4*)((c).dst + (size_t)((row_ >> 7) * (c).rstep + (row_ & 127)) * DM + 16 * piece_) = *(const LAS u32x4*)(tile + row_ * 144 + 16 * piece_); } \
        __syncthreads(); } while (0)
__device__ __forceinline__ void convert_moe_weights(KargP in, unsigned char* ws, LAS unsigned char* tile, int tid, int bid, int G) {
    const int w = tid >> 6, lane = tid & 63;
    constexpr int NIT = NEXP * (256 + 128);
    f32x4 va[16], vb[16];
    int it = bid;
    if (it >= NIT) return;
    CvItem ca = cv_decode(in, ws, it), cb = ca;
    CV_LOAD(va, ca);
    for (;;) {
        const bool hb = it + G < NIT;
        if (hb) { cb = cv_decode(in, ws, it + G); CV_LOAD(vb, cb); }
        CV_PROC(va, ca);
        if (!hb) break;
        it += G;
        const bool ha = it + G < NIT;
        if (ha) { ca = cv_decode(in, ws, it + G); CV_LOAD(va, ca); }
        CV_PROC(vb, cb);
        if (!ha) break;
        it += G;
    }
}
#undef CV_LOAD
#undef CV_PROC
__device__ __forceinline__ void p0_phase(Frame& F) {
    const KargP in = karg_opaque(F.in);
    LAS float* scr = (LAS float*)(F.lds + F.wave * 16384);
    const int gw = F.bid * NWAVES + F.wave, NGW = F.G * NWAVES;
    constexpr int IT_WIN = 32 * (WIN_ROWS / 32);
    constexpr int IT_WQK = 4 * 64;
    constexpr int IT_WPA2 = 32 * 64;
    constexpr int IT_WPH = 16 * 64;
    constexpr int IT_WOUT = 32 * 64;
    constexpr int NITEMS = IT_WIN + IT_WQK + IT_WPA2 + IT_WPH + IT_WOUT;
    for (int it = gw; it < NITEMS; it += NGW) {
        int r = it;
        if (r < IT_WIN) { const int g = r % (WIN_ROWS / 32), kb = r / (WIN_ROWS / 32); const int n0 = 32 * g; int sc, nv = 32;
            if (n0 < 2048) sc = n0; else if (n0 < 3072) sc = 2064 + (n0 - 2048); else if (n0 < 7168) sc = 6160 + (n0 - 3072); else if (n0 < 7200) { sc = 2048; nv = 16; } else if (n0 < WIN_HY0) { sc = 0; nv = 0; } else sc = 3088 + (n0 - WIN_HY0);
            transpose_item(in[I_WIN] + (size_t)(64 * kb) * N_IN + sc, N_IN, nv, 1.f, WSP(bf16_t, WS_WIN) + (size_t)n0 * DM + 64 * kb, DM, scr, F.lane); continue; } r -= IT_WIN;
        if (r < IT_WQK) { const int g = r % 64, kb = r / 64; const int n0 = 32 * g, h = n0 / 512, j = (n0 % 512) / 256, e0 = n0 % 256;
            const float* src = (j ? in[I_WKH] : in[I_WQH]) + (size_t)h * 65536 + (size_t)(64 * kb) * 256 + e0;
            transpose_item(src, 256, 32, j ? 0.0625f : 1.f, WSP(bf16_t, WS_WQK) + (size_t)n0 * 256 + 64 * kb, 256, scr, F.lane); continue; } r -= IT_WQK;
        if (r < IT_WPA2) { const int g = r % 64, kb = r / 64; const int n0 = 32 * g, k0 = 64 * kb;
            transpose_item(in[I_WPA] + (size_t)(k0 % 1024) * DM + n0, DM, 32, 1.f, WSP(bf16_t, WS_WPA2) + (size_t)n0 * 2048 + k0, 2048, scr, F.lane); continue; } r -= IT_WPA2;
        if (r < IT_WPH) { const int g = r % 64, kb = r / 64; const int n0 = 32 * g, k0 = 64 * kb;
            transpose_item(in[I_WPH] + (size_t)k0 * DM + n0, DM, 32, 1.f, WSP(bf16_t, WS_WPH) + (size_t)n0 * 1024 + k0, 1024, scr, F.lane); continue; } r -= IT_WPH;
        if (r < IT_WOUT) { const int g = r % 64, kb = r / 64; const int n0 = 32 * g, k0 = 64 * kb;
            transpose_item(in[I_WOUT] + (size_t)k0 * DM + n0, DM, 32, 1.f, WSP(bf16_t, WS_WOUT) + (size_t)n0 * 2048 + k0, 2048, scr, F.lane); continue; } r -= IT_WOUT;
        (void)r;
    }
    __syncthreads();
    convert_moe_weights(in, F.ws, (LAS unsigned char*)F.lds, F.tid, F.bid, F.G);
    for (int i = F.bid * NTHR + F.tid; i < WIN_ROWS; i += F.G * NTHR) { int sc = -1;
        if (i < 2048) sc = i; else if (i < 3072) sc = 2064 + (i - 2048); else if (i < 7168) sc = 6160 + (i - 3072); else if (i < 7184) sc = 2048 + (i - 7168); else if (i < WIN_HY0) sc = -1; else sc = 3088 + (i - WIN_HY0);
        WSP(float, WS_BINP)[i] = sc >= 0 ? in[I_BIN][sc] : 0.f; }
    for (int it = gw; it < 16 * 48; it += NGW) {
        const int ks = it / 48, cg = it % 48; const int col = cg * 256 + F.lane * 4;
        f32x4 a[9];
#pragma unroll
        for (int v = 0; v < 9; ++v) a[v] = (f32x4){0.f, 0.f, 0.f, 0.f};
#pragma unroll 1
        for (int kb = ks * 128; kb < ks * 128 + 128; kb += 16) {
            f32x4 w[16];
#pragma unroll
            for (int i = 0; i < 16; ++i) w[i] = *(const f32x4*)(in[I_WMOD] + (size_t)(kb + i) * 12288 + col);
#pragma unroll
            for (int i = 0; i < 16; ++i)
#pragma unroll
                for (int v = 0; v < 9; ++v) { const float cv = (v < 8) ? in[I_C][v * DM + kb + i] : in[I_CCTX][kb + i]; const float s = cv * sigmoidf_(cv); a[v] += w[i] * s; }
        }
#pragma unroll
        for (int v = 0; v < 9; ++v) *(f32x4*)(WSP(float, WS_MODP) + ((size_t)ks * 9 + v) * 12288 + col) = a[v];
    }
    for (int j = gw; j < SEQ; j += NGW) {
        const int l = F.lane;
        float zv = 0.f;
        if (l == 0) zv = (float)j / (float)(SEQ - 1);
        else if (l < 33) { const int bi = (l - 1) & 15; const float f = 1e-4f + (float)bi * ((15.0f - 1e-4f) / 15.0f); const float ang = 6.283185307179586f * (float)j * f / (float)SEQ; zv = (l < 17) ? cosf(ang) : -sinf(ang); }
        float pre = in[I_FB1][l];
        for (int i = 0; i < 33; ++i) pre += __shfl(zv, i) * in[I_FW1][i * 64 + l];
        float a = sinf(in[I_FFREQ][l] * pre);
        pre = in[I_FBH][l];
        for (int i = 0; i < 64; ++i) pre += __shfl(a, i) * in[I_FWH][i * 64 + l];
        float a2 = sinf(in[I_FFREQ][64 + l] * pre);
        pre = in[I_FBH][64 + l];
        for (int i = 0; i < 64; ++i) pre += __shfl(a2, i) * in[I_FWH][4096 + i * 64 + l];
        WSP(float, WS_A3)[j * 64 + l] = sinf(in[I_FFREQ][128 + l] * pre);
    }
}

__device__ __forceinline__ void p0b_phase(Frame& F) {
    const KargP in = karg_opaque(F.in);
    for (int i = F.bid * NTHR + F.tid; i < 9 * 12288; i += F.G * NTHR) { const int col = i % 12288; float s = in[I_BMOD][col];
        for (int ks = 0; ks < 16; ++ks) s += WSP(float, WS_MODP)[(size_t)ks * 9 * 12288 + i];
        WSP(float, WS_MOD)[i] = s; }
    LAS float* wl = (LAS float*)F.lds;
    for (int un = F.bid; un < 256; un += F.G) {
        const int ct = un >> 2, pg = un & 3;
        __syncthreads();
        for (int q = 0; q < 8; ++q) { const int idx = F.tid + 512 * q, i = idx >> 6, cc = idx & 63; wl[cc * 68 + i] = in[I_FWOUT][(size_t)i * 4096 + ct * 64 + cc]; }
        __syncthreads();
        const int j = pg * 512 + F.wave * 64 + F.lane;
        f32x4 ar[16];
#pragma unroll
        for (int q = 0; q < 16; ++q) ar[q] = *(const f32x4*)(WSP(float, WS_A3) + j * 64 + 4 * q);
        const float tj = (float)j / (float)(SEQ - 1);
        const float mind = -3.0701134573253944f, maxd = -15.350567286626972f;
        const int cbase = (ct * 64) & 1023;
#pragma unroll 1
        for (int cc = 0; cc < 64; ++cc) {
            f32x4 s = (f32x4){0.f, 0.f, 0.f, 0.f};
#pragma unroll
            for (int q = 0; q < 16; ++q) s += ar[q] * *(const LAS f32x4*)(wl + cc * 68 + 4 * q);
            const float delta = fabsf(mind + (float)(cbase + cc) * ((maxd - mind) / 1023.0f));
            const float v = ((s.x + s.y) + (s.z + s.w)) * __expf(-tj * delta);
            WSP(float, WS_HTAPS)[(size_t)(ct * 64 + cc) * SEQ + j] = v;
        }
    }
}

__device__ __forceinline__ f32x2 cmul(f32x2 a, f32x2 b) { return (f32x2){a.x * b.x - a.y * b.y, a.x * b.y + a.y * b.x}; }
__device__ __forceinline__ f32x2 cmulc(f32x2 a, f32x2 b) { return (f32x2){a.x * b.x + a.y * b.y, a.y * b.x - a.x * b.y}; }
template <bool INV> __device__ __forceinline__ void dft4(f32x2& a, f32x2& b, f32x2& c, f32x2& d) {
    const f32x2 s0 = a + c, s1 = a - c, s2 = b + d, s3 = b - d;
    const f32x2 is3 = (f32x2){-s3.y, s3.x};
    a = s0 + s2; c = s0 - s2;
    if (!INV) { b = s1 - is3; d = s1 + is3; } else { b = s1 + is3; d = s1 - is3; }
}
template <bool INV> __device__ __forceinline__ void dft16(f32x2 (&v)[16]) {
#pragma unroll
    for (int n0 = 0; n0 < 4; ++n0) dft4<INV>(v[n0], v[4 + n0], v[8 + n0], v[12 + n0]);
    const float c1 = 0.9238795325112867f, s1 = 0.3826834323650898f, r2 = 0.7071067811865476f;
    const float cs[10] = {1.f, c1, r2, s1, 0.f, -s1, -r2, -c1, -1.f, -c1};
    const float sn[10] = {0.f, s1, r2, c1, 1.f, c1, r2, s1, 0.f, -s1};
#pragma unroll
    for (int k0 = 1; k0 < 4; ++k0)
#pragma unroll
        for (int n0 = 1; n0 < 4; ++n0) { const int m = n0 * k0; const f32x2 w = (f32x2){cs[m], INV ? sn[m] : -sn[m]}; v[4 * k0 + n0] = cmul(v[4 * k0 + n0], w); }
#pragma unroll
    for (int k0 = 0; k0 < 4; ++k0) dft4<INV>(v[4 * k0], v[4 * k0 + 1], v[4 * k0 + 2], v[4 * k0 + 3]);
#pragma unroll
    for (int a = 0; a < 4; ++a)
#pragma unroll
        for (int b = a + 1; b < 4; ++b) { const f32x2 t = v[4 * a + b]; v[4 * a + b] = v[4 * b + a]; v[4 * b + a] = t; }
}
__device__ __forceinline__ int fphys(int i) { return i + (i >> 4); }
constexpr int FFT_BUF_BYTES = (4096 + 256) * 8;
struct FftTw { f32x2 wA, wB; };
__device__ __forceinline__ FftTw fft_tw(int ht) { FftTw t; float s, c; sincospif(-(float)ht / 2048.0f, &s, &c); t.wA = (f32x2){c, s}; sincospif(-(float)(ht & 15) / 128.0f, &s, &c); t.wB = (f32x2){c, s}; return t; }
__device__ __forceinline__ void fft_fwd(f32x2 (&v)[16], LAS f32x2* buf, int ht, const FftTw& tw_) {
    FftTw tw = tw_; asm volatile("" : "+v"(ht), "+v"(tw.wA.x), "+v"(tw.wA.y), "+v"(tw.wB.x), "+v"(tw.wB.y));
    dft16<false>(v);
    { f32x2 w = tw.wA;
#pragma unroll
      for (int k = 1; k < 16; ++k) { v[k] = cmul(v[k], w); w = cmul(w, tw.wA); } }
#pragma unroll
    for (int k = 0; k < 16; ++k) buf[fphys(256 * k + ht)] = v[k];
    __syncthreads();
    const int ka = ht >> 4, s = ht & 15;
#pragma unroll
    for (int b = 0; b < 16; ++b) v[b] = buf[fphys(256 * ka + 16 * b + s)];
    dft16<false>(v);
    { f32x2 w = tw.wB;
#pragma unroll
      for (int k = 1; k < 16; ++k) { v[k] = cmul(v[k], w); w = cmul(w, tw.wB); } }
#pragma unroll
    for (int k = 0; k < 16; ++k) buf[fphys(256 * ka + 16 * k + s)] = v[k];
    __syncthreads();
#pragma unroll
    for (int q = 0; q < 16; ++q) v[q] = buf[fphys(16 * ht + q)];
    dft16<false>(v);
}
__device__ __forceinline__ void fft_inv(f32x2 (&v)[16], LAS f32x2* buf, int ht, const FftTw& tw_) {
    FftTw tw = tw_; asm volatile("" : "+v"(ht), "+v"(tw.wA.x), "+v"(tw.wA.y), "+v"(tw.wB.x), "+v"(tw.wB.y));
    dft16<true>(v);
#pragma unroll
    for (int q = 0; q < 16; ++q) buf[fphys(16 * ht + q)] = v[q];
    __syncthreads();
    const int ka = ht >> 4, s = ht & 15;
#pragma unroll
    for (int k = 0; k < 16; ++k) v[k] = buf[fphys(256 * ka + 16 * k + s)];
    { f32x2 w = tw.wB;
#pragma unroll
      for (int k = 1; k < 16; ++k) { v[k] = cmulc(v[k], w); w = cmul(w, tw.wB); } }
    dft16<true>(v);
#pragma unroll
    for (int b = 0; b < 16; ++b) buf[fphys(256 * ka + 16 * b + s)] = v[b];
    __syncthreads();
#pragma unroll
    for (int k = 0; k < 16; ++k) v[k] = buf[fphys(256 * k + ht)];
    { f32x2 w = tw.wA;
#pragma unroll
      for (int k = 1; k < 16; ++k) { v[k] = cmulc(v[k], w); w = cmul(w, tw.wA); } }
    dft16<true>(v);
    __syncthreads();
}

__device__ __forceinline__ void p1_phase(Frame& F) {
    const KargP in = karg_opaque(F.in);
    const int gw = F.bid * NWAVES + F.wave, NGW = F.G * NWAVES;
    const float* mod = WSP(float, WS_MOD);
    {
        f32x4 pg[8], pb[8];
#pragma unroll
        for (int j = 0; j < 8; ++j) { pg[j] = *(const f32x4*)(in[I_LNG] + F.lane * 4 + 256 * j); pb[j] = *(const f32x4*)(in[I_LNB] + F.lane * 4 + 256 * j); }
#pragma unroll 1
        for (int grp = gw; grp < MALL / 8; grp += NGW) {
            const int row0 = grp * 8; const bool lat = row0 < MTOK;
            const float* xb = lat ? in[I_X] + (size_t)row0 * DM : in[I_CTX] + (size_t)(row0 - MTOK) * DM;
            const float* mv = mod + (size_t)(lat ? row0 / SEQ : 8) * 12288;
            f32x4 psh[8], psc[8];
#pragma unroll
            for (int j = 0; j < 8; ++j) { psh[j] = *(const f32x4*)(mv + F.lane * 4 + 256 * j); psc[j] = *(const f32x4*)(mv + 2048 + F.lane * 4 + 256 * j) + 1.0f; }
            f32x4 v[8], vn[8];
#pragma unroll
            for (int j = 0; j < 8; ++j) v[j] = *(const f32x4*)(xb + F.lane * 4 + 256 * j);
#pragma unroll 1
            for (int ri = 0; ri < 8; ++ri) {
                const float* xn = xb + (size_t)(ri < 7 ? ri + 1 : ri) * DM;
#pragma unroll
                for (int j = 0; j < 8; ++j) vn[j] = *(const f32x4*)(xn + F.lane * 4 + 256 * j);
                float s = 0.f;
#pragma unroll
                for (int j = 0; j < 8; ++j) s += (v[j].x + v[j].y) + (v[j].z + v[j].w);
                const float mean = wave_sum(s) * (1.f / DM); float s2 = 0.f;
#pragma unroll
                for (int j = 0; j < 8; ++j) { v[j] = v[j] - mean; s2 += (v[j].x * v[j].x + v[j].y * v[j].y) + (v[j].z * v[j].z + v[j].w * v[j].w); }
                const float rstd = 1.f / sqrtf(wave_sum(s2) * (1.f / DM) + LN_EPS);
                const int row = row0 + ri;
                if (lat && F.lane == 0) { WSP(float, WS_STATS)[row * 2] = mean; WSP(float, WS_STATS)[row * 2 + 1] = rstd; }
                bf16_t* orow = WSP(bf16_t, WS_HX) + (size_t)row * DM;
#pragma unroll
                for (int j = 0; j < 8; ++j) { const f32x4 y = (v[j] * rstd * pg[j] + pb[j]) * psc[j] + psh[j];
                    u32x2 o; o.x = pk2(y.x, y.y); o.y = pk2(y.z, y.w); *(u32x2*)(orow + F.lane * 4 + 256 * j) = o; }
#pragma unroll
                for (int j = 0; j < 8; ++j) v[j] = vn[j];
            }
        }
    }
    const int hb = F.tid >> 8, ht = F.tid & 255;
    LAS f32x2* buf = (LAS f32x2*)(F.lds + hb * FFT_BUF_BYTES);
    const FftTw tw = fft_tw(ht);
    const float* htaps = WSP(float, WS_HTAPS);
    for (int u0 = F.bid * 2; u0 < 2048; u0 += F.G * 2) {
        const int un = u0 + hb, c = un >> 1, n = un & 1;
        const float* hf = htaps + (size_t)((n * 2 + 0) * 1024 + c) * SEQ, * hbk = htaps + (size_t)((n * 2 + 1) * 1024 + c) * SEQ;
        f32x2 v[16];
#pragma unroll
        for (int a = 0; a < 16; ++a) { const int i = 256 * a + ht; float x;
            if (a < 8) x = hf[i]; else if (i == 2048) x = 0.f; else x = hbk[4096 - i];
            v[a] = (f32x2){x * (1.0f / 4096.0f), 0.f}; }
        fft_fwd(v, buf, ht, tw);
        f32x2* Hd = WSP(f32x2, WS_H) + (size_t)un * 4096;
#pragma unroll
        for (int ks = 0; ks < 16; ++ks) Hd[ks * 256 + ht] = v[ks];
        __syncthreads();
    }
}

struct SchedZ {
    static constexpr bool GATHER = false;
    int G, c; const char* hx; const char* win;
    __device__ __forceinline__ bool next(int i, Unit& u) const {
        int L = i * G + c;
        if (L < 1856) { pg8::decode_tile(L, 64, 29, u.pm, u.pn); u.ex = 0; return true; } L -= 1856;
        if (L < 768) { pg8::decode_tile(L, 12, 64, u.pm, u.pn); u.ex = 1; return true; } L -= 768;
        if (L < 72) { int pm, pn; pg8::decode_tile(L, 8, 9, pm, pn); u.pm = 64 + pm; u.pn = pn < 8 ? pn : 28; u.ex = 0; return true; }
        return false;
    }
    __device__ __forceinline__ const char* a_base(const Unit& u) const { return u.ex ? win + (size_t)(WIN_HY0 + 256 * u.pm) * DM * 2 : hx + (size_t)(256 * u.pm) * DM * 2; }
    __device__ __forceinline__ const char* b_base(const Unit& u) const { return u.ex ? hx + (size_t)(256 * u.pn) * DM * 2 : win + (size_t)(256 * u.pn) * DM * 2; }
    __device__ __forceinline__ int a_row(const Unit&, int R) const { return R; }
};
struct EpiZ {
    static constexpr bool PERM = true;
    bf16_t* Z; bf16_t* ZT; const float* bias;
    __device__ __forceinline__ void operator()(const f32x4 (&acc)[2][2][4][2], const Unit& u, int wr, int wc, int fr, int fq) const {
        if (u.ex == 0) {
            const int row0 = u.pm * 256 + wr * 64 + fr, col0 = u.pn * 256 + wc * 32 + 8 * fq;
            f32x4 bv[2][2];
#pragma unroll
            for (int bj = 0; bj < 2; ++bj)
#pragma unroll
                for (int n = 0; n < 2; ++n) bv[bj][n] = *(const f32x4*)(bias + col0 + bj * 128 + 4 * n);
#pragma unroll
            for (int ai = 0; ai < 2; ++ai)
#pragma unroll
                for (int m = 0; m < 4; ++m) { bf16_t* rowp = Z + (size_t)(row0 + ai * 128 + m * 16) * ZN + col0;
#pragma unroll
                    for (int bj = 0; bj < 2; ++bj) { const f32x4 v0 = acc[ai][bj][m][0] + bv[bj][0], v1 = acc[ai][bj][m][1] + bv[bj][1];
                        u32x4 w; w.x = pg8::cvt_pk_bf16(v0[0], v0[1]); w.y = pg8::cvt_pk_bf16(v0[2], v0[3]); w.z = pg8::cvt_pk_bf16(v1[0], v1[1]); w.w = pg8::cvt_pk_bf16(v1[2], v1[3]);
                        *(u32x4*)(rowp + bj * 128) = w; } }
        } else {
            const int ch0 = u.pm * 256 + wr * 64 + fr, b = u.pn >> 3, t0 = (u.pn & 7) * 256 + wc * 32 + 8 * fq;
#pragma unroll
            for (int ai = 0; ai < 2; ++ai)
#pragma unroll
                for (int m = 0; m < 4; ++m) { const int ch = ch0 + ai * 128 + m * 16; const float bb = bias[WIN_HY0 + ch];
                    bf16_t* rowp = ZT + ((size_t)b * 3072 + ch) * SEQ + t0;
#pragma unroll
                    for (int bj = 0; bj < 2; ++bj) { const f32x4 v0 = acc[ai][bj][m][0] + bb, v1 = acc[ai][bj][m][1] + bb;
                        u32x4 w; w.x = pg8::cvt_pk_bf16(v0[0], v0[1]); w.y = pg8::cvt_pk_bf16(v0[2], v0[3]); w.z = pg8::cvt_pk_bf16(v1[0], v1[1]); w.w = pg8::cvt_pk_bf16(v1[2], v1[3]);
                        *(u32x4*)(rowp + bj * 128) = w; } }
        }
    }
};

__device__ __forceinline__ void p3_phase(Frame& F) {
    const KargP in = karg_opaque(F.in);
    const bf16_t* Z = WSP(bf16_t, WS_Z); bf16_t* U = WSP(bf16_t, WS_U);
    const float* cw = in[I_MCW]; const float* cb = in[I_MCB];
    for (int it = F.bid * NTHR + F.tid; it < MALL * 128; it += F.G * NTHR) {
        const int row = it >> 7, c0 = (it & 127) * 8;
        float a[8];
        { const f32x4 b0 = *(const f32x4*)(cb + c0), b1 = *(const f32x4*)(cb + c0 + 4); a[0] = b0.x; a[1] = b0.y; a[2] = b0.z; a[3] = b0.w; a[4] = b1.x; a[5] = b1.y; a[6] = b1.z; a[7] = b1.w; }
        const bool lat = row < MTOK;
        int base, y, x, H, Wd;
        if (lat) { const int t = row & (SEQ - 1); base = row - t; y = t >> 6; x = t & 63; H = 32; Wd = 64; }
        else { const int t = (row - MTOK) & (CTX - 1); base = row - t; y = 0; x = t; H = 1; Wd = CTX; }
#pragma unroll
        for (int dy = -1; dy <= 1; ++dy)
#pragma unroll
            for (int dx = -1; dx <= 1; ++dx) {
                const int yy = y + dy, xx = x + dx;
                if (yy < 0 || yy >= H || xx < 0 || xx >= Wd) continue;
                const int srow = base + yy * Wd + xx;
                const u32x4 zz = *(const u32x4*)(Z + (size_t)srow * ZN + ZC_QK + c0);
                const float* wp = cw + ((dy + 1) * 3 + (dx + 1)) * MW + c0;
                const f32x4 w0 = *(const f32x4*)wp, w1 = *(const f32x4*)(wp + 4);
                a[0] += bflo(zz.x) * w0.x; a[1] += bfhi(zz.x) * w0.y; a[2] += bflo(zz.y) * w0.z; a[3] += bfhi(zz.y) * w0.w;
                a[4] += bflo(zz.z) * w1.x; a[5] += bfhi(zz.z) * w1.y; a[6] += bflo(zz.w) * w1.z; a[7] += bfhi(zz.w) * w1.w;
            }
#pragma unroll
        for (int j = 0; j < 8; ++j) a[j] = a[j] * sigmoidf_(a[j]);
        u32x4 o; o.x = pk2(a[0], a[1]); o.y = pk2(a[2], a[3]); o.z = pk2(a[4], a[5]); o.w = pk2(a[6], a[7]);
        *(u32x4*)(U + (size_t)row * MW + c0) = o;
    }
}

struct SchedQK {
    static constexpr bool GATHER = false;
    int G, c; const char* u; const char* w;
    __device__ __forceinline__ bool next(int i, Unit& un) const { const int L = i * G + c; if (L >= 72 * 8) return false; pg8::decode_tile(L, 72, 8, un.pm, un.pn); un.ex = 0; return true; }
    __device__ __forceinline__ const char* a_base(const Unit& un) const { return u + ((size_t)(256 * un.pm) * MW + (un.pn >> 1) * 256) * 2; }
    __device__ __forceinline__ const char* b_base(const Unit& un) const { return w + (size_t)(256 * un.pn) * 256 * 2; }
    __device__ __forceinline__ int a_row(const Unit&, int R) const { return R; }
};
struct EpiQK {
    static constexpr bool PERM = true;
    bf16_t* O;
    __device__ __forceinline__ void operator()(const f32x4 (&acc)[2][2][4][2], const Unit& u, int wr, int wc, int fr, int fq) const {
        const int row0 = u.pm * 256 + wr * 64 + fr, col0 = u.pn * 256 + wc * 32 + 8 * fq;
#pragma unroll
        for (int ai = 0; ai < 2; ++ai)
#pragma unroll
            for (int m = 0; m < 4; ++m) { bf16_t* rowp = O + (size_t)(row0 + ai * 128 + m * 16) * 2048 + col0;
#pragma unroll
                for (int bj = 0; bj < 2; ++bj) { const f32x4 v0 = acc[ai][bj][m][0], v1 = acc[ai][bj][m][1];
                    u32x4 w; w.x = pg8::cvt_pk_bf16(v0[0], v0[1]); w.y = pg8::cvt_pk_bf16(v0[2], v0[3]); w.z = pg8::cvt_pk_bf16(v1[0], v1[1]); w.w = pg8::cvt_pk_bf16(v1[2], v1[3]);
                    *(u32x4*)(rowp + bj * 128) = w; } }
    }
};

constexpr int ML_QS = 264, ML_VS = 72, ML_PS = 72;
constexpr int ML_Q = 0, ML_K = ML_Q + 64 * ML_QS * 2, ML_V = ML_K + 64 * ML_QS * 2, ML_C = ML_V + 64 * ML_VS * 2, ML_P = ML_C + 80 * ML_QS * 2, ML_SC = ML_P + 64 * ML_PS * 2;
constexpr int ML_SA = ML_SC, ML_SU = ML_SC + 256, ML_SSI = ML_SC + 512, ML_SWG = ML_SC + 768, ML_SEM = ML_SC + 1024, ML_SDEN = ML_SC + 1280, ML_SMISC = ML_SC + 1536, ML_END = ML_SC + 1600;
static_assert(ML_END <= MISC_OFF, "mlstm LDS");
__device__ __forceinline__ bf16x8 lds_frag(const LAS bf16_t* p) { return *(const LAS bf16x8*)p; }
__device__ __forceinline__ void mlstm_unit(Frame& F, int un) {
    const int vs = un & 3, dir = (un >> 2) & 1, h = (un >> 3) & 3, b = un >> 5;
    const bf16_t* Z = WSP(bf16_t, WS_Z); const bf16_t* QK = WSP(bf16_t, WS_QKB); bf16_t* AM = WSP(bf16_t, WS_AM);
    LAS unsigned char* lds = F.lds;
    LAS bf16_t* Qs = (LAS bf16_t*)(lds + ML_Q); LAS bf16_t* Ks = (LAS bf16_t*)(lds + ML_K); LAS bf16_t* Vs = (LAS bf16_t*)(lds + ML_V);
    LAS bf16_t* Cs = (LAS bf16_t*)(lds + ML_C); LAS bf16_t* Ps = (LAS bf16_t*)(lds + ML_P);
    LAS float* sA = (LAS float*)(lds + ML_SA); LAS float* sU = (LAS float*)(lds + ML_SU); LAS float* sSI = (LAS float*)(lds + ML_SSI);
    LAS float* sWG = (LAS float*)(lds + ML_SWG); LAS float* sEM = (LAS float*)(lds + ML_SEM); LAS float* sDEN = (LAS float*)(lds + ML_SDEN); LAS float* sMI = (LAS float*)(lds + ML_SMISC);
    const int tid = F.tid, lane = F.lane, w = F.wave, l15 = lane & 15, g4 = lane >> 4;
    __syncthreads();
    for (int i = tid; i < 80 * ML_QS / 2; i += NTHR) ((LAS unsigned*)Cs)[i] = 0u;
    if (tid < 64) { Vs[tid * ML_VS + 64] = (bf16_t)0x3F80; for (int j = 65; j < ML_VS; ++j) Vs[tid * ML_VS + j] = 0; }
    f32x4 cacc[2][5];
#pragma unroll
    for (int a = 0; a < 2; ++a)
#pragma unroll
        for (int c = 0; c < 5; ++c) cacc[a][c] = (f32x4){0.f, 0.f, 0.f, 0.f};
    float m_run = 0.f;
    u32x4 pq[4], pk[4], pv; unsigned pgate = 0u, pgate2 = 0u;
#define ML_ROW0(st) ((st) < 4 ? (MTOK + b * CTX + 64 * (dir ? 3 - (st) : (st))) : (b * SEQ + 64 * (dir ? 35 - (st) : (st) - 4)))
#define ML_LOAD(st) do { const int r0_ = ML_ROW0(st); \
        _Pragma("unroll") for (int q_ = 0; q_ < 4; ++q_) { const int p_ = tid + 512 * q_, rr_ = p_ >> 5, cc_ = (p_ & 31) * 8; \
            pq[q_] = *(const u32x4*)(QK + (size_t)(r0_ + rr_) * 2048 + h * 512 + cc_); pk[q_] = *(const u32x4*)(QK + (size_t)(r0_ + rr_) * 2048 + h * 512 + 256 + cc_); } \
        { const int rr_ = tid >> 3, cc_ = (tid & 7) * 8; pv = *(const u32x4*)(Z + (size_t)(r0_ + rr_) * ZN + ZC_V + h * 256 + vs * 64 + cc_); } \
        if (tid < 64) { const bf16_t* gp_ = Z + (size_t)(r0_ + tid) * ZN + ZC_GT + dir * 8 + h; pgate = gp_[0]; pgate2 = gp_[4]; } } while (0)
#define ML_STORE() do { \
        _Pragma("unroll") for (int q_ = 0; q_ < 4; ++q_) { const int p_ = tid + 512 * q_, rr_ = p_ >> 5, cc_ = (p_ & 31) * 8; \
            *(LAS u32x4*)(Qs + rr_ * ML_QS + cc_) = pq[q_]; *(LAS u32x4*)(Ks + rr_ * ML_QS + cc_) = pk[q_]; } \
        { const int rr_ = tid >> 3, cc_ = (tid & 7) * 8; *(LAS u32x4*)(Vs + rr_ * ML_VS + cc_) = pv; } } while (0)
    ML_LOAD(0);
    __syncthreads();
    const int tt = w & 3; const int nv = (w < 4) ? 3 : 2;
#pragma unroll 1
    for (int st = 0; st < 36; ++st) {
        ML_STORE();
        if (w == 0) {
            const float li = bf2f(pgate), zf = bf2f(pgate2);
            const float lf = fminf(zf, 0.f) - log1pf(__expf(-fabsf(zf)));
            float bcs = lf;
#pragma unroll
            for (int o = 1; o < 64; o <<= 1) { const float t = dir ? __shfl_down(bcs, o) : __shfl_up(bcs, o); const bool ok = dir ? (lane + o < 64) : (lane >= o); bcs += ok ? t : 0.f; }
            const float a = li - bcs;
            float am = a;
#pragma unroll
            for (int o = 1; o < 64; o <<= 1) { const float t = dir ? __shfl_down(am, o) : __shfl_up(am, o); const bool ok = dir ? (lane + o < 64) : (lane >= o); am = ok ? fmaxf(am, t) : am; }
            const float inter = bcs + m_run;
            const float mt = fmaxf(inter, bcs + am);
            const float b_end = __shfl(bcs, dir ? 0 : 63);
            const float gg = b_end - bcs + li;
            float gm = gg;
#pragma unroll
            for (int o = 1; o < 64; o <<= 1) gm = fmaxf(gm, __shfl_xor(gm, o));
            const float m_new = fmaxf(b_end + m_run, gm);
            sA[lane] = a; sU[lane] = bcs - mt; sSI[lane] = __expf(inter - mt); sWG[lane] = __expf(gg - m_new); sEM[lane] = __expf(-mt);
            if (lane == 0) sMI[0] = __expf(b_end + m_run - m_new);
            m_run = m_new;
        }
        const int row0 = ML_ROW0(st);
        if (st + 1 < 36) ML_LOAD(st + 1);
        __syncthreads();
        {
            f32x4 sacc[2] = {(f32x4){0.f, 0.f, 0.f, 0.f}, (f32x4){0.f, 0.f, 0.f, 0.f}};
#pragma unroll
            for (int ks = 0; ks < 8; ++ks) {
                const bf16x8 qf = lds_frag(Qs + (16 * tt + l15) * ML_QS + 32 * ks + 8 * g4);
#pragma unroll
                for (int j = 0; j < 2; ++j) { const int stl = 2 * (w >> 2) + j;
                    const bf16x8 kf = lds_frag(Ks + (16 * stl + l15) * ML_QS + 32 * ks + 8 * g4);
                    sacc[j] = __builtin_amdgcn_mfma_f32_16x16x32_bf16(kf, qf, sacc[j], 0, 0, 0); }
            }
            const int t = 16 * tt + l15; const float ut = sU[t];
#pragma unroll
            for (int j = 0; j < 2; ++j) { const int s0 = 16 * (2 * (w >> 2) + j) + 4 * g4;
                const f32x4 av = *(const LAS f32x4*)(sA + s0);
                float pvv[4];
#pragma unroll
                for (int r = 0; r < 4; ++r) { const int s = s0 + r; const bool ok = dir ? (s >= t) : (s <= t); pvv[r] = ok ? sacc[j][r] * __expf(ut + av[r]) : 0.f; }
                u32x2 o; o.x = pk2(pvv[0], pvv[1]); o.y = pk2(pvv[2], pvv[3]);
                *(LAS u32x2*)(Ps + t * ML_PS + s0) = o; }
        }
        __syncthreads();
        f32x4 nacc[3], iacc[3];
#pragma unroll
        for (int j = 0; j < 3; ++j) { nacc[j] = (f32x4){0.f, 0.f, 0.f, 0.f}; iacc[j] = (f32x4){0.f, 0.f, 0.f, 0.f}; }
#pragma unroll
        for (int ks = 0; ks < 8; ++ks) {
            const bf16x8 qf = lds_frag(Qs + (16 * tt + l15) * ML_QS + 32 * ks + 8 * g4);
#pragma unroll
            for (int j = 0; j < 3; ++j) if (j < nv) { const int vt = (w < 4) ? (j == 2 ? 4 : j) : 2 + j;
                const bf16x8 cf = lds_frag(Cs + (16 * vt + l15) * ML_QS + 32 * ks + 8 * g4);
                iacc[j] = __builtin_amdgcn_mfma_f32_16x16x32_bf16(qf, cf, iacc[j], 0, 0, 0); }
        }
#pragma unroll
        for (int ks = 0; ks < 2; ++ks) {
            const bf16x8 pf = lds_frag(Ps + (16 * tt + l15) * ML_PS + 32 * ks + 8 * g4);
#pragma unroll
            for (int j = 0; j < 3; ++j) if (j < nv) { const int vt = (w < 4) ? (j == 2 ? 4 : j) : 2 + j;
                bf16x8 vf;
#pragma unroll
                for (int e = 0; e < 8; ++e) vf[e] = (short)Vs[(32 * ks + 8 * g4 + e) * ML_VS + 16 * vt + l15];
                nacc[j] = __builtin_amdgcn_mfma_f32_16x16x32_bf16(pf, vf, nacc[j], 0, 0, 0); }
        }
        const int t0 = 16 * tt + 4 * g4;
        {
            const f32x4 si = *(const LAS f32x4*)(sSI + t0);
#pragma unroll
            for (int j = 0; j < 3; ++j) if (j < nv) nacc[j] = nacc[j] + iacc[j] * si;
            if (w < 4 && l15 == 0) *(LAS f32x4*)(sDEN + t0) = nacc[2];
        }
        {
            const float decay = sMI[0];
#pragma unroll
            for (int a = 0; a < 2; ++a)
#pragma unroll
                for (int c = 0; c < 5; ++c) cacc[a][c] = cacc[a][c] * decay;
#pragma unroll
            for (int ks = 0; ks < 2; ++ks) {
                bf16x8 kf[2];
#pragma unroll
                for (int a = 0; a < 2; ++a)
#pragma unroll
                    for (int e = 0; e < 8; ++e) kf[a][e] = (short)Ks[(32 * ks + 8 * g4 + e) * ML_QS + 16 * (2 * w + a) + l15];
                float wg[8];
#pragma unroll
                for (int e = 0; e < 8; ++e) wg[e] = sWG[32 * ks + 8 * g4 + e];
#pragma unroll
                for (int c = 0; c < 5; ++c) {
                    u32x4 vw;
                    { float x[8];
#pragma unroll
                      for (int e = 0; e < 8; ++e) x[e] = bf2f((unsigned)Vs[(32 * ks + 8 * g4 + e) * ML_VS + 16 * c + l15]) * wg[e];
                      vw.x = pk2(x[0], x[1]); vw.y = pk2(x[2], x[3]); vw.z = pk2(x[4], x[5]); vw.w = pk2(x[6], x[7]); }
                    const bf16x8 vf = __builtin_bit_cast(bf16x8, vw);
#pragma unroll
                    for (int a = 0; a < 2; ++a) cacc[a][c] = __builtin_amdgcn_mfma_f32_16x16x32_bf16(kf[a], vf, cacc[a][c], 0, 0, 0);
                }
            }
        }
        __syncthreads();
        if (st >= 4) {
            const f32x4 dn = *(const LAS f32x4*)(sDEN + t0), em = *(const LAS f32x4*)(sEM + t0);
#pragma unroll
            for (int j = 0; j < 2; ++j) { const int vt = (w < 4) ? j : 2 + j; const int col = h * 256 + vs * 64 + 16 * vt + l15;
#pragma unroll
                for (int r = 0; r < 4; ++r) { const int row = row0 + t0 + r;
                    const float hv = nacc[j][r] / fmaxf(fabsf(dn[r]), em[r]);
                    const float o = sigmoidf_(bf2f((unsigned)Z[(size_t)row * ZN + ZC_O + col]));
                    AM[(size_t)row * 2048 + dir * 1024 + col] = (bf16_t)f2bf(o * hv); } }
        }
#pragma unroll
        for (int a = 0; a < 2; ++a)
#pragma unroll
            for (int c = 0; c < 5; ++c) { u32x2 o; o.x = pk2(cacc[a][c][0], cacc[a][c][1]); o.y = pk2(cacc[a][c][2], cacc[a][c][3]);
                *(LAS u32x2*)(Cs + (16 * c + l15) * ML_QS + 16 * (2 * w + a) + 4 * g4) = o; }
        __syncthreads();
    }
#undef ML_LOAD
#undef ML_STORE
#undef ML_ROW0
}

constexpr int HY_RAW = 2 * FFT_BUF_BYTES, HY_OUT = HY_RAW + 16384, HY_END = HY_OUT + 65536;
static_assert(HY_END <= MISC_OFF, "hyena LDS");
__device__ __forceinline__ void hy_conv(const LAS bf16_t* raw, const float* cw, float bias, int c3, int ht, f32x2 (&o)[8]) {
    float w9[9];
#pragma unroll
    for (int q = 0; q < 9; ++q) w9[q] = cw[q * 3072 + c3];
    asm volatile("" : "+v"(ht));
    const int x = ht & 63;
#pragma unroll
    for (int a = 0; a < 8; ++a) { const int t = 256 * a + ht, y = t >> 6; float a0 = bias, a1 = bias;
#pragma unroll
        for (int dy = -1; dy <= 1; ++dy)
#pragma unroll
            for (int dx = -1; dx <= 1; ++dx) { const int yy = y + dy, xx = x + dx;
                if (yy >= 0 && yy < 32 && xx >= 0 && xx < 64) { const int idx = t + 64 * dy + dx; const float wv = w9[(dy + 1) * 3 + dx + 1];
                    a0 += wv * bf2f((unsigned)raw[idx]); a1 += wv * bf2f((unsigned)raw[2048 + idx]); } }
        o[a] = (f32x2){a0, a1}; asm volatile("" ::: "memory"); }
}
__device__ __forceinline__ void hyena_unit(Frame& F, int un) {
    const KargP in = karg_opaque(F.in);
    const int cg = un >> 2, bp = un & 3, c0 = cg * 8, b0 = bp * 2;
    const int hb = F.tid >> 8, ht = F.tid & 255;
    LAS f32x2* buf = (LAS f32x2*)(F.lds + hb * FFT_BUF_BYTES);
    LAS bf16_t* raw = (LAS bf16_t*)(F.lds + HY_RAW + hb * 8192);
    LAS bf16_t* outT = (LAS bf16_t*)(F.lds + HY_OUT);
    const bf16_t* ZT = WSP(bf16_t, WS_ZT); const f32x2* H = WSP(f32x2, WS_H);
    const FftTw tw = fft_tw(ht);
    __syncthreads();
#pragma unroll 1
    for (int i = 0; i < 4; ++i) {
        const int cl = 2 * i + hb, c = c0 + cl;
#define HY_LOADRAW(kind) do { _Pragma("unroll") for (int bb = 0; bb < 2; ++bb) \
            *(LAS u32x4*)(raw + bb * 2048 + ht * 8) = *(const u32x4*)(ZT + ((size_t)(b0 + bb) * 3072 + (kind) * 1024 + c) * SEQ + ht * 8); } while (0)
        HY_LOADRAW(2);
        __syncthreads();
        f32x2 vin[8], v[16];
        hy_conv(raw, in[I_HCW], in[I_HCB][2048 + c], 2048 + c, ht, vin);
#pragma unroll
        for (int a = 0; a < 8; ++a) { v[a] = vin[a]; v[8 + a] = (f32x2){0.f, 0.f}; }
        fft_fwd(v, buf, ht, tw);
        { const f32x2* Hd = H + (size_t)(c * 2 + 0) * 4096;
#pragma unroll
          for (int ks = 0; ks < 16; ++ks) v[ks] = cmul(v[ks], Hd[ks * 256 + ht]); }
        fft_inv(v, buf, ht, tw);
        HY_LOADRAW(0);
        __syncthreads();
        { f32x2 g[8]; hy_conv(raw, in[I_HCW], in[I_HCB][c], c, ht, g); const float sk = in[I_HSKIP][c];
#pragma unroll
          for (int a = 0; a < 8; ++a) vin[a] = g[a] * (v[a] + vin[a] * sk); }
#pragma unroll
        for (int a = 0; a < 8; ++a) { v[a] = vin[a]; v[8 + a] = (f32x2){0.f, 0.f}; }
        fft_fwd(v, buf, ht, tw);
        { const f32x2* Hd = H + (size_t)(c * 2 + 1) * 4096;
#pragma unroll
          for (int ks = 0; ks < 16; ++ks) v[ks] = cmul(v[ks], Hd[ks * 256 + ht]); }
        fft_inv(v, buf, ht, tw);
        HY_LOADRAW(1);
        __syncthreads();
        { f32x2 g[8]; hy_conv(raw, in[I_HCW], in[I_HCB][1024 + c], 1024 + c, ht, g); const float sk = in[I_HSKIP][1024 + c];
#pragma unroll
          for (int a = 0; a < 8; ++a) { const f32x2 o = g[a] * (v[a] + vin[a] * sk); const int t = 256 * a + ht;
              outT[(0 * 2048 + t) * 8 + cl] = (bf16_t)f2bf(o.x); outT[(1 * 2048 + t) * 8 + cl] = (bf16_t)f2bf(o.y); } }
        __syncthreads();
#undef HY_LOADRAW
    }
    bf16_t* HH = WSP(bf16_t, WS_HH);
#pragma unroll
    for (int q = 0; q < 8; ++q) { const int r = F.tid + 512 * q, bb = r >> 11, t = r & 2047;
        *(u32x4*)(HH + ((size_t)(b0 + bb) * SEQ + t) * HW + c0) = *(const LAS u32x4*)(outT + r * 8); }
    __syncthreads();
}

struct SchedP {
    static constexpr bool GATHER = false;
    int G, c; const char* a; const char* b; size_t astep, bstep;
    __device__ __forceinline__ bool next(int i, Unit& u) const { const int L = i * G + c; if (L >= 512) return false; pg8::decode_tile(L, 64, 8, u.pm, u.pn); u.ex = 0; return true; }
    __device__ __forceinline__ const char* a_base(const Unit& u) const { return a + (size_t)u.pm * astep; }
    __device__ __forceinline__ const char* b_base(const Unit& u) const { return b + (size_t)u.pn * bstep; }
    __device__ __forceinline__ int a_row(const Unit&, int R) const { return R; }
};
struct EpiMA {
    static constexpr bool PERM = true;
    float* T; const bf16_t* Z;
    __device__ __forceinline__ void operator()(const f32x4 (&acc)[2][2][4][2], const Unit& u, int wr, int wc, int fr, int fq) const {
        const int row0 = u.pm * 256 + wr * 64 + fr, col0 = u.pn * 256 + wc * 32 + 8 * fq;
#pragma unroll
        for (int ai = 0; ai < 2; ++ai)
#pragma unroll
            for (int m = 0; m < 4; ++m) { const size_t row = row0 + ai * 128 + m * 16;
#pragma unroll
                for (int bj = 0; bj < 2; ++bj) { const int c = col0 + bj * 128;
                    const u32x4 gz = *(const u32x4*)(Z + row * ZN + ZC_GA + c);
                    f32x4 g0 = (f32x4){sigmoidf_(bflo(gz.x)), sigmoidf_(bfhi(gz.x)), sigmoidf_(bflo(gz.y)), sigmoidf_(bfhi(gz.y))};
                    f32x4 g1 = (f32x4){sigmoidf_(bflo(gz.z)), sigmoidf_(bfhi(gz.z)), sigmoidf_(bflo(gz.w)), sigmoidf_(bfhi(gz.w))};
                    *(f32x4*)(T + row * DM + c) = acc[ai][bj][m][0] * g0; *(f32x4*)(T + row * DM + c + 4) = acc[ai][bj][m][1] * g1; } }
    }
};
struct EpiMB {
    static constexpr bool PERM = true;
    const float* T; const bf16_t* Z; bf16_t* MX;
    __device__ __forceinline__ void operator()(const f32x4 (&acc)[2][2][4][2], const Unit& u, int wr, int wc, int fr, int fq) const {
        const int row0 = u.pm * 256 + wr * 64 + fr, col0 = u.pn * 256 + wc * 32 + 8 * fq;
#pragma unroll
        for (int ai = 0; ai < 2; ++ai)
#pragma unroll
            for (int m = 0; m < 4; ++m) { const size_t row = row0 + ai * 128 + m * 16;
#pragma unroll
                for (int bj = 0; bj < 2; ++bj) { const int c = col0 + bj * 128;
                    const u32x4 gz = *(const u32x4*)(Z + row * ZN + ZC_GH + c);
                    const f32x4 t0 = *(const f32x4*)(T + row * DM + c), t1 = *(const f32x4*)(T + row * DM + c + 4);
                    f32x4 g0 = (f32x4){sigmoidf_(bflo(gz.x)), sigmoidf_(bfhi(gz.x)), sigmoidf_(bflo(gz.y)), sigmoidf_(bfhi(gz.y))};
                    f32x4 g1 = (f32x4){sigmoidf_(bflo(gz.z)), sigmoidf_(bfhi(gz.z)), sigmoidf_(bflo(gz.w)), sigmoidf_(bfhi(gz.w))};
                    const f32x4 v0 = t0 + acc[ai][bj][m][0] * g0, v1 = t1 + acc[ai][bj][m][1] * g1;
                    u32x4 w; w.x = pg8::cvt_pk_bf16(v0[0], v0[1]); w.y = pg8::cvt_pk_bf16(v0[2], v0[3]); w.z = pg8::cvt_pk_bf16(v1[0], v1[1]); w.w = pg8::cvt_pk_bf16(v1[2], v1[3]);
                    *(u32x4*)(MX + row * DM + c) = w; } }
    }
};
struct EpiWO {
    static constexpr bool PERM = false;
    float* R1; const float* x; const float* stats; const float* lng; const float* lnb; const float* mod;
    __device__ __forceinline__ void operator()(const f32x4 (&acc)[2][2][4][2], const Unit& u, int wr, int wc, int fr, int fq) const {
        const int row0 = u.pm * 256 + wr * 64 + fr, col0 = u.pn * 256 + wc * 32 + 4 * fq;
        const float* g1p = mod + (size_t)(u.pm >> 3) * 12288 + 4096;
#pragma unroll
        for (int ai = 0; ai < 2; ++ai)
#pragma unroll
            for (int m = 0; m < 4; ++m) { const size_t row = row0 + ai * 128 + m * 16; const float mean = stats[row * 2], rstd = stats[row * 2 + 1];
#pragma unroll
                for (int bj = 0; bj < 2; ++bj)
#pragma unroll
                    for (int n = 0; n < 2; ++n) { const int c = col0 + bj * 128 + n * 16;
                        const f32x4 xv = *(const f32x4*)(x + row * DM + c), g = *(const f32x4*)(lng + c), bb = *(const f32x4*)(lnb + c), g1 = *(const f32x4*)(g1p + c);
                        *(f32x4*)(R1 + row * DM + c) = ((xv - mean) * rstd * g + bb) * DN_ALPHA + g1 * acc[ai][bj][m][n]; } }
    }
};

__device__ __forceinline__ void p8_phase(Frame& F) {
    const KargP in = karg_opaque(F.in);
    const int lane = F.lane, l15 = lane & 15, g4 = lane >> 4;
    if (F.wave >= 4) return;
    const float* R1 = WSP(float, WS_R1); unsigned char* TOK = WSP(unsigned char, WS_TOK); const float* mod = WSP(float, WS_MOD);
    LAS float* pA = (LAS float*)(F.lds + F.wave * 20480);
    LAS float* pB = pA + 2048;
    LAS float* lg = pA + 4096;
    LAS int* te = (LAS int*)(lg + 576); LAS float* tw = (LAS float*)(te + 64);
    const float* wr = in[I_WR];
#pragma unroll 1
    for (int tile = F.bid + F.G * F.wave; tile < MTOK / 16; tile += F.G * 4) {
        const int bsel = (tile * 16) / SEQ; const float* mv = mod + (size_t)bsel * 12288;
#pragma unroll
        for (int j = 0; j < 8; ++j) { const int c = lane * 4 + 256 * j;
            const f32x4 g = *(const f32x4*)(in[I_LN1G] + c), bb = *(const f32x4*)(in[I_LN1B] + c), sh = *(const f32x4*)(mv + 6144 + c), sc = *(const f32x4*)(mv + 8192 + c) + 1.0f;
            *(LAS f32x4*)(pA + c) = g * sc; *(LAS f32x4*)(pB + c) = bb * sc + sh; }
        LDS_WAIT(); asm volatile("" ::: "memory");
        float my_mean = 0.f, my_rstd = 0.f;
        {
            const float* xb = R1 + (size_t)tile * 16 * DM + lane * 4;
            f32x4 v[8], vn[8];
#pragma unroll
            for (int j = 0; j < 8; ++j) v[j] = *(const f32x4*)(xb + 256 * j);
#pragma unroll 1
            for (int rr = 0; rr < 16; ++rr) {
                const float* xn = xb + (size_t)(rr < 15 ? rr + 1 : rr) * DM;
#pragma unroll
                for (int j = 0; j < 8; ++j) vn[j] = *(const f32x4*)(xn + 256 * j);
                float s = 0.f;
#pragma unroll
                for (int j = 0; j < 8; ++j) s += (v[j].x + v[j].y) + (v[j].z + v[j].w);
                const float mean = wave_sum(s) * (1.f / DM); float s2 = 0.f;
#pragma unroll
                for (int j = 0; j < 8; ++j) { v[j] = v[j] - mean; s2 += (v[j].x * v[j].x + v[j].y * v[j].y) + (v[j].z * v[j].z + v[j].w * v[j].w); }
                const float rstd = 1.f / sqrtf(wave_sum(s2) * (1.f / DM) + LN_EPS);
                if (l15 == rr) { my_mean = mean; my_rstd = rstd; }
                unsigned char* orow = TOK + (size_t)(tile * 16 + rr) * DM;
#pragma unroll
                for (int j = 0; j < 8; ++j) { const int c = lane * 4 + 256 * j;
                    const f32x4 y = v[j] * rstd * *(const LAS f32x4*)(pA + c) + *(const LAS f32x4*)(pB + c);
                    *(unsigned*)(orow + c) = pk4_fp8(y.x, y.y, y.z, y.w); }
#pragma unroll
                for (int j = 0; j < 8; ++j) v[j] = vn[j];
            }
        }
        f32x4 acc0 = (f32x4){0.f, 0.f, 0.f, 0.f}, acc1 = (f32x4){0.f, 0.f, 0.f, 0.f};
        const float* rowp = R1 + (size_t)(tile * 16 + l15) * DM + 512 * g4;
        const float* wp = wr + (size_t)(512 * g4) * 32 + l15;
        const float ra = my_rstd, rm = -my_mean * my_rstd;
        f32x4 r4 = *(const f32x4*)rowp; float w0[4], w1[4];
#pragma unroll
        for (int j = 0; j < 4; ++j) { w0[j] = wp[j * 32]; w1[j] = wp[j * 32 + 16]; }
#pragma unroll 1
        for (int s = 0; s < 512; s += 4) {
            const int sn = s + 4 < 512 ? s + 4 : s;
            const f32x4 r4n = *(const f32x4*)(rowp + sn); float w0n[4], w1n[4];
#pragma unroll
            for (int j = 0; j < 4; ++j) { w0n[j] = wp[(sn + j) * 32]; w1n[j] = wp[(sn + j) * 32 + 16]; }
            const f32x4 av = *(const LAS f32x4*)(pA + 512 * g4 + s), bv = *(const LAS f32x4*)(pB + 512 * g4 + s);
            const f32x4 tk = (r4 * ra + rm) * av + bv;
#pragma unroll
            for (int j = 0; j < 4; ++j) { acc0 = __builtin_amdgcn_mfma_f32_16x16x4f32(tk[j], w0[j], acc0, 0, 0, 0); acc1 = __builtin_amdgcn_mfma_f32_16x16x4f32(tk[j], w1[j], acc1, 0, 0, 0); }
            r4 = r4n;
#pragma unroll
            for (int j = 0; j < 4; ++j) { w0[j] = w0n[j]; w1[j] = w1n[j]; }
        }
        { const float b0 = in[I_BR][l15], b1 = in[I_BR][16 + l15];
#pragma unroll
          for (int r = 0; r < 4; ++r) { lg[(4 * g4 + r) * 33 + l15] = acc0[r] + b0; lg[(4 * g4 + r) * 33 + 16 + l15] = acc1[r] + b1; } }
        LDS_WAIT(); asm volatile("" ::: "memory");
        if (lane < 16) {
            unsigned chosen = 0u; float lv[4]; int le[4];
            for (int k = 0; k < 4; ++k) { float best = -3.4e38f; int be = 0;
                for (int e = 0; e < 32; ++e) { const float v = lg[lane * 33 + e]; if (!((chosen >> e) & 1u) && v > best) { best = v; be = e; } }
                chosen |= 1u << be; lv[k] = best; le[k] = be; }
            float ex[4], sum = 0.f;
            for (int k = 0; k < 4; ++k) { ex[k] = __expf(lv[k] - lv[0]); sum += ex[k]; }
            for (int k = 0; k < 4; ++k) { te[lane * 4 + k] = le[k]; tw[lane * 4 + k] = ex[k] / sum; }
        }
        LDS_WAIT(); asm volatile("" ::: "memory");
        { const int e = te[lane]; const float wv = tw[lane]; const int token = tile * 16 + (lane >> 2);
          const int pos = (int)__hip_atomic_fetch_add(F.ctl + CW_CNT + 64 * e, 1u, __ATOMIC_RELAXED, __HIP_MEMORY_SCOPE_AGENT);
          WSP(int, WS_TOPE)[token * 4 + (lane & 3)] = e; WSP(int, WS_TOPP)[token * 4 + (lane & 3)] = pos; WSP(float, WS_TOPW)[token * 4 + (lane & 3)] = wv;
          WSP(int, WS_RTOK)[e * POSCAP + pos] = token; }
        LDS_WAIT(); asm volatile("" ::: "memory");
    }
}

constexpr int MOE_TBL = 131072;
__device__ __forceinline__ void moe_table(Frame& F) {
    LAS int* tst = (LAS int*)(F.lds + MOE_TBL); LAS int* cn = (LAS int*)(F.lds + MOE_TBL + 256);
    __syncthreads();
    if (F.tid < 64) {
        const int e = F.tid & 31; const int c = (int)__hip_atomic_load(F.ctl + CW_CNT + 64 * e, __ATOMIC_RELAXED, __HIP_MEMORY_SCOPE_AGENT);
        int inc = (c + 255) >> 8;
#pragma unroll
        for (int o = 1; o < 32; o <<= 1) { const int t = __shfl_up(inc, o); if ((F.tid & 31) >= o) inc += t; }
        if (F.tid < 32) { cn[e] = c; tst[e] = inc - ((c + 255) >> 8); if (e == 31) tst[NEXP] = inc; } }
    __syncthreads();
}
template <bool GU> struct SchedMoE {
    static constexpr bool GATHER = GU;
    int G, c, NT; const LAS int* tst; const LAS int* cn; const int* rtok; const char* a; const char* b;
    __device__ __forceinline__ bool next(int i, Unit& u) const {
        const int nwg = __builtin_amdgcn_readfirstlane(tst[NEXP]) * NT; const int L = i * G + c; if (L >= nwg) return false;
        int wg; { const int q = nwg / 8, r = nwg % 8, xcd = L % 8, off = L / 8; wg = (xcd < r ? xcd * (q + 1) : r * (q + 1) + (xcd - r) * q) + off; }
        int e = 0;
#pragma unroll 1
        for (int k = 1; k < NEXP; ++k) { const int s = __builtin_amdgcn_readfirstlane(tst[k]); if (wg >= s * NT) e = k; }
        const int ts = __builtin_amdgcn_readfirstlane(tst[e]), ts1 = __builtin_amdgcn_readfirstlane(tst[e + 1]);
        const int rem = wg - ts * NT, ne = ts1 - ts;
        u.pm = ts + rem % ne; u.pn = rem / ne; u.ex = e; return true;
    }
    __device__ __forceinline__ const char* a_base(const Unit& u) const { return GU ? a : a + (size_t)u.pm * 256 * DM; }
    __device__ __forceinline__ const char* b_base(const Unit& u) const { return b + ((size_t)u.ex * (GU ? 4096 : 2048) + 256 * u.pn) * DM; }
    __device__ __forceinline__ int a_row(const Unit& u, int R) const { const int cnt = __builtin_amdgcn_readfirstlane(cn[u.ex]), t0 = __builtin_amdgcn_readfirstlane(tst[u.ex]); int pos = (u.pm - t0) * 256 + R; pos = pos < cnt ? pos : cnt - 1; return rtok[u.ex * POSCAP + pos]; }
};
struct EpiGU {
    static constexpr bool PERM = true;
    unsigned char* ACT; const float* bg; const float* bu;
    __device__ __forceinline__ void operator()(const f32x4 (&acc)[2][2][4][2], const Unit& u, int wr, int wc, int fr, int fq) const {
        const int row0 = u.pm * 256 + wr * 64 + fr, col0 = u.pn * 128 + wc * 32 + 8 * fq;
        const float* bgp = bg + (size_t)u.ex * DM + col0; const float* bup = bu + (size_t)u.ex * DM + col0;
        const f32x4 g0 = *(const f32x4*)bgp, g1 = *(const f32x4*)(bgp + 4), u0 = *(const f32x4*)bup, u1 = *(const f32x4*)(bup + 4);
#pragma unroll
        for (int ai = 0; ai < 2; ++ai)
#pragma unroll
            for (int m = 0; m < 4; ++m) { const size_t row = row0 + ai * 128 + m * 16;
                float o[8];
#pragma unroll
                for (int n = 0; n < 2; ++n)
#pragma unroll
                    for (int j = 0; j < 4; ++j) { const float gv = fminf(acc[ai][0][m][n][j] + (n ? g1[j] : g0[j]), 7.0f);
                        const float uv = fminf(fmaxf(acc[ai][1][m][n][j] + (n ? u1[j] : u0[j]), -7.0f), 7.0f);
                        o[n * 4 + j] = 4.0f * gv * sigmoidf_(1.702f * gv) * (uv + 1.0f); }
                u32x2 w; w.x = pk4_fp8(o[0], o[1], o[2], o[3]); w.y = pk4_fp8(o[4], o[5], o[6], o[7]);
                *(u32x2*)(ACT + row * DM + col0) = w; }
    }
};
struct EpiDN {
    static constexpr bool PERM = true;
    bf16_t* YR; const float* bd;
    __device__ __forceinline__ void operator()(const f32x4 (&acc)[2][2][4][2], const Unit& u, int wr, int wc, int fr, int fq) const {
        const int r0 = wr * 64 + fr, col0 = u.pn * 256 + wc * 32 + 8 * fq;
        const float* bp = bd + (size_t)u.ex * DM + col0;
        bf16_t* base = YR + ((size_t)u.pm * 256 + r0) * DM + col0;
#pragma unroll
        for (int bj = 0; bj < 2; ++bj) {
            const f32x4 bv0 = *(const f32x4*)(bp + bj * 128), bv1 = *(const f32x4*)(bp + bj * 128 + 4);
#pragma unroll
            for (int ai = 0; ai < 2; ++ai)
#pragma unroll
                for (int m = 0; m < 4; ++m) {
                    const f32x4 v0 = acc[ai][bj][m][0] + bv0, v1 = acc[ai][bj][m][1] + bv1;
                    u32x4 w; w.x = pg8::cvt_pk_bf16(v0[0], v0[1]); w.y = pg8::cvt_pk_bf16(v0[2], v0[3]); w.z = pg8::cvt_pk_bf16(v1[0], v1[1]); w.w = pg8::cvt_pk_bf16(v1[2], v1[3]);
                    *(u32x4*)(base + (size_t)(ai * 128 + m * 16) * DM + bj * 128) = w; }
        }
    }
};

__device__ __forceinline__ void p11_phase(Frame& F) {
    const KargP in = karg_opaque(F.in);
    const int gw = F.bid * NWAVES + F.wave, NGW = F.G * NWAVES, lane = F.lane;
    const LAS int* tst = (const LAS int*)(F.lds + MOE_TBL);
    const float* R1 = WSP(float, WS_R1); const bf16_t* YR = WSP(bf16_t, WS_YR); const float* mod = WSP(float, WS_MOD);
    LAS float* pl = (LAS float*)F.lds;
    for (int i = F.tid; i < 2048; i += NTHR) { pl[i] = in[I_LN1G][i]; pl[2048 + i] = in[I_LN1B][i]; pl[4096 + i] = in[I_LN2G][i]; pl[6144 + i] = in[I_LN2B][i]; }
    for (int i = F.tid; i < 8 * 2048; i += NTHR) pl[8192 + i] = mod[(size_t)(i >> 11) * 12288 + 10240 + (i & 2047)];
    __syncthreads();
    LAS int* sd = (LAS int*)(F.lds + 98304 + F.wave * 512); LAS float* sw = (LAS float*)(F.lds + 98304 + F.wave * 512 + 256);
#pragma unroll 1
    for (int rb = gw * 8; rb < MTOK; rb += NGW * 8) {
        const int li = lane & 31;
        { const int ve = WSP(int, WS_TOPE)[rb * 4 + li], vp = WSP(int, WS_TOPP)[rb * 4 + li]; const float vw = WSP(float, WS_TOPW)[rb * 4 + li];
          if (lane < 32) { sd[li] = tst[ve] * 256 + vp; sw[li] = vw; } }
        const LAS float* g2p = pl + 8192 + (rb / SEQ) * 2048;
        LDS_WAIT(); asm volatile("" ::: "memory");
#pragma unroll 1
        for (int ri = 0; ri < 8; ++ri) {
            const int row = rb + ri;
            int dest[4]; float wk[4];
#pragma unroll
            for (int k = 0; k < 4; ++k) { dest[k] = __builtin_amdgcn_readfirstlane(sd[ri * 4 + k]); wk[k] = __builtin_bit_cast(float, __builtin_amdgcn_readfirstlane(__builtin_bit_cast(int, sw[ri * 4 + k]))); }
            const float* xr = R1 + (size_t)row * DM + lane * 4;
            f32x4 v[8]; u32x2 yy[4][8];
#pragma unroll
            for (int j = 0; j < 8; ++j) v[j] = *(const f32x4*)(xr + 256 * j);
#pragma unroll
            for (int k = 0; k < 4; ++k) { const bf16_t* yp = YR + (size_t)dest[k] * DM + lane * 4;
#pragma unroll
                for (int j = 0; j < 8; ++j) yy[k][j] = *(const u32x2*)(yp + 256 * j); }
            float s = 0.f;
#pragma unroll
            for (int j = 0; j < 8; ++j) s += (v[j].x + v[j].y) + (v[j].z + v[j].w);
            float mean = wave_sum(s) * (1.f / DM); float s2 = 0.f;
#pragma unroll
            for (int j = 0; j < 8; ++j) { v[j] = v[j] - mean; s2 += (v[j].x * v[j].x + v[j].y * v[j].y) + (v[j].z * v[j].z + v[j].w * v[j].w); }
            float rstd = 1.f / sqrtf(wave_sum(s2) * (1.f / DM) + LN_EPS);
            s = 0.f;
#pragma unroll
            for (int j = 0; j < 8; ++j) { const int c = lane * 4 + 256 * j;
                const f32x4 g = *(const LAS f32x4*)(pl + c), bb = *(const LAS f32x4*)(pl + 2048 + c), g2v = *(const LAS f32x4*)(g2p + c);
                f32x4 y = (f32x4){0.f, 0.f, 0.f, 0.f};
#pragma unroll
                for (int k = 0; k < 4; ++k) y += (f32x4){bflo(yy[k][j].x), bfhi(yy[k][j].x), bflo(yy[k][j].y), bfhi(yy[k][j].y)} * wk[k];
                v[j] = (v[j] * rstd * g + bb) * DN_ALPHA + g2v * y;
                s += (v[j].x + v[j].y) + (v[j].z + v[j].w); __builtin_amdgcn_sched_barrier(0); }
            mean = wave_sum(s) * (1.f / DM); s2 = 0.f;
#pragma unroll
            for (int j = 0; j < 8; ++j) { v[j] = v[j] - mean; s2 += (v[j].x * v[j].x + v[j].y * v[j].y) + (v[j].z * v[j].z + v[j].w * v[j].w); }
            rstd = 1.f / sqrtf(wave_sum(s2) * (1.f / DM) + LN_EPS);
            float* orow = F.out + (size_t)row * DM;
#pragma unroll
            for (int j = 0; j < 8; ++j) { const int c = lane * 4 + 256 * j;
                const f32x4 g = *(const LAS f32x4*)(pl + 4096 + c), bb = *(const LAS f32x4*)(pl + 6144 + c);
                *(f32x4*)(orow + c) = v[j] * rstd * g + bb; }
        }
        LDS_WAIT(); asm volatile("" ::: "memory");
    }
}

constexpr int NPHASE = 13;
__global__ void __launch_bounds__(NTHR, 2) mk_fwd(Args args) {
    extern __shared__ __attribute__((aligned(16))) unsigned char lds_raw[];
    Frame F;
    F.lds = (LAS unsigned char*)lds_raw;
    F.MISC = (volatile LAS unsigned*)(F.lds + MISC_OFF);
    F.tid = threadIdx.x; F.lane = F.tid & 63; F.wave = __builtin_amdgcn_readfirstlane(F.tid >> 6);
    F.G = gridDim.x; F.bid = blockIdx.x;
    F.in = (KargP)__builtin_amdgcn_kernarg_segment_ptr(); F.out = args.out; F.ws = args.ws; F.ctl = (unsigned*)(args.ws + WS_CTL);
    for (int u = F.tid; u < (LDS_BYTES - MISC_OFF) / 4; u += NTHR) ((LAS unsigned*)(F.lds + MISC_OFF))[u] = 0u;
    __syncthreads();
    XcdBarrier bar; bar.bar = F.ctl + CW_BAR; bar.x = 0; bar.st = nullptr;
    if (MK_LAUNCHES == 1) bar = xcd_barrier_post(F.ctl + CW_BAR, F.MISC + 8);
    const int lo = args.ph_lo, hi = args.ph_hi;
#ifndef PH_MASK
#define PH_MASK 0xFFFF
#endif
#define RELOAD() do { const KargP k_ = karg_opaque(F.in); F.out = (float*)k_[38]; F.ws = (unsigned char*)k_[39]; F.ctl = (unsigned*)F.ws; int t_ = threadIdx.x; asm volatile("" : "+v"(t_)); F.tid = t_; F.lane = t_ & 63; F.wave = __builtin_amdgcn_readfirstlane(t_ >> 6); } while (0)
#define IN(k) (((PH_MASK >> (k)) & 1) && lo <= (k) && (k) < hi)
#define SEAM(k) do { if (IN(k) && IN((k) + 1)) xcd_barrier(bar); } while (0)
#ifndef DUP_MASK
#define DUP_MASK 0
#endif
#define REP(k) for (int rep_ = 0; rep_ < (((DUP_MASK >> (k)) & 1) ? 2 : 1); ++rep_)
    if (IN(0)) REP(0) p0_phase(F);
    SEAM(0);
    RELOAD();
    if (IN(1)) REP(1) p0b_phase(F);
    SEAM(1);
    RELOAD();
    if (IN(2)) REP(2) p1_phase(F);
    SEAM(2);
    RELOAD();
    if (IN(3)) REP(3) {
        SchedZ S{F.G, F.bid, (const char*)WSP(bf16_t, WS_HX), (const char*)WSP(bf16_t, WS_WIN)};
        EpiZ E{WSP(bf16_t, WS_Z), WSP(bf16_t, WS_ZT), WSP(float, WS_BINP)};
        pg8::gemm_phase<EpiZ, SchedZ>(F.lds, DM / 64, DM * 2, DM * 2, S, E);
    }
    SEAM(3);
    RELOAD();
    if (IN(4)) REP(4) p3_phase(F);
    SEAM(4);
    RELOAD();
    if (IN(5)) {
        SchedQK S{F.G, F.bid, (const char*)WSP(bf16_t, WS_U), (const char*)WSP(bf16_t, WS_WQK)};
        EpiQK E{WSP(bf16_t, WS_QKB)};
        pg8::gemm_phase<EpiQK, SchedQK>(F.lds, 256 / 64, MW * 2, 256 * 2, S, E);
    }
    SEAM(5);
    RELOAD();
    if (IN(6)) REP(6) {
#ifndef DUP_ML
#define DUP_ML 1
#endif
#ifndef DUP_HY
#define DUP_HY 1
#endif
        for (int un = F.bid; un < 256 * DUP_ML; un += F.G) mlstm_unit(F, un & 255);
        for (int un = F.bid; un < 512 * DUP_HY; un += F.G) hyena_unit(F, un & 511);
    }
    SEAM(6);
    RELOAD();
    if (IN(7)) REP(7) {
        { SchedP S{F.G, F.bid, (const char*)WSP(bf16_t, WS_AM), (const char*)WSP(bf16_t, WS_WPA2), (size_t)256 * 2048 * 2, (size_t)256 * 2048 * 2};
          EpiMA E{WSP(float, WS_T), WSP(bf16_t, WS_Z)};
          pg8::gemm_phase<EpiMA, SchedP>(F.lds, 2048 / 64, 2048 * 2, 2048 * 2, S, E); }
        VM_WAIT(); __syncthreads();
        { SchedP S{F.G, F.bid, (const char*)WSP(bf16_t, WS_HH), (const char*)WSP(bf16_t, WS_WPH), (size_t)256 * 1024 * 2, (size_t)256 * 1024 * 2};
          EpiMB E{WSP(float, WS_T), WSP(bf16_t, WS_Z), WSP(bf16_t, WS_MX)};
          pg8::gemm_phase<EpiMB, SchedP>(F.lds, 1024 / 64, 1024 * 2, 1024 * 2, S, E); }
    }
    SEAM(7);
    RELOAD();
    if (IN(8)) {
        SchedP S{F.G, F.bid, (const char*)WSP(bf16_t, WS_MX), (const char*)WSP(bf16_t, WS_WOUT), (size_t)256 * 2048 * 2, (size_t)256 * 2048 * 2};
        const KargP in = karg_opaque(F.in); EpiWO E{WSP(float, WS_R1), in[I_X], WSP(float, WS_STATS), in[I_LNG], in[I_LNB], WSP(float, WS_MOD)};
        pg8::gemm_phase<EpiWO, SchedP>(F.lds, 2048 / 64, 2048 * 2, 2048 * 2, S, E);
    }
    SEAM(8);
    RELOAD();
    if (IN(9)) p8_phase(F);
    SEAM(9);
    RELOAD();
    if (IN(10)) REP(10) {
        moe_table(F);
        SchedMoE<true> S{F.G, F.bid, 16, (const LAS int*)(F.lds + MOE_TBL), (const LAS int*)(F.lds + MOE_TBL + 256), WSP(int, WS_RTOK), (const char*)WSP(bf16_t, WS_TOK), (const char*)WSP(bf16_t, WS_WGU)};
        const KargP in = karg_opaque(F.in); EpiGU E{WSP(unsigned char, WS_ACT), in[I_BG], in[I_BU]};
        pg8::gemm_phase<EpiGU, SchedMoE<true>, true>(F.lds, DM / 128, DM, DM, S, E, 0x7A7A7A7A, 0x7F7F7F7F);
    }
    SEAM(10);
    RELOAD();
    if (IN(11)) REP(11) {
        moe_table(F);
        SchedMoE<false> S{F.G, F.bid, 8, (const LAS int*)(F.lds + MOE_TBL), (const LAS int*)(F.lds + MOE_TBL + 256), WSP(int, WS_RTOK), (const char*)WSP(bf16_t, WS_ACT), (const char*)WSP(bf16_t, WS_WD)};
        const KargP in = karg_opaque(F.in); EpiDN E{WSP(bf16_t, WS_YR), in[I_BDN]};
        pg8::gemm_phase<EpiDN, SchedMoE<false>, true>(F.lds, DM / 128, DM, DM, S, E, 0x79797979, 0x7D7D7D7D);
    }
    SEAM(11);
    RELOAD();
    if (IN(12)) REP(12) { moe_table(F); p11_phase(F); }
#undef IN
#undef SEAM
}

extern "C" void kernel_launch(void* const* d_in, const int* in_sizes, int n_in, void* d_out, int out_size, void* d_ws, size_t ws_size, hipStream_t stream) {
    static int grid = 0;
    if (grid == 0) {
        if (n_in != 38 || out_size != MTOK * DM || ws_size < WS_END) { fprintf(stderr, "kernel_launch: unexpected shapes: n_in %d out %d ws %zu (need %zu)\n", n_in, out_size, ws_size, (size_t)WS_END); grid = -1; return; }
        int dev = 0, cus = 0, per_cu = 0;
        if (hipGetDevice(&dev) != hipSuccess || hipDeviceGetAttribute(&cus, hipDeviceAttributeMultiprocessorCount, dev) != hipSuccess) { grid = -1; return; }
        if (hipFuncSetAttribute((const void*)mk_fwd, hipFuncAttributeMaxDynamicSharedMemorySize, LDS_BYTES) != hipSuccess) { fprintf(stderr, "kernel_launch: hipFuncSetAttribute failed\n"); grid = -1; return; }
        if (hipOccupancyMaxActiveBlocksPerMultiprocessor(&per_cu, (const void*)mk_fwd, NTHR, LDS_BYTES) != hipSuccess || per_cu < 1) fprintf(stderr, "kernel_launch: occupancy query says %d\n", per_cu);
        (void)hipGetLastError();
        grid = cus;
    }
    if (grid < 0) return;
    (void)hipMemsetAsync((char*)d_ws + WS_CTL, 0, CTL_ZERO_BYTES, stream);
    Args a{};
    for (int i = 0; i < 38; ++i) a.in[i] = (const float*)d_in[i];
    a.out = (float*)d_out; a.ws = (unsigned char*)d_ws;
#if MK_LAUNCHES == 1
    a.ph_lo = 0; a.ph_hi = NPHASE;
    hipLaunchKernelGGL(mk_fwd, dim3(grid), dim3(NTHR), LDS_BYTES, stream, a);
#else
    for (int p = 0; p < NPHASE; ++p) { a.ph_lo = p; a.ph_hi = p + 1; hipLaunchKernelGGL(mk_fwd, dim3(grid), dim3(NTHR), LDS_BYTES, stream, a); }
#endif
}
```

```cpp
#include <hip/hip_runtime.h>
#include <cstdio>
#include <cstdint>

#define GAS __attribute__((address_space(1)))
#define LAS __attribute__((address_space(3)))
typedef unsigned short bf16_t;
typedef short bf16x8 __attribute__((ext_vector_type(8)));
typedef float f32x4 __attribute__((ext_vector_type(4)));
typedef float f32x2 __attribute__((ext_vector_type(2)));
typedef unsigned u32x4 __attribute__((ext_vector_type(4)));
typedef unsigned u32x2 __attribute__((ext_vector_type(2)));

#ifndef MK_LAUNCHES
#define MK_LAUNCHES 1
#endif

constexpr int DM = 2048, NB = 8, SEQ = 2048, CTX = 256, GW = 64;
constexpr int MTOK = NB * SEQ;
constexpr int MCTX = NB * CTX;
constexpr int MALL = MTOK + MCTX;
constexpr int NH = 4, HD = 256, MW = 1024, HW = 1024;
constexpr int N_IN = 10256;
constexpr int NEXP = 32, TOPK = 4;
constexpr float LN_EPS = 1e-5f;
constexpr float DN_ALPHA = 1.189207115002721f;
constexpr int ZN = 7424, ZC_QK = 0, ZC_V = 1024, ZC_O = 2048, ZC_GA = 3072, ZC_GH = 5120, ZC_GT = 7168;
constexpr int WIN_ROWS = 10496, WIN_HY0 = 7424;
constexpr int MAXTILES = 288;
constexpr int POSCAP = 16384;

constexpr size_t MiB = 1u << 20;
constexpr size_t WS_CTL = 0;
constexpr size_t WS_MODP = 1 * MiB;
constexpr size_t WS_MOD = 9 * MiB;
constexpr size_t WS_BINP = 10 * MiB;
constexpr size_t WS_A3 = 10 * MiB + 64 * 1024;
constexpr size_t WS_STATS = 11 * MiB;
constexpr size_t WS_TOPE = 11 * MiB + 256 * 1024;
constexpr size_t WS_TOPP = 11 * MiB + 512 * 1024;
constexpr size_t WS_TOPW = 11 * MiB + 768 * 1024;
constexpr size_t WS_RTOK = 12 * MiB;
constexpr size_t WS_RW = 14 * MiB;
constexpr size_t WS_WQK = 16 * MiB;
constexpr size_t WS_WPH = 17 * MiB;
constexpr size_t WS_WPA2 = 21 * MiB;
constexpr size_t WS_WOUT = 29 * MiB;
constexpr size_t WS_WIN = 37 * MiB;
constexpr size_t WS_WGU = 78 * MiB;
constexpr size_t WS_WD = 590 * MiB;
constexpr size_t WS_RA = 846 * MiB;
constexpr size_t WS_Z = WS_RA, WS_ZT = WS_RA + 261 * MiB, WS_ACT = WS_RA;
constexpr size_t WS_RB = 1203 * MiB;
constexpr size_t WS_HX = WS_RB, WS_U = WS_RB + 72 * MiB, WS_QKB = WS_RB + 108 * MiB, WS_AM = WS_RB + 180 * MiB, WS_HH = WS_RB + 244 * MiB, WS_MX = WS_RB + 276 * MiB, WS_YR = WS_RB;
constexpr size_t WS_RC = 1543 * MiB;
constexpr size_t WS_HTAPS = WS_RC, WS_H = WS_RC + 32 * MiB, WS_T = WS_RC;
constexpr size_t WS_R1 = 1671 * MiB;
constexpr size_t WS_TOK = 1799 * MiB;
constexpr size_t WS_HX8 = WS_RC + 96 * MiB;
constexpr size_t WS_WIN8 = 1863 * MiB;
constexpr size_t WS_END = 1884 * MiB;
constexpr int CW_TMO = 0, CW_BAR = 4096, CW_CNT = 16384;
constexpr size_t CTL_ZERO_BYTES = 1 * MiB;

constexpr int LDS_BYTES = 160 * 1024 - 2048;
constexpr int MISC_OFF = LDS_BYTES - 1024;
constexpr int NWAVES = 8, NTHR = 512;

#define LDS_WAIT() asm volatile("s_waitcnt lgkmcnt(0)" ::: "memory")
#define VM_WAIT() asm volatile("s_waitcnt vmcnt(0)" ::: "memory")
__device__ __forceinline__ unsigned f2bf(float f) { unsigned u = __builtin_bit_cast(unsigned, f); return (u + 0x7fffu + ((u >> 16) & 1u)) >> 16; }
__device__ __forceinline__ unsigned pk2(float lo, float hi) { return f2bf(lo) | (f2bf(hi) << 16); }
__device__ __forceinline__ unsigned pk4_fp8(float a, float b, float c, float d) { int w = 0; w = __builtin_amdgcn_cvt_pk_fp8_f32(a, b, w, false); w = __builtin_amdgcn_cvt_pk_fp8_f32(c, d, w, true); return (unsigned)w; }
__device__ __forceinline__ float bf2f(unsigned b) { return __builtin_bit_cast(float, b << 16); }
__device__ __forceinline__ float bflo(unsigned w) { return __builtin_bit_cast(float, w << 16); }
__device__ __forceinline__ float bfhi(unsigned w) { return __builtin_bit_cast(float, w & 0xffff0000u); }
__device__ __forceinline__ float sigmoidf_(float x) { return 1.0f / (1.0f + __expf(-x)); }
__device__ __forceinline__ float wave_sum(float v) {
#pragma unroll
    for (int o = 1; o < 64; o <<= 1) v += __shfl_xor(v, o);
    return v;
}

#define XB_TMO      128
#define XB_XCNT(j)  (256  + 64 * (j))
#define XB_XSUB(j)  (1280 + 64 * (j))
#define XB_XGEN(j)  (2304 + 64 * (j))
#define XB_TOP      3328
#define XB_TOPGEN   3392
#define XCD_BAR_WORDS 3456
#define XB_SPIN_CAP (1u << 22)
__device__ __forceinline__ unsigned xb_ld(unsigned* p)              { return __hip_atomic_load(p, __ATOMIC_RELAXED, __HIP_MEMORY_SCOPE_AGENT); }
__device__ __forceinline__ unsigned xb_add(unsigned* p, unsigned v) { return __hip_atomic_fetch_add(p, v, __ATOMIC_RELAXED, __HIP_MEMORY_SCOPE_AGENT); }
__device__ __forceinline__ unsigned xb_xcc_id() { return (unsigned)__builtin_amdgcn_s_getreg((3 << 11) | 20) & 0xFu; }
#define XB_SPIN(cond, bar) do { unsigned _sp = 0; while (cond) { __builtin_amdgcn_s_sleep(1); \
    if ((++_sp & 255u) == 0u) { if (xb_ld(&(bar)[XB_TMO])) break; if (_sp > XB_SPIN_CAP) { atomicAdd(&(bar)[XB_TMO], 1u); break; } } } } while (0)
struct XcdBarrier { unsigned* bar; unsigned x; volatile LAS unsigned* st; };
__device__ __forceinline__ XcdBarrier xcd_barrier_post(unsigned* bar, volatile LAS unsigned* st) {
    XcdBarrier b; b.bar = bar; b.x = xb_xcc_id(); b.st = st;
    if (threadIdx.x == 0) (void)xb_add(&bar[XB_XCNT(b.x)], 1u);
    return b;
}
__device__ __forceinline__ void xcd_barrier_complete(unsigned* bar, unsigned x, unsigned& nloc, unsigned& nx) {
    const unsigned G = gridDim.x * gridDim.y * gridDim.z;
    unsigned sum, cnt, mine, sp = 0u;
    for (;;) {
        sum = 0u; cnt = 0u; mine = 0u;
#pragma unroll
        for (unsigned j = 0; j < 16; ++j) { const unsigned c = xb_ld(&bar[XB_XCNT(j)]); sum += c; cnt += (c > 0u) ? 1u : 0u; mine = (j == x) ? c : mine; }
        if (sum == G) break;
        __builtin_amdgcn_s_sleep(1);
        if ((++sp & 255u) == 0u) { if (xb_ld(&bar[XB_TMO])) break; if (sp > XB_SPIN_CAP) { atomicAdd(&bar[XB_TMO], 1u); break; } }
    }
    nloc = mine > 0u ? mine : 1u; nx = cnt > 0u ? cnt : 1u;
}
__device__ __forceinline__ void xcd_barrier(const XcdBarrier& b) {
    asm volatile("s_waitcnt vmcnt(0)" ::: "memory");
    __syncthreads();
    if (threadIdx.x == 0) {
        unsigned* bar = b.bar;
        __builtin_amdgcn_s_waitcnt(0);
        unsigned nloc = b.st[0], nx = b.st[1];
        if (nloc == 0u) { xcd_barrier_complete(bar, b.x, nloc, nx); b.st[0] = nloc; b.st[1] = nx; }
        const unsigned old = xb_add(&bar[XB_XSUB(b.x)], 1u);
        const unsigned gen = old / nloc;
        if (old + 1u == (gen + 1u) * nloc) {
            __builtin_amdgcn_fence(__ATOMIC_RELEASE, "agent");
            asm volatile("s_waitcnt vmcnt(0)" ::: "memory");
            const unsigned og = xb_add(&bar[XB_TOP], 1u);
            const unsigned tg = og / nx;
            if (og + 1u == (tg + 1u) * nx) xb_add(&bar[XB_TOPGEN], 1u);
            else XB_SPIN(xb_ld(&bar[XB_TOPGEN]) == tg, bar);
            __builtin_amdgcn_fence(__ATOMIC_ACQUIRE, "agent");
            xb_add(&bar[XB_XGEN(b.x)], 1u);
            asm volatile("s_waitcnt vmcnt(0)" ::: "memory");
        } else {
            XB_SPIN(xb_ld(&bar[XB_XGEN(b.x)]) == gen, bar);
            __builtin_amdgcn_fence(__ATOMIC_ACQUIRE, "agent");
            asm volatile("s_waitcnt vmcnt(0)" ::: "memory");
        }
    }
    __syncthreads();
}

struct Args {
    const float* in[38];
    float* out; unsigned char* ws;
    int ph_lo, ph_hi;
};
enum { I_X = 0, I_C, I_CTX, I_CCTX, I_LNG, I_LNB, I_WMOD, I_BMOD, I_WIN, I_BIN, I_MCW, I_MCB, I_WQH, I_WKH, I_HCW, I_HCB, I_FW1, I_FB1, I_FWH, I_FBH,
       I_FFREQ, I_FWOUT, I_HSKIP, I_WPA, I_WPH, I_WOUT, I_LN1G, I_LN1B, I_WR, I_BR, I_WG, I_BG, I_WU, I_BU, I_WDN, I_BDN, I_LN2G, I_LN2B };

namespace pg8 {
constexpr int BM = 256, BK = 64, HALF = 128, HTB = HALF * BK * 2, STAGE_BYTES = 8 * HTB, NXCD = 8, WGM = 8;
__host__ __device__ __forceinline__ int lds_byte(int r, int c) { const int st = (r >> 4) * 2 + (c >> 5), rr = r & 15, cc = c & 31, ob = rr * 64 + cc * 2; return st * 1024 + (ob ^ (((ob >> 9) & 1) << 5)); }
__host__ __device__ __forceinline__ void stage_rc(int b, int& R, int& C) { const int st = b / 1024, sb = b % 1024, swz = sb ^ (((sb >> 9) & 1) << 5); R = (st >> 1) * 16 + swz / 64; C = (st & 1) * 32 + (swz % 64) / 2; }
__host__ __device__ __forceinline__ int perm32(int rho) { const int n = rho >> 4, i = rho & 15; return 8 * (i >> 2) + 4 * n + (i & 3); }
struct Unit { int pm, pn, ex; };
__device__ __forceinline__ void decode_tile(int L, int nM, int nN, int& pm, int& pn) {
    const int nwg = nM * nN; int wgid = L;
    { const int q = nwg / NXCD, r = nwg % NXCD, xcd = wgid % NXCD, off = wgid / NXCD; wgid = (xcd < r ? xcd * (q + 1) : r * (q + 1) + (xcd - r) * q) + off; }
    const int nig = WGM * nN, gid = wgid / nig, fm = gid * WGM, gsz = (nM - fm) < WGM ? (nM - fm) : WGM;
    pm = fm + ((wgid % nig) % gsz); pn = (wgid % nig) / gsz;
}
__device__ __forceinline__ unsigned cvt_pk_bf16(float lo, float hi) { unsigned r; asm volatile("v_cvt_pk_bf16_f32 %0, %1, %2" : "=v"(r) : "v"(lo), "v"(hi)); return r; }

typedef int i32x8 __attribute__((ext_vector_type(8)));
template <class Epi, class Sched, bool F8 = false>
__device__ __forceinline__ void gemm_phase(LAS unsigned char* lds, const int nt, const int pitchA, const int pitchB, const Sched& S, const Epi& E, const int wscale = 0x7F7F7F7F, const int ascale = 0x7F7F7F7F) {
    const int tid = threadIdx.x, wid = __builtin_amdgcn_readfirstlane(tid >> 6), lane = tid & 63, wr = wid >> 2, wc = wid & 3, fr = lane & 15, fq = lane >> 4;
    int RA[2], CA[2]; unsigned voffB[2];
#pragma unroll
    for (int i = 0; i < 2; ++i) { int R, C; stage_rc(tid * 16 + i * 8192, R, C); const int Rb = Epi::PERM ? ((R & ~31) + perm32(R & 31)) : R;
        RA[i] = R; CA[i] = C; voffB[i] = (unsigned)(Rb * pitchB + C * 2); }
    const size_t kstep = (size_t)(BK * 2);
    const size_t hstepB = (size_t)HALF * pitchB;
    const unsigned ldsw = (unsigned)wid * 1024u;
    const int aoff = lds_byte(wr * 64 + fr, fq * 8), boff = lds_byte(wc * 32 + fr, fq * 8);
#define PG8_SA(b, h) (((b) * 2 + (h)) * HTB)
#define PG8_SB(b, h) ((4 + (b) * 2 + (h)) * HTB)
#define PG8_STAGE(bufoff, gbase, v0, v1) do { \
        __builtin_amdgcn_global_load_lds((const unsigned*)((const char*)(gbase) + (v0)), (LAS unsigned*)(lds + (bufoff) + ldsw), 16, 0, 0); \
        __builtin_amdgcn_global_load_lds((const unsigned*)((const char*)(gbase) + (v1)), (LAS unsigned*)(lds + (bufoff) + ldsw + 8192), 16, 0, 0); } while (0)
#define PG8_LD8(off) __builtin_bit_cast(i32x8, __builtin_shufflevector(*(const LAS u32x4*)(lds + (off)), *(const LAS u32x4*)(lds + (off) + 1024), 0, 1, 2, 3, 4, 5, 6, 7))
#define PG8_LDA(dst, b, h) do { _Pragma("unroll") for (int m = 0; m < 4; ++m) { if (F8) dst##8[m] = PG8_LD8(PG8_SA(b, h) + aoff + m * 2048); else { _Pragma("unroll") for (int k = 0; k < 2; ++k) dst[m][k] = *(const LAS bf16x8*)(lds + PG8_SA(b, h) + aoff + m * 2048 + k * 1024); } } } while (0)
#define PG8_LDB(dst, b, h) do { _Pragma("unroll") for (int n = 0; n < 2; ++n) { if (F8) dst##8[n] = PG8_LD8(PG8_SB(b, h) + boff + n * 2048); else { _Pragma("unroll") for (int k = 0; k < 2; ++k) dst[n][k] = *(const LAS bf16x8*)(lds + PG8_SB(b, h) + boff + n * 2048 + k * 1024); } } } while (0)
#define PG8_CAT(x) __builtin_shufflevector(__builtin_bit_cast(u32x4, x[0]), __builtin_bit_cast(u32x4, x[1]), 0, 1, 2, 3, 4, 5, 6, 7)
#define PG8_MMA(ai, bj, At, Bt) do { __builtin_amdgcn_s_setprio(1); _Pragma("unroll") for (int m = 0; m < 4; ++m) _Pragma("unroll") for (int n = 0; n < 2; ++n) { \
        if (F8) { asm volatile("v_mfma_scale_f32_16x16x128_f8f6f4 %0, %1, %2, %0, %3, %4 op_sel_hi:[0,0,0]" : "+v"(acc[ai][bj][m][n]) : "v"(Bt##8[n]), "v"(At##8[m]), "v"(wscale), "v"(ascale)); } \
        else { _Pragma("unroll") for (int k = 0; k < 2; ++k) acc[ai][bj][m][n] = __builtin_amdgcn_mfma_f32_16x16x32_bf16(Bt[n][k], At[m][k], acc[ai][bj][m][n], 0, 0, 0); } } __builtin_amdgcn_s_setprio(0); } while (0)
#define PG8_WAIT_V(n) asm volatile("s_waitcnt vmcnt(" #n ")" ::: "memory")
#define PG8_WAIT_L(n) asm volatile("s_waitcnt lgkmcnt(" #n ")" ::: "memory")
#define PG8_BAR __builtin_amdgcn_s_barrier()
#define PG8_SCHED __builtin_amdgcn_sched_barrier(0)
#define PG8_AOFF(u, o00, o01, o10, o11) do { \
        if (Sched::GATHER) { o00 = (unsigned)(S.a_row(u, RA[0]) * pitchA + CA[0] * 2); o01 = (unsigned)(S.a_row(u, RA[1]) * pitchA + CA[1] * 2); \
                             o10 = (unsigned)(S.a_row(u, RA[0] + HALF) * pitchA + CA[0] * 2); o11 = (unsigned)(S.a_row(u, RA[1] + HALF) * pitchA + CA[1] * 2); } \
        else { o00 = (unsigned)(RA[0] * pitchA + CA[0] * 2); o01 = (unsigned)(RA[1] * pitchA + CA[1] * 2); o10 = (unsigned)((RA[0] + HALF) * pitchA + CA[0] * 2); o11 = (unsigned)((RA[1] + HALF) * pitchA + CA[1] * 2); } } while (0)
    Unit cur, nxt; int ui = 0;
    if (!S.next(0, cur)) return;
    f32x4 acc[2][2][4][2];
#pragma unroll
    for (int a = 0; a < 2; ++a)
#pragma unroll
        for (int b = 0; b < 2; ++b)
#pragma unroll
            for (int m = 0; m < 4; ++m)
#pragma unroll
                for (int n = 0; n < 2; ++n) acc[a][b][m][n] = (f32x4){0.f, 0.f, 0.f, 0.f};
    bf16x8 At[4][2], B0[2][2], B1[2][2]; i32x8 At8[4], B08[2], B18[2];
    const char* cA = S.a_base(cur); const char* cB = S.b_base(cur);
    unsigned c00, c01, c10, c11; PG8_AOFF(cur, c00, c01, c10, c11);
    const unsigned vb0 = voffB[0], vb1 = voffB[1];
    PG8_STAGE(PG8_SB(0, 0), cB, vb0, vb1); PG8_STAGE(PG8_SA(0, 0), cA, c00, c01); PG8_STAGE(PG8_SB(0, 1), cB + hstepB, vb0, vb1); PG8_STAGE(PG8_SA(0, 1), cA, c10, c11);
    if (wr == 1) PG8_BAR;
    PG8_WAIT_V(4); PG8_BAR;
    PG8_STAGE(PG8_SB(1, 0), cB + kstep, vb0, vb1); PG8_STAGE(PG8_SA(1, 0), cA + kstep, c00, c01); PG8_STAGE(PG8_SB(1, 1), cB + hstepB + kstep, vb0, vb1);
    PG8_WAIT_V(6); PG8_BAR;
    for (;;) {
        const bool has_next = S.next(ui + 1, nxt);
        const char* nA = has_next ? S.a_base(nxt) : cA; const char* nB = has_next ? S.b_base(nxt) : cB;
        unsigned n00 = c00, n01 = c01, n10 = c10, n11 = c11;
        if (has_next) PG8_AOFF(nxt, n00, n01, n10, n11);
        for (int t = 0; t < nt; t += 2) {
            const bool last = (t == nt - 2);
            const char* a1 = cA + (size_t)(t + 1) * kstep;
            const char* a2 = last ? nA : cA + (size_t)(t + 2) * kstep; const char* b2 = last ? nB : cB + (size_t)(t + 2) * kstep;
            const char* a3 = a2 + kstep; const char* b3 = b2 + kstep;
            const unsigned x00 = last ? n00 : c00, x01 = last ? n01 : c01, x10 = last ? n10 : c10, x11 = last ? n11 : c11;
            PG8_LDB(B0, 0, 0); PG8_SCHED; PG8_LDA(At, 0, 0); PG8_STAGE(PG8_SA(1, 1), a1, c10, c11);
            PG8_WAIT_L(8); PG8_BAR; PG8_WAIT_L(0); PG8_MMA(0, 0, At, B0); PG8_BAR; PG8_SCHED;
            PG8_LDB(B1, 0, 1); PG8_STAGE(PG8_SB(0, 0), b2, vb0, vb1);
            PG8_BAR; PG8_WAIT_L(0); PG8_MMA(0, 1, At, B1); PG8_BAR;
            PG8_LDA(At, 0, 1); PG8_STAGE(PG8_SA(0, 0), a2, x00, x01);
            PG8_BAR; PG8_WAIT_L(0); PG8_MMA(1, 0, At, B0); PG8_BAR; PG8_SCHED;
            PG8_STAGE(PG8_SB(0, 1), b2 + hstepB, vb0, vb1);
            PG8_WAIT_V(6); PG8_BAR; PG8_MMA(1, 1, At, B1); PG8_BAR;
            PG8_LDB(B0, 1, 0); PG8_SCHED; PG8_LDA(At, 1, 0); PG8_STAGE(PG8_SA(0, 1), a2, x10, x11);
            PG8_WAIT_L(8); PG8_BAR; PG8_WAIT_L(0); PG8_MMA(0, 0, At, B0); PG8_BAR; PG8_SCHED;
            PG8_LDB(B1, 1, 1); PG8_STAGE(PG8_SB(1, 0), b3, vb0, vb1);
            PG8_BAR; PG8_WAIT_L(0); PG8_MMA(0, 1, At, B1); PG8_BAR;
            PG8_LDA(At, 1, 1); PG8_STAGE(PG8_SA(1, 0), a3, x00, x01);
            PG8_BAR; PG8_WAIT_L(0); PG8_MMA(1, 0, At, B0); PG8_BAR; PG8_SCHED;
            PG8_STAGE(PG8_SB(1, 1), b3 + hstepB, vb0, vb1);
            PG8_WAIT_V(6); PG8_BAR; PG8_MMA(1, 1, At, B1); PG8_BAR;
        }
        if (F8) asm volatile("s_nop 15\n\ts_nop 15" ::: "memory");
        E(acc, cur, wr, wc, fr, fq);
        if (!has_next) break;
#pragma unroll
        for (int a = 0; a < 2; ++a)
#pragma unroll
            for (int b = 0; b < 2; ++b)
#pragma unroll
                for (int m = 0; m < 4; ++m)
#pragma unroll
                    for (int n = 0; n < 2; ++n) acc[a][b][m][n] = (f32x4){0.f, 0.f, 0.f, 0.f};
        cur = nxt; cA = nA; cB = nB; c00 = n00; c01 = n01; c10 = n10; c11 = n11; ++ui;
    }
    PG8_WAIT_V(0);
    if (wr == 0) PG8_BAR;
    PG8_BAR;
#undef PG8_SA
#undef PG8_SB
#undef PG8_STAGE
#undef PG8_LDA
#undef PG8_LDB
#undef PG8_MMA
#undef PG8_WAIT_V
#undef PG8_WAIT_L
#undef PG8_BAR
#undef PG8_SCHED
#undef PG8_AOFF
#undef PG8_CAT
#undef PG8_LD8
}
}
using pg8::Unit;

typedef const float* cfp_t;
typedef __attribute__((address_space(4))) const cfp_t* KargP;
__device__ __forceinline__ KargP karg_opaque(KargP p) { asm volatile("" : "+s"(p)); return p; }
struct Frame {
    LAS unsigned char* lds;
    volatile LAS unsigned* MISC;
    unsigned* ctl;
    int tid, lane, wave, G, bid;
    KargP in;
    float* out; unsigned char* ws;
};
#define WSP(T, off) ((T*)(F.ws + (off)))

__device__ __forceinline__ void transpose_item(const float* src, size_t ld, int nvalid, float scale, bf16_t* dst, int K, LAS float* scr, int lane) {
#pragma unroll 8
    for (int i = 0; i < 32; ++i) { const int kk = 2 * i + (lane >> 5); const int j = lane & 31; scr[kk * 33 + j] = (j < nvalid) ? src[(size_t)kk * ld + j] * scale : 0.f; }
    LDS_WAIT(); asm volatile("" ::: "memory");
    const int c = lane & 7;
#pragma unroll
    for (int j = 0; j < 4; ++j) { const int n = (lane >> 3) + 8 * j; const LAS float* s = scr + (8 * c) * 33 + n;
        u32x4 o; o.x = pk2(s[0 * 33], s[1 * 33]); o.y = pk2(s[2 * 33], s[3 * 33]); o.z = pk2(s[4 * 33], s[5 * 33]); o.w = pk2(s[6 * 33], s[7 * 33]);
        *(u32x4*)(dst + (size_t)n * K + 8 * c) = o; }
    LDS_WAIT(); asm volatile("" ::: "memory");
}
struct CvItem { const float* src; unsigned char* dst; float scale; int rstep; };
__device__ __forceinline__ CvItem cv_decode(KargP in, unsigned char* ws, int it) {
    CvItem c;
    if (it < NEXP * 256) { const int e = it >> 8, q = it & 255, up = q & 1, g = (q >> 1) & 7, kb = q >> 4;
        c.src = (up ? in[I_WU] : in[I_WG]) + (size_t)e * DM * DM + (size_t)(128 * kb) * DM + 256 * g;
        c.dst = ws + WS_WGU + ((size_t)e * 4096 + 512 * g + up * 128) * DM + 128 * kb; c.scale = 32.f; c.rstep = 256; }
    else { const int r2 = it - NEXP * 256; const int e = r2 >> 7, q = r2 & 127, g = q & 7, kb = q >> 3;
        c.src = in[I_WDN] + (size_t)e * DM * DM + (size_t)(128 * kb) * DM + 256 * g;
        c.dst = ws + WS_WD + ((size_t)e * 2048 + 256 * g) * DM + 128 * kb; c.scale = 64.f; c.rstep = 128; }
    return c;
}
#define CV_LOAD(v, c) do { _Pragma("unroll") for (int i_ = 0; i_ < 16; ++i_) v[i_] = *(const f32x4*)((c).src + (size_t)(16 * w + i_) * DM + 4 * lane); } while (0)
#define CV_PROC(v, c) do { \
        _Pragma("unroll") for (int j_ = 0; j_ < 4; ++j_) { u32x4 o_; const float s_ = (c).scale; \
            o_.x = pk4_fp8(v[0][j_] * s_, v[1][j_] * s_, v[2][j_] * s_, v[3][j_] * s_);     o_.y = pk4_fp8(v[4][j_] * s_, v[5][j_] * s_, v[6][j_] * s_, v[7][j_] * s_); \
            o_.z = pk4_fp8(v[8][j_] * s_, v[9][j_] * s_, v[10][j_] * s_, v[11][j_] * s_);   o_.w = pk4_fp8(v[12][j_] * s_, v[13][j_] * s_, v[14][j_] * s_, v[15][j_] * s_); \
            *(LAS u32x4*)(tile + (4 * lane + j_) * 144 + 16 * w) = o_; } \
        __syncthreads(); \
        _Pragma("unroll") for (int q_ = 0; q_ < 4; ++q_) { const int idx_ = tid + 512 * q_, row_ = idx_ >> 3, piece_ = idx_ & 7; \
            *(u32x4*)((c).dst + (size_t)((row_ >> 7) * (c).rstep + (row_ & 127)) * DM + 16 * piece_) = *(const LAS u32x4*)(tile + row_ * 144 + 16 * piece_); } \
        __syncthreads(); } while (0)
__device__ __forceinline__ void convert_moe_weights(KargP in, unsigned char* ws, LAS unsigned char* tile, int tid, int bid, int G) {
    const int w = tid >> 6, lane = tid & 63;
    constexpr int NIT = NEXP * (256 + 128);
    f32x4 va[16], vb[16];
    int it = bid;
    if (it >= NIT) return;
    CvItem ca = cv_decode(in, ws, it), cb = ca;
    CV_LOAD(va, ca);
    for (;;) {
        const bool hb = it + G < NIT;
        if (hb) { cb = cv_decode(in, ws, it + G); CV_LOAD(vb, cb); }
        CV_PROC(va, ca);
        if (!hb) break;
        it += G;
        const bool ha = it + G < NIT;
        if (ha) { ca = cv_decode(in, ws, it + G); CV_LOAD(va, ca); }
        CV_PROC(vb, cb);
        if (!ha) break;
        it += G;
    }
}
#undef CV_LOAD
#undef CV_PROC
__device__ __forceinline__ void transpose_item_f8(const float* src, size_t ld, float scale, unsigned char* dst, int K, LAS float* scr, int lane) {
#pragma unroll 8
    for (int i = 0; i < 32; ++i) { const int kk = 2 * i + (lane >> 5); const int j = lane & 31; scr[kk * 33 + j] = src[(size_t)kk * ld + j] * scale; }
    LDS_WAIT(); asm volatile("" ::: "memory");
    const int c = lane & 3;
#pragma unroll
    for (int j = 0; j < 2; ++j) { const int n = (lane >> 2) + 16 * j; const LAS float* s = scr + (16 * c) * 33 + n;
        u32x4 o; o.x = pk4_fp8(s[0 * 33], s[1 * 33], s[2 * 33], s[3 * 33]); o.y = pk4_fp8(s[4 * 33], s[5 * 33], s[6 * 33], s[7 * 33]);
        o.z = pk4_fp8(s[8 * 33], s[9 * 33], s[10 * 33], s[11 * 33]); o.w = pk4_fp8(s[12 * 33], s[13 * 33], s[14 * 33], s[15 * 33]);
        *(u32x4*)(dst + (size_t)n * K + 16 * c) = o; }
    LDS_WAIT(); asm volatile("" ::: "memory");
}
__device__ __forceinline__ void p0_phase(Frame& F) {
    const KargP in = karg_opaque(F.in);
    LAS float* scr = (LAS float*)(F.lds + F.wave * 16384);
    const int gw = F.bid * NWAVES + F.wave, NGW = F.G * NWAVES;
    constexpr int IT_WIN = 32 * (WIN_ROWS / 32);
    constexpr int IT_WQK = 4 * 64;
    constexpr int IT_WPA2 = 32 * 64;
    constexpr int IT_WPH = 16 * 64;
    constexpr int IT_WOUT = 32 * 64;
    constexpr int NITEMS = IT_WIN + IT_WQK + IT_WPA2 + IT_WPH + IT_WOUT;
    for (int it = gw; it < NITEMS; it += NGW) {
        int r = it;
        if (r < IT_WIN) { const int g = r % (WIN_ROWS / 32), kb = r / (WIN_ROWS / 32); const int n0 = 32 * g; int sc, nv = 32;
            if (n0 < 2048) sc = n0; else if (n0 < 3072) sc = 2064 + (n0 - 2048); else if (n0 < 7168) sc = 6160 + (n0 - 3072); else if (n0 < 7200) { sc = 2048; nv = 16; } else if (n0 < WIN_HY0) { sc = 0; nv = 0; } else sc = 3088 + (n0 - WIN_HY0);
            if (n0 < 2048 || (n0 >= 7168 && n0 < WIN_HY0)) transpose_item(in[I_WIN] + (size_t)(64 * kb) * N_IN + sc, N_IN, nv, 1.f, WSP(bf16_t, WS_WIN) + (size_t)n0 * DM + 64 * kb, DM, scr, F.lane);
            else transpose_item_f8(in[I_WIN] + (size_t)(64 * kb) * N_IN + sc, N_IN, 32.f, WSP(unsigned char, WS_WIN8) + (size_t)n0 * DM + 64 * kb, DM, scr, F.lane);
            continue; } r -= IT_WIN;
        if (r < IT_WQK) { const int g = r % 64, kb = r / 64; const int n0 = 32 * g, h = n0 / 512, j = (n0 % 512) / 256, e0 = n0 % 256;
            const float* src = (j ? in[I_WKH] : in[I_WQH]) + (size_t)h * 65536 + (size_t)(64 * kb) * 256 + e0;
            transpose_item(src, 256, 32, j ? 0.0625f : 1.f, WSP(bf16_t, WS_WQK) + (size_t)n0 * 256 + 64 * kb, 256, scr, F.lane); continue; } r -= IT_WQK;
        if (r < IT_WPA2) { const int g = r % 64, kb = r / 64; const int n0 = 32 * g, k0 = 64 * kb;
            transpose_item(in[I_WPA] + (size_t)(k0 % 1024) * DM + n0, DM, 32, 1.f, WSP(bf16_t, WS_WPA2) + (size_t)n0 * 2048 + k0, 2048, scr, F.lane); continue; } r -= IT_WPA2;
        if (r < IT_WPH) { const int g = r % 64, kb = r / 64; const int n0 = 32 * g, k0 = 64 * kb;
            transpose_item(in[I_WPH] + (size_t)k0 * DM + n0, DM, 32, 1.f, WSP(bf16_t, WS_WPH) + (size_t)n0 * 1024 + k0, 1024, scr, F.lane); continue; } r -= IT_WPH;
        if (r < IT_WOUT) { const int g = r % 64, kb = r / 64; const int n0 = 32 * g, k0 = 64 * kb;
            transpose_item(in[I_WOUT] + (size_t)k0 * DM + n0, DM, 32, 1.f, WSP(bf16_t, WS_WOUT) + (size_t)n0 * 2048 + k0, 2048, scr, F.lane); continue; } r -= IT_WOUT;
        (void)r;
    }
    __syncthreads();
    convert_moe_weights(in, F.ws, (LAS unsigned char*)F.lds, F.tid, F.bid, F.G);
    for (int i = F.bid * NTHR + F.tid; i < WIN_ROWS; i += F.G * NTHR) { int sc = -1;
        if (i < 2048) sc = i; else if (i < 3072) sc = 2064 + (i - 2048); else if (i < 7168) sc = 6160 + (i - 3072); else if (i < 7184) sc = 2048 + (i - 7168); else if (i < WIN_HY0) sc = -1; else sc = 3088 + (i - WIN_HY0);
        WSP(float, WS_BINP)[i] = sc >= 0 ? in[I_BIN][sc] : 0.f; }
    for (int it = gw; it < 16 * 48; it += NGW) {
        const int ks = it / 48, cg = it % 48; const int col = cg * 256 + F.lane * 4;
        f32x4 a[9];
#pragma unroll
        for (int v = 0; v < 9; ++v) a[v] = (f32x4){0.f, 0.f, 0.f, 0.f};
#pragma unroll 1
        for (int kb = ks * 128; kb < ks * 128 + 128; kb += 16) {
            f32x4 w[16];
#pragma unroll
            for (int i = 0; i < 16; ++i) w[i] = *(const f32x4*)(in[I_WMOD] + (size_t)(kb + i) * 12288 + col);
#pragma unroll
            for (int i = 0; i < 16; ++i)
#pragma unroll
                for (int v = 0; v < 9; ++v) { const float cv = (v < 8) ? in[I_C][v * DM + kb + i] : in[I_CCTX][kb + i]; const float s = cv * sigmoidf_(cv); a[v] += w[i] * s; }
        }
#pragma unroll
        for (int v = 0; v < 9; ++v) *(f32x4*)(WSP(float, WS_MODP) + ((size_t)ks * 9 + v) * 12288 + col) = a[v];
    }
    for (int j = gw; j < SEQ; j += NGW) {
        const int l = F.lane;
        float zv = 0.f;
        if (l == 0) zv = (float)j / (float)(SEQ - 1);
        else if (l < 33) { const int bi = (l - 1) & 15; const float f = 1e-4f + (float)bi * ((15.0f - 1e-4f) / 15.0f); const float ang = 6.283185307179586f * (float)j * f / (float)SEQ; zv = (l < 17) ? cosf(ang) : -sinf(ang); }
        float pre = in[I_FB1][l];
        for (int i = 0; i < 33; ++i) pre += __shfl(zv, i) * in[I_FW1][i * 64 + l];
        float a = sinf(in[I_FFREQ][l] * pre);
        pre = in[I_FBH][l];
        for (int i = 0; i < 64; ++i) pre += __shfl(a, i) * in[I_FWH][i * 64 + l];
        float a2 = sinf(in[I_FFREQ][64 + l] * pre);
        pre = in[I_FBH][64 + l];
        for (int i = 0; i < 64; ++i) pre += __shfl(a2, i) * in[I_FWH][4096 + i * 64 + l];
        WSP(float, WS_A3)[j * 64 + l] = sinf(in[I_FFREQ][128 + l] * pre);
    }
}

__device__ __forceinline__ void p0b_phase(Frame& F) {
    const KargP in = karg_opaque(F.in);
    for (int i = F.bid * NTHR + F.tid; i < 9 * 12288; i += F.G * NTHR) { const int col = i % 12288; float s = in[I_BMOD][col];
        for (int ks = 0; ks < 16; ++ks) s += WSP(float, WS_MODP)[(size_t)ks * 9 * 12288 + i];
        WSP(float, WS_MOD)[i] = s; }
    LAS float* wl = (LAS float*)F.lds;
    for (int un = F.bid; un < 256; un += F.G) {
        const int ct = un >> 2, pg = un & 3;
        __syncthreads();
        for (int q = 0; q < 8; ++q) { const int idx = F.tid + 512 * q, i = idx >> 6, cc = idx & 63; wl[cc * 68 + i] = in[I_FWOUT][(size_t)i * 4096 + ct * 64 + cc]; }
        __syncthreads();
        const int j = pg * 512 + F.wave * 64 + F.lane;
        f32x4 ar[16];
#pragma unroll
        for (int q = 0; q < 16; ++q) ar[q] = *(const f32x4*)(WSP(float, WS_A3) + j * 64 + 4 * q);
        const float tj = (float)j / (float)(SEQ - 1);
        const float mind = -3.0701134573253944f, maxd = -15.350567286626972f;
        const int cbase = (ct * 64) & 1023;
#pragma unroll 1
        for (int cc = 0; cc < 64; ++cc) {
            f32x4 s = (f32x4){0.f, 0.f, 0.f, 0.f};
#pragma unroll
            for (int q = 0; q < 16; ++q) s += ar[q] * *(const LAS f32x4*)(wl + cc * 68 + 4 * q);
            const float delta = fabsf(mind + (float)(cbase + cc) * ((maxd - mind) / 1023.0f));
            const float v = ((s.x + s.y) + (s.z + s.w)) * __expf(-tj * delta);
            WSP(float, WS_HTAPS)[(size_t)(ct * 64 + cc) * SEQ + j] = v;
        }
    }
}

__device__ __forceinline__ f32x2 cmul(f32x2 a, f32x2 b) { return (f32x2){a.x * b.x - a.y * b.y, a.x * b.y + a.y * b.x}; }
__device__ __forceinline__ f32x2 cmulc(f32x2 a, f32x2 b) { return (f32x2){a.x * b.x + a.y * b.y, a.y * b.x - a.x * b.y}; }
template <bool INV> __device__ __forceinline__ void dft4(f32x2& a, f32x2& b, f32x2& c, f32x2& d) {
    const f32x2 s0 = a + c, s1 = a - c, s2 = b + d, s3 = b - d;
    const f32x2 is3 = (f32x2){-s3.y, s3.x};
    a = s0 + s2; c = s0 - s2;
    if (!INV) { b = s1 - is3; d = s1 + is3; } else { b = s1 + is3; d = s1 - is3; }
}
template <bool INV> __device__ __forceinline__ void dft16(f32x2 (&v)[16]) {
#pragma unroll
    for (int n0 = 0; n0 < 4; ++n0) dft4<INV>(v[n0], v[4 + n0], v[8 + n0], v[12 + n0]);
    const float c1 = 0.9238795325112867f, s1 = 0.3826834323650898f, r2 = 0.7071067811865476f;
    const float cs[10] = {1.f, c1, r2, s1, 0.f, -s1, -r2, -c1, -1.f, -c1};
    const float sn[10] = {0.f, s1, r2, c1, 1.f, c1, r2, s1, 0.f, -s1};
#pragma unroll
    for (int k0 = 1; k0 < 4; ++k0)
#pragma unroll
        for (int n0 = 1; n0 < 4; ++n0) { const int m = n0 * k0; const f32x2 w = (f32x2){cs[m], INV ? sn[m] : -sn[m]}; v[4 * k0 + n0] = cmul(v[4 * k0 + n0], w); }
#pragma unroll
    for (int k0 = 0; k0 < 4; ++k0) dft4<INV>(v[4 * k0], v[4 * k0 + 1], v[4 * k0 + 2], v[4 * k0 + 3]);
#pragma unroll
    for (int a = 0; a < 4; ++a)
#pragma unroll
        for (int b = a + 1; b < 4; ++b) { const f32x2 t = v[4 * a + b]; v[4 * a + b] = v[4 * b + a]; v[4 * b + a] = t; }
}
__device__ __forceinline__ int fphys(int i) { return i + (i >> 4); }
constexpr int FFT_BUF_BYTES = (4096 + 256) * 8;
struct FftTw { f32x2 wA, wB; };
__device__ __forceinline__ FftTw fft_tw(int ht) { FftTw t; float s, c; sincospif(-(float)ht / 2048.0f, &s, &c); t.wA = (f32x2){c, s}; sincospif(-(float)(ht & 15) / 128.0f, &s, &c); t.wB = (f32x2){c, s}; return t; }
__device__ __forceinline__ void fft_fwd(f32x2 (&v)[16], LAS f32x2* buf, int ht, const FftTw& tw_) {
    FftTw tw = tw_; asm volatile("" : "+v"(ht), "+v"(tw.wA.x), "+v"(tw.wA.y), "+v"(tw.wB.x), "+v"(tw.wB.y));
    dft16<false>(v);
    { f32x2 w = tw.wA;
#pragma unroll
      for (int k = 1; k < 16; ++k) { v[k] = cmul(v[k], w); w = cmul(w, tw.wA); } }
#pragma unroll
    for (int k = 0; k < 16; ++k) buf[fphys(256 * k + ht)] = v[k];
    __syncthreads();
    const int ka = ht >> 4, s = ht & 15;
#pragma unroll
    for (int b = 0; b < 16; ++b) v[b] = buf[fphys(256 * ka + 16 * b + s)];
    dft16<false>(v);
    { f32x2 w = tw.wB;
#pragma unroll
      for (int k = 1; k < 16; ++k) { v[k] = cmul(v[k], w); w = cmul(w, tw.wB); } }
#pragma unroll
    for (int k = 0; k < 16; ++k) buf[fphys(256 * ka + 16 * k + s)] = v[k];
    __syncthreads();
#pragma unroll
    for (int q = 0; q < 16; ++q) v[q] = buf[fphys(16 * ht + q)];
    dft16<false>(v);
}
__device__ __forceinline__ void fft_inv(f32x2 (&v)[16], LAS f32x2* buf, int ht, const FftTw& tw_) {
    FftTw tw = tw_; asm volatile("" : "+v"(ht), "+v"(tw.wA.x), "+v"(tw.wA.y), "+v"(tw.wB.x), "+v"(tw.wB.y));
    dft16<true>(v);
#pragma unroll
    for (int q = 0; q < 16; ++q) buf[fphys(16 * ht + q)] = v[q];
    __syncthreads();
    const int ka = ht >> 4, s = ht & 15;
#pragma unroll
    for (int k = 0; k < 16; ++k) v[k] = buf[fphys(256 * ka + 16 * k + s)];
    { f32x2 w = tw.wB;
#pragma unroll
      for (int k = 1; k < 16; ++k) { v[k] = cmulc(v[k], w); w = cmul(w, tw.wB); } }
    dft16<true>(v);
#pragma unroll
    for (int b = 0; b < 16; ++b) buf[fphys(256 * ka + 16 * b + s)] = v[b];
    __syncthreads();
#pragma unroll
    for (int k = 0; k < 16; ++k) v[k] = buf[fphys(256 * k + ht)];
    { f32x2 w = tw.wA;
#pragma unroll
      for (int k = 1; k < 16; ++k) { v[k] = cmulc(v[k], w); w = cmul(w, tw.wA); } }
    dft16<true>(v);
    __syncthreads();
}

__device__ __forceinline__ void p1_phase(Frame& F) {
    const KargP in = karg_opaque(F.in);
    const int gw = F.bid * NWAVES + F.wave, NGW = F.G * NWAVES;
    const float* mod = WSP(float, WS_MOD);
    {
        f32x4 pg[8], pb[8];
#pragma unroll
        for (int j = 0; j < 8; ++j) { pg[j] = *(const f32x4*)(in[I_LNG] + F.lane * 4 + 256 * j); pb[j] = *(const f32x4*)(in[I_LNB] + F.lane * 4 + 256 * j); }
#pragma unroll 1
        for (int grp = gw; grp < MALL / 8; grp += NGW) {
            const int row0 = grp * 8; const bool lat = row0 < MTOK;
            const float* xb = lat ? in[I_X] + (size_t)row0 * DM : in[I_CTX] + (size_t)(row0 - MTOK) * DM;
            const float* mv = mod + (size_t)(lat ? row0 / SEQ : 8) * 12288;
            f32x4 psh[8], psc[8];
#pragma unroll
            for (int j = 0; j < 8; ++j) { psh[j] = *(const f32x4*)(mv + F.lane * 4 + 256 * j); psc[j] = *(const f32x4*)(mv + 2048 + F.lane * 4 + 256 * j) + 1.0f; }
            f32x4 v[8], vn[8];
#pragma unroll
            for (int j = 0; j < 8; ++j) v[j] = *(const f32x4*)(xb + F.lane * 4 + 256 * j);
#pragma unroll 1
            for (int ri = 0; ri < 8; ++ri) {
                const float* xn = xb + (size_t)(ri < 7 ? ri + 1 : ri) * DM;
#pragma unroll
                for (int j = 0; j < 8; ++j) vn[j] = *(const f32x4*)(xn + F.lane * 4 + 256 * j);
                float s = 0.f;
#pragma unroll
                for (int j = 0; j < 8; ++j) s += (v[j].x + v[j].y) + (v[j].z + v[j].w);
                const float mean = wave_sum(s) * (1.f / DM); float s2 = 0.f;
#pragma unroll
                for (int j = 0; j < 8; ++j) { v[j] = v[j] - mean; s2 += (v[j].x * v[j].x + v[j].y * v[j].y) + (v[j].z * v[j].z + v[j].w * v[j].w); }
                const float rstd = 1.f / sqrtf(wave_sum(s2) * (1.f / DM) + LN_EPS);
                const int row = row0 + ri;
                if (lat && F.lane == 0) { WSP(float, WS_STATS)[row * 2] = mean; WSP(float, WS_STATS)[row * 2 + 1] = rstd; }
                bf16_t* orow = WSP(bf16_t, WS_HX) + (size_t)row * DM;
#pragma unroll
                for (int j = 0; j < 8; ++j) { const f32x4 y = (v[j] * rstd * pg[j] + pb[j]) * psc[j] + psh[j];
                    u32x2 o; o.x = pk2(y.x, y.y); o.y = pk2(y.z, y.w); *(u32x2*)(orow + F.lane * 4 + 256 * j) = o;
                    if (lat) *(unsigned*)(WSP(unsigned char, WS_HX8) + (size_t)row * DM + F.lane * 4 + 256 * j) = pk4_fp8(y.x, y.y, y.z, y.w); }
#pragma unroll
                for (int j = 0; j < 8; ++j) v[j] = vn[j];
            }
        }
    }
    const int hb = F.tid >> 8, ht = F.tid & 255;
    LAS f32x2* buf = (LAS f32x2*)(F.lds + hb * FFT_BUF_BYTES);
    const FftTw tw = fft_tw(ht);
    const float* htaps = WSP(float, WS_HTAPS);
    for (int u0 = F.bid * 2; u0 < 2048; u0 += F.G * 2) {
        const int un = u0 + hb, c = un >> 1, n = un & 1;
        const float* hf = htaps + (size_t)((n * 2 + 0) * 1024 + c) * SEQ, * hbk = htaps + (size_t)((n * 2 + 1) * 1024 + c) * SEQ;
        f32x2 v[16];
#pragma unroll
        for (int a = 0; a < 16; ++a) { const int i = 256 * a + ht; float x;
            if (a < 8) x = hf[i]; else if (i == 2048) x = 0.f; else x = hbk[4096 - i];
            v[a] = (f32x2){x * (1.0f / 4096.0f), 0.f}; }
        fft_fwd(v, buf, ht, tw);
        f32x2* Hd = WSP(f32x2, WS_H) + (size_t)un * 4096;
#pragma unroll
        for (int ks = 0; ks < 16; ++ks) Hd[ks * 256 + ht] = v[ks];
        __syncthreads();
    }
}

template <bool F8> struct SchedZ {
    static constexpr bool GATHER = false;
    int G, c; const char* hx; const char* win;
    static constexpr size_t P = F8 ? DM : 2 * DM;
    __device__ __forceinline__ bool next(int i, Unit& u) const {
        int L = i * G + c;
        if (!F8) {
            if (L < 576) { int pn; pg8::decode_tile(L, 64, 9, u.pm, pn); u.pn = pn < 8 ? pn : 28; u.ex = 0; return true; } L -= 576;
            if (L < 72) { int pm, pn; pg8::decode_tile(L, 8, 9, pm, pn); u.pm = 64 + pm; u.pn = pn < 8 ? pn : 28; u.ex = 0; return true; }
            return false;
        } else {
            if (L < 1280) { int pn; pg8::decode_tile(L, 64, 20, u.pm, pn); u.pn = 8 + pn; u.ex = 0; return true; } L -= 1280;
            if (L < 768) { pg8::decode_tile(L, 12, 64, u.pm, u.pn); u.ex = 1; return true; }
            return false;
        }
    }
    __device__ __forceinline__ const char* a_base(const Unit& u) const { return u.ex ? win + (size_t)(WIN_HY0 + 256 * u.pm) * P : hx + (size_t)(256 * u.pm) * P; }
    __device__ __forceinline__ const char* b_base(const Unit& u) const { return u.ex ? hx + (size_t)(256 * u.pn) * P : win + (size_t)(256 * u.pn) * P; }
    __device__ __forceinline__ int a_row(const Unit&, int R) const { return R; }
};
struct EpiZ {
    static constexpr bool PERM = true;
    bf16_t* Z; bf16_t* ZT; const float* bias;
    __device__ __forceinline__ void operator()(const f32x4 (&acc)[2][2][4][2], const Unit& u, int wr, int wc, int fr, int fq) const {
        if (u.ex == 0) {
            const int row0 = u.pm * 256 + wr * 64 + fr, col0 = u.pn * 256 + wc * 32 + 8 * fq;
            f32x4 bv[2][2];
#pragma unroll
            for (int bj = 0; bj < 2; ++bj)
#pragma unroll
                for (int n = 0; n < 2; ++n) bv[bj][n] = *(const f32x4*)(bias + col0 + bj * 128 + 4 * n);
#pragma unroll
            for (int ai = 0; ai < 2; ++ai)
#pragma unroll
                for (int m = 0; m < 4; ++m) { bf16_t* rowp = Z + (size_t)(row0 + ai * 128 + m * 16) * ZN + col0;
#pragma unroll
                    for (int bj = 0; bj < 2; ++bj) { const f32x4 v0 = acc[ai][bj][m][0] + bv[bj][0], v1 = acc[ai][bj][m][1] + bv[bj][1];
                        u32x4 w; w.x = pg8::cvt_pk_bf16(v0[0], v0[1]); w.y = pg8::cvt_pk_bf16(v0[2], v0[3]); w.z = pg8::cvt_pk_bf16(v1[0], v1[1]); w.w = pg8::cvt_pk_bf16(v1[2], v1[3]);
                        *(u32x4*)(rowp + bj * 128) = w; } }
        } else {
            const int ch0 = u.pm * 256 + wr * 64 + fr, b = u.pn >> 3, t0 = (u.pn & 7) * 256 + wc * 32 + 8 * fq;
#pragma unroll
            for (int ai = 0; ai < 2; ++ai)
#pragma unroll
                for (int m = 0; m < 4; ++m) { const int ch = ch0 + ai * 128 + m * 16; const float bb = bias[WIN_HY0 + ch];
                    bf16_t* rowp = ZT + ((size_t)b * 3072 + ch) * SEQ + t0;
#pragma unroll
                    for (int bj = 0; bj < 2; ++bj) { const f32x4 v0 = acc[ai][bj][m][0] + bb, v1 = acc[ai][bj][m][1] + bb;
                        u32x4 w; w.x = pg8::cvt_pk_bf16(v0[0], v0[1]); w.y = pg8::cvt_pk_bf16(v0[2], v0[3]); w.z = pg8::cvt_pk_bf16(v1[0], v1[1]); w.w = pg8::cvt_pk_bf16(v1[2], v1[3]);
                        *(u32x4*)(rowp + bj * 128) = w; } }
        }
    }
};

__device__ __forceinline__ void p3_phase(Frame& F) {
    const KargP in = karg_opaque(F.in);
    const bf16_t* Z = WSP(bf16_t, WS_Z); bf16_t* U = WSP(bf16_t, WS_U);
    const float* cw = in[I_MCW]; const float* cb = in[I_MCB];
    for (int it = F.bid * NTHR + F.tid; it < MALL * 128; it += F.G * NTHR) {
        const int row = it >> 7, c0 = (it & 127) * 8;
        float a[8];
        { const f32x4 b0 = *(const f32x4*)(cb + c0), b1 = *(const f32x4*)(cb + c0 + 4); a[0] = b0.x; a[1] = b0.y; a[2] = b0.z; a[3] = b0.w; a[4] = b1.x; a[5] = b1.y; a[6] = b1.z; a[7] = b1.w; }
        const bool lat = row < MTOK;
        int base, y, x, H, Wd;
        if (lat) { const int t = row & (SEQ - 1); base = row - t; y = t >> 6; x = t & 63; H = 32; Wd = 64; }
        else { const int t = (row - MTOK) & (CTX - 1); base = row - t; y = 0; x = t; H = 1; Wd = CTX; }
#pragma unroll
        for (int dy = -1; dy <= 1; ++dy)
#pragma unroll
            for (int dx = -1; dx <= 1; ++dx) {
                const int yy = y + dy, xx = x + dx;
                if (yy < 0 || yy >= H || xx < 0 || xx >= Wd) continue;
                const int srow = base + yy * Wd + xx;
                const u32x4 zz = *(const u32x4*)(Z + (size_t)srow * ZN + ZC_QK + c0);
                const float* wp = cw + ((dy + 1) * 3 + (dx + 1)) * MW + c0;
                const f32x4 w0 = *(const f32x4*)wp, w1 = *(const f32x4*)(wp + 4);
                a[0] += bflo(zz.x) * w0.x; a[1] += bfhi(zz.x) * w0.y; a[2] += bflo(zz.y) * w0.z; a[3] += bfhi(zz.y) * w0.w;
                a[4] += bflo(zz.z) * w1.x; a[5] += bfhi(zz.z) * w1.y; a[6] += bflo(zz.w) * w1.z; a[7] += bfhi(zz.w) * w1.w;
            }
#pragma unroll
        for (int j = 0; j < 8; ++j) a[j] = a[j] * sigmoidf_(a[j]);
        u32x4 o; o.x = pk2(a[0], a[1]); o.y = pk2(a[2], a[3]); o.z = pk2(a[4], a[5]); o.w = pk2(a[6], a[7]);
        *(u32x4*)(U + (size_t)row * MW + c0) = o;
    }
}

struct SchedQK {
    static constexpr bool GATHER = false;
    int G, c; const char* u; const char* w;
    __device__ __forceinline__ bool next(int i, Unit& un) const { const int L = i * G + c; if (L >= 72 * 8) return false; pg8::decode_tile(L, 72, 8, un.pm, un.pn); un.ex = 0; return true; }
    __device__ __forceinline__ const char* a_base(const Unit& un) const { return u + ((size_t)(256 * un.pm) * MW + (un.pn >> 1) * 256) * 2; }
    __device__ __forceinline__ const char* b_base(const Unit& un) const { return w + (size_t)(256 * un.pn) * 256 * 2; }
    __device__ __forceinline__ int a_row(const Unit&, int R) const { return R; }
};
struct EpiQK {
    static constexpr bool PERM = true;
    bf16_t* O;
    __device__ __forceinline__ void operator()(const f32x4 (&acc)[2][2][4][2], const Unit& u, int wr, int wc, int fr, int fq) const {
        const int row0 = u.pm * 256 + wr * 64 + fr, col0 = u.pn * 256 + wc * 32 + 8 * fq;
#pragma unroll
        for (int ai = 0; ai < 2; ++ai)
#pragma unroll
            for (int m = 0; m < 4; ++m) { bf16_t* rowp = O + (size_t)(row0 + ai * 128 + m * 16) * 2048 + col0;
#pragma unroll
                for (int bj = 0; bj < 2; ++bj) { const f32x4 v0 = acc[ai][bj][m][0], v1 = acc[ai][bj][m][1];
                    u32x4 w; w.x = pg8::cvt_pk_bf16(v0[0], v0[1]); w.y = pg8::cvt_pk_bf16(v0[2], v0[3]); w.z = pg8::cvt_pk_bf16(v1[0], v1[1]); w.w = pg8::cvt_pk_bf16(v1[2], v1[3]);
                    *(u32x4*)(rowp + bj * 128) = w; } }
    }
};

constexpr int ML_QS = 264, ML_VS = 72, ML_PS = 72;
constexpr int ML_Q = 0, ML_K = ML_Q + 64 * ML_QS * 2, ML_V = ML_K + 64 * ML_QS * 2, ML_C = ML_V + 64 * ML_VS * 2, ML_P = ML_C + 80 * ML_QS * 2, ML_SC = ML_P + 64 * ML_PS * 2;
constexpr int ML_SA = ML_SC, ML_SU = ML_SC + 256, ML_SSI = ML_SC + 512, ML_SWG = ML_SC + 768, ML_SEM = ML_SC + 1024, ML_SDEN = ML_SC + 1280, ML_SMISC = ML_SC + 1536, ML_END = ML_SC + 1600;
static_assert(ML_END <= MISC_OFF, "mlstm LDS");
__device__ __forceinline__ bf16x8 lds_frag(const LAS bf16_t* p) { return *(const LAS bf16x8*)p; }
__device__ __forceinline__ void mlstm_unit(Frame& F, int un) {
    const int vs = un & 3, dir = (un >> 2) & 1, h = (un >> 3) & 3, b = un >> 5;
    const bf16_t* Z = WSP(bf16_t, WS_Z); const bf16_t* QK = WSP(bf16_t, WS_QKB); bf16_t* AM = WSP(bf16_t, WS_AM);
    LAS unsigned char* lds = F.lds;
    LAS bf16_t* Qs = (LAS bf16_t*)(lds + ML_Q); LAS bf16_t* Ks = (LAS bf16_t*)(lds + ML_K); LAS bf16_t* Vs = (LAS bf16_t*)(lds + ML_V);
    LAS bf16_t* Cs = (LAS bf16_t*)(lds + ML_C); LAS bf16_t* Ps = (LAS bf16_t*)(lds + ML_P);
    LAS float* sA = (LAS float*)(lds + ML_SA); LAS float* sU = (LAS float*)(lds + ML_SU); LAS float* sSI = (LAS float*)(lds + ML_SSI);
    LAS float* sWG = (LAS float*)(lds + ML_SWG); LAS float* sEM = (LAS float*)(lds + ML_SEM); LAS float* sDEN = (LAS float*)(lds + ML_SDEN); LAS float* sMI = (LAS float*)(lds + ML_SMISC);
    const int tid = F.tid, lane = F.lane, w = F.wave, l15 = lane & 15, g4 = lane >> 4;
    __syncthreads();
    for (int i = tid; i < 80 * ML_QS / 2; i += NTHR) ((LAS unsigned*)Cs)[i] = 0u;
    if (tid < 64) { Vs[tid * ML_VS + 64] = (bf16_t)0x3F80; for (int j = 65; j < ML_VS; ++j) Vs[tid * ML_VS + j] = 0; }
    f32x4 cacc[2][5];
#pragma unroll
    for (int a = 0; a < 2; ++a)
#pragma unroll
        for (int c = 0; c < 5; ++c) cacc[a][c] = (f32x4){0.f, 0.f, 0.f, 0.f};
    float m_run = 0.f;
    u32x4 pq[4], pk[4], pv; unsigned pgate = 0u, pgate2 = 0u;
#define ML_ROW0(st) ((st) < 4 ? (MTOK + b * CTX + 64 * (dir ? 3 - (st) : (st))) : (b * SEQ + 64 * (dir ? 35 - (st) : (st) - 4)))
#define ML_LOAD(st) do { const int r0_ = ML_ROW0(st); \
        _Pragma("unroll") for (int q_ = 0; q_ < 4; ++q_) { const int p_ = tid + 512 * q_, rr_ = p_ >> 5, cc_ = (p_ & 31) * 8; \
            pq[q_] = *(const u32x4*)(QK + (size_t)(r0_ + rr_) * 2048 + h * 512 + cc_); pk[q_] = *(const u32x4*)(QK + (size_t)(r0_ + rr_) * 2048 + h * 512 + 256 + cc_); } \
        { const int rr_ = tid >> 3, cc_ = (tid & 7) * 8; pv = *(const u32x4*)(Z + (size_t)(r0_ + rr_) * ZN + ZC_V + h * 256 + vs * 64 + cc_); } \
        if (tid < 64) { const bf16_t* gp_ = Z + (size_t)(r0_ + tid) * ZN + ZC_GT + dir * 8 + h; pgate = gp_[0]; pgate2 = gp_[4]; } } while (0)
#define ML_STORE() do { \
        _Pragma("unroll") for (int q_ = 0; q_ < 4; ++q_) { const int p_ = tid + 512 * q_, rr_ = p_ >> 5, cc_ = (p_ & 31) * 8; \
            *(LAS u32x4*)(Qs + rr_ * ML_QS + cc_) = pq[q_]; *(LAS u32x4*)(Ks + rr_ * ML_QS + cc_) = pk[q_]; } \
        { const int rr_ = tid >> 3, cc_ = (tid & 7) * 8; *(LAS u32x4*)(Vs + rr_ * ML_VS + cc_) = pv; } } while (0)
    ML_LOAD(0);
    __syncthreads();
    const int tt = w & 3; const int nv = (w < 4) ? 3 : 2;
#pragma unroll 1
    for (int st = 0; st < 36; ++st) {
        ML_STORE();
        if (w == 0) {
            const float li = bf2f(pgate), zf = bf2f(pgate2);
            const float lf = fminf(zf, 0.f) - log1pf(__expf(-fabsf(zf)));
            float bcs = lf;
#pragma unroll
            for (int o = 1; o < 64; o <<= 1) { const float t = dir ? __shfl_down(bcs, o) : __shfl_up(bcs, o); const bool ok = dir ? (lane + o < 64) : (lane >= o); bcs += ok ? t : 0.f; }
            const float a = li - bcs;
            float am = a;
#pragma unroll
            for (int o = 1; o < 64; o <<= 1) { const float t = dir ? __shfl_down(am, o) : __shfl_up(am, o); const bool ok = dir ? (lane + o < 64) : (lane >= o); am = ok ? fmaxf(am, t) : am; }
            const float inter = bcs + m_run;
            const float mt = fmaxf(inter, bcs + am);
            const float b_end = __shfl(bcs, dir ? 0 : 63);
            const float gg = b_end - bcs + li;
            float gm = gg;
#pragma unroll
            for (int o = 1; o < 64; o <<= 1) gm = fmaxf(gm, __shfl_xor(gm, o));
            const float m_new = fmaxf(b_end + m_run, gm);
            sA[lane] = a; sU[lane] = bcs - mt; sSI[lane] = __expf(inter - mt); sWG[lane] = __expf(gg - m_new); sEM[lane] = __expf(-mt);
            if (lane == 0) sMI[0] = __expf(b_end + m_run - m_new);
            m_run = m_new;
        }
        const int row0 = ML_ROW0(st);
        if (st + 1 < 36) ML_LOAD(st + 1);
        __syncthreads();
        {
            f32x4 sacc[2] = {(f32x4){0.f, 0.f, 0.f, 0.f}, (f32x4){0.f, 0.f, 0.f, 0.f}};
#pragma unroll
            for (int ks = 0; ks < 8; ++ks) {
                const bf16x8 qf = lds_frag(Qs + (16 * tt + l15) * ML_QS + 32 * ks + 8 * g4);
#pragma unroll
                for (int j = 0; j < 2; ++j) { const int stl = 2 * (w >> 2) + j;
                    const bf16x8 kf = lds_frag(Ks + (16 * stl + l15) * ML_QS + 32 * ks + 8 * g4);
                    sacc[j] = __builtin_amdgcn_mfma_f32_16x16x32_bf16(kf, qf, sacc[j], 0, 0, 0); }
            }
            const int t = 16 * tt + l15; const float ut = sU[t];
#pragma unroll
            for (int j = 0; j < 2; ++j) { const int s0 = 16 * (2 * (w >> 2) + j) + 4 * g4;
                const f32x4 av = *(const LAS f32x4*)(sA + s0);
                float pvv[4];
#pragma unroll
                for (int r = 0; r < 4; ++r) { const int s = s0 + r; const bool ok = dir ? (s >= t) : (s <= t); pvv[r] = ok ? sacc[j][r] * __expf(ut + av[r]) : 0.f; }
                u32x2 o; o.x = pk2(pvv[0], pvv[1]); o.y = pk2(pvv[2], pvv[3]);
                *(LAS u32x2*)(Ps + t * ML_PS + s0) = o; }
        }
        __syncthreads();
        f32x4 nacc[3], iacc[3];
#pragma unroll
        for (int j = 0; j < 3; ++j) { nacc[j] = (f32x4){0.f, 0.f, 0.f, 0.f}; iacc[j] = (f32x4){0.f, 0.f, 0.f, 0.f}; }
#pragma unroll
        for (int ks = 0; ks < 8; ++ks) {
            const bf16x8 qf = lds_frag(Qs + (16 * tt + l15) * ML_QS + 32 * ks + 8 * g4);
#pragma unroll
            for (int j = 0; j < 3; ++j) if (j < nv) { const int vt = (w < 4) ? (j == 2 ? 4 : j) : 2 + j;
                const bf16x8 cf = lds_frag(Cs + (16 * vt + l15) * ML_QS + 32 * ks + 8 * g4);
                iacc[j] = __builtin_amdgcn_mfma_f32_16x16x32_bf16(qf, cf, iacc[j], 0, 0, 0); }
        }
#pragma unroll
        for (int ks = 0; ks < 2; ++ks) {
            const bf16x8 pf = lds_frag(Ps + (16 * tt + l15) * ML_PS + 32 * ks + 8 * g4);
#pragma unroll
            for (int j = 0; j < 3; ++j) if (j < nv) { const int vt = (w < 4) ? (j == 2 ? 4 : j) : 2 + j;
                bf16x8 vf;
#pragma unroll
                for (int e = 0; e < 8; ++e) vf[e] = (short)Vs[(32 * ks + 8 * g4 + e) * ML_VS + 16 * vt + l15];
                nacc[j] = __builtin_amdgcn_mfma_f32_16x16x32_bf16(pf, vf, nacc[j], 0, 0, 0); }
        }
        const int t0 = 16 * tt + 4 * g4;
        {
            const f32x4 si = *(const LAS f32x4*)(sSI + t0);
#pragma unroll
            for (int j = 0; j < 3; ++j) if (j < nv) nacc[j] = nacc[j] + iacc[j] * si;
            if (w < 4 && l15 == 0) *(LAS f32x4*)(sDEN + t0) = nacc[2];
        }
        {
            const float decay = sMI[0];
#pragma unroll
            for (int a = 0; a < 2; ++a)
#pragma unroll
                for (int c = 0; c < 5; ++c) cacc[a][c] = cacc[a][c] * decay;
#pragma unroll
            for (int ks = 0; ks < 2; ++ks) {
                bf16x8 kf[2];
#pragma unroll
                for (int a = 0; a < 2; ++a)
#pragma unroll
                    for (int e = 0; e < 8; ++e) kf[a][e] = (short)Ks[(32 * ks + 8 * g4 + e) * ML_QS + 16 * (2 * w + a) + l15];
                float wg[8];
#pragma unroll
                for (int e = 0; e < 8; ++e) wg[e] = sWG[32 * ks + 8 * g4 + e];
#pragma unroll
                for (int c = 0; c < 5; ++c) {
                    u32x4 vw;
                    { float x[8];
#pragma unroll
                      for (int e = 0; e < 8; ++e) x[e] = bf2f((unsigned)Vs[(32 * ks + 8 * g4 + e) * ML_VS + 16 * c + l15]) * wg[e];
                      vw.x = pk2(x[0], x[1]); vw.y = pk2(x[2], x[3]); vw.z = pk2(x[4], x[5]); vw.w = pk2(x[6], x[7]); }
                    const bf16x8 vf = __builtin_bit_cast(bf16x8, vw);
#pragma unroll
                    for (int a = 0; a < 2; ++a) cacc[a][c] = __builtin_amdgcn_mfma_f32_16x16x32_bf16(kf[a], vf, cacc[a][c], 0, 0, 0);
                }
            }
        }
        __syncthreads();
        if (st >= 4) {
            const f32x4 dn = *(const LAS f32x4*)(sDEN + t0), em = *(const LAS f32x4*)(sEM + t0);
#pragma unroll
            for (int j = 0; j < 2; ++j) { const int vt = (w < 4) ? j : 2 + j; const int col = h * 256 + vs * 64 + 16 * vt + l15;
#pragma unroll
                for (int r = 0; r < 4; ++r) { const int row = row0 + t0 + r;
                    const float hv = nacc[j][r] / fmaxf(fabsf(dn[r]), em[r]);
                    const float o = sigmoidf_(bf2f((unsigned)Z[(size_t)row * ZN + ZC_O + col]));
                    AM[(size_t)row * 2048 + dir * 1024 + col] = (bf16_t)f2bf(o * hv); } }
        }
#pragma unroll
        for (int a = 0; a < 2; ++a)
#pragma unroll
            for (int c = 0; c < 5; ++c) { u32x2 o; o.x = pk2(cacc[a][c][0], cacc[a][c][1]); o.y = pk2(cacc[a][c][2], cacc[a][c][3]);
                *(LAS u32x2*)(Cs + (16 * c + l15) * ML_QS + 16 * (2 * w + a) + 4 * g4) = o; }
        __syncthreads();
    }
#undef ML_LOAD
#undef ML_STORE
#undef ML_ROW0
}

constexpr int HY_RAW = 2 * FFT_BUF_BYTES, HY_OUT = HY_RAW + 16384, HY_END = HY_OUT + 65536;
static_assert(HY_END <= MISC_OFF, "hyena LDS");
__device__ __forceinline__ void hy_conv(const LAS bf16_t* raw, const float* cw, float bias, int c3, int ht, f32x2 (&o)[8]) {
    float w9[9];
#pragma unroll
    for (int q = 0; q < 9; ++q) w9[q] = cw[q * 3072 + c3];
    asm volatile("" : "+v"(ht));
    const int x = ht & 63;
#pragma unroll
    for (int a = 0; a < 8; ++a) { const int t = 256 * a + ht, y = t >> 6; float a0 = bias, a1 = bias;
#pragma unroll
        for (int dy = -1; dy <= 1; ++dy)
#pragma unroll
            for (int dx = -1; dx <= 1; ++dx) { const int yy = y + dy, xx = x + dx;
                if (yy >= 0 && yy < 32 && xx >= 0 && xx < 64) { const int idx = t + 64 * dy + dx; const float wv = w9[(dy + 1) * 3 + dx + 1];
                    a0 += wv * bf2f((unsigned)raw[idx]); a1 += wv * bf2f((unsigned)raw[2048 + idx]); } }
        o[a] = (f32x2){a0, a1}; asm volatile("" ::: "memory"); }
}
__device__ __forceinline__ void hyena_unit(Frame& F, int un) {
    const KargP in = karg_opaque(F.in);
    const int cg = un >> 2, bp = un & 3, c0 = cg * 8, b0 = bp * 2;
    const int hb = F.tid >> 8, ht = F.tid & 255;
    LAS f32x2* buf = (LAS f32x2*)(F.lds + hb * FFT_BUF_BYTES);
    LAS bf16_t* raw = (LAS bf16_t*)(F.lds + HY_RAW + hb * 8192);
    LAS bf16_t* outT = (LAS bf16_t*)(F.lds + HY_OUT);
    const bf16_t* ZT = WSP(bf16_t, WS_ZT); const f32x2* H = WSP(f32x2, WS_H);
    const FftTw tw = fft_tw(ht);
    __syncthreads();
#pragma unroll 1
    for (int i = 0; i < 4; ++i) {
        const int cl = 2 * i + hb, c = c0 + cl;
#define HY_LOADRAW(kind) do { _Pragma("unroll") for (int bb = 0; bb < 2; ++bb) \
            *(LAS u32x4*)(raw + bb * 2048 + ht * 8) = *(const u32x4*)(ZT + ((size_t)(b0 + bb) * 3072 + (kind) * 1024 + c) * SEQ + ht * 8); } while (0)
        HY_LOADRAW(2);
        __syncthreads();
        f32x2 vin[8], v[16];
        hy_conv(raw, in[I_HCW], in[I_HCB][2048 + c], 2048 + c, ht, vin);
#pragma unroll
        for (int a = 0; a < 8; ++a) { v[a] = vin[a]; v[8 + a] = (f32x2){0.f, 0.f}; }
        fft_fwd(v, buf, ht, tw);
        { const f32x2* Hd = H + (size_t)(c * 2 + 0) * 4096;
#pragma unroll
          for (int ks = 0; ks < 16; ++ks) v[ks] = cmul(v[ks], Hd[ks * 256 + ht]); }
        fft_inv(v, buf, ht, tw);
        HY_LOADRAW(0);
        __syncthreads();
        { f32x2 g[8]; hy_conv(raw, in[I_HCW], in[I_HCB][c], c, ht, g); const float sk = in[I_HSKIP][c];
#pragma unroll
          for (int a = 0; a < 8; ++a) vin[a] = g[a] * (v[a] + vin[a] * sk); }
#pragma unroll
        for (int a = 0; a < 8; ++a) { v[a] = vin[a]; v[8 + a] = (f32x2){0.f, 0.f}; }
        fft_fwd(v, buf, ht, tw);
        { const f32x2* Hd = H + (size_t)(c * 2 + 1) * 4096;
#pragma unroll
          for (int ks = 0; ks < 16; ++ks) v[ks] = cmul(v[ks], Hd[ks * 256 + ht]); }
        fft_inv(v, buf, ht, tw);
        HY_LOADRAW(1);
        __syncthreads();
        { f32x2 g[8]; hy_conv(raw, in[I_HCW], in[I_HCB][1024 + c], 1024 + c, ht, g); const float sk = in[I_HSKIP][1024 + c];
#pragma unroll
          for (int a = 0; a < 8; ++a) { const f32x2 o = g[a] * (v[a] + vin[a] * sk); const int t = 256 * a + ht;
              outT[(0 * 2048 + t) * 8 + cl] = (bf16_t)f2bf(o.x); outT[(1 * 2048 + t) * 8 + cl] = (bf16_t)f2bf(o.y); } }
        __syncthreads();
#undef HY_LOADRAW
    }
    bf16_t* HH = WSP(bf16_t, WS_HH);
#pragma unroll
    for (int q = 0; q < 8; ++q) { const int r = F.tid + 512 * q, bb = r >> 11, t = r & 2047;
        *(u32x4*)(HH + ((size_t)(b0 + bb) * SEQ + t) * HW + c0) = *(const LAS u32x4*)(outT + r * 8); }
    __syncthreads();
}

struct SchedP {
    static constexpr bool GATHER = false;
    int G, c; const char* a; const char* b; size_t astep, bstep;
    __device__ __forceinline__ bool next(int i, Unit& u) const { const int L = i * G + c; if (L >= 512) return false; pg8::decode_tile(L, 64, 8, u.pm, u.pn); u.ex = 0; return true; }
    __device__ __forceinline__ const char* a_base(const Unit& u) const { return a + (size_t)u.pm * astep; }
    __device__ __forceinline__ const char* b_base(const Unit& u) const { return b + (size_t)u.pn * bstep; }
    __device__ __forceinline__ int a_row(const Unit&, int R) const { return R; }
};
struct EpiMA {
    static constexpr bool PERM = true;
    float* T; const bf16_t* Z;
    __device__ __forceinline__ void operator()(const f32x4 (&acc)[2][2][4][2], const Unit& u, int wr, int wc, int fr, int fq) const {
        const int row0 = u.pm * 256 + wr * 64 + fr, col0 = u.pn * 256 + wc * 32 + 8 * fq;
#pragma unroll
        for (int ai = 0; ai < 2; ++ai)
#pragma unroll
            for (int m = 0; m < 4; ++m) { const size_t row = row0 + ai * 128 + m * 16;
#pragma unroll
                for (int bj = 0; bj < 2; ++bj) { const int c = col0 + bj * 128;
                    const u32x4 gz = *(const u32x4*)(Z + row * ZN + ZC_GA + c);
                    f32x4 g0 = (f32x4){sigmoidf_(bflo(gz.x)), sigmoidf_(bfhi(gz.x)), sigmoidf_(bflo(gz.y)), sigmoidf_(bfhi(gz.y))};
                    f32x4 g1 = (f32x4){sigmoidf_(bflo(gz.z)), sigmoidf_(bfhi(gz.z)), sigmoidf_(bflo(gz.w)), sigmoidf_(bfhi(gz.w))};
                    *(f32x4*)(T + row * DM + c) = acc[ai][bj][m][0] * g0; *(f32x4*)(T + row * DM + c + 4) = acc[ai][bj][m][1] * g1; } }
    }
};
struct EpiMB {
    static constexpr bool PERM = true;
    const float* T; const bf16_t* Z; bf16_t* MX;
    __device__ __forceinline__ void operator()(const f32x4 (&acc)[2][2][4][2], const Unit& u, int wr, int wc, int fr, int fq) const {
        const int row0 = u.pm * 256 + wr * 64 + fr, col0 = u.pn * 256 + wc * 32 + 8 * fq;
#pragma unroll
        for (int ai = 0; ai < 2; ++ai)
#pragma unroll
            for (int m = 0; m < 4; ++m) { const size_t row = row0 + ai * 128 + m * 16;
#pragma unroll
                for (int bj = 0; bj < 2; ++bj) { const int c = col0 + bj * 128;
                    const u32x4 gz = *(const u32x4*)(Z + row * ZN + ZC_GH + c);
                    const f32x4 t0 = *(const f32x4*)(T + row * DM + c), t1 = *(const f32x4*)(T + row * DM + c + 4);
                    f32x4 g0 = (f32x4){sigmoidf_(bflo(gz.x)), sigmoidf_(bfhi(gz.x)), sigmoidf_(bflo(gz.y)), sigmoidf_(bfhi(gz.y))};
                    f32x4 g1 = (f32x4){sigmoidf_(bflo(gz.z)), sigmoidf_(bfhi(gz.z)), sigmoidf_(bflo(gz.w)), sigmoidf_(bfhi(gz.w))};
                    const f32x4 v0 = t0 + acc[ai][bj][m][0] * g0, v1 = t1 + acc[ai][bj][m][1] * g1;
                    u32x4 w; w.x = pg8::cvt_pk_bf16(v0[0], v0[1]); w.y = pg8::cvt_pk_bf16(v0[2], v0[3]); w.z = pg8::cvt_pk_bf16(v1[0], v1[1]); w.w = pg8::cvt_pk_bf16(v1[2], v1[3]);
                    *(u32x4*)(MX + row * DM + c) = w; } }
    }
};
struct EpiWO {
    static constexpr bool PERM = false;
    float* R1; const float* x; const float* stats; const float* lng; const float* lnb; const float* mod;
    __device__ __forceinline__ void operator()(const f32x4 (&acc)[2][2][4][2], const Unit& u, int wr, int wc, int fr, int fq) const {
        const int row0 = u.pm * 256 + wr * 64 + fr, col0 = u.pn * 256 + wc * 32 + 4 * fq;
        const float* g1p = mod + (size_t)(u.pm >> 3) * 12288 + 4096;
#pragma unroll
        for (int ai = 0; ai < 2; ++ai)
#pragma unroll
            for (int m = 0; m < 4; ++m) { const size_t row = row0 + ai * 128 + m * 16; const float mean = stats[row * 2], rstd = stats[row * 2 + 1];
#pragma unroll
                for (int bj = 0; bj < 2; ++bj)
#pragma unroll
                    for (int n = 0; n < 2; ++n) { const int c = col0 + bj * 128 + n * 16;
                        const f32x4 xv = *(const f32x4*)(x + row * DM + c), g = *(const f32x4*)(lng + c), bb = *(const f32x4*)(lnb + c), g1 = *(const f32x4*)(g1p + c);
                        *(f32x4*)(R1 + row * DM + c) = ((xv - mean) * rstd * g + bb) * DN_ALPHA + g1 * acc[ai][bj][m][n]; } }
    }
};

__device__ __forceinline__ void p8_phase(Frame& F) {
    const KargP in = karg_opaque(F.in);
    const int lane = F.lane, l15 = lane & 15, g4 = lane >> 4;
    if (F.wave >= 4) return;
    const float* R1 = WSP(float, WS_R1); unsigned char* TOK = WSP(unsigned char, WS_TOK); const float* mod = WSP(float, WS_MOD);
    LAS float* pA = (LAS float*)(F.lds + F.wave * 20480);
    LAS float* pB = pA + 2048;
    LAS float* lg = pA + 4096;
    LAS int* te = (LAS int*)(lg + 576); LAS float* tw = (LAS float*)(te + 64);
    const float* wr = in[I_WR];
#pragma unroll 1
    for (int tile = F.bid + F.G * F.wave; tile < MTOK / 16; tile += F.G * 4) {
        const int bsel = (tile * 16) / SEQ; const float* mv = mod + (size_t)bsel * 12288;
#pragma unroll
        for (int j = 0; j < 8; ++j) { const int c = lane * 4 + 256 * j;
            const f32x4 g = *(const f32x4*)(in[I_LN1G] + c), bb = *(const f32x4*)(in[I_LN1B] + c), sh = *(const f32x4*)(mv + 6144 + c), sc = *(const f32x4*)(mv + 8192 + c) + 1.0f;
            *(LAS f32x4*)(pA + c) = g * sc; *(LAS f32x4*)(pB + c) = bb * sc + sh; }
        LDS_WAIT(); asm volatile("" ::: "memory");
        float my_mean = 0.f, my_rstd = 0.f;
        {
            const float* xb = R1 + (size_t)tile * 16 * DM + lane * 4;
            f32x4 v[8], vn[8];
#pragma unroll
            for (int j = 0; j < 8; ++j) v[j] = *(const f32x4*)(xb + 256 * j);
#pragma unroll 1
            for (int rr = 0; rr < 16; ++rr) {
                const float* xn = xb + (size_t)(rr < 15 ? rr + 1 : rr) * DM;
#pragma unroll
                for (int j = 0; j < 8; ++j) vn[j] = *(const f32x4*)(xn + 256 * j);
                float s = 0.f;
#pragma unroll
                for (int j = 0; j < 8; ++j) s += (v[j].x + v[j].y) + (v[j].z + v[j].w);
                const float mean = wave_sum(s) * (1.f / DM); float s2 = 0.f;
#pragma unroll
                for (int j = 0; j < 8; ++j) { v[j] = v[j] - mean; s2 += (v[j].x * v[j].x + v[j].y * v[j].y) + (v[j].z * v[j].z + v[j].w * v[j].w); }
                const float rstd = 1.f / sqrtf(wave_sum(s2) * (1.f / DM) + LN_EPS);
                if (l15 == rr) { my_mean = mean; my_rstd = rstd; }
                unsigned char* orow = TOK + (size_t)(tile * 16 + rr) * DM;
#pragma unroll
                for (int j = 0; j < 8; ++j) { const int c = lane * 4 + 256 * j;
                    const f32x4 y = v[j] * rstd * *(const LAS f32x4*)(pA + c) + *(const LAS f32x4*)(pB + c);
                    *(unsigned*)(orow + c) = pk4_fp8(y.x, y.y, y.z, y.w); }
#pragma unroll
                for (int j = 0; j < 8; ++j) v[j] = vn[j];
            }
        }
        f32x4 acc0 = (f32x4){0.f, 0.f, 0.f, 0.f}, acc1 = (f32x4){0.f, 0.f, 0.f, 0.f};
        const float* rowp = R1 + (size_t)(tile * 16 + l15) * DM + 512 * g4;
        const float* wp = wr + (size_t)(512 * g4) * 32 + l15;
        const float ra = my_rstd, rm = -my_mean * my_rstd;
        f32x4 r4 = *(const f32x4*)rowp; float w0[4], w1[4];
#pragma unroll
        for (int j = 0; j < 4; ++j) { w0[j] = wp[j * 32]; w1[j] = wp[j * 32 + 16]; }
#pragma unroll 1
        for (int s = 0; s < 512; s += 4) {
            const int sn = s + 4 < 512 ? s + 4 : s;
            const f32x4 r4n = *(const f32x4*)(rowp + sn); float w0n[4], w1n[4];
#pragma unroll
            for (int j = 0; j < 4; ++j) { w0n[j] = wp[(sn + j) * 32]; w1n[j] = wp[(sn + j) * 32 + 16]; }
            const f32x4 av = *(const LAS f32x4*)(pA + 512 * g4 + s), bv = *(const LAS f32x4*)(pB + 512 * g4 + s);
            const f32x4 tk = (r4 * ra + rm) * av + bv;
#pragma unroll
            for (int j = 0; j < 4; ++j) { acc0 = __builtin_amdgcn_mfma_f32_16x16x4f32(tk[j], w0[j], acc0, 0, 0, 0); acc1 = __builtin_amdgcn_mfma_f32_16x16x4f32(tk[j], w1[j], acc1, 0, 0, 0); }
            r4 = r4n;
#pragma unroll
            for (int j = 0; j < 4; ++j) { w0[j] = w0n[j]; w1[j] = w1n[j]; }
        }
        { const float b0 = in[I_BR][l15], b1 = in[I_BR][16 + l15];
#pragma unroll
          for (int r = 0; r < 4; ++r) { lg[(4 * g4 + r) * 33 + l15] = acc0[r] + b0; lg[(4 * g4 + r) * 33 + 16 + l15] = acc1[r] + b1; } }
        LDS_WAIT(); asm volatile("" ::: "memory");
        if (lane < 16) {
            unsigned chosen = 0u; float lv[4]; int le[4];
            for (int k = 0; k < 4; ++k) { float best = -3.4e38f; int be = 0;
                for (int e = 0; e < 32; ++e) { const float v = lg[lane * 33 + e]; if (!((chosen >> e) & 1u) && v > best) { best = v; be = e; } }
                chosen |= 1u << be; lv[k] = best; le[k] = be; }
            float ex[4], sum = 0.f;
            for (int k = 0; k < 4; ++k) { ex[k] = __expf(lv[k] - lv[0]); sum += ex[k]; }
            for (int k = 0; k < 4; ++k) { te[lane * 4 + k] = le[k]; tw[lane * 4 + k] = ex[k] / sum; }
        }
        LDS_WAIT(); asm volatile("" ::: "memory");
        { const int e = te[lane]; const float wv = tw[lane]; const int token = tile * 16 + (lane >> 2);
          const int pos = (int)__hip_atomic_fetch_add(F.ctl + CW_CNT + 64 * e, 1u, __ATOMIC_RELAXED, __HIP_MEMORY_SCOPE_AGENT);
          WSP(int, WS_TOPE)[token * 4 + (lane & 3)] = e; WSP(int, WS_TOPP)[token * 4 + (lane & 3)] = pos; WSP(float, WS_TOPW)[token * 4 + (lane & 3)] = wv;
          WSP(int, WS_RTOK)[e * POSCAP + pos] = token; }
        LDS_WAIT(); asm volatile("" ::: "memory");
    }
}

constexpr int MOE_TBL = 131072;
__device__ __forceinline__ void moe_table(Frame& F) {
    LAS int* tst = (LAS int*)(F.lds + MOE_TBL); LAS int* cn = (LAS int*)(F.lds + MOE_TBL + 256);
    __syncthreads();
    if (F.tid < 64) {
        const int e = F.tid & 31; const int c = (int)__hip_atomic_load(F.ctl + CW_CNT + 64 * e, __ATOMIC_RELAXED, __HIP_MEMORY_SCOPE_AGENT);
        int inc = (c + 255) >> 8;
#pragma unroll
        for (int o = 1; o < 32; o <<= 1) { const int t = __shfl_up(inc, o); if ((F.tid & 31) >= o) inc += t; }
        if (F.tid < 32) { cn[e] = c; tst[e] = inc - ((c + 255) >> 8); if (e == 31) tst[NEXP] = inc; } }
    __syncthreads();
}
template <bool GU> struct SchedMoE {
    static constexpr bool GATHER = GU;
    int G, c, NT; const LAS int* tst; const LAS int* cn; const int* rtok; const char* a; const char* b;
    __device__ __forceinline__ bool next(int i, Unit& u) const {
        const int nwg = __builtin_amdgcn_readfirstlane(tst[NEXP]) * NT; const int L = i * G + c; if (L >= nwg) return false;
        int wg; { const int q = nwg / 8, r = nwg % 8, xcd = L % 8, off = L / 8; wg = (xcd < r ? xcd * (q + 1) : r * (q + 1) + (xcd - r) * q) + off; }
        int e = 0;
#pragma unroll 1
        for (int k = 1; k < NEXP; ++k) { const int s = __builtin_amdgcn_readfirstlane(tst[k]); if (wg >= s * NT) e = k; }
        const int ts = __builtin_amdgcn_readfirstlane(tst[e]), ts1 = __builtin_amdgcn_readfirstlane(tst[e + 1]);
        const int rem = wg - ts * NT, ne = ts1 - ts;
        u.pm = ts + rem % ne; u.pn = rem / ne; u.ex = e; return true;
    }
    __device__ __forceinline__ const char* a_base(const Unit& u) const { return GU ? a : a + (size_t)u.pm * 256 * DM; }
    __device__ __forceinline__ const char* b_base(const Unit& u) const { return b + ((size_t)u.ex * (GU ? 4096 : 2048) + 256 * u.pn) * DM; }
    __device__ __forceinline__ int a_row(const Unit& u, int R) const { const int cnt = __builtin_amdgcn_readfirstlane(cn[u.ex]), t0 = __builtin_amdgcn_readfirstlane(tst[u.ex]); int pos = (u.pm - t0) * 256 + R; pos = pos < cnt ? pos : cnt - 1; return rtok[u.ex * POSCAP + pos]; }
};
struct EpiGU {
    static constexpr bool PERM = true;
    unsigned char* ACT; const float* bg; const float* bu;
    __device__ __forceinline__ void operator()(const f32x4 (&acc)[2][2][4][2], const Unit& u, int wr, int wc, int fr, int fq) const {
        const int row0 = u.pm * 256 + wr * 64 + fr, col0 = u.pn * 128 + wc * 32 + 8 * fq;
        const float* bgp = bg + (size_t)u.ex * DM + col0; const float* bup = bu + (size_t)u.ex * DM + col0;
        const f32x4 g0 = *(const f32x4*)bgp, g1 = *(const f32x4*)(bgp + 4), u0 = *(const f32x4*)bup, u1 = *(const f32x4*)(bup + 4);
#pragma unroll
        for (int ai = 0; ai < 2; ++ai)
#pragma unroll
            for (int m = 0; m < 4; ++m) { const size_t row = row0 + ai * 128 + m * 16;
                float o[8];
#pragma unroll
                for (int n = 0; n < 2; ++n)
#pragma unroll
                    for (int j = 0; j < 4; ++j) { const float gv = fminf(acc[ai][0][m][n][j] + (n ? g1[j] : g0[j]), 7.0f);
                        const float uv = fminf(fmaxf(acc[ai][1][m][n][j] + (n ? u1[j] : u0[j]), -7.0f), 7.0f);
                        o[n * 4 + j] = 4.0f * gv * sigmoidf_(1.702f * gv) * (uv + 1.0f); }
                u32x2 w; w.x = pk4_fp8(o[0], o[1], o[2], o[3]); w.y = pk4_fp8(o[4], o[5], o[6], o[7]);
                *(u32x2*)(ACT + row * DM + col0) = w; }
    }
};
struct EpiDN {
    static constexpr bool PERM = true;
    bf16_t* YR; const float* bd;
    __device__ __forceinline__ void operator()(const f32x4 (&acc)[2][2][4][2], const Unit& u, int wr, int wc, int fr, int fq) const {
        const int r0 = wr * 64 + fr, col0 = u.pn * 256 + wc * 32 + 8 * fq;
        const float* bp = bd + (size_t)u.ex * DM + col0;
        bf16_t* base = YR + ((size_t)u.pm * 256 + r0) * DM + col0;
#pragma unroll
        for (int bj = 0; bj < 2; ++bj) {
            const f32x4 bv0 = *(const f32x4*)(bp + bj * 128), bv1 = *(const f32x4*)(bp + bj * 128 + 4);
#pragma unroll
            for (int ai = 0; ai < 2; ++ai)
#pragma unroll
                for (int m = 0; m < 4; ++m) {
                    const f32x4 v0 = acc[ai][bj][m][0] + bv0, v1 = acc[ai][bj][m][1] + bv1;
                    u32x4 w; w.x = pg8::cvt_pk_bf16(v0[0], v0[1]); w.y = pg8::cvt_pk_bf16(v0[2], v0[3]); w.z = pg8::cvt_pk_bf16(v1[0], v1[1]); w.w = pg8::cvt_pk_bf16(v1[2], v1[3]);
                    *(u32x4*)(base + (size_t)(ai * 128 + m * 16) * DM + bj * 128) = w; }
        }
    }
};

__device__ __forceinline__ void p11_phase(Frame& F) {
    const KargP in = karg_opaque(F.in);
    const int gw = F.bid * NWAVES + F.wave, NGW = F.G * NWAVES, lane = F.lane;
    const LAS int* tst = (const LAS int*)(F.lds + MOE_TBL);
    const float* R1 = WSP(float, WS_R1); const bf16_t* YR = WSP(bf16_t, WS_YR); const float* mod = WSP(float, WS_MOD);
    LAS float* pl = (LAS float*)F.lds;
    for (int i = F.tid; i < 2048; i += NTHR) { pl[i] = in[I_LN1G][i]; pl[2048 + i] = in[I_LN1B][i]; pl[4096 + i] = in[I_LN2G][i]; pl[6144 + i] = in[I_LN2B][i]; }
    for (int i = F.tid; i < 8 * 2048; i += NTHR) pl[8192 + i] = mod[(size_t)(i >> 11) * 12288 + 10240 + (i & 2047)];
    __syncthreads();
    LAS int* sd = (LAS int*)(F.lds + 98304 + F.wave * 512); LAS float* sw = (LAS float*)(F.lds + 98304 + F.wave * 512 + 256);
#pragma unroll 1
    for (int rb = gw * 8; rb < MTOK; rb += NGW * 8) {
        const int li = lane & 31;
        { const int ve = WSP(int, WS_TOPE)[rb * 4 + li], vp = WSP(int, WS_TOPP)[rb * 4 + li]; const float vw = WSP(float, WS_TOPW)[rb * 4 + li];
          if (lane < 32) { sd[li] = tst[ve] * 256 + vp; sw[li] = vw; } }
        const LAS float* g2p = pl + 8192 + (rb / SEQ) * 2048;
        LDS_WAIT(); asm volatile("" ::: "memory");
#pragma unroll 1
        for (int ri = 0; ri < 8; ++ri) {
            const int row = rb + ri;
            int dest[4]; float wk[4];
#pragma unroll
            for (int k = 0; k < 4; ++k) { dest[k] = __builtin_amdgcn_readfirstlane(sd[ri * 4 + k]); wk[k] = __builtin_bit_cast(float, __builtin_amdgcn_readfirstlane(__builtin_bit_cast(int, sw[ri * 4 + k]))); }
            const float* xr = R1 + (size_t)row * DM + lane * 4;
            f32x4 v[8]; u32x2 yy[4][8];
#pragma unroll
            for (int j = 0; j < 8; ++j) v[j] = *(const f32x4*)(xr + 256 * j);
#pragma unroll
            for (int k = 0; k < 4; ++k) { const bf16_t* yp = YR + (size_t)dest[k] * DM + lane * 4;
#pragma unroll
                for (int j = 0; j < 8; ++j) yy[k][j] = *(const u32x2*)(yp + 256 * j); }
            float s = 0.f;
#pragma unroll
            for (int j = 0; j < 8; ++j) s += (v[j].x + v[j].y) + (v[j].z + v[j].w);
            float mean = wave_sum(s) * (1.f / DM); float s2 = 0.f;
#pragma unroll
            for (int j = 0; j < 8; ++j) { v[j] = v[j] - mean; s2 += (v[j].x * v[j].x + v[j].y * v[j].y) + (v[j].z * v[j].z + v[j].w * v[j].w); }
            float rstd = 1.f / sqrtf(wave_sum(s2) * (1.f / DM) + LN_EPS);
            s = 0.f;
#pragma unroll
            for (int j = 0; j < 8; ++j) { const int c = lane * 4 + 256 * j;
                const f32x4 g = *(const LAS f32x4*)(pl + c), bb = *(const LAS f32x4*)(pl + 2048 + c), g2v = *(const LAS f32x4*)(g2p + c);
                f32x4 y = (f32x4){0.f, 0.f, 0.f, 0.f};
#pragma unroll
                for (int k = 0; k < 4; ++k) y += (f32x4){bflo(yy[k][j].x), bfhi(yy[k][j].x), bflo(yy[k][j].y), bfhi(yy[k][j].y)} * wk[k];
                v[j] = (v[j] * rstd * g + bb) * DN_ALPHA + g2v * y;
                s += (v[j].x + v[j].y) + (v[j].z + v[j].w); __builtin_amdgcn_sched_barrier(0); }
            mean = wave_sum(s) * (1.f / DM); s2 = 0.f;
#pragma unroll
            for (int j = 0; j < 8; ++j) { v[j] = v[j] - mean; s2 += (v[j].x * v[j].x + v[j].y * v[j].y) + (v[j].z * v[j].z + v[j].w * v[j].w); }
            rstd = 1.f / sqrtf(wave_sum(s2) * (1.f / DM) + LN_EPS);
            float* orow = F.out + (size_t)row * DM;
#pragma unroll
            for (int j = 0; j < 8; ++j) { const int c = lane * 4 + 256 * j;
                const f32x4 g = *(const LAS f32x4*)(pl + 4096 + c), bb = *(const LAS f32x4*)(pl + 6144 + c);
                *(f32x4*)(orow + c) = v[j] * rstd * g + bb; }
        }
        LDS_WAIT(); asm volatile("" ::: "memory");
    }
}

constexpr int NPHASE = 13;
__global__ void __launch_bounds__(NTHR, 2) mk_fwd(Args args) {
    extern __shared__ __attribute__((aligned(16))) unsigned char lds_raw[];
    Frame F;
    F.lds = (LAS unsigned char*)lds_raw;
    F.MISC = (volatile LAS unsigned*)(F.lds + MISC_OFF);
    F.tid = threadIdx.x; F.lane = F.tid & 63; F.wave = __builtin_amdgcn_readfirstlane(F.tid >> 6);
    F.G = gridDim.x; F.bid = blockIdx.x;
    F.in = (KargP)__builtin_amdgcn_kernarg_segment_ptr(); F.out = args.out; F.ws = args.ws; F.ctl = (unsigned*)(args.ws + WS_CTL);
    for (int u = F.tid; u < (LDS_BYTES - MISC_OFF) / 4; u += NTHR) ((LAS unsigned*)(F.lds + MISC_OFF))[u] = 0u;
    __syncthreads();
    XcdBarrier bar; bar.bar = F.ctl + CW_BAR; bar.x = 0; bar.st = nullptr;
    if (MK_LAUNCHES == 1) bar = xcd_barrier_post(F.ctl + CW_BAR, F.MISC + 8);
    const int lo = args.ph_lo, hi = args.ph_hi;
#ifndef PH_MASK
#define PH_MASK 0xFFFF
#endif
#define RELOAD() do { const KargP k_ = karg_opaque(F.in); F.out = (float*)k_[38]; F.ws = (unsigned char*)k_[39]; F.ctl = (unsigned*)F.ws; int t_ = threadIdx.x; asm volatile("" : "+v"(t_)); F.tid = t_; F.lane = t_ & 63; F.wave = __builtin_amdgcn_readfirstlane(t_ >> 6); } while (0)
#define IN(k) (((PH_MASK >> (k)) & 1) && lo <= (k) && (k) < hi)
#define SEAM(k) do { if (IN(k) && IN((k) + 1)) xcd_barrier(bar); } while (0)
#ifndef DUP_MASK
#define DUP_MASK 0
#endif
#define REP(k) for (int rep_ = 0; rep_ < (((DUP_MASK >> (k)) & 1) ? 2 : 1); ++rep_)
    if (IN(0)) REP(0) p0_phase(F);
    SEAM(0);
    RELOAD();
    if (IN(1)) REP(1) p0b_phase(F);
    SEAM(1);
    RELOAD();
    if (IN(2)) REP(2) p1_phase(F);
    SEAM(2);
    RELOAD();
    if (IN(3)) REP(3) {
        EpiZ E{WSP(bf16_t, WS_Z), WSP(bf16_t, WS_ZT), WSP(float, WS_BINP)};
        { SchedZ<false> S{F.G, F.bid, (const char*)WSP(bf16_t, WS_HX), (const char*)WSP(bf16_t, WS_WIN)};
          pg8::gemm_phase<EpiZ, SchedZ<false>>(F.lds, DM / 64, DM * 2, DM * 2, S, E); }
        { SchedZ<true> S{F.G, F.G - 1 - F.bid, (const char*)WSP(unsigned char, WS_HX8), (const char*)WSP(unsigned char, WS_WIN8)};
          pg8::gemm_phase<EpiZ, SchedZ<true>, true>(F.lds, DM / 128, DM, DM, S, E, 0x7A7A7A7A, 0x7F7F7F7F); }
    }
    SEAM(3);
    RELOAD();
    if (IN(4)) REP(4) p3_phase(F);
    SEAM(4);
    RELOAD();
    if (IN(5)) {
        SchedQK S{F.G, F.bid, (const char*)WSP(bf16_t, WS_U), (const char*)WSP(bf16_t, WS_WQK)};
        EpiQK E{WSP(bf16_t, WS_QKB)};
        pg8::gemm_phase<EpiQK, SchedQK>(F.lds, 256 / 64, MW * 2, 256 * 2, S, E);
    }
    SEAM(5);
    RELOAD();
    if (IN(6)) REP(6) {
#ifndef DUP_ML
#define DUP_ML 1
#endif
#ifndef DUP_HY
#define DUP_HY 1
#endif
        for (int un = F.bid; un < 256 * DUP_ML; un += F.G) mlstm_unit(F, un & 255);
        for (int un = F.bid; un < 512 * DUP_HY; un += F.G) hyena_unit(F, un & 511);
    }
    SEAM(6);
    RELOAD();
    if (IN(7)) REP(7) {
        { SchedP S{F.G, F.bid, (const char*)WSP(bf16_t, WS_AM), (const char*)WSP(bf16_t, WS_WPA2), (size_t)256 * 2048 * 2, (size_t)256 * 2048 * 2};
          EpiMA E{WSP(float, WS_T), WSP(bf16_t, WS_Z)};
          pg8::gemm_phase<EpiMA, SchedP>(F.lds, 2048 / 64, 2048 * 2, 2048 * 2, S, E); }
        VM_WAIT(); __syncthreads();
        { SchedP S{F.G, F.bid, (const char*)WSP(bf16_t, WS_HH), (const char*)WSP(bf16_t, WS_WPH), (size_t)256 * 1024 * 2, (size_t)256 * 1024 * 2};
          EpiMB E{WSP(float, WS_T), WSP(bf16_t, WS_Z), WSP(bf16_t, WS_MX)};
          pg8::gemm_phase<EpiMB, SchedP>(F.lds, 1024 / 64, 1024 * 2, 1024 * 2, S, E); }
    }
    SEAM(7);
    RELOAD();
    if (IN(8)) {
        SchedP S{F.G, F.bid, (const char*)WSP(bf16_t, WS_MX), (const char*)WSP(bf16_t, WS_WOUT), (size_t)256 * 2048 * 2, (size_t)256 * 2048 * 2};
        const KargP in = karg_opaque(F.in); EpiWO E{WSP(float, WS_R1), in[I_X], WSP(float, WS_STATS), in[I_LNG], in[I_LNB], WSP(float, WS_MOD)};
        pg8::gemm_phase<EpiWO, SchedP>(F.lds, 2048 / 64, 2048 * 2, 2048 * 2, S, E);
    }
    SEAM(8);
    RELOAD();
    if (IN(9)) p8_phase(F);
    SEAM(9);
    RELOAD();
    if (IN(10)) REP(10) {
        moe_table(F);
        SchedMoE<true> S{F.G, F.bid, 16, (const LAS int*)(F.lds + MOE_TBL), (const LAS int*)(F.lds + MOE_TBL + 256), WSP(int, WS_RTOK), (const char*)WSP(bf16_t, WS_TOK), (const char*)WSP(bf16_t, WS_WGU)};
        const KargP in = karg_opaque(F.in); EpiGU E{WSP(unsigned char, WS_ACT), in[I_BG], in[I_BU]};
        pg8::gemm_phase<EpiGU, SchedMoE<true>, true>(F.lds, DM / 128, DM, DM, S, E, 0x7A7A7A7A, 0x7F7F7F7F);
    }
    SEAM(10);
    RELOAD();
    if (IN(11)) REP(11) {
        moe_table(F);
        SchedMoE<false> S{F.G, F.bid, 8, (const LAS int*)(F.lds + MOE_TBL), (const LAS int*)(F.lds + MOE_TBL + 256), WSP(int, WS_RTOK), (const char*)WSP(bf16_t, WS_ACT), (const char*)WSP(bf16_t, WS_WD)};
        const KargP in = karg_opaque(F.in); EpiDN E{WSP(bf16_t, WS_YR), in[I_BDN]};
        pg8::gemm_phase<EpiDN, SchedMoE<false>, true>(F.lds, DM / 128, DM, DM, S, E, 0x79797979, 0x7D7D7D7D);
    }
    SEAM(11);
    RELOAD();
    if (IN(12)) REP(12) { moe_table(F); p11_phase(F); }
#undef IN
#undef SEAM
}

extern "C" void kernel_launch(void* const* d_in, const int* in_sizes, int n_in, void* d_out, int out_size, void* d_ws, size_t ws_size, hipStream_t stream) {
    static int grid = 0;
    if (grid == 0) {
        if (n_in != 38 || out_size != MTOK * DM || ws_size < WS_END) { fprintf(stderr, "kernel_launch: unexpected shapes: n_in %d out %d ws %zu (need %zu)\n", n_in, out_size, ws_size, (size_t)WS_END); grid = -1; return; }
        int dev = 0, cus = 0, per_cu = 0;
        if (hipGetDevice(&dev) != hipSuccess || hipDeviceGetAttribute(&cus, hipDeviceAttributeMultiprocessorCount, dev) != hipSuccess) { grid = -1; return; }
        if (hipFuncSetAttribute((const void*)mk_fwd, hipFuncAttributeMaxDynamicSharedMemorySize, LDS_BYTES) != hipSuccess) { fprintf(stderr, "kernel_launch: hipFuncSetAttribute failed\n"); grid = -1; return; }
        if (hipOccupancyMaxActiveBlocksPerMultiprocessor(&per_cu, (const void*)mk_fwd, NTHR, LDS_BYTES) != hipSuccess || per_cu < 1) fprintf(stderr, "kernel_launch: occupancy query says %d\n", per_cu);
        (void)hipGetLastError();
        grid = cus;
    }
    if (grid < 0) return;
    (void)hipMemsetAsync((char*)d_ws + WS_CTL, 0, CTL_ZERO_BYTES, stream);
    Args a{};
    for (int i = 0; i < 38; ++i) a.in[i] = (const float*)d_in[i];
    a.out = (float*)d_out; a.ws = (unsigned char*)d_ws;
#if MK_LAUNCHES == 1
    a.ph_lo = 0; a.ph_hi = NPHASE;
    hipLaunchKernelGGL(mk_fwd, dim3(grid), dim3(NTHR), LDS_BYTES, stream, a);
#else
    for (int p = 0; p < NPHASE; ++p) { a.ph_lo = p; a.ph_hi = p + 1; hipLaunchKernelGGL(mk_fwd, dim3(grid), dim3(NTHR), LDS_BYTES, stream, a); }
#endif
}
```

```cpp
#include <hip/hip_runtime.h>
#include <cstdio>
#include <cstdint>

#define GAS __attribute__((address_space(1)))
#define LAS __attribute__((address_space(3)))
typedef unsigned short bf16_t;
typedef short bf16x8 __attribute__((ext_vector_type(8)));
typedef float f32x4 __attribute__((ext_vector_type(4)));
typedef float f32x2 __attribute__((ext_vector_type(2)));
typedef unsigned u32x4 __attribute__((ext_vector_type(4)));
typedef unsigned u32x2 __attribute__((ext_vector_type(2)));

#ifndef MK_LAUNCHES
#define MK_LAUNCHES 1
#endif

constexpr int DM = 2048, NB = 8, SEQ = 2048, CTX = 256, GW = 64;
constexpr int MTOK = NB * SEQ;
constexpr int MCTX = NB * CTX;
constexpr int MALL = MTOK + MCTX;
constexpr int NH = 4, HD = 256, MW = 1024, HW = 1024;
constexpr int N_IN = 10256;
constexpr int NEXP = 32, TOPK = 4;
constexpr float LN_EPS = 1e-5f;
constexpr float DN_ALPHA = 1.189207115002721f;
constexpr int ZN = 7424, ZC_QK = 0, ZC_V = 1024, ZC_O = 2048, ZC_GA = 3072, ZC_GH = 5120, ZC_GT = 7168;
constexpr int WIN_ROWS = 10496, WIN_HY0 = 7424;
constexpr int MAXTILES = 288;
constexpr int POSCAP = 16384;

constexpr size_t MiB = 1u << 20;
constexpr size_t WS_CTL = 0;
constexpr size_t WS_MODP = 1 * MiB;
constexpr size_t WS_MOD = 9 * MiB;
constexpr size_t WS_BINP = 10 * MiB;
constexpr size_t WS_A3 = 10 * MiB + 64 * 1024;
constexpr size_t WS_STATS = 11 * MiB;
constexpr size_t WS_TOPE = 11 * MiB + 256 * 1024;
constexpr size_t WS_TOPP = 11 * MiB + 512 * 1024;
constexpr size_t WS_TOPW = 11 * MiB + 768 * 1024;
constexpr size_t WS_RTOK = 12 * MiB;
constexpr size_t WS_RW = 14 * MiB;
constexpr size_t WS_WQK = 16 * MiB;
constexpr size_t WS_WPH = 17 * MiB;
constexpr size_t WS_WPA2 = 21 * MiB;
constexpr size_t WS_WOUT = 29 * MiB;
constexpr size_t WS_WIN = 37 * MiB;
constexpr size_t WS_WGU = 78 * MiB;
constexpr size_t WS_WD = 590 * MiB;
constexpr size_t WS_RA = 846 * MiB;
constexpr size_t WS_Z = WS_RA, WS_ZT = WS_RA + 261 * MiB, WS_ACT = WS_RA;
constexpr size_t WS_RB = 1203 * MiB;
constexpr size_t WS_HX = WS_RB, WS_U = WS_RB + 72 * MiB, WS_QKB = WS_RB + 108 * MiB, WS_AM = WS_RB + 180 * MiB, WS_HH = WS_RB + 244 * MiB, WS_MX = WS_RB + 276 * MiB, WS_YR = WS_RB;
constexpr size_t WS_RC = 1543 * MiB;
constexpr size_t WS_HTAPS = WS_RC, WS_H = WS_RC + 32 * MiB, WS_T = WS_RC;
constexpr size_t WS_R1 = 1671 * MiB;
constexpr size_t WS_TOK = 1799 * MiB;
constexpr size_t WS_HX8 = WS_RC + 96 * MiB;
constexpr size_t WS_WIN8 = 1863 * MiB;
constexpr size_t WS_END = 1884 * MiB;
constexpr int CW_TMO = 0, CW_BAR = 4096, CW_CNT = 16384;
constexpr size_t CTL_ZERO_BYTES = 1 * MiB;

constexpr int LDS_BYTES = 160 * 1024 - 2048;
constexpr int MISC_OFF = LDS_BYTES - 1024;
constexpr int NWAVES = 8, NTHR = 512;

#define LDS_WAIT() asm volatile("s_waitcnt lgkmcnt(0)" ::: "memory")
#define VM_WAIT() asm volatile("s_waitcnt vmcnt(0)" ::: "memory")
__device__ __forceinline__ unsigned f2bf(float f) { unsigned u = __builtin_bit_cast(unsigned, f); return (u + 0x7fffu + ((u >> 16) & 1u)) >> 16; }
__device__ __forceinline__ unsigned pk2(float lo, float hi) { return f2bf(lo) | (f2bf(hi) << 16); }
__device__ __forceinline__ unsigned pk4_fp8(float a, float b, float c, float d) { int w = 0; w = __builtin_amdgcn_cvt_pk_fp8_f32(a, b, w, false); w = __builtin_amdgcn_cvt_pk_fp8_f32(c, d, w, true); return (unsigned)w; }
__device__ __forceinline__ float bf2f(unsigned b) { return __builtin_bit_cast(float, b << 16); }
__device__ __forceinline__ float bflo(unsigned w) { return __builtin_bit_cast(float, w << 16); }
__device__ __forceinline__ float bfhi(unsigned w) { return __builtin_bit_cast(float, w & 0xffff0000u); }
__device__ __forceinline__ float sigmoidf_(float x) { return 1.0f / (1.0f + __expf(-x)); }
__device__ __forceinline__ float wave_sum(float v) {
#pragma unroll
    for (int o = 1; o < 64; o <<= 1) v += __shfl_xor(v, o);
    return v;
}

#define XB_TMO      128
#define XB_XCNT(j)  (256  + 64 * (j))
#define XB_XSUB(j)  (1280 + 64 * (j))
#define XB_XGEN(j)  (2304 + 64 * (j))
#define XB_TOP      3328
#define XB_TOPGEN   3392
#define XCD_BAR_WORDS 3456
#define XB_SPIN_CAP (1u << 22)
__device__ __forceinline__ unsigned xb_ld(unsigned* p)              { return __hip_atomic_load(p, __ATOMIC_RELAXED, __HIP_MEMORY_SCOPE_AGENT); }
__device__ __forceinline__ unsigned xb_add(unsigned* p, unsigned v) { return __hip_atomic_fetch_add(p, v, __ATOMIC_RELAXED, __HIP_MEMORY_SCOPE_AGENT); }
__device__ __forceinline__ unsigned xb_xcc_id() { return (unsigned)__builtin_amdgcn_s_getreg((3 << 11) | 20) & 0xFu; }
#define XB_SPIN(cond, bar) do { unsigned _sp = 0; while (cond) { __builtin_amdgcn_s_sleep(1); \
    if ((++_sp & 255u) == 0u) { if (xb_ld(&(bar)[XB_TMO])) break; if (_sp > XB_SPIN_CAP) { atomicAdd(&(bar)[XB_TMO], 1u); break; } } } } while (0)
struct XcdBarrier { unsigned* bar; unsigned x; volatile LAS unsigned* st; };
__device__ __forceinline__ XcdBarrier xcd_barrier_post(unsigned* bar, volatile LAS unsigned* st) {
    XcdBarrier b; b.bar = bar; b.x = xb_xcc_id(); b.st = st;
    if (threadIdx.x == 0) (void)xb_add(&bar[XB_XCNT(b.x)], 1u);
    return b;
}
__device__ __forceinline__ void xcd_barrier_complete(unsigned* bar, unsigned x, unsigned& nloc, unsigned& nx) {
    const unsigned G = gridDim.x * gridDim.y * gridDim.z;
    unsigned sum, cnt, mine, sp = 0u;
    for (;;) {
        sum = 0u; cnt = 0u; mine = 0u;
#pragma unroll
        for (unsigned j = 0; j < 16; ++j) { const unsigned c = xb_ld(&bar[XB_XCNT(j)]); sum += c; cnt += (c > 0u) ? 1u : 0u; mine = (j == x) ? c : mine; }
        if (sum == G) break;
        __builtin_amdgcn_s_sleep(1);
        if ((++sp & 255u) == 0u) { if (xb_ld(&bar[XB_TMO])) break; if (sp > XB_SPIN_CAP) { atomicAdd(&bar[XB_TMO], 1u); break; } }
    }
    nloc = mine > 0u ? mine : 1u; nx = cnt > 0u ? cnt : 1u;
}
__device__ __forceinline__ void xcd_barrier(const XcdBarrier& b) {
    asm volatile("s_waitcnt vmcnt(0)" ::: "memory");
    __syncthreads();
    if (threadIdx.x == 0) {
        unsigned* bar = b.bar;
        __builtin_amdgcn_s_waitcnt(0);
        unsigned nloc = b.st[0], nx = b.st[1];
        if (nloc == 0u) { xcd_barrier_complete(bar, b.x, nloc, nx); b.st[0] = nloc; b.st[1] = nx; }
        const unsigned old = xb_add(&bar[XB_XSUB(b.x)], 1u);
        const unsigned gen = old / nloc;
        if (old + 1u == (gen + 1u) * nloc) {
            __builtin_amdgcn_fence(__ATOMIC_RELEASE, "agent");
            asm volatile("s_waitcnt vmcnt(0)" ::: "memory");
            const unsigned og = xb_add(&bar[XB_TOP], 1u);
            const unsigned tg = og / nx;
            if (og + 1u == (tg + 1u) * nx) xb_add(&bar[XB_TOPGEN], 1u);
            else XB_SPIN(xb_ld(&bar[XB_TOPGEN]) == tg, bar);
            __builtin_amdgcn_fence(__ATOMIC_ACQUIRE, "agent");
            xb_add(&bar[XB_XGEN(b.x)], 1u);
            asm volatile("s_waitcnt vmcnt(0)" ::: "memory");
        } else {
            XB_SPIN(xb_ld(&bar[XB_XGEN(b.x)]) == gen, bar);
            __builtin_amdgcn_fence(__ATOMIC_ACQUIRE, "agent");
            asm volatile("s_waitcnt vmcnt(0)" ::: "memory");
        }
    }
    __syncthreads();
}

struct Args {
    const float* in[38];
    float* out; unsigned char* ws;
    int ph_lo, ph_hi;
};
enum { I_X = 0, I_C, I_CTX, I_CCTX, I_LNG, I_LNB, I_WMOD, I_BMOD, I_WIN, I_BIN, I_MCW, I_MCB, I_WQH, I_WKH, I_HCW, I_HCB, I_FW1, I_FB1, I_FWH, I_FBH,
       I_FFREQ, I_FWOUT, I_HSKIP, I_WPA, I_WPH, I_WOUT, I_LN1G, I_LN1B, I_WR, I_BR, I_WG, I_BG, I_WU, I_BU, I_WDN, I_BDN, I_LN2G, I_LN2B };

namespace pg8 {
constexpr int BM = 256, BK = 64, HALF = 128, HTB = HALF * BK * 2, STAGE_BYTES = 8 * HTB, NXCD = 8, WGM = 8;
__host__ __device__ __forceinline__ int lds_byte(int r, int c) { const int st = (r >> 4) * 2 + (c >> 5), rr = r & 15, cc = c & 31, ob = rr * 64 + cc * 2; return st * 1024 + (ob ^ (((ob >> 9) & 1) << 5)); }
__host__ __device__ __forceinline__ void stage_rc(int b, int& R, int& C) { const int st = b / 1024, sb = b % 1024, swz = sb ^ (((sb >> 9) & 1) << 5); R = (st >> 1) * 16 + swz / 64; C = (st & 1) * 32 + (swz % 64) / 2; }
__host__ __device__ __forceinline__ int perm32(int rho) { const int n = rho >> 4, i = rho & 15; return 8 * (i >> 2) + 4 * n + (i & 3); }
struct Unit { int pm, pn, ex; };
__device__ __forceinline__ void decode_tile(int L, int nM, int nN, int& pm, int& pn) {
    const int nwg = nM * nN; int wgid = L;
    { const int q = nwg / NXCD, r = nwg % NXCD, xcd = wgid % NXCD, off = wgid / NXCD; wgid = (xcd < r ? xcd * (q + 1) : r * (q + 1) + (xcd - r) * q) + off; }
    const int nig = WGM * nN, gid = wgid / nig, fm = gid * WGM, gsz = (nM - fm) < WGM ? (nM - fm) : WGM;
    pm = fm + ((wgid % nig) % gsz); pn = (wgid % nig) / gsz;
}
__device__ __forceinline__ unsigned cvt_pk_bf16(float lo, float hi) { unsigned r; asm volatile("v_cvt_pk_bf16_f32 %0, %1, %2" : "=v"(r) : "v"(lo), "v"(hi)); return r; }

typedef int i32x8 __attribute__((ext_vector_type(8)));
template <class Epi, class Sched, bool F8 = false>
__device__ __forceinline__ void gemm_phase(LAS unsigned char* lds, const int nt, const int pitchA, const int pitchB, const Sched& S, const Epi& E, const int wscale = 0x7F7F7F7F, const int ascale = 0x7F7F7F7F) {
    const int tid = threadIdx.x, wid = __builtin_amdgcn_readfirstlane(tid >> 6), lane = tid & 63, wr = wid >> 2, wc = wid & 3, fr = lane & 15, fq = lane >> 4;
    int RA[2], CA[2]; unsigned voffB[2];
#pragma unroll
    for (int i = 0; i < 2; ++i) { int R, C; stage_rc(tid * 16 + i * 8192, R, C); const int Rb = Epi::PERM ? ((R & ~31) + perm32(R & 31)) : R;
        RA[i] = R; CA[i] = C; voffB[i] = (unsigned)(Rb * pitchB + C * 2); }
    const size_t kstep = (size_t)(BK * 2);
    const size_t hstepB = (size_t)HALF * pitchB;
    const unsigned ldsw = (unsigned)wid * 1024u;
    const int aoff = lds_byte(wr * 64 + fr, fq * 8), boff = lds_byte(wc * 32 + fr, fq * 8);
#define PG8_SA(b, h) (((b) * 2 + (h)) * HTB)
#define PG8_SB(b, h) ((4 + (b) * 2 + (h)) * HTB)
#define PG8_STAGE(bufoff, gbase, v0, v1) do { \
        __builtin_amdgcn_global_load_lds((const unsigned*)((const char*)(gbase) + (v0)), (LAS unsigned*)(lds + (bufoff) + ldsw), 16, 0, 0); \
        __builtin_amdgcn_global_load_lds((const unsigned*)((const char*)(gbase) + (v1)), (LAS unsigned*)(lds + (bufoff) + ldsw + 8192), 16, 0, 0); } while (0)
#define PG8_LD8(off) __builtin_bit_cast(i32x8, __builtin_shufflevector(*(const LAS u32x4*)(lds + (off)), *(const LAS u32x4*)(lds + (off) + 1024), 0, 1, 2, 3, 4, 5, 6, 7))
#define PG8_LDA(dst, b, h) do { _Pragma("unroll") for (int m = 0; m < 4; ++m) { if (F8) dst##8[m] = PG8_LD8(PG8_SA(b, h) + aoff + m * 2048); else { _Pragma("unroll") for (int k = 0; k < 2; ++k) dst[m][k] = *(const LAS bf16x8*)(lds + PG8_SA(b, h) + aoff + m * 2048 + k * 1024); } } } while (0)
#define PG8_LDB(dst, b, h) do { _Pragma("unroll") for (int n = 0; n < 2; ++n) { if (F8) dst##8[n] = PG8_LD8(PG8_SB(b, h) + boff + n * 2048); else { _Pragma("unroll") for (int k = 0; k < 2; ++k) dst[n][k] = *(const LAS bf16x8*)(lds + PG8_SB(b, h) + boff + n * 2048 + k * 1024); } } } while (0)
#define PG8_CAT(x) __builtin_shufflevector(__builtin_bit_cast(u32x4, x[0]), __builtin_bit_cast(u32x4, x[1]), 0, 1, 2, 3, 4, 5, 6, 7)
#define PG8_MMA(ai, bj, At, Bt) do { __builtin_amdgcn_s_setprio(1); _Pragma("unroll") for (int m = 0; m < 4; ++m) _Pragma("unroll") for (int n = 0; n < 2; ++n) { \
        if (F8) { asm volatile("v_mfma_scale_f32_16x16x128_f8f6f4 %0, %1, %2, %0, %3, %4 op_sel_hi:[0,0,0]" : "+v"(acc[ai][bj][m][n]) : "v"(Bt##8[n]), "v"(At##8[m]), "v"(wscale), "v"(ascale)); } \
        else { _Pragma("unroll") for (int k = 0; k < 2; ++k) acc[ai][bj][m][n] = __builtin_amdgcn_mfma_f32_16x16x32_bf16(Bt[n][k], At[m][k], acc[ai][bj][m][n], 0, 0, 0); } } __builtin_amdgcn_s_setprio(0); } while (0)
#define PG8_WAIT_V(n) asm volatile("s_waitcnt vmcnt(" #n ")" ::: "memory")
#define PG8_WAIT_L(n) asm volatile("s_waitcnt lgkmcnt(" #n ")" ::: "memory")
#define PG8_BAR __builtin_amdgcn_s_barrier()
#define PG8_SCHED __builtin_amdgcn_sched_barrier(0)
#define PG8_AOFF(u, o00, o01, o10, o11) do { \
        if (Sched::GATHER) { o00 = (unsigned)(S.a_row(u, RA[0]) * pitchA + CA[0] * 2); o01 = (unsigned)(S.a_row(u, RA[1]) * pitchA + CA[1] * 2); \
                             o10 = (unsigned)(S.a_row(u, RA[0] + HALF) * pitchA + CA[0] * 2); o11 = (unsigned)(S.a_row(u, RA[1] + HALF) * pitchA + CA[1] * 2); } \
        else { o00 = (unsigned)(RA[0] * pitchA + CA[0] * 2); o01 = (unsigned)(RA[1] * pitchA + CA[1] * 2); o10 = (unsigned)((RA[0] + HALF) * pitchA + CA[0] * 2); o11 = (unsigned)((RA[1] + HALF) * pitchA + CA[1] * 2); } } while (0)
    Unit cur, nxt; int ui = 0;
    if (!S.next(0, cur)) return;
    f32x4 acc[2][2][4][2];
#pragma unroll
    for (int a = 0; a < 2; ++a)
#pragma unroll
        for (int b = 0; b < 2; ++b)
#pragma unroll
            for (int m = 0; m < 4; ++m)
#pragma unroll
                for (int n = 0; n < 2; ++n) acc[a][b][m][n] = (f32x4){0.f, 0.f, 0.f, 0.f};
    bf16x8 At[4][2], B0[2][2], B1[2][2]; i32x8 At8[4], B08[2], B18[2];
    const char* cA = S.a_base(cur); const char* cB = S.b_base(cur);
    unsigned c00, c01, c10, c11; PG8_AOFF(cur, c00, c01, c10, c11);
    const unsigned vb0 = voffB[0], vb1 = voffB[1];
    PG8_STAGE(PG8_SB(0, 0), cB, vb0, vb1); PG8_STAGE(PG8_SA(0, 0), cA, c00, c01); PG8_STAGE(PG8_SB(0, 1), cB + hstepB, vb0, vb1); PG8_STAGE(PG8_SA(0, 1), cA, c10, c11);
    if (wr == 1) PG8_BAR;
    PG8_WAIT_V(4); PG8_BAR;
    PG8_STAGE(PG8_SB(1, 0), cB + kstep, vb0, vb1); PG8_STAGE(PG8_SA(1, 0), cA + kstep, c00, c01); PG8_STAGE(PG8_SB(1, 1), cB + hstepB + kstep, vb0, vb1);
    PG8_WAIT_V(6); PG8_BAR;
    for (;;) {
        const bool has_next = S.next(ui + 1, nxt);
        const char* nA = has_next ? S.a_base(nxt) : cA; const char* nB = has_next ? S.b_base(nxt) : cB;
        unsigned n00 = c00, n01 = c01, n10 = c10, n11 = c11;
        if (has_next) PG8_AOFF(nxt, n00, n01, n10, n11);
        for (int t = 0; t < nt; t += 2) {
            const bool last = (t == nt - 2);
            const char* a1 = cA + (size_t)(t + 1) * kstep;
            const char* a2 = last ? nA : cA + (size_t)(t + 2) * kstep; const char* b2 = last ? nB : cB + (size_t)(t + 2) * kstep;
            const char* a3 = a2 + kstep; const char* b3 = b2 + kstep;
            const unsigned x00 = last ? n00 : c00, x01 = last ? n01 : c01, x10 = last ? n10 : c10, x11 = last ? n11 : c11;
            PG8_LDB(B0, 0, 0); PG8_SCHED; PG8_LDA(At, 0, 0); PG8_STAGE(PG8_SA(1, 1), a1, c10, c11);
            PG8_WAIT_L(8); PG8_BAR; PG8_WAIT_L(0); PG8_MMA(0, 0, At, B0); PG8_BAR; PG8_SCHED;
            PG8_LDB(B1, 0, 1); PG8_STAGE(PG8_SB(0, 0), b2, vb0, vb1);
            PG8_BAR; PG8_WAIT_L(0); PG8_MMA(0, 1, At, B1); PG8_BAR;
            PG8_LDA(At, 0, 1); PG8_STAGE(PG8_SA(0, 0), a2, x00, x01);
            PG8_BAR; PG8_WAIT_L(0); PG8_MMA(1, 0, At, B0); PG8_BAR; PG8_SCHED;
            PG8_STAGE(PG8_SB(0, 1), b2 + hstepB, vb0, vb1);
            PG8_WAIT_V(6); PG8_BAR; PG8_MMA(1, 1, At, B1); PG8_BAR;
            PG8_LDB(B0, 1, 0); PG8_SCHED; PG8_LDA(At, 1, 0); PG8_STAGE(PG8_SA(0, 1), a2, x10, x11);
            PG8_WAIT_L(8); PG8_BAR; PG8_WAIT_L(0); PG8_MMA(0, 0, At, B0); PG8_BAR; PG8_SCHED;
            PG8_LDB(B1, 1, 1); PG8_STAGE(PG8_SB(1, 0), b3, vb0, vb1);
            PG8_BAR; PG8_WAIT_L(0); PG8_MMA(0, 1, At, B1); PG8_BAR;
            PG8_LDA(At, 1, 1); PG8_STAGE(PG8_SA(1, 0), a3, x00, x01);
            PG8_BAR; PG8_WAIT_L(0); PG8_MMA(1, 0, At, B0); PG8_BAR; PG8_SCHED;
            PG8_STAGE(PG8_SB(1, 1), b3 + hstepB, vb0, vb1);
            PG8_WAIT_V(6); PG8_BAR; PG8_MMA(1, 1, At, B1); PG8_BAR;
        }
        if (F8) asm volatile("s_nop 15\n\ts_nop 15" ::: "memory");
        E(acc, cur, wr, wc, fr, fq);
        if (!has_next) break;
#pragma unroll
        for (int a = 0; a < 2; ++a)
#pragma unroll
            for (int b = 0; b < 2; ++b)
#pragma unroll
                for (int m = 0; m < 4; ++m)
#pragma unroll
                    for (int n = 0; n < 2; ++n) acc[a][b][m][n] = (f32x4){0.f, 0.f, 0.f, 0.f};
        cur = nxt; cA = nA; cB = nB; c00 = n00; c01 = n01; c10 = n10; c11 = n11; ++ui;
    }
    PG8_WAIT_V(0);
    if (wr == 0) PG8_BAR;
    PG8_BAR;
#undef PG8_SA
#undef PG8_SB
#undef PG8_STAGE
#undef PG8_LDA
#undef PG8_LDB
#undef PG8_MMA
#undef PG8_WAIT_V
#undef PG8_WAIT_L
#undef PG8_BAR
#undef PG8_SCHED
#undef PG8_AOFF
#undef PG8_CAT
#undef PG8_LD8
}
}
using pg8::Unit;

typedef const float* cfp_t;
typedef __attribute__((address_space(4))) const cfp_t* KargP;
__device__ __forceinline__ KargP karg_opaque(KargP p) { asm volatile("" : "+s"(p)); return p; }
struct Frame {
    LAS unsigned char* lds;
    volatile LAS unsigned* MISC;
    unsigned* ctl;
    int tid, lane, wave, G, bid;
    KargP in;
    float* out; unsigned char* ws;
};
#define WSP(T, off) ((T*)(F.ws + (off)))

__device__ __forceinline__ void transpose_item(const float* src, size_t ld, int nvalid, float scale, bf16_t* dst, int K, LAS float* scr, int lane) {
    { float tv[32]; const int j = lane & 31;
#pragma unroll
      for (int i = 0; i < 32; ++i) tv[i] = (j < nvalid) ? src[(size_t)(2 * i + (lane >> 5)) * ld + j] : 0.f;
#pragma unroll
      for (int i = 0; i < 32; ++i) scr[(2 * i + (lane >> 5)) * 33 + j] = tv[i] * scale; }
    LDS_WAIT(); asm volatile("" ::: "memory");
    const int c = lane & 7;
#pragma unroll
    for (int j = 0; j < 4; ++j) { const int n = (lane >> 3) + 8 * j; const LAS float* s = scr + (8 * c) * 33 + n;
        u32x4 o; o.x = pk2(s[0 * 33], s[1 * 33]); o.y = pk2(s[2 * 33], s[3 * 33]); o.z = pk2(s[4 * 33], s[5 * 33]); o.w = pk2(s[6 * 33], s[7 * 33]);
        *(u32x4*)(dst + (size_t)n * K + 8 * c) = o; }
    LDS_WAIT(); asm volatile("" ::: "memory");
}
struct CvItem { const float* src; unsigned char* dst; float scale; int rstep; };
__device__ __forceinline__ CvItem cv_decode(KargP in, unsigned char* ws, int it) {
    CvItem c;
    if (it < NEXP * 256) { const int e = it >> 8, q = it & 255, up = q & 1, g = (q >> 1) & 7, kb = q >> 4;
        c.src = (up ? in[I_WU] : in[I_WG]) + (size_t)e * DM * DM + (size_t)(128 * kb) * DM + 256 * g;
        c.dst = ws + WS_WGU + ((size_t)e * 4096 + 512 * g + up * 128) * DM + 128 * kb; c.scale = 32.f; c.rstep = 256; }
    else { const int r2 = it - NEXP * 256; const int e = r2 >> 7, q = r2 & 127, g = q & 7, kb = q >> 3;
        c.src = in[I_WDN] + (size_t)e * DM * DM + (size_t)(128 * kb) * DM + 256 * g;
        c.dst = ws + WS_WD + ((size_t)e * 2048 + 256 * g) * DM + 128 * kb; c.scale = 64.f; c.rstep = 128; }
    return c;
}
constexpr int CV_E8X = 8;
__device__ __forceinline__ int cv_map(int i) { constexpr int n1 = (NEXP - CV_E8X) * 256; return i < n1 ? CV_E8X * 256 + i : NEXP * 256 + CV_E8X * 128 + (i - n1); }
#define CV_LOAD(v, c) do { _Pragma("unroll") for (int i_ = 0; i_ < 16; ++i_) v[i_] = *(const f32x4*)((c).src + (size_t)(16 * w + i_) * DM + 4 * lane); } while (0)
#define CV_PROC(v, c) do { \
        _Pragma("unroll") for (int j_ = 0; j_ < 4; ++j_) { u32x4 o_; const float s_ = (c).scale; \
            o_.x = pk4_fp8(v[0][j_] * s_, v[1][j_] * s_, v[2][j_] * s_, v[3][j_] * s_);     o_.y = pk4_fp8(v[4][j_] * s_, v[5][j_] * s_, v[6][j_] * s_, v[7][j_] * s_); \
            o_.z = pk4_fp8(v[8][j_] * s_, v[9][j_] * s_, v[10][j_] * s_, v[11][j_] * s_);   o_.w = pk4_fp8(v[12][j_] * s_, v[13][j_] * s_, v[14][j_] * s_, v[15][j_] * s_); \
            *(LAS u32x4*)(tile + (4 * lane + j_) * 144 + 16 * w) = o_; } \
        __syncthreads(); \
        _Pragma("unroll") for (int q_ = 0; q_ < 4; ++q_) { const int idx_ = tid + 512 * q_, row_ = idx_ >> 3, piece_ = idx_ & 7; \
            *(u32x4*)((c).dst + (size_t)((row_ >> 7) * (c).rstep + (row_ & 127)) * DM + 16 * piece_) = *(const LAS u32x4*)(tile + row_ * 144 + 16 * piece_); } \
        __syncthreads(); } while (0)
__device__ __forceinline__ void convert_moe_weights(KargP in, unsigned char* ws, LAS unsigned char* tile, int tid, int bid, int G) {
    const int w = tid >> 6, lane = tid & 63;
    constexpr int NIT = (NEXP - CV_E8X) * (256 + 128);
    f32x4 va[16], vb[16];
    int it = bid;
    if (it >= NIT) return;
    CvItem ca = cv_decode(in, ws, cv_map(it)), cb = ca;
    CV_LOAD(va, ca);
    for (;;) {
        const bool hb = it + G < NIT;
        if (hb) { cb = cv_decode(in, ws, cv_map(it + G)); CV_LOAD(vb, cb); }
        CV_PROC(va, ca);
        if (!hb) break;
        it += G;
        const bool ha = it + G < NIT;
        if (ha) { ca = cv_decode(in, ws, cv_map(it + G)); CV_LOAD(va, ca); }
        CV_PROC(vb, cb);
        if (!ha) break;
        it += G;
    }
}
#undef CV_LOAD
#undef CV_PROC
__device__ __forceinline__ void transpose_item_f8(const float* src, size_t ld, float scale, unsigned char* dst, int K, LAS float* scr, int lane) {
    { float tv[32]; const int j = lane & 31;
#pragma unroll
      for (int i = 0; i < 32; ++i) tv[i] = src[(size_t)(2 * i + (lane >> 5)) * ld + j];
#pragma unroll
      for (int i = 0; i < 32; ++i) scr[(2 * i + (lane >> 5)) * 33 + j] = tv[i] * scale; }
    LDS_WAIT(); asm volatile("" ::: "memory");
    const int c = lane & 3;
#pragma unroll
    for (int j = 0; j < 2; ++j) { const int n = (lane >> 2) + 16 * j; const LAS float* s = scr + (16 * c) * 33 + n;
        u32x4 o; o.x = pk4_fp8(s[0 * 33], s[1 * 33], s[2 * 33], s[3 * 33]); o.y = pk4_fp8(s[4 * 33], s[5 * 33], s[6 * 33], s[7 * 33]);
        o.z = pk4_fp8(s[8 * 33], s[9 * 33], s[10 * 33], s[11 * 33]); o.w = pk4_fp8(s[12 * 33], s[13 * 33], s[14 * 33], s[15 * 33]);
        *(u32x4*)(dst + (size_t)n * K + 16 * c) = o; }
    LDS_WAIT(); asm volatile("" ::: "memory");
}
__device__ __forceinline__ void p0_phase(Frame& F) {
    const KargP in = karg_opaque(F.in);
    LAS float* scr = (LAS float*)(F.lds + F.wave * 16384);
    const int gw = F.bid * NWAVES + F.wave, NGW = F.G * NWAVES;
    constexpr int IT_WIN = 32 * (WIN_ROWS / 32);
    constexpr int IT_WQK = 4 * 64;
    constexpr int IT_WPA2 = 32 * 64;
    constexpr int IT_WPH = 16 * 64;
    constexpr int IT_WOUT = 32 * 64;
    constexpr int NITEMS = IT_WIN + IT_WQK + IT_WPA2 + IT_WPH + IT_WOUT;
    for (int it = gw; it < NITEMS; it += NGW) {
        int r = it;
        if (r < IT_WIN) { const int g = r % (WIN_ROWS / 32), kb = r / (WIN_ROWS / 32); const int n0 = 32 * g; int sc, nv = 32;
            if (n0 < 2048) sc = n0; else if (n0 < 3072) sc = 2064 + (n0 - 2048); else if (n0 < 7168) sc = 6160 + (n0 - 3072); else if (n0 < 7200) { sc = 2048; nv = 16; } else if (n0 < WIN_HY0) { sc = 0; nv = 0; } else sc = 3088 + (n0 - WIN_HY0);
            if (n0 < 2048 || (n0 >= 7168 && n0 < WIN_HY0)) transpose_item(in[I_WIN] + (size_t)(64 * kb) * N_IN + sc, N_IN, nv, 1.f, WSP(bf16_t, WS_WIN) + (size_t)n0 * DM + 64 * kb, DM, scr, F.lane);
            else transpose_item_f8(in[I_WIN] + (size_t)(64 * kb) * N_IN + sc, N_IN, 32.f, WSP(unsigned char, WS_WIN8) + (size_t)n0 * DM + 64 * kb, DM, scr, F.lane);
            continue; } r -= IT_WIN;
        if (r < IT_WQK) { const int g = r % 64, kb = r / 64; const int n0 = 32 * g, h = n0 / 512, j = (n0 % 512) / 256, e0 = n0 % 256;
            const float* src = (j ? in[I_WKH] : in[I_WQH]) + (size_t)h * 65536 + (size_t)(64 * kb) * 256 + e0;
            transpose_item(src, 256, 32, j ? 0.0625f : 1.f, WSP(bf16_t, WS_WQK) + (size_t)n0 * 256 + 64 * kb, 256, scr, F.lane); continue; } r -= IT_WQK;
        if (r < IT_WPA2) { const int g = r % 64, kb = r / 64; const int n0 = 32 * g, k0 = 64 * kb;
            transpose_item_f8(in[I_WPA] + (size_t)(k0 % 1024) * DM + n0, DM, 32.f, WSP(unsigned char, WS_WPA2) + (size_t)n0 * 2048 + k0, 2048, scr, F.lane); continue; } r -= IT_WPA2;
        if (r < IT_WPH) { const int g = r % 64, kb = r / 64; const int n0 = 32 * g, k0 = 64 * kb;
            transpose_item(in[I_WPH] + (size_t)k0 * DM + n0, DM, 32, 1.f, WSP(bf16_t, WS_WPH) + (size_t)n0 * 1024 + k0, 1024, scr, F.lane); continue; } r -= IT_WPH;
        if (r < IT_WOUT) { const int g = r % 64, kb = r / 64; const int n0 = 32 * g, k0 = 64 * kb;
            transpose_item_f8(in[I_WOUT] + (size_t)k0 * DM + n0, DM, 64.f, WSP(unsigned char, WS_WOUT) + (size_t)n0 * 2048 + k0, 2048, scr, F.lane); continue; } r -= IT_WOUT;
        (void)r;
    }
    __syncthreads();
    convert_moe_weights(in, F.ws, (LAS unsigned char*)F.lds, F.tid, F.bid, F.G);
    for (int i = F.bid * NTHR + F.tid; i < WIN_ROWS; i += F.G * NTHR) { int sc = -1;
        if (i < 2048) sc = i; else if (i < 3072) sc = 2064 + (i - 2048); else if (i < 7168) sc = 6160 + (i - 3072); else if (i < 7184) sc = 2048 + (i - 7168); else if (i < WIN_HY0) sc = -1; else sc = 3088 + (i - WIN_HY0);
        WSP(float, WS_BINP)[i] = sc >= 0 ? in[I_BIN][sc] : 0.f; }
    for (int it = F.bid + F.G * F.wave; it < 16 * 48; it += F.G * NWAVES) {
        const int ks = it / 48, cg = it % 48; const int col = cg * 256 + F.lane * 4;
        f32x4 a[9];
#pragma unroll
        for (int v = 0; v < 9; ++v) a[v] = (f32x4){0.f, 0.f, 0.f, 0.f};
#pragma unroll 1
        for (int kb = ks * 128; kb < ks * 128 + 128; kb += 16) {
            f32x4 w[16];
#pragma unroll
            for (int i = 0; i < 16; ++i) w[i] = *(const f32x4*)(in[I_WMOD] + (size_t)(kb + i) * 12288 + col);
#pragma unroll
            for (int i = 0; i < 16; ++i)
#pragma unroll
                for (int v = 0; v < 9; ++v) { const float cv = (v < 8) ? in[I_C][v * DM + kb + i] : in[I_CCTX][kb + i]; const float s = cv * sigmoidf_(cv); a[v] += w[i] * s; }
        }
#pragma unroll
        for (int v = 0; v < 9; ++v) *(f32x4*)(WSP(float, WS_MODP) + ((size_t)ks * 9 + v) * 12288 + col) = a[v];
    }
    for (int j = gw; j < SEQ; j += NGW) {
        const int l = F.lane;
        float zv = 0.f;
        if (l == 0) zv = (float)j / (float)(SEQ - 1);
        else if (l < 33) { const int bi = (l - 1) & 15; const float f = 1e-4f + (float)bi * ((15.0f - 1e-4f) / 15.0f); const float ang = 6.283185307179586f * (float)j * f / (float)SEQ; zv = (l < 17) ? cosf(ang) : -sinf(ang); }
        float pre = in[I_FB1][l];
        for (int i = 0; i < 33; ++i) pre += __shfl(zv, i) * in[I_FW1][i * 64 + l];
        float a = sinf(in[I_FFREQ][l] * pre);
        pre = in[I_FBH][l];
        for (int i = 0; i < 64; ++i) pre += __shfl(a, i) * in[I_FWH][i * 64 + l];
        float a2 = sinf(in[I_FFREQ][64 + l] * pre);
        pre = in[I_FBH][64 + l];
        for (int i = 0; i < 64; ++i) pre += __shfl(a2, i) * in[I_FWH][4096 + i * 64 + l];
        WSP(float, WS_A3)[j * 64 + l] = sinf(in[I_FFREQ][128 + l] * pre);
    }
}

__device__ __forceinline__ void p0b_phase(Frame& F) {
    const KargP in = karg_opaque(F.in);
    for (int i = F.bid * NTHR + F.tid; i < 9 * 12288; i += F.G * NTHR) { const int col = i % 12288; float s = in[I_BMOD][col];
        for (int ks = 0; ks < 16; ++ks) s += WSP(float, WS_MODP)[(size_t)ks * 9 * 12288 + i];
        WSP(float, WS_MOD)[i] = s; }
    LAS float* wl = (LAS float*)F.lds;
    for (int un = F.bid; un < 256; un += F.G) {
        const int ct = un >> 2, pg = un & 3;
        __syncthreads();
        for (int q = 0; q < 8; ++q) { const int idx = F.tid + 512 * q, i = idx >> 6, cc = idx & 63; wl[cc * 68 + i] = in[I_FWOUT][(size_t)i * 4096 + ct * 64 + cc]; }
        __syncthreads();
        const int j = pg * 512 + F.wave * 64 + F.lane;
        f32x4 ar[16];
#pragma unroll
        for (int q = 0; q < 16; ++q) ar[q] = *(const f32x4*)(WSP(float, WS_A3) + j * 64 + 4 * q);
        const float tj = (float)j / (float)(SEQ - 1);
        const float mind = -3.0701134573253944f, maxd = -15.350567286626972f;
        const int cbase = (ct * 64) & 1023;
#pragma unroll 1
        for (int cc = 0; cc < 64; ++cc) {
            f32x4 s = (f32x4){0.f, 0.f, 0.f, 0.f};
#pragma unroll
            for (int q = 0; q < 16; ++q) s += ar[q] * *(const LAS f32x4*)(wl + cc * 68 + 4 * q);
            const float delta = fabsf(mind + (float)(cbase + cc) * ((maxd - mind) / 1023.0f));
            const float v = ((s.x + s.y) + (s.z + s.w)) * __expf(-tj * delta);
            WSP(float, WS_HTAPS)[(size_t)(ct * 64 + cc) * SEQ + j] = v;
        }
    }
}

__device__ __forceinline__ f32x2 cmul(f32x2 a, f32x2 b) { return (f32x2){a.x * b.x - a.y * b.y, a.x * b.y + a.y * b.x}; }
__device__ __forceinline__ f32x2 cmulc(f32x2 a, f32x2 b) { return (f32x2){a.x * b.x + a.y * b.y, a.y * b.x - a.x * b.y}; }
template <bool INV> __device__ __forceinline__ void dft4(f32x2& a, f32x2& b, f32x2& c, f32x2& d) {
    const f32x2 s0 = a + c, s1 = a - c, s2 = b + d, s3 = b - d;
    const f32x2 is3 = (f32x2){-s3.y, s3.x};
    a = s0 + s2; c = s0 - s2;
    if (!INV) { b = s1 - is3; d = s1 + is3; } else { b = s1 + is3; d = s1 - is3; }
}
template <bool INV> __device__ __forceinline__ void dft16(f32x2 (&v)[16]) {
#pragma unroll
    for (int n0 = 0; n0 < 4; ++n0) dft4<INV>(v[n0], v[4 + n0], v[8 + n0], v[12 + n0]);
    const float c1 = 0.9238795325112867f, s1 = 0.3826834323650898f, r2 = 0.7071067811865476f;
    const float cs[10] = {1.f, c1, r2, s1, 0.f, -s1, -r2, -c1, -1.f, -c1};
    const float sn[10] = {0.f, s1, r2, c1, 1.f, c1, r2, s1, 0.f, -s1};
#pragma unroll
    for (int k0 = 1; k0 < 4; ++k0)
#pragma unroll
        for (int n0 = 1; n0 < 4; ++n0) { const int m = n0 * k0; const f32x2 w = (f32x2){cs[m], INV ? sn[m] : -sn[m]}; v[4 * k0 + n0] = cmul(v[4 * k0 + n0], w); }
#pragma unroll
    for (int k0 = 0; k0 < 4; ++k0) dft4<INV>(v[4 * k0], v[4 * k0 + 1], v[4 * k0 + 2], v[4 * k0 + 3]);
#pragma unroll
    for (int a = 0; a < 4; ++a)
#pragma unroll
        for (int b = a + 1; b < 4; ++b) { const f32x2 t = v[4 * a + b]; v[4 * a + b] = v[4 * b + a]; v[4 * b + a] = t; }
}
__device__ __forceinline__ int fphys(int i) { return i + (i >> 4); }
constexpr int FFT_BUF_BYTES = (4096 + 256) * 8;
struct FftTw { f32x2 wA, wB; };
__device__ __forceinline__ FftTw fft_tw(int ht) { FftTw t; float s, c; sincospif(-(float)ht / 2048.0f, &s, &c); t.wA = (f32x2){c, s}; sincospif(-(float)(ht & 15) / 128.0f, &s, &c); t.wB = (f32x2){c, s}; return t; }
template <bool CONJ> __device__ __forceinline__ void tw_apply(f32x2 (&v)[16], f32x2 w1) {
    if (CONJ) w1.y = -w1.y;
    const f32x2 w2 = cmul(w1, w1), w3 = cmul(w2, w1), w4 = cmul(w2, w2), w5 = cmul(w4, w1), w6 = cmul(w4, w2), w7 = cmul(w4, w3), w8 = cmul(w4, w4);
    v[1] = cmul(v[1], w1); v[2] = cmul(v[2], w2); v[3] = cmul(v[3], w3); v[4] = cmul(v[4], w4); v[5] = cmul(v[5], w5); v[6] = cmul(v[6], w6); v[7] = cmul(v[7], w7); v[8] = cmul(v[8], w8);
    v[9] = cmul(v[9], cmul(w8, w1)); v[10] = cmul(v[10], cmul(w8, w2)); v[11] = cmul(v[11], cmul(w8, w3)); v[12] = cmul(v[12], cmul(w8, w4));
    v[13] = cmul(v[13], cmul(w8, w5)); v[14] = cmul(v[14], cmul(w8, w6)); v[15] = cmul(v[15], cmul(w8, w7));
}
__device__ __forceinline__ void fft_fwd(f32x2 (&v)[16], LAS f32x2* buf, int ht, const FftTw& tw_) {
    FftTw tw = tw_; asm volatile("" : "+v"(ht), "+v"(tw.wA.x), "+v"(tw.wA.y), "+v"(tw.wB.x), "+v"(tw.wB.y));
    dft16<false>(v);
    tw_apply<false>(v, tw.wA);
#pragma unroll
    for (int k = 0; k < 16; ++k) buf[fphys(256 * k + ht)] = v[k];
    __syncthreads();
    const int ka = ht >> 4, s = ht & 15;
#pragma unroll
    for (int b = 0; b < 16; ++b) v[b] = buf[fphys(256 * ka + 16 * b + s)];
    dft16<false>(v);
    tw_apply<false>(v, tw.wB);
#pragma unroll
    for (int k = 0; k < 16; ++k) buf[fphys(256 * ka + 16 * k + s)] = v[k];
    __syncthreads();
#pragma unroll
    for (int q = 0; q < 16; ++q) v[q] = buf[fphys(16 * ht + q)];
    dft16<false>(v);
}
__device__ __forceinline__ void fft_inv(f32x2 (&v)[16], LAS f32x2* buf, int ht, const FftTw& tw_) {
    FftTw tw = tw_; asm volatile("" : "+v"(ht), "+v"(tw.wA.x), "+v"(tw.wA.y), "+v"(tw.wB.x), "+v"(tw.wB.y));
    dft16<true>(v);
#pragma unroll
    for (int q = 0; q < 16; ++q) buf[fphys(16 * ht + q)] = v[q];
    __syncthreads();
    const int ka = ht >> 4, s = ht & 15;
#pragma unroll
    for (int k = 0; k < 16; ++k) v[k] = buf[fphys(256 * ka + 16 * k + s)];
    tw_apply<true>(v, tw.wB);
    dft16<true>(v);
#pragma unroll
    for (int b = 0; b < 16; ++b) buf[fphys(256 * ka + 16 * b + s)] = v[b];
    __syncthreads();
#pragma unroll
    for (int k = 0; k < 16; ++k) v[k] = buf[fphys(256 * k + ht)];
    tw_apply<true>(v, tw.wA);
    dft16<true>(v);
    __syncthreads();
}

__device__ __forceinline__ void p1_phase(Frame& F) {
    const KargP in = karg_opaque(F.in);
    const int gw = F.bid * NWAVES + F.wave, NGW = F.G * NWAVES;
    const float* mod = WSP(float, WS_MOD);
    {
        f32x4 pg[8], pb[8];
#pragma unroll
        for (int j = 0; j < 8; ++j) { pg[j] = *(const f32x4*)(in[I_LNG] + F.lane * 4 + 256 * j); pb[j] = *(const f32x4*)(in[I_LNB] + F.lane * 4 + 256 * j); }
#pragma unroll 1
        for (int grp = gw; grp < MALL / 8; grp += NGW) {
            const int row0 = grp * 8; const bool lat = row0 < MTOK;
            const float* xb = lat ? in[I_X] + (size_t)row0 * DM : in[I_CTX] + (size_t)(row0 - MTOK) * DM;
            const float* mv = mod + (size_t)(lat ? row0 / SEQ : 8) * 12288;
            f32x4 psh[8], psc[8];
#pragma unroll
            for (int j = 0; j < 8; ++j) { psh[j] = *(const f32x4*)(mv + F.lane * 4 + 256 * j); psc[j] = *(const f32x4*)(mv + 2048 + F.lane * 4 + 256 * j) + 1.0f; }
            f32x4 v[8], vn[8];
#pragma unroll
            for (int j = 0; j < 8; ++j) v[j] = *(const f32x4*)(xb + F.lane * 4 + 256 * j);
#pragma unroll 1
            for (int ri = 0; ri < 8; ++ri) {
                const float* xn = xb + (size_t)(ri < 7 ? ri + 1 : ri) * DM;
#pragma unroll
                for (int j = 0; j < 8; ++j) vn[j] = *(const f32x4*)(xn + F.lane * 4 + 256 * j);
                float s = 0.f;
#pragma unroll
                for (int j = 0; j < 8; ++j) s += (v[j].x + v[j].y) + (v[j].z + v[j].w);
                const float mean = wave_sum(s) * (1.f / DM); float s2 = 0.f;
#pragma unroll
                for (int j = 0; j < 8; ++j) { v[j] = v[j] - mean; s2 += (v[j].x * v[j].x + v[j].y * v[j].y) + (v[j].z * v[j].z + v[j].w * v[j].w); }
                const float rstd = 1.f / sqrtf(wave_sum(s2) * (1.f / DM) + LN_EPS);
                const int row = row0 + ri;
                if (lat && F.lane == 0) { WSP(float, WS_STATS)[row * 2] = mean; WSP(float, WS_STATS)[row * 2 + 1] = rstd; }
                bf16_t* orow = WSP(bf16_t, WS_HX) + (size_t)row * DM;
#pragma unroll
                for (int j = 0; j < 8; ++j) { const f32x4 y = (v[j] * rstd * pg[j] + pb[j]) * psc[j] + psh[j];
                    u32x2 o; o.x = pk2(y.x, y.y); o.y = pk2(y.z, y.w); *(u32x2*)(orow + F.lane * 4 + 256 * j) = o;
                    if (lat) *(unsigned*)(WSP(unsigned char, WS_HX8) + (size_t)row * DM + F.lane * 4 + 256 * j) = pk4_fp8(y.x, y.y, y.z, y.w); }
#pragma unroll
                for (int j = 0; j < 8; ++j) v[j] = vn[j];
            }
        }
    }
    const int hb = F.tid >> 8, ht = F.tid & 255;
    LAS f32x2* buf = (LAS f32x2*)(F.lds + hb * FFT_BUF_BYTES);
    const FftTw tw = fft_tw(ht);
    const float* htaps = WSP(float, WS_HTAPS);
    for (int u0 = F.bid * 2; u0 < 2048; u0 += F.G * 2) {
        const int un = u0 + hb, c = un >> 1, n = un & 1;
        const float* hf = htaps + (size_t)((n * 2 + 0) * 1024 + c) * SEQ, * hbk = htaps + (size_t)((n * 2 + 1) * 1024 + c) * SEQ;
        f32x2 v[16];
#pragma unroll
        for (int a = 0; a < 16; ++a) { const int i = 256 * a + ht; float x;
            if (a < 8) x = hf[i]; else if (i == 2048) x = 0.f; else x = hbk[4096 - i];
            v[a] = (f32x2){x * (1.0f / 4096.0f), 0.f}; }
        fft_fwd(v, buf, ht, tw);
        f32x2* Hd = WSP(f32x2, WS_H) + (size_t)un * 4096;
#pragma unroll
        for (int ks = 0; ks < 16; ++ks) Hd[ks * 256 + ht] = v[ks];
        __syncthreads();
    }
}

template <bool F8> struct SchedZ {
    static constexpr bool GATHER = false;
    int G, c; const char* hx; const char* win;
    static constexpr size_t P = F8 ? DM : 2 * DM;
    __device__ __forceinline__ bool next(int i, Unit& u) const {
        int L = i * G + c;
        if (!F8) {
            if (L < 576) { int pn; pg8::decode_tile(L, 64, 9, u.pm, pn); u.pn = pn < 8 ? pn : 28; u.ex = 0; return true; } L -= 576;
            if (L < 72) { int pm, pn; pg8::decode_tile(L, 8, 9, pm, pn); u.pm = 64 + pm; u.pn = pn < 8 ? pn : 28; u.ex = 0; return true; }
            return false;
        } else {
            if (L < 1280) { int pn; pg8::decode_tile(L, 64, 20, u.pm, pn); u.pn = 8 + pn; u.ex = 0; return true; } L -= 1280;
            if (L < 768) { pg8::decode_tile(L, 12, 64, u.pm, u.pn); u.ex = 1; return true; }
            return false;
        }
    }
    __device__ __forceinline__ const char* a_base(const Unit& u) const { return u.ex ? win + (size_t)(WIN_HY0 + 256 * u.pm) * P : hx + (size_t)(256 * u.pm) * P; }
    __device__ __forceinline__ const char* b_base(const Unit& u) const { return u.ex ? hx + (size_t)(256 * u.pn) * P : win + (size_t)(256 * u.pn) * P; }
    __device__ __forceinline__ int a_row(const Unit&, int R) const { return R; }
};
struct EpiZ {
    static constexpr bool PERM = true;
    bf16_t* Z; bf16_t* ZT; const float* bias;
    __device__ __forceinline__ void operator()(const f32x4 (&acc)[2][2][4][2], const Unit& u, int wr, int wc, int fr, int fq) const {
        if (u.ex == 0) {
            const int row0 = u.pm * 256 + wr * 64 + fr, col0 = u.pn * 256 + wc * 32 + 8 * fq;
            f32x4 bv[2][2];
#pragma unroll
            for (int bj = 0; bj < 2; ++bj)
#pragma unroll
                for (int n = 0; n < 2; ++n) bv[bj][n] = *(const f32x4*)(bias + col0 + bj * 128 + 4 * n);
#pragma unroll
            for (int ai = 0; ai < 2; ++ai)
#pragma unroll
                for (int m = 0; m < 4; ++m) { bf16_t* rowp = Z + (size_t)(row0 + ai * 128 + m * 16) * ZN + col0;
#pragma unroll
                    for (int bj = 0; bj < 2; ++bj) { const f32x4 v0 = acc[ai][bj][m][0] + bv[bj][0], v1 = acc[ai][bj][m][1] + bv[bj][1];
                        u32x4 w; w.x = pg8::cvt_pk_bf16(v0[0], v0[1]); w.y = pg8::cvt_pk_bf16(v0[2], v0[3]); w.z = pg8::cvt_pk_bf16(v1[0], v1[1]); w.w = pg8::cvt_pk_bf16(v1[2], v1[3]);
                        *(u32x4*)(rowp + bj * 128) = w; } }
        } else {
            const int ch0 = u.pm * 256 + wr * 64 + fr, b = u.pn >> 3, t0 = (u.pn & 7) * 256 + wc * 32 + 8 * fq;
#pragma unroll
            for (int ai = 0; ai < 2; ++ai)
#pragma unroll
                for (int m = 0; m < 4; ++m) { const int ch = ch0 + ai * 128 + m * 16; const float bb = bias[WIN_HY0 + ch];
                    bf16_t* rowp = ZT + ((size_t)b * 3072 + ch) * SEQ + t0;
#pragma unroll
                    for (int bj = 0; bj < 2; ++bj) { const f32x4 v0 = acc[ai][bj][m][0] + bb, v1 = acc[ai][bj][m][1] + bb;
                        u32x4 w; w.x = pg8::cvt_pk_bf16(v0[0], v0[1]); w.y = pg8::cvt_pk_bf16(v0[2], v0[3]); w.z = pg8::cvt_pk_bf16(v1[0], v1[1]); w.w = pg8::cvt_pk_bf16(v1[2], v1[3]);
                        *(u32x4*)(rowp + bj * 128) = w; } }
        }
    }
};

__device__ __forceinline__ void p3_phase(Frame& F) {
    const KargP in = karg_opaque(F.in);
    const bf16_t* Z = WSP(bf16_t, WS_Z); bf16_t* U = WSP(bf16_t, WS_U);
    const float* cw = in[I_MCW]; const float* cb = in[I_MCB];
    for (int it = F.bid * NTHR + F.tid; it < MALL * 128; it += F.G * NTHR) {
        const int row = it >> 7, c0 = (it & 127) * 8;
        float a[8];
        { const f32x4 b0 = *(const f32x4*)(cb + c0), b1 = *(const f32x4*)(cb + c0 + 4); a[0] = b0.x; a[1] = b0.y; a[2] = b0.z; a[3] = b0.w; a[4] = b1.x; a[5] = b1.y; a[6] = b1.z; a[7] = b1.w; }
        const bool lat = row < MTOK;
        int base, y, x, H, Wd;
        if (lat) { const int t = row & (SEQ - 1); base = row - t; y = t >> 6; x = t & 63; H = 32; Wd = 64; }
        else { const int t = (row - MTOK) & (CTX - 1); base = row - t; y = 0; x = t; H = 1; Wd = CTX; }
#pragma unroll
        for (int dy = -1; dy <= 1; ++dy)
#pragma unroll
            for (int dx = -1; dx <= 1; ++dx) {
                const int yy = y + dy, xx = x + dx;
                if (yy < 0 || yy >= H || xx < 0 || xx >= Wd) continue;
                const int srow = base + yy * Wd + xx;
                const u32x4 zz = *(const u32x4*)(Z + (size_t)srow * ZN + ZC_QK + c0);
                const float* wp = cw + ((dy + 1) * 3 + (dx + 1)) * MW + c0;
                const f32x4 w0 = *(const f32x4*)wp, w1 = *(const f32x4*)(wp + 4);
                a[0] += bflo(zz.x) * w0.x; a[1] += bfhi(zz.x) * w0.y; a[2] += bflo(zz.y) * w0.z; a[3] += bfhi(zz.y) * w0.w;
                a[4] += bflo(zz.z) * w1.x; a[5] += bfhi(zz.z) * w1.y; a[6] += bflo(zz.w) * w1.z; a[7] += bfhi(zz.w) * w1.w;
            }
#pragma unroll
        for (int j = 0; j < 8; ++j) a[j] = a[j] * sigmoidf_(a[j]);
        u32x4 o; o.x = pk2(a[0], a[1]); o.y = pk2(a[2], a[3]); o.z = pk2(a[4], a[5]); o.w = pk2(a[6], a[7]);
        *(u32x4*)(U + (size_t)row * MW + c0) = o;
    }
}

struct SchedQK {
    static constexpr bool GATHER = false;
    int G, c; const char* u; const char* w;
    __device__ __forceinline__ bool next(int i, Unit& un) const { const int L = i * G + c; if (L >= 72 * 8) return false; pg8::decode_tile(L, 72, 8, un.pm, un.pn); un.ex = 0; return true; }
    __device__ __forceinline__ const char* a_base(const Unit& un) const { return u + ((size_t)(256 * un.pm) * MW + (un.pn >> 1) * 256) * 2; }
    __device__ __forceinline__ const char* b_base(const Unit& un) const { return w + (size_t)(256 * un.pn) * 256 * 2; }
    __device__ __forceinline__ int a_row(const Unit&, int R) const { return R; }
};
struct EpiQK {
    static constexpr bool PERM = true;
    bf16_t* O;
    __device__ __forceinline__ void operator()(const f32x4 (&acc)[2][2][4][2], const Unit& u, int wr, int wc, int fr, int fq) const {
        const int row0 = u.pm * 256 + wr * 64 + fr, col0 = u.pn * 256 + wc * 32 + 8 * fq;
#pragma unroll
        for (int ai = 0; ai < 2; ++ai)
#pragma unroll
            for (int m = 0; m < 4; ++m) { bf16_t* rowp = O + (size_t)(row0 + ai * 128 + m * 16) * 2048 + col0;
#pragma unroll
                for (int bj = 0; bj < 2; ++bj) { const f32x4 v0 = acc[ai][bj][m][0], v1 = acc[ai][bj][m][1];
                    u32x4 w; w.x = pg8::cvt_pk_bf16(v0[0], v0[1]); w.y = pg8::cvt_pk_bf16(v0[2], v0[3]); w.z = pg8::cvt_pk_bf16(v1[0], v1[1]); w.w = pg8::cvt_pk_bf16(v1[2], v1[3]);
                    *(u32x4*)(rowp + bj * 128) = w; } }
    }
};

constexpr int ML_QS = 264, ML_VS = 72, ML_PS = 72;
constexpr int ML_Q = 0, ML_K = ML_Q + 64 * ML_QS * 2, ML_V = ML_K + 64 * ML_QS * 2, ML_C = ML_V + 64 * ML_VS * 2, ML_P = ML_C + 80 * ML_QS * 2, ML_SC = ML_P + 64 * ML_PS * 2;
constexpr int ML_SA = ML_SC, ML_SDEN = ML_SC + 4096, ML_END = ML_SC + 4096 + 256;
static_assert(ML_END <= MISC_OFF, "mlstm LDS");
__device__ __forceinline__ bf16x8 lds_frag(const LAS bf16_t* p) { return *(const LAS bf16x8*)p; }
__device__ __forceinline__ void mlstm_unit(Frame& F, int un) {
    const int vs = un & 3, dir = (un >> 2) & 1, h = (un >> 3) & 3, b = un >> 5;
    const bf16_t* Z = WSP(bf16_t, WS_Z); const bf16_t* QK = WSP(bf16_t, WS_QKB); unsigned char* AM = WSP(unsigned char, WS_AM);
    LAS unsigned char* lds = F.lds;
    LAS bf16_t* Qs = (LAS bf16_t*)(lds + ML_Q); LAS bf16_t* Ks = (LAS bf16_t*)(lds + ML_K); LAS bf16_t* Vs = (LAS bf16_t*)(lds + ML_V);
    LAS bf16_t* Cs = (LAS bf16_t*)(lds + ML_C); LAS bf16_t* Ps = (LAS bf16_t*)(lds + ML_P);
    LAS float* sDEN = (LAS float*)(lds + ML_SDEN);
    LAS float* sc0 = (LAS float*)(lds + ML_SA);
    const int tid = F.tid, lane = F.lane, w = F.wave, l15 = lane & 15, g4 = lane >> 4;
    __syncthreads();
    for (int i = tid; i < 80 * ML_QS / 2; i += NTHR) ((LAS unsigned*)Cs)[i] = 0u;
    if (tid < 64) { Vs[tid * ML_VS + 64] = (bf16_t)0x3F80; for (int j = 65; j < ML_VS; ++j) Vs[tid * ML_VS + j] = 0; }
    f32x4 cacc[2][5];
#pragma unroll
    for (int a = 0; a < 2; ++a)
#pragma unroll
        for (int c = 0; c < 5; ++c) cacc[a][c] = (f32x4){0.f, 0.f, 0.f, 0.f};
    float m_run = 0.f;
    u32x4 pq[4], pk[4], pv; unsigned pgate = 0u, pgate2 = 0u;
#define ML_ROW0(st) ((st) < 4 ? (MTOK + b * CTX + 64 * (dir ? 3 - (st) : (st))) : (b * SEQ + 64 * (dir ? 35 - (st) : (st) - 4)))
#define ML_LOAD(st) do { const int r0_ = ML_ROW0(st); \
        _Pragma("unroll") for (int q_ = 0; q_ < 4; ++q_) { const int p_ = tid + 512 * q_, rr_ = p_ >> 5, cc_ = (p_ & 31) * 8; \
            pq[q_] = *(const u32x4*)(QK + (size_t)(r0_ + rr_) * 2048 + h * 512 + cc_); pk[q_] = *(const u32x4*)(QK + (size_t)(r0_ + rr_) * 2048 + h * 512 + 256 + cc_); } \
        { const int rr_ = tid >> 3, cc_ = (tid & 7) * 8; pv = *(const u32x4*)(Z + (size_t)(r0_ + rr_) * ZN + ZC_V + h * 256 + vs * 64 + cc_); } \
        if (tid < 64) { const bf16_t* gp_ = Z + (size_t)(r0_ + tid) * ZN + ZC_GT + dir * 8 + h; pgate = gp_[0]; pgate2 = gp_[4]; } } while (0)
#define ML_STORE() do { \
        _Pragma("unroll") for (int q_ = 0; q_ < 4; ++q_) { const int p_ = tid + 512 * q_, rr_ = p_ >> 5, cc_ = (p_ & 31) * 8; \
            *(LAS u32x4*)(Qs + rr_ * ML_QS + cc_) = pq[q_]; *(LAS u32x4*)(Ks + rr_ * ML_QS + cc_) = pk[q_]; } \
        { const int rr_ = tid >> 3, cc_ = (tid & 7) * 8; *(LAS u32x4*)(Vs + rr_ * ML_VS + cc_) = pv; } } while (0)
#define ML_SCALARS(stp) do { LAS float* sb_ = sc0 + ((stp) & 1) * 512; \
            const float li = bf2f(pgate), zf = bf2f(pgate2); \
            const float lf = fminf(zf, 0.f) - log1pf(__expf(-fabsf(zf))); \
            float bcs = lf; \
            _Pragma("unroll") for (int o = 1; o < 64; o <<= 1) { const float t = dir ? __shfl_down(bcs, o) : __shfl_up(bcs, o); const bool ok = dir ? (lane + o < 64) : (lane >= o); bcs += ok ? t : 0.f; } \
            const float a = li - bcs; \
            float am = a; \
            _Pragma("unroll") for (int o = 1; o < 64; o <<= 1) { const float t = dir ? __shfl_down(am, o) : __shfl_up(am, o); const bool ok = dir ? (lane + o < 64) : (lane >= o); am = ok ? fmaxf(am, t) : am; } \
            const float inter = bcs + m_run; \
            const float mt = fmaxf(inter, bcs + am); \
            const float b_end = __shfl(bcs, dir ? 0 : 63); \
            const float gg = b_end - bcs + li; \
            float gm = gg; \
            _Pragma("unroll") for (int o = 1; o < 64; o <<= 1) gm = fmaxf(gm, __shfl_xor(gm, o)); \
            const float m_new = fmaxf(b_end + m_run, gm); \
            sb_[lane] = a; sb_[64 + lane] = bcs - mt; sb_[128 + lane] = __expf(inter - mt); sb_[192 + lane] = __expf(gg - m_new); sb_[256 + lane] = __expf(-mt); \
            if (lane == 0) sb_[320] = __expf(b_end + m_run - m_new); \
            m_run = m_new; } while (0)
    ML_LOAD(0);
    __syncthreads();
    if (w == 0) ML_SCALARS(0);
    const int tt = w & 3; const int nv = (w < 4) ? 3 : 2;
#pragma unroll 1
    for (int st = 0; st < 36; ++st) {
        ML_STORE();
        LAS float* sA = sc0 + (st & 1) * 512; LAS float* sU = sA + 64; LAS float* sSI = sA + 128; LAS float* sWG = sA + 192; LAS float* sEM = sA + 256; LAS float* sMI = sA + 320;
        const int row0 = ML_ROW0(st);
        if (st + 1 < 36) ML_LOAD(st + 1);
        __syncthreads();
        {
            f32x4 sacc[2] = {(f32x4){0.f, 0.f, 0.f, 0.f}, (f32x4){0.f, 0.f, 0.f, 0.f}};
#pragma unroll
            for (int ks = 0; ks < 8; ++ks) {
                const bf16x8 qf = lds_frag(Qs + (16 * tt + l15) * ML_QS + 32 * ks + 8 * g4);
#pragma unroll
                for (int j = 0; j < 2; ++j) { const int stl = 2 * (w >> 2) + j;
                    const bf16x8 kf = lds_frag(Ks + (16 * stl + l15) * ML_QS + 32 * ks + 8 * g4);
                    sacc[j] = __builtin_amdgcn_mfma_f32_16x16x32_bf16(kf, qf, sacc[j], 0, 0, 0); }
            }
            const int t = 16 * tt + l15; const float ut = sU[t];
#pragma unroll
            for (int j = 0; j < 2; ++j) { const int s0 = 16 * (2 * (w >> 2) + j) + 4 * g4;
                const f32x4 av = *(const LAS f32x4*)(sA + s0);
                float pvv[4];
#pragma unroll
                for (int r = 0; r < 4; ++r) { const int s = s0 + r; const bool ok = dir ? (s >= t) : (s <= t); pvv[r] = ok ? sacc[j][r] * __expf(ut + av[r]) : 0.f; }
                u32x2 o; o.x = pk2(pvv[0], pvv[1]); o.y = pk2(pvv[2], pvv[3]);
                *(LAS u32x2*)(Ps + t * ML_PS + s0) = o; }
        }
        __syncthreads();
        unsigned og[2][4];
        if (st >= 4) {
#pragma unroll
            for (int j = 0; j < 2; ++j) { const int vt_ = (w < 4) ? j : 2 + j;
#pragma unroll
                for (int r = 0; r < 4; ++r) og[j][r] = Z[(size_t)(row0 + 16 * tt + 4 * g4 + r) * ZN + ZC_O + h * 256 + vs * 64 + 16 * vt_ + l15]; } }
        f32x4 nacc[3], iacc[3];
#pragma unroll
        for (int j = 0; j < 3; ++j) { nacc[j] = (f32x4){0.f, 0.f, 0.f, 0.f}; iacc[j] = (f32x4){0.f, 0.f, 0.f, 0.f}; }
#pragma unroll
        for (int ks = 0; ks < 8; ++ks) {
            const bf16x8 qf = lds_frag(Qs + (16 * tt + l15) * ML_QS + 32 * ks + 8 * g4);
#pragma unroll
            for (int j = 0; j < 3; ++j) if (j < nv) { const int vt = (w < 4) ? (j == 2 ? 4 : j) : 2 + j;
                const bf16x8 cf = lds_frag(Cs + (16 * vt + l15) * ML_QS + 32 * ks + 8 * g4);
                iacc[j] = __builtin_amdgcn_mfma_f32_16x16x32_bf16(qf, cf, iacc[j], 0, 0, 0); }
        }
#pragma unroll
        for (int ks = 0; ks < 2; ++ks) {
            const bf16x8 pf = lds_frag(Ps + (16 * tt + l15) * ML_PS + 32 * ks + 8 * g4);
#pragma unroll
            for (int j = 0; j < 3; ++j) if (j < nv) { const int vt = (w < 4) ? (j == 2 ? 4 : j) : 2 + j;
                bf16x8 vf;
#pragma unroll
                for (int e = 0; e < 8; ++e) vf[e] = (short)Vs[(32 * ks + 8 * g4 + e) * ML_VS + 16 * vt + l15];
                nacc[j] = __builtin_amdgcn_mfma_f32_16x16x32_bf16(pf, vf, nacc[j], 0, 0, 0); }
        }
        const int t0 = 16 * tt + 4 * g4;
        {
            const f32x4 si = *(const LAS f32x4*)(sSI + t0);
#pragma unroll
            for (int j = 0; j < 3; ++j) if (j < nv) nacc[j] = nacc[j] + iacc[j] * si;
            if (w < 4 && l15 == 0) *(LAS f32x4*)(sDEN + t0) = nacc[2];
        }
        {
            const float decay = sMI[0];
#pragma unroll
            for (int a = 0; a < 2; ++a)
#pragma unroll
                for (int c = 0; c < 5; ++c) cacc[a][c] = cacc[a][c] * decay;
#pragma unroll
            for (int ks = 0; ks < 2; ++ks) {
                bf16x8 kf[2];
#pragma unroll
                for (int a = 0; a < 2; ++a)
#pragma unroll
                    for (int e = 0; e < 8; ++e) kf[a][e] = (short)Ks[(32 * ks + 8 * g4 + e) * ML_QS + 16 * (2 * w + a) + l15];
                float wg[8];
#pragma unroll
                for (int e = 0; e < 8; ++e) wg[e] = sWG[32 * ks + 8 * g4 + e];
#pragma unroll
                for (int c = 0; c < 5; ++c) {
                    u32x4 vw;
                    { float x[8];
#pragma unroll
                      for (int e = 0; e < 8; ++e) x[e] = bf2f((unsigned)Vs[(32 * ks + 8 * g4 + e) * ML_VS + 16 * c + l15]) * wg[e];
                      vw.x = pk2(x[0], x[1]); vw.y = pk2(x[2], x[3]); vw.z = pk2(x[4], x[5]); vw.w = pk2(x[6], x[7]); }
                    const bf16x8 vf = __builtin_bit_cast(bf16x8, vw);
#pragma unroll
                    for (int a = 0; a < 2; ++a) cacc[a][c] = __builtin_amdgcn_mfma_f32_16x16x32_bf16(kf[a], vf, cacc[a][c], 0, 0, 0);
                }
            }
        }
        __syncthreads();
        if (w == 0 && st + 1 < 36) ML_SCALARS(st + 1);
        if (st >= 4) {
            const f32x4 dn = *(const LAS f32x4*)(sDEN + t0), em = *(const LAS f32x4*)(sEM + t0);
#pragma unroll
            for (int j = 0; j < 2; ++j) { const int vt = (w < 4) ? j : 2 + j; const int col = h * 256 + vs * 64 + 16 * vt + l15;
#pragma unroll
                for (int r = 0; r < 4; ++r) { const int row = row0 + t0 + r;
                    const float hv = nacc[j][r] / fmaxf(fabsf(dn[r]), em[r]);
                    const float o = sigmoidf_(bf2f(og[j][r]));
                    AM[(size_t)row * 2048 + dir * 1024 + col] = (unsigned char)(pk4_fp8(fminf(fmaxf(o * hv, -448.f), 448.f), 0.f, 0.f, 0.f) & 0xffu); } }
        }
#pragma unroll
        for (int a = 0; a < 2; ++a)
#pragma unroll
            for (int c = 0; c < 5; ++c) { u32x2 o; o.x = pk2(cacc[a][c][0], cacc[a][c][1]); o.y = pk2(cacc[a][c][2], cacc[a][c][3]);
                *(LAS u32x2*)(Cs + (16 * c + l15) * ML_QS + 16 * (2 * w + a) + 4 * g4) = o; }
    }
    __syncthreads();
#undef ML_LOAD
#undef ML_STORE
#undef ML_ROW0
#undef ML_SCALARS
}

constexpr int HY_RAW = 2 * FFT_BUF_BYTES, HY_OUT = HY_RAW + 16384, HY_END = HY_OUT + 65536;
static_assert(HY_END <= MISC_OFF, "hyena LDS");
__device__ __forceinline__ void hy_conv(const LAS bf16_t* raw, const float* cw, float bias, int c3, int ht, f32x2 (&o)[8]) {
    float w9[9];
#pragma unroll
    for (int q = 0; q < 9; ++q) w9[q] = cw[q * 3072 + c3];
    asm volatile("" : "+v"(ht));
    const int x = ht & 63;
#pragma unroll
    for (int a = 0; a < 8; ++a) { const int t = 256 * a + ht, y = t >> 6; float a0 = bias, a1 = bias;
#pragma unroll
        for (int dy = -1; dy <= 1; ++dy)
#pragma unroll
            for (int dx = -1; dx <= 1; ++dx) { const int yy = y + dy, xx = x + dx;
                if (yy >= 0 && yy < 32 && xx >= 0 && xx < 64) { const int idx = t + 64 * dy + dx; const float wv = w9[(dy + 1) * 3 + dx + 1];
                    a0 += wv * bf2f((unsigned)raw[idx]); a1 += wv * bf2f((unsigned)raw[2048 + idx]); } }
        o[a] = (f32x2){a0, a1}; asm volatile("" ::: "memory"); }
}
__device__ __forceinline__ void hyena_unit(Frame& F, int un) {
    const KargP in = karg_opaque(F.in);
    const int cg = un >> 2, bp = un & 3, c0 = cg * 8, b0 = bp * 2;
    const int hb = F.tid >> 8, ht = F.tid & 255;
    LAS f32x2* buf = (LAS f32x2*)(F.lds + hb * FFT_BUF_BYTES);
    LAS bf16_t* raw = (LAS bf16_t*)(F.lds + HY_RAW + hb * 8192);
    LAS bf16_t* outT = (LAS bf16_t*)(F.lds + HY_OUT);
    const bf16_t* ZT = WSP(bf16_t, WS_ZT); const f32x2* H = WSP(f32x2, WS_H);
    const FftTw tw = fft_tw(ht);
    __syncthreads();
#define HY_FETCH(dst, kind, ch) do { _Pragma("unroll") for (int bb = 0; bb < 2; ++bb) dst[bb] = *(const u32x4*)(ZT + ((size_t)(b0 + bb) * 3072 + (kind) * 1024 + (ch)) * SEQ + ht * 8); } while (0)
#define HY_PUT(srcv) do { _Pragma("unroll") for (int bb = 0; bb < 2; ++bb) *(LAS u32x4*)(raw + bb * 2048 + ht * 8) = srcv[bb]; } while (0)
    u32x4 rv[2], rn[2];
    HY_FETCH(rv, 2, c0 + hb);
#pragma unroll 1
    for (int i = 0; i < 4; ++i) {
        const int cl = 2 * i + hb, c = c0 + cl;
        HY_PUT(rv);
        HY_FETCH(rn, 0, c);
        __syncthreads();
        f32x2 vin[8], v[16], hv[16];
        hy_conv(raw, in[I_HCW], in[I_HCB][2048 + c], 2048 + c, ht, vin);
#pragma unroll
        for (int a = 0; a < 8; ++a) { v[a] = vin[a]; v[8 + a] = (f32x2){0.f, 0.f}; }
        { const f32x2* Hd = H + (size_t)(c * 2 + 0) * 4096;
#pragma unroll
          for (int ks = 0; ks < 16; ++ks) hv[ks] = Hd[ks * 256 + ht]; }
        fft_fwd(v, buf, ht, tw);
#pragma unroll
        for (int ks = 0; ks < 16; ++ks) v[ks] = cmul(v[ks], hv[ks]);
        fft_inv(v, buf, ht, tw);
        HY_PUT(rn);
        HY_FETCH(rv, 1, c);
        __syncthreads();
        { f32x2 g[8]; hy_conv(raw, in[I_HCW], in[I_HCB][c], c, ht, g); const float sk = in[I_HSKIP][c];
#pragma unroll
          for (int a = 0; a < 8; ++a) vin[a] = g[a] * (v[a] + vin[a] * sk); }
#pragma unroll
        for (int a = 0; a < 8; ++a) { v[a] = vin[a]; v[8 + a] = (f32x2){0.f, 0.f}; }
        { const f32x2* Hd = H + (size_t)(c * 2 + 1) * 4096;
#pragma unroll
          for (int ks = 0; ks < 16; ++ks) hv[ks] = Hd[ks * 256 + ht]; }
        fft_fwd(v, buf, ht, tw);
#pragma unroll
        for (int ks = 0; ks < 16; ++ks) v[ks] = cmul(v[ks], hv[ks]);
        fft_inv(v, buf, ht, tw);
        HY_PUT(rv);
        if (i < 3) HY_FETCH(rv, 2, c + 2);
        __syncthreads();
        { f32x2 g[8]; hy_conv(raw, in[I_HCW], in[I_HCB][1024 + c], 1024 + c, ht, g); const float sk = in[I_HSKIP][1024 + c];
#pragma unroll
          for (int a = 0; a < 8; ++a) { const f32x2 o = g[a] * (v[a] + vin[a] * sk); const int t = 256 * a + ht;
              outT[(0 * 2048 + t) * 8 + cl] = (bf16_t)f2bf(o.x); outT[(1 * 2048 + t) * 8 + cl] = (bf16_t)f2bf(o.y); } }
        __syncthreads();
    }
#undef HY_FETCH
#undef HY_PUT
    bf16_t* HH = WSP(bf16_t, WS_HH);
#pragma unroll
    for (int q = 0; q < 8; ++q) { const int r = F.tid + 512 * q, bb = r >> 11, t = r & 2047;
        *(u32x4*)(HH + ((size_t)(b0 + bb) * SEQ + t) * HW + c0) = *(const LAS u32x4*)(outT + r * 8); }
    __syncthreads();
}

struct SchedP {
    static constexpr bool GATHER = false;
    int G, c; const char* a; const char* b; size_t astep, bstep;
    __device__ __forceinline__ bool next(int i, Unit& u) const { const int L = i * G + c; if (L >= 512) return false; pg8::decode_tile(L, 64, 8, u.pm, u.pn); u.ex = 0; return true; }
    __device__ __forceinline__ const char* a_base(const Unit& u) const { return a + (size_t)u.pm * astep; }
    __device__ __forceinline__ const char* b_base(const Unit& u) const { return b + (size_t)u.pn * bstep; }
    __device__ __forceinline__ int a_row(const Unit&, int R) const { return R; }
};
struct EpiMA {
    static constexpr bool PERM = true;
    float* T; const bf16_t* Z;
    __device__ __forceinline__ void operator()(const f32x4 (&acc)[2][2][4][2], const Unit& u, int wr, int wc, int fr, int fq) const {
        const int row0 = u.pm * 256 + wr * 64 + fr, col0 = u.pn * 256 + wc * 32 + 8 * fq;
#pragma unroll
        for (int ai = 0; ai < 2; ++ai)
#pragma unroll
            for (int m = 0; m < 4; ++m) { const size_t row = row0 + ai * 128 + m * 16;
#pragma unroll
                for (int bj = 0; bj < 2; ++bj) { const int c = col0 + bj * 128;
                    const u32x4 gz = *(const u32x4*)(Z + row * ZN + ZC_GA + c);
                    f32x4 g0 = (f32x4){sigmoidf_(bflo(gz.x)), sigmoidf_(bfhi(gz.x)), sigmoidf_(bflo(gz.y)), sigmoidf_(bfhi(gz.y))};
                    f32x4 g1 = (f32x4){sigmoidf_(bflo(gz.z)), sigmoidf_(bfhi(gz.z)), sigmoidf_(bflo(gz.w)), sigmoidf_(bfhi(gz.w))};
                    *(f32x4*)(T + row * DM + c) = acc[ai][bj][m][0] * g0; *(f32x4*)(T + row * DM + c + 4) = acc[ai][bj][m][1] * g1; } }
    }
};
struct EpiMB {
    static constexpr bool PERM = true;
    const float* T; const bf16_t* Z; unsigned char* MX;
    __device__ __forceinline__ void operator()(const f32x4 (&acc)[2][2][4][2], const Unit& u, int wr, int wc, int fr, int fq) const {
        const int row0 = u.pm * 256 + wr * 64 + fr, col0 = u.pn * 256 + wc * 32 + 8 * fq;
#pragma unroll
        for (int ai = 0; ai < 2; ++ai)
#pragma unroll
            for (int m = 0; m < 4; ++m) { const size_t row = row0 + ai * 128 + m * 16;
#pragma unroll
                for (int bj = 0; bj < 2; ++bj) { const int c = col0 + bj * 128;
                    const u32x4 gz = *(const u32x4*)(Z + row * ZN + ZC_GH + c);
                    const f32x4 t0 = *(const f32x4*)(T + row * DM + c), t1 = *(const f32x4*)(T + row * DM + c + 4);
                    f32x4 g0 = (f32x4){sigmoidf_(bflo(gz.x)), sigmoidf_(bfhi(gz.x)), sigmoidf_(bflo(gz.y)), sigmoidf_(bfhi(gz.y))};
                    f32x4 g1 = (f32x4){sigmoidf_(bflo(gz.z)), sigmoidf_(bfhi(gz.z)), sigmoidf_(bflo(gz.w)), sigmoidf_(bfhi(gz.w))};
                    const f32x4 v0 = t0 + acc[ai][bj][m][0] * g0, v1 = t1 + acc[ai][bj][m][1] * g1;
                    const f32x4 c0 = __builtin_elementwise_min(__builtin_elementwise_max(v0, (f32x4){-448.f, -448.f, -448.f, -448.f}), (f32x4){448.f, 448.f, 448.f, 448.f});
                    const f32x4 c1 = __builtin_elementwise_min(__builtin_elementwise_max(v1, (f32x4){-448.f, -448.f, -448.f, -448.f}), (f32x4){448.f, 448.f, 448.f, 448.f});
                    u32x2 w; w.x = pk4_fp8(c0[0], c0[1], c0[2], c0[3]); w.y = pk4_fp8(c1[0], c1[1], c1[2], c1[3]);
                    *(u32x2*)(MX + row * DM + c) = w; } }
    }
};
struct EpiWO {
    static constexpr bool PERM = false;
    float* R1; const float* x; const float* stats; const float* lng; const float* lnb; const float* mod;
    __device__ __forceinline__ void operator()(const f32x4 (&acc)[2][2][4][2], const Unit& u, int wr, int wc, int fr, int fq) const {
        const int row0 = u.pm * 256 + wr * 64 + fr, col0 = u.pn * 256 + wc * 32 + 4 * fq;
        const float* g1p = mod + (size_t)(u.pm >> 3) * 12288 + 4096;
#pragma unroll
        for (int ai = 0; ai < 2; ++ai)
#pragma unroll
            for (int m = 0; m < 4; ++m) { const size_t row = row0 + ai * 128 + m * 16; const float mean = stats[row * 2], rstd = stats[row * 2 + 1];
#pragma unroll
                for (int bj = 0; bj < 2; ++bj)
#pragma unroll
                    for (int n = 0; n < 2; ++n) { const int c = col0 + bj * 128 + n * 16;
                        const f32x4 xv = *(const f32x4*)(x + row * DM + c), g = *(const f32x4*)(lng + c), bb = *(const f32x4*)(lnb + c), g1 = *(const f32x4*)(g1p + c);
                        *(f32x4*)(R1 + row * DM + c) = ((xv - mean) * rstd * g + bb) * DN_ALPHA + g1 * acc[ai][bj][m][n]; } }
    }
};

struct CwItem { const float* src; unsigned char* dst; float scale; };
__device__ __forceinline__ CwItem cw_decode(KargP in, unsigned char* ws, int it) {
    CwItem c;
    if (it < NEXP * 2048) { const int e = it >> 11, q = it & 2047, g = q & 127, kb = q >> 7; const int n0 = 32 * g, tile = n0 >> 8, within = n0 & 255;
        c.src = (within < 128 ? in[I_WG] : in[I_WU]) + (size_t)e * DM * DM + (size_t)(128 * kb) * DM + tile * 128 + (within & 127);
        c.dst = ws + WS_WGU + ((size_t)e * 4096 + n0) * DM + 128 * kb; c.scale = 32.f; }
    else { const int r2 = it - NEXP * 2048; const int e = r2 >> 10, q = r2 & 1023, g = q & 63, kb = q >> 6;
        c.src = in[I_WDN] + (size_t)e * DM * DM + (size_t)(128 * kb) * DM + 32 * g;
        c.dst = ws + WS_WD + ((size_t)e * 2048 + 32 * g) * DM + 128 * kb; c.scale = 64.f; }
    return c;
}
constexpr int CV_E8 = 8;
__device__ __forceinline__ int cw_map(int i) { return i < CV_E8 * 2048 ? i : NEXP * 2048 + (i - CV_E8 * 2048); }
__device__ __forceinline__ void convert_moe_wave(KargP in, unsigned char* ws, LAS unsigned char* tile, int lane, int cw, int ncw) {
    constexpr int NIT = CV_E8 * (2048 + 1024);
    const int kq = lane >> 3, nq = lane & 7;
#define CW_LOAD(v, c) do { _Pragma("unroll") for (int i_ = 0; i_ < 16; ++i_) v[i_] = *(const f32x4*)((c).src + (size_t)(16 * kq + i_) * DM + 4 * nq); } while (0)
#define CW_PROC(v, c) do { \
        _Pragma("unroll") for (int j_ = 0; j_ < 4; ++j_) { u32x4 o_; const float s_ = (c).scale; \
            o_.x = pk4_fp8(v[0][j_] * s_, v[1][j_] * s_, v[2][j_] * s_, v[3][j_] * s_);     o_.y = pk4_fp8(v[4][j_] * s_, v[5][j_] * s_, v[6][j_] * s_, v[7][j_] * s_); \
            o_.z = pk4_fp8(v[8][j_] * s_, v[9][j_] * s_, v[10][j_] * s_, v[11][j_] * s_);   o_.w = pk4_fp8(v[12][j_] * s_, v[13][j_] * s_, v[14][j_] * s_, v[15][j_] * s_); \
            *(LAS u32x4*)(tile + (4 * nq + j_) * 144 + 16 * kq) = o_; } \
        asm volatile("s_waitcnt lgkmcnt(0)" ::: "memory"); \
        _Pragma("unroll") for (int q_ = 0; q_ < 4; ++q_) { const int idx_ = lane + 64 * q_, row_ = idx_ >> 3, piece_ = idx_ & 7; \
            *(u32x4*)((c).dst + (size_t)row_ * DM + 16 * piece_) = *(const LAS u32x4*)(tile + row_ * 144 + 16 * piece_); } \
        asm volatile("s_waitcnt lgkmcnt(0)" ::: "memory"); } while (0)
    f32x4 va[16], vb[16];
    int it = cw;
    if (it >= NIT) return;
    CwItem ca = cw_decode(in, ws, cw_map(it)), cb = ca;
    CW_LOAD(va, ca);
    for (;;) {
        const bool hb = it + ncw < NIT;
        if (hb) { cb = cw_decode(in, ws, cw_map(it + ncw)); CW_LOAD(vb, cb); }
        CW_PROC(va, ca);
        if (!hb) break;
        it += ncw;
        const bool ha = it + ncw < NIT;
        if (ha) { ca = cw_decode(in, ws, cw_map(it + ncw)); CW_LOAD(va, ca); }
        CW_PROC(vb, cb);
        if (!ha) break;
        it += ncw;
    }
#undef CW_LOAD
#undef CW_PROC
}

__device__ __forceinline__ void p8_phase(Frame& F) {
    const KargP in = karg_opaque(F.in);
    const int lane = F.lane, l15 = lane & 15, g4 = lane >> 4;
    if (F.wave >= 4) {
        convert_moe_wave(in, F.ws, (LAS unsigned char*)(F.lds + 4 * 20480 + (F.wave - 4) * 4608), lane, F.bid * 4 + (F.wave - 4), F.G * 4);
        return; }
    const float* R1 = WSP(float, WS_R1); unsigned char* TOK = WSP(unsigned char, WS_TOK); const float* mod = WSP(float, WS_MOD);
    LAS float* pA = (LAS float*)(F.lds + F.wave * 20480);
    LAS float* pB = pA + 2048;
    LAS float* lg = pA + 4096;
    LAS int* te = (LAS int*)(lg + 576); LAS float* tw = (LAS float*)(te + 64);
    const float* wr = in[I_WR];
#pragma unroll 1
    for (int tile = F.bid + F.G * F.wave; tile < MTOK / 16; tile += F.G * 4) {
        const int bsel = (tile * 16) / SEQ; const float* mv = mod + (size_t)bsel * 12288;
#pragma unroll
        for (int j = 0; j < 8; ++j) { const int c = lane * 4 + 256 * j;
            const f32x4 g = *(const f32x4*)(in[I_LN1G] + c), bb = *(const f32x4*)(in[I_LN1B] + c), sh = *(const f32x4*)(mv + 6144 + c), sc = *(const f32x4*)(mv + 8192 + c) + 1.0f;
            *(LAS f32x4*)(pA + c) = g * sc; *(LAS f32x4*)(pB + c) = bb * sc + sh; }
        LDS_WAIT(); asm volatile("" ::: "memory");
        float my_mean = 0.f, my_rstd = 0.f;
        {
            const float* xb = R1 + (size_t)tile * 16 * DM + lane * 4;
            f32x4 v[8], vn[8];
#pragma unroll
            for (int j = 0; j < 8; ++j) v[j] = *(const f32x4*)(xb + 256 * j);
#pragma unroll 1
            for (int rr = 0; rr < 16; ++rr) {
                const float* xn = xb + (size_t)(rr < 15 ? rr + 1 : rr) * DM;
#pragma unroll
                for (int j = 0; j < 8; ++j) vn[j] = *(const f32x4*)(xn + 256 * j);
                float s = 0.f;
#pragma unroll
                for (int j = 0; j < 8; ++j) s += (v[j].x + v[j].y) + (v[j].z + v[j].w);
                const float mean = wave_sum(s) * (1.f / DM); float s2 = 0.f;
#pragma unroll
                for (int j = 0; j < 8; ++j) { v[j] = v[j] - mean; s2 += (v[j].x * v[j].x + v[j].y * v[j].y) + (v[j].z * v[j].z + v[j].w * v[j].w); }
                const float rstd = 1.f / sqrtf(wave_sum(s2) * (1.f / DM) + LN_EPS);
                if (l15 == rr) { my_mean = mean; my_rstd = rstd; }
                unsigned char* orow = TOK + (size_t)(tile * 16 + rr) * DM;
#pragma unroll
                for (int j = 0; j < 8; ++j) { const int c = lane * 4 + 256 * j;
                    const f32x4 y = v[j] * rstd * *(const LAS f32x4*)(pA + c) + *(const LAS f32x4*)(pB + c);
                    *(unsigned*)(orow + c) = pk4_fp8(y.x, y.y, y.z, y.w); }
#pragma unroll
                for (int j = 0; j < 8; ++j) v[j] = vn[j];
            }
        }
        f32x4 acc0 = (f32x4){0.f, 0.f, 0.f, 0.f}, acc1 = (f32x4){0.f, 0.f, 0.f, 0.f};
        const float* rowp = R1 + (size_t)(tile * 16 + l15) * DM + 512 * g4;
        const float* wp = wr + (size_t)(512 * g4) * 32 + l15;
        const float ra = my_rstd, rm = -my_mean * my_rstd;
        f32x4 r4 = *(const f32x4*)rowp; float w0[4], w1[4];
#pragma unroll
        for (int j = 0; j < 4; ++j) { w0[j] = wp[j * 32]; w1[j] = wp[j * 32 + 16]; }
#pragma unroll 1
        for (int s = 0; s < 512; s += 4) {
            const int sn = s + 4 < 512 ? s + 4 : s;
            const f32x4 r4n = *(const f32x4*)(rowp + sn); float w0n[4], w1n[4];
#pragma unroll
            for (int j = 0; j < 4; ++j) { w0n[j] = wp[(sn + j) * 32]; w1n[j] = wp[(sn + j) * 32 + 16]; }
            const f32x4 av = *(const LAS f32x4*)(pA + 512 * g4 + s), bv = *(const LAS f32x4*)(pB + 512 * g4 + s);
            const f32x4 tk = (r4 * ra + rm) * av + bv;
#pragma unroll
            for (int j = 0; j < 4; ++j) { acc0 = __builtin_amdgcn_mfma_f32_16x16x4f32(tk[j], w0[j], acc0, 0, 0, 0); acc1 = __builtin_amdgcn_mfma_f32_16x16x4f32(tk[j], w1[j], acc1, 0, 0, 0); }
            r4 = r4n;
#pragma unroll
            for (int j = 0; j < 4; ++j) { w0[j] = w0n[j]; w1[j] = w1n[j]; }
        }
        { const float b0 = in[I_BR][l15], b1 = in[I_BR][16 + l15];
#pragma unroll
          for (int r = 0; r < 4; ++r) { lg[(4 * g4 + r) * 33 + l15] = acc0[r] + b0; lg[(4 * g4 + r) * 33 + 16 + l15] = acc1[r] + b1; } }
        LDS_WAIT(); asm volatile("" ::: "memory");
        if (lane < 16) {
            unsigned chosen = 0u; float lv[4]; int le[4];
            for (int k = 0; k < 4; ++k) { float best = -3.4e38f; int be = 0;
                for (int e = 0; e < 32; ++e) { const float v = lg[lane * 33 + e]; if (!((chosen >> e) & 1u) && v > best) { best = v; be = e; } }
                chosen |= 1u << be; lv[k] = best; le[k] = be; }
            float ex[4], sum = 0.f;
            for (int k = 0; k < 4; ++k) { ex[k] = __expf(lv[k] - lv[0]); sum += ex[k]; }
            for (int k = 0; k < 4; ++k) { te[lane * 4 + k] = le[k]; tw[lane * 4 + k] = ex[k] / sum; }
        }
        LDS_WAIT(); asm volatile("" ::: "memory");
        { const int e = te[lane]; const float wv = tw[lane]; const int token = tile * 16 + (lane >> 2);
          const int pos = (int)__hip_atomic_fetch_add(F.ctl + CW_CNT + 64 * e, 1u, __ATOMIC_RELAXED, __HIP_MEMORY_SCOPE_AGENT);
          WSP(int, WS_TOPE)[token * 4 + (lane & 3)] = e; WSP(int, WS_TOPP)[token * 4 + (lane & 3)] = pos; WSP(float, WS_TOPW)[token * 4 + (lane & 3)] = wv;
          WSP(int, WS_RTOK)[e * POSCAP + pos] = token; }
        LDS_WAIT(); asm volatile("" ::: "memory");
    }
}

constexpr int MOE_TBL = 131072;
__device__ __forceinline__ void moe_table(Frame& F) {
    LAS int* tst = (LAS int*)(F.lds + MOE_TBL); LAS int* cn = (LAS int*)(F.lds + MOE_TBL + 256);
    __syncthreads();
    if (F.tid < 64) {
        const int e = F.tid & 31; const int c = (int)__hip_atomic_load(F.ctl + CW_CNT + 64 * e, __ATOMIC_RELAXED, __HIP_MEMORY_SCOPE_AGENT);
        int inc = (c + 255) >> 8;
#pragma unroll
        for (int o = 1; o < 32; o <<= 1) { const int t = __shfl_up(inc, o); if ((F.tid & 31) >= o) inc += t; }
        if (F.tid < 32) { cn[e] = c; tst[e] = inc - ((c + 255) >> 8); if (e == 31) tst[NEXP] = inc; } }
    __syncthreads();
}
template <bool GU> struct SchedMoE {
    static constexpr bool GATHER = GU;
    int G, c, NT; const LAS int* tst; const LAS int* cn; const int* rtok; const char* a; const char* b;
    __device__ __forceinline__ bool next(int i, Unit& u) const {
        const int nwg = __builtin_amdgcn_readfirstlane(tst[NEXP]) * NT; const int L = i * G + c; if (L >= nwg) return false;
        int wg; { const int q = nwg / 8, r = nwg % 8, xcd = L % 8, off = L / 8; wg = (xcd < r ? xcd * (q + 1) : r * (q + 1) + (xcd - r) * q) + off; }
        int e = 0;
#pragma unroll 1
        for (int k = 1; k < NEXP; ++k) { const int s = __builtin_amdgcn_readfirstlane(tst[k]); if (wg >= s * NT) e = k; }
        const int ts = __builtin_amdgcn_readfirstlane(tst[e]), ts1 = __builtin_amdgcn_readfirstlane(tst[e + 1]);
        const int rem = wg - ts * NT, ne = ts1 - ts;
        u.pm = ts + rem % ne; u.pn = rem / ne; u.ex = e; return true;
    }
    __device__ __forceinline__ const char* a_base(const Unit& u) const { return GU ? a : a + (size_t)u.pm * 256 * DM; }
    __device__ __forceinline__ const char* b_base(const Unit& u) const { return b + ((size_t)u.ex * (GU ? 4096 : 2048) + 256 * u.pn) * DM; }
    __device__ __forceinline__ int a_row(const Unit& u, int R) const { const int cnt = __builtin_amdgcn_readfirstlane(cn[u.ex]), t0 = __builtin_amdgcn_readfirstlane(tst[u.ex]); int pos = (u.pm - t0) * 256 + R; pos = pos < cnt ? pos : cnt - 1; return rtok[u.ex * POSCAP + pos]; }
};
struct EpiGU {
    static constexpr bool PERM = true;
    unsigned char* ACT; const float* bg; const float* bu;
    __device__ __forceinline__ void operator()(const f32x4 (&acc)[2][2][4][2], const Unit& u, int wr, int wc, int fr, int fq) const {
        const int row0 = u.pm * 256 + wr * 64 + fr, col0 = u.pn * 128 + wc * 32 + 8 * fq;
        const float* bgp = bg + (size_t)u.ex * DM + col0; const float* bup = bu + (size_t)u.ex * DM + col0;
        const f32x4 g0 = *(const f32x4*)bgp, g1 = *(const f32x4*)(bgp + 4), u0 = *(const f32x4*)bup, u1 = *(const f32x4*)(bup + 4);
#pragma unroll
        for (int ai = 0; ai < 2; ++ai)
#pragma unroll
            for (int m = 0; m < 4; ++m) { const size_t row = row0 + ai * 128 + m * 16;
                float o[8];
#pragma unroll
                for (int n = 0; n < 2; ++n)
#pragma unroll
                    for (int j = 0; j < 4; ++j) { const float gv = fminf(acc[ai][0][m][n][j] + (n ? g1[j] : g0[j]), 7.0f);
                        const float uv = fminf(fmaxf(acc[ai][1][m][n][j] + (n ? u1[j] : u0[j]), -7.0f), 7.0f);
                        o[n * 4 + j] = 4.0f * gv * sigmoidf_(1.702f * gv) * (uv + 1.0f); }
                u32x2 w; w.x = pk4_fp8(o[0], o[1], o[2], o[3]); w.y = pk4_fp8(o[4], o[5], o[6], o[7]);
                *(u32x2*)(ACT + row * DM + col0) = w; }
    }
};
struct EpiDN {
    static constexpr bool PERM = true;
    bf16_t* YR; const float* bd;
    __device__ __forceinline__ void operator()(const f32x4 (&acc)[2][2][4][2], const Unit& u, int wr, int wc, int fr, int fq) const {
        const int r0 = wr * 64 + fr, col0 = u.pn * 256 + wc * 32 + 8 * fq;
        const float* bp = bd + (size_t)u.ex * DM + col0;
        bf16_t* base = YR + ((size_t)u.pm * 256 + r0) * DM + col0;
#pragma unroll
        for (int bj = 0; bj < 2; ++bj) {
            const f32x4 bv0 = *(const f32x4*)(bp + bj * 128), bv1 = *(const f32x4*)(bp + bj * 128 + 4);
#pragma unroll
            for (int ai = 0; ai < 2; ++ai)
#pragma unroll
                for (int m = 0; m < 4; ++m) {
                    const f32x4 v0 = acc[ai][bj][m][0] + bv0, v1 = acc[ai][bj][m][1] + bv1;
                    u32x4 w; w.x = pg8::cvt_pk_bf16(v0[0], v0[1]); w.y = pg8::cvt_pk_bf16(v0[2], v0[3]); w.z = pg8::cvt_pk_bf16(v1[0], v1[1]); w.w = pg8::cvt_pk_bf16(v1[2], v1[3]);
                    *(u32x4*)(base + (size_t)(ai * 128 + m * 16) * DM + bj * 128) = w; }
        }
    }
};

__device__ __forceinline__ void p11_phase(Frame& F) {
    const KargP in = karg_opaque(F.in);
    const int gw = F.bid * NWAVES + F.wave, NGW = F.G * NWAVES, lane = F.lane;
    const LAS int* tst = (const LAS int*)(F.lds + MOE_TBL);
    const float* R1 = WSP(float, WS_R1); const bf16_t* YR = WSP(bf16_t, WS_YR); const float* mod = WSP(float, WS_MOD);
    LAS float* pl = (LAS float*)F.lds;
    for (int i = F.tid; i < 2048; i += NTHR) { pl[i] = in[I_LN1G][i]; pl[2048 + i] = in[I_LN1B][i]; pl[4096 + i] = in[I_LN2G][i]; pl[6144 + i] = in[I_LN2B][i]; }
    for (int i = F.tid; i < 8 * 2048; i += NTHR) pl[8192 + i] = mod[(size_t)(i >> 11) * 12288 + 10240 + (i & 2047)];
    __syncthreads();
    LAS int* sd = (LAS int*)(F.lds + 98304 + F.wave * 512); LAS float* sw = (LAS float*)(F.lds + 98304 + F.wave * 512 + 256);
#pragma unroll 1
    for (int rb = gw * 8; rb < MTOK; rb += NGW * 8) {
        const int li = lane & 31;
        { const int ve = WSP(int, WS_TOPE)[rb * 4 + li], vp = WSP(int, WS_TOPP)[rb * 4 + li]; const float vw = WSP(float, WS_TOPW)[rb * 4 + li];
          if (lane < 32) { sd[li] = tst[ve] * 256 + vp; sw[li] = vw; } }
        const LAS float* g2p = pl + 8192 + (rb / SEQ) * 2048;
        LDS_WAIT(); asm volatile("" ::: "memory");
#pragma unroll 1
        for (int ri = 0; ri < 8; ++ri) {
            const int row = rb + ri;
            int dest[4]; float wk[4];
#pragma unroll
            for (int k = 0; k < 4; ++k) { dest[k] = __builtin_amdgcn_readfirstlane(sd[ri * 4 + k]); wk[k] = __builtin_bit_cast(float, __builtin_amdgcn_readfirstlane(__builtin_bit_cast(int, sw[ri * 4 + k]))); }
            const float* xr = R1 + (size_t)row * DM + lane * 4;
            f32x4 v[8]; u32x2 yy[4][8];
#pragma unroll
            for (int j = 0; j < 8; ++j) v[j] = *(const f32x4*)(xr + 256 * j);
#pragma unroll
            for (int k = 0; k < 4; ++k) { const bf16_t* yp = YR + (size_t)dest[k] * DM + lane * 4;
#pragma unroll
                for (int j = 0; j < 8; ++j) yy[k][j] = *(const u32x2*)(yp + 256 * j); }
            float s = 0.f;
#pragma unroll
            for (int j = 0; j < 8; ++j) s += (v[j].x + v[j].y) + (v[j].z + v[j].w);
            float mean = wave_sum(s) * (1.f / DM); float s2 = 0.f;
#pragma unroll
            for (int j = 0; j < 8; ++j) { v[j] = v[j] - mean; s2 += (v[j].x * v[j].x + v[j].y * v[j].y) + (v[j].z * v[j].z + v[j].w * v[j].w); }
            float rstd = 1.f / sqrtf(wave_sum(s2) * (1.f / DM) + LN_EPS);
            s = 0.f;
#pragma unroll
            for (int j = 0; j < 8; ++j) { const int c = lane * 4 + 256 * j;
                const f32x4 g = *(const LAS f32x4*)(pl + c), bb = *(const LAS f32x4*)(pl + 2048 + c), g2v = *(const LAS f32x4*)(g2p + c);
                f32x4 y = (f32x4){0.f, 0.f, 0.f, 0.f};
#pragma unroll
                for (int k = 0; k < 4; ++k) y += (f32x4){bflo(yy[k][j].x), bfhi(yy[k][j].x), bflo(yy[k][j].y), bfhi(yy[k][j].y)} * wk[k];
                v[j] = (v[j] * rstd * g + bb) * DN_ALPHA + g2v * y;
                s += (v[j].x + v[j].y) + (v[j].z + v[j].w); __builtin_amdgcn_sched_barrier(0); }
            mean = wave_sum(s) * (1.f / DM); s2 = 0.f;
#pragma unroll
            for (int j = 0; j < 8; ++j) { v[j] = v[j] - mean; s2 += (v[j].x * v[j].x + v[j].y * v[j].y) + (v[j].z * v[j].z + v[j].w * v[j].w); }
            rstd = 1.f / sqrtf(wave_sum(s2) * (1.f / DM) + LN_EPS);
            float* orow = F.out + (size_t)row * DM;
#pragma unroll
            for (int j = 0; j < 8; ++j) { const int c = lane * 4 + 256 * j;
                const f32x4 g = *(const LAS f32x4*)(pl + 4096 + c), bb = *(const LAS f32x4*)(pl + 6144 + c);
                *(f32x4*)(orow + c) = v[j] * rstd * g + bb; }
        }
        LDS_WAIT(); asm volatile("" ::: "memory");
    }
}

constexpr int NPHASE = 13;
__global__ void __launch_bounds__(NTHR, 2) mk_fwd(Args args) {
    extern __shared__ __attribute__((aligned(16))) unsigned char lds_raw[];
    Frame F;
    F.lds = (LAS unsigned char*)lds_raw;
    F.MISC = (volatile LAS unsigned*)(F.lds + MISC_OFF);
    F.tid = threadIdx.x; F.lane = F.tid & 63; F.wave = __builtin_amdgcn_readfirstlane(F.tid >> 6);
    F.G = gridDim.x; F.bid = blockIdx.x;
    F.in = (KargP)__builtin_amdgcn_kernarg_segment_ptr(); F.out = args.out; F.ws = args.ws; F.ctl = (unsigned*)(args.ws + WS_CTL);
    for (int u = F.tid; u < (LDS_BYTES - MISC_OFF) / 4; u += NTHR) ((LAS unsigned*)(F.lds + MISC_OFF))[u] = 0u;
    __syncthreads();
    XcdBarrier bar; bar.bar = F.ctl + CW_BAR; bar.x = 0; bar.st = nullptr;
    if (MK_LAUNCHES == 1) bar = xcd_barrier_post(F.ctl + CW_BAR, F.MISC + 8);
    const int lo = args.ph_lo, hi = args.ph_hi;
#ifndef PH_MASK
#define PH_MASK 0xFFFF
#endif
#define RELOAD() do { const KargP k_ = karg_opaque(F.in); F.out = (float*)k_[38]; F.ws = (unsigned char*)k_[39]; F.ctl = (unsigned*)F.ws; int t_ = threadIdx.x; asm volatile("" : "+v"(t_)); F.tid = t_; F.lane = t_ & 63; F.wave = __builtin_amdgcn_readfirstlane(t_ >> 6); } while (0)
#define IN(k) (((PH_MASK >> (k)) & 1) && lo <= (k) && (k) < hi)
#define SEAM(k) do { if (IN(k) && IN((k) + 1)) xcd_barrier(bar); } while (0)
#ifndef DUP_MASK
#define DUP_MASK 0
#endif
#define REP(k) for (int rep_ = 0; rep_ < (((DUP_MASK >> (k)) & 1) ? 2 : 1); ++rep_)
    if (IN(0)) REP(0) p0_phase(F);
    SEAM(0);
    RELOAD();
    if (IN(1)) REP(1) p0b_phase(F);
    SEAM(1);
    RELOAD();
    if (IN(2)) REP(2) p1_phase(F);
    SEAM(2);
    RELOAD();
    if (IN(3)) REP(3) {
        EpiZ E{WSP(bf16_t, WS_Z), WSP(bf16_t, WS_ZT), WSP(float, WS_BINP)};
        { SchedZ<false> S{F.G, F.bid, (const char*)WSP(bf16_t, WS_HX), (const char*)WSP(bf16_t, WS_WIN)};
          pg8::gemm_phase<EpiZ, SchedZ<false>>(F.lds, DM / 64, DM * 2, DM * 2, S, E); }
        { SchedZ<true> S{F.G, F.G - 1 - F.bid, (const char*)WSP(unsigned char, WS_HX8), (const char*)WSP(unsigned char, WS_WIN8)};
          pg8::gemm_phase<EpiZ, SchedZ<true>, true>(F.lds, DM / 128, DM, DM, S, E, 0x7A7A7A7A, 0x7F7F7F7F); }
    }
    SEAM(3);
    RELOAD();
    if (IN(4)) REP(4) p3_phase(F);
    SEAM(4);
    RELOAD();
    if (IN(5)) REP(5) {
        SchedQK S{F.G, F.bid, (const char*)WSP(bf16_t, WS_U), (const char*)WSP(bf16_t, WS_WQK)};
        EpiQK E{WSP(bf16_t, WS_QKB)};
        pg8::gemm_phase<EpiQK, SchedQK>(F.lds, 256 / 64, MW * 2, 256 * 2, S, E);
    }
    SEAM(5);
    RELOAD();
    if (IN(6)) REP(6) {
#ifndef DUP_ML
#define DUP_ML 1
#endif
#ifndef DUP_HY
#define DUP_HY 1
#endif
        for (int un = F.bid; un < 256 * DUP_ML; un += F.G) mlstm_unit(F, un & 255);
        for (int un = F.bid; un < 512 * DUP_HY; un += F.G) hyena_unit(F, un & 511);
    }
    SEAM(6);
    RELOAD();
    if (IN(7)) REP(7) {
        { SchedP S{F.G, F.bid, (const char*)WSP(unsigned char, WS_AM), (const char*)WSP(unsigned char, WS_WPA2), (size_t)256 * 2048, (size_t)256 * 2048};
          EpiMA E{WSP(float, WS_T), WSP(bf16_t, WS_Z)};
          pg8::gemm_phase<EpiMA, SchedP, true>(F.lds, 2048 / 128, 2048, 2048, S, E, 0x7A7A7A7A, 0x7F7F7F7F); }
        VM_WAIT(); __syncthreads();
        { SchedP S{F.G, F.bid, (const char*)WSP(bf16_t, WS_HH), (const char*)WSP(bf16_t, WS_WPH), (size_t)256 * 1024 * 2, (size_t)256 * 1024 * 2};
          EpiMB E{WSP(float, WS_T), WSP(bf16_t, WS_Z), WSP(unsigned char, WS_MX)};
          pg8::gemm_phase<EpiMB, SchedP>(F.lds, 1024 / 64, 1024 * 2, 1024 * 2, S, E); }
    }
    SEAM(7);
    RELOAD();
    if (IN(8)) REP(8) {
        SchedP S{F.G, F.bid, (const char*)WSP(unsigned char, WS_MX), (const char*)WSP(unsigned char, WS_WOUT), (size_t)256 * 2048, (size_t)256 * 2048};
        const KargP in = karg_opaque(F.in); EpiWO E{WSP(float, WS_R1), in[I_X], WSP(float, WS_STATS), in[I_LNG], in[I_LNB], WSP(float, WS_MOD)};
        pg8::gemm_phase<EpiWO, SchedP, true>(F.lds, 2048 / 128, 2048, 2048, S, E, 0x79797979, 0x7F7F7F7F);
    }
    SEAM(8);
    RELOAD();
    if (IN(9)) p8_phase(F);
    SEAM(9);
    RELOAD();
    if (IN(10)) REP(10) {
        moe_table(F);
        SchedMoE<true> S{F.G, F.bid, 16, (const LAS int*)(F.lds + MOE_TBL), (const LAS int*)(F.lds + MOE_TBL + 256), WSP(int, WS_RTOK), (const char*)WSP(bf16_t, WS_TOK), (const char*)WSP(bf16_t, WS_WGU)};
        const KargP in = karg_opaque(F.in); EpiGU E{WSP(unsigned char, WS_ACT), in[I_BG], in[I_BU]};
        pg8::gemm_phase<EpiGU, SchedMoE<true>, true>(F.lds, DM / 128, DM, DM, S, E, 0x7A7A7A7A, 0x7F7F7F7F);
    }
    SEAM(10);
    RELOAD();
    if (IN(11)) REP(11) {
        moe_table(F);
        SchedMoE<false> S{F.G, F.bid, 8, (const LAS int*)(F.lds + MOE_TBL), (const LAS int*)(F.lds + MOE_TBL + 256), WSP(int, WS_RTOK), (const char*)WSP(bf16_t, WS_ACT), (const char*)WSP(bf16_t, WS_WD)};
        const KargP in = karg_opaque(F.in); EpiDN E{WSP(bf16_t, WS_YR), in[I_BDN]};
        pg8::gemm_phase<EpiDN, SchedMoE<false>, true>(F.lds, DM / 128, DM, DM, S, E, 0x79797979, 0x7D7D7D7D);
    }
    SEAM(11);
    RELOAD();
    if (IN(12)) REP(12) { moe_table(F); p11_phase(F); }
#undef IN
#undef SEAM
}

extern "C" void kernel_launch(void* const* d_in, const int* in_sizes, int n_in, void* d_out, int out_size, void* d_ws, size_t ws_size, hipStream_t stream) {
    static int grid = 0;
    if (grid == 0) {
        if (n_in != 38 || out_size != MTOK * DM || ws_size < WS_END) { fprintf(stderr, "kernel_launch: unexpected shapes: n_in %d out %d ws %zu (need %zu)\n", n_in, out_size, ws_size, (size_t)WS_END); grid = -1; return; }
        int dev = 0, cus = 0, per_cu = 0;
        if (hipGetDevice(&dev) != hipSuccess || hipDeviceGetAttribute(&cus, hipDeviceAttributeMultiprocessorCount, dev) != hipSuccess) { grid = -1; return; }
        if (hipFuncSetAttribute((const void*)mk_fwd, hipFuncAttributeMaxDynamicSharedMemorySize, LDS_BYTES) != hipSuccess) { fprintf(stderr, "kernel_launch: hipFuncSetAttribute failed\n"); grid = -1; return; }
        if (hipOccupancyMaxActiveBlocksPerMultiprocessor(&per_cu, (const void*)mk_fwd, NTHR, LDS_BYTES) != hipSuccess || per_cu < 1) fprintf(stderr, "kernel_launch: occupancy query says %d\n", per_cu);
        (void)hipGetLastError();
        grid = cus;
    }
    if (grid < 0) return;
    (void)hipMemsetAsync((char*)d_ws + WS_CTL, 0, CTL_ZERO_BYTES, stream);
    Args a{};
    for (int i = 0; i < 38; ++i) a.in[i] = (const float*)d_in[i];
    a.out = (float*)d_out; a.ws = (unsigned char*)d_ws;
#if MK_LAUNCHES == 1
    a.ph_lo = 0; a.ph_hi = NPHASE;
    hipLaunchKernelGGL(mk_fwd, dim3(grid), dim3(NTHR), LDS_BYTES, stream, a);
#else
    for (int p = 0; p < NPHASE; ++p) { a.ph_lo = p; a.ph_hi = p + 1; hipLaunchKernelGGL(mk_fwd, dim3(grid), dim3(NTHR), LDS_BYTES, stream, a); }
#endif
}
```

```cpp
#include <hip/hip_runtime.h>
#include <cstdio>
#include <cstdint>

#define GAS __attribute__((address_space(1)))
#define LAS __attribute__((address_space(3)))
typedef unsigned short bf16_t;
typedef short bf16x8 __attribute__((ext_vector_type(8)));
typedef float f32x4 __attribute__((ext_vector_type(4)));
typedef float f32x2 __attribute__((ext_vector_type(2)));
typedef unsigned u32x4 __attribute__((ext_vector_type(4)));
typedef unsigned u32x2 __attribute__((ext_vector_type(2)));

#ifndef MK_LAUNCHES
#define MK_LAUNCHES 1
#endif

constexpr int DM = 2048, NB = 8, SEQ = 2048, CTX = 256, GW = 64;
constexpr int MTOK = NB * SEQ;
constexpr int MCTX = NB * CTX;
constexpr int MALL = MTOK + MCTX;
constexpr int NH = 4, HD = 256, MW = 1024, HW = 1024;
constexpr int N_IN = 10256;
constexpr int NEXP = 32, TOPK = 4;
constexpr float LN_EPS = 1e-5f;
constexpr float DN_ALPHA = 1.189207115002721f;
constexpr int ZN = 7424, ZC_QK = 0, ZC_V = 1024, ZC_O = 2048, ZC_GA = 3072, ZC_GH = 5120, ZC_GT = 7168;
constexpr int WIN_ROWS = 10496, WIN_HY0 = 7424;
constexpr int MAXTILES = 288;
constexpr int POSCAP = 16384;

constexpr size_t MiB = 1u << 20;
constexpr size_t WS_CTL = 0;
constexpr size_t WS_MODP = 1 * MiB;
constexpr size_t WS_MOD = 9 * MiB;
constexpr size_t WS_BINP = 10 * MiB;
constexpr size_t WS_A3 = 10 * MiB + 64 * 1024;
constexpr size_t WS_STATS = 11 * MiB;
constexpr size_t WS_TOPE = 11 * MiB + 256 * 1024;
constexpr size_t WS_TOPP = 11 * MiB + 512 * 1024;
constexpr size_t WS_TOPW = 11 * MiB + 768 * 1024;
constexpr size_t WS_RTOK = 12 * MiB;
constexpr size_t WS_RW = 14 * MiB;
constexpr size_t WS_WQK = 16 * MiB;
constexpr size_t WS_WPH = 17 * MiB;
constexpr size_t WS_WPA2 = 21 * MiB;
constexpr size_t WS_WOUT = 29 * MiB;
constexpr size_t WS_WIN = 37 * MiB;
constexpr size_t WS_WGU = 78 * MiB;
constexpr size_t WS_WD = 590 * MiB;
constexpr size_t WS_RA = 846 * MiB;
constexpr size_t WS_Z = WS_RA, WS_ZT = WS_RA + 261 * MiB, WS_ACT = WS_RA;
constexpr size_t WS_RB = 1203 * MiB;
constexpr size_t WS_HX = WS_RB, WS_U = WS_RB + 72 * MiB, WS_QKB = WS_RB + 108 * MiB, WS_AM = WS_RB + 180 * MiB, WS_HH = WS_RB + 244 * MiB, WS_MX = WS_RB + 276 * MiB, WS_YR = WS_RB;
constexpr size_t WS_RC = 1543 * MiB;
constexpr size_t WS_HTAPS = WS_RC, WS_H = WS_RC + 32 * MiB, WS_T = WS_RC;
constexpr size_t WS_R1 = 1671 * MiB;
constexpr size_t WS_TOK = 1799 * MiB;
constexpr size_t WS_HX8 = WS_RC + 96 * MiB;
constexpr size_t WS_WIN8 = 1863 * MiB;
constexpr size_t WS_END = 1884 * MiB;
constexpr int CW_TMO = 0, CW_BAR = 4096, CW_CNT = 16384;
constexpr size_t CTL_ZERO_BYTES = 1 * MiB;

constexpr int LDS_BYTES = 160 * 1024 - 2048;
constexpr int MISC_OFF = LDS_BYTES - 1024;
constexpr int NWAVES = 8, NTHR = 512;

#define LDS_WAIT() asm volatile("s_waitcnt lgkmcnt(0)" ::: "memory")
#define VM_WAIT() asm volatile("s_waitcnt vmcnt(0)" ::: "memory")
__device__ __forceinline__ unsigned f2bf(float f) { unsigned u = __builtin_bit_cast(unsigned, f); return (u + 0x7fffu + ((u >> 16) & 1u)) >> 16; }
__device__ __forceinline__ unsigned pk2(float lo, float hi) { return f2bf(lo) | (f2bf(hi) << 16); }
__device__ __forceinline__ unsigned pk4_fp8(float a, float b, float c, float d) { int w = 0; w = __builtin_amdgcn_cvt_pk_fp8_f32(a, b, w, false); w = __builtin_amdgcn_cvt_pk_fp8_f32(c, d, w, true); return (unsigned)w; }
__device__ __forceinline__ float bf2f(unsigned b) { return __builtin_bit_cast(float, b << 16); }
__device__ __forceinline__ float bflo(unsigned w) { return __builtin_bit_cast(float, w << 16); }
__device__ __forceinline__ float bfhi(unsigned w) { return __builtin_bit_cast(float, w & 0xffff0000u); }
__device__ __forceinline__ float sigmoidf_(float x) { return 1.0f / (1.0f + __expf(-x)); }
__device__ __forceinline__ float wave_sum(float v) {
#pragma unroll
    for (int o = 1; o < 64; o <<= 1) v += __shfl_xor(v, o);
    return v;
}

#define XB_TMO      128
#define XB_XCNT(j)  (256  + 64 * (j))
#define XB_XSUB(j)  (1280 + 64 * (j))
#define XB_XGEN(j)  (2304 + 64 * (j))
#define XB_TOP      3328
#define XB_TOPGEN   3392
#define XCD_BAR_WORDS 3456
#define XB_SPIN_CAP (1u << 22)
__device__ __forceinline__ unsigned xb_ld(unsigned* p)              { return __hip_atomic_load(p, __ATOMIC_RELAXED, __HIP_MEMORY_SCOPE_AGENT); }
__device__ __forceinline__ unsigned xb_add(unsigned* p, unsigned v) { return __hip_atomic_fetch_add(p, v, __ATOMIC_RELAXED, __HIP_MEMORY_SCOPE_AGENT); }
__device__ __forceinline__ unsigned xb_xcc_id() { return (unsigned)__builtin_amdgcn_s_getreg((3 << 11) | 20) & 0xFu; }
#define XB_SPIN(cond, bar) do { unsigned _sp = 0; while (cond) { __builtin_amdgcn_s_sleep(1); \
    if ((++_sp & 255u) == 0u) { if (xb_ld(&(bar)[XB_TMO])) break; if (_sp > XB_SPIN_CAP) { atomicAdd(&(bar)[XB_TMO], 1u); break; } } } } while (0)
struct XcdBarrier { unsigned* bar; unsigned x; volatile LAS unsigned* st; };
__device__ __forceinline__ XcdBarrier xcd_barrier_post(unsigned* bar, volatile LAS unsigned* st) {
    XcdBarrier b; b.bar = bar; b.x = xb_xcc_id(); b.st = st;
    if (threadIdx.x == 0) (void)xb_add(&bar[XB_XCNT(b.x)], 1u);
    return b;
}
__device__ __forceinline__ void xcd_barrier_complete(unsigned* bar, unsigned x, unsigned& nloc, unsigned& nx) {
    const unsigned G = gridDim.x * gridDim.y * gridDim.z;
    unsigned sum, cnt, mine, sp = 0u;
    for (;;) {
        sum = 0u; cnt = 0u; mine = 0u;
#pragma unroll
        for (unsigned j = 0; j < 16; ++j) { const unsigned c = xb_ld(&bar[XB_XCNT(j)]); sum += c; cnt += (c > 0u) ? 1u : 0u; mine = (j == x) ? c : mine; }
        if (sum == G) break;
        __builtin_amdgcn_s_sleep(1);
        if ((++sp & 255u) == 0u) { if (xb_ld(&bar[XB_TMO])) break; if (sp > XB_SPIN_CAP) { atomicAdd(&bar[XB_TMO], 1u); break; } }
    }
    nloc = mine > 0u ? mine : 1u; nx = cnt > 0u ? cnt : 1u;
}
__device__ __forceinline__ void xcd_barrier(const XcdBarrier& b) {
    asm volatile("s_waitcnt vmcnt(0)" ::: "memory");
    __syncthreads();
    if (threadIdx.x == 0) {
        unsigned* bar = b.bar;
        __builtin_amdgcn_s_waitcnt(0);
        unsigned nloc = b.st[0], nx = b.st[1];
        if (nloc == 0u) { xcd_barrier_complete(bar, b.x, nloc, nx); b.st[0] = nloc; b.st[1] = nx; }
        const unsigned old = xb_add(&bar[XB_XSUB(b.x)], 1u);
        const unsigned gen = old / nloc;
        if (old + 1u == (gen + 1u) * nloc) {
            __builtin_amdgcn_fence(__ATOMIC_RELEASE, "agent");
            asm volatile("s_waitcnt vmcnt(0)" ::: "memory");
            const unsigned og = xb_add(&bar[XB_TOP], 1u);
            const unsigned tg = og / nx;
            if (og + 1u == (tg + 1u) * nx) xb_add(&bar[XB_TOPGEN], 1u);
            else XB_SPIN(xb_ld(&bar[XB_TOPGEN]) == tg, bar);
            __builtin_amdgcn_fence(__ATOMIC_ACQUIRE, "agent");
            xb_add(&bar[XB_XGEN(b.x)], 1u);
            asm volatile("s_waitcnt vmcnt(0)" ::: "memory");
        } else {
            XB_SPIN(xb_ld(&bar[XB_XGEN(b.x)]) == gen, bar);
            __builtin_amdgcn_fence(__ATOMIC_ACQUIRE, "agent");
            asm volatile("s_waitcnt vmcnt(0)" ::: "memory");
        }
    }
    __syncthreads();
}

struct Args {
    const float* in[38];
    float* out; unsigned char* ws;
    int ph_lo, ph_hi;
};
enum { I_X = 0, I_C, I_CTX, I_CCTX, I_LNG, I_LNB, I_WMOD, I_BMOD, I_WIN, I_BIN, I_MCW, I_MCB, I_WQH, I_WKH, I_HCW, I_HCB, I_FW1, I_FB1, I_FWH, I_FBH,
       I_FFREQ, I_FWOUT, I_HSKIP, I_WPA, I_WPH, I_WOUT, I_LN1G, I_LN1B, I_WR, I_BR, I_WG, I_BG, I_WU, I_BU, I_WDN, I_BDN, I_LN2G, I_LN2B };

namespace pg8 {
constexpr int BM = 256, BK = 64, HALF = 128, HTB = HALF * BK * 2, STAGE_BYTES = 8 * HTB, NXCD = 8, WGM = 8;
__host__ __device__ __forceinline__ int lds_byte(int r, int c) { const int st = (r >> 4) * 2 + (c >> 5), rr = r & 15, cc = c & 31, ob = rr * 64 + cc * 2; return st * 1024 + (ob ^ (((ob >> 9) & 1) << 5)); }
__host__ __device__ __forceinline__ void stage_rc(int b, int& R, int& C) { const int st = b / 1024, sb = b % 1024, swz = sb ^ (((sb >> 9) & 1) << 5); R = (st >> 1) * 16 + swz / 64; C = (st & 1) * 32 + (swz % 64) / 2; }
__host__ __device__ __forceinline__ int perm32(int rho) { const int n = rho >> 4, i = rho & 15; return 8 * (i >> 2) + 4 * n + (i & 3); }
struct Unit { int pm, pn, ex; };
__device__ __forceinline__ void decode_tile(int L, int nM, int nN, int& pm, int& pn) {
    const int nwg = nM * nN; int wgid = L;
    { const int q = nwg / NXCD, r = nwg % NXCD, xcd = wgid % NXCD, off = wgid / NXCD; wgid = (xcd < r ? xcd * (q + 1) : r * (q + 1) + (xcd - r) * q) + off; }
    const int nig = WGM * nN, gid = wgid / nig, fm = gid * WGM, gsz = (nM - fm) < WGM ? (nM - fm) : WGM;
    pm = fm + ((wgid % nig) % gsz); pn = (wgid % nig) / gsz;
}
__device__ __forceinline__ unsigned cvt_pk_bf16(float lo, float hi) { unsigned r; asm volatile("v_cvt_pk_bf16_f32 %0, %1, %2" : "=v"(r) : "v"(lo), "v"(hi)); return r; }

typedef int i32x8 __attribute__((ext_vector_type(8)));
template <class Epi, class Sched, bool F8 = false>
__device__ __forceinline__ void gemm_phase(LAS unsigned char* lds, const int nt, const int pitchA, const int pitchB, const Sched& S, const Epi& E, const int wscale = 0x7F7F7F7F, const int ascale = 0x7F7F7F7F) {
    const int tid = threadIdx.x, wid = __builtin_amdgcn_readfirstlane(tid >> 6), lane = tid & 63, wr = wid >> 2, wc = wid & 3, fr = lane & 15, fq = lane >> 4;
    int RA[2], CA[2]; unsigned voffB[2];
#pragma unroll
    for (int i = 0; i < 2; ++i) { int R, C; stage_rc(tid * 16 + i * 8192, R, C); const int Rb = Epi::PERM ? ((R & ~31) + perm32(R & 31)) : R;
        RA[i] = R; CA[i] = C; voffB[i] = (unsigned)(Rb * pitchB + C * 2); }
    const size_t kstep = (size_t)(BK * 2);
    const size_t hstepB = (size_t)HALF * pitchB;
    const unsigned ldsw = (unsigned)wid * 1024u;
    const int aoff = lds_byte(wr * 64 + fr, fq * 8), boff = lds_byte(wc * 32 + fr, fq * 8);
#define PG8_SA(b, h) (((b) * 2 + (h)) * HTB)
#define PG8_SB(b, h) ((4 + (b) * 2 + (h)) * HTB)
#define PG8_STAGE(bufoff, gbase, v0, v1) do { \
        __builtin_amdgcn_global_load_lds((const unsigned*)((const char*)(gbase) + (v0)), (LAS unsigned*)(lds + (bufoff) + ldsw), 16, 0, 0); \
        __builtin_amdgcn_global_load_lds((const unsigned*)((const char*)(gbase) + (v1)), (LAS unsigned*)(lds + (bufoff) + ldsw + 8192), 16, 0, 0); } while (0)
#define PG8_LD8(off) __builtin_bit_cast(i32x8, __builtin_shufflevector(*(const LAS u32x4*)(lds + (off)), *(const LAS u32x4*)(lds + (off) + 1024), 0, 1, 2, 3, 4, 5, 6, 7))
#define PG8_LDA(dst, b, h) do { _Pragma("unroll") for (int m = 0; m < 4; ++m) { if (F8) dst##8[m] = PG8_LD8(PG8_SA(b, h) + aoff + m * 2048); else { _Pragma("unroll") for (int k = 0; k < 2; ++k) dst[m][k] = *(const LAS bf16x8*)(lds + PG8_SA(b, h) + aoff + m * 2048 + k * 1024); } } } while (0)
#define PG8_LDB(dst, b, h) do { _Pragma("unroll") for (int n = 0; n < 2; ++n) { if (F8) dst##8[n] = PG8_LD8(PG8_SB(b, h) + boff + n * 2048); else { _Pragma("unroll") for (int k = 0; k < 2; ++k) dst[n][k] = *(const LAS bf16x8*)(lds + PG8_SB(b, h) + boff + n * 2048 + k * 1024); } } } while (0)
#define PG8_CAT(x) __builtin_shufflevector(__builtin_bit_cast(u32x4, x[0]), __builtin_bit_cast(u32x4, x[1]), 0, 1, 2, 3, 4, 5, 6, 7)
#define PG8_MMA(ai, bj, At, Bt) do { __builtin_amdgcn_s_setprio(1); _Pragma("unroll") for (int m = 0; m < 4; ++m) _Pragma("unroll") for (int n = 0; n < 2; ++n) { \
        if (F8) { asm volatile("v_mfma_scale_f32_16x16x128_f8f6f4 %0, %1, %2, %0, %3, %4 op_sel_hi:[0,0,0]" : "+v"(acc[ai][bj][m][n]) : "v"(Bt##8[n]), "v"(At##8[m]), "v"(wscale), "v"(ascale)); } \
        else { _Pragma("unroll") for (int k = 0; k < 2; ++k) acc[ai][bj][m][n] = __builtin_amdgcn_mfma_f32_16x16x32_bf16(Bt[n][k], At[m][k], acc[ai][bj][m][n], 0, 0, 0); } } __builtin_amdgcn_s_setprio(0); } while (0)
#define PG8_WAIT_V(n) asm volatile("s_waitcnt vmcnt(" #n ")" ::: "memory")
#define PG8_WAIT_L(n) asm volatile("s_waitcnt lgkmcnt(" #n ")" ::: "memory")
#define PG8_BAR __builtin_amdgcn_s_barrier()
#define PG8_SCHED __builtin_amdgcn_sched_barrier(0)
#define PG8_AOFF(u, o00, o01, o10, o11) do { \
        if (Sched::GATHER) { o00 = (unsigned)(S.a_row(u, RA[0]) * pitchA + CA[0] * 2); o01 = (unsigned)(S.a_row(u, RA[1]) * pitchA + CA[1] * 2); \
                             o10 = (unsigned)(S.a_row(u, RA[0] + HALF) * pitchA + CA[0] * 2); o11 = (unsigned)(S.a_row(u, RA[1] + HALF) * pitchA + CA[1] * 2); } \
        else { o00 = (unsigned)(RA[0] * pitchA + CA[0] * 2); o01 = (unsigned)(RA[1] * pitchA + CA[1] * 2); o10 = (unsigned)((RA[0] + HALF) * pitchA + CA[0] * 2); o11 = (unsigned)((RA[1] + HALF) * pitchA + CA[1] * 2); } } while (0)
    Unit cur, nxt; int ui = 0;
    if (!S.next(0, cur)) return;
    f32x4 acc[2][2][4][2];
#pragma unroll
    for (int a = 0; a < 2; ++a)
#pragma unroll
        for (int b = 0; b < 2; ++b)
#pragma unroll
            for (int m = 0; m < 4; ++m)
#pragma unroll
                for (int n = 0; n < 2; ++n) acc[a][b][m][n] = (f32x4){0.f, 0.f, 0.f, 0.f};
    bf16x8 At[4][2], B0[2][2], B1[2][2]; i32x8 At8[4], B08[2], B18[2];
    const char* cA = S.a_base(cur); const char* cB = S.b_base(cur);
    unsigned c00, c01, c10, c11; PG8_AOFF(cur, c00, c01, c10, c11);
    const unsigned vb0 = voffB[0], vb1 = voffB[1];
    PG8_STAGE(PG8_SB(0, 0), cB, vb0, vb1); PG8_STAGE(PG8_SA(0, 0), cA, c00, c01); PG8_STAGE(PG8_SB(0, 1), cB + hstepB, vb0, vb1); PG8_STAGE(PG8_SA(0, 1), cA, c10, c11);
    if (wr == 1) PG8_BAR;
    PG8_WAIT_V(4); PG8_BAR;
    PG8_STAGE(PG8_SB(1, 0), cB + kstep, vb0, vb1); PG8_STAGE(PG8_SA(1, 0), cA + kstep, c00, c01); PG8_STAGE(PG8_SB(1, 1), cB + hstepB + kstep, vb0, vb1);
    PG8_WAIT_V(6); PG8_BAR;
    for (;;) {
        const bool has_next = S.next(ui + 1, nxt);
        const char* nA = has_next ? S.a_base(nxt) : cA; const char* nB = has_next ? S.b_base(nxt) : cB;
        unsigned n00 = c00, n01 = c01, n10 = c10, n11 = c11;
        if (has_next) PG8_AOFF(nxt, n00, n01, n10, n11);
        for (int t = 0; t < nt; t += 2) {
            const bool last = (t == nt - 2);
            const char* a1 = cA + (size_t)(t + 1) * kstep;
            const char* a2 = last ? nA : cA + (size_t)(t + 2) * kstep; const char* b2 = last ? nB : cB + (size_t)(t + 2) * kstep;
            const char* a3 = a2 + kstep; const char* b3 = b2 + kstep;
            const unsigned x00 = last ? n00 : c00, x01 = last ? n01 : c01, x10 = last ? n10 : c10, x11 = last ? n11 : c11;
            PG8_LDB(B0, 0, 0); PG8_SCHED; PG8_LDA(At, 0, 0); PG8_STAGE(PG8_SA(1, 1), a1, c10, c11);
            PG8_WAIT_L(8); PG8_BAR; PG8_WAIT_L(0); PG8_MMA(0, 0, At, B0); PG8_BAR; PG8_SCHED;
            PG8_LDB(B1, 0, 1); PG8_STAGE(PG8_SB(0, 0), b2, vb0, vb1);
            PG8_BAR; PG8_WAIT_L(0); PG8_MMA(0, 1, At, B1); PG8_BAR;
            PG8_LDA(At, 0, 1); PG8_STAGE(PG8_SA(0, 0), a2, x00, x01);
            PG8_BAR; PG8_WAIT_L(0); PG8_MMA(1, 0, At, B0); PG8_BAR; PG8_SCHED;
            PG8_STAGE(PG8_SB(0, 1), b2 + hstepB, vb0, vb1);
            PG8_WAIT_V(6); PG8_BAR; PG8_MMA(1, 1, At, B1); PG8_BAR;
            PG8_LDB(B0, 1, 0); PG8_SCHED; PG8_LDA(At, 1, 0); PG8_STAGE(PG8_SA(0, 1), a2, x10, x11);
            PG8_WAIT_L(8); PG8_BAR; PG8_WAIT_L(0); PG8_MMA(0, 0, At, B0); PG8_BAR; PG8_SCHED;
            PG8_LDB(B1, 1, 1); PG8_STAGE(PG8_SB(1, 0), b3, vb0, vb1);
            PG8_BAR; PG8_WAIT_L(0); PG8_MMA(0, 1, At, B1); PG8_BAR;
            PG8_LDA(At, 1, 1); PG8_STAGE(PG8_SA(1, 0), a3, x00, x01);
            PG8_BAR; PG8_WAIT_L(0); PG8_MMA(1, 0, At, B0); PG8_BAR; PG8_SCHED;
            PG8_STAGE(PG8_SB(1, 1), b3 + hstepB, vb0, vb1);
            PG8_WAIT_V(6); PG8_BAR; PG8_MMA(1, 1, At, B1); PG8_BAR;
        }
        if (F8) asm volatile("s_nop 15\n\ts_nop 15" ::: "memory");
        E(acc, cur, wr, wc, fr, fq);
        if (!has_next) break;
#pragma unroll
        for (int a = 0; a < 2; ++a)
#pragma unroll
            for (int b = 0; b < 2; ++b)
#pragma unroll
                for (int m = 0; m < 4; ++m)
#pragma unroll
                    for (int n = 0; n < 2; ++n) acc[a][b][m][n] = (f32x4){0.f, 0.f, 0.f, 0.f};
        cur = nxt; cA = nA; cB = nB; c00 = n00; c01 = n01; c10 = n10; c11 = n11; ++ui;
    }
    PG8_WAIT_V(0);
    if (wr == 0) PG8_BAR;
    PG8_BAR;
#undef PG8_SA
#undef PG8_SB
#undef PG8_STAGE
#undef PG8_LDA
#undef PG8_LDB
#undef PG8_MMA
#undef PG8_WAIT_V
#undef PG8_WAIT_L
#undef PG8_BAR
#undef PG8_SCHED
#undef PG8_AOFF
#undef PG8_CAT
#undef PG8_LD8
}
}
using pg8::Unit;

typedef const float* cfp_t;
typedef __attribute__((address_space(4))) const cfp_t* KargP;
__device__ __forceinline__ KargP karg_opaque(KargP p) { asm volatile("" : "+s"(p)); return p; }
struct Frame {
    LAS unsigned char* lds;
    volatile LAS unsigned* MISC;
    unsigned* ctl;
    int tid, lane, wave, G, bid;
    KargP in;
    float* out; unsigned char* ws;
};
#define WSP(T, off) ((T*)(F.ws + (off)))

__device__ __forceinline__ void transpose_item(const float* src, size_t ld, int nvalid, float scale, bf16_t* dst, int K, LAS float* scr, int lane) {
    { float tv[32]; const int j = lane & 31;
#pragma unroll
      for (int i = 0; i < 32; ++i) tv[i] = (j < nvalid) ? src[(size_t)(2 * i + (lane >> 5)) * ld + j] : 0.f;
#pragma unroll
      for (int i = 0; i < 32; ++i) scr[(2 * i + (lane >> 5)) * 33 + j] = tv[i] * scale; }
    LDS_WAIT(); asm volatile("" ::: "memory");
    const int c = lane & 7;
#pragma unroll
    for (int j = 0; j < 4; ++j) { const int n = (lane >> 3) + 8 * j; const LAS float* s = scr + (8 * c) * 33 + n;
        u32x4 o; o.x = pk2(s[0 * 33], s[1 * 33]); o.y = pk2(s[2 * 33], s[3 * 33]); o.z = pk2(s[4 * 33], s[5 * 33]); o.w = pk2(s[6 * 33], s[7 * 33]);
        *(u32x4*)(dst + (size_t)n * K + 8 * c) = o; }
    LDS_WAIT(); asm volatile("" ::: "memory");
}
struct CvItem { const float* src; unsigned char* dst; float scale; int rstep; };
__device__ __forceinline__ CvItem cv_decode(KargP in, unsigned char* ws, int it) {
    CvItem c;
    if (it < NEXP * 256) { const int e = it >> 8, q = it & 255, up = q & 1, g = (q >> 1) & 7, kb = q >> 4;
        c.src = (up ? in[I_WU] : in[I_WG]) + (size_t)e * DM * DM + (size_t)(128 * kb) * DM + 256 * g;
        c.dst = ws + WS_WGU + ((size_t)e * 4096 + 512 * g + up * 128) * DM + 128 * kb; c.scale = 32.f; c.rstep = 256; }
    else { const int r2 = it - NEXP * 256; const int e = r2 >> 7, q = r2 & 127, g = q & 7, kb = q >> 3;
        c.src = in[I_WDN] + (size_t)e * DM * DM + (size_t)(128 * kb) * DM + 256 * g;
        c.dst = ws + WS_WD + ((size_t)e * 2048 + 256 * g) * DM + 128 * kb; c.scale = 64.f; c.rstep = 128; }
    return c;
}
constexpr int CV_E8X = 8;
__device__ __forceinline__ int cv_map(int i) { constexpr int n1 = (NEXP - CV_E8X) * 256; return i < n1 ? CV_E8X * 256 + i : NEXP * 256 + CV_E8X * 128 + (i - n1); }
#define CV_LOAD(v, c) do { _Pragma("unroll") for (int i_ = 0; i_ < 16; ++i_) v[i_] = __builtin_nontemporal_load((const f32x4*)((c).src + (size_t)(16 * w + i_) * DM + 4 * lane)); } while (0)
#define CV_PROC(v, c) do { \
        _Pragma("unroll") for (int j_ = 0; j_ < 4; ++j_) { u32x4 o_; const float s_ = (c).scale; \
            o_.x = pk4_fp8(v[0][j_] * s_, v[1][j_] * s_, v[2][j_] * s_, v[3][j_] * s_);     o_.y = pk4_fp8(v[4][j_] * s_, v[5][j_] * s_, v[6][j_] * s_, v[7][j_] * s_); \
            o_.z = pk4_fp8(v[8][j_] * s_, v[9][j_] * s_, v[10][j_] * s_, v[11][j_] * s_);   o_.w = pk4_fp8(v[12][j_] * s_, v[13][j_] * s_, v[14][j_] * s_, v[15][j_] * s_); \
            *(LAS u32x4*)(tile + (4 * lane + j_) * 144 + 16 * w) = o_; } \
        __syncthreads(); \
        _Pragma("unroll") for (int q_ = 0; q_ < 4; ++q_) { const int idx_ = tid + 512 * q_, row_ = idx_ >> 3, piece_ = idx_ & 7; \
            *(u32x4*)((c).dst + (size_t)((row_ >> 7) * (c).rstep + (row_ & 127)) * DM + 16 * piece_) = *(const LAS u32x4*)(tile + row_ * 144 + 16 * piece_); } \
        __syncthreads(); } while (0)
__device__ __forceinline__ void convert_moe_weights(KargP in, unsigned char* ws, LAS unsigned char* tile, int tid, int bid, int G) {
    const int w = tid >> 6, lane = tid & 63;
    constexpr int NIT = (NEXP - CV_E8X) * (256 + 128);
    f32x4 va[16], vb[16];
    int it = bid;
    if (it >= NIT) return;
    CvItem ca = cv_decode(in, ws, cv_map(it)), cb = ca;
    CV_LOAD(va, ca);
    for (;;) {
        const bool hb = it + G < NIT;
        if (hb) { cb = cv_decode(in, ws, cv_map(it + G)); CV_LOAD(vb, cb); }
        CV_PROC(va, ca);
        if (!hb) break;
        it += G;
        const bool ha = it + G < NIT;
        if (ha) { ca = cv_decode(in, ws, cv_map(it + G)); CV_LOAD(va, ca); }
        CV_PROC(vb, cb);
        if (!ha) break;
        it += G;
    }
}
#undef CV_LOAD
#undef CV_PROC
__device__ __forceinline__ void transpose_item_f8(const float* src, size_t ld, float scale, unsigned char* dst, int K, LAS float* scr, int lane) {
    { float tv[32]; const int j = lane & 31;
#pragma unroll
      for (int i = 0; i < 32; ++i) tv[i] = src[(size_t)(2 * i + (lane >> 5)) * ld + j];
#pragma unroll
      for (int i = 0; i < 32; ++i) scr[(2 * i + (lane >> 5)) * 33 + j] = tv[i] * scale; }
    LDS_WAIT(); asm volatile("" ::: "memory");
    const int c = lane & 3;
#pragma unroll
    for (int j = 0; j < 2; ++j) { const int n = (lane >> 2) + 16 * j; const LAS float* s = scr + (16 * c) * 33 + n;
        u32x4 o; o.x = pk4_fp8(s[0 * 33], s[1 * 33], s[2 * 33], s[3 * 33]); o.y = pk4_fp8(s[4 * 33], s[5 * 33], s[6 * 33], s[7 * 33]);
        o.z = pk4_fp8(s[8 * 33], s[9 * 33], s[10 * 33], s[11 * 33]); o.w = pk4_fp8(s[12 * 33], s[13 * 33], s[14 * 33], s[15 * 33]);
        *(u32x4*)(dst + (size_t)n * K + 16 * c) = o; }
    LDS_WAIT(); asm volatile("" ::: "memory");
}
__device__ __forceinline__ void p0_phase(Frame& F) {
    const KargP in = karg_opaque(F.in);
    LAS float* scr = (LAS float*)(F.lds + F.wave * 16384);
    const int gw = F.bid * NWAVES + F.wave, NGW = F.G * NWAVES;
    constexpr int IT_WIN = 32 * (WIN_ROWS / 32);
    constexpr int IT_WQK = 4 * 64;
    constexpr int IT_WPA2 = 32 * 64;
    constexpr int IT_WPH = 16 * 64;
    constexpr int IT_WOUT = 32 * 64;
    constexpr int NITEMS = IT_WIN + IT_WQK + IT_WPA2 + IT_WPH + IT_WOUT;
    for (int it = gw; it < NITEMS; it += NGW) {
        int r = it;
        if (r < IT_WIN) { const int g = r % (WIN_ROWS / 32), kb = r / (WIN_ROWS / 32); const int n0 = 32 * g; int sc, nv = 32;
            if (n0 < 2048) sc = n0; else if (n0 < 3072) sc = 2064 + (n0 - 2048); else if (n0 < 7168) sc = 6160 + (n0 - 3072); else if (n0 < 7200) { sc = 2048; nv = 16; } else if (n0 < WIN_HY0) { sc = 0; nv = 0; } else sc = 3088 + (n0 - WIN_HY0);
            if (n0 < 2048 || (n0 >= 7168 && n0 < WIN_HY0)) transpose_item(in[I_WIN] + (size_t)(64 * kb) * N_IN + sc, N_IN, nv, 1.f, WSP(bf16_t, WS_WIN) + (size_t)n0 * DM + 64 * kb, DM, scr, F.lane);
            if (n0 >= 1024 && !(n0 >= 7168 && n0 < WIN_HY0)) transpose_item_f8(in[I_WIN] + (size_t)(64 * kb) * N_IN + sc, N_IN, 32.f, WSP(unsigned char, WS_WIN8) + (size_t)n0 * DM + 64 * kb, DM, scr, F.lane);
            continue; } r -= IT_WIN;
        if (r < IT_WQK) { const int g = r % 64, kb = r / 64; const int n0 = 32 * g, h = n0 / 512, j = (n0 % 512) / 256, e0 = n0 % 256;
            const float* src = (j ? in[I_WKH] : in[I_WQH]) + (size_t)h * 65536 + (size_t)(64 * kb) * 256 + e0;
            transpose_item(src, 256, 32, j ? 0.0625f : 1.f, WSP(bf16_t, WS_WQK) + (size_t)n0 * 256 + 64 * kb, 256, scr, F.lane); continue; } r -= IT_WQK;
        if (r < IT_WPA2) { const int g = r % 64, kb = r / 64; const int n0 = 32 * g, k0 = 64 * kb;
            transpose_item_f8(in[I_WPA] + (size_t)(k0 % 1024) * DM + n0, DM, 32.f, WSP(unsigned char, WS_WPA2) + (size_t)n0 * 2048 + k0, 2048, scr, F.lane); continue; } r -= IT_WPA2;
        if (r < IT_WPH) { const int g = r % 64, kb = r / 64; const int n0 = 32 * g, k0 = 64 * kb;
            transpose_item_f8(in[I_WPH] + (size_t)k0 * DM + n0, DM, 32.f, WSP(unsigned char, WS_WPH) + (size_t)n0 * 1024 + k0, 1024, scr, F.lane); continue; } r -= IT_WPH;
        if (r < IT_WOUT) { const int g = r % 64, kb = r / 64; const int n0 = 32 * g, k0 = 64 * kb;
            transpose_item_f8(in[I_WOUT] + (size_t)k0 * DM + n0, DM, 64.f, WSP(unsigned char, WS_WOUT) + (size_t)n0 * 2048 + k0, 2048, scr, F.lane); continue; } r -= IT_WOUT;
        (void)r;
    }
    __syncthreads();
    convert_moe_weights(in, F.ws, (LAS unsigned char*)F.lds, F.tid, F.bid, F.G);
    for (int i = F.bid * NTHR + F.tid; i < WIN_ROWS; i += F.G * NTHR) { int sc = -1;
        if (i < 2048) sc = i; else if (i < 3072) sc = 2064 + (i - 2048); else if (i < 7168) sc = 6160 + (i - 3072); else if (i < 7184) sc = 2048 + (i - 7168); else if (i < WIN_HY0) sc = -1; else sc = 3088 + (i - WIN_HY0);
        WSP(float, WS_BINP)[i] = sc >= 0 ? in[I_BIN][sc] : 0.f; }
    for (int it = F.bid + F.G * F.wave; it < 16 * 48; it += F.G * NWAVES) {
        const int ks = it / 48, cg = it % 48; const int col = cg * 256 + F.lane * 4;
        f32x4 a[9];
#pragma unroll
        for (int v = 0; v < 9; ++v) a[v] = (f32x4){0.f, 0.f, 0.f, 0.f};
#pragma unroll 1
        for (int kb = ks * 128; kb < ks * 128 + 128; kb += 16) {
            f32x4 w[16];
#pragma unroll
            for (int i = 0; i < 16; ++i) w[i] = *(const f32x4*)(in[I_WMOD] + (size_t)(kb + i) * 12288 + col);
#pragma unroll
            for (int i = 0; i < 16; ++i)
#pragma unroll
                for (int v = 0; v < 9; ++v) { const float cv = (v < 8) ? in[I_C][v * DM + kb + i] : in[I_CCTX][kb + i]; const float s = cv * sigmoidf_(cv); a[v] += w[i] * s; }
        }
#pragma unroll
        for (int v = 0; v < 9; ++v) *(f32x4*)(WSP(float, WS_MODP) + ((size_t)ks * 9 + v) * 12288 + col) = a[v];
    }
    for (int j = gw; j < SEQ; j += NGW) {
        const int l = F.lane;
        float zv = 0.f;
        if (l == 0) zv = (float)j / (float)(SEQ - 1);
        else if (l < 33) { const int bi = (l - 1) & 15; const float f = 1e-4f + (float)bi * ((15.0f - 1e-4f) / 15.0f); const float ang = 6.283185307179586f * (float)j * f / (float)SEQ; zv = (l < 17) ? cosf(ang) : -sinf(ang); }
        float pre = in[I_FB1][l];
        for (int i = 0; i < 33; ++i) pre += __shfl(zv, i) * in[I_FW1][i * 64 + l];
        float a = sinf(in[I_FFREQ][l] * pre);
        pre = in[I_FBH][l];
        for (int i = 0; i < 64; ++i) pre += __shfl(a, i) * in[I_FWH][i * 64 + l];
        float a2 = sinf(in[I_FFREQ][64 + l] * pre);
        pre = in[I_FBH][64 + l];
        for (int i = 0; i < 64; ++i) pre += __shfl(a2, i) * in[I_FWH][4096 + i * 64 + l];
        WSP(float, WS_A3)[j * 64 + l] = sinf(in[I_FFREQ][128 + l] * pre);
    }
}

__device__ __forceinline__ void p0b_phase(Frame& F) {
    const KargP in = karg_opaque(F.in);
    for (int i = F.bid * NTHR + F.tid; i < 9 * 12288; i += F.G * NTHR) { const int col = i % 12288; float s = in[I_BMOD][col];
        for (int ks = 0; ks < 16; ++ks) s += WSP(float, WS_MODP)[(size_t)ks * 9 * 12288 + i];
        WSP(float, WS_MOD)[i] = s; }
    LAS float* wl = (LAS float*)F.lds;
    for (int un = F.bid; un < 256; un += F.G) {
        const int ct = un >> 2, pg = un & 3;
        __syncthreads();
        for (int q = 0; q < 8; ++q) { const int idx = F.tid + 512 * q, i = idx >> 6, cc = idx & 63; wl[cc * 68 + i] = in[I_FWOUT][(size_t)i * 4096 + ct * 64 + cc]; }
        __syncthreads();
        const int j = pg * 512 + F.wave * 64 + F.lane;
        f32x4 ar[16];
#pragma unroll
        for (int q = 0; q < 16; ++q) ar[q] = *(const f32x4*)(WSP(float, WS_A3) + j * 64 + 4 * q);
        const float tj = (float)j / (float)(SEQ - 1);
        const float mind = -3.0701134573253944f, maxd = -15.350567286626972f;
        const int cbase = (ct * 64) & 1023;
#pragma unroll 1
        for (int cc = 0; cc < 64; ++cc) {
            f32x4 s = (f32x4){0.f, 0.f, 0.f, 0.f};
#pragma unroll
            for (int q = 0; q < 16; ++q) s += ar[q] * *(const LAS f32x4*)(wl + cc * 68 + 4 * q);
            const float delta = fabsf(mind + (float)(cbase + cc) * ((maxd - mind) / 1023.0f));
            const float v = ((s.x + s.y) + (s.z + s.w)) * __expf(-tj * delta);
            WSP(float, WS_HTAPS)[(size_t)(ct * 64 + cc) * SEQ + j] = v;
        }
    }
}

__device__ __forceinline__ f32x2 cmul(f32x2 a, f32x2 b) { return (f32x2){a.x * b.x - a.y * b.y, a.x * b.y + a.y * b.x}; }
__device__ __forceinline__ f32x2 cmulc(f32x2 a, f32x2 b) { return (f32x2){a.x * b.x + a.y * b.y, a.y * b.x - a.x * b.y}; }
template <bool INV> __device__ __forceinline__ void dft4(f32x2& a, f32x2& b, f32x2& c, f32x2& d) {
    const f32x2 s0 = a + c, s1 = a - c, s2 = b + d, s3 = b - d;
    const f32x2 is3 = (f32x2){-s3.y, s3.x};
    a = s0 + s2; c = s0 - s2;
    if (!INV) { b = s1 - is3; d = s1 + is3; } else { b = s1 + is3; d = s1 - is3; }
}
template <bool INV> __device__ __forceinline__ void dft16(f32x2 (&v)[16]) {
#pragma unroll
    for (int n0 = 0; n0 < 4; ++n0) dft4<INV>(v[n0], v[4 + n0], v[8 + n0], v[12 + n0]);
    const float c1 = 0.9238795325112867f, s1 = 0.3826834323650898f, r2 = 0.7071067811865476f;
    const float cs[10] = {1.f, c1, r2, s1, 0.f, -s1, -r2, -c1, -1.f, -c1};
    const float sn[10] = {0.f, s1, r2, c1, 1.f, c1, r2, s1, 0.f, -s1};
#pragma unroll
    for (int k0 = 1; k0 < 4; ++k0)
#pragma unroll
        for (int n0 = 1; n0 < 4; ++n0) { const int m = n0 * k0; const f32x2 w = (f32x2){cs[m], INV ? sn[m] : -sn[m]}; v[4 * k0 + n0] = cmul(v[4 * k0 + n0], w); }
#pragma unroll
    for (int k0 = 0; k0 < 4; ++k0) dft4<INV>(v[4 * k0], v[4 * k0 + 1], v[4 * k0 + 2], v[4 * k0 + 3]);
#pragma unroll
    for (int a = 0; a < 4; ++a)
#pragma unroll
        for (int b = a + 1; b < 4; ++b) { const f32x2 t = v[4 * a + b]; v[4 * a + b] = v[4 * b + a]; v[4 * b + a] = t; }
}
__device__ __forceinline__ int fphys(int i) { return i + (i >> 4); }
constexpr int FFT_BUF_BYTES = (4096 + 256) * 8;
struct FftTw { f32x2 wA, wB; };
__device__ __forceinline__ FftTw fft_tw(int ht) { FftTw t; float s, c; sincospif(-(float)ht / 2048.0f, &s, &c); t.wA = (f32x2){c, s}; sincospif(-(float)(ht & 15) / 128.0f, &s, &c); t.wB = (f32x2){c, s}; return t; }
template <bool CONJ> __device__ __forceinline__ void tw_apply(f32x2 (&v)[16], f32x2 w1) {
    if (CONJ) w1.y = -w1.y;
    const f32x2 w2 = cmul(w1, w1), w3 = cmul(w2, w1), w4 = cmul(w2, w2), w5 = cmul(w4, w1), w6 = cmul(w4, w2), w7 = cmul(w4, w3), w8 = cmul(w4, w4);
    v[1] = cmul(v[1], w1); v[2] = cmul(v[2], w2); v[3] = cmul(v[3], w3); v[4] = cmul(v[4], w4); v[5] = cmul(v[5], w5); v[6] = cmul(v[6], w6); v[7] = cmul(v[7], w7); v[8] = cmul(v[8], w8);
    v[9] = cmul(v[9], cmul(w8, w1)); v[10] = cmul(v[10], cmul(w8, w2)); v[11] = cmul(v[11], cmul(w8, w3)); v[12] = cmul(v[12], cmul(w8, w4));
    v[13] = cmul(v[13], cmul(w8, w5)); v[14] = cmul(v[14], cmul(w8, w6)); v[15] = cmul(v[15], cmul(w8, w7));
}
__device__ __forceinline__ void fft_fwd(f32x2 (&v)[16], LAS f32x2* buf, int ht, const FftTw& tw_) {
    FftTw tw = tw_; asm volatile("" : "+v"(ht), "+v"(tw.wA.x), "+v"(tw.wA.y), "+v"(tw.wB.x), "+v"(tw.wB.y));
    dft16<false>(v);
    tw_apply<false>(v, tw.wA);
#pragma unroll
    for (int k = 0; k < 16; ++k) buf[fphys(256 * k + ht)] = v[k];
    __syncthreads();
    const int ka = ht >> 4, s = ht & 15;
#pragma unroll
    for (int b = 0; b < 16; ++b) v[b] = buf[fphys(256 * ka + 16 * b + s)];
    dft16<false>(v);
    tw_apply<false>(v, tw.wB);
#pragma unroll
    for (int k = 0; k < 16; ++k) buf[fphys(256 * ka + 16 * k + s)] = v[k];
    __syncthreads();
#pragma unroll
    for (int q = 0; q < 16; ++q) v[q] = buf[fphys(16 * ht + q)];
    dft16<false>(v);
}
__device__ __forceinline__ void fft_inv(f32x2 (&v)[16], LAS f32x2* buf, int ht, const FftTw& tw_) {
    FftTw tw = tw_; asm volatile("" : "+v"(ht), "+v"(tw.wA.x), "+v"(tw.wA.y), "+v"(tw.wB.x), "+v"(tw.wB.y));
    dft16<true>(v);
#pragma unroll
    for (int q = 0; q < 16; ++q) buf[fphys(16 * ht + q)] = v[q];
    __syncthreads();
    const int ka = ht >> 4, s = ht & 15;
#pragma unroll
    for (int k = 0; k < 16; ++k) v[k] = buf[fphys(256 * ka + 16 * k + s)];
    tw_apply<true>(v, tw.wB);
    dft16<true>(v);
#pragma unroll
    for (int b = 0; b < 16; ++b) buf[fphys(256 * ka + 16 * b + s)] = v[b];
    __syncthreads();
#pragma unroll
    for (int k = 0; k < 16; ++k) v[k] = buf[fphys(256 * k + ht)];
    tw_apply<true>(v, tw.wA);
    dft16<true>(v);
    __syncthreads();
}

__device__ __forceinline__ void p1_phase(Frame& F) {
    const KargP in = karg_opaque(F.in);
    const int gw = F.bid * NWAVES + F.wave, NGW = F.G * NWAVES;
    const float* mod = WSP(float, WS_MOD);
    {
        f32x4 pg[8], pb[8];
#pragma unroll
        for (int j = 0; j < 8; ++j) { pg[j] = *(const f32x4*)(in[I_LNG] + F.lane * 4 + 256 * j); pb[j] = *(const f32x4*)(in[I_LNB] + F.lane * 4 + 256 * j); }
#pragma unroll 1
        for (int grp = gw; grp < MALL / 8; grp += NGW) {
            const int row0 = grp * 8; const bool lat = row0 < MTOK;
            const float* xb = lat ? in[I_X] + (size_t)row0 * DM : in[I_CTX] + (size_t)(row0 - MTOK) * DM;
            const float* mv = mod + (size_t)(lat ? row0 / SEQ : 8) * 12288;
            f32x4 psh[8], psc[8];
#pragma unroll
            for (int j = 0; j < 8; ++j) { psh[j] = *(const f32x4*)(mv + F.lane * 4 + 256 * j); psc[j] = *(const f32x4*)(mv + 2048 + F.lane * 4 + 256 * j) + 1.0f; }
            f32x4 v[8], vn[8];
#pragma unroll
            for (int j = 0; j < 8; ++j) v[j] = *(const f32x4*)(xb + F.lane * 4 + 256 * j);
#pragma unroll 1
            for (int ri = 0; ri < 8; ++ri) {
                const float* xn = xb + (size_t)(ri < 7 ? ri + 1 : ri) * DM;
#pragma unroll
                for (int j = 0; j < 8; ++j) vn[j] = *(const f32x4*)(xn + F.lane * 4 + 256 * j);
                float s = 0.f;
#pragma unroll
                for (int j = 0; j < 8; ++j) s += (v[j].x + v[j].y) + (v[j].z + v[j].w);
                const float mean = wave_sum(s) * (1.f / DM); float s2 = 0.f;
#pragma unroll
                for (int j = 0; j < 8; ++j) { v[j] = v[j] - mean; s2 += (v[j].x * v[j].x + v[j].y * v[j].y) + (v[j].z * v[j].z + v[j].w * v[j].w); }
                const float rstd = 1.f / sqrtf(wave_sum(s2) * (1.f / DM) + LN_EPS);
                const int row = row0 + ri;
                if (lat && F.lane == 0) { WSP(float, WS_STATS)[row * 2] = mean; WSP(float, WS_STATS)[row * 2 + 1] = rstd; }
                bf16_t* orow = WSP(bf16_t, WS_HX) + (size_t)row * DM;
#pragma unroll
                for (int j = 0; j < 8; ++j) { const f32x4 y = (v[j] * rstd * pg[j] + pb[j]) * psc[j] + psh[j];
                    u32x2 o; o.x = pk2(y.x, y.y); o.y = pk2(y.z, y.w); *(u32x2*)(orow + F.lane * 4 + 256 * j) = o;
                    if (lat) *(unsigned*)(WSP(unsigned char, WS_HX8) + (size_t)row * DM + F.lane * 4 + 256 * j) = pk4_fp8(y.x, y.y, y.z, y.w); }
#pragma unroll
                for (int j = 0; j < 8; ++j) v[j] = vn[j];
            }
        }
    }
    const int hb = F.tid >> 8, ht = F.tid & 255;
    LAS f32x2* buf = (LAS f32x2*)(F.lds + hb * FFT_BUF_BYTES);
    const FftTw tw = fft_tw(ht);
    const float* htaps = WSP(float, WS_HTAPS);
    for (int u0 = F.bid * 2; u0 < 2048; u0 += F.G * 2) {
        const int un = u0 + hb, c = un >> 1, n = un & 1;
        const float* hf = htaps + (size_t)((n * 2 + 0) * 1024 + c) * SEQ, * hbk = htaps + (size_t)((n * 2 + 1) * 1024 + c) * SEQ;
        f32x2 v[16];
#pragma unroll
        for (int a = 0; a < 16; ++a) { const int i = 256 * a + ht; float x;
            if (a < 8) x = hf[i]; else if (i == 2048) x = 0.f; else x = hbk[4096 - i];
            v[a] = (f32x2){x * (1.0f / 4096.0f), 0.f}; }
        fft_fwd(v, buf, ht, tw);
        f32x2* Hd = WSP(f32x2, WS_H) + (size_t)un * 4096;
#pragma unroll
        for (int ks = 0; ks < 16; ++ks) Hd[ks * 256 + ht] = v[ks];
        __syncthreads();
    }
}

template <bool F8> struct SchedZ {
    static constexpr bool GATHER = false;
    int G, c; const char* hx; const char* win;
    static constexpr size_t P = F8 ? DM : 2 * DM;
    __device__ __forceinline__ bool next(int i, Unit& u) const {
        int L = i * G + c;
        if (!F8) {
            if (L < 320) { int pn; pg8::decode_tile(L, 64, 5, u.pm, pn); u.pn = pn < 4 ? pn : 28; u.ex = 0; return true; } L -= 320;
            if (L < 72) { int pm, pn; pg8::decode_tile(L, 8, 9, pm, pn); u.pm = 64 + pm; u.pn = pn < 8 ? pn : 28; u.ex = 0; return true; }
            return false;
        } else {
            if (L < 1536) { int pn; pg8::decode_tile(L, 64, 24, u.pm, pn); u.pn = 4 + pn; u.ex = 0; return true; } L -= 1536;
            if (L < 768) { pg8::decode_tile(L, 12, 64, u.pm, u.pn); u.ex = 1; return true; }
            return false;
        }
    }
    __device__ __forceinline__ const char* a_base(const Unit& u) const { return u.ex ? win + (size_t)(WIN_HY0 + 256 * u.pm) * P : hx + (size_t)(256 * u.pm) * P; }
    __device__ __forceinline__ const char* b_base(const Unit& u) const { return u.ex ? hx + (size_t)(256 * u.pn) * P : win + (size_t)(256 * u.pn) * P; }
    __device__ __forceinline__ int a_row(const Unit&, int R) const { return R; }
};
struct EpiZ {
    static constexpr bool PERM = true;
    bf16_t* Z; bf16_t* ZT; const float* bias;
    __device__ __forceinline__ void operator()(const f32x4 (&acc)[2][2][4][2], const Unit& u, int wr, int wc, int fr, int fq) const {
        if (u.ex == 0) {
            const int row0 = u.pm * 256 + wr * 64 + fr, col0 = u.pn * 256 + wc * 32 + 8 * fq;
            f32x4 bv[2][2];
#pragma unroll
            for (int bj = 0; bj < 2; ++bj)
#pragma unroll
                for (int n = 0; n < 2; ++n) bv[bj][n] = *(const f32x4*)(bias + col0 + bj * 128 + 4 * n);
#pragma unroll
            for (int ai = 0; ai < 2; ++ai)
#pragma unroll
                for (int m = 0; m < 4; ++m) { bf16_t* rowp = Z + (size_t)(row0 + ai * 128 + m * 16) * ZN + col0;
#pragma unroll
                    for (int bj = 0; bj < 2; ++bj) { const f32x4 v0 = acc[ai][bj][m][0] + bv[bj][0], v1 = acc[ai][bj][m][1] + bv[bj][1];
                        u32x4 w; w.x = pg8::cvt_pk_bf16(v0[0], v0[1]); w.y = pg8::cvt_pk_bf16(v0[2], v0[3]); w.z = pg8::cvt_pk_bf16(v1[0], v1[1]); w.w = pg8::cvt_pk_bf16(v1[2], v1[3]);
                        *(u32x4*)(rowp + bj * 128) = w; } }
        } else {
            const int ch0 = u.pm * 256 + wr * 64 + fr, b = u.pn >> 3, t0 = (u.pn & 7) * 256 + wc * 32 + 8 * fq;
#pragma unroll
            for (int ai = 0; ai < 2; ++ai)
#pragma unroll
                for (int m = 0; m < 4; ++m) { const int ch = ch0 + ai * 128 + m * 16; const float bb = bias[WIN_HY0 + ch];
                    bf16_t* rowp = ZT + ((size_t)b * 3072 + ch) * SEQ + t0;
#pragma unroll
                    for (int bj = 0; bj < 2; ++bj) { const f32x4 v0 = acc[ai][bj][m][0] + bb, v1 = acc[ai][bj][m][1] + bb;
                        u32x4 w; w.x = pg8::cvt_pk_bf16(v0[0], v0[1]); w.y = pg8::cvt_pk_bf16(v0[2], v0[3]); w.z = pg8::cvt_pk_bf16(v1[0], v1[1]); w.w = pg8::cvt_pk_bf16(v1[2], v1[3]);
                        *(u32x4*)(rowp + bj * 128) = w; } }
        }
    }
};

__device__ __forceinline__ void p3_phase(Frame& F) {
    const KargP in = karg_opaque(F.in);
    const bf16_t* Z = WSP(bf16_t, WS_Z); bf16_t* U = WSP(bf16_t, WS_U);
    const float* cw = in[I_MCW]; const float* cb = in[I_MCB];
    for (int it = F.bid * NTHR + F.tid; it < MALL * 128; it += F.G * NTHR) {
        const int row = it >> 7, c0 = (it & 127) * 8;
        float a[8];
        { const f32x4 b0 = *(const f32x4*)(cb + c0), b1 = *(const f32x4*)(cb + c0 + 4); a[0] = b0.x; a[1] = b0.y; a[2] = b0.z; a[3] = b0.w; a[4] = b1.x; a[5] = b1.y; a[6] = b1.z; a[7] = b1.w; }
        const bool lat = row < MTOK;
        int base, y, x, H, Wd;
        if (lat) { const int t = row & (SEQ - 1); base = row - t; y = t >> 6; x = t & 63; H = 32; Wd = 64; }
        else { const int t = (row - MTOK) & (CTX - 1); base = row - t; y = 0; x = t; H = 1; Wd = CTX; }
#pragma unroll
        for (int dy = -1; dy <= 1; ++dy)
#pragma unroll
            for (int dx = -1; dx <= 1; ++dx) {
                const int yy = y + dy, xx = x + dx;
                if (yy < 0 || yy >= H || xx < 0 || xx >= Wd) continue;
                const int srow = base + yy * Wd + xx;
                const u32x4 zz = *(const u32x4*)(Z + (size_t)srow * ZN + ZC_QK + c0);
                const float* wp = cw + ((dy + 1) * 3 + (dx + 1)) * MW + c0;
                const f32x4 w0 = *(const f32x4*)wp, w1 = *(const f32x4*)(wp + 4);
                a[0] += bflo(zz.x) * w0.x; a[1] += bfhi(zz.x) * w0.y; a[2] += bflo(zz.y) * w0.z; a[3] += bfhi(zz.y) * w0.w;
                a[4] += bflo(zz.z) * w1.x; a[5] += bfhi(zz.z) * w1.y; a[6] += bflo(zz.w) * w1.z; a[7] += bfhi(zz.w) * w1.w;
            }
#pragma unroll
        for (int j = 0; j < 8; ++j) a[j] = a[j] * sigmoidf_(a[j]);
        u32x4 o; o.x = pk2(a[0], a[1]); o.y = pk2(a[2], a[3]); o.z = pk2(a[4], a[5]); o.w = pk2(a[6], a[7]);
        *(u32x4*)(U + (size_t)row * MW + c0) = o;
    }
}

struct SchedQK {
    static constexpr bool GATHER = false;
    int G, c; const char* u; const char* w;
    __device__ __forceinline__ bool next(int i, Unit& un) const { const int L = i * G + c; if (L >= 72 * 8) return false; pg8::decode_tile(L, 72, 8, un.pm, un.pn); un.ex = 0; return true; }
    __device__ __forceinline__ const char* a_base(const Unit& un) const { return u + ((size_t)(256 * un.pm) * MW + (un.pn >> 1) * 256) * 2; }
    __device__ __forceinline__ const char* b_base(const Unit& un) const { return w + (size_t)(256 * un.pn) * 256 * 2; }
    __device__ __forceinline__ int a_row(const Unit&, int R) const { return R; }
};
struct EpiQK {
    static constexpr bool PERM = true;
    bf16_t* O;
    __device__ __forceinline__ void operator()(const f32x4 (&acc)[2][2][4][2], const Unit& u, int wr, int wc, int fr, int fq) const {
        const int row0 = u.pm * 256 + wr * 64 + fr, col0 = u.pn * 256 + wc * 32 + 8 * fq;
#pragma unroll
        for (int ai = 0; ai < 2; ++ai)
#pragma unroll
            for (int m = 0; m < 4; ++m) { bf16_t* rowp = O + (size_t)(row0 + ai * 128 + m * 16) * 2048 + col0;
#pragma unroll
                for (int bj = 0; bj < 2; ++bj) { const f32x4 v0 = acc[ai][bj][m][0], v1 = acc[ai][bj][m][1];
                    u32x4 w; w.x = pg8::cvt_pk_bf16(v0[0], v0[1]); w.y = pg8::cvt_pk_bf16(v0[2], v0[3]); w.z = pg8::cvt_pk_bf16(v1[0], v1[1]); w.w = pg8::cvt_pk_bf16(v1[2], v1[3]);
                    *(u32x4*)(rowp + bj * 128) = w; } }
    }
};

constexpr int ML_QS = 264, ML_VS = 72, ML_PS = 72;
constexpr int ML_Q = 0, ML_K = ML_Q + 64 * ML_QS * 2, ML_V = ML_K + 64 * ML_QS * 2, ML_C = ML_V + 64 * ML_VS * 2, ML_P = ML_C + 80 * ML_QS * 2, ML_SC = ML_P + 64 * ML_PS * 2;
constexpr int ML_SA = ML_SC, ML_SDEN = ML_SC + 4096, ML_END = ML_SC + 4096 + 256;
static_assert(ML_END <= MISC_OFF, "mlstm LDS");
__device__ __forceinline__ bf16x8 lds_frag(const LAS bf16_t* p) { return *(const LAS bf16x8*)p; }
__device__ __forceinline__ void mlstm_unit(Frame& F, int un) {
    const int vs = un & 3, dir = (un >> 2) & 1, h = (un >> 3) & 3, b = un >> 5;
    const bf16_t* Z = WSP(bf16_t, WS_Z); const bf16_t* QK = WSP(bf16_t, WS_QKB); unsigned char* AM = WSP(unsigned char, WS_AM);
    LAS unsigned char* lds = F.lds;
    LAS bf16_t* Qs = (LAS bf16_t*)(lds + ML_Q); LAS bf16_t* Ks = (LAS bf16_t*)(lds + ML_K); LAS bf16_t* Vs = (LAS bf16_t*)(lds + ML_V);
    LAS bf16_t* Cs = (LAS bf16_t*)(lds + ML_C); LAS bf16_t* Ps = (LAS bf16_t*)(lds + ML_P);
    LAS float* sDEN = (LAS float*)(lds + ML_SDEN);
    LAS float* sc0 = (LAS float*)(lds + ML_SA);
    const int tid = F.tid, lane = F.lane, w = F.wave, l15 = lane & 15, g4 = lane >> 4;
    __syncthreads();
    for (int i = tid; i < 80 * ML_QS / 2; i += NTHR) ((LAS unsigned*)Cs)[i] = 0u;
    if (tid < 64) { Vs[tid * ML_VS + 64] = (bf16_t)0x3F80; for (int j = 65; j < ML_VS; ++j) Vs[tid * ML_VS + j] = 0; }
    f32x4 cacc[2][5];
#pragma unroll
    for (int a = 0; a < 2; ++a)
#pragma unroll
        for (int c = 0; c < 5; ++c) cacc[a][c] = (f32x4){0.f, 0.f, 0.f, 0.f};
    float m_run = 0.f;
    u32x4 pq[4], pk[4], pv; unsigned pgate = 0u, pgate2 = 0u;
#define ML_ROW0(st) ((st) < 4 ? (MTOK + b * CTX + 64 * (dir ? 3 - (st) : (st))) : (b * SEQ + 64 * (dir ? 35 - (st) : (st) - 4)))
#define ML_LOAD(st) do { const int r0_ = ML_ROW0(st); \
        _Pragma("unroll") for (int q_ = 0; q_ < 4; ++q_) { const int p_ = tid + 512 * q_, rr_ = p_ >> 5, cc_ = (p_ & 31) * 8; \
            pq[q_] = *(const u32x4*)(QK + (size_t)(r0_ + rr_) * 2048 + h * 512 + cc_); pk[q_] = *(const u32x4*)(QK + (size_t)(r0_ + rr_) * 2048 + h * 512 + 256 + cc_); } \
        { const int rr_ = tid >> 3, cc_ = (tid & 7) * 8; pv = *(const u32x4*)(Z + (size_t)(r0_ + rr_) * ZN + ZC_V + h * 256 + vs * 64 + cc_); } \
        if (tid < 64) { const bf16_t* gp_ = Z + (size_t)(r0_ + tid) * ZN + ZC_GT + dir * 8 + h; pgate = gp_[0]; pgate2 = gp_[4]; } } while (0)
#define ML_STORE() do { \
        _Pragma("unroll") for (int q_ = 0; q_ < 4; ++q_) { const int p_ = tid + 512 * q_, rr_ = p_ >> 5, cc_ = (p_ & 31) * 8; \
            *(LAS u32x4*)(Qs + rr_ * ML_QS + cc_) = pq[q_]; *(LAS u32x4*)(Ks + rr_ * ML_QS + cc_) = pk[q_]; } \
        { const int rr_ = tid >> 3, cc_ = (tid & 7) * 8; *(LAS u32x4*)(Vs + rr_ * ML_VS + cc_) = pv; } } while (0)
#define ML_SCALARS(stp) do { LAS float* sb_ = sc0 + ((stp) & 1) * 512; \
            const float li = bf2f(pgate), zf = bf2f(pgate2); \
            const float lf = fminf(zf, 0.f) - log1pf(__expf(-fabsf(zf))); \
            float bcs = lf; \
            _Pragma("unroll") for (int o = 1; o < 64; o <<= 1) { const float t = dir ? __shfl_down(bcs, o) : __shfl_up(bcs, o); const bool ok = dir ? (lane + o < 64) : (lane >= o); bcs += ok ? t : 0.f; } \
            const float a = li - bcs; \
            float am = a; \
            _Pragma("unroll") for (int o = 1; o < 64; o <<= 1) { const float t = dir ? __shfl_down(am, o) : __shfl_up(am, o); const bool ok = dir ? (lane + o < 64) : (lane >= o); am = ok ? fmaxf(am, t) : am; } \
            const float inter = bcs + m_run; \
            const float mt = fmaxf(inter, bcs + am); \
            const float b_end = __shfl(bcs, dir ? 0 : 63); \
            const float gg = b_end - bcs + li; \
            float gm = gg; \
            _Pragma("unroll") for (int o = 1; o < 64; o <<= 1) gm = fmaxf(gm, __shfl_xor(gm, o)); \
            const float m_new = fmaxf(b_end + m_run, gm); \
            sb_[lane] = a; sb_[64 + lane] = bcs - mt; sb_[128 + lane] = __expf(inter - mt); sb_[192 + lane] = __expf(gg - m_new); sb_[256 + lane] = __expf(-mt); \
            if (lane == 0) sb_[320] = __expf(b_end + m_run - m_new); \
            m_run = m_new; } while (0)
    ML_LOAD(0);
    __syncthreads();
    if (w == 0) ML_SCALARS(0);
    const int tt = w & 3; const int nv = (w < 4) ? 3 : 2;
#pragma unroll 1
    for (int st = 0; st < 36; ++st) {
        ML_STORE();
        LAS float* sA = sc0 + (st & 1) * 512; LAS float* sU = sA + 64; LAS float* sSI = sA + 128; LAS float* sWG = sA + 192; LAS float* sEM = sA + 256; LAS float* sMI = sA + 320;
        const int row0 = ML_ROW0(st);
        if (st + 1 < 36) ML_LOAD(st + 1);
        __syncthreads();
        {
            f32x4 sacc[2] = {(f32x4){0.f, 0.f, 0.f, 0.f}, (f32x4){0.f, 0.f, 0.f, 0.f}};
#pragma unroll
            for (int ks = 0; ks < 8; ++ks) {
                const bf16x8 qf = lds_frag(Qs + (16 * tt + l15) * ML_QS + 32 * ks + 8 * g4);
#pragma unroll
                for (int j = 0; j < 2; ++j) { const int stl = 2 * (w >> 2) + j;
                    const bf16x8 kf = lds_frag(Ks + (16 * stl + l15) * ML_QS + 32 * ks + 8 * g4);
                    sacc[j] = __builtin_amdgcn_mfma_f32_16x16x32_bf16(kf, qf, sacc[j], 0, 0, 0); }
            }
            const int t = 16 * tt + l15; const float ut = sU[t];
#pragma unroll
            for (int j = 0; j < 2; ++j) { const int s0 = 16 * (2 * (w >> 2) + j) + 4 * g4;
                const f32x4 av = *(const LAS f32x4*)(sA + s0);
                float pvv[4];
#pragma unroll
                for (int r = 0; r < 4; ++r) { const int s = s0 + r; const bool ok = dir ? (s >= t) : (s <= t); pvv[r] = ok ? sacc[j][r] * __expf(ut + av[r]) : 0.f; }
                u32x2 o; o.x = pk2(pvv[0], pvv[1]); o.y = pk2(pvv[2], pvv[3]);
                *(LAS u32x2*)(Ps + t * ML_PS + s0) = o; }
        }
        __syncthreads();
        unsigned og[2][4];
        if (st >= 4) {
#pragma unroll
            for (int j = 0; j < 2; ++j) { const int vt_ = (w < 4) ? j : 2 + j;
#pragma unroll
                for (int r = 0; r < 4; ++r) og[j][r] = Z[(size_t)(row0 + 16 * tt + 4 * g4 + r) * ZN + ZC_O + h * 256 + vs * 64 + 16 * vt_ + l15]; } }
        f32x4 nacc[3], iacc[3];
#pragma unroll
        for (int j = 0; j < 3; ++j) { nacc[j] = (f32x4){0.f, 0.f, 0.f, 0.f}; iacc[j] = (f32x4){0.f, 0.f, 0.f, 0.f}; }
#pragma unroll
        for (int ks = 0; ks < 8; ++ks) {
            const bf16x8 qf = lds_frag(Qs + (16 * tt + l15) * ML_QS + 32 * ks + 8 * g4);
#pragma unroll
            for (int j = 0; j < 3; ++j) if (j < nv) { const int vt = (w < 4) ? (j == 2 ? 4 : j) : 2 + j;
                const bf16x8 cf = lds_frag(Cs + (16 * vt + l15) * ML_QS + 32 * ks + 8 * g4);
                iacc[j] = __builtin_amdgcn_mfma_f32_16x16x32_bf16(qf, cf, iacc[j], 0, 0, 0); }
        }
#pragma unroll
        for (int ks = 0; ks < 2; ++ks) {
            const bf16x8 pf = lds_frag(Ps + (16 * tt + l15) * ML_PS + 32 * ks + 8 * g4);
#pragma unroll
            for (int j = 0; j < 3; ++j) if (j < nv) { const int vt = (w < 4) ? (j == 2 ? 4 : j) : 2 + j;
                bf16x8 vf;
#pragma unroll
                for (int e = 0; e < 8; ++e) vf[e] = (short)Vs[(32 * ks + 8 * g4 + e) * ML_VS + 16 * vt + l15];
                nacc[j] = __builtin_amdgcn_mfma_f32_16x16x32_bf16(pf, vf, nacc[j], 0, 0, 0); }
        }
        const int t0 = 16 * tt + 4 * g4;
        {
            const f32x4 si = *(const LAS f32x4*)(sSI + t0);
#pragma unroll
            for (int j = 0; j < 3; ++j) if (j < nv) nacc[j] = nacc[j] + iacc[j] * si;
            if (w < 4 && l15 == 0) *(LAS f32x4*)(sDEN + t0) = nacc[2];
        }
        {
            const float decay = sMI[0];
#pragma unroll
            for (int a = 0; a < 2; ++a)
#pragma unroll
                for (int c = 0; c < 5; ++c) cacc[a][c] = cacc[a][c] * decay;
#pragma unroll
            for (int ks = 0; ks < 2; ++ks) {
                bf16x8 kf[2];
#pragma unroll
                for (int a = 0; a < 2; ++a)
#pragma unroll
                    for (int e = 0; e < 8; ++e) kf[a][e] = (short)Ks[(32 * ks + 8 * g4 + e) * ML_QS + 16 * (2 * w + a) + l15];
                float wg[8];
#pragma unroll
                for (int e = 0; e < 8; ++e) wg[e] = sWG[32 * ks + 8 * g4 + e];
#pragma unroll
                for (int c = 0; c < 5; ++c) {
                    u32x4 vw;
                    { float x[8];
#pragma unroll
                      for (int e = 0; e < 8; ++e) x[e] = bf2f((unsigned)Vs[(32 * ks + 8 * g4 + e) * ML_VS + 16 * c + l15]) * wg[e];
                      vw.x = pk2(x[0], x[1]); vw.y = pk2(x[2], x[3]); vw.z = pk2(x[4], x[5]); vw.w = pk2(x[6], x[7]); }
                    const bf16x8 vf = __builtin_bit_cast(bf16x8, vw);
#pragma unroll
                    for (int a = 0; a < 2; ++a) cacc[a][c] = __builtin_amdgcn_mfma_f32_16x16x32_bf16(kf[a], vf, cacc[a][c], 0, 0, 0);
                }
            }
        }
        __syncthreads();
        if (w == 0 && st + 1 < 36) ML_SCALARS(st + 1);
        if (st >= 4) {
            const f32x4 dn = *(const LAS f32x4*)(sDEN + t0), em = *(const LAS f32x4*)(sEM + t0);
#pragma unroll
            for (int j = 0; j < 2; ++j) { const int vt = (w < 4) ? j : 2 + j; const int col = h * 256 + vs * 64 + 16 * vt + l15;
#pragma unroll
                for (int r = 0; r < 4; ++r) { const int row = row0 + t0 + r;
                    const float hv = nacc[j][r] / fmaxf(fabsf(dn[r]), em[r]);
                    const float o = sigmoidf_(bf2f(og[j][r]));
                    AM[(size_t)row * 2048 + dir * 1024 + col] = (unsigned char)(pk4_fp8(fminf(fmaxf(o * hv, -448.f), 448.f), 0.f, 0.f, 0.f) & 0xffu); } }
        }
#pragma unroll
        for (int a = 0; a < 2; ++a)
#pragma unroll
            for (int c = 0; c < 5; ++c) { u32x2 o; o.x = pk2(cacc[a][c][0], cacc[a][c][1]); o.y = pk2(cacc[a][c][2], cacc[a][c][3]);
                *(LAS u32x2*)(Cs + (16 * c + l15) * ML_QS + 16 * (2 * w + a) + 4 * g4) = o; }
    }
    __syncthreads();
#undef ML_LOAD
#undef ML_STORE
#undef ML_ROW0
#undef ML_SCALARS
}

constexpr int HY_RAW = 2 * FFT_BUF_BYTES, HY_OUT = HY_RAW + 16384, HY_END = HY_OUT + 65536;
static_assert(HY_END <= MISC_OFF, "hyena LDS");
__device__ __forceinline__ void hy_conv(const LAS bf16_t* raw, const float* cw, float bias, int c3, int ht, f32x2 (&o)[8]) {
    float w9[9];
#pragma unroll
    for (int q = 0; q < 9; ++q) w9[q] = cw[q * 3072 + c3];
    asm volatile("" : "+v"(ht));
    const int x = ht & 63;
#pragma unroll
    for (int a = 0; a < 8; ++a) { const int t = 256 * a + ht, y = t >> 6; float a0 = bias, a1 = bias;
#pragma unroll
        for (int dy = -1; dy <= 1; ++dy)
#pragma unroll
            for (int dx = -1; dx <= 1; ++dx) { const int yy = y + dy, xx = x + dx;
                if (yy >= 0 && yy < 32 && xx >= 0 && xx < 64) { const int idx = t + 64 * dy + dx; const float wv = w9[(dy + 1) * 3 + dx + 1];
                    a0 += wv * bf2f((unsigned)raw[idx]); a1 += wv * bf2f((unsigned)raw[2048 + idx]); } }
        o[a] = (f32x2){a0, a1}; asm volatile("" ::: "memory"); }
}
__device__ __forceinline__ void hyena_unit(Frame& F, int un) {
    const KargP in = karg_opaque(F.in);
    const int cg = un >> 2, bp = un & 3, c0 = cg * 8, b0 = bp * 2;
    const int hb = F.tid >> 8, ht = F.tid & 255;
    LAS f32x2* buf = (LAS f32x2*)(F.lds + hb * FFT_BUF_BYTES);
    LAS bf16_t* raw = (LAS bf16_t*)(F.lds + HY_RAW + hb * 8192);
    LAS unsigned char* outT = (LAS unsigned char*)(F.lds + HY_OUT);
    const bf16_t* ZT = WSP(bf16_t, WS_ZT); const f32x2* H = WSP(f32x2, WS_H);
    const FftTw tw = fft_tw(ht);
    __syncthreads();
#define HY_FETCH(dst, kind, ch) do { _Pragma("unroll") for (int bb = 0; bb < 2; ++bb) dst[bb] = *(const u32x4*)(ZT + ((size_t)(b0 + bb) * 3072 + (kind) * 1024 + (ch)) * SEQ + ht * 8); } while (0)
#define HY_PUT(srcv) do { _Pragma("unroll") for (int bb = 0; bb < 2; ++bb) *(LAS u32x4*)(raw + bb * 2048 + ht * 8) = srcv[bb]; } while (0)
    u32x4 rv[2], rn[2];
    HY_FETCH(rv, 2, c0 + hb);
#pragma unroll 1
    for (int i = 0; i < 4; ++i) {
        const int cl = 2 * i + hb, c = c0 + cl;
        HY_PUT(rv);
        HY_FETCH(rn, 0, c);
        __syncthreads();
        f32x2 vin[8], v[16], hv[16];
        hy_conv(raw, in[I_HCW], in[I_HCB][2048 + c], 2048 + c, ht, vin);
#pragma unroll
        for (int a = 0; a < 8; ++a) { v[a] = vin[a]; v[8 + a] = (f32x2){0.f, 0.f}; }
        { const f32x2* Hd = H + (size_t)(c * 2 + 0) * 4096;
#pragma unroll
          for (int ks = 0; ks < 16; ++ks) hv[ks] = Hd[ks * 256 + ht]; }
        fft_fwd(v, buf, ht, tw);
#pragma unroll
        for (int ks = 0; ks < 16; ++ks) v[ks] = cmul(v[ks], hv[ks]);
        fft_inv(v, buf, ht, tw);
        HY_PUT(rn);
        HY_FETCH(rv, 1, c);
        __syncthreads();
        { f32x2 g[8]; hy_conv(raw, in[I_HCW], in[I_HCB][c], c, ht, g); const float sk = in[I_HSKIP][c];
#pragma unroll
          for (int a = 0; a < 8; ++a) vin[a] = g[a] * (v[a] + vin[a] * sk); }
#pragma unroll
        for (int a = 0; a < 8; ++a) { v[a] = vin[a]; v[8 + a] = (f32x2){0.f, 0.f}; }
        { const f32x2* Hd = H + (size_t)(c * 2 + 1) * 4096;
#pragma unroll
          for (int ks = 0; ks < 16; ++ks) hv[ks] = Hd[ks * 256 + ht]; }
        fft_fwd(v, buf, ht, tw);
#pragma unroll
        for (int ks = 0; ks < 16; ++ks) v[ks] = cmul(v[ks], hv[ks]);
        fft_inv(v, buf, ht, tw);
        HY_PUT(rv);
        if (i < 3) HY_FETCH(rv, 2, c + 2);
        __syncthreads();
        { f32x2 g[8]; hy_conv(raw, in[I_HCW], in[I_HCB][1024 + c], 1024 + c, ht, g); const float sk = in[I_HSKIP][1024 + c];
#pragma unroll
          for (int a = 0; a < 8; ++a) { const f32x2 o = g[a] * (v[a] + vin[a] * sk); const int t = 256 * a + ht;
              const unsigned pk_ = pk4_fp8(fminf(fmaxf(o.x, -448.f), 448.f), fminf(fmaxf(o.y, -448.f), 448.f), 0.f, 0.f);
              outT[(0 * 2048 + t) * 8 + cl] = (unsigned char)(pk_ & 0xffu); outT[(1 * 2048 + t) * 8 + cl] = (unsigned char)((pk_ >> 8) & 0xffu); } }
        __syncthreads();
    }
#undef HY_FETCH
#undef HY_PUT
    unsigned char* HH = WSP(unsigned char, WS_HH);
#pragma unroll
    for (int q = 0; q < 8; ++q) { const int r = F.tid + 512 * q, bb = r >> 11, t = r & 2047;
        *(u32x2*)(HH + ((size_t)(b0 + bb) * SEQ + t) * HW + c0) = *(const LAS u32x2*)(outT + r * 8); }
    __syncthreads();
}

struct SchedP {
    static constexpr bool GATHER = false;
    int G, c; const char* a; const char* b; size_t astep, bstep;
    __device__ __forceinline__ bool next(int i, Unit& u) const { const int L = i * G + c; if (L >= 512) return false; pg8::decode_tile(L, 64, 8, u.pm, u.pn); u.ex = 0; return true; }
    __device__ __forceinline__ const char* a_base(const Unit& u) const { return a + (size_t)u.pm * astep; }
    __device__ __forceinline__ const char* b_base(const Unit& u) const { return b + (size_t)u.pn * bstep; }
    __device__ __forceinline__ int a_row(const Unit&, int R) const { return R; }
};
struct EpiMA {
    static constexpr bool PERM = true;
    bf16_t* T; const bf16_t* Z;
    __device__ __forceinline__ void operator()(const f32x4 (&acc)[2][2][4][2], const Unit& u, int wr, int wc, int fr, int fq) const {
        const int row0 = u.pm * 256 + wr * 64 + fr, col0 = u.pn * 256 + wc * 32 + 8 * fq;
#pragma unroll
        for (int ai = 0; ai < 2; ++ai)
#pragma unroll
            for (int m = 0; m < 4; ++m) { const size_t row = row0 + ai * 128 + m * 16;
#pragma unroll
                for (int bj = 0; bj < 2; ++bj) { const int c = col0 + bj * 128;
                    const u32x4 gz = *(const u32x4*)(Z + row * ZN + ZC_GA + c);
                    f32x4 g0 = (f32x4){sigmoidf_(bflo(gz.x)), sigmoidf_(bfhi(gz.x)), sigmoidf_(bflo(gz.y)), sigmoidf_(bfhi(gz.y))};
                    f32x4 g1 = (f32x4){sigmoidf_(bflo(gz.z)), sigmoidf_(bfhi(gz.z)), sigmoidf_(bflo(gz.w)), sigmoidf_(bfhi(gz.w))};
                    const f32x4 t0 = acc[ai][bj][m][0] * g0, t1 = acc[ai][bj][m][1] * g1;
                    u32x4 w; w.x = pg8::cvt_pk_bf16(t0[0], t0[1]); w.y = pg8::cvt_pk_bf16(t0[2], t0[3]); w.z = pg8::cvt_pk_bf16(t1[0], t1[1]); w.w = pg8::cvt_pk_bf16(t1[2], t1[3]);
                    *(u32x4*)(T + row * DM + c) = w; } }
    }
};
struct EpiMB {
    static constexpr bool PERM = true;
    const bf16_t* T; const bf16_t* Z; unsigned char* MX;
    __device__ __forceinline__ void operator()(const f32x4 (&acc)[2][2][4][2], const Unit& u, int wr, int wc, int fr, int fq) const {
        const int row0 = u.pm * 256 + wr * 64 + fr, col0 = u.pn * 256 + wc * 32 + 8 * fq;
#pragma unroll
        for (int ai = 0; ai < 2; ++ai)
#pragma unroll
            for (int m = 0; m < 4; ++m) { const size_t row = row0 + ai * 128 + m * 16;
#pragma unroll
                for (int bj = 0; bj < 2; ++bj) { const int c = col0 + bj * 128;
                    const u32x4 gz = *(const u32x4*)(Z + row * ZN + ZC_GH + c);
                    const u32x4 tt_ = *(const u32x4*)(T + row * DM + c);
                    const f32x4 t0 = (f32x4){bflo(tt_.x), bfhi(tt_.x), bflo(tt_.y), bfhi(tt_.y)}, t1 = (f32x4){bflo(tt_.z), bfhi(tt_.z), bflo(tt_.w), bfhi(tt_.w)};
                    f32x4 g0 = (f32x4){sigmoidf_(bflo(gz.x)), sigmoidf_(bfhi(gz.x)), sigmoidf_(bflo(gz.y)), sigmoidf_(bfhi(gz.y))};
                    f32x4 g1 = (f32x4){sigmoidf_(bflo(gz.z)), sigmoidf_(bfhi(gz.z)), sigmoidf_(bflo(gz.w)), sigmoidf_(bfhi(gz.w))};
                    const f32x4 v0 = t0 + acc[ai][bj][m][0] * g0, v1 = t1 + acc[ai][bj][m][1] * g1;
                    const f32x4 c0 = __builtin_elementwise_min(__builtin_elementwise_max(v0, (f32x4){-448.f, -448.f, -448.f, -448.f}), (f32x4){448.f, 448.f, 448.f, 448.f});
                    const f32x4 c1 = __builtin_elementwise_min(__builtin_elementwise_max(v1, (f32x4){-448.f, -448.f, -448.f, -448.f}), (f32x4){448.f, 448.f, 448.f, 448.f});
                    u32x2 w; w.x = pk4_fp8(c0[0], c0[1], c0[2], c0[3]); w.y = pk4_fp8(c1[0], c1[1], c1[2], c1[3]);
                    *(u32x2*)(MX + row * DM + c) = w; } }
    }
};
struct EpiWO {
    static constexpr bool PERM = true;
    bf16_t* R1; const float* x; const float* stats; const float* lng; const float* lnb; const float* mod;
    __device__ __forceinline__ void operator()(const f32x4 (&acc)[2][2][4][2], const Unit& u, int wr, int wc, int fr, int fq) const {
        const int row0 = u.pm * 256 + wr * 64 + fr, col0 = u.pn * 256 + wc * 32 + 8 * fq;
        const float* g1p = mod + (size_t)(u.pm >> 3) * 12288 + 4096;
#pragma unroll
        for (int bj = 0; bj < 2; ++bj) { const int c = col0 + bj * 128;
            const f32x4 ga = *(const f32x4*)(lng + c), gb = *(const f32x4*)(lng + c + 4), ba = *(const f32x4*)(lnb + c), bb = *(const f32x4*)(lnb + c + 4), g1a = *(const f32x4*)(g1p + c), g1b = *(const f32x4*)(g1p + c + 4);
#pragma unroll
            for (int ai = 0; ai < 2; ++ai)
#pragma unroll
                for (int m = 0; m < 4; ++m) { const size_t row = row0 + ai * 128 + m * 16; const float mean = stats[row * 2], rstd = stats[row * 2 + 1];
                    const f32x4 xa = *(const f32x4*)(x + row * DM + c), xb = *(const f32x4*)(x + row * DM + c + 4);
                    const f32x4 v0 = ((xa - mean) * rstd * ga + ba) * DN_ALPHA + g1a * acc[ai][bj][m][0], v1 = ((xb - mean) * rstd * gb + bb) * DN_ALPHA + g1b * acc[ai][bj][m][1];
                    u32x4 w; w.x = pg8::cvt_pk_bf16(v0[0], v0[1]); w.y = pg8::cvt_pk_bf16(v0[2], v0[3]); w.z = pg8::cvt_pk_bf16(v1[0], v1[1]); w.w = pg8::cvt_pk_bf16(v1[2], v1[3]);
                    *(u32x4*)(R1 + row * DM + c) = w; }
            asm volatile("" ::: "memory"); }
    }
};

struct CwItem { const float* src; unsigned char* dst; float scale; };
__device__ __forceinline__ CwItem cw_decode(KargP in, unsigned char* ws, int it) {
    CwItem c;
    if (it < NEXP * 2048) { const int e = it >> 11, q = it & 2047, g = q & 127, kb = q >> 7; const int n0 = 32 * g, tile = n0 >> 8, within = n0 & 255;
        c.src = (within < 128 ? in[I_WG] : in[I_WU]) + (size_t)e * DM * DM + (size_t)(128 * kb) * DM + tile * 128 + (within & 127);
        c.dst = ws + WS_WGU + ((size_t)e * 4096 + n0) * DM + 128 * kb; c.scale = 32.f; }
    else { const int r2 = it - NEXP * 2048; const int e = r2 >> 10, q = r2 & 1023, g = q & 63, kb = q >> 6;
        c.src = in[I_WDN] + (size_t)e * DM * DM + (size_t)(128 * kb) * DM + 32 * g;
        c.dst = ws + WS_WD + ((size_t)e * 2048 + 32 * g) * DM + 128 * kb; c.scale = 64.f; }
    return c;
}
constexpr int CV_E8 = 8;
__device__ __forceinline__ int cw_map(int i) { return i < CV_E8 * 2048 ? i : NEXP * 2048 + (i - CV_E8 * 2048); }
__device__ __forceinline__ void convert_moe_wave(KargP in, unsigned char* ws, LAS unsigned char* tile, int lane, int cw, int ncw) {
    constexpr int NIT = CV_E8 * (2048 + 1024);
    const int kq = lane >> 3, nq = lane & 7;
#define CW_LOAD(v, c) do { _Pragma("unroll") for (int i_ = 0; i_ < 16; ++i_) v[i_] = __builtin_nontemporal_load((const f32x4*)((c).src + (size_t)(16 * kq + i_) * DM + 4 * nq)); } while (0)
#define CW_PROC(v, c) do { \
        _Pragma("unroll") for (int j_ = 0; j_ < 4; ++j_) { u32x4 o_; const float s_ = (c).scale; \
            o_.x = pk4_fp8(v[0][j_] * s_, v[1][j_] * s_, v[2][j_] * s_, v[3][j_] * s_);     o_.y = pk4_fp8(v[4][j_] * s_, v[5][j_] * s_, v[6][j_] * s_, v[7][j_] * s_); \
            o_.z = pk4_fp8(v[8][j_] * s_, v[9][j_] * s_, v[10][j_] * s_, v[11][j_] * s_);   o_.w = pk4_fp8(v[12][j_] * s_, v[13][j_] * s_, v[14][j_] * s_, v[15][j_] * s_); \
            *(LAS u32x4*)(tile + (4 * nq + j_) * 144 + 16 * kq) = o_; } \
        asm volatile("s_waitcnt lgkmcnt(0)" ::: "memory"); \
        _Pragma("unroll") for (int q_ = 0; q_ < 4; ++q_) { const int idx_ = lane + 64 * q_, row_ = idx_ >> 3, piece_ = idx_ & 7; \
            *(u32x4*)((c).dst + (size_t)row_ * DM + 16 * piece_) = *(const LAS u32x4*)(tile + row_ * 144 + 16 * piece_); } \
        asm volatile("s_waitcnt lgkmcnt(0)" ::: "memory"); } while (0)
    f32x4 va[16], vb[16];
    int it = cw;
    if (it >= NIT) return;
    CwItem ca = cw_decode(in, ws, cw_map(it)), cb = ca;
    CW_LOAD(va, ca);
    for (;;) {
        const bool hb = it + ncw < NIT;
        if (hb) { cb = cw_decode(in, ws, cw_map(it + ncw)); CW_LOAD(vb, cb); }
        CW_PROC(va, ca);
        if (!hb) break;
        it += ncw;
        const bool ha = it + ncw < NIT;
        if (ha) { ca = cw_decode(in, ws, cw_map(it + ncw)); CW_LOAD(va, ca); }
        CW_PROC(vb, cb);
        if (!ha) break;
        it += ncw;
    }
#undef CW_LOAD
#undef CW_PROC
}

__device__ __forceinline__ void p8_phase(Frame& F) {
    const KargP in = karg_opaque(F.in);
    const int lane = F.lane, l15 = lane & 15, g4 = lane >> 4;
    if (F.wave >= 4) {
        convert_moe_wave(in, F.ws, (LAS unsigned char*)(F.lds + 4 * 20480 + (F.wave - 4) * 4608), lane, F.bid * 4 + (F.wave - 4), F.G * 4);
        return; }
    const bf16_t* R1 = WSP(bf16_t, WS_R1); unsigned char* TOK = WSP(unsigned char, WS_TOK); const float* mod = WSP(float, WS_MOD);
    LAS float* pA = (LAS float*)(F.lds + F.wave * 20480);
    LAS float* pB = pA + 2048;
    LAS float* lg = pA + 4096;
    LAS int* te = (LAS int*)(lg + 576); LAS float* tw = (LAS float*)(te + 64);
    const float* wr = in[I_WR];
#pragma unroll 1
    for (int tile = F.bid + F.G * F.wave; tile < MTOK / 16; tile += F.G * 4) {
        const int bsel = (tile * 16) / SEQ; const float* mv = mod + (size_t)bsel * 12288;
#pragma unroll
        for (int j = 0; j < 8; ++j) { const int c = lane * 4 + 256 * j;
            const f32x4 g = *(const f32x4*)(in[I_LN1G] + c), bb = *(const f32x4*)(in[I_LN1B] + c), sh = *(const f32x4*)(mv + 6144 + c), sc = *(const f32x4*)(mv + 8192 + c) + 1.0f;
            *(LAS f32x4*)(pA + c) = g * sc; *(LAS f32x4*)(pB + c) = bb * sc + sh; }
        LDS_WAIT(); asm volatile("" ::: "memory");
        float my_mean = 0.f, my_rstd = 0.f;
        {
            const bf16_t* xb = R1 + (size_t)tile * 16 * DM + lane * 4;
            f32x4 v[8]; u32x2 vn[8];
#pragma unroll
            for (int j = 0; j < 8; ++j) { const u32x2 t_ = *(const u32x2*)(xb + 256 * j); v[j] = (f32x4){bflo(t_.x), bfhi(t_.x), bflo(t_.y), bfhi(t_.y)}; }
#pragma unroll 1
            for (int rr = 0; rr < 16; ++rr) {
                const bf16_t* xn = xb + (size_t)(rr < 15 ? rr + 1 : rr) * DM;
#pragma unroll
                for (int j = 0; j < 8; ++j) vn[j] = *(const u32x2*)(xn + 256 * j);
                float s = 0.f;
#pragma unroll
                for (int j = 0; j < 8; ++j) s += (v[j].x + v[j].y) + (v[j].z + v[j].w);
                const float mean = wave_sum(s) * (1.f / DM); float s2 = 0.f;
#pragma unroll
                for (int j = 0; j < 8; ++j) { v[j] = v[j] - mean; s2 += (v[j].x * v[j].x + v[j].y * v[j].y) + (v[j].z * v[j].z + v[j].w * v[j].w); }
                const float rstd = 1.f / sqrtf(wave_sum(s2) * (1.f / DM) + LN_EPS);
                if (l15 == rr) { my_mean = mean; my_rstd = rstd; }
                unsigned char* orow = TOK + (size_t)(tile * 16 + rr) * DM;
#pragma unroll
                for (int j = 0; j < 8; ++j) { const int c = lane * 4 + 256 * j;
                    const f32x4 y = v[j] * rstd * *(const LAS f32x4*)(pA + c) + *(const LAS f32x4*)(pB + c);
                    *(unsigned*)(orow + c) = pk4_fp8(y.x, y.y, y.z, y.w); }
#pragma unroll
                for (int j = 0; j < 8; ++j) v[j] = (f32x4){bflo(vn[j].x), bfhi(vn[j].x), bflo(vn[j].y), bfhi(vn[j].y)};
            }
        }
        f32x4 acc0 = (f32x4){0.f, 0.f, 0.f, 0.f}, acc1 = (f32x4){0.f, 0.f, 0.f, 0.f};
        const bf16_t* rowp = R1 + (size_t)(tile * 16 + l15) * DM + 512 * g4;
        const float* wp = wr + (size_t)(512 * g4) * 32 + l15;
        const float ra = my_rstd, rm = -my_mean * my_rstd;
        u32x2 r4 = *(const u32x2*)rowp; float w0[4], w1[4];
#pragma unroll
        for (int j = 0; j < 4; ++j) { w0[j] = wp[j * 32]; w1[j] = wp[j * 32 + 16]; }
#pragma unroll 1
        for (int s = 0; s < 512; s += 4) {
            const int sn = s + 4 < 512 ? s + 4 : s;
            const u32x2 r4n = *(const u32x2*)(rowp + sn); float w0n[4], w1n[4];
#pragma unroll
            for (int j = 0; j < 4; ++j) { w0n[j] = wp[(sn + j) * 32]; w1n[j] = wp[(sn + j) * 32 + 16]; }
            const f32x4 av = *(const LAS f32x4*)(pA + 512 * g4 + s), bv = *(const LAS f32x4*)(pB + 512 * g4 + s);
            const f32x4 tk = ((f32x4){bflo(r4.x), bfhi(r4.x), bflo(r4.y), bfhi(r4.y)} * ra + rm) * av + bv;
#pragma unroll
            for (int j = 0; j < 4; ++j) { acc0 = __builtin_amdgcn_mfma_f32_16x16x4f32(tk[j], w0[j], acc0, 0, 0, 0); acc1 = __builtin_amdgcn_mfma_f32_16x16x4f32(tk[j], w1[j], acc1, 0, 0, 0); }
            r4 = r4n;
#pragma unroll
            for (int j = 0; j < 4; ++j) { w0[j] = w0n[j]; w1[j] = w1n[j]; }
        }
        { const float b0 = in[I_BR][l15], b1 = in[I_BR][16 + l15];
#pragma unroll
          for (int r = 0; r < 4; ++r) { lg[(4 * g4 + r) * 33 + l15] = acc0[r] + b0; lg[(4 * g4 + r) * 33 + 16 + l15] = acc1[r] + b1; } }
        LDS_WAIT(); asm volatile("" ::: "memory");
        if (lane < 16) {
            unsigned chosen = 0u; float lv[4]; int le[4];
            for (int k = 0; k < 4; ++k) { float best = -3.4e38f; int be = 0;
                for (int e = 0; e < 32; ++e) { const float v = lg[lane * 33 + e]; if (!((chosen >> e) & 1u) && v > best) { best = v; be = e; } }
                chosen |= 1u << be; lv[k] = best; le[k] = be; }
            float ex[4], sum = 0.f;
            for (int k = 0; k < 4; ++k) { ex[k] = __expf(lv[k] - lv[0]); sum += ex[k]; }
            for (int k = 0; k < 4; ++k) { te[lane * 4 + k] = le[k]; tw[lane * 4 + k] = ex[k] / sum; }
        }
        LDS_WAIT(); asm volatile("" ::: "memory");
        { const int e = te[lane]; const float wv = tw[lane]; const int token = tile * 16 + (lane >> 2);
          const int pos = (int)__hip_atomic_fetch_add(F.ctl + CW_CNT + 64 * e, 1u, __ATOMIC_RELAXED, __HIP_MEMORY_SCOPE_AGENT);
          WSP(int, WS_TOPE)[token * 4 + (lane & 3)] = e; WSP(int, WS_TOPP)[token * 4 + (lane & 3)] = pos; WSP(float, WS_TOPW)[token * 4 + (lane & 3)] = wv;
          WSP(int, WS_RTOK)[e * POSCAP + pos] = token; }
        LDS_WAIT(); asm volatile("" ::: "memory");
    }
}

constexpr int MOE_TBL = 131072;
__device__ __forceinline__ void moe_table(Frame& F) {
    LAS int* tst = (LAS int*)(F.lds + MOE_TBL); LAS int* cn = (LAS int*)(F.lds + MOE_TBL + 256);
    __syncthreads();
    if (F.tid < 64) {
        const int e = F.tid & 31; const int c = (int)__hip_atomic_load(F.ctl + CW_CNT + 64 * e, __ATOMIC_RELAXED, __HIP_MEMORY_SCOPE_AGENT);
        int inc = (c + 255) >> 8;
#pragma unroll
        for (int o = 1; o < 32; o <<= 1) { const int t = __shfl_up(inc, o); if ((F.tid & 31) >= o) inc += t; }
        if (F.tid < 32) { cn[e] = c; tst[e] = inc - ((c + 255) >> 8); if (e == 31) tst[NEXP] = inc; } }
    __syncthreads();
}
template <bool GU> struct SchedMoE {
    static constexpr bool GATHER = GU;
    int G, c, NT; const LAS int* tst; const LAS int* cn; const int* rtok; const char* a; const char* b;
    __device__ __forceinline__ bool next(int i, Unit& u) const {
        const int nwg = __builtin_amdgcn_readfirstlane(tst[NEXP]) * NT; const int L = i * G + c; if (L >= nwg) return false;
        int wg; { const int q = nwg / 8, r = nwg % 8, xcd = L % 8, off = L / 8; wg = (xcd < r ? xcd * (q + 1) : r * (q + 1) + (xcd - r) * q) + off; }
        int e = 0;
#pragma unroll 1
        for (int k = 1; k < NEXP; ++k) { const int s = __builtin_amdgcn_readfirstlane(tst[k]); if (wg >= s * NT) e = k; }
        const int ts = __builtin_amdgcn_readfirstlane(tst[e]), ts1 = __builtin_amdgcn_readfirstlane(tst[e + 1]);
        const int rem = wg - ts * NT, ne = ts1 - ts;
        u.pm = ts + rem % ne; u.pn = rem / ne; u.ex = e; return true;
    }
    __device__ __forceinline__ const char* a_base(const Unit& u) const { return GU ? a : a + (size_t)u.pm * 256 * DM; }
    __device__ __forceinline__ const char* b_base(const Unit& u) const { return b + ((size_t)u.ex * (GU ? 4096 : 2048) + 256 * u.pn) * DM; }
    __device__ __forceinline__ int a_row(const Unit& u, int R) const { const int cnt = __builtin_amdgcn_readfirstlane(cn[u.ex]), t0 = __builtin_amdgcn_readfirstlane(tst[u.ex]); int pos = (u.pm - t0) * 256 + R; pos = pos < cnt ? pos : cnt - 1; return rtok[u.ex * POSCAP + pos]; }
};
struct EpiGU {
    static constexpr bool PERM = true;
    unsigned char* ACT; const float* bg; const float* bu;
    __device__ __forceinline__ void operator()(const f32x4 (&acc)[2][2][4][2], const Unit& u, int wr, int wc, int fr, int fq) const {
        const int row0 = u.pm * 256 + wr * 64 + fr, col0 = u.pn * 128 + wc * 32 + 8 * fq;
        const float* bgp = bg + (size_t)u.ex * DM + col0; const float* bup = bu + (size_t)u.ex * DM + col0;
        const f32x4 g0 = *(const f32x4*)bgp, g1 = *(const f32x4*)(bgp + 4), u0 = *(const f32x4*)bup, u1 = *(const f32x4*)(bup + 4);
#pragma unroll
        for (int ai = 0; ai < 2; ++ai)
#pragma unroll
            for (int m = 0; m < 4; ++m) { const size_t row = row0 + ai * 128 + m * 16;
                float o[8];
#pragma unroll
                for (int n = 0; n < 2; ++n)
#pragma unroll
                    for (int j = 0; j < 4; ++j) { const float gv = fminf(acc[ai][0][m][n][j] + (n ? g1[j] : g0[j]), 7.0f);
                        const float uv = fminf(fmaxf(acc[ai][1][m][n][j] + (n ? u1[j] : u0[j]), -7.0f), 7.0f);
                        o[n * 4 + j] = 4.0f * gv * sigmoidf_(1.702f * gv) * (uv + 1.0f); }
                u32x2 w; w.x = pk4_fp8(o[0], o[1], o[2], o[3]); w.y = pk4_fp8(o[4], o[5], o[6], o[7]);
                *(u32x2*)(ACT + row * DM + col0) = w; }
    }
};
struct EpiDN {
    static constexpr bool PERM = true;
    bf16_t* YR; const float* bd;
    __device__ __forceinline__ void operator()(const f32x4 (&acc)[2][2][4][2], const Unit& u, int wr, int wc, int fr, int fq) const {
        const int r0 = wr * 64 + fr, col0 = u.pn * 256 + wc * 32 + 8 * fq;
        const float* bp = bd + (size_t)u.ex * DM + col0;
        bf16_t* base = YR + ((size_t)u.pm * 256 + r0) * DM + col0;
#pragma unroll
        for (int bj = 0; bj < 2; ++bj) {
            const f32x4 bv0 = *(const f32x4*)(bp + bj * 128), bv1 = *(const f32x4*)(bp + bj * 128 + 4);
#pragma unroll
            for (int ai = 0; ai < 2; ++ai)
#pragma unroll
                for (int m = 0; m < 4; ++m) {
                    const f32x4 v0 = acc[ai][bj][m][0] + bv0, v1 = acc[ai][bj][m][1] + bv1;
                    u32x4 w; w.x = pg8::cvt_pk_bf16(v0[0], v0[1]); w.y = pg8::cvt_pk_bf16(v0[2], v0[3]); w.z = pg8::cvt_pk_bf16(v1[0], v1[1]); w.w = pg8::cvt_pk_bf16(v1[2], v1[3]);
                    *(u32x4*)(base + (size_t)(ai * 128 + m * 16) * DM + bj * 128) = w; }
        }
    }
};

__device__ __forceinline__ void p11_phase(Frame& F) {
    const KargP in = karg_opaque(F.in);
    const int gw = F.bid * NWAVES + F.wave, NGW = F.G * NWAVES, lane = F.lane;
    const LAS int* tst = (const LAS int*)(F.lds + MOE_TBL);
    const bf16_t* R1 = WSP(bf16_t, WS_R1); const bf16_t* YR = WSP(bf16_t, WS_YR); const float* mod = WSP(float, WS_MOD);
    LAS float* pl = (LAS float*)F.lds;
    for (int i = F.tid; i < 2048; i += NTHR) { pl[i] = in[I_LN1G][i]; pl[2048 + i] = in[I_LN1B][i]; pl[4096 + i] = in[I_LN2G][i]; pl[6144 + i] = in[I_LN2B][i]; }
    for (int i = F.tid; i < 8 * 2048; i += NTHR) pl[8192 + i] = mod[(size_t)(i >> 11) * 12288 + 10240 + (i & 2047)];
    __syncthreads();
    LAS int* sd = (LAS int*)(F.lds + 98304 + F.wave * 512); LAS float* sw = (LAS float*)(F.lds + 98304 + F.wave * 512 + 256);
#pragma unroll 1
    for (int rb = gw * 8; rb < MTOK; rb += NGW * 8) {
        const int li = lane & 31;
        { const int ve = WSP(int, WS_TOPE)[rb * 4 + li], vp = WSP(int, WS_TOPP)[rb * 4 + li]; const float vw = WSP(float, WS_TOPW)[rb * 4 + li];
          if (lane < 32) { sd[li] = tst[ve] * 256 + vp; sw[li] = vw; } }
        const LAS float* g2p = pl + 8192 + (rb / SEQ) * 2048;
        LDS_WAIT(); asm volatile("" ::: "memory");
#pragma unroll 1
        for (int ri = 0; ri < 8; ++ri) {
            const int row = rb + ri;
            int dest[4]; float wk[4];
#pragma unroll
            for (int k = 0; k < 4; ++k) { dest[k] = __builtin_amdgcn_readfirstlane(sd[ri * 4 + k]); wk[k] = __builtin_bit_cast(float, __builtin_amdgcn_readfirstlane(__builtin_bit_cast(int, sw[ri * 4 + k]))); }
            const bf16_t* xr = R1 + (size_t)row * DM + lane * 4;
            f32x4 v[8]; u32x2 yy[4][8]; u32x2 vr[8];
#pragma unroll
            for (int j = 0; j < 8; ++j) vr[j] = *(const u32x2*)(xr + 256 * j);
#pragma unroll
            for (int k = 0; k < 4; ++k) { const bf16_t* yp = YR + (size_t)dest[k] * DM + lane * 4;
#pragma unroll
                for (int j = 0; j < 8; ++j) yy[k][j] = *(const u32x2*)(yp + 256 * j); }
            float s = 0.f;
#pragma unroll
            for (int j = 0; j < 8; ++j) { v[j] = (f32x4){bflo(vr[j].x), bfhi(vr[j].x), bflo(vr[j].y), bfhi(vr[j].y)}; s += (v[j].x + v[j].y) + (v[j].z + v[j].w); }
            float mean = wave_sum(s) * (1.f / DM); float s2 = 0.f;
#pragma unroll
            for (int j = 0; j < 8; ++j) { v[j] = v[j] - mean; s2 += (v[j].x * v[j].x + v[j].y * v[j].y) + (v[j].z * v[j].z + v[j].w * v[j].w); }
            float rstd = 1.f / sqrtf(wave_sum(s2) * (1.f / DM) + LN_EPS);
            s = 0.f;
#pragma unroll
            for (int j = 0; j < 8; ++j) { const int c = lane * 4 + 256 * j;
                const f32x4 g = *(const LAS f32x4*)(pl + c), bb = *(const LAS f32x4*)(pl + 2048 + c), g2v = *(const LAS f32x4*)(g2p + c);
                f32x4 y = (f32x4){0.f, 0.f, 0.f, 0.f};
#pragma unroll
                for (int k = 0; k < 4; ++k) y += (f32x4){bflo(yy[k][j].x), bfhi(yy[k][j].x), bflo(yy[k][j].y), bfhi(yy[k][j].y)} * wk[k];
                v[j] = (v[j] * rstd * g + bb) * DN_ALPHA + g2v * y;
                s += (v[j].x + v[j].y) + (v[j].z + v[j].w); __builtin_amdgcn_sched_barrier(0); }
            mean = wave_sum(s) * (1.f / DM); s2 = 0.f;
#pragma unroll
            for (int j = 0; j < 8; ++j) { v[j] = v[j] - mean; s2 += (v[j].x * v[j].x + v[j].y * v[j].y) + (v[j].z * v[j].z + v[j].w * v[j].w); }
            rstd = 1.f / sqrtf(wave_sum(s2) * (1.f / DM) + LN_EPS);
            float* orow = F.out + (size_t)row * DM;
#pragma unroll
            for (int j = 0; j < 8; ++j) { const int c = lane * 4 + 256 * j;
                const f32x4 g = *(const LAS f32x4*)(pl + 4096 + c), bb = *(const LAS f32x4*)(pl + 6144 + c);
                *(f32x4*)(orow + c) = v[j] * rstd * g + bb; }
        }
        LDS_WAIT(); asm volatile("" ::: "memory");
    }
}

constexpr int NPHASE = 13;
__global__ void __launch_bounds__(NTHR, 2) mk_fwd(Args args) {
    extern __shared__ __attribute__((aligned(16))) unsigned char lds_raw[];
    Frame F;
    F.lds = (LAS unsigned char*)lds_raw;
    F.MISC = (volatile LAS unsigned*)(F.lds + MISC_OFF);
    F.tid = threadIdx.x; F.lane = F.tid & 63; F.wave = __builtin_amdgcn_readfirstlane(F.tid >> 6);
    F.G = gridDim.x; F.bid = blockIdx.x;
    F.in = (KargP)__builtin_amdgcn_kernarg_segment_ptr(); F.out = args.out; F.ws = args.ws; F.ctl = (unsigned*)(args.ws + WS_CTL);
    for (int u = F.tid; u < (LDS_BYTES - MISC_OFF) / 4; u += NTHR) ((LAS unsigned*)(F.lds + MISC_OFF))[u] = 0u;
    __syncthreads();
    XcdBarrier bar; bar.bar = F.ctl + CW_BAR; bar.x = 0; bar.st = nullptr;
    if (MK_LAUNCHES == 1) bar = xcd_barrier_post(F.ctl + CW_BAR, F.MISC + 8);
    const int lo = args.ph_lo, hi = args.ph_hi;
#ifndef PH_MASK
#define PH_MASK 0xFFFF
#endif
#define RELOAD() do { const KargP k_ = karg_opaque(F.in); F.out = (float*)k_[38]; F.ws = (unsigned char*)k_[39]; F.ctl = (unsigned*)F.ws; int t_ = threadIdx.x; asm volatile("" : "+v"(t_)); F.tid = t_; F.lane = t_ & 63; F.wave = __builtin_amdgcn_readfirstlane(t_ >> 6); } while (0)
#define IN(k) (((PH_MASK >> (k)) & 1) && lo <= (k) && (k) < hi)
#define SEAM(k) do { if (IN(k) && IN((k) + 1)) xcd_barrier(bar); } while (0)
#ifndef DUP_MASK
#define DUP_MASK 0
#endif
#define REP(k) for (int rep_ = 0; rep_ < (((DUP_MASK >> (k)) & 1) ? 2 : 1); ++rep_)
    if (IN(0)) REP(0) p0_phase(F);
    SEAM(0);
    RELOAD();
    if (IN(1)) REP(1) p0b_phase(F);
    SEAM(1);
    RELOAD();
    if (IN(2)) REP(2) p1_phase(F);
    SEAM(2);
    RELOAD();
    if (IN(3)) REP(3) {
        EpiZ E{WSP(bf16_t, WS_Z), WSP(bf16_t, WS_ZT), WSP(float, WS_BINP)};
        { SchedZ<false> S{F.G, F.bid, (const char*)WSP(bf16_t, WS_HX), (const char*)WSP(bf16_t, WS_WIN)};
          pg8::gemm_phase<EpiZ, SchedZ<false>>(F.lds, DM / 64, DM * 2, DM * 2, S, E); }
        { SchedZ<true> S{F.G, F.G - 1 - F.bid, (const char*)WSP(unsigned char, WS_HX8), (const char*)WSP(unsigned char, WS_WIN8)};
          pg8::gemm_phase<EpiZ, SchedZ<true>, true>(F.lds, DM / 128, DM, DM, S, E, 0x7A7A7A7A, 0x7F7F7F7F); }
    }
    SEAM(3);
    RELOAD();
    if (IN(4)) REP(4) p3_phase(F);
    SEAM(4);
    RELOAD();
    if (IN(5)) REP(5) {
        SchedQK S{F.G, F.bid, (const char*)WSP(bf16_t, WS_U), (const char*)WSP(bf16_t, WS_WQK)};
        EpiQK E{WSP(bf16_t, WS_QKB)};
        pg8::gemm_phase<EpiQK, SchedQK>(F.lds, 256 / 64, MW * 2, 256 * 2, S, E);
    }
    SEAM(5);
    RELOAD();
    if (IN(6)) REP(6) {
#ifndef DUP_ML
#define DUP_ML 1
#endif
#ifndef DUP_HY
#define DUP_HY 1
#endif
        for (int un = F.bid; un < 256 * DUP_ML; un += F.G) mlstm_unit(F, un & 255);
        for (int un = F.bid; un < 512 * DUP_HY; un += F.G) hyena_unit(F, un & 511);
    }
    SEAM(6);
    RELOAD();
    if (IN(7)) REP(7) {
        { SchedP S{F.G, F.bid, (const char*)WSP(unsigned char, WS_AM), (const char*)WSP(unsigned char, WS_WPA2), (size_t)256 * 2048, (size_t)256 * 2048};
          EpiMA E{WSP(bf16_t, WS_T), WSP(bf16_t, WS_Z)};
          pg8::gemm_phase<EpiMA, SchedP, true>(F.lds, 2048 / 128, 2048, 2048, S, E, 0x7A7A7A7A, 0x7F7F7F7F); }
        VM_WAIT(); __syncthreads();
        { SchedP S{F.G, F.bid, (const char*)WSP(unsigned char, WS_HH), (const char*)WSP(unsigned char, WS_WPH), (size_t)256 * 1024, (size_t)256 * 1024};
          EpiMB E{WSP(bf16_t, WS_T), WSP(bf16_t, WS_Z), WSP(unsigned char, WS_MX)};
          pg8::gemm_phase<EpiMB, SchedP, true>(F.lds, 1024 / 128, 1024, 1024, S, E, 0x7A7A7A7A, 0x7F7F7F7F); }
    }
    SEAM(7);
    RELOAD();
    if (IN(8)) REP(8) {
        SchedP S{F.G, F.bid, (const char*)WSP(unsigned char, WS_MX), (const char*)WSP(unsigned char, WS_WOUT), (size_t)256 * 2048, (size_t)256 * 2048};
        const KargP in = karg_opaque(F.in); EpiWO E{WSP(bf16_t, WS_R1), in[I_X], WSP(float, WS_STATS), in[I_LNG], in[I_LNB], WSP(float, WS_MOD)};
        pg8::gemm_phase<EpiWO, SchedP, true>(F.lds, 2048 / 128, 2048, 2048, S, E, 0x79797979, 0x7F7F7F7F);
    }
    SEAM(8);
    RELOAD();
    if (IN(9)) p8_phase(F);
    SEAM(9);
    RELOAD();
    if (IN(10)) REP(10) {
        moe_table(F);
        SchedMoE<true> S{F.G, F.bid, 16, (const LAS int*)(F.lds + MOE_TBL), (const LAS int*)(F.lds + MOE_TBL + 256), WSP(int, WS_RTOK), (const char*)WSP(bf16_t, WS_TOK), (const char*)WSP(bf16_t, WS_WGU)};
        const KargP in = karg_opaque(F.in); EpiGU E{WSP(unsigned char, WS_ACT), in[I_BG], in[I_BU]};
        pg8::gemm_phase<EpiGU, SchedMoE<true>, true>(F.lds, DM / 128, DM, DM, S, E, 0x7A7A7A7A, 0x7F7F7F7F);
    }
    SEAM(10);
    RELOAD();
    if (IN(11)) REP(11) {
        moe_table(F);
        SchedMoE<false> S{F.G, F.bid, 8, (const LAS int*)(F.lds + MOE_TBL), (const LAS int*)(F.lds + MOE_TBL + 256), WSP(int, WS_RTOK), (const char*)WSP(bf16_t, WS_ACT), (const char*)WSP(bf16_t, WS_WD)};
        const KargP in = karg_opaque(F.in); EpiDN E{WSP(bf16_t, WS_YR), in[I_BDN]};
        pg8::gemm_phase<EpiDN, SchedMoE<false>, true>(F.lds, DM / 128, DM, DM, S, E, 0x79797979, 0x7D7D7D7D);
    }
    SEAM(11);
    RELOAD();
    if (IN(12)) REP(12) { moe_table(F); p11_phase(F); }
#undef IN
#undef SEAM
}

extern "C" void kernel_launch(void* const* d_in, const int* in_sizes, int n_in, void* d_out, int out_size, void* d_ws, size_t ws_size, hipStream_t stream) {
    static int grid = 0;
    if (grid == 0) {
        if (n_in != 38 || out_size != MTOK * DM || ws_size < WS_END) { fprintf(stderr, "kernel_launch: unexpected shapes: n_in %d out %d ws %zu (need %zu)\n", n_in, out_size, ws_size, (size_t)WS_END); grid = -1; return; }
        int dev = 0, cus = 0, per_cu = 0;
        if (hipGetDevice(&dev) != hipSuccess || hipDeviceGetAttribute(&cus, hipDeviceAttributeMultiprocessorCount, dev) != hipSuccess) { grid = -1; return; }
        if (hipFuncSetAttribute((const void*)mk_fwd, hipFuncAttributeMaxDynamicSharedMemorySize, LDS_BYTES) != hipSuccess) { fprintf(stderr, "kernel_launch: hipFuncSetAttribute failed\n"); grid = -1; return; }
        if (hipOccupancyMaxActiveBlocksPerMultiprocessor(&per_cu, (const void*)mk_fwd, NTHR, LDS_BYTES) != hipSuccess || per_cu < 1) fprintf(stderr, "kernel_launch: occupancy query says %d\n", per_cu);
        (void)hipGetLastError();
        grid = cus;
    }
    if (grid < 0) return;
    (void)hipMemsetAsync((char*)d_ws + WS_CTL, 0, CTL_ZERO_BYTES, stream);
    Args a{};
    for (int i = 0; i < 38; ++i) a.in[i] = (const float*)d_in[i];
    a.out = (float*)d_out; a.ws = (unsigned char*)d_ws;
#if MK_LAUNCHES == 1
    a.ph_lo = 0; a.ph_hi = NPHASE;
    hipLaunchKernelGGL(mk_fwd, dim3(grid), dim3(NTHR), LDS_BYTES, stream, a);
#else
    for (int p = 0; p < NPHASE; ++p) { a.ph_lo = p; a.ph_hi = p + 1; hipLaunchKernelGGL(mk_fwd, dim3(grid), dim3(NTHR), LDS_BYTES, stream, a); }
#endif
}
```

```cpp
#include <hip/hip_runtime.h>
#include <cstdio>
#include <cstdint>

#define GAS __attribute__((address_space(1)))
#define LAS __attribute__((address_space(3)))
typedef unsigned short bf16_t;
typedef short bf16x8 __attribute__((ext_vector_type(8)));
typedef float f32x4 __attribute__((ext_vector_type(4)));
typedef float f32x2 __attribute__((ext_vector_type(2)));
typedef unsigned u32x4 __attribute__((ext_vector_type(4)));
typedef unsigned u32x2 __attribute__((ext_vector_type(2)));

#ifndef PROBE_PH
#define PROBE_PH -1
#endif
#ifndef MK_LAUNCHES
#define MK_LAUNCHES 1
#endif

constexpr int DM = 2048, NB = 8, SEQ = 2048, CTX = 256, GW = 64;
constexpr int MTOK = NB * SEQ;
constexpr int MCTX = NB * CTX;
constexpr int MALL = MTOK + MCTX;
constexpr int NH = 4, HD = 256, MW = 1024, HW = 1024;
constexpr int N_IN = 10256;
constexpr int NEXP = 32, TOPK = 4;
constexpr float LN_EPS = 1e-5f;
constexpr float DN_ALPHA = 1.189207115002721f;
constexpr int ZN = 7424, ZC_QK = 0, ZC_V = 1024, ZC_O = 2048, ZC_GA = 3072, ZC_GH = 5120, ZC_GT = 7168;
constexpr int WIN_ROWS = 10496, WIN_HY0 = 7424;
constexpr int MAXTILES = 288;
constexpr int POSCAP = 16384;

constexpr size_t MiB = 1u << 20;
constexpr size_t WS_CTL = 0;
constexpr size_t WS_MODP = 1 * MiB;
constexpr size_t WS_MOD = 9 * MiB;
constexpr size_t WS_BINP = 10 * MiB;
constexpr size_t WS_A3 = 10 * MiB + 64 * 1024;
constexpr size_t WS_STATS = 11 * MiB;
constexpr size_t WS_TOPE = 11 * MiB + 256 * 1024;
constexpr size_t WS_TOPP = 11 * MiB + 512 * 1024;
constexpr size_t WS_TOPW = 11 * MiB + 768 * 1024;
constexpr size_t WS_RTOK = 12 * MiB;
constexpr size_t WS_RW = 14 * MiB;
constexpr size_t WS_WQK = 16 * MiB;
constexpr size_t WS_WPH = 17 * MiB;
constexpr size_t WS_WPA2 = 21 * MiB;
constexpr size_t WS_WOUT = 29 * MiB;
constexpr size_t WS_WIN = 37 * MiB;
constexpr size_t WS_WGU = 78 * MiB;
constexpr size_t WS_WD = 590 * MiB;
constexpr size_t WS_RA = 846 * MiB;
constexpr size_t WS_Z = WS_RA, WS_ZT = WS_RA + 261 * MiB, WS_ACT = WS_RA;
constexpr size_t WS_RB = 1203 * MiB;
constexpr size_t WS_HX = WS_RB, WS_U = WS_RB + 72 * MiB, WS_QKB = WS_RB + 108 * MiB, WS_AM = WS_RB + 180 * MiB, WS_HH = WS_RB + 244 * MiB, WS_MX = WS_RB + 276 * MiB, WS_YR = WS_RB;
constexpr size_t WS_RC = 1543 * MiB;
constexpr size_t WS_HTAPS = WS_RC, WS_H = WS_RC + 32 * MiB, WS_T = WS_RC;
constexpr size_t WS_R1 = 1671 * MiB;
constexpr size_t WS_TOK = 1799 * MiB;
constexpr size_t WS_HX8 = WS_RC + 96 * MiB;
constexpr size_t WS_WIN8 = 1863 * MiB;
constexpr size_t WS_DUMMY = 1884 * MiB;
constexpr size_t WS_END = 1890 * MiB;
constexpr int CW_TMO = 0, CW_BAR = 4096, CW_CNT = 16384;
constexpr size_t CTL_ZERO_BYTES = 1 * MiB;

constexpr int LDS_BYTES = 160 * 1024 - 2048;
constexpr int MISC_OFF = LDS_BYTES - 1024;
constexpr int NWAVES = 8, NTHR = 512;

#define LDS_WAIT() asm volatile("s_waitcnt lgkmcnt(0)" ::: "memory")
#define VM_WAIT() asm volatile("s_waitcnt vmcnt(0)" ::: "memory")
__device__ __forceinline__ unsigned f2bf(float f) { unsigned u = __builtin_bit_cast(unsigned, f); return (u + 0x7fffu + ((u >> 16) & 1u)) >> 16; }
__device__ __forceinline__ unsigned pk2(float lo, float hi) { unsigned r; asm("v_cvt_pk_bf16_f32 %0, %1, %2" : "=v"(r) : "v"(lo), "v"(hi)); return r; }
__device__ __forceinline__ unsigned pk4_fp8(float a, float b, float c, float d) { int w = 0; w = __builtin_amdgcn_cvt_pk_fp8_f32(a, b, w, false); w = __builtin_amdgcn_cvt_pk_fp8_f32(c, d, w, true); return (unsigned)w; }
__device__ __forceinline__ float bf2f(unsigned b) { return __builtin_bit_cast(float, b << 16); }
__device__ __forceinline__ float bflo(unsigned w) { return __builtin_bit_cast(float, w << 16); }
__device__ __forceinline__ float bfhi(unsigned w) { return __builtin_bit_cast(float, w & 0xffff0000u); }
__device__ __forceinline__ float sigmoidf_(float x) { return 1.0f / (1.0f + __expf(-x)); }
__device__ __forceinline__ float sigmoid_fast(float x) { return __builtin_amdgcn_rcpf(1.0f + __expf(-x)); }
__device__ __forceinline__ float wave_sum(float v) {
#pragma unroll
    for (int o = 1; o < 64; o <<= 1) v += __shfl_xor(v, o);
    return v;
}

#define DPP_STEP_(OP, x, ctrl, rmask, bmask, ident) { const float t_ = __builtin_bit_cast(float, __builtin_amdgcn_update_dpp(__builtin_bit_cast(int, ident), __builtin_bit_cast(int, x), ctrl, rmask, bmask, false)); x = OP(x, t_); }
__device__ __forceinline__ float scan_add_(float a, float b) { return a + b; }
__device__ __forceinline__ float wave_scan_sum(float v) {
    float x = v; const float z = 0.f;
    { const float t1 = __builtin_bit_cast(float, __builtin_amdgcn_update_dpp(0, __builtin_bit_cast(int, v), 0x111, 0xf, 0xf, false));
      const float t2 = __builtin_bit_cast(float, __builtin_amdgcn_update_dpp(0, __builtin_bit_cast(int, v), 0x112, 0xf, 0xf, false));
      const float t3 = __builtin_bit_cast(float, __builtin_amdgcn_update_dpp(0, __builtin_bit_cast(int, v), 0x113, 0xf, 0xf, false));
      x = (v + t1) + (t2 + t3); }
    DPP_STEP_(scan_add_, x, 0x114, 0xf, 0xe, z)
    DPP_STEP_(scan_add_, x, 0x118, 0xf, 0xc, z)
    DPP_STEP_(scan_add_, x, 0x142, 0xa, 0xf, z)
    DPP_STEP_(scan_add_, x, 0x143, 0xc, 0xf, z)
    return x;
}
__device__ __forceinline__ float wave_scan_max(float v) {
    float x = v; const float ninf = -__builtin_inff(); const int ni = __builtin_bit_cast(int, ninf);
    { const float t1 = __builtin_bit_cast(float, __builtin_amdgcn_update_dpp(ni, __builtin_bit_cast(int, v), 0x111, 0xf, 0xf, false));
      const float t2 = __builtin_bit_cast(float, __builtin_amdgcn_update_dpp(ni, __builtin_bit_cast(int, v), 0x112, 0xf, 0xf, false));
      const float t3 = __builtin_bit_cast(float, __builtin_amdgcn_update_dpp(ni, __builtin_bit_cast(int, v), 0x113, 0xf, 0xf, false));
      x = fmaxf(fmaxf(v, t1), fmaxf(t2, t3)); }
    DPP_STEP_(fmaxf, x, 0x114, 0xf, 0xe, ninf)
    DPP_STEP_(fmaxf, x, 0x118, 0xf, 0xc, ninf)
    DPP_STEP_(fmaxf, x, 0x142, 0xa, 0xf, ninf)
    DPP_STEP_(fmaxf, x, 0x143, 0xc, 0xf, ninf)
    return x;
}
__device__ __forceinline__ float lane_bcast(float v, int l) { return __builtin_bit_cast(float, __builtin_amdgcn_readlane(__builtin_bit_cast(int, v), l)); }
#define XB_TMO      128
#define XB_XCNT(j)  (256  + 64 * (j))
#define XB_XSUB(j)  (1280 + 64 * (j))
#define XB_XGEN(j)  (2304 + 64 * (j))
#define XB_TOP      3328
#define XB_TOPGEN   3392
#define XCD_BAR_WORDS 3456
#define XB_SPIN_CAP (1u << 22)
__device__ __forceinline__ unsigned xb_ld(unsigned* p)              { return __hip_atomic_load(p, __ATOMIC_RELAXED, __HIP_MEMORY_SCOPE_AGENT); }
__device__ __forceinline__ unsigned xb_add(unsigned* p, unsigned v) { return __hip_atomic_fetch_add(p, v, __ATOMIC_RELAXED, __HIP_MEMORY_SCOPE_AGENT); }
__device__ __forceinline__ unsigned xb_xcc_id() { return (unsigned)__builtin_amdgcn_s_getreg((3 << 11) | 20) & 0xFu; }
#define XB_SPIN(cond, bar) do { unsigned _sp = 0; while (cond) { __builtin_amdgcn_s_sleep(1); \
    if ((++_sp & 255u) == 0u) { if (xb_ld(&(bar)[XB_TMO])) break; if (_sp > XB_SPIN_CAP) { atomicAdd(&(bar)[XB_TMO], 1u); break; } } } } while (0)
struct XcdBarrier { unsigned* bar; unsigned x; volatile LAS unsigned* st; };
__device__ __forceinline__ XcdBarrier xcd_barrier_post(unsigned* bar, volatile LAS unsigned* st) {
    XcdBarrier b; b.bar = bar; b.x = xb_xcc_id(); b.st = st;
    if (threadIdx.x == 0) (void)xb_add(&bar[XB_XCNT(b.x)], 1u);
    return b;
}
__device__ __forceinline__ void xcd_barrier_complete(unsigned* bar, unsigned x, unsigned& nloc, unsigned& nx) {
    const unsigned G = gridDim.x * gridDim.y * gridDim.z;
    unsigned sum, cnt, mine, sp = 0u;
    for (;;) {
        sum = 0u; cnt = 0u; mine = 0u;
#pragma unroll
        for (unsigned j = 0; j < 16; ++j) { const unsigned c = xb_ld(&bar[XB_XCNT(j)]); sum += c; cnt += (c > 0u) ? 1u : 0u; mine = (j == x) ? c : mine; }
        if (sum == G) break;
        __builtin_amdgcn_s_sleep(1);
        if ((++sp & 255u) == 0u) { if (xb_ld(&bar[XB_TMO])) break; if (sp > XB_SPIN_CAP) { atomicAdd(&bar[XB_TMO], 1u); break; } }
    }
    nloc = mine > 0u ? mine : 1u; nx = cnt > 0u ? cnt : 1u;
}
__device__ __forceinline__ void xcd_barrier(const XcdBarrier& b) {
    asm volatile("s_waitcnt vmcnt(0)" ::: "memory");
    __syncthreads();
    if (threadIdx.x == 0) {
        unsigned* bar = b.bar;
        __builtin_amdgcn_s_waitcnt(0);
        unsigned nloc = b.st[0], nx = b.st[1];
        if (nloc == 0u) { xcd_barrier_complete(bar, b.x, nloc, nx); b.st[0] = nloc; b.st[1] = nx; }
        const unsigned old = xb_add(&bar[XB_XSUB(b.x)], 1u);
        const unsigned gen = old / nloc;
        if (old + 1u == (gen + 1u) * nloc) {
            __builtin_amdgcn_fence(__ATOMIC_RELEASE, "agent");
            asm volatile("s_waitcnt vmcnt(0)" ::: "memory");
            const unsigned og = xb_add(&bar[XB_TOP], 1u);
            const unsigned tg = og / nx;
            if (og + 1u == (tg + 1u) * nx) xb_add(&bar[XB_TOPGEN], 1u);
            else XB_SPIN(xb_ld(&bar[XB_TOPGEN]) == tg, bar);
            __builtin_amdgcn_fence(__ATOMIC_ACQUIRE, "agent");
            xb_add(&bar[XB_XGEN(b.x)], 1u);
            asm volatile("s_waitcnt vmcnt(0)" ::: "memory");
        } else {
            XB_SPIN(xb_ld(&bar[XB_XGEN(b.x)]) == gen, bar);
            __builtin_amdgcn_fence(__ATOMIC_ACQUIRE, "agent");
            asm volatile("s_waitcnt vmcnt(0)" ::: "memory");
        }
    }
    __syncthreads();
}

struct Args {
    const float* in[38];
    float* out; unsigned char* ws;
    int ph_lo, ph_hi;
};
enum { I_X = 0, I_C, I_CTX, I_CCTX, I_LNG, I_LNB, I_WMOD, I_BMOD, I_WIN, I_BIN, I_MCW, I_MCB, I_WQH, I_WKH, I_HCW, I_HCB, I_FW1, I_FB1, I_FWH, I_FBH,
       I_FFREQ, I_FWOUT, I_HSKIP, I_WPA, I_WPH, I_WOUT, I_LN1G, I_LN1B, I_WR, I_BR, I_WG, I_BG, I_WU, I_BU, I_WDN, I_BDN, I_LN2G, I_LN2B };

namespace pg8 {
constexpr int BM = 256, BK = 64, HALF = 128, HTB = HALF * BK * 2, STAGE_BYTES = 8 * HTB, NXCD = 8, WGM = 8;
__host__ __device__ __forceinline__ int lds_byte(int r, int c) { const int st = (r >> 4) * 2 + (c >> 5), rr = r & 15, cc = c & 31, ob = rr * 64 + cc * 2; return st * 1024 + (ob ^ (((ob >> 9) & 1) << 5)); }
__host__ __device__ __forceinline__ void stage_rc(int b, int& R, int& C) { const int st = b / 1024, sb = b % 1024, swz = sb ^ (((sb >> 9) & 1) << 5); R = (st >> 1) * 16 + swz / 64; C = (st & 1) * 32 + (swz % 64) / 2; }
__host__ __device__ __forceinline__ int perm32(int rho) { const int n = rho >> 4, i = rho & 15; return 8 * (i >> 2) + 4 * n + (i & 3); }
struct Unit { int pm, pn, ex; };
__device__ __forceinline__ void decode_tile(int L, int nM, int nN, int& pm, int& pn) {
    const int nwg = nM * nN; int wgid = L;
    { const int q = nwg / NXCD, r = nwg % NXCD, xcd = wgid % NXCD, off = wgid / NXCD; wgid = (xcd < r ? xcd * (q + 1) : r * (q + 1) + (xcd - r) * q) + off; }
    const int nig = WGM * nN, gid = wgid / nig, fm = gid * WGM, gsz = (nM - fm) < WGM ? (nM - fm) : WGM;
    pm = fm + ((wgid % nig) % gsz); pn = (wgid % nig) / gsz;
}
__device__ __forceinline__ unsigned cvt_pk_bf16(float lo, float hi) { unsigned r; asm volatile("v_cvt_pk_bf16_f32 %0, %1, %2" : "=v"(r) : "v"(lo), "v"(hi)); return r; }

typedef int i32x8 __attribute__((ext_vector_type(8)));
template <class Epi, class Sched, bool F8 = false>
__device__ __forceinline__ void gemm_phase(LAS unsigned char* lds, const int nt, const int pitchA, const int pitchB, const Sched& S, const Epi& E, const int wscale = 0x7F7F7F7F, const int ascale = 0x7F7F7F7F) {
    const int tid = threadIdx.x, wid = __builtin_amdgcn_readfirstlane(tid >> 6), lane = tid & 63, wr = wid >> 2, wc = wid & 3, fr = lane & 15, fq = lane >> 4;
    int RA[2], CA[2]; unsigned voffB[2];
#pragma unroll
    for (int i = 0; i < 2; ++i) { int R, C; stage_rc(tid * 16 + i * 8192, R, C); const int Rb = Epi::PERM ? ((R & ~31) + perm32(R & 31)) : R;
        RA[i] = R; CA[i] = C; voffB[i] = (unsigned)(Rb * pitchB + C * 2); }
    const size_t kstep = (size_t)(BK * 2);
    const size_t hstepB = (size_t)HALF * pitchB;
    const unsigned ldsw = (unsigned)wid * 1024u;
    const int aoff = lds_byte(wr * 64 + fr, fq * 8), boff = lds_byte(wc * 32 + fr, fq * 8);
#define PG8_SA(b, h) (((b) * 2 + (h)) * HTB)
#define PG8_SB(b, h) ((4 + (b) * 2 + (h)) * HTB)
#define PG8_STAGE(bufoff, gbase, v0, v1) do { \
        __builtin_amdgcn_global_load_lds((const unsigned*)((const char*)(gbase) + (v0)), (LAS unsigned*)(lds + (bufoff) + ldsw), 16, 0, 0); \
        __builtin_amdgcn_global_load_lds((const unsigned*)((const char*)(gbase) + (v1)), (LAS unsigned*)(lds + (bufoff) + ldsw + 8192), 16, 0, 0); } while (0)
#define PG8_LD8(off) __builtin_bit_cast(i32x8, __builtin_shufflevector(*(const LAS u32x4*)(lds + (off)), *(const LAS u32x4*)(lds + (off) + 1024), 0, 1, 2, 3, 4, 5, 6, 7))
#define PG8_LDA(dst, b, h) do { _Pragma("unroll") for (int m = 0; m < 4; ++m) { if (F8) dst##8[m] = PG8_LD8(PG8_SA(b, h) + aoff + m * 2048); else { _Pragma("unroll") for (int k = 0; k < 2; ++k) dst[m][k] = *(const LAS bf16x8*)(lds + PG8_SA(b, h) + aoff + m * 2048 + k * 1024); } } } while (0)
#define PG8_LDB(dst, b, h) do { _Pragma("unroll") for (int n = 0; n < 2; ++n) { if (F8) dst##8[n] = PG8_LD8(PG8_SB(b, h) + boff + n * 2048); else { _Pragma("unroll") for (int k = 0; k < 2; ++k) dst[n][k] = *(const LAS bf16x8*)(lds + PG8_SB(b, h) + boff + n * 2048 + k * 1024); } } } while (0)
#define PG8_CAT(x) __builtin_shufflevector(__builtin_bit_cast(u32x4, x[0]), __builtin_bit_cast(u32x4, x[1]), 0, 1, 2, 3, 4, 5, 6, 7)
#define PG8_MMA(ai, bj, At, Bt) do { __builtin_amdgcn_s_setprio(1); _Pragma("unroll") for (int m = 0; m < 4; ++m) _Pragma("unroll") for (int n = 0; n < 2; ++n) { \
        if (F8) { asm volatile("v_mfma_scale_f32_16x16x128_f8f6f4 %0, %1, %2, %0, %3, %4 op_sel_hi:[0,0,0]" : "+v"(acc[ai][bj][m][n]) : "v"(Bt##8[n]), "v"(At##8[m]), "v"(wscale), "v"(ascale)); } \
        else { _Pragma("unroll") for (int k = 0; k < 2; ++k) acc[ai][bj][m][n] = __builtin_amdgcn_mfma_f32_16x16x32_bf16(Bt[n][k], At[m][k], acc[ai][bj][m][n], 0, 0, 0); } } __builtin_amdgcn_s_setprio(0); } while (0)
#define PG8_WAIT_V(n) asm volatile("s_waitcnt vmcnt(" #n ")" ::: "memory")
#define PG8_WAIT_L(n) asm volatile("s_waitcnt lgkmcnt(" #n ")" ::: "memory")
#define PG8_BAR __builtin_amdgcn_s_barrier()
#define PG8_SCHED __builtin_amdgcn_sched_barrier(0)
#define PG8_AOFF(u, o00, o01, o10, o11) do { \
        if (Sched::GATHER) { o00 = (unsigned)(S.a_row(u, RA[0]) * pitchA + CA[0] * 2); o01 = (unsigned)(S.a_row(u, RA[1]) * pitchA + CA[1] * 2); \
                             o10 = (unsigned)(S.a_row(u, RA[0] + HALF) * pitchA + CA[0] * 2); o11 = (unsigned)(S.a_row(u, RA[1] + HALF) * pitchA + CA[1] * 2); } \
        else { o00 = (unsigned)(RA[0] * pitchA + CA[0] * 2); o01 = (unsigned)(RA[1] * pitchA + CA[1] * 2); o10 = (unsigned)((RA[0] + HALF) * pitchA + CA[0] * 2); o11 = (unsigned)((RA[1] + HALF) * pitchA + CA[1] * 2); } } while (0)
    Unit cur, nxt; int ui = 0;
    if (!S.next(0, cur)) return;
    f32x4 acc[2][2][4][2];
#pragma unroll
    for (int a = 0; a < 2; ++a)
#pragma unroll
        for (int b = 0; b < 2; ++b)
#pragma unroll
            for (int m = 0; m < 4; ++m)
#pragma unroll
                for (int n = 0; n < 2; ++n) acc[a][b][m][n] = (f32x4){0.f, 0.f, 0.f, 0.f};
    bf16x8 At[4][2], B0[2][2], B1[2][2]; i32x8 At8[4], B08[2], B18[2];
    const char* cA = S.a_base(cur); const char* cB = S.b_base(cur);
    unsigned c00, c01, c10, c11; PG8_AOFF(cur, c00, c01, c10, c11);
    const unsigned vb0 = voffB[0], vb1 = voffB[1];
    PG8_STAGE(PG8_SB(0, 0), cB, vb0, vb1); PG8_STAGE(PG8_SA(0, 0), cA, c00, c01); PG8_STAGE(PG8_SB(0, 1), cB + hstepB, vb0, vb1); PG8_STAGE(PG8_SA(0, 1), cA, c10, c11);
    if (wr == 1) PG8_BAR;
    PG8_WAIT_V(4); PG8_BAR;
    PG8_STAGE(PG8_SB(1, 0), cB + kstep, vb0, vb1); PG8_STAGE(PG8_SA(1, 0), cA + kstep, c00, c01); PG8_STAGE(PG8_SB(1, 1), cB + hstepB + kstep, vb0, vb1);
    PG8_WAIT_V(6); PG8_BAR;
    for (;;) {
        const bool has_next = S.next(ui + 1, nxt);
        const char* nA = has_next ? S.a_base(nxt) : cA; const char* nB = has_next ? S.b_base(nxt) : cB;
        unsigned n00 = c00, n01 = c01, n10 = c10, n11 = c11;
        if (has_next) PG8_AOFF(nxt, n00, n01, n10, n11);
        for (int t = 0; t < nt; t += 2) {
            const bool last = (t == nt - 2);
            const char* a1 = cA + (size_t)(t + 1) * kstep;
            const char* a2 = last ? nA : cA + (size_t)(t + 2) * kstep; const char* b2 = last ? nB : cB + (size_t)(t + 2) * kstep;
            const char* a3 = a2 + kstep; const char* b3 = b2 + kstep;
            const unsigned x00 = last ? n00 : c00, x01 = last ? n01 : c01, x10 = last ? n10 : c10, x11 = last ? n11 : c11;
            PG8_LDB(B0, 0, 0); PG8_SCHED; PG8_LDA(At, 0, 0); PG8_STAGE(PG8_SA(1, 1), a1, c10, c11);
            PG8_WAIT_L(8); PG8_BAR; PG8_WAIT_L(0); PG8_MMA(0, 0, At, B0); PG8_BAR; PG8_SCHED;
            PG8_LDB(B1, 0, 1); PG8_STAGE(PG8_SB(0, 0), b2, vb0, vb1);
            PG8_BAR; PG8_WAIT_L(0); PG8_MMA(0, 1, At, B1); PG8_BAR;
            PG8_LDA(At, 0, 1); PG8_STAGE(PG8_SA(0, 0), a2, x00, x01);
            PG8_BAR; PG8_WAIT_L(0); PG8_MMA(1, 0, At, B0); PG8_BAR; PG8_SCHED;
            PG8_STAGE(PG8_SB(0, 1), b2 + hstepB, vb0, vb1);
            PG8_WAIT_V(6); PG8_BAR; PG8_MMA(1, 1, At, B1); PG8_BAR;
            PG8_LDB(B0, 1, 0); PG8_SCHED; PG8_LDA(At, 1, 0); PG8_STAGE(PG8_SA(0, 1), a2, x10, x11);
            PG8_WAIT_L(8); PG8_BAR; PG8_WAIT_L(0); PG8_MMA(0, 0, At, B0); PG8_BAR; PG8_SCHED;
            PG8_LDB(B1, 1, 1); PG8_STAGE(PG8_SB(1, 0), b3, vb0, vb1);
            PG8_BAR; PG8_WAIT_L(0); PG8_MMA(0, 1, At, B1); PG8_BAR;
            PG8_LDA(At, 1, 1); PG8_STAGE(PG8_SA(1, 0), a3, x00, x01);
            PG8_BAR; PG8_WAIT_L(0); PG8_MMA(1, 0, At, B0); PG8_BAR; PG8_SCHED;
            PG8_STAGE(PG8_SB(1, 1), b3 + hstepB, vb0, vb1);
            PG8_WAIT_V(6); PG8_BAR; PG8_MMA(1, 1, At, B1); PG8_BAR;
        }
        if (F8) asm volatile("s_nop 15\n\ts_nop 15" ::: "memory");
        E(acc, cur, wr, wc, fr, fq);
        if (!has_next) break;
#pragma unroll
        for (int a = 0; a < 2; ++a)
#pragma unroll
            for (int b = 0; b < 2; ++b)
#pragma unroll
                for (int m = 0; m < 4; ++m)
#pragma unroll
                    for (int n = 0; n < 2; ++n) acc[a][b][m][n] = (f32x4){0.f, 0.f, 0.f, 0.f};
        cur = nxt; cA = nA; cB = nB; c00 = n00; c01 = n01; c10 = n10; c11 = n11; ++ui;
    }
    PG8_WAIT_V(0);
    if (wr == 0) PG8_BAR;
    PG8_BAR;
#undef PG8_SA
#undef PG8_SB
#undef PG8_STAGE
#undef PG8_LDA
#undef PG8_LDB
#undef PG8_MMA
#undef PG8_WAIT_V
#undef PG8_WAIT_L
#undef PG8_BAR
#undef PG8_SCHED
#undef PG8_AOFF
#undef PG8_CAT
#undef PG8_LD8
}
}
using pg8::Unit;

typedef const float* cfp_t;
typedef __attribute__((address_space(4))) const cfp_t* KargP;
__device__ __forceinline__ KargP karg_opaque(KargP p) { asm volatile("" : "+s"(p)); return p; }
struct Frame {
    LAS unsigned char* lds;
    volatile LAS unsigned* MISC;
    unsigned* ctl;
    int tid, lane, wave, G, bid;
    KargP in;
    float* out; unsigned char* ws;
};
#define WSP(T, off) ((T*)(F.ws + (off)))

__device__ __forceinline__ void transpose_item(const float* src, size_t ld, int nvalid, float scale, bf16_t* dst, int K, LAS float* scr, int lane) {
    { float tv[32]; const int j = lane & 31;
#pragma unroll
      for (int i = 0; i < 32; ++i) tv[i] = (j < nvalid) ? src[(size_t)(2 * i + (lane >> 5)) * ld + j] : 0.f;
#pragma unroll
      for (int i = 0; i < 32; ++i) scr[(2 * i + (lane >> 5)) * 33 + j] = tv[i] * scale; }
    LDS_WAIT(); asm volatile("" ::: "memory");
    const int c = lane & 7;
#pragma unroll
    for (int j = 0; j < 4; ++j) { const int n = (lane >> 3) + 8 * j; const LAS float* s = scr + (8 * c) * 33 + n;
        u32x4 o; o.x = pk2(s[0 * 33], s[1 * 33]); o.y = pk2(s[2 * 33], s[3 * 33]); o.z = pk2(s[4 * 33], s[5 * 33]); o.w = pk2(s[6 * 33], s[7 * 33]);
        *(u32x4*)(dst + (size_t)n * K + 8 * c) = o; }
    LDS_WAIT(); asm volatile("" ::: "memory");
}
struct CvItem { const float* src; unsigned char* dst; float scale; int rstep; };
__device__ __forceinline__ CvItem cv_decode(KargP in, unsigned char* ws, int it) {
    CvItem c;
    if (it < NEXP * 256) { const int e = it >> 8, q = it & 255, up = q & 1, g = (q >> 1) & 7, kb = q >> 4;
        c.src = (up ? in[I_WU] : in[I_WG]) + (size_t)e * DM * DM + (size_t)(128 * kb) * DM + 256 * g;
        c.dst = ws + WS_WGU + ((size_t)e * 4096 + 512 * g + up * 128) * DM + 128 * kb; c.scale = 32.f; c.rstep = 256; }
    else { const int r2 = it - NEXP * 256; const int e = r2 >> 7, q = r2 & 127, g = q & 7, kb = q >> 3;
        c.src = in[I_WDN] + (size_t)e * DM * DM + (size_t)(128 * kb) * DM + 256 * g;
        c.dst = ws + WS_WD + ((size_t)e * 2048 + 256 * g) * DM + 128 * kb; c.scale = 64.f; c.rstep = 128; }
    return c;
}
constexpr int CV_E8X = 9, CV_P0N = 2;
__device__ __forceinline__ int cv_map(int i) { constexpr int n1 = CV_P0N * 256; return i < n1 ? CV_E8X * 256 + i : NEXP * 256 + CV_E8X * 128 + (i - n1); }
#define CV_LOAD(v, c) do { _Pragma("unroll") for (int i_ = 0; i_ < 16; ++i_) v[i_] = __builtin_nontemporal_load((const f32x4*)((c).src + (size_t)(16 * w + i_) * DM + 4 * lane)); } while (0)
#define CV_PROC(v, c) do { \
        _Pragma("unroll") for (int j_ = 0; j_ < 4; ++j_) { u32x4 o_; const float s_ = (c).scale; \
            o_.x = pk4_fp8(v[0][j_] * s_, v[1][j_] * s_, v[2][j_] * s_, v[3][j_] * s_);     o_.y = pk4_fp8(v[4][j_] * s_, v[5][j_] * s_, v[6][j_] * s_, v[7][j_] * s_); \
            o_.z = pk4_fp8(v[8][j_] * s_, v[9][j_] * s_, v[10][j_] * s_, v[11][j_] * s_);   o_.w = pk4_fp8(v[12][j_] * s_, v[13][j_] * s_, v[14][j_] * s_, v[15][j_] * s_); \
            *(LAS u32x4*)(tile + (4 * lane + j_) * 144 + 16 * w) = o_; } \
        __syncthreads(); \
        _Pragma("unroll") for (int q_ = 0; q_ < 4; ++q_) { const int idx_ = tid + 512 * q_, row_ = idx_ >> 3, piece_ = idx_ & 7; \
            *(u32x4*)((c).dst + (size_t)((row_ >> 7) * (c).rstep + (row_ & 127)) * DM + 16 * piece_) = *(const LAS u32x4*)(tile + row_ * 144 + 16 * piece_); } \
        __syncthreads(); } while (0)
__device__ __forceinline__ void convert_moe_weights(KargP in, unsigned char* ws, LAS unsigned char* tile, int tid, int bid, int G) {
    const int w = tid >> 6, lane = tid & 63;
    constexpr int NIT = CV_P0N * (256 + 128);
    f32x4 va[16], vb[16];
    int it = bid;
    if (it >= NIT) return;
    CvItem ca = cv_decode(in, ws, cv_map(it)), cb = ca;
    CV_LOAD(va, ca);
    for (;;) {
        const bool hb = it + G < NIT;
        if (hb) { cb = cv_decode(in, ws, cv_map(it + G)); CV_LOAD(vb, cb); }
        CV_PROC(va, ca);
        if (!hb) break;
        it += G;
        const bool ha = it + G < NIT;
        if (ha) { ca = cv_decode(in, ws, cv_map(it + G)); CV_LOAD(va, ca); }
        CV_PROC(vb, cb);
        if (!ha) break;
        it += G;
    }
}
#undef CV_LOAD
#undef CV_PROC
__device__ __forceinline__ void transpose_item_f8(const float* src, size_t ld, float scale, unsigned char* dst, int K, LAS float* scr, int lane) {
    { float tv[32]; const int j = lane & 31;
#pragma unroll
      for (int i = 0; i < 32; ++i) tv[i] = src[(size_t)(2 * i + (lane >> 5)) * ld + j];
#pragma unroll
      for (int i = 0; i < 32; ++i) scr[(2 * i + (lane >> 5)) * 33 + j] = tv[i] * scale; }
    LDS_WAIT(); asm volatile("" ::: "memory");
    const int c = lane & 3;
#pragma unroll
    for (int j = 0; j < 2; ++j) { const int n = (lane >> 2) + 16 * j; const LAS float* s = scr + (16 * c) * 33 + n;
        u32x4 o; o.x = pk4_fp8(s[0 * 33], s[1 * 33], s[2 * 33], s[3 * 33]); o.y = pk4_fp8(s[4 * 33], s[5 * 33], s[6 * 33], s[7 * 33]);
        o.z = pk4_fp8(s[8 * 33], s[9 * 33], s[10 * 33], s[11 * 33]); o.w = pk4_fp8(s[12 * 33], s[13 * 33], s[14 * 33], s[15 * 33]);
        *(u32x4*)(dst + (size_t)n * K + 16 * c) = o; }
    LDS_WAIT(); asm volatile("" ::: "memory");
}
__device__ __forceinline__ void p0_phase(Frame& F) {
    const KargP in = karg_opaque(F.in);
    LAS float* scr = (LAS float*)(F.lds + F.wave * 16384);
    const int gw = F.bid * NWAVES + F.wave, NGW = F.G * NWAVES;
    constexpr int IT_WIN = 32 * (WIN_ROWS / 32);
    constexpr int IT_WQK = 4 * 64;
    constexpr int IT_WPA2 = 32 * 64;
    constexpr int IT_WPH = 16 * 64;
    constexpr int IT_WOUT = 32 * 64;
    constexpr int NITEMS = IT_WIN + IT_WQK + IT_WPA2 + IT_WPH + IT_WOUT;
    for (int it = gw; it < NITEMS; it += NGW) {
        int r = it;
        if (r < IT_WIN) { const int g = r % (WIN_ROWS / 32), kb = r / (WIN_ROWS / 32); const int n0 = 32 * g; int sc, nv = 32;
            if (n0 < 2048) sc = n0; else if (n0 < 3072) sc = 2064 + (n0 - 2048); else if (n0 < 7168) sc = 6160 + (n0 - 3072); else if (n0 < 7200) { sc = 2048; nv = 16; } else if (n0 < WIN_HY0) { sc = 0; nv = 0; } else sc = 3088 + (n0 - WIN_HY0);
            if (n0 < 2048 || (n0 >= 7168 && n0 < WIN_HY0)) transpose_item(in[I_WIN] + (size_t)(64 * kb) * N_IN + sc, N_IN, nv, 1.f, WSP(bf16_t, WS_WIN) + (size_t)n0 * DM + 64 * kb, DM, scr, F.lane);
            if (n0 >= 1024 && !(n0 >= 7168 && n0 < WIN_HY0)) transpose_item_f8(in[I_WIN] + (size_t)(64 * kb) * N_IN + sc, N_IN, 32.f, WSP(unsigned char, WS_WIN8) + (size_t)n0 * DM + 64 * kb, DM, scr, F.lane);
            continue; } r -= IT_WIN;
        if (r < IT_WQK) { const int g = r % 64, kb = r / 64; const int n0 = 32 * g, h = n0 / 512, j = (n0 % 512) / 256, e0 = n0 % 256;
            const float* src = (j ? in[I_WKH] : in[I_WQH]) + (size_t)h * 65536 + (size_t)(64 * kb) * 256 + e0;
            transpose_item(src, 256, 32, j ? 0.0625f : 1.f, WSP(bf16_t, WS_WQK) + (size_t)n0 * 256 + 64 * kb, 256, scr, F.lane); continue; } r -= IT_WQK;
        if (r < IT_WPA2) { const int g = r % 64, kb = r / 64; const int n0 = 32 * g, k0 = 64 * kb;
            transpose_item_f8(in[I_WPA] + (size_t)(k0 % 1024) * DM + n0, DM, 32.f, WSP(unsigned char, WS_WPA2) + (size_t)n0 * 2048 + k0, 2048, scr, F.lane); continue; } r -= IT_WPA2;
        if (r < IT_WPH) { const int g = r % 64, kb = r / 64; const int n0 = 32 * g, k0 = 64 * kb;
            transpose_item_f8(in[I_WPH] + (size_t)k0 * DM + n0, DM, 32.f, WSP(unsigned char, WS_WPH) + (size_t)n0 * 1024 + k0, 1024, scr, F.lane); continue; } r -= IT_WPH;
        if (r < IT_WOUT) { const int g = r % 64, kb = r / 64; const int n0 = 32 * g, k0 = 64 * kb;
            transpose_item_f8(in[I_WOUT] + (size_t)k0 * DM + n0, DM, 64.f, WSP(unsigned char, WS_WOUT) + (size_t)n0 * 2048 + k0, 2048, scr, F.lane); continue; } r -= IT_WOUT;
        (void)r;
    }
    __syncthreads();
    convert_moe_weights(in, F.ws, (LAS unsigned char*)F.lds, F.tid, F.bid, F.G);
    for (int i = F.bid * NTHR + F.tid; i < WIN_ROWS; i += F.G * NTHR) { int sc = -1;
        if (i < 2048) sc = i; else if (i < 3072) sc = 2064 + (i - 2048); else if (i < 7168) sc = 6160 + (i - 3072); else if (i < 7184) sc = 2048 + (i - 7168); else if (i < WIN_HY0) sc = -1; else sc = 3088 + (i - WIN_HY0);
        WSP(float, WS_BINP)[i] = sc >= 0 ? in[I_BIN][sc] : 0.f; }
    for (int it = F.bid + F.G * F.wave; it < 16 * 48; it += F.G * NWAVES) {
        const int ks = it / 48, cg = it % 48; const int col = cg * 256 + F.lane * 4;
        f32x4 a[9];
#pragma unroll
        for (int v = 0; v < 9; ++v) a[v] = (f32x4){0.f, 0.f, 0.f, 0.f};
#pragma unroll 1
        for (int kb = ks * 128; kb < ks * 128 + 128; kb += 16) {
            f32x4 w[16];
#pragma unroll
            for (int i = 0; i < 16; ++i) w[i] = *(const f32x4*)(in[I_WMOD] + (size_t)(kb + i) * 12288 + col);
#pragma unroll
            for (int i = 0; i < 16; ++i)
#pragma unroll
                for (int v = 0; v < 9; ++v) { const float cv = (v < 8) ? in[I_C][v * DM + kb + i] : in[I_CCTX][kb + i]; const float s = cv * sigmoidf_(cv); a[v] += w[i] * s; }
        }
#pragma unroll
        for (int v = 0; v < 9; ++v) *(f32x4*)(WSP(float, WS_MODP) + ((size_t)ks * 9 + v) * 12288 + col) = a[v];
    }
    for (int j = gw; j < SEQ; j += NGW) {
        const int l = F.lane;
        float zv = 0.f;
        if (l == 0) zv = (float)j / (float)(SEQ - 1);
        else if (l < 33) { const int bi = (l - 1) & 15; const float f = 1e-4f + (float)bi * ((15.0f - 1e-4f) / 15.0f); const float ang = 6.283185307179586f * (float)j * f / (float)SEQ; zv = (l < 17) ? cosf(ang) : -sinf(ang); }
        float pre = in[I_FB1][l];
        for (int i = 0; i < 33; ++i) pre += __shfl(zv, i) * in[I_FW1][i * 64 + l];
        float a = sinf(in[I_FFREQ][l] * pre);
        pre = in[I_FBH][l];
        for (int i = 0; i < 64; ++i) pre += __shfl(a, i) * in[I_FWH][i * 64 + l];
        float a2 = sinf(in[I_FFREQ][64 + l] * pre);
        pre = in[I_FBH][64 + l];
        for (int i = 0; i < 64; ++i) pre += __shfl(a2, i) * in[I_FWH][4096 + i * 64 + l];
        WSP(float, WS_A3)[j * 64 + l] = sinf(in[I_FFREQ][128 + l] * pre);
    }
}

__device__ __forceinline__ void p0b_phase(Frame& F) {
    const KargP in = karg_opaque(F.in);
    for (int i = F.bid * NTHR + F.tid; i < 9 * 12288; i += F.G * NTHR) { const int col = i % 12288; float s = in[I_BMOD][col];
        for (int ks = 0; ks < 16; ++ks) s += WSP(float, WS_MODP)[(size_t)ks * 9 * 12288 + i];
        WSP(float, WS_MOD)[i] = s; }
    LAS float* wl = (LAS float*)F.lds;
    for (int un = F.bid; un < 256; un += F.G) {
        const int ct = un >> 2, pg = un & 3;
        __syncthreads();
        for (int q = 0; q < 8; ++q) { const int idx = F.tid + 512 * q, i = idx >> 6, cc = idx & 63; wl[cc * 68 + i] = in[I_FWOUT][(size_t)i * 4096 + ct * 64 + cc]; }
        __syncthreads();
        const int j = pg * 512 + F.wave * 64 + F.lane;
        f32x4 ar[16];
#pragma unroll
        for (int q = 0; q < 16; ++q) ar[q] = *(const f32x4*)(WSP(float, WS_A3) + j * 64 + 4 * q);
        const float tj = (float)j / (float)(SEQ - 1);
        const float mind = -3.0701134573253944f, maxd = -15.350567286626972f;
        const int cbase = (ct * 64) & 1023;
#pragma unroll 1
        for (int cc = 0; cc < 64; ++cc) {
            f32x4 s = (f32x4){0.f, 0.f, 0.f, 0.f};
#pragma unroll
            for (int q = 0; q < 16; ++q) s += ar[q] * *(const LAS f32x4*)(wl + cc * 68 + 4 * q);
            const float delta = fabsf(mind + (float)(cbase + cc) * ((maxd - mind) / 1023.0f));
            const float v = ((s.x + s.y) + (s.z + s.w)) * __expf(-tj * delta);
            WSP(float, WS_HTAPS)[(size_t)(ct * 64 + cc) * SEQ + j] = v;
        }
    }
}

__device__ __forceinline__ f32x2 cmul(f32x2 a, f32x2 b) { return (f32x2){a.x * b.x - a.y * b.y, a.x * b.y + a.y * b.x}; }
__device__ __forceinline__ f32x2 cmulc(f32x2 a, f32x2 b) { return (f32x2){a.x * b.x + a.y * b.y, a.y * b.x - a.x * b.y}; }
template <bool INV> __device__ __forceinline__ void dft4(f32x2& a, f32x2& b, f32x2& c, f32x2& d) {
    const f32x2 s0 = a + c, s1 = a - c, s2 = b + d, s3 = b - d;
    const f32x2 is3 = (f32x2){-s3.y, s3.x};
    a = s0 + s2; c = s0 - s2;
    if (!INV) { b = s1 - is3; d = s1 + is3; } else { b = s1 + is3; d = s1 - is3; }
}
template <bool INV> __device__ __forceinline__ void dft16(f32x2 (&v)[16]) {
#pragma unroll
    for (int n0 = 0; n0 < 4; ++n0) dft4<INV>(v[n0], v[4 + n0], v[8 + n0], v[12 + n0]);
    const float c1 = 0.9238795325112867f, s1 = 0.3826834323650898f, r2 = 0.7071067811865476f;
    const float cs[10] = {1.f, c1, r2, s1, 0.f, -s1, -r2, -c1, -1.f, -c1};
    const float sn[10] = {0.f, s1, r2, c1, 1.f, c1, r2, s1, 0.f, -s1};
#pragma unroll
    for (int k0 = 1; k0 < 4; ++k0)
#pragma unroll
        for (int n0 = 1; n0 < 4; ++n0) { const int m = n0 * k0; const f32x2 w = (f32x2){cs[m], INV ? sn[m] : -sn[m]}; v[4 * k0 + n0] = cmul(v[4 * k0 + n0], w); }
#pragma unroll
    for (int k0 = 0; k0 < 4; ++k0) dft4<INV>(v[4 * k0], v[4 * k0 + 1], v[4 * k0 + 2], v[4 * k0 + 3]);
#pragma unroll
    for (int a = 0; a < 4; ++a)
#pragma unroll
        for (int b = a + 1; b < 4; ++b) { const f32x2 t = v[4 * a + b]; v[4 * a + b] = v[4 * b + a]; v[4 * b + a] = t; }
}
__device__ __forceinline__ int fphys(int i) { return i + (i >> 4); }
constexpr int FFT_BUF_BYTES = (4096 + 256) * 8;
struct FftTw { f32x2 wA, wB; };
__device__ __forceinline__ FftTw fft_tw(int ht) { FftTw t; float s, c; sincospif(-(float)ht / 2048.0f, &s, &c); t.wA = (f32x2){c, s}; sincospif(-(float)(ht & 15) / 128.0f, &s, &c); t.wB = (f32x2){c, s}; return t; }
template <bool CONJ> __device__ __forceinline__ void tw_apply(f32x2 (&v)[16], f32x2 w1) {
    if (CONJ) w1.y = -w1.y;
    const f32x2 w2 = cmul(w1, w1), w3 = cmul(w2, w1), w4 = cmul(w2, w2), w5 = cmul(w4, w1), w6 = cmul(w4, w2), w7 = cmul(w4, w3), w8 = cmul(w4, w4);
    v[1] = cmul(v[1], w1); v[2] = cmul(v[2], w2); v[3] = cmul(v[3], w3); v[4] = cmul(v[4], w4); v[5] = cmul(v[5], w5); v[6] = cmul(v[6], w6); v[7] = cmul(v[7], w7); v[8] = cmul(v[8], w8);
    v[9] = cmul(v[9], cmul(w8, w1)); v[10] = cmul(v[10], cmul(w8, w2)); v[11] = cmul(v[11], cmul(w8, w3)); v[12] = cmul(v[12], cmul(w8, w4));
    v[13] = cmul(v[13], cmul(w8, w5)); v[14] = cmul(v[14], cmul(w8, w6)); v[15] = cmul(v[15], cmul(w8, w7));
}
struct NoHook { __device__ __forceinline__ void act() {} };
struct NoPf { __device__ __forceinline__ void operator()() const {} };
template <bool A0, bool A1, class HK, class PF> __device__ __forceinline__ void fft_fwd(f32x2 (&v)[16], LAS f32x2* buf, int ht, const FftTw& tw_, HK& hk, const PF& pf) {
    FftTw tw = tw_; asm volatile("" : "+v"(ht), "+v"(tw.wA.x), "+v"(tw.wA.y), "+v"(tw.wB.x), "+v"(tw.wB.y));
    dft16<false>(v);
    tw_apply<false>(v, tw.wA);
#pragma unroll
    for (int k = 0; k < 16; ++k) buf[fphys(256 * k + ht)] = v[k];
    __syncthreads(); if (A0) hk.act();
    const int ka = ht >> 4, s = ht & 15;
#pragma unroll
    for (int b = 0; b < 16; ++b) v[b] = buf[fphys(256 * ka + 16 * b + s)];
    dft16<false>(v);
    tw_apply<false>(v, tw.wB);
#pragma unroll
    for (int k = 0; k < 16; ++k) buf[fphys(256 * ka + 16 * k + s)] = v[k];
    pf();
    __syncthreads(); if (A1) hk.act();
#pragma unroll
    for (int q = 0; q < 16; ++q) v[q] = buf[fphys(16 * ht + q)];
    dft16<false>(v);
}
template <bool A0, bool A1, bool A2, class HK> __device__ __forceinline__ void fft_inv(f32x2 (&v)[16], LAS f32x2* buf, int ht, const FftTw& tw_, HK& hk) {
    FftTw tw = tw_; asm volatile("" : "+v"(ht), "+v"(tw.wA.x), "+v"(tw.wA.y), "+v"(tw.wB.x), "+v"(tw.wB.y));
    dft16<true>(v);
#pragma unroll
    for (int q = 0; q < 16; ++q) buf[fphys(16 * ht + q)] = v[q];
    __syncthreads(); if (A0) hk.act();
    const int ka = ht >> 4, s = ht & 15;
#pragma unroll
    for (int k = 0; k < 16; ++k) v[k] = buf[fphys(256 * ka + 16 * k + s)];
    tw_apply<true>(v, tw.wB);
    dft16<true>(v);
#pragma unroll
    for (int b = 0; b < 16; ++b) buf[fphys(256 * ka + 16 * b + s)] = v[b];
    __syncthreads(); if (A1) hk.act();
#pragma unroll
    for (int k = 0; k < 16; ++k) v[k] = buf[fphys(256 * k + ht)];
    tw_apply<true>(v, tw.wA);
    dft16<true>(v);
    __syncthreads(); if (A2) hk.act();
}

__device__ __forceinline__ void p1_phase(Frame& F) {
    const KargP in = karg_opaque(F.in);
    const int gw = F.bid * NWAVES + F.wave, NGW = F.G * NWAVES;
    const float* mod = WSP(float, WS_MOD);
    {
        f32x4 pg[8], pb[8];
#pragma unroll
        for (int j = 0; j < 8; ++j) { pg[j] = *(const f32x4*)(in[I_LNG] + F.lane * 4 + 256 * j); pb[j] = *(const f32x4*)(in[I_LNB] + F.lane * 4 + 256 * j); }
#pragma unroll 1
        for (int grp = gw; grp < MALL / 8; grp += NGW) {
            const int row0 = grp * 8; const bool lat = row0 < MTOK;
            const float* xb = lat ? in[I_X] + (size_t)row0 * DM : in[I_CTX] + (size_t)(row0 - MTOK) * DM;
            const float* mv = mod + (size_t)(lat ? row0 / SEQ : 8) * 12288;
            f32x4 psh[8], psc[8];
#pragma unroll
            for (int j = 0; j < 8; ++j) { psh[j] = *(const f32x4*)(mv + F.lane * 4 + 256 * j); psc[j] = *(const f32x4*)(mv + 2048 + F.lane * 4 + 256 * j) + 1.0f; }
            f32x4 v[8], vn[8];
#pragma unroll
            for (int j = 0; j < 8; ++j) v[j] = *(const f32x4*)(xb + F.lane * 4 + 256 * j);
#pragma unroll 1
            for (int ri = 0; ri < 8; ++ri) {
                const float* xn = xb + (size_t)(ri < 7 ? ri + 1 : ri) * DM;
#pragma unroll
                for (int j = 0; j < 8; ++j) vn[j] = *(const f32x4*)(xn + F.lane * 4 + 256 * j);
                float s = 0.f;
#pragma unroll
                for (int j = 0; j < 8; ++j) s += (v[j].x + v[j].y) + (v[j].z + v[j].w);
                const float mean = wave_sum(s) * (1.f / DM); float s2 = 0.f;
#pragma unroll
                for (int j = 0; j < 8; ++j) { v[j] = v[j] - mean; s2 += (v[j].x * v[j].x + v[j].y * v[j].y) + (v[j].z * v[j].z + v[j].w * v[j].w); }
                const float rstd = 1.f / sqrtf(wave_sum(s2) * (1.f / DM) + LN_EPS);
                const int row = row0 + ri;
                if (lat && F.lane == 0) { WSP(float, WS_STATS)[row * 2] = mean; WSP(float, WS_STATS)[row * 2 + 1] = rstd; }
                bf16_t* orow = WSP(bf16_t, WS_HX) + (size_t)row * DM;
#pragma unroll
                for (int j = 0; j < 8; ++j) { const f32x4 y = (v[j] * rstd * pg[j] + pb[j]) * psc[j] + psh[j];
                    u32x2 o; o.x = pk2(y.x, y.y); o.y = pk2(y.z, y.w); *(u32x2*)(orow + F.lane * 4 + 256 * j) = o;
                    if (lat) *(unsigned*)(WSP(unsigned char, WS_HX8) + (size_t)row * DM + F.lane * 4 + 256 * j) = pk4_fp8(y.x, y.y, y.z, y.w); }
#pragma unroll
                for (int j = 0; j < 8; ++j) v[j] = vn[j];
            }
        }
    }
    const int hb = F.tid >> 8, ht = F.tid & 255;
    LAS f32x2* buf = (LAS f32x2*)(F.lds + hb * FFT_BUF_BYTES);
    const FftTw tw = fft_tw(ht);
    const float* htaps = WSP(float, WS_HTAPS);
    for (int u0 = F.bid * 2; u0 < 2048; u0 += F.G * 2) {
        const int un = u0 + hb, c = un >> 1, n = un & 1;
        const float* hf = htaps + (size_t)((n * 2 + 0) * 1024 + c) * SEQ, * hbk = htaps + (size_t)((n * 2 + 1) * 1024 + c) * SEQ;
        f32x2 v[16];
#pragma unroll
        for (int a = 0; a < 16; ++a) { const int i = 256 * a + ht; float x;
            if (a < 8) x = hf[i]; else if (i == 2048) x = 0.f; else x = hbk[4096 - i];
            v[a] = (f32x2){x * (1.0f / 4096.0f), 0.f}; }
        { NoHook nh; fft_fwd<false, false>(v, buf, ht, tw, nh, NoPf{}); }
        f32x2* Hd = WSP(f32x2, WS_H) + (size_t)un * 4096;
#pragma unroll
        for (int ks = 0; ks < 16; ++ks) Hd[ks * 256 + ht] = v[ks];
        __syncthreads();
    }
}

template <bool F8> struct SchedZ {
    static constexpr bool GATHER = false;
    int G, c; const char* hx; const char* win;
    static constexpr size_t P = F8 ? DM : 2 * DM;
    __device__ __forceinline__ bool next(int i, Unit& u) const {
        int L = i * G + c;
        if (!F8) {
            if (L < 320) { int pn; pg8::decode_tile(L, 64, 5, u.pm, pn); u.pn = pn < 4 ? pn : 28; u.ex = 0; return true; } L -= 320;
            if (L < 72) { int pm, pn; pg8::decode_tile(L, 8, 9, pm, pn); u.pm = 64 + pm; u.pn = pn < 8 ? pn : 28; u.ex = 0; return true; }
            return false;
        } else {
            if (L < 1536) { int pn; pg8::decode_tile(L, 64, 24, u.pm, pn); u.pn = 4 + pn; u.ex = 0; return true; } L -= 1536;
            if (L < 768) { pg8::decode_tile(L, 12, 64, u.pm, u.pn); u.ex = 1; return true; }
            return false;
        }
    }
    __device__ __forceinline__ const char* a_base(const Unit& u) const { return u.ex ? win + (size_t)(WIN_HY0 + 256 * u.pm) * P : hx + (size_t)(256 * u.pm) * P; }
    __device__ __forceinline__ const char* b_base(const Unit& u) const { return u.ex ? hx + (size_t)(256 * u.pn) * P : win + (size_t)(256 * u.pn) * P; }
    __device__ __forceinline__ int a_row(const Unit&, int R) const { return R; }
};
struct EpiZ {
    static constexpr bool PERM = true;
    bf16_t* Z; bf16_t* ZT; const float* bias;
    __device__ __forceinline__ void operator()(const f32x4 (&acc)[2][2][4][2], const Unit& u, int wr, int wc, int fr, int fq) const {
        if (u.ex == 0) {
            const int row0 = u.pm * 256 + wr * 64 + fr, col0 = u.pn * 256 + wc * 32 + 8 * fq;
            f32x4 bv[2][2];
#pragma unroll
            for (int bj = 0; bj < 2; ++bj)
#pragma unroll
                for (int n = 0; n < 2; ++n) bv[bj][n] = *(const f32x4*)(bias + col0 + bj * 128 + 4 * n);
#pragma unroll
            for (int ai = 0; ai < 2; ++ai)
#pragma unroll
                for (int m = 0; m < 4; ++m) { bf16_t* rowp = Z + (size_t)(row0 + ai * 128 + m * 16) * ZN + col0;
#pragma unroll
                    for (int bj = 0; bj < 2; ++bj) { const f32x4 v0 = acc[ai][bj][m][0] + bv[bj][0], v1 = acc[ai][bj][m][1] + bv[bj][1];
                        u32x4 w; w.x = pg8::cvt_pk_bf16(v0[0], v0[1]); w.y = pg8::cvt_pk_bf16(v0[2], v0[3]); w.z = pg8::cvt_pk_bf16(v1[0], v1[1]); w.w = pg8::cvt_pk_bf16(v1[2], v1[3]);
                        *(u32x4*)(rowp + bj * 128) = w; } }
        } else {
            const int ch0 = u.pm * 256 + wr * 64 + fr, b = u.pn >> 3, t0 = (u.pn & 7) * 256 + wc * 32 + 8 * fq;
            float bbv[8];
#pragma unroll
            for (int r = 0; r < 8; ++r) bbv[r] = bias[WIN_HY0 + ch0 + (r >> 2) * 128 + (r & 3) * 16];
#pragma unroll
            for (int ai = 0; ai < 2; ++ai)
#pragma unroll
                for (int m = 0; m < 4; ++m) { const int ch = ch0 + ai * 128 + m * 16; const float bb = bbv[ai * 4 + m];
                    bf16_t* rowp = ZT + ((size_t)b * 3072 + ch) * SEQ + t0;
#pragma unroll
                    for (int bj = 0; bj < 2; ++bj) { const f32x4 v0 = acc[ai][bj][m][0] + bb, v1 = acc[ai][bj][m][1] + bb;
                        u32x4 w; w.x = pg8::cvt_pk_bf16(v0[0], v0[1]); w.y = pg8::cvt_pk_bf16(v0[2], v0[3]); w.z = pg8::cvt_pk_bf16(v1[0], v1[1]); w.w = pg8::cvt_pk_bf16(v1[2], v1[3]);
                        *(u32x4*)(rowp + bj * 128) = w; } }
        }
    }
};

__device__ __forceinline__ void p3_phase(Frame& F) {
    const KargP in = karg_opaque(F.in);
    const bf16_t* Z = WSP(bf16_t, WS_Z); bf16_t* U = WSP(bf16_t, WS_U);
    const float* cw = in[I_MCW]; const float* cb = in[I_MCB];
    const int c0 = (F.tid & 127) * 8;
    f32x4 w0[9], w1[9];
#pragma unroll
    for (int q = 0; q < 9; ++q) { w0[q] = *(const f32x4*)(cw + q * MW + c0); w1[q] = *(const f32x4*)(cw + q * MW + c0 + 4); }
    const f32x4 b0 = *(const f32x4*)(cb + c0), b1 = *(const f32x4*)(cb + c0 + 4);
#pragma unroll 1
    for (int it = F.bid * NTHR + F.tid; it < MALL * 128; it += F.G * NTHR) {
        const int row = it >> 7;
        const bool lat = row < MTOK;
        int base, y, x, H, Wd;
        if (lat) { const int t = row & (SEQ - 1); base = row - t; y = t >> 6; x = t & 63; H = 32; Wd = 64; }
        else { const int t = (row - MTOK) & (CTX - 1); base = row - t; y = 0; x = t; H = 1; Wd = CTX; }
        u32x4 zz[9]; bool ok[9];
#pragma unroll
        for (int q = 0; q < 9; ++q) { const int yy = y + q / 3 - 1, xx = x + q % 3 - 1; ok[q] = yy >= 0 && yy < H && xx >= 0 && xx < Wd;
            const int srow = ok[q] ? base + yy * Wd + xx : row;
            zz[q] = *(const u32x4*)(Z + (size_t)srow * ZN + ZC_QK + c0); }
        f32x4 a0 = b0, a1 = b1;
#pragma unroll
        for (int q = 0; q < 9; ++q) { const float m = ok[q] ? 1.f : 0.f;
            a0 += (f32x4){bflo(zz[q].x), bfhi(zz[q].x), bflo(zz[q].y), bfhi(zz[q].y)} * w0[q] * m;
            a1 += (f32x4){bflo(zz[q].z), bfhi(zz[q].z), bflo(zz[q].w), bfhi(zz[q].w)} * w1[q] * m; }
        float a[8] = {a0.x, a0.y, a0.z, a0.w, a1.x, a1.y, a1.z, a1.w};
#pragma unroll
        for (int j = 0; j < 8; ++j) a[j] = a[j] * sigmoid_fast(a[j]);
        u32x4 o; o.x = pk2(a[0], a[1]); o.y = pk2(a[2], a[3]); o.z = pk2(a[4], a[5]); o.w = pk2(a[6], a[7]);
        *(u32x4*)(U + (size_t)row * MW + c0) = o;
    }
}

struct SchedQK {
    static constexpr bool GATHER = false;
    int G, c; const char* u; const char* w;
    __device__ __forceinline__ bool next(int i, Unit& un) const { const int L = i * G + c; if (L >= 72 * 8) return false; pg8::decode_tile(L, 72, 8, un.pm, un.pn); un.ex = 0; return true; }
    __device__ __forceinline__ const char* a_base(const Unit& un) const { return u + ((size_t)(256 * un.pm) * MW + (un.pn >> 1) * 256) * 2; }
    __device__ __forceinline__ const char* b_base(const Unit& un) const { return w + (size_t)(256 * un.pn) * 256 * 2; }
    __device__ __forceinline__ int a_row(const Unit&, int R) const { return R; }
};
struct EpiQK {
    static constexpr bool PERM = true;
    bf16_t* O;
    __device__ __forceinline__ void operator()(const f32x4 (&acc)[2][2][4][2], const Unit& u, int wr, int wc, int fr, int fq) const {
        const int row0 = u.pm * 256 + wr * 64 + fr, col0 = u.pn * 256 + wc * 32 + 8 * fq;
#pragma unroll
        for (int ai = 0; ai < 2; ++ai)
#pragma unroll
            for (int m = 0; m < 4; ++m) { bf16_t* rowp = O + (size_t)(row0 + ai * 128 + m * 16) * 2048 + col0;
#pragma unroll
                for (int bj = 0; bj < 2; ++bj) { const f32x4 v0 = acc[ai][bj][m][0], v1 = acc[ai][bj][m][1];
                    u32x4 w; w.x = pg8::cvt_pk_bf16(v0[0], v0[1]); w.y = pg8::cvt_pk_bf16(v0[2], v0[3]); w.z = pg8::cvt_pk_bf16(v1[0], v1[1]); w.w = pg8::cvt_pk_bf16(v1[2], v1[3]);
                    *(u32x4*)(rowp + bj * 128) = w; } }
    }
};

constexpr int ML_QS = 264, ML_VS = 72, ML_PS = 72;
constexpr int ML_Q = 0, ML_K = ML_Q + 64 * ML_QS * 2, ML_V = ML_K + 64 * ML_QS * 2, ML_C = ML_V + 64 * ML_VS * 2, ML_P = ML_C + 80 * ML_QS * 2, ML_VT = ML_P + 64 * ML_PS * 2, ML_SC = ML_VT + 80 * ML_VS * 2;
constexpr int ML_SA = ML_SC, ML_SDEN = ML_SC + 4096, ML_END = ML_SC + 4096 + 256;
static_assert(ML_END <= MISC_OFF, "mlstm LDS");
__device__ __forceinline__ bf16x8 lds_frag(const LAS bf16_t* p) { return *(const LAS bf16x8*)p; }
__device__ __forceinline__ void mlstm_unit(Frame& F, int un) {
    const int vs = un & 3, dir = (un >> 2) & 1, h = (un >> 3) & 3, b = un >> 5;
    const bf16_t* Z = WSP(bf16_t, WS_Z); const bf16_t* QK = WSP(bf16_t, WS_QKB); unsigned char* AM = WSP(unsigned char, WS_AM);
    LAS unsigned char* lds = F.lds;
    LAS bf16_t* Qs = (LAS bf16_t*)(lds + ML_Q); LAS bf16_t* Ks = (LAS bf16_t*)(lds + ML_K); LAS bf16_t* Vs = (LAS bf16_t*)(lds + ML_V);
    LAS bf16_t* Cs = (LAS bf16_t*)(lds + ML_C); LAS bf16_t* Ps = (LAS bf16_t*)(lds + ML_P); LAS bf16_t* VT = (LAS bf16_t*)(lds + ML_VT);
    LAS float* sDEN = (LAS float*)(lds + ML_SDEN);
    LAS float* sc0 = (LAS float*)(lds + ML_SA);
    const int tid = F.tid, lane = F.lane, w = F.wave, l15 = lane & 15, g4 = lane >> 4;
    __syncthreads();
    for (int i = tid; i < 80 * ML_QS / 2; i += NTHR) ((LAS unsigned*)Cs)[i] = 0u;
    if (tid < 64) { Vs[tid * ML_VS + 64] = (bf16_t)0x3F80; for (int j = 65; j < ML_VS; ++j) Vs[tid * ML_VS + j] = 0; }
    for (int i = tid; i < 16 * ML_VS; i += NTHR) VT[64 * ML_VS + i] = (i < 64) ? (bf16_t)0x3F80 : (bf16_t)0;
    f32x4 cacc[2][5];
#pragma unroll
    for (int a = 0; a < 2; ++a)
#pragma unroll
        for (int c = 0; c < 5; ++c) cacc[a][c] = (f32x4){0.f, 0.f, 0.f, 0.f};
    float m_run = 0.f;
    u32x4 pq[4], pk[4], pv; unsigned pgate = 0u, pgate2 = 0u;
#define ML_ROW0(st) ((st) < 4 ? (MTOK + b * CTX + 64 * (dir ? 3 - (st) : (st))) : (b * SEQ + 64 * (dir ? 35 - (st) : (st) - 4)))
#define ML_LOAD(st) do { const int r0_ = ML_ROW0(st); \
        _Pragma("unroll") for (int q_ = 0; q_ < 4; ++q_) { const int p_ = tid + 512 * q_, rr_ = p_ >> 5, cc_ = (p_ & 31) * 8; \
            pq[q_] = *(const u32x4*)(QK + (size_t)(r0_ + rr_) * 2048 + h * 512 + cc_); pk[q_] = *(const u32x4*)(QK + (size_t)(r0_ + rr_) * 2048 + h * 512 + 256 + cc_); } \
        { const int rr_ = tid >> 3, cc_ = (tid & 7) * 8; pv = *(const u32x4*)(Z + (size_t)(r0_ + rr_) * ZN + ZC_V + h * 256 + vs * 64 + cc_); } \
        if (tid < 64) { const bf16_t* gp_ = Z + (size_t)(r0_ + tid) * ZN + ZC_GT + dir * 8 + h; pgate = gp_[0]; pgate2 = gp_[4]; } } while (0)
#define ML_STORE() do { \
        _Pragma("unroll") for (int q_ = 0; q_ < 4; ++q_) { const int p_ = tid + 512 * q_, rr_ = p_ >> 5, cc_ = (p_ & 31) * 8; \
            *(LAS u32x4*)(Qs + rr_ * ML_QS + cc_) = pq[q_]; *(LAS u32x4*)(Ks + rr_ * ML_QS + cc_) = pk[q_]; } \
        { const int rr_ = tid >> 3, cc_ = (tid & 7) * 8; *(LAS u32x4*)(Vs + rr_ * ML_VS + cc_) = pv; \
          VT[(cc_ + 0) * ML_VS + rr_] = (bf16_t)(pv.x & 0xffffu); VT[(cc_ + 1) * ML_VS + rr_] = (bf16_t)(pv.x >> 16); VT[(cc_ + 2) * ML_VS + rr_] = (bf16_t)(pv.y & 0xffffu); VT[(cc_ + 3) * ML_VS + rr_] = (bf16_t)(pv.y >> 16); \
          VT[(cc_ + 4) * ML_VS + rr_] = (bf16_t)(pv.z & 0xffffu); VT[(cc_ + 5) * ML_VS + rr_] = (bf16_t)(pv.z >> 16); VT[(cc_ + 6) * ML_VS + rr_] = (bf16_t)(pv.w & 0xffffu); VT[(cc_ + 7) * ML_VS + rr_] = (bf16_t)(pv.w >> 16); } } while (0)
#define ML_SCALARS(stp) do { LAS float* sb_ = sc0 + ((stp) & 1) * 512; \
              \
            float li = bf2f(pgate), zf = bf2f(pgate2); \
            if (dir) { li = __shfl(li, 63 - lane); zf = __shfl(zf, 63 - lane); } \
            const float lf = fminf(zf, 0.f) - log1pf(__expf(-fabsf(zf))); \
            const float bcs = wave_scan_sum(lf); \
            const float a = li - bcs; \
            const float am = wave_scan_max(a); \
            const float inter = bcs + m_run; \
            const float mt = fmaxf(inter, bcs + am); \
            const float b_end = lane_bcast(bcs, 63); \
            const float gg = b_end - bcs + li; \
            const float gm = lane_bcast(wave_scan_max(gg), 63); \
            const float m_new = fmaxf(b_end + m_run, gm); \
            const int pos_ = dir ? 63 - lane : lane; \
            sb_[pos_] = a; sb_[64 + pos_] = bcs - mt; sb_[128 + pos_] = __expf(inter - mt); sb_[192 + pos_] = __expf(gg - m_new); sb_[256 + pos_] = __expf(-mt); \
            if (lane == 0) sb_[320] = __expf(b_end + m_run - m_new); \
            m_run = m_new; } while (0)
    ML_LOAD(0);
    __syncthreads();
    if (w == 0) ML_SCALARS(0);
    const int tt = w & 3; const int nv = (w < 4) ? 3 : 2;
#pragma unroll 1
    for (int st = 0; st < 36; ++st) {
        ML_STORE();
        LAS float* sA = sc0 + (st & 1) * 512; LAS float* sU = sA + 64; LAS float* sSI = sA + 128; LAS float* sWG = sA + 192; LAS float* sEM = sA + 256; LAS float* sMI = sA + 320;
        const int row0 = ML_ROW0(st);
        if (st + 1 < 36) ML_LOAD(st + 1);
        __syncthreads();
        {
            f32x4 sacc[2] = {(f32x4){0.f, 0.f, 0.f, 0.f}, (f32x4){0.f, 0.f, 0.f, 0.f}};
#pragma unroll
            for (int ks = 0; ks < 8; ++ks) {
                const bf16x8 qf = lds_frag(Qs + (16 * tt + l15) * ML_QS + 32 * ks + 8 * g4);
#pragma unroll
                for (int j = 0; j < 2; ++j) { const int stl = 2 * (w >> 2) + j;
                    const bf16x8 kf = lds_frag(Ks + (16 * stl + l15) * ML_QS + 32 * ks + 8 * g4);
                    sacc[j] = __builtin_amdgcn_mfma_f32_16x16x32_bf16(kf, qf, sacc[j], 0, 0, 0); }
            }
            const int t = 16 * tt + l15; const float ut = sU[t];
#pragma unroll
            for (int j = 0; j < 2; ++j) { const int s0 = 16 * (2 * (w >> 2) + j) + 4 * g4;
                const f32x4 av = *(const LAS f32x4*)(sA + s0);
                float pvv[4];
#pragma unroll
                for (int r = 0; r < 4; ++r) { const int s = s0 + r; const bool ok = dir ? (s >= t) : (s <= t); pvv[r] = ok ? sacc[j][r] * __expf(ut + av[r]) : 0.f; }
                u32x2 o; o.x = pk2(pvv[0], pvv[1]); o.y = pk2(pvv[2], pvv[3]);
                *(LAS u32x2*)(Ps + t * ML_PS + s0) = o; }
        }
        __syncthreads();
        unsigned og[2][4];
        if (st >= 4) {
#pragma unroll
            for (int j = 0; j < 2; ++j) { const int vt_ = (w < 4) ? j : 2 + j;
#pragma unroll
                for (int r = 0; r < 4; ++r) og[j][r] = Z[(size_t)(row0 + 16 * tt + 4 * g4 + r) * ZN + ZC_O + h * 256 + vs * 64 + 16 * vt_ + l15]; } }
        f32x4 nacc[3], iacc[3];
#pragma unroll
        for (int j = 0; j < 3; ++j) { nacc[j] = (f32x4){0.f, 0.f, 0.f, 0.f}; iacc[j] = (f32x4){0.f, 0.f, 0.f, 0.f}; }
#pragma unroll
        for (int ks = 0; ks < 8; ++ks) {
            const bf16x8 qf = lds_frag(Qs + (16 * tt + l15) * ML_QS + 32 * ks + 8 * g4);
#pragma unroll
            for (int j = 0; j < 3; ++j) if (j < nv) { const int vt = (w < 4) ? (j == 2 ? 4 : j) : 2 + j;
                const bf16x8 cf = lds_frag(Cs + (16 * vt + l15) * ML_QS + 32 * ks + 8 * g4);
                iacc[j] = __builtin_amdgcn_mfma_f32_16x16x32_bf16(qf, cf, iacc[j], 0, 0, 0); }
        }
#pragma unroll
        for (int ks = 0; ks < 2; ++ks) {
            const bf16x8 pf = lds_frag(Ps + (16 * tt + l15) * ML_PS + 32 * ks + 8 * g4);
#pragma unroll
            for (int j = 0; j < 3; ++j) if (j < nv) { const int vt = (w < 4) ? (j == 2 ? 4 : j) : 2 + j;
                const bf16x8 vf = lds_frag(VT + (16 * vt + l15) * ML_VS + 32 * ks + 8 * g4);
                nacc[j] = __builtin_amdgcn_mfma_f32_16x16x32_bf16(pf, vf, nacc[j], 0, 0, 0); }
        }
        const int t0 = 16 * tt + 4 * g4;
        {
            const f32x4 si = *(const LAS f32x4*)(sSI + t0);
#pragma unroll
            for (int j = 0; j < 3; ++j) if (j < nv) nacc[j] = nacc[j] + iacc[j] * si;
            if (w < 4 && l15 == 0) *(LAS f32x4*)(sDEN + t0) = nacc[2];
        }
        {
            const float decay = sMI[0];
#pragma unroll
            for (int a = 0; a < 2; ++a)
#pragma unroll
                for (int c = 0; c < 5; ++c) cacc[a][c] = cacc[a][c] * decay;
#pragma unroll
            for (int ks = 0; ks < 2; ++ks) {
                float wg[8];
#pragma unroll
                for (int e = 0; e < 8; ++e) wg[e] = sWG[32 * ks + 8 * g4 + e];
                bf16x8 kf[2];
#pragma unroll
                for (int a = 0; a < 2; ++a) { float x[8];
#pragma unroll
                    for (int e = 0; e < 8; ++e) x[e] = bf2f((unsigned)Ks[(32 * ks + 8 * g4 + e) * ML_QS + 16 * (2 * w + a) + l15]) * wg[e];
                    u32x4 o; o.x = pk2(x[0], x[1]); o.y = pk2(x[2], x[3]); o.z = pk2(x[4], x[5]); o.w = pk2(x[6], x[7]);
                    kf[a] = __builtin_bit_cast(bf16x8, o); }
#pragma unroll
                for (int c = 0; c < 5; ++c) {
                    const bf16x8 vf = lds_frag(VT + (16 * c + l15) * ML_VS + 32 * ks + 8 * g4);
#pragma unroll
                    for (int a = 0; a < 2; ++a) cacc[a][c] = __builtin_amdgcn_mfma_f32_16x16x32_bf16(kf[a], vf, cacc[a][c], 0, 0, 0);
                }
            }
        }
        __syncthreads();
        if (w == 0 && st + 1 < 36) ML_SCALARS(st + 1);
        if (st >= 4) {
            const f32x4 dn = *(const LAS f32x4*)(sDEN + t0), em = *(const LAS f32x4*)(sEM + t0);
#pragma unroll
            for (int j = 0; j < 2; ++j) { const int vt = (w < 4) ? j : 2 + j; const int col = h * 256 + vs * 64 + 16 * vt + l15;
#pragma unroll
                for (int r = 0; r < 4; ++r) { const int row = row0 + t0 + r;
                    const float hv = nacc[j][r] * __builtin_amdgcn_rcpf(fmaxf(fabsf(dn[r]), em[r]));
                    const float o = __builtin_amdgcn_rcpf(1.0f + __expf(-bf2f(og[j][r])));
                    AM[(size_t)row * 2048 + dir * 1024 + col] = (unsigned char)(pk4_fp8(fminf(fmaxf(o * hv, -448.f), 448.f), 0.f, 0.f, 0.f) & 0xffu); } }
        }
#pragma unroll
        for (int a = 0; a < 2; ++a)
#pragma unroll
            for (int c = 0; c < 5; ++c) { u32x2 o; o.x = pk2(cacc[a][c][0], cacc[a][c][1]); o.y = pk2(cacc[a][c][2], cacc[a][c][3]);
                *(LAS u32x2*)(Cs + (16 * c + l15) * ML_QS + 16 * (2 * w + a) + 4 * g4) = o; }
    }
    __syncthreads();
#undef ML_LOAD
#undef ML_STORE
#undef ML_ROW0
#undef ML_SCALARS
}

constexpr int CVH_E0 = 11;
constexpr int CVH_NITEMS = (NEXP - CVH_E0) * 768;
constexpr int CVH_KG_BYTES = 1040, CVH_TILE_BYTES = 16 * CVH_KG_BYTES;
struct CvHook {
    KargP in; unsigned char* ws; LAS unsigned char* tiles; int tid, bid, G, kmax; int s;
    f32x4 v[8];
    __device__ __forceinline__ void decode(int h, const float*& src, unsigned char*& dst, int& rstep) const {
        const int e = CVH_E0 + h / 768, q = h % 768;
        if (q < 512) { const int up = q & 1, g = (q >> 1) & 7, kb = q >> 4;
            src = (up ? in[I_WU] : in[I_WG]) + (size_t)e * DM * DM + (size_t)(64 * kb) * DM + 256 * g;
            dst = ws + WS_WGU + ((size_t)e * 4096 + 512 * g + up * 128) * DM + 64 * kb; rstep = 256; }
        else { const int q2 = q - 512, g = q2 & 7, kb = q2 >> 3;
            src = in[I_WDN] + (size_t)e * DM * DM + (size_t)(64 * kb) * DM + 256 * g;
            dst = ws + WS_WD + ((size_t)e * 2048 + 256 * g) * DM + 64 * kb; rstep = 128; }
    }
    __device__ __forceinline__ int item(int k) const { return (k < kmax ? k : kmax) * G + bid; }
    __device__ __forceinline__ void request(int k) {
        const float* src; unsigned char* dst; int rs; decode(item(k), src, dst, rs);
        const int w = tid >> 6, lane = tid & 63;
#pragma unroll
        for (int i = 0; i < 8; ++i) v[i] = __builtin_nontemporal_load((const f32x4*)(src + (size_t)(8 * w + i) * DM + 4 * lane));
    }
    __device__ __forceinline__ void act() {
        const int k = s; s = k + 1;
        const int w = tid >> 6, lane = tid & 63;
        {
            const float sc = (item(k - 1) % 768) < 512 ? 32.f : 64.f;
            LAS unsigned char* t = tiles + ((k - 1) & 1) * CVH_TILE_BYTES;
#pragma unroll
            for (int g = 0; g < 2; ++g) { u32x4 o;
                o.x = pk4_fp8(v[4 * g][0] * sc, v[4 * g + 1][0] * sc, v[4 * g + 2][0] * sc, v[4 * g + 3][0] * sc); o.y = pk4_fp8(v[4 * g][1] * sc, v[4 * g + 1][1] * sc, v[4 * g + 2][1] * sc, v[4 * g + 3][1] * sc);
                o.z = pk4_fp8(v[4 * g][2] * sc, v[4 * g + 1][2] * sc, v[4 * g + 2][2] * sc, v[4 * g + 3][2] * sc); o.w = pk4_fp8(v[4 * g][3] * sc, v[4 * g + 1][3] * sc, v[4 * g + 2][3] * sc, v[4 * g + 3][3] * sc);
                *(LAS u32x4*)(t + (2 * w + g) * CVH_KG_BYTES + 16 * lane) = o; }
        }
        request(k);
        {
            const float* src; unsigned char* dst; int rs; decode(item(k >= 2 ? k - 2 : 0), src, dst, rs);
            if (k < 2) { dst = ws + WS_DUMMY; rs = 128; }
            const LAS unsigned char* t = tiles + (k & 1) * CVH_TILE_BYTES;
#pragma unroll
            for (int q = 0; q < 2; ++q) { const int idx = tid + 512 * q, row = idx >> 2, piece = idx & 3;
                const LAS unsigned char* tp = t + (4 * piece) * CVH_KG_BYTES + 4 * row;
                u32x4 o; o.x = *(const LAS unsigned*)(tp); o.y = *(const LAS unsigned*)(tp + CVH_KG_BYTES); o.z = *(const LAS unsigned*)(tp + 2 * CVH_KG_BYTES); o.w = *(const LAS unsigned*)(tp + 3 * CVH_KG_BYTES);
                *(u32x4*)(dst + (size_t)((row >> 7) * rs + (row & 127)) * DM + 16 * piece) = o; }
        }
    }
};
struct HPf {
    const f32x2* Hd; int ht; f32x2 (&h)[16];
    __device__ __forceinline__ void operator()() const {
#pragma unroll
        for (int ks = 0; ks < 16; ++ks) h[ks] = Hd[ks * 256 + ht];
    }
};

constexpr int HY_RAW = 2 * FFT_BUF_BYTES, HY_OUT = HY_RAW + 16384, HY_CVT = HY_OUT + 32768, HY_COEF = HY_CVT + 2 * CVH_TILE_BYTES, HY_END = HY_COEF + 512;
static_assert(HY_END <= MISC_OFF, "hyena LDS");
__device__ __forceinline__ void hy_conv_to_buf(const LAS bf16_t* raw, LAS f32x2* buf, const LAS float* cf, int kind, int ht) {
    float w9[9]; const float bias = cf[27 + kind];
#pragma unroll
    for (int q = 0; q < 9; ++q) w9[q] = cf[9 * kind + q];
    asm volatile("" : "+v"(ht));
    const int t0 = 8 * ht, y = t0 >> 6, x0 = t0 & 63;
    float acc[2][8];
#pragma unroll
    for (int bb = 0; bb < 2; ++bb)
#pragma unroll
        for (int i = 0; i < 8; ++i) acc[bb][i] = bias;
#pragma unroll
    for (int dy = -1; dy <= 1; ++dy) {
        const int yy = y + dy;
        if (yy >= 0 && yy < 32) {
#pragma unroll
            for (int bb = 0; bb < 2; ++bb) {
                const LAS bf16_t* base = raw + bb * 2048 + t0 + 64 * dy;
                const u32x4 mid = *(const LAS u32x4*)base;
                float vals[10];
                vals[0] = (x0 > 0) ? bf2f((unsigned)base[-1]) : 0.f; vals[9] = (x0 + 8 < 64) ? bf2f((unsigned)base[8]) : 0.f;
                vals[1] = bflo(mid.x); vals[2] = bfhi(mid.x); vals[3] = bflo(mid.y); vals[4] = bfhi(mid.y); vals[5] = bflo(mid.z); vals[6] = bfhi(mid.z); vals[7] = bflo(mid.w); vals[8] = bfhi(mid.w);
                const float wl = w9[(dy + 1) * 3], wm = w9[(dy + 1) * 3 + 1], wr_ = w9[(dy + 1) * 3 + 2];
#pragma unroll
                for (int i = 0; i < 8; ++i) acc[bb][i] += wl * vals[i] + wm * vals[i + 1] + wr_ * vals[i + 2];
            }
        }
    }
#pragma unroll
    for (int i = 0; i < 8; ++i) buf[fphys(t0 + i)] = (f32x2){acc[0][i], acc[1][i]};
}
__device__ __forceinline__ float hy_coef_load(KargP in, int c, int ht) {
    const int i = ht & 31;
    if (i < 27) { const int kind = i / 9, q = i % 9; const int ch = (kind == 0 ? 2048 : kind == 1 ? 0 : 1024) + c; return in[I_HCW][q * 3072 + ch]; }
    if (i < 30) { const int kind = i - 27; return in[I_HCB][(kind == 0 ? 2048 : kind == 1 ? 0 : 1024) + c]; }
    return in[I_HSKIP][(i - 30) * 1024 + c];
}
__device__ __forceinline__ void hyena_unit(Frame& F, int un, CvHook& hk) {
    const KargP in = karg_opaque(F.in);
    const int cg = un >> 2, bp = un & 3, c0 = cg * 8, b0 = bp * 2;
    const int hb = F.tid >> 8, ht = F.tid & 255;
    LAS f32x2* buf = (LAS f32x2*)(F.lds + hb * FFT_BUF_BYTES);
    LAS bf16_t* raw = (LAS bf16_t*)(F.lds + HY_RAW + hb * 8192);
    LAS unsigned char* outT = (LAS unsigned char*)(F.lds + HY_OUT);
    const bf16_t* ZT = WSP(bf16_t, WS_ZT); const f32x2* H = WSP(f32x2, WS_H);
    const FftTw tw = fft_tw(ht);
    __syncthreads();
#define HY_FETCH(dst, kind, ch) do { _Pragma("unroll") for (int bb = 0; bb < 2; ++bb) dst[bb] = *(const u32x4*)(ZT + ((size_t)(b0 + bb) * 3072 + (kind) * 1024 + (ch)) * SEQ + ht * 8); } while (0)
#define HY_PUT(srcv) do { _Pragma("unroll") for (int bb = 0; bb < 2; ++bb) *(LAS u32x4*)(raw + bb * 2048 + ht * 8) = srcv[bb]; } while (0)
    u32x4 rv[2], rn[2];
    HY_FETCH(rv, 2, c0 + hb);
    LAS float* coef = (LAS float*)(F.lds + HY_COEF) + hb * 64;
    if (ht < 32) coef[ht] = hy_coef_load(in, c0 + hb, ht);
    float cpre = 0.f;
#pragma unroll 1
    for (int i = 0; i < 4; ++i) {
        const int cl = 2 * i + hb, c = c0 + cl;
        const LAS float* cf = coef + (i & 1) * 32;
        { int hto = ht; asm volatile("" : "+v"(hto));
          if (i < 3 && hto < 32) cpre = hy_coef_load(in, c + 2, hto); }
        HY_PUT(rv);
        HY_FETCH(rn, 0, c);
        __syncthreads(); hk.act();
        f32x2 vin[8], v[16], hpre[16];
        hy_conv_to_buf(raw, buf, cf, 0, ht);
        __syncthreads();
#pragma unroll
        for (int a = 0; a < 8; ++a) { vin[a] = buf[fphys(256 * a + ht)]; v[a] = vin[a]; v[8 + a] = (f32x2){0.f, 0.f}; }
        fft_fwd<true, false>(v, buf, ht, tw, hk, HPf{H + (size_t)(c * 2 + 0) * 4096, ht, hpre});
#pragma unroll
        for (int ks = 0; ks < 16; ++ks) v[ks] = cmul(v[ks], hpre[ks]);
        fft_inv<true, false, true>(v, buf, ht, tw, hk);
        HY_PUT(rn);
        HY_FETCH(rv, 1, c);
        __syncthreads();
        hy_conv_to_buf(raw, buf, cf, 1, ht);
        __syncthreads(); hk.act();
        { const float sk = cf[30];
#pragma unroll
          for (int a = 0; a < 8; ++a) { const f32x2 g = buf[fphys(256 * a + ht)]; vin[a] = g * (v[a] + vin[a] * sk); } }
#pragma unroll
        for (int a = 0; a < 8; ++a) { v[a] = vin[a]; v[8 + a] = (f32x2){0.f, 0.f}; }
        fft_fwd<false, true>(v, buf, ht, tw, hk, HPf{H + (size_t)(c * 2 + 1) * 4096, ht, hpre});
#pragma unroll
        for (int ks = 0; ks < 16; ++ks) v[ks] = cmul(v[ks], hpre[ks]);
        fft_inv<false, true, false>(v, buf, ht, tw, hk);
        HY_PUT(rv);
        if (i < 3) HY_FETCH(rv, 2, c + 2);
        __syncthreads(); hk.act();
        hy_conv_to_buf(raw, buf, cf, 2, ht);
        __syncthreads();
        { const float sk = cf[31];
#pragma unroll
          for (int a = 0; a < 8; ++a) { const f32x2 g = buf[fphys(256 * a + ht)]; const f32x2 o = g * (v[a] + vin[a] * sk); const int t = 256 * a + ht;
              const unsigned pk_ = pk4_fp8(fminf(fmaxf(o.x, -448.f), 448.f), fminf(fmaxf(o.y, -448.f), 448.f), 0.f, 0.f);
              outT[(0 * 2048 + t) * 8 + cl] = (unsigned char)(pk_ & 0xffu); outT[(1 * 2048 + t) * 8 + cl] = (unsigned char)((pk_ >> 8) & 0xffu); } }
        if (i < 3 && ht < 32) coef[((i + 1) & 1) * 32 + ht] = cpre;
        __syncthreads();
    }
#undef HY_FETCH
#undef HY_PUT
    unsigned char* HH = WSP(unsigned char, WS_HH);
    int tido = F.tid; asm volatile("" : "+v"(tido));
#pragma unroll
    for (int q = 0; q < 8; ++q) { const int r = tido + 512 * q, bb = r >> 11, t = r & 2047;
        *(u32x2*)(HH + ((size_t)(b0 + bb) * SEQ + t) * HW + c0) = *(const LAS u32x2*)(outT + r * 8); }
    __syncthreads();
}

struct SchedP {
    static constexpr bool GATHER = false;
    int G, c; const char* a; const char* b; size_t astep, bstep;
    __device__ __forceinline__ bool next(int i, Unit& u) const { const int L = i * G + c; if (L >= 512) return false; pg8::decode_tile(L, 64, 8, u.pm, u.pn); u.ex = 0; return true; }
    __device__ __forceinline__ const char* a_base(const Unit& u) const { return a + (size_t)u.pm * astep; }
    __device__ __forceinline__ const char* b_base(const Unit& u) const { return b + (size_t)u.pn * bstep; }
    __device__ __forceinline__ int a_row(const Unit&, int R) const { return R; }
};
struct EpiMA {
    static constexpr bool PERM = true;
    bf16_t* T; const bf16_t* Z;
    __device__ __forceinline__ void operator()(const f32x4 (&acc)[2][2][4][2], const Unit& u, int wr, int wc, int fr, int fq) const {
        const int row0 = u.pm * 256 + wr * 64 + fr, col0 = u.pn * 256 + wc * 32 + 8 * fq;
#pragma unroll
        for (int ai = 0; ai < 2; ++ai)
#pragma unroll
            for (int bj = 0; bj < 2; ++bj) { const int c = col0 + bj * 128;
                u32x4 gz[4];
#pragma unroll
                for (int m = 0; m < 4; ++m) gz[m] = *(const u32x4*)(Z + (size_t)(row0 + ai * 128 + m * 16) * ZN + ZC_GA + c);
#pragma unroll
                for (int m = 0; m < 4; ++m) { const size_t row = row0 + ai * 128 + m * 16;
                    const f32x4 g0 = (f32x4){sigmoid_fast(bflo(gz[m].x)), sigmoid_fast(bfhi(gz[m].x)), sigmoid_fast(bflo(gz[m].y)), sigmoid_fast(bfhi(gz[m].y))};
                    const f32x4 g1 = (f32x4){sigmoid_fast(bflo(gz[m].z)), sigmoid_fast(bfhi(gz[m].z)), sigmoid_fast(bflo(gz[m].w)), sigmoid_fast(bfhi(gz[m].w))};
                    const f32x4 t0 = acc[ai][bj][m][0] * g0, t1 = acc[ai][bj][m][1] * g1;
                    u32x4 w; w.x = pg8::cvt_pk_bf16(t0[0], t0[1]); w.y = pg8::cvt_pk_bf16(t0[2], t0[3]); w.z = pg8::cvt_pk_bf16(t1[0], t1[1]); w.w = pg8::cvt_pk_bf16(t1[2], t1[3]);
                    *(u32x4*)(T + row * DM + c) = w; }
                asm volatile("" ::: "memory"); }
    }
};
struct EpiMB {
    static constexpr bool PERM = true;
    const bf16_t* T; const bf16_t* Z; unsigned char* MX;
    __device__ __forceinline__ void operator()(const f32x4 (&acc)[2][2][4][2], const Unit& u, int wr, int wc, int fr, int fq) const {
        const int row0 = u.pm * 256 + wr * 64 + fr, col0 = u.pn * 256 + wc * 32 + 8 * fq;
#pragma unroll
        for (int ai = 0; ai < 2; ++ai)
#pragma unroll
            for (int bj = 0; bj < 2; ++bj) { const int c = col0 + bj * 128;
                u32x4 gz[4], tv[4];
#pragma unroll
                for (int m = 0; m < 4; ++m) { const size_t row = row0 + ai * 128 + m * 16; gz[m] = *(const u32x4*)(Z + row * ZN + ZC_GH + c); tv[m] = *(const u32x4*)(T + row * DM + c); }
#pragma unroll
                for (int m = 0; m < 4; ++m) { const size_t row = row0 + ai * 128 + m * 16;
                    const f32x4 t0 = (f32x4){bflo(tv[m].x), bfhi(tv[m].x), bflo(tv[m].y), bfhi(tv[m].y)}, t1 = (f32x4){bflo(tv[m].z), bfhi(tv[m].z), bflo(tv[m].w), bfhi(tv[m].w)};
                    const f32x4 g0 = (f32x4){sigmoid_fast(bflo(gz[m].x)), sigmoid_fast(bfhi(gz[m].x)), sigmoid_fast(bflo(gz[m].y)), sigmoid_fast(bfhi(gz[m].y))};
                    const f32x4 g1 = (f32x4){sigmoid_fast(bflo(gz[m].z)), sigmoid_fast(bfhi(gz[m].z)), sigmoid_fast(bflo(gz[m].w)), sigmoid_fast(bfhi(gz[m].w))};
                    const f32x4 v0 = t0 + acc[ai][bj][m][0] * g0, v1 = t1 + acc[ai][bj][m][1] * g1;
                    const f32x4 c0 = __builtin_elementwise_min(__builtin_elementwise_max(v0, (f32x4){-448.f, -448.f, -448.f, -448.f}), (f32x4){448.f, 448.f, 448.f, 448.f});
                    const f32x4 c1 = __builtin_elementwise_min(__builtin_elementwise_max(v1, (f32x4){-448.f, -448.f, -448.f, -448.f}), (f32x4){448.f, 448.f, 448.f, 448.f});
                    u32x2 w; w.x = pk4_fp8(c0[0], c0[1], c0[2], c0[3]); w.y = pk4_fp8(c1[0], c1[1], c1[2], c1[3]);
                    *(u32x2*)(MX + row * DM + c) = w; }
                asm volatile("" ::: "memory"); }
    }
};
struct EpiWO {
    static constexpr bool PERM = true;
    bf16_t* R1; const float* x; const float* stats; const float* lng; const float* lnb; const float* mod;
    __device__ __forceinline__ void operator()(const f32x4 (&acc)[2][2][4][2], const Unit& u, int wr, int wc, int fr, int fq) const {
        const int row0 = u.pm * 256 + wr * 64 + fr, col0 = u.pn * 256 + wc * 32 + 8 * fq;
        const float* g1p = mod + (size_t)(u.pm >> 3) * 12288 + 4096;
#pragma unroll
        for (int bj = 0; bj < 2; ++bj) { const int c = col0 + bj * 128;
            const f32x4 ga = *(const f32x4*)(lng + c), gb = *(const f32x4*)(lng + c + 4), ba = *(const f32x4*)(lnb + c), bb = *(const f32x4*)(lnb + c + 4), g1a = *(const f32x4*)(g1p + c), g1b = *(const f32x4*)(g1p + c + 4);
#pragma unroll
            for (int ai = 0; ai < 2; ++ai)
#pragma unroll
                for (int mh = 0; mh < 2; ++mh) {
                    f32x4 xa[2], xb[2]; f32x2 st[2];
#pragma unroll
                    for (int q = 0; q < 2; ++q) { const size_t row = row0 + ai * 128 + (2 * mh + q) * 16; xa[q] = *(const f32x4*)(x + row * DM + c); xb[q] = *(const f32x4*)(x + row * DM + c + 4); st[q] = *(const f32x2*)(stats + row * 2); }
#pragma unroll
                    for (int q = 0; q < 2; ++q) { const int m = 2 * mh + q; const size_t row = row0 + ai * 128 + m * 16; const float mean = st[q].x, rstd = st[q].y;
                        const f32x4 v0 = ((xa[q] - mean) * rstd * ga + ba) * DN_ALPHA + g1a * acc[ai][bj][m][0], v1 = ((xb[q] - mean) * rstd * gb + bb) * DN_ALPHA + g1b * acc[ai][bj][m][1];
                        u32x4 w; w.x = pg8::cvt_pk_bf16(v0[0], v0[1]); w.y = pg8::cvt_pk_bf16(v0[2], v0[3]); w.z = pg8::cvt_pk_bf16(v1[0], v1[1]); w.w = pg8::cvt_pk_bf16(v1[2], v1[3]);
                        *(u32x4*)(R1 + row * DM + c) = w; }
                    asm volatile("" ::: "memory"); } }
    }
};

struct CwItem { const float* src; unsigned char* dst; float scale; };
__device__ __forceinline__ CwItem cw_decode(KargP in, unsigned char* ws, int it) {
    CwItem c;
    if (it < NEXP * 2048) { const int e = it >> 11, q = it & 2047, g = q & 127, kb = q >> 7; const int n0 = 32 * g, tile = n0 >> 8, within = n0 & 255;
        c.src = (within < 128 ? in[I_WG] : in[I_WU]) + (size_t)e * DM * DM + (size_t)(128 * kb) * DM + tile * 128 + (within & 127);
        c.dst = ws + WS_WGU + ((size_t)e * 4096 + n0) * DM + 128 * kb; c.scale = 32.f; }
    else { const int r2 = it - NEXP * 2048; const int e = r2 >> 10, q = r2 & 1023, g = q & 63, kb = q >> 6;
        c.src = in[I_WDN] + (size_t)e * DM * DM + (size_t)(128 * kb) * DM + 32 * g;
        c.dst = ws + WS_WD + ((size_t)e * 2048 + 32 * g) * DM + 128 * kb; c.scale = 64.f; }
    return c;
}
constexpr int CV_E8 = 9;
__device__ __forceinline__ int cw_map(int i) { return i < CV_E8 * 2048 ? i : NEXP * 2048 + (i - CV_E8 * 2048); }
__device__ __forceinline__ void convert_moe_wave(KargP in, unsigned char* ws, LAS unsigned char* tile, int lane, int cw, int ncw) {
    constexpr int NIT = CV_E8 * (2048 + 1024);
    const int kq = lane >> 3, nq = lane & 7;
#define CW_LOAD(v, c) do { _Pragma("unroll") for (int i_ = 0; i_ < 16; ++i_) v[i_] = __builtin_nontemporal_load((const f32x4*)((c).src + (size_t)(16 * kq + i_) * DM + 4 * nq)); } while (0)
#define CW_PROC(v, c) do { \
        _Pragma("unroll") for (int j_ = 0; j_ < 4; ++j_) { u32x4 o_; const float s_ = (c).scale; \
            o_.x = pk4_fp8(v[0][j_] * s_, v[1][j_] * s_, v[2][j_] * s_, v[3][j_] * s_);     o_.y = pk4_fp8(v[4][j_] * s_, v[5][j_] * s_, v[6][j_] * s_, v[7][j_] * s_); \
            o_.z = pk4_fp8(v[8][j_] * s_, v[9][j_] * s_, v[10][j_] * s_, v[11][j_] * s_);   o_.w = pk4_fp8(v[12][j_] * s_, v[13][j_] * s_, v[14][j_] * s_, v[15][j_] * s_); \
            *(LAS u32x4*)(tile + (4 * nq + j_) * 144 + 16 * kq) = o_; } \
        asm volatile("s_waitcnt lgkmcnt(0)" ::: "memory"); \
        _Pragma("unroll") for (int q_ = 0; q_ < 4; ++q_) { const int idx_ = lane + 64 * q_, row_ = idx_ >> 3, piece_ = idx_ & 7; \
            *(u32x4*)((c).dst + (size_t)row_ * DM + 16 * piece_) = *(const LAS u32x4*)(tile + row_ * 144 + 16 * piece_); } \
        asm volatile("s_waitcnt lgkmcnt(0)" ::: "memory"); } while (0)
    f32x4 va[16], vb[16];
    int it = cw;
    if (it >= NIT) return;
    CwItem ca = cw_decode(in, ws, cw_map(it)), cb = ca;
    CW_LOAD(va, ca);
    for (;;) {
        const bool hb = it + ncw < NIT;
        if (hb) { cb = cw_decode(in, ws, cw_map(it + ncw)); CW_LOAD(vb, cb); }
        CW_PROC(va, ca);
        if (!hb) break;
        it += ncw;
        const bool ha = it + ncw < NIT;
        if (ha) { ca = cw_decode(in, ws, cw_map(it + ncw)); CW_LOAD(va, ca); }
        CW_PROC(vb, cb);
        if (!ha) break;
        it += ncw;
    }
#undef CW_LOAD
#undef CW_PROC
}

__device__ __forceinline__ void sw_bar4(volatile LAS unsigned* cnt, unsigned& target, int lane) {
    asm volatile("s_waitcnt lgkmcnt(0)" ::: "memory");
    target += 4u;
    if (lane == 0) __hip_atomic_fetch_add((LAS unsigned*)cnt, 1u, __ATOMIC_RELAXED, __HIP_MEMORY_SCOPE_WORKGROUP);
    for (unsigned sp_ = 0; __hip_atomic_load((LAS unsigned*)cnt, __ATOMIC_RELAXED, __HIP_MEMORY_SCOPE_WORKGROUP) < target && sp_ < (1u << 24); ++sp_) __builtin_amdgcn_s_sleep(0);
    asm volatile("" ::: "memory");
}
__device__ __forceinline__ void p8_phase(Frame& F) {
    const KargP in = karg_opaque(F.in);
    const int lane = F.lane, l15 = lane & 15, g4 = lane >> 4;
    if (F.wave >= 4) {
        convert_moe_wave(in, F.ws, (LAS unsigned char*)(F.lds + 4 * 20480 + (F.wave - 4) * 4608), lane, F.bid * 4 + (F.wave - 4), F.G * 4);
        return; }
    const bf16_t* R1 = WSP(bf16_t, WS_R1); unsigned char* TOK = WSP(unsigned char, WS_TOK); const float* mod = WSP(float, WS_MOD);
    LAS float* pA = (LAS float*)(F.lds + F.wave * 20480);
    LAS float* pB = pA + 2048;
    LAS float* lg = pA + 4096;
    LAS int* te = (LAS int*)(lg + 576); LAS float* tw = (LAS float*)(te + 64);
    const float* wr = in[I_WR];
    LAS float* wl = (LAS float*)(F.lds + 4 * 20480 + 4 * 4608);
    unsigned rbt = 0u;
#pragma unroll 1
    for (int tile = F.bid + F.G * F.wave; tile < MTOK / 16; tile += F.G * 4) {
        const int bsel = (tile * 16) / SEQ; const float* mv = mod + (size_t)bsel * 12288;
#pragma unroll
        for (int j = 0; j < 8; ++j) { const int c = lane * 4 + 256 * j;
            const f32x4 g = *(const f32x4*)(in[I_LN1G] + c), bb = *(const f32x4*)(in[I_LN1B] + c), sh = *(const f32x4*)(mv + 6144 + c), sc = *(const f32x4*)(mv + 8192 + c) + 1.0f;
            *(LAS f32x4*)(pA + c) = g * sc; *(LAS f32x4*)(pB + c) = bb * sc + sh; }
        LDS_WAIT(); asm volatile("" ::: "memory");
        float my_mean = 0.f, my_rstd = 0.f;
        {
            const bf16_t* xb = R1 + (size_t)tile * 16 * DM + lane * 4;
            f32x4 v[8]; u32x2 vn[8];
#pragma unroll
            for (int j = 0; j < 8; ++j) { const u32x2 t_ = *(const u32x2*)(xb + 256 * j); v[j] = (f32x4){bflo(t_.x), bfhi(t_.x), bflo(t_.y), bfhi(t_.y)}; }
#pragma unroll 1
            for (int rr = 0; rr < 16; ++rr) {
                const bf16_t* xn = xb + (size_t)(rr < 15 ? rr + 1 : rr) * DM;
#pragma unroll
                for (int j = 0; j < 8; ++j) vn[j] = *(const u32x2*)(xn + 256 * j);
                float s = 0.f;
#pragma unroll
                for (int j = 0; j < 8; ++j) s += (v[j].x + v[j].y) + (v[j].z + v[j].w);
                const float mean = wave_sum(s) * (1.f / DM); float s2 = 0.f;
#pragma unroll
                for (int j = 0; j < 8; ++j) { v[j] = v[j] - mean; s2 += (v[j].x * v[j].x + v[j].y * v[j].y) + (v[j].z * v[j].z + v[j].w * v[j].w); }
                const float rstd = 1.f / sqrtf(wave_sum(s2) * (1.f / DM) + LN_EPS);
                if (l15 == rr) { my_mean = mean; my_rstd = rstd; }
                unsigned char* orow = TOK + (size_t)(tile * 16 + rr) * DM;
#pragma unroll
                for (int j = 0; j < 8; ++j) { const int c = lane * 4 + 256 * j;
                    const f32x4 y = v[j] * rstd * *(const LAS f32x4*)(pA + c) + *(const LAS f32x4*)(pB + c);
                    *(unsigned*)(orow + c) = pk4_fp8(y.x, y.y, y.z, y.w); }
#pragma unroll
                for (int j = 0; j < 8; ++j) v[j] = (f32x4){bflo(vn[j].x), bfhi(vn[j].x), bflo(vn[j].y), bfhi(vn[j].y)};
            }
        }
        f32x4 acc0 = (f32x4){0.f, 0.f, 0.f, 0.f}, acc1 = (f32x4){0.f, 0.f, 0.f, 0.f};
        const bf16_t* rowp = R1 + (size_t)(tile * 16 + l15) * DM + 512 * g4;
        const float ra = my_rstd, rm = -my_mean * my_rstd;
        const int rt = F.tid;
        float wst[32]; u32x4 ar[8];
#define RT_WLOAD(c) do { int rt_ = rt; asm volatile("" : "+v"(rt_)); const float* wb_ = wr + (size_t)(64 * (c) + (rt_ >> 5)) * 32 + (rt_ & 31); \
            _Pragma("unroll") for (int q_ = 0; q_ < 32; ++q_) wst[q_] = wb_[(512 * (q_ >> 3) + 8 * (q_ & 7)) * 32]; } while (0)
        RT_WLOAD(0);
#pragma unroll
        for (int q = 0; q < 8; ++q) ar[q] = *(const u32x4*)(rowp + 8 * q);
#pragma unroll 1
        for (int c = 0; c < 8; ++c) {
            { int rt_ = rt; asm volatile("" : "+v"(rt_)); LAS float* wd_ = wl + (rt_ & 31) * 68 + (rt_ >> 5);
#pragma unroll
              for (int q = 0; q < 32; ++q) wd_[(q >> 3) * 32 * 68 + 8 * (q & 7)] = wst[q]; }
            sw_bar4(F.MISC + 16, rbt, lane);
            if (c < 7) RT_WLOAD(c + 1);
            const LAS float* w0p = wl + (g4 * 32 + l15) * 68; const LAS float* w1p = w0p + 16 * 68;
            const bf16_t* rown = rowp + 64 * (c < 7 ? c + 1 : c);
#pragma unroll
            for (int i = 0; i < 16; ++i) {
                const f32x4 av = *(const LAS f32x4*)(pA + 512 * g4 + 64 * c + 4 * i), bv = *(const LAS f32x4*)(pB + 512 * g4 + 64 * c + 4 * i);
                const f32x4 w0 = *(const LAS f32x4*)(w0p + 4 * i), w1 = *(const LAS f32x4*)(w1p + 4 * i);
                const unsigned lo = (i & 1) ? ar[i >> 1].z : ar[i >> 1].x, hi = (i & 1) ? ar[i >> 1].w : ar[i >> 1].y;
                const f32x4 tk = ((f32x4){bflo(lo), bfhi(lo), bflo(hi), bfhi(hi)} * ra + rm) * av + bv;
#pragma unroll
                for (int j = 0; j < 4; ++j) { acc0 = __builtin_amdgcn_mfma_f32_16x16x4f32(tk[j], w0[j], acc0, 0, 0, 0); acc1 = __builtin_amdgcn_mfma_f32_16x16x4f32(tk[j], w1[j], acc1, 0, 0, 0); }
                if (i == 7) {
#pragma unroll
                    for (int q = 0; q < 4; ++q) ar[q] = *(const u32x4*)(rown + 8 * q); }
            }
#pragma unroll
            for (int q = 4; q < 8; ++q) ar[q] = *(const u32x4*)(rown + 8 * q);
            sw_bar4(F.MISC + 16, rbt, lane);
        }
#undef RT_WLOAD
        { const float b0 = in[I_BR][l15], b1 = in[I_BR][16 + l15];
#pragma unroll
          for (int r = 0; r < 4; ++r) { lg[(4 * g4 + r) * 33 + l15] = acc0[r] + b0; lg[(4 * g4 + r) * 33 + 16 + l15] = acc1[r] + b1; } }
        LDS_WAIT(); asm volatile("" ::: "memory");
        if (lane < 16) {
            unsigned chosen = 0u; float lv[4]; int le[4];
            for (int k = 0; k < 4; ++k) { float best = -3.4e38f; int be = 0;
                for (int e = 0; e < 32; ++e) { const float v = lg[lane * 33 + e]; if (!((chosen >> e) & 1u) && v > best) { best = v; be = e; } }
                chosen |= 1u << be; lv[k] = best; le[k] = be; }
            float ex[4], sum = 0.f;
            for (int k = 0; k < 4; ++k) { ex[k] = __expf(lv[k] - lv[0]); sum += ex[k]; }
            for (int k = 0; k < 4; ++k) { te[lane * 4 + k] = le[k]; tw[lane * 4 + k] = ex[k] / sum; }
        }
        LDS_WAIT(); asm volatile("" ::: "memory");
        { const int e = te[lane]; const float wv = tw[lane]; const int token = tile * 16 + (lane >> 2);
          const int pos = (int)__hip_atomic_fetch_add(F.ctl + CW_CNT + 64 * e, 1u, __ATOMIC_RELAXED, __HIP_MEMORY_SCOPE_AGENT);
          WSP(int, WS_TOPE)[token * 4 + (lane & 3)] = e; WSP(int, WS_TOPP)[token * 4 + (lane & 3)] = pos; WSP(float, WS_TOPW)[token * 4 + (lane & 3)] = wv;
          WSP(int, WS_RTOK)[e * POSCAP + pos] = token; }
        LDS_WAIT(); asm volatile("" ::: "memory");
    }
}

constexpr int MOE_TBL = 131072;
__device__ __forceinline__ void moe_table(Frame& F) {
    LAS int* tst = (LAS int*)(F.lds + MOE_TBL); LAS int* cn = (LAS int*)(F.lds + MOE_TBL + 256);
    __syncthreads();
    if (F.tid < 64) {
        const int e = F.tid & 31; const int c = (int)__hip_atomic_load(F.ctl + CW_CNT + 64 * e, __ATOMIC_RELAXED, __HIP_MEMORY_SCOPE_AGENT);
        int inc = (c + 255) >> 8;
#pragma unroll
        for (int o = 1; o < 32; o <<= 1) { const int t = __shfl_up(inc, o); if ((F.tid & 31) >= o) inc += t; }
        if (F.tid < 32) { cn[e] = c; tst[e] = inc - ((c + 255) >> 8); if (e == 31) tst[NEXP] = inc; } }
    __syncthreads();
}
constexpr int MOE_UL = MOE_TBL + 512;
__device__ __forceinline__ void moe_unit_list(Frame& F, int NT) {
    const LAS int* tst = (const LAS int*)(F.lds + MOE_TBL); LAS int* ul = (LAS int*)(F.lds + MOE_UL);
    if (F.tid < 64) {
        const int nwg = tst[NEXP] * NT; const int L = F.tid * F.G + F.bid;
        int pm = -1, pn = 0, e = 0;
        if (L < nwg) {
            int wg; { const int q = nwg / 8, r = nwg % 8, xcd = L % 8, off = L / 8; wg = (xcd < r ? xcd * (q + 1) : r * (q + 1) + (xcd - r) * q) + off; }
            for (int k = 1; k < NEXP; ++k) if (wg >= tst[k] * NT) e = k;
            const int ts = tst[e], ne = tst[e + 1] - ts, rem = wg - ts * NT;
            pm = ts + rem % ne; pn = rem / ne; }
        ul[F.tid * 4 + 0] = pm; ul[F.tid * 4 + 1] = pn; ul[F.tid * 4 + 2] = e; ul[F.tid * 4 + 3] = 0;
    }
    __syncthreads();
}
constexpr int MOE_ROWS = MOE_UL + 1024, MOE_ROWS_MAX = 18;
constexpr int MOE_BIAS = MOE_ROWS + MOE_ROWS_MAX * 512;
static_assert(MOE_BIAS + MOE_ROWS_MAX * 1024 <= MISC_OFF, "MoE LDS tables");
__device__ __forceinline__ void moe_row_table(Frame& F, const int* rtok) {
    const LAS int* tst = (const LAS int*)(F.lds + MOE_TBL); const LAS int* cn = (const LAS int*)(F.lds + MOE_TBL + 256); const LAS int* ul = (const LAS int*)(F.lds + MOE_UL);
    LAS unsigned short* rows = (LAS unsigned short*)(F.lds + MOE_ROWS);
    for (int idx = F.tid; idx < MOE_ROWS_MAX * 256; idx += NTHR) { const int i = idx >> 8, r = idx & 255; const int pm = ul[i * 4];
        if (pm >= 0) { const int e = ul[i * 4 + 2]; int pos = (pm - tst[e]) * 256 + r; const int cnt = cn[e]; pos = pos < cnt ? pos : cnt - 1; rows[idx] = (unsigned short)rtok[e * POSCAP + pos]; } }
    __syncthreads();
}
__device__ __forceinline__ void moe_bias_table(Frame& F, const float* b0, const float* b1, bool gu) {
    const LAS int* ul = (const LAS int*)(F.lds + MOE_UL); LAS float* bt = (LAS float*)(F.lds + MOE_BIAS);
    for (int idx = F.tid; idx < MOE_ROWS_MAX * 256; idx += NTHR) { const int i = idx >> 8, j = idx & 255; const int pm = ul[i * 4];
        if (pm >= 0) { const int pn = ul[i * 4 + 1], e = ul[i * 4 + 2];
            bt[idx] = gu ? (j < 128 ? b0[(size_t)e * DM + pn * 128 + j] : b1[(size_t)e * DM + pn * 128 + j - 128]) : b0[(size_t)e * DM + pn * 256 + j]; } }
    __syncthreads();
}
template <bool GU> struct SchedMoE {
    static constexpr bool GATHER = GU;
    int G, c, NT; const LAS int* tst; const LAS int* cn; const int* rtok; const char* a; const char* b; const LAS int* ul;
    __device__ __forceinline__ bool next(int i, Unit& u) const {
        if (i >= MOE_ROWS_MAX) return false;
        const int pm = __builtin_amdgcn_readfirstlane(ul[i * 4 + 0]); if (pm < 0) return false;
        u.pm = pm; u.pn = __builtin_amdgcn_readfirstlane(ul[i * 4 + 1]); u.ex = i; return true;
    }
    __device__ __forceinline__ const char* a_base(const Unit& u) const { return GU ? a : a + (size_t)u.pm * 256 * DM; }
    __device__ __forceinline__ int expert(const Unit& u) const { return __builtin_amdgcn_readfirstlane(ul[u.ex * 4 + 2]); }
    __device__ __forceinline__ const char* b_base(const Unit& u) const { return b + ((size_t)expert(u) * (GU ? 4096 : 2048) + 256 * u.pn) * DM; }
    __device__ __forceinline__ int a_row(const Unit& u, int R) const { return (int)((const LAS unsigned short*)((const LAS char*)ul + (MOE_ROWS - MOE_UL)))[u.ex * 256 + R]; }
};
struct EpiGU {
    static constexpr bool PERM = true;
    unsigned char* ACT; const float* bg; const float* bu; const LAS int* ul;
    __device__ __forceinline__ void operator()(const f32x4 (&acc)[2][2][4][2], const Unit& u, int wr, int wc, int fr, int fq) const {
        const int row0 = u.pm * 256 + wr * 64 + fr, col0 = u.pn * 128 + wc * 32 + 8 * fq;
        const LAS float* bt = (const LAS float*)((const LAS char*)ul + (MOE_BIAS - MOE_UL)) + u.ex * 256 + wc * 32 + 8 * fq;
        const f32x4 g0 = *(const LAS f32x4*)bt, g1 = *(const LAS f32x4*)(bt + 4), u0 = *(const LAS f32x4*)(bt + 128), u1 = *(const LAS f32x4*)(bt + 132);
#pragma unroll
        for (int ai = 0; ai < 2; ++ai)
#pragma unroll
            for (int m = 0; m < 4; ++m) { const size_t row = row0 + ai * 128 + m * 16;
                float o[8];
#pragma unroll
                for (int n = 0; n < 2; ++n)
#pragma unroll
                    for (int j = 0; j < 4; ++j) { const float gv = fminf(acc[ai][0][m][n][j] + (n ? g1[j] : g0[j]), 7.0f);
                        const float uv = fminf(fmaxf(acc[ai][1][m][n][j] + (n ? u1[j] : u0[j]), -7.0f), 7.0f);
                        o[n * 4 + j] = 4.0f * gv * sigmoid_fast(1.702f * gv) * (uv + 1.0f); }
                u32x2 w; w.x = pk4_fp8(o[0], o[1], o[2], o[3]); w.y = pk4_fp8(o[4], o[5], o[6], o[7]);
                *(u32x2*)(ACT + row * DM + col0) = w; }
    }
};
struct EpiDN {
    static constexpr bool PERM = true;
    unsigned char* YR; const LAS int* ul;
    __device__ __forceinline__ void operator()(const f32x4 (&acc)[2][2][4][2], const Unit& u, int wr, int wc, int fr, int fq) const {
        const int r0 = wr * 64 + fr, col0 = u.pn * 256 + wc * 32 + 8 * fq;
        const LAS float* bp = (const LAS float*)((const LAS char*)ul + (MOE_BIAS - MOE_UL)) + u.ex * 256 + wc * 32 + 8 * fq;
        unsigned char* base = YR + ((size_t)u.pm * 256 + r0) * DM + col0;
#pragma unroll
        for (int bj = 0; bj < 2; ++bj) {
            const f32x4 bv0 = *(const LAS f32x4*)(bp + bj * 128), bv1 = *(const LAS f32x4*)(bp + bj * 128 + 4);
#pragma unroll
            for (int ai = 0; ai < 2; ++ai)
#pragma unroll
                for (int m = 0; m < 4; ++m) {
                    const f32x4 lim = (f32x4){448.f, 448.f, 448.f, 448.f};
                    const f32x4 v0 = __builtin_elementwise_min(__builtin_elementwise_max((acc[ai][bj][m][0] + bv0) * 16.0f, -lim), lim), v1 = __builtin_elementwise_min(__builtin_elementwise_max((acc[ai][bj][m][1] + bv1) * 16.0f, -lim), lim);
                    u32x2 w; w.x = pk4_fp8(v0[0], v0[1], v0[2], v0[3]); w.y = pk4_fp8(v1[0], v1[1], v1[2], v1[3]);
                    *(u32x2*)(base + (size_t)(ai * 128 + m * 16) * DM + bj * 128) = w; }
        }
    }
};

__device__ __forceinline__ void p11_phase(Frame& F) {
    const KargP in = karg_opaque(F.in);
    const int gw = F.bid * NWAVES + F.wave, NGW = F.G * NWAVES, lane = F.lane;
    const LAS int* tst = (const LAS int*)(F.lds + MOE_TBL);
    const bf16_t* R1 = WSP(bf16_t, WS_R1); const unsigned char* YR = WSP(unsigned char, WS_YR); const float* mod = WSP(float, WS_MOD);
    LAS float* pl = (LAS float*)F.lds;
    for (int i = F.tid; i < 2048; i += NTHR) { pl[i] = in[I_LN1G][i]; pl[2048 + i] = in[I_LN1B][i]; pl[4096 + i] = in[I_LN2G][i]; pl[6144 + i] = in[I_LN2B][i]; }
    for (int i = F.tid; i < 8 * 2048; i += NTHR) pl[8192 + i] = mod[(size_t)(i >> 11) * 12288 + 10240 + (i & 2047)];
    __syncthreads();
    LAS int* sd = (LAS int*)(F.lds + 98304 + F.wave * 512); LAS float* sw = (LAS float*)(F.lds + 98304 + F.wave * 512 + 256);
#pragma unroll 1
    for (int rb = gw * 8; rb < MTOK; rb += NGW * 8) {
        const int li = lane & 31;
        { const int ve = WSP(int, WS_TOPE)[rb * 4 + li], vp = WSP(int, WS_TOPP)[rb * 4 + li]; const float vw = WSP(float, WS_TOPW)[rb * 4 + li];
          if (lane < 32) { sd[li] = tst[ve] * 256 + vp; sw[li] = vw; } }
        const LAS float* g2p = pl + 8192 + (rb / SEQ) * 2048;
        LDS_WAIT(); asm volatile("" ::: "memory");
#pragma unroll 1
        for (int ri = 0; ri < 8; ++ri) {
            const int row = rb + ri;
            int dest[4]; float wk[4];
#pragma unroll
            for (int k = 0; k < 4; ++k) { dest[k] = __builtin_amdgcn_readfirstlane(sd[ri * 4 + k]); wk[k] = __builtin_bit_cast(float, __builtin_amdgcn_readfirstlane(__builtin_bit_cast(int, sw[ri * 4 + k]))); }
            const bf16_t* xr = R1 + (size_t)row * DM + lane * 4;
            f32x4 v[8]; unsigned yy[4][8]; u32x2 vr[8];
#pragma unroll
            for (int j = 0; j < 8; ++j) vr[j] = *(const u32x2*)(xr + 256 * j);
#pragma unroll
            for (int k = 0; k < 4; ++k) { const unsigned char* yp = YR + (size_t)dest[k] * DM + lane * 4;
#pragma unroll
                for (int j = 0; j < 8; ++j) yy[k][j] = *(const unsigned*)(yp + 256 * j); }
            float s = 0.f;
#pragma unroll
            for (int j = 0; j < 8; ++j) { v[j] = (f32x4){bflo(vr[j].x), bfhi(vr[j].x), bflo(vr[j].y), bfhi(vr[j].y)}; s += (v[j].x + v[j].y) + (v[j].z + v[j].w); }
            float mean = wave_sum(s) * (1.f / DM); float s2 = 0.f;
#pragma unroll
            for (int j = 0; j < 8; ++j) { v[j] = v[j] - mean; s2 += (v[j].x * v[j].x + v[j].y * v[j].y) + (v[j].z * v[j].z + v[j].w * v[j].w); }
            float rstd = 1.f / sqrtf(wave_sum(s2) * (1.f / DM) + LN_EPS);
            s = 0.f;
#pragma unroll
            for (int j = 0; j < 8; ++j) { const int c = lane * 4 + 256 * j;
                const f32x4 g = *(const LAS f32x4*)(pl + c), bb = *(const LAS f32x4*)(pl + 2048 + c), g2v = *(const LAS f32x4*)(g2p + c);
                f32x4 y = (f32x4){0.f, 0.f, 0.f, 0.f};
#pragma unroll
                for (int k = 0; k < 4; ++k) { const f32x2 lo = __builtin_amdgcn_cvt_pk_f32_fp8((int)yy[k][j], false), hi = __builtin_amdgcn_cvt_pk_f32_fp8((int)yy[k][j], true); y += (f32x4){lo.x, lo.y, hi.x, hi.y} * (wk[k] * 0.0625f); }
                v[j] = (v[j] * rstd * g + bb) * DN_ALPHA + g2v * y;
                s += (v[j].x + v[j].y) + (v[j].z + v[j].w); __builtin_amdgcn_sched_barrier(0); }
            mean = wave_sum(s) * (1.f / DM); s2 = 0.f;
#pragma unroll
            for (int j = 0; j < 8; ++j) { v[j] = v[j] - mean; s2 += (v[j].x * v[j].x + v[j].y * v[j].y) + (v[j].z * v[j].z + v[j].w * v[j].w); }
            rstd = 1.f / sqrtf(wave_sum(s2) * (1.f / DM) + LN_EPS);
            float* orow = F.out + (size_t)row * DM;
#pragma unroll
            for (int j = 0; j < 8; ++j) { const int c = lane * 4 + 256 * j;
                const f32x4 g = *(const LAS f32x4*)(pl + 4096 + c), bb = *(const LAS f32x4*)(pl + 6144 + c);
                *(f32x4*)(orow + c) = v[j] * rstd * g + bb; }
        }
        LDS_WAIT(); asm volatile("" ::: "memory");
    }
}

constexpr int NPHASE = 13;
__global__ void __launch_bounds__(NTHR, 2) mk_fwd(Args args) {
    extern __shared__ __attribute__((aligned(16))) unsigned char lds_raw[];
    Frame F;
    F.lds = (LAS unsigned char*)lds_raw;
    F.MISC = (volatile LAS unsigned*)(F.lds + MISC_OFF);
    F.tid = threadIdx.x; F.lane = F.tid & 63; F.wave = __builtin_amdgcn_readfirstlane(F.tid >> 6);
    F.G = gridDim.x; F.bid = blockIdx.x;
    F.in = (KargP)__builtin_amdgcn_kernarg_segment_ptr(); F.out = args.out; F.ws = args.ws; F.ctl = (unsigned*)(args.ws + WS_CTL);
    for (int u = F.tid; u < (LDS_BYTES - MISC_OFF) / 4; u += NTHR) ((LAS unsigned*)(F.lds + MISC_OFF))[u] = 0u;
    __syncthreads();
    XcdBarrier bar; bar.bar = F.ctl + CW_BAR; bar.x = 0; bar.st = nullptr;
    if (MK_LAUNCHES == 1) bar = xcd_barrier_post(F.ctl + CW_BAR, F.MISC + 8);
    const int lo = args.ph_lo, hi = args.ph_hi;
    unsigned long long tph_ = (PROBE_PH >= 0) ? __builtin_amdgcn_s_memrealtime() : 0ull;
#ifndef PH_MASK
#define PH_MASK 0xFFFF
#endif
#define RELOAD() do { const KargP k_ = karg_opaque(F.in); F.out = (float*)k_[38]; F.ws = (unsigned char*)k_[39]; F.ctl = (unsigned*)F.ws; int t_ = threadIdx.x; asm volatile("" : "+v"(t_)); F.tid = t_; F.lane = t_ & 63; F.wave = __builtin_amdgcn_readfirstlane(t_ >> 6); } while (0)
#define IN(k) (((PH_MASK >> (k)) & 1) && lo <= (k) && (k) < hi)
#define SEAM(k) do { if (IN(k) && IN((k) + 1)) xcd_barrier(bar); \
        if (PROBE_PH >= 0) { const unsigned long long t1_ = __builtin_amdgcn_s_memrealtime(); \
            if (PROBE_PH == (k)) { while (__builtin_amdgcn_s_memrealtime() - t1_ < t1_ - tph_) __builtin_amdgcn_s_sleep(8); } \
            tph_ = __builtin_amdgcn_s_memrealtime(); } } while (0)
#ifndef DUP_MASK
#define DUP_MASK 0
#endif
#define REP(k) for (int rep_ = 0; rep_ < (((DUP_MASK >> (k)) & 1) ? 2 : 1); ++rep_)
    if (IN(0)) REP(0) p0_phase(F);
    SEAM(0);
    RELOAD();
    if (IN(1)) REP(1) p0b_phase(F);
    SEAM(1);
    RELOAD();
    if (IN(2)) REP(2) p1_phase(F);
    SEAM(2);
    RELOAD();
    if (IN(3)) REP(3) {
        EpiZ E{WSP(bf16_t, WS_Z), WSP(bf16_t, WS_ZT), WSP(float, WS_BINP)};
        { SchedZ<false> S{F.G, F.bid, (const char*)WSP(bf16_t, WS_HX), (const char*)WSP(bf16_t, WS_WIN)};
          pg8::gemm_phase<EpiZ, SchedZ<false>>(F.lds, DM / 64, DM * 2, DM * 2, S, E); }
        { SchedZ<true> S{F.G, F.G - 1 - F.bid, (const char*)WSP(unsigned char, WS_HX8), (const char*)WSP(unsigned char, WS_WIN8)};
          pg8::gemm_phase<EpiZ, SchedZ<true>, true>(F.lds, DM / 128, DM, DM, S, E, 0x7A7A7A7A, 0x7F7F7F7F); }
    }
    SEAM(3);
    RELOAD();
    if (IN(4)) REP(4) p3_phase(F);
    SEAM(4);
    RELOAD();
    if (IN(5)) REP(5) {
        SchedQK S{F.G, F.bid, (const char*)WSP(bf16_t, WS_U), (const char*)WSP(bf16_t, WS_WQK)};
        EpiQK E{WSP(bf16_t, WS_QKB)};
        pg8::gemm_phase<EpiQK, SchedQK>(F.lds, 256 / 64, MW * 2, 256 * 2, S, E);
    }
    SEAM(5);
    RELOAD();
    if (IN(6)) REP(6) {
#ifndef DUP_ML
#define DUP_ML 1
#endif
#ifndef DUP_HY
#define DUP_HY 1
#endif
        for (int un = F.bid; un < 256 * DUP_ML; un += F.G) mlstm_unit(F, un & 255);
        RELOAD();
        { CvHook hk; hk.in = karg_opaque(F.in); hk.ws = F.ws; hk.tiles = (LAS unsigned char*)(F.lds + HY_CVT); hk.tid = F.tid; hk.bid = F.bid; hk.G = F.G; hk.kmax = (CVH_NITEMS - 1 - F.bid) / F.G; hk.s = 1; hk.request(0);
          for (int un = F.bid; un < 512 * DUP_HY; un += F.G) hyena_unit(F, un & 511, hk);
          while (hk.s <= hk.kmax + 2) { __syncthreads(); hk.act(); }
          __syncthreads(); }
    }
    SEAM(6);
    RELOAD();
    if (IN(7)) REP(7) {
        { SchedP S{F.G, F.bid, (const char*)WSP(unsigned char, WS_AM), (const char*)WSP(unsigned char, WS_WPA2), (size_t)256 * 2048, (size_t)256 * 2048};
          EpiMA E{WSP(bf16_t, WS_T), WSP(bf16_t, WS_Z)};
          pg8::gemm_phase<EpiMA, SchedP, true>(F.lds, 2048 / 128, 2048, 2048, S, E, 0x7A7A7A7A, 0x7F7F7F7F); }
        VM_WAIT(); __syncthreads();
        { SchedP S{F.G, F.bid, (const char*)WSP(unsigned char, WS_HH), (const char*)WSP(unsigned char, WS_WPH), (size_t)256 * 1024, (size_t)256 * 1024};
          EpiMB E{WSP(bf16_t, WS_T), WSP(bf16_t, WS_Z), WSP(unsigned char, WS_MX)};
          pg8::gemm_phase<EpiMB, SchedP, true>(F.lds, 1024 / 128, 1024, 1024, S, E, 0x7A7A7A7A, 0x7F7F7F7F); }
    }
    SEAM(7);
    RELOAD();
    if (IN(8)) REP(8) {
        SchedP S{F.G, F.bid, (const char*)WSP(unsigned char, WS_MX), (const char*)WSP(unsigned char, WS_WOUT), (size_t)256 * 2048, (size_t)256 * 2048};
        const KargP in = karg_opaque(F.in); EpiWO E{WSP(bf16_t, WS_R1), in[I_X], WSP(float, WS_STATS), in[I_LNG], in[I_LNB], WSP(float, WS_MOD)};
        pg8::gemm_phase<EpiWO, SchedP, true>(F.lds, 2048 / 128, 2048, 2048, S, E, 0x79797979, 0x7F7F7F7F);
    }
    SEAM(8);
    RELOAD();
    if (IN(9)) p8_phase(F);
    SEAM(9);
    RELOAD();
    if (IN(10)) REP(10) {
        moe_table(F);
        moe_unit_list(F, 16); moe_row_table(F, WSP(int, WS_RTOK)); { const KargP in_ = karg_opaque(F.in); moe_bias_table(F, in_[I_BG], in_[I_BU], true); }
        SchedMoE<true> S{F.G, F.bid, 16, (const LAS int*)(F.lds + MOE_TBL), (const LAS int*)(F.lds + MOE_TBL + 256), WSP(int, WS_RTOK), (const char*)WSP(bf16_t, WS_TOK), (const char*)WSP(bf16_t, WS_WGU), (const LAS int*)(F.lds + MOE_UL)};
        const KargP in = karg_opaque(F.in); EpiGU E{WSP(unsigned char, WS_ACT), in[I_BG], in[I_BU], (const LAS int*)(F.lds + MOE_UL)};
        pg8::gemm_phase<EpiGU, SchedMoE<true>, true>(F.lds, DM / 128, DM, DM, S, E, 0x7A7A7A7A, 0x7F7F7F7F);
    }
    SEAM(10);
    RELOAD();
    if (IN(11)) REP(11) {
        moe_table(F);
        moe_unit_list(F, 8); { const KargP in_ = karg_opaque(F.in); moe_bias_table(F, in_[I_BDN], in_[I_BDN], false); }
        SchedMoE<false> S{F.G, F.bid, 8, (const LAS int*)(F.lds + MOE_TBL), (const LAS int*)(F.lds + MOE_TBL + 256), WSP(int, WS_RTOK), (const char*)WSP(bf16_t, WS_ACT), (const char*)WSP(bf16_t, WS_WD), (const LAS int*)(F.lds + MOE_UL)};
        const KargP in = karg_opaque(F.in); EpiDN E{WSP(unsigned char, WS_YR), (const LAS int*)(F.lds + MOE_UL)};
        pg8::gemm_phase<EpiDN, SchedMoE<false>, true>(F.lds, DM / 128, DM, DM, S, E, 0x79797979, 0x7D7D7D7D);
    }
    SEAM(11);
    RELOAD();
    if (IN(12)) REP(12) { moe_table(F); p11_phase(F); }
#undef IN
#undef SEAM
}

extern "C" void kernel_launch(void* const* d_in, const int* in_sizes, int n_in, void* d_out, int out_size, void* d_ws, size_t ws_size, hipStream_t stream) {
    static int grid = 0;
    if (grid == 0) {
        if (n_in != 38 || out_size != MTOK * DM || ws_size < WS_END) { fprintf(stderr, "kernel_launch: unexpected shapes: n_in %d out %d ws %zu (need %zu)\n", n_in, out_size, ws_size, (size_t)WS_END); grid = -1; return; }
        int dev = 0, cus = 0, per_cu = 0;
        if (hipGetDevice(&dev) != hipSuccess || hipDeviceGetAttribute(&cus, hipDeviceAttributeMultiprocessorCount, dev) != hipSuccess) { grid = -1; return; }
        if (hipFuncSetAttribute((const void*)mk_fwd, hipFuncAttributeMaxDynamicSharedMemorySize, LDS_BYTES) != hipSuccess) { fprintf(stderr, "kernel_launch: hipFuncSetAttribute failed\n"); grid = -1; return; }
        if (hipOccupancyMaxActiveBlocksPerMultiprocessor(&per_cu, (const void*)mk_fwd, NTHR, LDS_BYTES) != hipSuccess || per_cu < 1) fprintf(stderr, "kernel_launch: occupancy query says %d\n", per_cu);
        (void)hipGetLastError();
        grid = cus;
    }
    if (grid < 0) return;
    (void)hipMemsetAsync((char*)d_ws + WS_CTL, 0, CTL_ZERO_BYTES, stream);
    Args a{};
    for (int i = 0; i < 38; ++i) a.in[i] = (const float*)d_in[i];
    a.out = (float*)d_out; a.ws = (unsigned char*)d_ws;
#if MK_LAUNCHES == 1
    a.ph_lo = 0; a.ph_hi = NPHASE;
    hipLaunchKernelGGL(mk_fwd, dim3(grid), dim3(NTHR), LDS_BYTES, stream, a);
#else
    for (int p = 0; p < NPHASE; ++p) { a.ph_lo = p; a.ph_hi = p + 1; hipLaunchKernelGGL(mk_fwd, dim3(grid), dim3(NTHR), LDS_BYTES, stream, a); }
#endif
}
```

```cpp
#include <hip/hip_runtime.h>
#include <cstdio>
#include <cstdint>

#define GAS __attribute__((address_space(1)))
#define LAS __attribute__((address_space(3)))
typedef unsigned short bf16_t;
typedef short bf16x8 __attribute__((ext_vector_type(8)));
typedef float f32x4 __attribute__((ext_vector_type(4)));
typedef float f32x2 __attribute__((ext_vector_type(2)));
typedef unsigned u32x4 __attribute__((ext_vector_type(4)));
typedef unsigned u32x2 __attribute__((ext_vector_type(2)));

#ifndef PROBE_PH
#define PROBE_PH -1
#endif
#ifndef MK_LAUNCHES
#define MK_LAUNCHES 1
#endif

constexpr int DM = 2048, NB = 8, SEQ = 2048, CTX = 256, GW = 64;
constexpr int MTOK = NB * SEQ;
constexpr int MCTX = NB * CTX;
constexpr int MALL = MTOK + MCTX;
constexpr int NH = 4, HD = 256, MW = 1024, HW = 1024;
constexpr int N_IN = 10256;
constexpr int NEXP = 32, TOPK = 4;
constexpr float LN_EPS = 1e-5f;
constexpr float DN_ALPHA = 1.189207115002721f;
constexpr int ZN = 7424, ZC_QK = 0, ZC_V = 1024, ZC_O = 2048, ZC_GA = 3072, ZC_GH = 5120, ZC_GT = 7168;
constexpr int WIN_ROWS = 10496, WIN_HY0 = 7424;
constexpr int MAXTILES = 288;
constexpr int POSCAP = 16384;

constexpr size_t MiB = 1u << 20;
constexpr size_t WS_CTL = 0;
constexpr size_t WS_MODP = 1 * MiB;
constexpr size_t WS_MOD = 9 * MiB;
constexpr size_t WS_BINP = 10 * MiB;
constexpr size_t WS_A3 = 10 * MiB + 64 * 1024;
constexpr size_t WS_STATS = 11 * MiB;
constexpr size_t WS_TOPE = 11 * MiB + 256 * 1024;
constexpr size_t WS_TOPP = 11 * MiB + 512 * 1024;
constexpr size_t WS_TOPW = 11 * MiB + 768 * 1024;
constexpr size_t WS_RTOK = 12 * MiB;
constexpr size_t WS_RW = 14 * MiB;
constexpr size_t WS_WQK = 16 * MiB;
constexpr size_t WS_WPH = 17 * MiB;
constexpr size_t WS_WPA2 = 21 * MiB;
constexpr size_t WS_WOUT = 29 * MiB;
constexpr size_t WS_WIN = 37 * MiB;
constexpr size_t WS_WGU = 78 * MiB;
constexpr size_t WS_WD = 590 * MiB;
constexpr size_t WS_RA = 846 * MiB;
constexpr size_t WS_Z = WS_RA, WS_ZT = WS_RA + 261 * MiB, WS_ACT = WS_RA;
constexpr size_t WS_RB = 1203 * MiB;
constexpr size_t WS_HX = WS_RB, WS_U = WS_RB + 72 * MiB, WS_QKB = WS_RB + 108 * MiB, WS_AM = WS_RB + 180 * MiB, WS_HH = WS_RB + 244 * MiB, WS_MX = WS_RB + 276 * MiB, WS_YR = WS_RB;
constexpr size_t WS_RC = 1543 * MiB;
constexpr size_t WS_HTAPS = WS_RC, WS_H = WS_RC + 32 * MiB, WS_T = WS_RC;
constexpr size_t WS_R1 = 1671 * MiB;
constexpr size_t WS_TOK = 1799 * MiB;
constexpr size_t WS_HX8 = WS_RC + 96 * MiB;
constexpr size_t WS_WIN8 = 1863 * MiB;
constexpr size_t WS_DUMMY = 1884 * MiB;
constexpr size_t WS_END = 1890 * MiB;
constexpr int CW_TMO = 0, CW_BAR = 4096, CW_CNT = 16384;
constexpr size_t CTL_ZERO_BYTES = 1 * MiB;

constexpr int LDS_BYTES = 160 * 1024 - 2048;
constexpr int MISC_OFF = LDS_BYTES - 1024;
constexpr int NWAVES = 8, NTHR = 512;

#define LDS_WAIT() asm volatile("s_waitcnt lgkmcnt(0)" ::: "memory")
#define VM_WAIT() asm volatile("s_waitcnt vmcnt(0)" ::: "memory")
__device__ __forceinline__ unsigned f2bf(float f) { unsigned u = __builtin_bit_cast(unsigned, f); return (u + 0x7fffu + ((u >> 16) & 1u)) >> 16; }
__device__ __forceinline__ unsigned pk2(float lo, float hi) { unsigned r; asm("v_cvt_pk_bf16_f32 %0, %1, %2" : "=v"(r) : "v"(lo), "v"(hi)); return r; }
__device__ __forceinline__ unsigned pk4_fp8(float a, float b, float c, float d) { int w = 0; w = __builtin_amdgcn_cvt_pk_fp8_f32(a, b, w, false); w = __builtin_amdgcn_cvt_pk_fp8_f32(c, d, w, true); return (unsigned)w; }
__device__ __forceinline__ float bf2f(unsigned b) { return __builtin_bit_cast(float, b << 16); }
__device__ __forceinline__ float bflo(unsigned w) { return __builtin_bit_cast(float, w << 16); }
__device__ __forceinline__ float bfhi(unsigned w) { return __builtin_bit_cast(float, w & 0xffff0000u); }
__device__ __forceinline__ float sigmoidf_(float x) { return 1.0f / (1.0f + __expf(-x)); }
__device__ __forceinline__ float sigmoid_fast(float x) { return __builtin_amdgcn_rcpf(1.0f + __expf(-x)); }
__device__ __forceinline__ float wave_sum(float v) {
#pragma unroll
    for (int o = 1; o < 64; o <<= 1) v += __shfl_xor(v, o);
    return v;
}

#define DPP_STEP_(OP, x, ctrl, rmask, bmask, ident) { const float t_ = __builtin_bit_cast(float, __builtin_amdgcn_update_dpp(__builtin_bit_cast(int, ident), __builtin_bit_cast(int, x), ctrl, rmask, bmask, false)); x = OP(x, t_); }
__device__ __forceinline__ float scan_add_(float a, float b) { return a + b; }
__device__ __forceinline__ float wave_scan_sum(float v) {
    float x = v; const float z = 0.f;
    { const float t1 = __builtin_bit_cast(float, __builtin_amdgcn_update_dpp(0, __builtin_bit_cast(int, v), 0x111, 0xf, 0xf, false));
      const float t2 = __builtin_bit_cast(float, __builtin_amdgcn_update_dpp(0, __builtin_bit_cast(int, v), 0x112, 0xf, 0xf, false));
      const float t3 = __builtin_bit_cast(float, __builtin_amdgcn_update_dpp(0, __builtin_bit_cast(int, v), 0x113, 0xf, 0xf, false));
      x = (v + t1) + (t2 + t3); }
    DPP_STEP_(scan_add_, x, 0x114, 0xf, 0xe, z)
    DPP_STEP_(scan_add_, x, 0x118, 0xf, 0xc, z)
    DPP_STEP_(scan_add_, x, 0x142, 0xa, 0xf, z)
    DPP_STEP_(scan_add_, x, 0x143, 0xc, 0xf, z)
    return x;
}
__device__ __forceinline__ float wave_scan_max(float v) {
    float x = v; const float ninf = -__builtin_inff(); const int ni = __builtin_bit_cast(int, ninf);
    { const float t1 = __builtin_bit_cast(float, __builtin_amdgcn_update_dpp(ni, __builtin_bit_cast(int, v), 0x111, 0xf, 0xf, false));
      const float t2 = __builtin_bit_cast(float, __builtin_amdgcn_update_dpp(ni, __builtin_bit_cast(int, v), 0x112, 0xf, 0xf, false));
      const float t3 = __builtin_bit_cast(float, __builtin_amdgcn_update_dpp(ni, __builtin_bit_cast(int, v), 0x113, 0xf, 0xf, false));
      x = fmaxf(fmaxf(v, t1), fmaxf(t2, t3)); }
    DPP_STEP_(fmaxf, x, 0x114, 0xf, 0xe, ninf)
    DPP_STEP_(fmaxf, x, 0x118, 0xf, 0xc, ninf)
    DPP_STEP_(fmaxf, x, 0x142, 0xa, 0xf, ninf)
    DPP_STEP_(fmaxf, x, 0x143, 0xc, 0xf, ninf)
    return x;
}
__device__ __forceinline__ float lane_bcast(float v, int l) { return __builtin_bit_cast(float, __builtin_amdgcn_readlane(__builtin_bit_cast(int, v), l)); }
#define XB_TMO      128
#define XB_XCNT(j)  (256  + 64 * (j))
#define XB_XSUB(j)  (1280 + 64 * (j))
#define XB_XGEN(j)  (2304 + 64 * (j))
#define XB_TOP      3328
#define XB_TOPGEN   3392
#define XCD_BAR_WORDS 3456
#define XB_SPIN_CAP (1u << 22)
__device__ __forceinline__ unsigned xb_ld(unsigned* p)              { return __hip_atomic_load(p, __ATOMIC_RELAXED, __HIP_MEMORY_SCOPE_AGENT); }
__device__ __forceinline__ unsigned xb_add(unsigned* p, unsigned v) { return __hip_atomic_fetch_add(p, v, __ATOMIC_RELAXED, __HIP_MEMORY_SCOPE_AGENT); }
__device__ __forceinline__ unsigned xb_xcc_id() { return (unsigned)__builtin_amdgcn_s_getreg((3 << 11) | 20) & 0xFu; }
#define XB_SPIN(cond, bar) do { unsigned _sp = 0; while (cond) { __builtin_amdgcn_s_sleep(1); \
    if ((++_sp & 255u) == 0u) { if (xb_ld(&(bar)[XB_TMO])) break; if (_sp > XB_SPIN_CAP) { atomicAdd(&(bar)[XB_TMO], 1u); break; } } } } while (0)
struct XcdBarrier { unsigned* bar; unsigned x; volatile LAS unsigned* st; };
__device__ __forceinline__ XcdBarrier xcd_barrier_post(unsigned* bar, volatile LAS unsigned* st, int tid) {
    XcdBarrier b; b.bar = bar; b.x = xb_xcc_id(); b.st = st;
    if (tid == 0) (void)xb_add(&bar[XB_XCNT(b.x)], 1u);
    return b;
}
__device__ __forceinline__ void xcd_barrier_complete(unsigned* bar, unsigned x, unsigned& nloc, unsigned& nx) {
    const unsigned G = gridDim.x * gridDim.y * gridDim.z;
    unsigned sum, cnt, mine, sp = 0u;
    for (;;) {
        sum = 0u; cnt = 0u; mine = 0u;
#pragma unroll
        for (unsigned j = 0; j < 16; ++j) { const unsigned c = xb_ld(&bar[XB_XCNT(j)]); sum += c; cnt += (c > 0u) ? 1u : 0u; mine = (j == x) ? c : mine; }
        if (sum == G) break;
        __builtin_amdgcn_s_sleep(1);
        if ((++sp & 255u) == 0u) { if (xb_ld(&bar[XB_TMO])) break; if (sp > XB_SPIN_CAP) { atomicAdd(&bar[XB_TMO], 1u); break; } }
    }
    nloc = mine > 0u ? mine : 1u; nx = cnt > 0u ? cnt : 1u;
}
__device__ __forceinline__ void xcd_barrier(const XcdBarrier& b, int tid) {
    asm volatile("s_waitcnt vmcnt(0)" ::: "memory");
    __syncthreads();
    if (tid == 0) {
        unsigned* bar = b.bar;
        __builtin_amdgcn_s_waitcnt(0);
        unsigned nloc = b.st[0], nx = b.st[1];
        if (nloc == 0u) { xcd_barrier_complete(bar, b.x, nloc, nx); b.st[0] = nloc; b.st[1] = nx; }
        const unsigned old = xb_add(&bar[XB_XSUB(b.x)], 1u);
        const unsigned gen = old / nloc;
        if (old + 1u == (gen + 1u) * nloc) {
            __builtin_amdgcn_fence(__ATOMIC_RELEASE, "agent");
            asm volatile("s_waitcnt vmcnt(0)" ::: "memory");
            const unsigned og = xb_add(&bar[XB_TOP], 1u);
            const unsigned tg = og / nx;
            if (og + 1u == (tg + 1u) * nx) xb_add(&bar[XB_TOPGEN], 1u);
            else XB_SPIN(xb_ld(&bar[XB_TOPGEN]) == tg, bar);
            __builtin_amdgcn_fence(__ATOMIC_ACQUIRE, "agent");
            xb_add(&bar[XB_XGEN(b.x)], 1u);
            asm volatile("s_waitcnt vmcnt(0)" ::: "memory");
        } else {
            XB_SPIN(xb_ld(&bar[XB_XGEN(b.x)]) == gen, bar);
            __builtin_amdgcn_fence(__ATOMIC_ACQUIRE, "agent");
            asm volatile("s_waitcnt vmcnt(0)" ::: "memory");
        }
    }
    __syncthreads();
}

struct Args {
    const float* in[38];
    float* out; unsigned char* ws;
    int ph_lo, ph_hi;
};
enum { I_X = 0, I_C, I_CTX, I_CCTX, I_LNG, I_LNB, I_WMOD, I_BMOD, I_WIN, I_BIN, I_MCW, I_MCB, I_WQH, I_WKH, I_HCW, I_HCB, I_FW1, I_FB1, I_FWH, I_FBH,
       I_FFREQ, I_FWOUT, I_HSKIP, I_WPA, I_WPH, I_WOUT, I_LN1G, I_LN1B, I_WR, I_BR, I_WG, I_BG, I_WU, I_BU, I_WDN, I_BDN, I_LN2G, I_LN2B };

namespace pg8 {
constexpr int BM = 256, BK = 64, HALF = 128, HTB = HALF * BK * 2, STAGE_BYTES = 8 * HTB, NXCD = 8, WGM = 8;
__host__ __device__ __forceinline__ int lds_byte(int r, int c) { const int st = (r >> 4) * 2 + (c >> 5), rr = r & 15, cc = c & 31, ob = rr * 64 + cc * 2; return st * 1024 + (ob ^ (((ob >> 9) & 1) << 5)); }
__host__ __device__ __forceinline__ void stage_rc(int b, int& R, int& C) { const int st = b / 1024, sb = b % 1024, swz = sb ^ (((sb >> 9) & 1) << 5); R = (st >> 1) * 16 + swz / 64; C = (st & 1) * 32 + (swz % 64) / 2; }
__host__ __device__ __forceinline__ int perm32(int rho) { const int n = rho >> 4, i = rho & 15; return 8 * (i >> 2) + 4 * n + (i & 3); }
struct Unit { int pm, pn, ex; };
__device__ __forceinline__ void decode_tile(int L, int nM, int nN, int& pm, int& pn) {
    const int nwg = nM * nN; int wgid = L;
    { const int q = nwg / NXCD, r = nwg % NXCD, xcd = wgid % NXCD, off = wgid / NXCD; wgid = (xcd < r ? xcd * (q + 1) : r * (q + 1) + (xcd - r) * q) + off; }
    const int nig = WGM * nN, gid = wgid / nig, fm = gid * WGM, gsz = (nM - fm) < WGM ? (nM - fm) : WGM;
    pm = fm + ((wgid % nig) % gsz); pn = (wgid % nig) / gsz;
}
__device__ __forceinline__ unsigned cvt_pk_bf16(float lo, float hi) { unsigned r; asm volatile("v_cvt_pk_bf16_f32 %0, %1, %2" : "=v"(r) : "v"(lo), "v"(hi)); return r; }

typedef int i32x8 __attribute__((ext_vector_type(8)));
template <class Epi, class Sched, bool F8 = false>
__device__ __forceinline__ void gemm_phase(const int tid, LAS unsigned char* lds, const int nt, const int pitchA, const int pitchB, const Sched& S, const Epi& E, const int wscale = 0x7F7F7F7F, const int ascale = 0x7F7F7F7F) {
    const int wid = __builtin_amdgcn_readfirstlane(tid >> 6), lane = tid & 63, wr = wid >> 2, wc = wid & 3, fr = lane & 15, fq = lane >> 4;
    int RA[2], CA[2]; unsigned voffB[2];
#pragma unroll
    for (int i = 0; i < 2; ++i) { int R, C; stage_rc(tid * 16 + i * 8192, R, C); const int Rb = Epi::PERM ? ((R & ~31) + perm32(R & 31)) : R;
        RA[i] = R; CA[i] = C; voffB[i] = (unsigned)(Rb * pitchB + C * 2); }
    const size_t kstep = (size_t)(BK * 2);
    const size_t hstepB = (size_t)HALF * pitchB;
    const unsigned ldsw = (unsigned)wid * 1024u;
    const int aoff = lds_byte(wr * 64 + fr, fq * 8), boff = lds_byte(wc * 32 + fr, fq * 8);
#define PG8_SA(b, h) (((b) * 2 + (h)) * HTB)
#define PG8_SB(b, h) ((4 + (b) * 2 + (h)) * HTB)
#define PG8_STAGE(bufoff, gbase, v0, v1) do { \
        __builtin_amdgcn_global_load_lds((const unsigned*)((const char*)(gbase) + (v0)), (LAS unsigned*)(lds + (bufoff) + ldsw), 16, 0, 0); \
        __builtin_amdgcn_global_load_lds((const unsigned*)((const char*)(gbase) + (v1)), (LAS unsigned*)(lds + (bufoff) + ldsw + 8192), 16, 0, 0); } while (0)
#define PG8_LD8(off) __builtin_bit_cast(i32x8, __builtin_shufflevector(*(const LAS u32x4*)(lds + (off)), *(const LAS u32x4*)(lds + (off) + 1024), 0, 1, 2, 3, 4, 5, 6, 7))
#define PG8_LDA(dst, b, h) do { _Pragma("unroll") for (int m = 0; m < 4; ++m) { if (F8) dst##8[m] = PG8_LD8(PG8_SA(b, h) + aoff + m * 2048); else { _Pragma("unroll") for (int k = 0; k < 2; ++k) dst[m][k] = *(const LAS bf16x8*)(lds + PG8_SA(b, h) + aoff + m * 2048 + k * 1024); } } } while (0)
#define PG8_LDB(dst, b, h) do { _Pragma("unroll") for (int n = 0; n < 2; ++n) { if (F8) dst##8[n] = PG8_LD8(PG8_SB(b, h) + boff + n * 2048); else { _Pragma("unroll") for (int k = 0; k < 2; ++k) dst[n][k] = *(const LAS bf16x8*)(lds + PG8_SB(b, h) + boff + n * 2048 + k * 1024); } } } while (0)
#define PG8_CAT(x) __builtin_shufflevector(__builtin_bit_cast(u32x4, x[0]), __builtin_bit_cast(u32x4, x[1]), 0, 1, 2, 3, 4, 5, 6, 7)
#define PG8_MMA(ai, bj, At, Bt) do { __builtin_amdgcn_s_setprio(1); _Pragma("unroll") for (int m = 0; m < 4; ++m) _Pragma("unroll") for (int n = 0; n < 2; ++n) { \
        if (F8) { asm volatile("v_mfma_scale_f32_16x16x128_f8f6f4 %0, %1, %2, %0, %3, %4 op_sel_hi:[0,0,0]" : "+v"(acc[ai][bj][m][n]) : "v"(Bt##8[n]), "v"(At##8[m]), "v"(wscale), "v"(ascale)); } \
        else { _Pragma("unroll") for (int k = 0; k < 2; ++k) acc[ai][bj][m][n] = __builtin_amdgcn_mfma_f32_16x16x32_bf16(Bt[n][k], At[m][k], acc[ai][bj][m][n], 0, 0, 0); } } __builtin_amdgcn_s_setprio(0); } while (0)
#define PG8_WAIT_V(n) asm volatile("s_waitcnt vmcnt(" #n ")" ::: "memory")
#define PG8_WAIT_L(n) asm volatile("s_waitcnt lgkmcnt(" #n ")" ::: "memory")
#define PG8_BAR __builtin_amdgcn_s_barrier()
#define PG8_SCHED __builtin_amdgcn_sched_barrier(0)
#define PG8_AOFF(u, o00, o01, o10, o11) do { \
        if (Sched::GATHER) { o00 = (unsigned)(S.a_row(u, RA[0]) * pitchA + CA[0] * 2); o01 = (unsigned)(S.a_row(u, RA[1]) * pitchA + CA[1] * 2); \
                             o10 = (unsigned)(S.a_row(u, RA[0] + HALF) * pitchA + CA[0] * 2); o11 = (unsigned)(S.a_row(u, RA[1] + HALF) * pitchA + CA[1] * 2); } \
        else { o00 = (unsigned)(RA[0] * pitchA + CA[0] * 2); o01 = (unsigned)(RA[1] * pitchA + CA[1] * 2); o10 = (unsigned)((RA[0] + HALF) * pitchA + CA[0] * 2); o11 = (unsigned)((RA[1] + HALF) * pitchA + CA[1] * 2); } } while (0)
    Unit cur, nxt; int ui = 0;
    if (!S.next(0, cur)) return;
    f32x4 acc[2][2][4][2];
#pragma unroll
    for (int a = 0; a < 2; ++a)
#pragma unroll
        for (int b = 0; b < 2; ++b)
#pragma unroll
            for (int m = 0; m < 4; ++m)
#pragma unroll
                for (int n = 0; n < 2; ++n) acc[a][b][m][n] = (f32x4){0.f, 0.f, 0.f, 0.f};
    bf16x8 At[4][2], B0[2][2], B1[2][2]; i32x8 At8[4], B08[2], B18[2];
    const char* cA = S.a_base(cur); const char* cB = S.b_base(cur);
    unsigned c00, c01, c10, c11; PG8_AOFF(cur, c00, c01, c10, c11);
    const unsigned vb0 = voffB[0], vb1 = voffB[1];
    PG8_STAGE(PG8_SB(0, 0), cB, vb0, vb1); PG8_STAGE(PG8_SA(0, 0), cA, c00, c01); PG8_STAGE(PG8_SB(0, 1), cB + hstepB, vb0, vb1); PG8_STAGE(PG8_SA(0, 1), cA, c10, c11);
    if (wr == 1) PG8_BAR;
    PG8_WAIT_V(4); PG8_BAR;
    PG8_STAGE(PG8_SB(1, 0), cB + kstep, vb0, vb1); PG8_STAGE(PG8_SA(1, 0), cA + kstep, c00, c01); PG8_STAGE(PG8_SB(1, 1), cB + hstepB + kstep, vb0, vb1);
    PG8_WAIT_V(6); PG8_BAR;
    for (;;) {
        const bool has_next = S.next(ui + 1, nxt);
        const char* nA = has_next ? S.a_base(nxt) : cA; const char* nB = has_next ? S.b_base(nxt) : cB;
        unsigned n00 = c00, n01 = c01, n10 = c10, n11 = c11;
        if (has_next) PG8_AOFF(nxt, n00, n01, n10, n11);
        for (int t = 0; t < nt; t += 2) {
            const bool last = (t == nt - 2);
            const char* a1 = cA + (size_t)(t + 1) * kstep;
            const char* a2 = last ? nA : cA + (size_t)(t + 2) * kstep; const char* b2 = last ? nB : cB + (size_t)(t + 2) * kstep;
            const char* a3 = a2 + kstep; const char* b3 = b2 + kstep;
            const unsigned x00 = last ? n00 : c00, x01 = last ? n01 : c01, x10 = last ? n10 : c10, x11 = last ? n11 : c11;
            PG8_LDB(B0, 0, 0); PG8_SCHED; PG8_LDA(At, 0, 0); PG8_STAGE(PG8_SA(1, 1), a1, c10, c11);
            PG8_WAIT_L(8); PG8_BAR; PG8_WAIT_L(0); PG8_MMA(0, 0, At, B0); PG8_BAR; PG8_SCHED;
            PG8_LDB(B1, 0, 1); PG8_STAGE(PG8_SB(0, 0), b2, vb0, vb1);
            PG8_BAR; PG8_WAIT_L(0); PG8_MMA(0, 1, At, B1); PG8_BAR;
            PG8_LDA(At, 0, 1); PG8_STAGE(PG8_SA(0, 0), a2, x00, x01);
            PG8_BAR; PG8_WAIT_L(0); PG8_MMA(1, 0, At, B0); PG8_BAR; PG8_SCHED;
            PG8_STAGE(PG8_SB(0, 1), b2 + hstepB, vb0, vb1);
            PG8_WAIT_V(6); PG8_BAR; PG8_MMA(1, 1, At, B1); PG8_BAR;
            PG8_LDB(B0, 1, 0); PG8_SCHED; PG8_LDA(At, 1, 0); PG8_STAGE(PG8_SA(0, 1), a2, x10, x11);
            PG8_WAIT_L(8); PG8_BAR; PG8_WAIT_L(0); PG8_MMA(0, 0, At, B0); PG8_BAR; PG8_SCHED;
            PG8_LDB(B1, 1, 1); PG8_STAGE(PG8_SB(1, 0), b3, vb0, vb1);
            PG8_BAR; PG8_WAIT_L(0); PG8_MMA(0, 1, At, B1); PG8_BAR;
            PG8_LDA(At, 1, 1); PG8_STAGE(PG8_SA(1, 0), a3, x00, x01);
            PG8_BAR; PG8_WAIT_L(0); PG8_MMA(1, 0, At, B0); PG8_BAR; PG8_SCHED;
            PG8_STAGE(PG8_SB(1, 1), b3 + hstepB, vb0, vb1);
            PG8_WAIT_V(6); PG8_BAR; PG8_MMA(1, 1, At, B1); PG8_BAR;
        }
        if (F8) asm volatile("s_nop 15\n\ts_nop 15" ::: "memory");
        E(acc, cur, wr, wc, fr, fq);
        if (!has_next) break;
#pragma unroll
        for (int a = 0; a < 2; ++a)
#pragma unroll
            for (int b = 0; b < 2; ++b)
#pragma unroll
                for (int m = 0; m < 4; ++m)
#pragma unroll
                    for (int n = 0; n < 2; ++n) acc[a][b][m][n] = (f32x4){0.f, 0.f, 0.f, 0.f};
        cur = nxt; cA = nA; cB = nB; c00 = n00; c01 = n01; c10 = n10; c11 = n11; ++ui;
    }
    PG8_WAIT_V(0);
    if (wr == 0) PG8_BAR;
    PG8_BAR;
#undef PG8_SA
#undef PG8_SB
#undef PG8_STAGE
#undef PG8_LDA
#undef PG8_LDB
#undef PG8_MMA
#undef PG8_WAIT_V
#undef PG8_WAIT_L
#undef PG8_BAR
#undef PG8_SCHED
#undef PG8_AOFF
#undef PG8_CAT
#undef PG8_LD8
}
}
using pg8::Unit;

typedef const float* cfp_t;
typedef __attribute__((address_space(4))) const cfp_t* KargP;
__device__ __forceinline__ KargP karg_opaque(KargP p) { asm volatile("" : "+s"(p)); return p; }
struct Frame {
    LAS unsigned char* lds;
    volatile LAS unsigned* MISC;
    unsigned* ctl;
    int tid, lane, wave, wave0, G, bid;
    KargP in;
    float* out; unsigned char* ws;
};
#define WSP(T, off) ((T*)(F.ws + (off)))

__device__ __forceinline__ void transpose_item(const float* src, size_t ld, int nvalid, float scale, bf16_t* dst, int K, LAS float* scr, int lane) {
    { float tv[32]; const int j = lane & 31;
#pragma unroll
      for (int i = 0; i < 32; ++i) tv[i] = (j < nvalid) ? src[(size_t)(2 * i + (lane >> 5)) * ld + j] : 0.f;
#pragma unroll
      for (int i = 0; i < 32; ++i) scr[(2 * i + (lane >> 5)) * 33 + j] = tv[i] * scale; }
    LDS_WAIT(); asm volatile("" ::: "memory");
    const int c = lane & 7;
#pragma unroll
    for (int j = 0; j < 4; ++j) { const int n = (lane >> 3) + 8 * j; const LAS float* s = scr + (8 * c) * 33 + n;
        u32x4 o; o.x = pk2(s[0 * 33], s[1 * 33]); o.y = pk2(s[2 * 33], s[3 * 33]); o.z = pk2(s[4 * 33], s[5 * 33]); o.w = pk2(s[6 * 33], s[7 * 33]);
        *(u32x4*)(dst + (size_t)n * K + 8 * c) = o; }
    LDS_WAIT(); asm volatile("" ::: "memory");
}
struct CvItem { const float* src; unsigned char* dst; float scale; int rstep; };
__device__ __forceinline__ CvItem cv_decode(KargP in, unsigned char* ws, int it) {
    CvItem c;
    if (it < NEXP * 256) { const int e = it >> 8, q = it & 255, up = q & 1, g = (q >> 1) & 7, kb = q >> 4;
        c.src = (up ? in[I_WU] : in[I_WG]) + (size_t)e * DM * DM + (size_t)(128 * kb) * DM + 256 * g;
        c.dst = ws + WS_WGU + ((size_t)e * 4096 + 512 * g + up * 128) * DM + 128 * kb; c.scale = 32.f; c.rstep = 256; }
    else { const int r2 = it - NEXP * 256; const int e = r2 >> 7, q = r2 & 127, g = q & 7, kb = q >> 3;
        c.src = in[I_WDN] + (size_t)e * DM * DM + (size_t)(128 * kb) * DM + 256 * g;
        c.dst = ws + WS_WD + ((size_t)e * 2048 + 256 * g) * DM + 128 * kb; c.scale = 64.f; c.rstep = 128; }
    return c;
}
constexpr int CV_E8X = 8, CV_P0N = 3;
__device__ __forceinline__ int cv_map(int i) { constexpr int n1 = CV_P0N * 256; return i < n1 ? CV_E8X * 256 + i : NEXP * 256 + CV_E8X * 128 + (i - n1); }
#define CV_LOAD(v, c) do { _Pragma("unroll") for (int i_ = 0; i_ < 16; ++i_) v[i_] = __builtin_nontemporal_load((const f32x4*)((c).src + (size_t)(16 * w + i_) * DM + 4 * lane)); } while (0)
#define CV_PROC(v, c) do { \
        _Pragma("unroll") for (int j_ = 0; j_ < 4; ++j_) { u32x4 o_; const float s_ = (c).scale; \
            o_.x = pk4_fp8(v[0][j_] * s_, v[1][j_] * s_, v[2][j_] * s_, v[3][j_] * s_);     o_.y = pk4_fp8(v[4][j_] * s_, v[5][j_] * s_, v[6][j_] * s_, v[7][j_] * s_); \
            o_.z = pk4_fp8(v[8][j_] * s_, v[9][j_] * s_, v[10][j_] * s_, v[11][j_] * s_);   o_.w = pk4_fp8(v[12][j_] * s_, v[13][j_] * s_, v[14][j_] * s_, v[15][j_] * s_); \
            *(LAS u32x4*)(tile + (4 * lane + j_) * 144 + 16 * w) = o_; } \
        __syncthreads(); \
        _Pragma("unroll") for (int q_ = 0; q_ < 4; ++q_) { const int idx_ = tid + 512 * q_, row_ = idx_ >> 3, piece_ = idx_ & 7; \
            *(u32x4*)((c).dst + (size_t)((row_ >> 7) * (c).rstep + (row_ & 127)) * DM + 16 * piece_) = *(const LAS u32x4*)(tile + row_ * 144 + 16 * piece_); } \
        __syncthreads(); } while (0)
__device__ __forceinline__ void convert_moe_weights(KargP in, unsigned char* ws, LAS unsigned char* tile, int tid, int bid, int G) {
    const int w = tid >> 6, lane = tid & 63;
    constexpr int NIT = CV_P0N * (256 + 128);
    f32x4 va[16], vb[16];
    int it = bid;
    if (it >= NIT) return;
    CvItem ca = cv_decode(in, ws, cv_map(it)), cb = ca;
    CV_LOAD(va, ca);
    for (;;) {
        const bool hb = it + G < NIT;
        if (hb) { cb = cv_decode(in, ws, cv_map(it + G)); CV_LOAD(vb, cb); }
        CV_PROC(va, ca);
        if (!hb) break;
        it += G;
        const bool ha = it + G < NIT;
        if (ha) { ca = cv_decode(in, ws, cv_map(it + G)); CV_LOAD(va, ca); }
        CV_PROC(vb, cb);
        if (!ha) break;
        it += G;
    }
}
#undef CV_LOAD
#undef CV_PROC
__device__ __forceinline__ void transpose_item_f8(const float* src, size_t ld, float scale, unsigned char* dst, int K, LAS float* scr, int lane) {
    { float tv[32]; const int j = lane & 31;
#pragma unroll
      for (int i = 0; i < 32; ++i) tv[i] = src[(size_t)(2 * i + (lane >> 5)) * ld + j];
#pragma unroll
      for (int i = 0; i < 32; ++i) scr[(2 * i + (lane >> 5)) * 33 + j] = tv[i] * scale; }
    LDS_WAIT(); asm volatile("" ::: "memory");
    const int c = lane & 3;
#pragma unroll
    for (int j = 0; j < 2; ++j) { const int n = (lane >> 2) + 16 * j; const LAS float* s = scr + (16 * c) * 33 + n;
        u32x4 o; o.x = pk4_fp8(s[0 * 33], s[1 * 33], s[2 * 33], s[3 * 33]); o.y = pk4_fp8(s[4 * 33], s[5 * 33], s[6 * 33], s[7 * 33]);
        o.z = pk4_fp8(s[8 * 33], s[9 * 33], s[10 * 33], s[11 * 33]); o.w = pk4_fp8(s[12 * 33], s[13 * 33], s[14 * 33], s[15 * 33]);
        *(u32x4*)(dst + (size_t)n * K + 16 * c) = o; }
    LDS_WAIT(); asm volatile("" ::: "memory");
}
__device__ __forceinline__ void p0_phase(Frame& F) {
    const KargP in = karg_opaque(F.in);
    LAS float* scr = (LAS float*)(F.lds + F.wave * 16384);
    const int gw = F.bid * NWAVES + F.wave, NGW = F.G * NWAVES;
    constexpr int IT_WIN = 32 * (WIN_ROWS / 32);
    constexpr int IT_WQK = 4 * 64;
    constexpr int IT_WPA2 = 32 * 64;
    constexpr int IT_WPH = 16 * 64;
    constexpr int IT_WOUT = 32 * 64;
    constexpr int NITEMS = IT_WIN + IT_WQK + IT_WPA2 + IT_WPH + IT_WOUT;
    for (int it = gw; it < NITEMS; it += NGW) {
        int r = it;
        if (r < IT_WIN) { const int g = r % (WIN_ROWS / 32), kb = r / (WIN_ROWS / 32); const int n0 = 32 * g; int sc, nv = 32;
            if (n0 < 2048) sc = n0; else if (n0 < 3072) sc = 2064 + (n0 - 2048); else if (n0 < 7168) sc = 6160 + (n0 - 3072); else if (n0 < 7200) { sc = 2048; nv = 16; } else if (n0 < WIN_HY0) { sc = 0; nv = 0; } else sc = 3088 + (n0 - WIN_HY0);
            if (n0 < 2048 || (n0 >= 7168 && n0 < WIN_HY0)) transpose_item(in[I_WIN] + (size_t)(64 * kb) * N_IN + sc, N_IN, nv, 1.f, WSP(bf16_t, WS_WIN) + (size_t)n0 * DM + 64 * kb, DM, scr, F.lane);
            if (n0 >= 1024 && !(n0 >= 7168 && n0 < WIN_HY0)) transpose_item_f8(in[I_WIN] + (size_t)(64 * kb) * N_IN + sc, N_IN, 32.f, WSP(unsigned char, WS_WIN8) + (size_t)n0 * DM + 64 * kb, DM, scr, F.lane);
            continue; } r -= IT_WIN;
        if (r < IT_WQK) { const int g = r % 64, kb = r / 64; const int n0 = 32 * g, h = n0 / 512, j = (n0 % 512) / 256, e0 = n0 % 256;
            const float* src = (j ? in[I_WKH] : in[I_WQH]) + (size_t)h * 65536 + (size_t)(64 * kb) * 256 + e0;
            transpose_item(src, 256, 32, j ? 0.0625f : 1.f, WSP(bf16_t, WS_WQK) + (size_t)n0 * 256 + 64 * kb, 256, scr, F.lane); continue; } r -= IT_WQK;
        if (r < IT_WPA2) { const int g = r % 64, kb = r / 64; const int n0 = 32 * g, k0 = 64 * kb;
            transpose_item_f8(in[I_WPA] + (size_t)(k0 % 1024) * DM + n0, DM, 32.f, WSP(unsigned char, WS_WPA2) + (size_t)n0 * 2048 + k0, 2048, scr, F.lane); continue; } r -= IT_WPA2;
        if (r < IT_WPH) { const int g = r % 64, kb = r / 64; const int n0 = 32 * g, k0 = 64 * kb;
            transpose_item_f8(in[I_WPH] + (size_t)k0 * DM + n0, DM, 32.f, WSP(unsigned char, WS_WPH) + (size_t)n0 * 1024 + k0, 1024, scr, F.lane); continue; } r -= IT_WPH;
        if (r < IT_WOUT) { const int g = r % 64, kb = r / 64; const int n0 = 32 * g, k0 = 64 * kb;
            transpose_item_f8(in[I_WOUT] + (size_t)k0 * DM + n0, DM, 64.f, WSP(unsigned char, WS_WOUT) + (size_t)n0 * 2048 + k0, 2048, scr, F.lane); continue; } r -= IT_WOUT;
        (void)r;
    }
    __syncthreads();
    convert_moe_weights(in, F.ws, (LAS unsigned char*)F.lds, F.tid, F.bid, F.G);
    for (int i = F.bid * NTHR + F.tid; i < WIN_ROWS; i += F.G * NTHR) { int sc = -1;
        if (i < 2048) sc = i; else if (i < 3072) sc = 2064 + (i - 2048); else if (i < 7168) sc = 6160 + (i - 3072); else if (i < 7184) sc = 2048 + (i - 7168); else if (i < WIN_HY0) sc = -1; else sc = 3088 + (i - WIN_HY0);
        WSP(float, WS_BINP)[i] = sc >= 0 ? in[I_BIN][sc] : 0.f; }
    for (int it = F.bid + F.G * F.wave; it < 16 * 48; it += F.G * NWAVES) {
        const int ks = it / 48, cg = it % 48; const int col = cg * 256 + F.lane * 4;
        f32x4 a[9];
#pragma unroll
        for (int v = 0; v < 9; ++v) a[v] = (f32x4){0.f, 0.f, 0.f, 0.f};
#pragma unroll 1
        for (int kb = ks * 128; kb < ks * 128 + 128; kb += 16) {
            f32x4 w[16];
#pragma unroll
            for (int i = 0; i < 16; ++i) w[i] = *(const f32x4*)(in[I_WMOD] + (size_t)(kb + i) * 12288 + col);
#pragma unroll
            for (int i = 0; i < 16; ++i)
#pragma unroll
                for (int v = 0; v < 9; ++v) { const float cv = (v < 8) ? in[I_C][v * DM + kb + i] : in[I_CCTX][kb + i]; const float s = cv * sigmoidf_(cv); a[v] += w[i] * s; }
        }
#pragma unroll
        for (int v = 0; v < 9; ++v) *(f32x4*)(WSP(float, WS_MODP) + ((size_t)ks * 9 + v) * 12288 + col) = a[v];
    }
    for (int j = gw; j < SEQ; j += NGW) {
        const int l = F.lane;
        float zv = 0.f;
        if (l == 0) zv = (float)j / (float)(SEQ - 1);
        else if (l < 33) { const int bi = (l - 1) & 15; const float f = 1e-4f + (float)bi * ((15.0f - 1e-4f) / 15.0f); const float ang = 6.283185307179586f * (float)j * f / (float)SEQ; zv = (l < 17) ? cosf(ang) : -sinf(ang); }
        float pre = in[I_FB1][l];
        for (int i = 0; i < 33; ++i) pre += __shfl(zv, i) * in[I_FW1][i * 64 + l];
        float a = sinf(in[I_FFREQ][l] * pre);
        pre = in[I_FBH][l];
        for (int i = 0; i < 64; ++i) pre += __shfl(a, i) * in[I_FWH][i * 64 + l];
        float a2 = sinf(in[I_FFREQ][64 + l] * pre);
        pre = in[I_FBH][64 + l];
        for (int i = 0; i < 64; ++i) pre += __shfl(a2, i) * in[I_FWH][4096 + i * 64 + l];
        WSP(float, WS_A3)[j * 64 + l] = sinf(in[I_FFREQ][128 + l] * pre);
    }
}

__device__ __forceinline__ void p0b_phase(Frame& F) {
    const KargP in = karg_opaque(F.in);
    for (int i = F.bid * NTHR + F.tid; i < 9 * 12288; i += F.G * NTHR) { const int col = i % 12288; float s = in[I_BMOD][col];
        for (int ks = 0; ks < 16; ++ks) s += WSP(float, WS_MODP)[(size_t)ks * 9 * 12288 + i];
        WSP(float, WS_MOD)[i] = s; }
    LAS float* wl = (LAS float*)F.lds;
    for (int un = F.bid; un < 256; un += F.G) {
        const int ct = un >> 2, pg = un & 3;
        __syncthreads();
        for (int q = 0; q < 8; ++q) { const int idx = F.tid + 512 * q, i = idx >> 6, cc = idx & 63; wl[cc * 68 + i] = in[I_FWOUT][(size_t)i * 4096 + ct * 64 + cc]; }
        __syncthreads();
        const int j = pg * 512 + F.wave * 64 + F.lane;
        f32x4 ar[16];
#pragma unroll
        for (int q = 0; q < 16; ++q) ar[q] = *(const f32x4*)(WSP(float, WS_A3) + j * 64 + 4 * q);
        const float tj = (float)j / (float)(SEQ - 1);
        const float mind = -3.0701134573253944f, maxd = -15.350567286626972f;
        const int cbase = (ct * 64) & 1023;
#pragma unroll 1
        for (int cc = 0; cc < 64; ++cc) {
            f32x4 s = (f32x4){0.f, 0.f, 0.f, 0.f};
#pragma unroll
            for (int q = 0; q < 16; ++q) s += ar[q] * *(const LAS f32x4*)(wl + cc * 68 + 4 * q);
            const float delta = fabsf(mind + (float)(cbase + cc) * ((maxd - mind) / 1023.0f));
            const float v = ((s.x + s.y) + (s.z + s.w)) * __expf(-tj * delta);
            WSP(float, WS_HTAPS)[(size_t)(ct * 64 + cc) * SEQ + j] = v;
        }
    }
}

__device__ __forceinline__ f32x2 cmul(f32x2 a, f32x2 b) { return (f32x2){a.x * b.x - a.y * b.y, a.x * b.y + a.y * b.x}; }
__device__ __forceinline__ f32x2 cmulc(f32x2 a, f32x2 b) { return (f32x2){a.x * b.x + a.y * b.y, a.y * b.x - a.x * b.y}; }
__device__ __forceinline__ f32x2 cmulp(f32x2 a, f32x2 w, f32x2 iw) { return __builtin_elementwise_fma(a.yy, iw, a.xx * w); }
__device__ __forceinline__ f32x2 rot_i(f32x2 w) { return w.yx * (f32x2){-1.f, 1.f}; }
__device__ __forceinline__ f32x2 cmulq(f32x2 a, f32x2 b) { return cmulp(a, b, rot_i(b)); }
template <bool INV> __device__ __forceinline__ void dft4(f32x2& a, f32x2& b, f32x2& c, f32x2& d) {
    const f32x2 s0 = a + c, s1 = a - c, s2 = b + d, s3 = b - d;
    const f32x2 pm = (f32x2){1.f, -1.f}, mp = (f32x2){-1.f, 1.f};
    a = s0 + s2; c = s0 - s2;
    if (!INV) { b = __builtin_elementwise_fma(s3.yx, pm, s1); d = __builtin_elementwise_fma(s3.yx, mp, s1); }
    else      { b = __builtin_elementwise_fma(s3.yx, mp, s1); d = __builtin_elementwise_fma(s3.yx, pm, s1); }
}
template <bool INV> __device__ __forceinline__ void dft16(f32x2 (&v)[16]) {
#pragma unroll
    for (int n0 = 0; n0 < 4; ++n0) dft4<INV>(v[n0], v[4 + n0], v[8 + n0], v[12 + n0]);
    const float c1 = 0.9238795325112867f, s1 = 0.3826834323650898f, r2 = 0.7071067811865476f;
    const float cs[10] = {1.f, c1, r2, s1, 0.f, -s1, -r2, -c1, -1.f, -c1};
    const float sn[10] = {0.f, s1, r2, c1, 1.f, c1, r2, s1, 0.f, -s1};
#pragma unroll
    for (int k0 = 1; k0 < 4; ++k0)
#pragma unroll
        for (int n0 = 1; n0 < 4; ++n0) { const int m = n0 * k0; const f32x2 w = (f32x2){cs[m], INV ? sn[m] : -sn[m]}; v[4 * k0 + n0] = cmulp(v[4 * k0 + n0], w, (f32x2){-w.y, w.x}); }
#pragma unroll
    for (int k0 = 0; k0 < 4; ++k0) dft4<INV>(v[4 * k0], v[4 * k0 + 1], v[4 * k0 + 2], v[4 * k0 + 3]);
#pragma unroll
    for (int a = 0; a < 4; ++a)
#pragma unroll
        for (int b = a + 1; b < 4; ++b) { const f32x2 t = v[4 * a + b]; v[4 * a + b] = v[4 * b + a]; v[4 * b + a] = t; }
}
__device__ __forceinline__ int fphys(int i) { return i + (i >> 4); }
constexpr int FFT_BUF_BYTES = (4096 + 256) * 8;
struct FftTw { f32x2 wA, wB; };
__device__ __forceinline__ FftTw fft_tw(int ht) { FftTw t; float s, c; sincospif(-(float)ht / 2048.0f, &s, &c); t.wA = (f32x2){c, s}; sincospif(-(float)(ht & 15) / 128.0f, &s, &c); t.wB = (f32x2){c, s}; return t; }
template <bool CONJ> __device__ __forceinline__ void tw_apply(f32x2 (&v)[16], f32x2 w1) {
    if (CONJ) w1 = rot_i(w1).yx;
    const f32x2 w2 = cmulq(w1, w1), w3 = cmulq(w2, w1), w4 = cmulq(w2, w2), w5 = cmulq(w4, w1), w6 = cmulq(w4, w2), w7 = cmulq(w4, w3), w8 = cmulq(w4, w4);
    v[1] = cmulq(v[1], w1); v[2] = cmulq(v[2], w2); v[3] = cmulq(v[3], w3); v[4] = cmulq(v[4], w4); v[5] = cmulq(v[5], w5); v[6] = cmulq(v[6], w6); v[7] = cmulq(v[7], w7); v[8] = cmulq(v[8], w8);
    const f32x2 i8 = rot_i(w8);
    v[9] = cmulq(v[9], cmulp(w1, w8, i8)); v[10] = cmulq(v[10], cmulp(w2, w8, i8)); v[11] = cmulq(v[11], cmulp(w3, w8, i8)); v[12] = cmulq(v[12], cmulp(w4, w8, i8));
    v[13] = cmulq(v[13], cmulp(w5, w8, i8)); v[14] = cmulq(v[14], cmulp(w6, w8, i8)); v[15] = cmulq(v[15], cmulp(w7, w8, i8));
}
struct NoHook { template <int SET> __device__ __forceinline__ void act() {} };
struct NoPf { __device__ __forceinline__ void operator()() const {} };
template <int A0, int A1, class HK, class PF> __device__ __forceinline__ void fft_fwd(f32x2 (&v)[16], LAS f32x2* buf, int ht, const FftTw& tw_, HK& hk, const PF& pf) {
    FftTw tw = tw_; asm volatile("" : "+v"(ht), "+v"(tw.wA.x), "+v"(tw.wA.y), "+v"(tw.wB.x), "+v"(tw.wB.y));
    dft16<false>(v);
    tw_apply<false>(v, tw.wA);
#pragma unroll
    for (int k = 0; k < 16; ++k) buf[fphys(256 * k + ht)] = v[k];
    __syncthreads(); if (A0 >= 0) hk.template act<(A0 > 0)>();
    const int ka = ht >> 4, s = ht & 15;
#pragma unroll
    for (int b = 0; b < 16; ++b) v[b] = buf[fphys(256 * ka + 16 * b + s)];
    dft16<false>(v);
    tw_apply<false>(v, tw.wB);
#pragma unroll
    for (int k = 0; k < 16; ++k) buf[fphys(256 * ka + 16 * k + s)] = v[k];
    pf();
    __syncthreads(); if (A1 >= 0) hk.template act<(A1 > 0)>();
#pragma unroll
    for (int q = 0; q < 16; ++q) v[q] = buf[fphys(16 * ht + q)];
    dft16<false>(v);
}
template <int A0, int A1, int A2, class HK> __device__ __forceinline__ void fft_inv(f32x2 (&v)[16], LAS f32x2* buf, int ht, const FftTw& tw_, HK& hk) {
    FftTw tw = tw_; asm volatile("" : "+v"(ht), "+v"(tw.wA.x), "+v"(tw.wA.y), "+v"(tw.wB.x), "+v"(tw.wB.y));
    dft16<true>(v);
#pragma unroll
    for (int q = 0; q < 16; ++q) buf[fphys(16 * ht + q)] = v[q];
    __syncthreads(); if (A0 >= 0) hk.template act<(A0 > 0)>();
    const int ka = ht >> 4, s = ht & 15;
#pragma unroll
    for (int k = 0; k < 16; ++k) v[k] = buf[fphys(256 * ka + 16 * k + s)];
    tw_apply<true>(v, tw.wB);
    dft16<true>(v);
#pragma unroll
    for (int b = 0; b < 16; ++b) buf[fphys(256 * ka + 16 * b + s)] = v[b];
    __syncthreads(); if (A1 >= 0) hk.template act<(A1 > 0)>();
#pragma unroll
    for (int k = 0; k < 16; ++k) v[k] = buf[fphys(256 * k + ht)];
    tw_apply<true>(v, tw.wA);
    dft16<true>(v);
    __syncthreads(); if (A2 >= 0) hk.template act<(A2 > 0)>();
}

__device__ __forceinline__ void p1_phase(Frame& F) {
    const KargP in = karg_opaque(F.in);
    const int gw = F.bid * NWAVES + F.wave, NGW = F.G * NWAVES;
    const float* mod = WSP(float, WS_MOD);
    {
        f32x4 pg[8], pb[8];
#pragma unroll
        for (int j = 0; j < 8; ++j) { pg[j] = *(const f32x4*)(in[I_LNG] + F.lane * 4 + 256 * j); pb[j] = *(const f32x4*)(in[I_LNB] + F.lane * 4 + 256 * j); }
#pragma unroll 1
        for (int grp = gw; grp < MALL / 8; grp += NGW) {
            const int row0 = grp * 8; const bool lat = row0 < MTOK;
            const float* xb = lat ? in[I_X] + (size_t)row0 * DM : in[I_CTX] + (size_t)(row0 - MTOK) * DM;
            const float* mv = mod + (size_t)(lat ? row0 / SEQ : 8) * 12288;
            f32x4 psh[8], psc[8];
#pragma unroll
            for (int j = 0; j < 8; ++j) { psh[j] = *(const f32x4*)(mv + F.lane * 4 + 256 * j); psc[j] = *(const f32x4*)(mv + 2048 + F.lane * 4 + 256 * j) + 1.0f; }
            f32x4 v[8], vn[8];
#pragma unroll
            for (int j = 0; j < 8; ++j) v[j] = *(const f32x4*)(xb + F.lane * 4 + 256 * j);
#pragma unroll 1
            for (int ri = 0; ri < 8; ++ri) {
                const float* xn = xb + (size_t)(ri < 7 ? ri + 1 : ri) * DM;
#pragma unroll
                for (int j = 0; j < 8; ++j) vn[j] = *(const f32x4*)(xn + F.lane * 4 + 256 * j);
                float s = 0.f;
#pragma unroll
                for (int j = 0; j < 8; ++j) s += (v[j].x + v[j].y) + (v[j].z + v[j].w);
                const float mean = wave_sum(s) * (1.f / DM); float s2 = 0.f;
#pragma unroll
                for (int j = 0; j < 8; ++j) { v[j] = v[j] - mean; s2 += (v[j].x * v[j].x + v[j].y * v[j].y) + (v[j].z * v[j].z + v[j].w * v[j].w); }
                const float rstd = 1.f / sqrtf(wave_sum(s2) * (1.f / DM) + LN_EPS);
                const int row = row0 + ri;
                if (lat && F.lane == 0) { WSP(float, WS_STATS)[row * 2] = mean; WSP(float, WS_STATS)[row * 2 + 1] = rstd; }
                bf16_t* orow = WSP(bf16_t, WS_HX) + (size_t)row * DM;
#pragma unroll
                for (int j = 0; j < 8; ++j) { const f32x4 y = (v[j] * rstd * pg[j] + pb[j]) * psc[j] + psh[j];
                    u32x2 o; o.x = pk2(y.x, y.y); o.y = pk2(y.z, y.w); *(u32x2*)(orow + F.lane * 4 + 256 * j) = o;
                    if (lat) *(unsigned*)(WSP(unsigned char, WS_HX8) + (size_t)row * DM + F.lane * 4 + 256 * j) = pk4_fp8(y.x, y.y, y.z, y.w); }
#pragma unroll
                for (int j = 0; j < 8; ++j) v[j] = vn[j];
            }
        }
    }
    const int hb = F.tid >> 8, ht = F.tid & 255;
    LAS f32x2* buf = (LAS f32x2*)(F.lds + hb * FFT_BUF_BYTES);
    const FftTw tw = fft_tw(ht);
    const float* htaps = WSP(float, WS_HTAPS);
    for (int u0 = F.bid * 2; u0 < 2048; u0 += F.G * 2) {
        const int un = u0 + hb, c = un >> 1, n = un & 1;
        const float* hf = htaps + (size_t)((n * 2 + 0) * 1024 + c) * SEQ, * hbk = htaps + (size_t)((n * 2 + 1) * 1024 + c) * SEQ;
        f32x2 v[16];
#pragma unroll
        for (int a = 0; a < 16; ++a) { const int i = 256 * a + ht; float x;
            if (a < 8) x = hf[i]; else if (i == 2048) x = 0.f; else x = hbk[4096 - i];
            v[a] = (f32x2){x * (1.0f / 4096.0f), 0.f}; }
        { NoHook nh; fft_fwd<-1, -1>(v, buf, ht, tw, nh, NoPf{}); }
        unsigned* Hd = WSP(unsigned, WS_H) + (size_t)un * 4096;
#pragma unroll
        for (int ks = 0; ks < 16; ++ks) Hd[ks * 256 + ht] = pk2(v[ks].x, v[ks].y);
        __syncthreads();
    }
}

template <bool F8> struct SchedZ {
    static constexpr bool GATHER = false;
    int G, c; const char* hx; const char* win;
    static constexpr size_t P = F8 ? DM : 2 * DM;
    __device__ __forceinline__ bool next(int i, Unit& u) const {
        int L = i * G + c;
        if (!F8) {
            if (L < 320) { int pn; pg8::decode_tile(L, 64, 5, u.pm, pn); u.pn = pn < 4 ? pn : 28; u.ex = 0; return true; } L -= 320;
            if (L < 72) { int pm, pn; pg8::decode_tile(L, 8, 9, pm, pn); u.pm = 64 + pm; u.pn = pn < 8 ? pn : 28; u.ex = 0; return true; }
            return false;
        } else {
            if (L < 1536) { int pn; pg8::decode_tile(L, 64, 24, u.pm, pn); u.pn = 4 + pn; u.ex = 0; return true; } L -= 1536;
            if (L < 768) { pg8::decode_tile(L, 12, 64, u.pm, u.pn); u.ex = 1; return true; }
            return false;
        }
    }
    __device__ __forceinline__ const char* a_base(const Unit& u) const { return u.ex ? win + (size_t)(WIN_HY0 + 256 * u.pm) * P : hx + (size_t)(256 * u.pm) * P; }
    __device__ __forceinline__ const char* b_base(const Unit& u) const { return u.ex ? hx + (size_t)(256 * u.pn) * P : win + (size_t)(256 * u.pn) * P; }
    __device__ __forceinline__ int a_row(const Unit&, int R) const { return R; }
};
struct EpiZ {
    static constexpr bool PERM = true;
    bf16_t* Z; bf16_t* ZT; const float* bias;
    __device__ __forceinline__ void operator()(const f32x4 (&acc)[2][2][4][2], const Unit& u, int wr, int wc, int fr, int fq) const {
        if (u.ex == 0) {
            const int row0 = u.pm * 256 + wr * 64 + fr, col0 = u.pn * 256 + wc * 32 + 8 * fq;
            f32x4 bv[2][2];
#pragma unroll
            for (int bj = 0; bj < 2; ++bj)
#pragma unroll
                for (int n = 0; n < 2; ++n) bv[bj][n] = *(const f32x4*)(bias + col0 + bj * 128 + 4 * n);
#pragma unroll
            for (int ai = 0; ai < 2; ++ai)
#pragma unroll
                for (int m = 0; m < 4; ++m) { bf16_t* rowp = Z + (size_t)(row0 + ai * 128 + m * 16) * ZN + col0;
#pragma unroll
                    for (int bj = 0; bj < 2; ++bj) { const f32x4 v0 = acc[ai][bj][m][0] + bv[bj][0], v1 = acc[ai][bj][m][1] + bv[bj][1];
                        u32x4 w; w.x = pg8::cvt_pk_bf16(v0[0], v0[1]); w.y = pg8::cvt_pk_bf16(v0[2], v0[3]); w.z = pg8::cvt_pk_bf16(v1[0], v1[1]); w.w = pg8::cvt_pk_bf16(v1[2], v1[3]);
                        *(u32x4*)(rowp + bj * 128) = w; } }
        } else {
            const int ch0 = u.pm * 256 + wr * 64 + fr, b = u.pn >> 3, t0 = (u.pn & 7) * 256 + wc * 32 + 8 * fq;
            float bbv[8];
#pragma unroll
            for (int r = 0; r < 8; ++r) bbv[r] = bias[WIN_HY0 + ch0 + (r >> 2) * 128 + (r & 3) * 16];
#pragma unroll
            for (int ai = 0; ai < 2; ++ai)
#pragma unroll
                for (int m = 0; m < 4; ++m) { const int ch = ch0 + ai * 128 + m * 16; const float bb = bbv[ai * 4 + m];
                    bf16_t* rowp = ZT + ((size_t)b * 3072 + ch) * SEQ + t0;
#pragma unroll
                    for (int bj = 0; bj < 2; ++bj) { const f32x4 v0 = acc[ai][bj][m][0] + bb, v1 = acc[ai][bj][m][1] + bb;
                        u32x4 w; w.x = pg8::cvt_pk_bf16(v0[0], v0[1]); w.y = pg8::cvt_pk_bf16(v0[2], v0[3]); w.z = pg8::cvt_pk_bf16(v1[0], v1[1]); w.w = pg8::cvt_pk_bf16(v1[2], v1[3]);
                        *(u32x4*)(rowp + bj * 128) = w; } }
        }
    }
};

__device__ __forceinline__ void p3_phase(Frame& F) {
    const KargP in = karg_opaque(F.in);
    const bf16_t* Z = WSP(bf16_t, WS_Z); bf16_t* U = WSP(bf16_t, WS_U);
    const float* cw = in[I_MCW]; const float* cb = in[I_MCB];
    const int c0 = (F.tid & 127) * 8;
    f32x4 w0[9], w1[9];
#pragma unroll
    for (int q = 0; q < 9; ++q) { w0[q] = *(const f32x4*)(cw + q * MW + c0); w1[q] = *(const f32x4*)(cw + q * MW + c0 + 4); }
    const f32x4 b0 = *(const f32x4*)(cb + c0), b1 = *(const f32x4*)(cb + c0 + 4);
#pragma unroll 1
    for (int it = F.bid * NTHR + F.tid; it < MALL * 128; it += F.G * NTHR) {
        const int row = it >> 7;
        const bool lat = row < MTOK;
        int base, y, x, H, Wd;
        if (lat) { const int t = row & (SEQ - 1); base = row - t; y = t >> 6; x = t & 63; H = 32; Wd = 64; }
        else { const int t = (row - MTOK) & (CTX - 1); base = row - t; y = 0; x = t; H = 1; Wd = CTX; }
        u32x4 zz[9]; bool ok[9];
#pragma unroll
        for (int q = 0; q < 9; ++q) { const int yy = y + q / 3 - 1, xx = x + q % 3 - 1; ok[q] = yy >= 0 && yy < H && xx >= 0 && xx < Wd;
            const int srow = ok[q] ? base + yy * Wd + xx : row;
            zz[q] = *(const u32x4*)(Z + (size_t)srow * ZN + ZC_QK + c0); }
        f32x4 a0 = b0, a1 = b1;
#pragma unroll
        for (int q = 0; q < 9; ++q) { const float m = ok[q] ? 1.f : 0.f;
            a0 += (f32x4){bflo(zz[q].x), bfhi(zz[q].x), bflo(zz[q].y), bfhi(zz[q].y)} * w0[q] * m;
            a1 += (f32x4){bflo(zz[q].z), bfhi(zz[q].z), bflo(zz[q].w), bfhi(zz[q].w)} * w1[q] * m; }
        float a[8] = {a0.x, a0.y, a0.z, a0.w, a1.x, a1.y, a1.z, a1.w};
#pragma unroll
        for (int j = 0; j < 8; ++j) a[j] = a[j] * sigmoid_fast(a[j]);
        u32x4 o; o.x = pk2(a[0], a[1]); o.y = pk2(a[2], a[3]); o.z = pk2(a[4], a[5]); o.w = pk2(a[6], a[7]);
        *(u32x4*)(U + (size_t)row * MW + c0) = o;
    }
}

struct SchedQK {
    static constexpr bool GATHER = false;
    int G, c; const char* u; const char* w;
    __device__ __forceinline__ bool next(int i, Unit& un) const { const int L = i * G + c; if (L >= 72 * 8) return false; pg8::decode_tile(L, 72, 8, un.pm, un.pn); un.ex = 0; return true; }
    __device__ __forceinline__ const char* a_base(const Unit& un) const { return u + ((size_t)(256 * un.pm) * MW + (un.pn >> 1) * 256) * 2; }
    __device__ __forceinline__ const char* b_base(const Unit& un) const { return w + (size_t)(256 * un.pn) * 256 * 2; }
    __device__ __forceinline__ int a_row(const Unit&, int R) const { return R; }
};
struct EpiQK {
    static constexpr bool PERM = true;
    bf16_t* O;
    __device__ __forceinline__ void operator()(const f32x4 (&acc)[2][2][4][2], const Unit& u, int wr, int wc, int fr, int fq) const {
        const int row0 = u.pm * 256 + wr * 64 + fr, col0 = u.pn * 256 + wc * 32 + 8 * fq;
#pragma unroll
        for (int ai = 0; ai < 2; ++ai)
#pragma unroll
            for (int m = 0; m < 4; ++m) { bf16_t* rowp = O + (size_t)(row0 + ai * 128 + m * 16) * 2048 + col0;
#pragma unroll
                for (int bj = 0; bj < 2; ++bj) { const f32x4 v0 = acc[ai][bj][m][0], v1 = acc[ai][bj][m][1];
                    u32x4 w; w.x = pg8::cvt_pk_bf16(v0[0], v0[1]); w.y = pg8::cvt_pk_bf16(v0[2], v0[3]); w.z = pg8::cvt_pk_bf16(v1[0], v1[1]); w.w = pg8::cvt_pk_bf16(v1[2], v1[3]);
                    *(u32x4*)(rowp + bj * 128) = w; } }
    }
};

constexpr int ML_QS = 264, ML_VS = 72, ML_PS = 72;
constexpr int ML_Q = 0, ML_K = ML_Q + 64 * ML_QS * 2, ML_V = ML_K + 64 * ML_QS * 2, ML_C = ML_V + 64 * ML_VS * 2, ML_P = ML_C + 80 * ML_QS * 2, ML_VT = ML_P + 64 * ML_PS * 2, ML_SC = ML_VT + 80 * ML_VS * 2;
constexpr int ML_SA = ML_SC, ML_SDEN = ML_SC + 4096, ML_END = ML_SC + 4096 + 256;
static_assert(ML_END <= MISC_OFF, "mlstm LDS");
__device__ __forceinline__ bf16x8 lds_frag(const LAS bf16_t* p) { return *(const LAS bf16x8*)p; }
__device__ __forceinline__ void mlstm_unit(Frame& F, int un) {
    const int vs = un & 3, dir = (un >> 2) & 1, h = (un >> 3) & 3, b = un >> 5;
    const bf16_t* Z = WSP(bf16_t, WS_Z); const bf16_t* QK = WSP(bf16_t, WS_QKB); unsigned char* AM = WSP(unsigned char, WS_AM);
    LAS unsigned char* lds = F.lds;
    LAS bf16_t* Qs = (LAS bf16_t*)(lds + ML_Q); LAS bf16_t* Ks = (LAS bf16_t*)(lds + ML_K); LAS bf16_t* Vs = (LAS bf16_t*)(lds + ML_V);
    LAS bf16_t* Cs = (LAS bf16_t*)(lds + ML_C); LAS bf16_t* Ps = (LAS bf16_t*)(lds + ML_P); LAS bf16_t* VT = (LAS bf16_t*)(lds + ML_VT);
    LAS float* sDEN = (LAS float*)(lds + ML_SDEN);
    LAS float* sc0 = (LAS float*)(lds + ML_SA);
    const int tid = F.tid, lane = F.lane, w = F.wave, l15 = lane & 15, g4 = lane >> 4;
    __syncthreads();
    for (int i = tid; i < 80 * ML_QS / 2; i += NTHR) ((LAS unsigned*)Cs)[i] = 0u;
    if (tid < 64) { Vs[tid * ML_VS + 64] = (bf16_t)0x3F80; for (int j = 65; j < ML_VS; ++j) Vs[tid * ML_VS + j] = 0; }
    for (int i = tid; i < 16 * ML_VS; i += NTHR) VT[64 * ML_VS + i] = (i < 64) ? (bf16_t)0x3F80 : (bf16_t)0;
    f32x4 cacc[2][5];
#pragma unroll
    for (int a = 0; a < 2; ++a)
#pragma unroll
        for (int c = 0; c < 5; ++c) cacc[a][c] = (f32x4){0.f, 0.f, 0.f, 0.f};
    float m_run = 0.f;
    u32x4 pq[4], pk[4], pv; unsigned pgate = 0u, pgate2 = 0u;
#define ML_ROW0(st) ((st) < 4 ? (MTOK + b * CTX + 64 * (dir ? 3 - (st) : (st))) : (b * SEQ + 64 * (dir ? 35 - (st) : (st) - 4)))
#define ML_LOAD(st) do { const int r0_ = ML_ROW0(st); \
        _Pragma("unroll") for (int q_ = 0; q_ < 4; ++q_) { const int p_ = tid + 512 * q_, rr_ = p_ >> 5, cc_ = (p_ & 31) * 8; \
            pq[q_] = *(const u32x4*)(QK + (size_t)(r0_ + rr_) * 2048 + h * 512 + cc_); pk[q_] = *(const u32x4*)(QK + (size_t)(r0_ + rr_) * 2048 + h * 512 + 256 + cc_); } \
        { const int rr_ = tid >> 3, cc_ = (tid & 7) * 8; pv = *(const u32x4*)(Z + (size_t)(r0_ + rr_) * ZN + ZC_V + h * 256 + vs * 64 + cc_); } \
        if (tid < 64) { const bf16_t* gp_ = Z + (size_t)(r0_ + tid) * ZN + ZC_GT + dir * 8 + h; pgate = gp_[0]; pgate2 = gp_[4]; } } while (0)
#define ML_STORE() do { \
        _Pragma("unroll") for (int q_ = 0; q_ < 4; ++q_) { const int p_ = tid + 512 * q_, rr_ = p_ >> 5, cc_ = (p_ & 31) * 8; \
            *(LAS u32x4*)(Qs + rr_ * ML_QS + cc_) = pq[q_]; *(LAS u32x4*)(Ks + rr_ * ML_QS + cc_) = pk[q_]; } \
        { const int rr_ = tid >> 3, cc_ = (tid & 7) * 8; *(LAS u32x4*)(Vs + rr_ * ML_VS + cc_) = pv; \
          VT[(cc_ + 0) * ML_VS + rr_] = (bf16_t)(pv.x & 0xffffu); VT[(cc_ + 1) * ML_VS + rr_] = (bf16_t)(pv.x >> 16); VT[(cc_ + 2) * ML_VS + rr_] = (bf16_t)(pv.y & 0xffffu); VT[(cc_ + 3) * ML_VS + rr_] = (bf16_t)(pv.y >> 16); \
          VT[(cc_ + 4) * ML_VS + rr_] = (bf16_t)(pv.z & 0xffffu); VT[(cc_ + 5) * ML_VS + rr_] = (bf16_t)(pv.z >> 16); VT[(cc_ + 6) * ML_VS + rr_] = (bf16_t)(pv.w & 0xffffu); VT[(cc_ + 7) * ML_VS + rr_] = (bf16_t)(pv.w >> 16); } } while (0)
#define ML_SCALARS(stp) do { LAS float* sb_ = sc0 + ((stp) & 1) * 512; \
              \
            float li = bf2f(pgate), zf = bf2f(pgate2); \
            if (dir) { li = __shfl(li, 63 - lane); zf = __shfl(zf, 63 - lane); } \
            const float lf = fminf(zf, 0.f) - log1pf(__expf(-fabsf(zf))); \
            const float bcs = wave_scan_sum(lf); \
            const float a = li - bcs; \
            const float am = wave_scan_max(a); \
            const float inter = bcs + m_run; \
            const float mt = fmaxf(inter, bcs + am); \
            const float b_end = lane_bcast(bcs, 63); \
            const float gg = b_end - bcs + li; \
            const float gm = lane_bcast(wave_scan_max(gg), 63); \
            const float m_new = fmaxf(b_end + m_run, gm); \
            const int pos_ = dir ? 63 - lane : lane; \
            sb_[pos_] = a; sb_[64 + pos_] = bcs - mt; sb_[128 + pos_] = __expf(inter - mt); sb_[192 + pos_] = __expf(gg - m_new); sb_[256 + pos_] = __expf(-mt); \
            if (lane == 0) sb_[320] = __expf(b_end + m_run - m_new); \
            m_run = m_new; } while (0)
    ML_LOAD(0);
    __syncthreads();
    if (w == 0) ML_SCALARS(0);
    const int tt = w & 3; const int nv = (w < 4) ? 3 : 2;
#pragma unroll 1
    for (int st = 0; st < 36; ++st) {
        ML_STORE();
        LAS float* sA = sc0 + (st & 1) * 512; LAS float* sU = sA + 64; LAS float* sSI = sA + 128; LAS float* sWG = sA + 192; LAS float* sEM = sA + 256; LAS float* sMI = sA + 320;
        const int row0 = ML_ROW0(st);
        if (st + 1 < 36) ML_LOAD(st + 1);
        __syncthreads();
        {
            f32x4 sacc[2] = {(f32x4){0.f, 0.f, 0.f, 0.f}, (f32x4){0.f, 0.f, 0.f, 0.f}};
#pragma unroll
            for (int ks = 0; ks < 8; ++ks) {
                const bf16x8 qf = lds_frag(Qs + (16 * tt + l15) * ML_QS + 32 * ks + 8 * g4);
#pragma unroll
                for (int j = 0; j < 2; ++j) { const int stl = 2 * (w >> 2) + j;
                    const bf16x8 kf = lds_frag(Ks + (16 * stl + l15) * ML_QS + 32 * ks + 8 * g4);
                    sacc[j] = __builtin_amdgcn_mfma_f32_16x16x32_bf16(kf, qf, sacc[j], 0, 0, 0); }
            }
            const int t = 16 * tt + l15; const float ut = sU[t];
#pragma unroll
            for (int j = 0; j < 2; ++j) { const int s0 = 16 * (2 * (w >> 2) + j) + 4 * g4;
                const f32x4 av = *(const LAS f32x4*)(sA + s0);
                float pvv[4];
#pragma unroll
                for (int r = 0; r < 4; ++r) { const int s = s0 + r; const bool ok = dir ? (s >= t) : (s <= t); pvv[r] = ok ? sacc[j][r] * __expf(ut + av[r]) : 0.f; }
                u32x2 o; o.x = pk2(pvv[0], pvv[1]); o.y = pk2(pvv[2], pvv[3]);
                *(LAS u32x2*)(Ps + t * ML_PS + s0) = o; }
        }
        __syncthreads();
        unsigned og[2][4];
        if (st >= 4) {
#pragma unroll
            for (int j = 0; j < 2; ++j) { const int vt_ = (w < 4) ? j : 2 + j;
#pragma unroll
                for (int r = 0; r < 4; ++r) og[j][r] = Z[(size_t)(row0 + 16 * tt + 4 * g4 + r) * ZN + ZC_O + h * 256 + vs * 64 + 16 * vt_ + l15]; } }
        f32x4 nacc[3], iacc[3];
#pragma unroll
        for (int j = 0; j < 3; ++j) { nacc[j] = (f32x4){0.f, 0.f, 0.f, 0.f}; iacc[j] = (f32x4){0.f, 0.f, 0.f, 0.f}; }
#pragma unroll
        for (int ks = 0; ks < 8; ++ks) {
            const bf16x8 qf = lds_frag(Qs + (16 * tt + l15) * ML_QS + 32 * ks + 8 * g4);
#pragma unroll
            for (int j = 0; j < 3; ++j) if (j < nv) { const int vt = (w < 4) ? (j == 2 ? 4 : j) : 2 + j;
                const bf16x8 cf = lds_frag(Cs + (16 * vt + l15) * ML_QS + 32 * ks + 8 * g4);
                iacc[j] = __builtin_amdgcn_mfma_f32_16x16x32_bf16(qf, cf, iacc[j], 0, 0, 0); }
        }
#pragma unroll
        for (int ks = 0; ks < 2; ++ks) {
            const bf16x8 pf = lds_frag(Ps + (16 * tt + l15) * ML_PS + 32 * ks + 8 * g4);
#pragma unroll
            for (int j = 0; j < 3; ++j) if (j < nv) { const int vt = (w < 4) ? (j == 2 ? 4 : j) : 2 + j;
                const bf16x8 vf = lds_frag(VT + (16 * vt + l15) * ML_VS + 32 * ks + 8 * g4);
                nacc[j] = __builtin_amdgcn_mfma_f32_16x16x32_bf16(pf, vf, nacc[j], 0, 0, 0); }
        }
        const int t0 = 16 * tt + 4 * g4;
        {
            const f32x4 si = *(const LAS f32x4*)(sSI + t0);
#pragma unroll
            for (int j = 0; j < 3; ++j) if (j < nv) nacc[j] = nacc[j] + iacc[j] * si;
            if (w < 4 && l15 == 0) *(LAS f32x4*)(sDEN + t0) = nacc[2];
        }
        {
            const float decay = sMI[0];
#pragma unroll
            for (int a = 0; a < 2; ++a)
#pragma unroll
                for (int c = 0; c < 5; ++c) cacc[a][c] = cacc[a][c] * decay;
#pragma unroll
            for (int ks = 0; ks < 2; ++ks) {
                float wg[8];
#pragma unroll
                for (int e = 0; e < 8; ++e) wg[e] = sWG[32 * ks + 8 * g4 + e];
                bf16x8 kf[2];
#pragma unroll
                for (int a = 0; a < 2; ++a) { float x[8];
#pragma unroll
                    for (int e = 0; e < 8; ++e) x[e] = bf2f((unsigned)Ks[(32 * ks + 8 * g4 + e) * ML_QS + 16 * (2 * w + a) + l15]) * wg[e];
                    u32x4 o; o.x = pk2(x[0], x[1]); o.y = pk2(x[2], x[3]); o.z = pk2(x[4], x[5]); o.w = pk2(x[6], x[7]);
                    kf[a] = __builtin_bit_cast(bf16x8, o); }
#pragma unroll
                for (int c = 0; c < 5; ++c) {
                    const bf16x8 vf = lds_frag(VT + (16 * c + l15) * ML_VS + 32 * ks + 8 * g4);
#pragma unroll
                    for (int a = 0; a < 2; ++a) cacc[a][c] = __builtin_amdgcn_mfma_f32_16x16x32_bf16(kf[a], vf, cacc[a][c], 0, 0, 0);
                }
            }
        }
        __syncthreads();
        if (w == 0 && st + 1 < 36) ML_SCALARS(st + 1);
        if (st >= 4) {
            const f32x4 dn = *(const LAS f32x4*)(sDEN + t0), em = *(const LAS f32x4*)(sEM + t0);
#pragma unroll
            for (int j = 0; j < 2; ++j) { const int vt = (w < 4) ? j : 2 + j; const int col = h * 256 + vs * 64 + 16 * vt + l15;
#pragma unroll
                for (int r = 0; r < 4; ++r) { const int row = row0 + t0 + r;
                    const float hv = nacc[j][r] * __builtin_amdgcn_rcpf(fmaxf(fabsf(dn[r]), em[r]));
                    const float o = __builtin_amdgcn_rcpf(1.0f + __expf(-bf2f(og[j][r])));
                    AM[(size_t)row * 2048 + dir * 1024 + col] = (unsigned char)(pk4_fp8(fminf(fmaxf(o * hv, -448.f), 448.f), 0.f, 0.f, 0.f) & 0xffu); } }
        }
#pragma unroll
        for (int a = 0; a < 2; ++a)
#pragma unroll
            for (int c = 0; c < 5; ++c) { u32x2 o; o.x = pk2(cacc[a][c][0], cacc[a][c][1]); o.y = pk2(cacc[a][c][2], cacc[a][c][3]);
                *(LAS u32x2*)(Cs + (16 * c + l15) * ML_QS + 16 * (2 * w + a) + 4 * g4) = o; }
    }
    __syncthreads();
#undef ML_LOAD
#undef ML_STORE
#undef ML_ROW0
#undef ML_SCALARS
}

constexpr int CVH_E0 = 11;
constexpr int CVH_NITEMS = (NEXP - CVH_E0) * 768;
constexpr int CVH_KG_BYTES = 1040, CVH_TILE_BYTES = 16 * CVH_KG_BYTES;
struct CvHook {
    KargP in; unsigned char* ws; LAS unsigned char* tiles; int tid, bid, G, kmax; int s;
    f32x4 v[2][8];
    __device__ __forceinline__ void decode(int h, const float*& src, unsigned char*& dst, int& rstep) const {
        const int e = CVH_E0 + h / 768, q = h % 768;
        if (q < 512) { const int up = q & 1, g = (q >> 1) & 7, kb = q >> 4;
            src = (up ? in[I_WU] : in[I_WG]) + (size_t)e * DM * DM + (size_t)(64 * kb) * DM + 256 * g;
            dst = ws + WS_WGU + ((size_t)e * 4096 + 512 * g + up * 128) * DM + 64 * kb; rstep = 256; }
        else { const int q2 = q - 512, g = q2 & 7, kb = q2 >> 3;
            src = in[I_WDN] + (size_t)e * DM * DM + (size_t)(64 * kb) * DM + 256 * g;
            dst = ws + WS_WD + ((size_t)e * 2048 + 256 * g) * DM + 64 * kb; rstep = 128; }
    }
    __device__ __forceinline__ int item(int k) const { return (k < kmax ? k : kmax) * G + bid; }
    template <int SET> __device__ __forceinline__ void request(int k) {
        const float* src; unsigned char* dst; int rs; decode(item(k), src, dst, rs);
        const int w = tid >> 6, lane = tid & 63;
#pragma unroll
        for (int i = 0; i < 8; ++i) v[SET][i] = __builtin_nontemporal_load((const f32x4*)(src + (size_t)(8 * w + i) * DM + 4 * lane));
    }
    template <int SET> __device__ __forceinline__ void act() {
        const int k = s; s = k + 1;
        const int w = tid >> 6, lane = tid & 63;
        {
            const float sc = (item(k - 2) % 768) < 512 ? 32.f : 64.f;
            LAS unsigned char* t = tiles + SET * CVH_TILE_BYTES;
#pragma unroll
            for (int g = 0; g < 2; ++g) { u32x4 o;
                o.x = pk4_fp8(v[SET][4 * g][0] * sc, v[SET][4 * g + 1][0] * sc, v[SET][4 * g + 2][0] * sc, v[SET][4 * g + 3][0] * sc); o.y = pk4_fp8(v[SET][4 * g][1] * sc, v[SET][4 * g + 1][1] * sc, v[SET][4 * g + 2][1] * sc, v[SET][4 * g + 3][1] * sc);
                o.z = pk4_fp8(v[SET][4 * g][2] * sc, v[SET][4 * g + 1][2] * sc, v[SET][4 * g + 2][2] * sc, v[SET][4 * g + 3][2] * sc); o.w = pk4_fp8(v[SET][4 * g][3] * sc, v[SET][4 * g + 1][3] * sc, v[SET][4 * g + 2][3] * sc, v[SET][4 * g + 3][3] * sc);
                *(LAS u32x4*)(t + (2 * w + g) * CVH_KG_BYTES + 16 * lane) = o; }
        }
        request<SET>(k);
        {
            const float* src; unsigned char* dst; int rs; decode(item(k >= 3 ? k - 3 : 0), src, dst, rs);
            if (k < 3) { dst = ws + WS_DUMMY; rs = 128; }
            const LAS unsigned char* t = tiles + (1 - SET) * CVH_TILE_BYTES;
#pragma unroll
            for (int q = 0; q < 2; ++q) { const int idx = tid + 512 * q, row = idx >> 2, piece = idx & 3;
                const LAS unsigned char* tp = t + (4 * piece) * CVH_KG_BYTES + 4 * row;
                u32x4 o; o.x = *(const LAS unsigned*)(tp); o.y = *(const LAS unsigned*)(tp + CVH_KG_BYTES); o.z = *(const LAS unsigned*)(tp + 2 * CVH_KG_BYTES); o.w = *(const LAS unsigned*)(tp + 3 * CVH_KG_BYTES);
                *(u32x4*)(dst + (size_t)((row >> 7) * rs + (row & 127)) * DM + 16 * piece) = o; }
        }
    }
};
struct HPf {
    const unsigned* Hd; int ht; unsigned (&h)[16];
    __device__ __forceinline__ void operator()() const {
#pragma unroll
        for (int ks = 0; ks < 16; ++ks) h[ks] = Hd[ks * 256 + ht];
    }
};

constexpr int HY_RAW = 2 * FFT_BUF_BYTES, HY_OUT = HY_RAW + 16384, HY_CVT = HY_OUT + 32768, HY_COEF = HY_CVT + 2 * CVH_TILE_BYTES, HY_END = HY_COEF + 512;
static_assert(HY_END <= MISC_OFF, "hyena LDS");
__device__ __forceinline__ void hy_conv_to_buf(const LAS bf16_t* raw, LAS f32x2* buf, const LAS float* cf, int kind, int ht) {
    float w9[9]; const float bias = cf[27 + kind];
#pragma unroll
    for (int q = 0; q < 9; ++q) w9[q] = cf[9 * kind + q];
    asm volatile("" : "+v"(ht));
    const int t0 = 8 * ht, y = t0 >> 6, x0 = t0 & 63;
    float acc[2][8];
#pragma unroll
    for (int bb = 0; bb < 2; ++bb)
#pragma unroll
        for (int i = 0; i < 8; ++i) acc[bb][i] = bias;
#pragma unroll
    for (int dy = -1; dy <= 1; ++dy) {
        const int yy = y + dy;
        if (yy >= 0 && yy < 32) {
#pragma unroll
            for (int bb = 0; bb < 2; ++bb) {
                const LAS bf16_t* base = raw + bb * 2048 + t0 + 64 * dy;
                const u32x4 mid = *(const LAS u32x4*)base;
                float vals[10];
                vals[0] = (x0 > 0) ? bf2f((unsigned)base[-1]) : 0.f; vals[9] = (x0 + 8 < 64) ? bf2f((unsigned)base[8]) : 0.f;
                vals[1] = bflo(mid.x); vals[2] = bfhi(mid.x); vals[3] = bflo(mid.y); vals[4] = bfhi(mid.y); vals[5] = bflo(mid.z); vals[6] = bfhi(mid.z); vals[7] = bflo(mid.w); vals[8] = bfhi(mid.w);
                const float wl = w9[(dy + 1) * 3], wm = w9[(dy + 1) * 3 + 1], wr_ = w9[(dy + 1) * 3 + 2];
#pragma unroll
                for (int i = 0; i < 8; ++i) acc[bb][i] += wl * vals[i] + wm * vals[i + 1] + wr_ * vals[i + 2];
            }
        }
    }
#pragma unroll
    for (int i = 0; i < 8; ++i) buf[fphys(t0 + i)] = (f32x2){acc[0][i], acc[1][i]};
}
__device__ __forceinline__ float hy_coef_load(KargP in, int c, int ht) {
    const int i = ht & 31;
    if (i < 27) { const int kind = i / 9, q = i % 9; const int ch = (kind == 0 ? 2048 : kind == 1 ? 0 : 1024) + c; return in[I_HCW][q * 3072 + ch]; }
    if (i < 30) { const int kind = i - 27; return in[I_HCB][(kind == 0 ? 2048 : kind == 1 ? 0 : 1024) + c]; }
    return in[I_HSKIP][(i - 30) * 1024 + c];
}
__device__ __forceinline__ void hyena_unit(Frame& F, int un, CvHook& hk) {
    const KargP in = karg_opaque(F.in);
    const int cg = un >> 2, bp = un & 3, c0 = cg * 8, b0 = bp * 2;
    int tid_ = F.tid; asm volatile("" : "+v"(tid_));
    const int hb = tid_ >> 8, ht = tid_ & 255;
    LAS f32x2* buf = (LAS f32x2*)(F.lds + hb * FFT_BUF_BYTES);
    LAS bf16_t* raw = (LAS bf16_t*)(F.lds + HY_RAW + hb * 8192);
    LAS unsigned char* outT = (LAS unsigned char*)(F.lds + HY_OUT);
    const bf16_t* ZT = WSP(bf16_t, WS_ZT); const unsigned* H = WSP(unsigned, WS_H);
    const FftTw tw = fft_tw(ht);
    __syncthreads();
#define HY_FETCH(dst, kind, ch) do { _Pragma("unroll") for (int bb = 0; bb < 2; ++bb) dst[bb] = *(const u32x4*)(ZT + ((size_t)(b0 + bb) * 3072 + (kind) * 1024 + (ch)) * SEQ + ht * 8); } while (0)
#define HY_PUT(srcv) do { _Pragma("unroll") for (int bb = 0; bb < 2; ++bb) *(LAS u32x4*)(raw + bb * 2048 + ht * 8) = srcv[bb]; } while (0)
    u32x4 rv[2], rn[2];
    HY_FETCH(rv, 2, c0 + hb);
    LAS float* coef = (LAS float*)(F.lds + HY_COEF) + hb * 64;
    if (ht < 32) coef[ht] = hy_coef_load(in, c0 + hb, ht);
    float cpre = 0.f;
#pragma unroll 1
    for (int i = 0; i < 4; ++i) {
        const int cl = 2 * i + hb, c = c0 + cl;
        const LAS float* cf = coef + (i & 1) * 32;
        { int hto = ht; asm volatile("" : "+v"(hto));
          if (i < 3 && hto < 32) cpre = hy_coef_load(in, c + 2, hto); }
        HY_PUT(rv);
        HY_FETCH(rn, 0, c);
        __syncthreads();
        f32x2 vin[8], v[16]; unsigned hpre[16];
        hy_conv_to_buf(raw, buf, cf, 0, ht);
        __syncthreads();
#pragma unroll
        for (int a = 0; a < 8; ++a) { vin[a] = buf[fphys(256 * a + ht)]; v[a] = vin[a]; v[8 + a] = (f32x2){0.f, 0.f}; }
        fft_fwd<-1, -1>(v, buf, ht, tw, hk, HPf{H + (size_t)(c * 2 + 0) * 4096, ht, hpre});
#pragma unroll
        for (int ks = 0; ks < 16; ++ks) v[ks] = cmulq(v[ks], (f32x2){bflo(hpre[ks]), bfhi(hpre[ks])});
        fft_inv<0, 1, 0>(v, buf, ht, tw, hk);
        HY_PUT(rn);
        HY_FETCH(rv, 1, c);
        __syncthreads(); hk.act<1>();
        hy_conv_to_buf(raw, buf, cf, 1, ht);
        __syncthreads();
        { const float sk = cf[30];
#pragma unroll
          for (int a = 0; a < 8; ++a) { const f32x2 g = buf[fphys(256 * a + ht)]; vin[a] = g * (v[a] + vin[a] * sk); } }
#pragma unroll
        for (int a = 0; a < 8; ++a) { v[a] = vin[a]; v[8 + a] = (f32x2){0.f, 0.f}; }
        fft_fwd<-1, -1>(v, buf, ht, tw, hk, HPf{H + (size_t)(c * 2 + 1) * 4096, ht, hpre});
#pragma unroll
        for (int ks = 0; ks < 16; ++ks) v[ks] = cmulq(v[ks], (f32x2){bflo(hpre[ks]), bfhi(hpre[ks])});
        fft_inv<0, 1, 0>(v, buf, ht, tw, hk);
        HY_PUT(rv);
        if (i < 3) HY_FETCH(rv, 2, c + 2);
        __syncthreads(); hk.act<1>();
        hy_conv_to_buf(raw, buf, cf, 2, ht);
        __syncthreads();
        { const float sk = cf[31];
#pragma unroll
          for (int a = 0; a < 8; ++a) { const f32x2 g = buf[fphys(256 * a + ht)]; const f32x2 o = g * (v[a] + vin[a] * sk); const int t = 256 * a + ht;
              const unsigned pk_ = pk4_fp8(fminf(fmaxf(o.x, -448.f), 448.f), fminf(fmaxf(o.y, -448.f), 448.f), 0.f, 0.f);
              outT[(0 * 2048 + t) * 8 + cl] = (unsigned char)(pk_ & 0xffu); outT[(1 * 2048 + t) * 8 + cl] = (unsigned char)((pk_ >> 8) & 0xffu); } }
        if (i < 3 && ht < 32) coef[((i + 1) & 1) * 32 + ht] = cpre;
        __syncthreads();
    }
#undef HY_FETCH
#undef HY_PUT
    unsigned char* HH = WSP(unsigned char, WS_HH);
    int tido = F.tid; asm volatile("" : "+v"(tido));
#pragma unroll
    for (int q = 0; q < 8; ++q) { const int r = tido + 512 * q, bb = r >> 11, t = r & 2047;
        *(u32x2*)(HH + ((size_t)(b0 + bb) * SEQ + t) * HW + c0) = *(const LAS u32x2*)(outT + r * 8); }
    __syncthreads();
}

struct SchedP {
    static constexpr bool GATHER = false;
    int G, c; const char* a; const char* b; size_t astep, bstep;
    __device__ __forceinline__ bool next(int i, Unit& u) const { const int L = i * G + c; if (L >= 512) return false; pg8::decode_tile(L, 64, 8, u.pm, u.pn); u.ex = 0; return true; }
    __device__ __forceinline__ const char* a_base(const Unit& u) const { return a + (size_t)u.pm * astep; }
    __device__ __forceinline__ const char* b_base(const Unit& u) const { return b + (size_t)u.pn * bstep; }
    __device__ __forceinline__ int a_row(const Unit&, int R) const { return R; }
};
struct EpiMA {
    static constexpr bool PERM = true;
    bf16_t* T; const bf16_t* Z;
    __device__ __forceinline__ void operator()(const f32x4 (&acc)[2][2][4][2], const Unit& u, int wr, int wc, int fr, int fq) const {
        const int row0 = u.pm * 256 + wr * 64 + fr, col0 = u.pn * 256 + wc * 32 + 8 * fq;
#pragma unroll
        for (int ai = 0; ai < 2; ++ai)
#pragma unroll
            for (int bj = 0; bj < 2; ++bj) { const int c = col0 + bj * 128;
                u32x4 gz[4];
#pragma unroll
                for (int m = 0; m < 4; ++m) gz[m] = *(const u32x4*)(Z + (size_t)(row0 + ai * 128 + m * 16) * ZN + ZC_GA + c);
#pragma unroll
                for (int m = 0; m < 4; ++m) { const size_t row = row0 + ai * 128 + m * 16;
                    const f32x4 g0 = (f32x4){sigmoid_fast(bflo(gz[m].x)), sigmoid_fast(bfhi(gz[m].x)), sigmoid_fast(bflo(gz[m].y)), sigmoid_fast(bfhi(gz[m].y))};
                    const f32x4 g1 = (f32x4){sigmoid_fast(bflo(gz[m].z)), sigmoid_fast(bfhi(gz[m].z)), sigmoid_fast(bflo(gz[m].w)), sigmoid_fast(bfhi(gz[m].w))};
                    const f32x4 t0 = acc[ai][bj][m][0] * g0, t1 = acc[ai][bj][m][1] * g1;
                    u32x4 w; w.x = pg8::cvt_pk_bf16(t0[0], t0[1]); w.y = pg8::cvt_pk_bf16(t0[2], t0[3]); w.z = pg8::cvt_pk_bf16(t1[0], t1[1]); w.w = pg8::cvt_pk_bf16(t1[2], t1[3]);
                    *(u32x4*)(T + row * DM + c) = w; }
                asm volatile("" ::: "memory"); }
    }
};
struct EpiMB {
    static constexpr bool PERM = true;
    const bf16_t* T; const bf16_t* Z; unsigned char* MX;
    __device__ __forceinline__ void operator()(const f32x4 (&acc)[2][2][4][2], const Unit& u, int wr, int wc, int fr, int fq) const {
        const int row0 = u.pm * 256 + wr * 64 + fr, col0 = u.pn * 256 + wc * 32 + 8 * fq;
#pragma unroll
        for (int ai = 0; ai < 2; ++ai)
#pragma unroll
            for (int bj = 0; bj < 2; ++bj) { const int c = col0 + bj * 128;
                u32x4 gz[4], tv[4];
#pragma unroll
                for (int m = 0; m < 4; ++m) { const size_t row = row0 + ai * 128 + m * 16; gz[m] = *(const u32x4*)(Z + row * ZN + ZC_GH + c); tv[m] = *(const u32x4*)(T + row * DM + c); }
#pragma unroll
                for (int m = 0; m < 4; ++m) { const size_t row = row0 + ai * 128 + m * 16;
                    const f32x4 t0 = (f32x4){bflo(tv[m].x), bfhi(tv[m].x), bflo(tv[m].y), bfhi(tv[m].y)}, t1 = (f32x4){bflo(tv[m].z), bfhi(tv[m].z), bflo(tv[m].w), bfhi(tv[m].w)};
                    const f32x4 g0 = (f32x4){sigmoid_fast(bflo(gz[m].x)), sigmoid_fast(bfhi(gz[m].x)), sigmoid_fast(bflo(gz[m].y)), sigmoid_fast(bfhi(gz[m].y))};
                    const f32x4 g1 = (f32x4){sigmoid_fast(bflo(gz[m].z)), sigmoid_fast(bfhi(gz[m].z)), sigmoid_fast(bflo(gz[m].w)), sigmoid_fast(bfhi(gz[m].w))};
                    const f32x4 v0 = t0 + acc[ai][bj][m][0] * g0, v1 = t1 + acc[ai][bj][m][1] * g1;
                    const f32x4 c0 = __builtin_elementwise_min(__builtin_elementwise_max(v0, (f32x4){-448.f, -448.f, -448.f, -448.f}), (f32x4){448.f, 448.f, 448.f, 448.f});
                    const f32x4 c1 = __builtin_elementwise_min(__builtin_elementwise_max(v1, (f32x4){-448.f, -448.f, -448.f, -448.f}), (f32x4){448.f, 448.f, 448.f, 448.f});
                    u32x2 w; w.x = pk4_fp8(c0[0], c0[1], c0[2], c0[3]); w.y = pk4_fp8(c1[0], c1[1], c1[2], c1[3]);
                    *(u32x2*)(MX + row * DM + c) = w; }
                asm volatile("" ::: "memory"); }
    }
};
struct EpiWO {
    static constexpr bool PERM = true;
    bf16_t* R1; const float* x; const float* stats; const float* lng; const float* lnb; const float* mod;
    __device__ __forceinline__ void operator()(const f32x4 (&acc)[2][2][4][2], const Unit& u, int wr, int wc, int fr, int fq) const {
        const int row0 = u.pm * 256 + wr * 64 + fr, col0 = u.pn * 256 + wc * 32 + 8 * fq;
        const float* g1p = mod + (size_t)(u.pm >> 3) * 12288 + 4096;
#pragma unroll
        for (int bj = 0; bj < 2; ++bj) { const int c = col0 + bj * 128;
            const f32x4 ga = *(const f32x4*)(lng + c), gb = *(const f32x4*)(lng + c + 4), ba = *(const f32x4*)(lnb + c), bb = *(const f32x4*)(lnb + c + 4), g1a = *(const f32x4*)(g1p + c), g1b = *(const f32x4*)(g1p + c + 4);
#pragma unroll
            for (int ai = 0; ai < 2; ++ai)
#pragma unroll
                for (int mh = 0; mh < 2; ++mh) {
                    f32x4 xa[2], xb[2]; f32x2 st[2];
#pragma unroll
                    for (int q = 0; q < 2; ++q) { const size_t row = row0 + ai * 128 + (2 * mh + q) * 16; xa[q] = *(const f32x4*)(x + row * DM + c); xb[q] = *(const f32x4*)(x + row * DM + c + 4); st[q] = *(const f32x2*)(stats + row * 2); }
#pragma unroll
                    for (int q = 0; q < 2; ++q) { const int m = 2 * mh + q; const size_t row = row0 + ai * 128 + m * 16; const float mean = st[q].x, rstd = st[q].y;
                        const f32x4 v0 = ((xa[q] - mean) * rstd * ga + ba) * DN_ALPHA + g1a * acc[ai][bj][m][0], v1 = ((xb[q] - mean) * rstd * gb + bb) * DN_ALPHA + g1b * acc[ai][bj][m][1];
                        u32x4 w; w.x = pg8::cvt_pk_bf16(v0[0], v0[1]); w.y = pg8::cvt_pk_bf16(v0[2], v0[3]); w.z = pg8::cvt_pk_bf16(v1[0], v1[1]); w.w = pg8::cvt_pk_bf16(v1[2], v1[3]);
                        *(u32x4*)(R1 + row * DM + c) = w; }
                    asm volatile("" ::: "memory"); } }
    }
};

struct CwItem { const float* src; unsigned char* dst; float scale; };
__device__ __forceinline__ CwItem cw_decode(KargP in, unsigned char* ws, int it) {
    CwItem c;
    if (it < NEXP * 2048) { const int e = it >> 11, q = it & 2047, g = q & 127, kb = q >> 7; const int n0 = 32 * g, tile = n0 >> 8, within = n0 & 255;
        c.src = (within < 128 ? in[I_WG] : in[I_WU]) + (size_t)e * DM * DM + (size_t)(128 * kb) * DM + tile * 128 + (within & 127);
        c.dst = ws + WS_WGU + ((size_t)e * 4096 + n0) * DM + 128 * kb; c.scale = 32.f; }
    else { const int r2 = it - NEXP * 2048; const int e = r2 >> 10, q = r2 & 1023, g = q & 63, kb = q >> 6;
        c.src = in[I_WDN] + (size_t)e * DM * DM + (size_t)(128 * kb) * DM + 32 * g;
        c.dst = ws + WS_WD + ((size_t)e * 2048 + 32 * g) * DM + 128 * kb; c.scale = 64.f; }
    return c;
}
constexpr int CV_E8 = 8;
__device__ __forceinline__ int cw_map(int i) { return i < CV_E8 * 2048 ? i : NEXP * 2048 + (i - CV_E8 * 2048); }
__device__ __forceinline__ void convert_moe_wave(KargP in, unsigned char* ws, LAS unsigned char* tile, int lane, int cw, int ncw) {
    constexpr int NIT = CV_E8 * (2048 + 1024);
    const int kq = lane >> 3, nq = lane & 7;
#define CW_LOAD(v, c) do { _Pragma("unroll") for (int i_ = 0; i_ < 16; ++i_) v[i_] = __builtin_nontemporal_load((const f32x4*)((c).src + (size_t)(16 * kq + i_) * DM + 4 * nq)); } while (0)
#define CW_PROC(v, c) do { \
        _Pragma("unroll") for (int j_ = 0; j_ < 4; ++j_) { u32x4 o_; const float s_ = (c).scale; \
            o_.x = pk4_fp8(v[0][j_] * s_, v[1][j_] * s_, v[2][j_] * s_, v[3][j_] * s_);     o_.y = pk4_fp8(v[4][j_] * s_, v[5][j_] * s_, v[6][j_] * s_, v[7][j_] * s_); \
            o_.z = pk4_fp8(v[8][j_] * s_, v[9][j_] * s_, v[10][j_] * s_, v[11][j_] * s_);   o_.w = pk4_fp8(v[12][j_] * s_, v[13][j_] * s_, v[14][j_] * s_, v[15][j_] * s_); \
            *(LAS u32x4*)(tile + (4 * nq + j_) * 144 + 16 * kq) = o_; } \
        asm volatile("s_waitcnt lgkmcnt(0)" ::: "memory"); \
        _Pragma("unroll") for (int q_ = 0; q_ < 4; ++q_) { const int idx_ = lane + 64 * q_, row_ = idx_ >> 3, piece_ = idx_ & 7; \
            *(u32x4*)((c).dst + (size_t)row_ * DM + 16 * piece_) = *(const LAS u32x4*)(tile + row_ * 144 + 16 * piece_); } \
        asm volatile("s_waitcnt lgkmcnt(0)" ::: "memory"); } while (0)
    f32x4 va[16], vb[16];
    int it = cw;
    if (it >= NIT) return;
    CwItem ca = cw_decode(in, ws, cw_map(it)), cb = ca;
    CW_LOAD(va, ca);
    for (;;) {
        const bool hb = it + ncw < NIT;
        if (hb) { cb = cw_decode(in, ws, cw_map(it + ncw)); CW_LOAD(vb, cb); }
        CW_PROC(va, ca);
        if (!hb) break;
        it += ncw;
        const bool ha = it + ncw < NIT;
        if (ha) { ca = cw_decode(in, ws, cw_map(it + ncw)); CW_LOAD(va, ca); }
        CW_PROC(vb, cb);
        if (!ha) break;
        it += ncw;
    }
#undef CW_LOAD
#undef CW_PROC
}

__device__ __forceinline__ void sw_bar4(volatile LAS unsigned* cnt, unsigned& target, int lane) {
    asm volatile("s_waitcnt lgkmcnt(0)" ::: "memory");
    target += 4u;
    if (lane == 0) __hip_atomic_fetch_add((LAS unsigned*)cnt, 1u, __ATOMIC_RELAXED, __HIP_MEMORY_SCOPE_WORKGROUP);
    for (unsigned sp_ = 0; __hip_atomic_load((LAS unsigned*)cnt, __ATOMIC_RELAXED, __HIP_MEMORY_SCOPE_WORKGROUP) < target && sp_ < (1u << 24); ++sp_) __builtin_amdgcn_s_sleep(0);
    asm volatile("" ::: "memory");
}
__device__ __forceinline__ void p8_phase(Frame& F) {
    const KargP in = karg_opaque(F.in);
    const int lane = F.lane, l15 = lane & 15, g4 = lane >> 4;
    if (F.wave >= 4) {
        convert_moe_wave(in, F.ws, (LAS unsigned char*)(F.lds + 4 * 20480 + (F.wave - 4) * 4608), lane, F.bid * 4 + (F.wave - 4), F.G * 4);
        return; }
    const bf16_t* R1 = WSP(bf16_t, WS_R1); unsigned char* TOK = WSP(unsigned char, WS_TOK); const float* mod = WSP(float, WS_MOD);
    LAS float* pA = (LAS float*)(F.lds + F.wave * 20480);
    LAS float* pB = pA + 2048;
    LAS float* lg = pA + 4096;
    LAS int* te = (LAS int*)(lg + 576); LAS float* tw = (LAS float*)(te + 64);
    const float* wr = in[I_WR];
    LAS float* wl = (LAS float*)(F.lds + 4 * 20480 + 4 * 4608);
    unsigned rbt = 0u;
#pragma unroll 1
    for (int tile = F.bid + F.G * F.wave; tile < MTOK / 16; tile += F.G * 4) {
        const int bsel = (tile * 16) / SEQ; const float* mv = mod + (size_t)bsel * 12288;
#pragma unroll
        for (int j = 0; j < 8; ++j) { const int c = lane * 4 + 256 * j;
            const f32x4 g = *(const f32x4*)(in[I_LN1G] + c), bb = *(const f32x4*)(in[I_LN1B] + c), sh = *(const f32x4*)(mv + 6144 + c), sc = *(const f32x4*)(mv + 8192 + c) + 1.0f;
            *(LAS f32x4*)(pA + c) = g * sc; *(LAS f32x4*)(pB + c) = bb * sc + sh; }
        LDS_WAIT(); asm volatile("" ::: "memory");
        float my_mean = 0.f, my_rstd = 0.f;
        {
            const bf16_t* xb = R1 + (size_t)tile * 16 * DM + lane * 4;
            f32x4 v[8]; u32x2 vn[8];
#pragma unroll
            for (int j = 0; j < 8; ++j) { const u32x2 t_ = *(const u32x2*)(xb + 256 * j); v[j] = (f32x4){bflo(t_.x), bfhi(t_.x), bflo(t_.y), bfhi(t_.y)}; }
#pragma unroll 1
            for (int rr = 0; rr < 16; ++rr) {
                const bf16_t* xn = xb + (size_t)(rr < 15 ? rr + 1 : rr) * DM;
#pragma unroll
                for (int j = 0; j < 8; ++j) vn[j] = *(const u32x2*)(xn + 256 * j);
                float s = 0.f;
#pragma unroll
                for (int j = 0; j < 8; ++j) s += (v[j].x + v[j].y) + (v[j].z + v[j].w);
                const float mean = wave_sum(s) * (1.f / DM); float s2 = 0.f;
#pragma unroll
                for (int j = 0; j < 8; ++j) { v[j] = v[j] - mean; s2 += (v[j].x * v[j].x + v[j].y * v[j].y) + (v[j].z * v[j].z + v[j].w * v[j].w); }
                const float rstd = 1.f / sqrtf(wave_sum(s2) * (1.f / DM) + LN_EPS);
                if (l15 == rr) { my_mean = mean; my_rstd = rstd; }
                unsigned char* orow = TOK + (size_t)(tile * 16 + rr) * DM;
#pragma unroll
                for (int j = 0; j < 8; ++j) { const int c = lane * 4 + 256 * j;
                    const f32x4 y = v[j] * rstd * *(const LAS f32x4*)(pA + c) + *(const LAS f32x4*)(pB + c);
                    *(unsigned*)(orow + c) = pk4_fp8(y.x, y.y, y.z, y.w); }
#pragma unroll
                for (int j = 0; j < 8; ++j) v[j] = (f32x4){bflo(vn[j].x), bfhi(vn[j].x), bflo(vn[j].y), bfhi(vn[j].y)};
            }
        }
        f32x4 acc0 = (f32x4){0.f, 0.f, 0.f, 0.f}, acc1 = (f32x4){0.f, 0.f, 0.f, 0.f};
        const bf16_t* rowp = R1 + (size_t)(tile * 16 + l15) * DM + 512 * g4;
        const float ra = my_rstd, rm = -my_mean * my_rstd;
        const int rt = F.tid;
        float wst[32]; u32x4 ar[8];
#define RT_WLOAD(c) do { int rt_ = rt; asm volatile("" : "+v"(rt_)); const float* wb_ = wr + (size_t)(64 * (c) + (rt_ >> 5)) * 32 + (rt_ & 31); \
            _Pragma("unroll") for (int q_ = 0; q_ < 32; ++q_) wst[q_] = wb_[(512 * (q_ >> 3) + 8 * (q_ & 7)) * 32]; } while (0)
        RT_WLOAD(0);
#pragma unroll
        for (int q = 0; q < 8; ++q) ar[q] = *(const u32x4*)(rowp + 8 * q);
#pragma unroll 1
        for (int c = 0; c < 8; ++c) {
            { int rt_ = rt; asm volatile("" : "+v"(rt_)); LAS float* wd_ = wl + (rt_ & 31) * 68 + (rt_ >> 5);
#pragma unroll
              for (int q = 0; q < 32; ++q) wd_[(q >> 3) * 32 * 68 + 8 * (q & 7)] = wst[q]; }
            sw_bar4(F.MISC + 16, rbt, lane);
            if (c < 7) RT_WLOAD(c + 1);
            const LAS float* w0p = wl + (g4 * 32 + l15) * 68; const LAS float* w1p = w0p + 16 * 68;
            const bf16_t* rown = rowp + 64 * (c < 7 ? c + 1 : c);
#pragma unroll
            for (int i = 0; i < 16; ++i) {
                const f32x4 av = *(const LAS f32x4*)(pA + 512 * g4 + 64 * c + 4 * i), bv = *(const LAS f32x4*)(pB + 512 * g4 + 64 * c + 4 * i);
                const f32x4 w0 = *(const LAS f32x4*)(w0p + 4 * i), w1 = *(const LAS f32x4*)(w1p + 4 * i);
                const unsigned lo = (i & 1) ? ar[i >> 1].z : ar[i >> 1].x, hi = (i & 1) ? ar[i >> 1].w : ar[i >> 1].y;
                const f32x4 tk = ((f32x4){bflo(lo), bfhi(lo), bflo(hi), bfhi(hi)} * ra + rm) * av + bv;
#pragma unroll
                for (int j = 0; j < 4; ++j) { acc0 = __builtin_amdgcn_mfma_f32_16x16x4f32(tk[j], w0[j], acc0, 0, 0, 0); acc1 = __builtin_amdgcn_mfma_f32_16x16x4f32(tk[j], w1[j], acc1, 0, 0, 0); }
                if (i == 7) {
#pragma unroll
                    for (int q = 0; q < 4; ++q) ar[q] = *(const u32x4*)(rown + 8 * q); }
            }
#pragma unroll
            for (int q = 4; q < 8; ++q) ar[q] = *(const u32x4*)(rown + 8 * q);
            sw_bar4(F.MISC + 16, rbt, lane);
        }
#undef RT_WLOAD
        { const float b0 = in[I_BR][l15], b1 = in[I_BR][16 + l15];
#pragma unroll
          for (int r = 0; r < 4; ++r) { lg[(4 * g4 + r) * 33 + l15] = acc0[r] + b0; lg[(4 * g4 + r) * 33 + 16 + l15] = acc1[r] + b1; } }
        LDS_WAIT(); asm volatile("" ::: "memory");
        if (lane < 16) {
            unsigned chosen = 0u; float lv[4]; int le[4];
            for (int k = 0; k < 4; ++k) { float best = -3.4e38f; int be = 0;
                for (int e = 0; e < 32; ++e) { const float v = lg[lane * 33 + e]; if (!((chosen >> e) & 1u) && v > best) { best = v; be = e; } }
                chosen |= 1u << be; lv[k] = best; le[k] = be; }
            float ex[4], sum = 0.f;
            for (int k = 0; k < 4; ++k) { ex[k] = __expf(lv[k] - lv[0]); sum += ex[k]; }
            for (int k = 0; k < 4; ++k) { te[lane * 4 + k] = le[k]; tw[lane * 4 + k] = ex[k] / sum; }
        }
        LDS_WAIT(); asm volatile("" ::: "memory");
        { const int e = te[lane]; const float wv = tw[lane]; const int token = tile * 16 + (lane >> 2);
          const int pos = (int)__hip_atomic_fetch_add(F.ctl + CW_CNT + 64 * e, 1u, __ATOMIC_RELAXED, __HIP_MEMORY_SCOPE_AGENT);
          WSP(int, WS_TOPE)[token * 4 + (lane & 3)] = e; WSP(int, WS_TOPP)[token * 4 + (lane & 3)] = pos; WSP(float, WS_TOPW)[token * 4 + (lane & 3)] = wv;
          WSP(int, WS_RTOK)[e * POSCAP + pos] = token; }
        LDS_WAIT(); asm volatile("" ::: "memory");
    }
}

constexpr int MOE_TBL = 131072;
__device__ __forceinline__ void moe_table(Frame& F) {
    LAS int* tst = (LAS int*)(F.lds + MOE_TBL); LAS int* cn = (LAS int*)(F.lds + MOE_TBL + 256);
    __syncthreads();
    if (F.tid < 64) {
        const int e = F.tid & 31; const int c = (int)__hip_atomic_load(F.ctl + CW_CNT + 64 * e, __ATOMIC_RELAXED, __HIP_MEMORY_SCOPE_AGENT);
        int inc = (c + 255) >> 8;
#pragma unroll
        for (int o = 1; o < 32; o <<= 1) { const int t = __shfl_up(inc, o); if ((F.tid & 31) >= o) inc += t; }
        if (F.tid < 32) { cn[e] = c; tst[e] = inc - ((c + 255) >> 8); if (e == 31) tst[NEXP] = inc; } }
    __syncthreads();
}
constexpr int MOE_UL = MOE_TBL + 512;
__device__ __forceinline__ void moe_unit_list(Frame& F, int NT) {
    const LAS int* tst = (const LAS int*)(F.lds + MOE_TBL); LAS int* ul = (LAS int*)(F.lds + MOE_UL);
    if (F.tid < 64) {
        const int nwg = tst[NEXP] * NT; const int L = F.tid * F.G + F.bid;
        int pm = -1, pn = 0, e = 0;
        if (L < nwg) {
            int wg; { const int q = nwg / 8, r = nwg % 8, xcd = L % 8, off = L / 8; wg = (xcd < r ? xcd * (q + 1) : r * (q + 1) + (xcd - r) * q) + off; }
            for (int k = 1; k < NEXP; ++k) if (wg >= tst[k] * NT) e = k;
            const int ts = tst[e], ne = tst[e + 1] - ts, rem = wg - ts * NT;
            pm = ts + rem % ne; pn = rem / ne; }
        ul[F.tid * 4 + 0] = pm; ul[F.tid * 4 + 1] = pn; ul[F.tid * 4 + 2] = e; ul[F.tid * 4 + 3] = 0;
    }
    __syncthreads();
}
constexpr int MOE_ROWS = MOE_UL + 1024, MOE_ROWS_MAX = 18;
constexpr int MOE_BIAS = MOE_ROWS + MOE_ROWS_MAX * 512;
static_assert(MOE_BIAS + MOE_ROWS_MAX * 1024 <= MISC_OFF, "MoE LDS tables");
__device__ __forceinline__ void moe_row_table(Frame& F, const int* rtok) {
    const LAS int* tst = (const LAS int*)(F.lds + MOE_TBL); const LAS int* cn = (const LAS int*)(F.lds + MOE_TBL + 256); const LAS int* ul = (const LAS int*)(F.lds + MOE_UL);
    LAS unsigned short* rows = (LAS unsigned short*)(F.lds + MOE_ROWS);
    for (int idx = F.tid; idx < MOE_ROWS_MAX * 256; idx += NTHR) { const int i = idx >> 8, r = idx & 255; const int pm = ul[i * 4];
        if (pm >= 0) { const int e = ul[i * 4 + 2]; int pos = (pm - tst[e]) * 256 + r; const int cnt = cn[e]; pos = pos < cnt ? pos : cnt - 1; rows[idx] = (unsigned short)rtok[e * POSCAP + pos]; } }
    __syncthreads();
}
__device__ __forceinline__ void moe_bias_table(Frame& F, const float* b0, const float* b1, bool gu) {
    const LAS int* ul = (const LAS int*)(F.lds + MOE_UL); LAS float* bt = (LAS float*)(F.lds + MOE_BIAS);
    for (int idx = F.tid; idx < MOE_ROWS_MAX * 256; idx += NTHR) { const int i = idx >> 8, j = idx & 255; const int pm = ul[i * 4];
        if (pm >= 0) { const int pn = ul[i * 4 + 1], e = ul[i * 4 + 2];
            bt[idx] = gu ? (j < 128 ? b0[(size_t)e * DM + pn * 128 + j] : b1[(size_t)e * DM + pn * 128 + j - 128]) : b0[(size_t)e * DM + pn * 256 + j]; } }
    __syncthreads();
}
template <bool GU> struct SchedMoE {
    static constexpr bool GATHER = GU;
    int G, c, NT; const LAS int* tst; const LAS int* cn; const int* rtok; const char* a; const char* b; const LAS int* ul;
    __device__ __forceinline__ bool next(int i, Unit& u) const {
        if (i >= MOE_ROWS_MAX) return false;
        const int pm = __builtin_amdgcn_readfirstlane(ul[i * 4 + 0]); if (pm < 0) return false;
        u.pm = pm; u.pn = __builtin_amdgcn_readfirstlane(ul[i * 4 + 1]); u.ex = i; return true;
    }
    __device__ __forceinline__ const char* a_base(const Unit& u) const { return GU ? a : a + (size_t)u.pm * 256 * DM; }
    __device__ __forceinline__ int expert(const Unit& u) const { return __builtin_amdgcn_readfirstlane(ul[u.ex * 4 + 2]); }
    __device__ __forceinline__ const char* b_base(const Unit& u) const { return b + ((size_t)expert(u) * (GU ? 4096 : 2048) + 256 * u.pn) * DM; }
    __device__ __forceinline__ int a_row(const Unit& u, int R) const { return (int)((const LAS unsigned short*)((const LAS char*)ul + (MOE_ROWS - MOE_UL)))[u.ex * 256 + R]; }
};
struct EpiGU {
    static constexpr bool PERM = true;
    unsigned char* ACT; const float* bg; const float* bu; const LAS int* ul;
    __device__ __forceinline__ void operator()(const f32x4 (&acc)[2][2][4][2], const Unit& u, int wr, int wc, int fr, int fq) const {
        const int row0 = u.pm * 256 + wr * 64 + fr, col0 = u.pn * 128 + wc * 32 + 8 * fq;
        const LAS float* bt = (const LAS float*)((const LAS char*)ul + (MOE_BIAS - MOE_UL)) + u.ex * 256 + wc * 32 + 8 * fq;
        const f32x4 g0 = *(const LAS f32x4*)bt, g1 = *(const LAS f32x4*)(bt + 4), u0 = *(const LAS f32x4*)(bt + 128), u1 = *(const LAS f32x4*)(bt + 132);
#pragma unroll
        for (int ai = 0; ai < 2; ++ai)
#pragma unroll
            for (int m = 0; m < 4; ++m) { const size_t row = row0 + ai * 128 + m * 16;
                float o[8];
#pragma unroll
                for (int n = 0; n < 2; ++n)
#pragma unroll
                    for (int j = 0; j < 4; ++j) { const float gv = fminf(acc[ai][0][m][n][j] + (n ? g1[j] : g0[j]), 7.0f);
                        const float uv = fminf(fmaxf(acc[ai][1][m][n][j] + (n ? u1[j] : u0[j]), -7.0f), 7.0f);
                        o[n * 4 + j] = 4.0f * gv * sigmoid_fast(1.702f * gv) * (uv + 1.0f); }
                u32x2 w; w.x = pk4_fp8(o[0], o[1], o[2], o[3]); w.y = pk4_fp8(o[4], o[5], o[6], o[7]);
                *(u32x2*)(ACT + row * DM + col0) = w; }
    }
};
struct EpiDN {
    static constexpr bool PERM = true;
    unsigned char* YR; const LAS int* ul;
    __device__ __forceinline__ void operator()(const f32x4 (&acc)[2][2][4][2], const Unit& u, int wr, int wc, int fr, int fq) const {
        const int r0 = wr * 64 + fr, col0 = u.pn * 256 + wc * 32 + 8 * fq;
        const LAS float* bp = (const LAS float*)((const LAS char*)ul + (MOE_BIAS - MOE_UL)) + u.ex * 256 + wc * 32 + 8 * fq;
        unsigned char* base = YR + ((size_t)u.pm * 256 + r0) * DM + col0;
#pragma unroll
        for (int bj = 0; bj < 2; ++bj) {
            const f32x4 bv0 = *(const LAS f32x4*)(bp + bj * 128), bv1 = *(const LAS f32x4*)(bp + bj * 128 + 4);
#pragma unroll
            for (int ai = 0; ai < 2; ++ai)
#pragma unroll
                for (int m = 0; m < 4; ++m) {
                    const f32x4 lim = (f32x4){448.f, 448.f, 448.f, 448.f};
                    const f32x4 v0 = __builtin_elementwise_min(__builtin_elementwise_max((acc[ai][bj][m][0] + bv0) * 16.0f, -lim), lim), v1 = __builtin_elementwise_min(__builtin_elementwise_max((acc[ai][bj][m][1] + bv1) * 16.0f, -lim), lim);
                    u32x2 w; w.x = pk4_fp8(v0[0], v0[1], v0[2], v0[3]); w.y = pk4_fp8(v1[0], v1[1], v1[2], v1[3]);
                    *(u32x2*)(base + (size_t)(ai * 128 + m * 16) * DM + bj * 128) = w; }
        }
    }
};

__device__ __forceinline__ void p11_phase(Frame& F) {
    const KargP in = karg_opaque(F.in);
    const int gw = F.bid * NWAVES + F.wave, NGW = F.G * NWAVES, lane = F.lane;
    const LAS int* tst = (const LAS int*)(F.lds + MOE_TBL);
    const bf16_t* R1 = WSP(bf16_t, WS_R1); const unsigned char* YR = WSP(unsigned char, WS_YR); const float* mod = WSP(float, WS_MOD);
    LAS float* pl = (LAS float*)F.lds;
    for (int i = F.tid; i < 2048; i += NTHR) { pl[i] = in[I_LN1G][i]; pl[2048 + i] = in[I_LN1B][i]; pl[4096 + i] = in[I_LN2G][i]; pl[6144 + i] = in[I_LN2B][i]; }
    for (int i = F.tid; i < 8 * 2048; i += NTHR) pl[8192 + i] = mod[(size_t)(i >> 11) * 12288 + 10240 + (i & 2047)];
    __syncthreads();
    LAS int* sd = (LAS int*)(F.lds + 98304 + F.wave * 512); LAS float* sw = (LAS float*)(F.lds + 98304 + F.wave * 512 + 256);
#pragma unroll 1
    for (int rb = gw * 8; rb < MTOK; rb += NGW * 8) {
        const int li = lane & 31;
        { const int ve = WSP(int, WS_TOPE)[rb * 4 + li], vp = WSP(int, WS_TOPP)[rb * 4 + li]; const float vw = WSP(float, WS_TOPW)[rb * 4 + li];
          if (lane < 32) { sd[li] = tst[ve] * 256 + vp; sw[li] = vw; } }
        const LAS float* g2p = pl + 8192 + (rb / SEQ) * 2048;
        LDS_WAIT(); asm volatile("" ::: "memory");
#pragma unroll 1
        for (int ri = 0; ri < 8; ++ri) {
            const int row = rb + ri;
            int dest[4]; float wk[4];
#pragma unroll
            for (int k = 0; k < 4; ++k) { dest[k] = __builtin_amdgcn_readfirstlane(sd[ri * 4 + k]); wk[k] = __builtin_bit_cast(float, __builtin_amdgcn_readfirstlane(__builtin_bit_cast(int, sw[ri * 4 + k]))); }
            const bf16_t* xr = R1 + (size_t)row * DM + lane * 4;
            f32x4 v[8]; unsigned yy[4][8]; u32x2 vr[8];
#pragma unroll
            for (int j = 0; j < 8; ++j) vr[j] = *(const u32x2*)(xr + 256 * j);
#pragma unroll
            for (int k = 0; k < 4; ++k) { const unsigned char* yp = YR + (size_t)dest[k] * DM + lane * 4;
#pragma unroll
                for (int j = 0; j < 8; ++j) yy[k][j] = *(const unsigned*)(yp + 256 * j); }
            float s = 0.f;
#pragma unroll
            for (int j = 0; j < 8; ++j) { v[j] = (f32x4){bflo(vr[j].x), bfhi(vr[j].x), bflo(vr[j].y), bfhi(vr[j].y)}; s += (v[j].x + v[j].y) + (v[j].z + v[j].w); }
            float mean = wave_sum(s) * (1.f / DM); float s2 = 0.f;
#pragma unroll
            for (int j = 0; j < 8; ++j) { v[j] = v[j] - mean; s2 += (v[j].x * v[j].x + v[j].y * v[j].y) + (v[j].z * v[j].z + v[j].w * v[j].w); }
            float rstd = 1.f / sqrtf(wave_sum(s2) * (1.f / DM) + LN_EPS);
            s = 0.f;
#pragma unroll
            for (int j = 0; j < 8; ++j) { const int c = lane * 4 + 256 * j;
                const f32x4 g = *(const LAS f32x4*)(pl + c), bb = *(const LAS f32x4*)(pl + 2048 + c), g2v = *(const LAS f32x4*)(g2p + c);
                f32x4 y = (f32x4){0.f, 0.f, 0.f, 0.f};
#pragma unroll
                for (int k = 0; k < 4; ++k) { const f32x2 lo = __builtin_amdgcn_cvt_pk_f32_fp8((int)yy[k][j], false), hi = __builtin_amdgcn_cvt_pk_f32_fp8((int)yy[k][j], true); y += (f32x4){lo.x, lo.y, hi.x, hi.y} * (wk[k] * 0.0625f); }
                v[j] = (v[j] * rstd * g + bb) * DN_ALPHA + g2v * y;
                s += (v[j].x + v[j].y) + (v[j].z + v[j].w); __builtin_amdgcn_sched_barrier(0); }
            mean = wave_sum(s) * (1.f / DM); s2 = 0.f;
#pragma unroll
            for (int j = 0; j < 8; ++j) { v[j] = v[j] - mean; s2 += (v[j].x * v[j].x + v[j].y * v[j].y) + (v[j].z * v[j].z + v[j].w * v[j].w); }
            rstd = 1.f / sqrtf(wave_sum(s2) * (1.f / DM) + LN_EPS);
            float* orow = F.out + (size_t)row * DM;
#pragma unroll
            for (int j = 0; j < 8; ++j) { const int c = lane * 4 + 256 * j;
                const f32x4 g = *(const LAS f32x4*)(pl + 4096 + c), bb = *(const LAS f32x4*)(pl + 6144 + c);
                *(f32x4*)(orow + c) = v[j] * rstd * g + bb; }
        }
        LDS_WAIT(); asm volatile("" ::: "memory");
    }
}

constexpr int NPHASE = 13;
__global__ void __launch_bounds__(NTHR, 2) mk_fwd(Args args) {
    extern __shared__ __attribute__((aligned(16))) unsigned char lds_raw[];
    Frame F;
    F.lds = (LAS unsigned char*)lds_raw;
    F.MISC = (volatile LAS unsigned*)(F.lds + MISC_OFF);
    F.tid = threadIdx.x; F.lane = F.tid & 63; F.wave = __builtin_amdgcn_readfirstlane(F.tid >> 6); F.wave0 = F.wave;
    F.G = gridDim.x; F.bid = blockIdx.x;
    F.in = (KargP)__builtin_amdgcn_kernarg_segment_ptr(); F.out = args.out; F.ws = args.ws; F.ctl = (unsigned*)(args.ws + WS_CTL);
    for (int u = F.tid; u < (LDS_BYTES - MISC_OFF) / 4; u += NTHR) ((LAS unsigned*)(F.lds + MISC_OFF))[u] = 0u;
    __syncthreads();
    XcdBarrier bar; bar.bar = F.ctl + CW_BAR; bar.x = 0; bar.st = nullptr;
    if (MK_LAUNCHES == 1) bar = xcd_barrier_post(F.ctl + CW_BAR, F.MISC + 8, F.tid);
    const int lo = args.ph_lo, hi = args.ph_hi;
    unsigned long long tph_ = (PROBE_PH >= 0) ? __builtin_amdgcn_s_memrealtime() : 0ull;
#ifndef PH_MASK
#define PH_MASK 0xFFFF
#endif
#define TID_NOW(var) int var; { unsigned z_ = 0u; asm volatile("" : "+s"(z_)); var = (F.wave0 << 6) | (int)__builtin_amdgcn_mbcnt_hi(~0u, __builtin_amdgcn_mbcnt_lo(~0u, z_)); }
#define RELOAD() do { const KargP k_ = karg_opaque(F.in); F.out = (float*)k_[38]; F.ws = (unsigned char*)k_[39]; F.ctl = (unsigned*)F.ws; TID_NOW(t_); asm volatile("" : "+v"(t_)); F.tid = t_; F.lane = t_ & 63; F.wave = __builtin_amdgcn_readfirstlane(t_ >> 6); } while (0)
#define IN(k) (((PH_MASK >> (k)) & 1) && lo <= (k) && (k) < hi)
#define SEAM(k) do { if (IN(k) && IN((k) + 1)) { TID_NOW(ts_); xcd_barrier(bar, ts_); } \
        if (PROBE_PH >= 0) { const unsigned long long t1_ = __builtin_amdgcn_s_memrealtime(); \
            if (PROBE_PH == (k)) { while (__builtin_amdgcn_s_memrealtime() - t1_ < t1_ - tph_) __builtin_amdgcn_s_sleep(8); } \
            tph_ = __builtin_amdgcn_s_memrealtime(); } } while (0)
#ifndef DUP_MASK
#define DUP_MASK 0
#endif
#define REP(k) for (int rep_ = 0; rep_ < (((DUP_MASK >> (k)) & 1) ? 2 : 1); ++rep_)
    if (IN(0)) REP(0) p0_phase(F);
    SEAM(0);
    RELOAD();
    if (IN(1)) REP(1) p0b_phase(F);
    SEAM(1);
    RELOAD();
    if (IN(2)) REP(2) p1_phase(F);
    SEAM(2);
    RELOAD();
    if (IN(3)) REP(3) {
        EpiZ E{WSP(bf16_t, WS_Z), WSP(bf16_t, WS_ZT), WSP(float, WS_BINP)};
        { SchedZ<false> S{F.G, F.bid, (const char*)WSP(bf16_t, WS_HX), (const char*)WSP(bf16_t, WS_WIN)};
          pg8::gemm_phase<EpiZ, SchedZ<false>>(F.tid, F.lds, DM / 64, DM * 2, DM * 2, S, E); }
        { SchedZ<true> S{F.G, F.G - 1 - F.bid, (const char*)WSP(unsigned char, WS_HX8), (const char*)WSP(unsigned char, WS_WIN8)};
          pg8::gemm_phase<EpiZ, SchedZ<true>, true>(F.tid, F.lds, DM / 128, DM, DM, S, E, 0x7A7A7A7A, 0x7F7F7F7F); }
    }
    SEAM(3);
    RELOAD();
    if (IN(4)) REP(4) p3_phase(F);
    SEAM(4);
    RELOAD();
    if (IN(5)) REP(5) {
        SchedQK S{F.G, F.bid, (const char*)WSP(bf16_t, WS_U), (const char*)WSP(bf16_t, WS_WQK)};
        EpiQK E{WSP(bf16_t, WS_QKB)};
        pg8::gemm_phase<EpiQK, SchedQK>(F.tid, F.lds, 256 / 64, MW * 2, 256 * 2, S, E);
    }
    SEAM(5);
    RELOAD();
    if (IN(6)) REP(6) {
#ifndef DUP_ML
#define DUP_ML 1
#endif
#ifndef DUP_HY
#define DUP_HY 1
#endif
        for (int un = F.bid; un < 256 * DUP_ML; un += F.G) mlstm_unit(F, un & 255);
        RELOAD();
        { CvHook hk; hk.in = karg_opaque(F.in); hk.ws = F.ws; hk.tiles = (LAS unsigned char*)(F.lds + HY_CVT); hk.tid = F.tid; hk.bid = F.bid; hk.G = F.G; hk.kmax = (CVH_NITEMS - 1 - F.bid) / F.G; hk.s = 2; hk.request<0>(0); hk.request<1>(1);
          for (int un = F.bid; un < 512 * DUP_HY; un += F.G) hyena_unit(F, un & 511, hk);
          while (hk.s <= hk.kmax + 3) { __syncthreads(); if (hk.s & 1) hk.act<1>(); else hk.act<0>(); }
          __syncthreads(); }
    }
    SEAM(6);
    RELOAD();
    if (IN(7)) REP(7) {
        { SchedP S{F.G, F.bid, (const char*)WSP(unsigned char, WS_AM), (const char*)WSP(unsigned char, WS_WPA2), (size_t)256 * 2048, (size_t)256 * 2048};
          EpiMA E{WSP(bf16_t, WS_T), WSP(bf16_t, WS_Z)};
          pg8::gemm_phase<EpiMA, SchedP, true>(F.tid, F.lds, 2048 / 128, 2048, 2048, S, E, 0x7A7A7A7A, 0x7F7F7F7F); }
        VM_WAIT(); __syncthreads();
        { SchedP S{F.G, F.bid, (const char*)WSP(unsigned char, WS_HH), (const char*)WSP(unsigned char, WS_WPH), (size_t)256 * 1024, (size_t)256 * 1024};
          EpiMB E{WSP(bf16_t, WS_T), WSP(bf16_t, WS_Z), WSP(unsigned char, WS_MX)};
          pg8::gemm_phase<EpiMB, SchedP, true>(F.tid, F.lds, 1024 / 128, 1024, 1024, S, E, 0x7A7A7A7A, 0x7F7F7F7F); }
    }
    SEAM(7);
    RELOAD();
    if (IN(8)) REP(8) {
        SchedP S{F.G, F.bid, (const char*)WSP(unsigned char, WS_MX), (const char*)WSP(unsigned char, WS_WOUT), (size_t)256 * 2048, (size_t)256 * 2048};
        const KargP in = karg_opaque(F.in); EpiWO E{WSP(bf16_t, WS_R1), in[I_X], WSP(float, WS_STATS), in[I_LNG], in[I_LNB], WSP(float, WS_MOD)};
        pg8::gemm_phase<EpiWO, SchedP, true>(F.tid, F.lds, 2048 / 128, 2048, 2048, S, E, 0x79797979, 0x7F7F7F7F);
    }
    SEAM(8);
    RELOAD();
    if (IN(9)) p8_phase(F);
    SEAM(9);
    RELOAD();
    if (IN(10)) REP(10) {
        moe_table(F);
        moe_unit_list(F, 16); moe_row_table(F, WSP(int, WS_RTOK)); { const KargP in_ = karg_opaque(F.in); moe_bias_table(F, in_[I_BG], in_[I_BU], true); }
        SchedMoE<true> S{F.G, F.bid, 16, (const LAS int*)(F.lds + MOE_TBL), (const LAS int*)(F.lds + MOE_TBL + 256), WSP(int, WS_RTOK), (const char*)WSP(bf16_t, WS_TOK), (const char*)WSP(bf16_t, WS_WGU), (const LAS int*)(F.lds + MOE_UL)};
        const KargP in = karg_opaque(F.in); EpiGU E{WSP(unsigned char, WS_ACT), in[I_BG], in[I_BU], (const LAS int*)(F.lds + MOE_UL)};
        pg8::gemm_phase<EpiGU, SchedMoE<true>, true>(F.tid, F.lds, DM / 128, DM, DM, S, E, 0x7A7A7A7A, 0x7F7F7F7F);
    }
    SEAM(10);
    RELOAD();
    if (IN(11)) REP(11) {
        moe_table(F);
        moe_unit_list(F, 8); { const KargP in_ = karg_opaque(F.in); moe_bias_table(F, in_[I_BDN], in_[I_BDN], false); }
        SchedMoE<false> S{F.G, F.bid, 8, (const LAS int*)(F.lds + MOE_TBL), (const LAS int*)(F.lds + MOE_TBL + 256), WSP(int, WS_RTOK), (const char*)WSP(bf16_t, WS_ACT), (const char*)WSP(bf16_t, WS_WD), (const LAS int*)(F.lds + MOE_UL)};
        const KargP in = karg_opaque(F.in); EpiDN E{WSP(unsigned char, WS_YR), (const LAS int*)(F.lds + MOE_UL)};
        pg8::gemm_phase<EpiDN, SchedMoE<false>, true>(F.tid, F.lds, DM / 128, DM, DM, S, E, 0x79797979, 0x7D7D7D7D);
    }
    SEAM(11);
    RELOAD();
    if (IN(12)) REP(12) { moe_table(F); p11_phase(F); }
#undef IN
#undef SEAM
}

extern "C" void kernel_launch(void* const* d_in, const int* in_sizes, int n_in, void* d_out, int out_size, void* d_ws, size_t ws_size, hipStream_t stream) {
    static int grid = 0;
    if (grid == 0) {
        if (n_in != 38 || out_size != MTOK * DM || ws_size < WS_END) { fprintf(stderr, "kernel_launch: unexpected shapes: n_in %d out %d ws %zu (need %zu)\n", n_in, out_size, ws_size, (size_t)WS_END); grid = -1; return; }
        int dev = 0, cus = 0, per_cu = 0;
        if (hipGetDevice(&dev) != hipSuccess || hipDeviceGetAttribute(&cus, hipDeviceAttributeMultiprocessorCount, dev) != hipSuccess) { grid = -1; return; }
        if (hipFuncSetAttribute((const void*)mk_fwd, hipFuncAttributeMaxDynamicSharedMemorySize, LDS_BYTES) != hipSuccess) { fprintf(stderr, "kernel_launch: hipFuncSetAttribute failed\n"); grid = -1; return; }
        if (hipOccupancyMaxActiveBlocksPerMultiprocessor(&per_cu, (const void*)mk_fwd, NTHR, LDS_BYTES) != hipSuccess || per_cu < 1) fprintf(stderr, "kernel_launch: occupancy query says %d\n", per_cu);
        (void)hipGetLastError();
        grid = cus;
    }
    if (grid < 0) return;
    (void)hipMemsetAsync((char*)d_ws + WS_CTL, 0, CTL_ZERO_BYTES, stream);
    Args a{};
    for (int i = 0; i < 38; ++i) a.in[i] = (const float*)d_in[i];
    a.out = (float*)d_out; a.ws = (unsigned char*)d_ws;
#if MK_LAUNCHES == 1
    a.ph_lo = 0; a.ph_hi = NPHASE;
    hipLaunchKernelGGL(mk_fwd, dim3(grid), dim3(NTHR), LDS_BYTES, stream, a);
#else
    for (int p = 0; p < NPHASE; ++p) { a.ph_lo = p; a.ph_hi = p + 1; hipLaunchKernelGGL(mk_fwd, dim3(grid), dim3(NTHR), LDS_BYTES, stream, a); }
#endif
}
```

```cpp
#include <hip/hip_runtime.h>
#include <cstdio>
#include <cstdint>

#define GAS __attribute__((address_space(1)))
#define LAS __attribute__((address_space(3)))
typedef unsigned short bf16_t;
typedef short bf16x8 __attribute__((ext_vector_type(8)));
typedef float f32x4 __attribute__((ext_vector_type(4)));
typedef float f32x2 __attribute__((ext_vector_type(2)));
typedef unsigned u32x4 __attribute__((ext_vector_type(4)));
typedef unsigned u32x2 __attribute__((ext_vector_type(2)));

#ifndef PROBE_PH
#define PROBE_PH -1
#endif
#ifndef MK_LAUNCHES
#define MK_LAUNCHES 1
#endif

constexpr int DM = 2048, NB = 8, SEQ = 2048, CTX = 256, GW = 64;
constexpr int MTOK = NB * SEQ;
constexpr int MCTX = NB * CTX;
constexpr int MALL = MTOK + MCTX;
constexpr int NH = 4, HD = 256, MW = 1024, HW = 1024;
constexpr int N_IN = 10256;
constexpr int NEXP = 32, TOPK = 4;
constexpr float LN_EPS = 1e-5f;
constexpr float DN_ALPHA = 1.189207115002721f;
constexpr int ZN = 7424, ZC_QK = 0, ZC_V = 1024, ZC_O = 2048, ZC_GA = 3072, ZC_GH = 5120, ZC_GT = 7168;
constexpr int WIN_ROWS = 10496, WIN_HY0 = 7424;
constexpr int MAXTILES = 288;
constexpr int POSCAP = 16384;

constexpr size_t MiB = 1u << 20;
constexpr size_t WS_CTL = 0;
constexpr size_t WS_MODP = 1203 * MiB;
constexpr size_t WS_MOD = 9 * MiB;
constexpr size_t WS_BINP = 10 * MiB;
constexpr size_t WS_A3 = 10 * MiB + 64 * 1024;
constexpr size_t WS_STATS = 11 * MiB;
constexpr size_t WS_TOPE = 11 * MiB + 256 * 1024;
constexpr size_t WS_TOPP = 11 * MiB + 512 * 1024;
constexpr size_t WS_TOPW = 11 * MiB + 768 * 1024;
constexpr size_t WS_RTOK = 12 * MiB;
constexpr size_t WS_RW = 14 * MiB;
constexpr size_t WS_WQK = 16 * MiB;
constexpr size_t WS_WPH = 17 * MiB;
constexpr size_t WS_WPA2 = 21 * MiB;
constexpr size_t WS_WOUT = 29 * MiB;
constexpr size_t WS_WIN = 37 * MiB;
constexpr size_t WS_WGU = 78 * MiB;
constexpr size_t WS_WD = 590 * MiB;
constexpr size_t WS_RA = 846 * MiB;
constexpr size_t WS_Z = WS_RA, WS_ZT = WS_RA + 261 * MiB, WS_ACT = WS_RA;
constexpr size_t WS_RB = 1203 * MiB;
constexpr size_t WS_HX = WS_RB, WS_U = WS_RB + 72 * MiB, WS_QKB = WS_RB + 108 * MiB, WS_AM = WS_RB + 180 * MiB, WS_HH = WS_RB + 244 * MiB, WS_MX = WS_RB + 276 * MiB, WS_YR = WS_RB;
constexpr size_t WS_RC = 1543 * MiB;
constexpr size_t WS_HTAPS = WS_RC, WS_H = WS_RC + 32 * MiB, WS_T = WS_RC;
constexpr size_t WS_R1 = 1671 * MiB;
constexpr size_t WS_TOK = 1799 * MiB;
constexpr size_t WS_HX8 = WS_RC + 96 * MiB;
constexpr size_t WS_WIN8 = 1863 * MiB;
constexpr size_t WS_DUMMY = 1884 * MiB;
constexpr size_t WS_END = 1890 * MiB;
constexpr int CW_TMO = 0, CW_BAR = 4096, CW_CNT = 16384;
constexpr size_t CTL_ZERO_BYTES = 1 * MiB;

constexpr int LDS_BYTES = 160 * 1024 - 2048;
constexpr int MISC_OFF = LDS_BYTES - 1024;
constexpr int NWAVES = 8, NTHR = 512;

#define LDS_WAIT() asm volatile("s_waitcnt lgkmcnt(0)" ::: "memory")
#define VM_WAIT() asm volatile("s_waitcnt vmcnt(0)" ::: "memory")
__device__ __forceinline__ unsigned f2bf(float f) { unsigned u = __builtin_bit_cast(unsigned, f); return (u + 0x7fffu + ((u >> 16) & 1u)) >> 16; }
__device__ __forceinline__ unsigned pk2(float lo, float hi) { unsigned r; asm("v_cvt_pk_bf16_f32 %0, %1, %2" : "=v"(r) : "v"(lo), "v"(hi)); return r; }
__device__ __forceinline__ unsigned pk4_fp8(float a, float b, float c, float d) { int w = 0; w = __builtin_amdgcn_cvt_pk_fp8_f32(a, b, w, false); w = __builtin_amdgcn_cvt_pk_fp8_f32(c, d, w, true); return (unsigned)w; }
__device__ __forceinline__ float bf2f(unsigned b) { return __builtin_bit_cast(float, b << 16); }
__device__ __forceinline__ float bflo(unsigned w) { return __builtin_bit_cast(float, w << 16); }
__device__ __forceinline__ float bfhi(unsigned w) { return __builtin_bit_cast(float, w & 0xffff0000u); }
__device__ __forceinline__ float sigmoidf_(float x) { return 1.0f / (1.0f + __expf(-x)); }
__device__ __forceinline__ float sigmoid_fast(float x) { return __builtin_amdgcn_rcpf(1.0f + __expf(-x)); }
__device__ __forceinline__ float wave_sum(float v) {
#pragma unroll
    for (int o = 1; o < 64; o <<= 1) v += __shfl_xor(v, o);
    return v;
}

#define DPP_STEP_(OP, x, ctrl, rmask, bmask, ident) { const float t_ = __builtin_bit_cast(float, __builtin_amdgcn_update_dpp(__builtin_bit_cast(int, ident), __builtin_bit_cast(int, x), ctrl, rmask, bmask, false)); x = OP(x, t_); }
__device__ __forceinline__ float scan_add_(float a, float b) { return a + b; }
__device__ __forceinline__ float wave_scan_sum(float v) {
    float x = v; const float z = 0.f;
    { const float t1 = __builtin_bit_cast(float, __builtin_amdgcn_update_dpp(0, __builtin_bit_cast(int, v), 0x111, 0xf, 0xf, false));
      const float t2 = __builtin_bit_cast(float, __builtin_amdgcn_update_dpp(0, __builtin_bit_cast(int, v), 0x112, 0xf, 0xf, false));
      const float t3 = __builtin_bit_cast(float, __builtin_amdgcn_update_dpp(0, __builtin_bit_cast(int, v), 0x113, 0xf, 0xf, false));
      x = (v + t1) + (t2 + t3); }
    DPP_STEP_(scan_add_, x, 0x114, 0xf, 0xe, z)
    DPP_STEP_(scan_add_, x, 0x118, 0xf, 0xc, z)
    DPP_STEP_(scan_add_, x, 0x142, 0xa, 0xf, z)
    DPP_STEP_(scan_add_, x, 0x143, 0xc, 0xf, z)
    return x;
}
__device__ __forceinline__ float wave_scan_max(float v) {
    float x = v; const float ninf = -__builtin_inff(); const int ni = __builtin_bit_cast(int, ninf);
    { const float t1 = __builtin_bit_cast(float, __builtin_amdgcn_update_dpp(ni, __builtin_bit_cast(int, v), 0x111, 0xf, 0xf, false));
      const float t2 = __builtin_bit_cast(float, __builtin_amdgcn_update_dpp(ni, __builtin_bit_cast(int, v), 0x112, 0xf, 0xf, false));
      const float t3 = __builtin_bit_cast(float, __builtin_amdgcn_update_dpp(ni, __builtin_bit_cast(int, v), 0x113, 0xf, 0xf, false));
      x = fmaxf(fmaxf(v, t1), fmaxf(t2, t3)); }
    DPP_STEP_(fmaxf, x, 0x114, 0xf, 0xe, ninf)
    DPP_STEP_(fmaxf, x, 0x118, 0xf, 0xc, ninf)
    DPP_STEP_(fmaxf, x, 0x142, 0xa, 0xf, ninf)
    DPP_STEP_(fmaxf, x, 0x143, 0xc, 0xf, ninf)
    return x;
}
__device__ __forceinline__ float lane_bcast(float v, int l) { return __builtin_bit_cast(float, __builtin_amdgcn_readlane(__builtin_bit_cast(int, v), l)); }
#define XB_TMO      128
#define XB_XCNT(j)  (256  + 64 * (j))
#define XB_XSUB(j)  (1280 + 64 * (j))
#define XB_XGEN(j)  (2304 + 64 * (j))
#define XB_TOP      3328
#define XB_TOPGEN   3392
#define XCD_BAR_WORDS 3456
#define XB_SPIN_CAP (1u << 22)
__device__ __forceinline__ unsigned xb_ld(unsigned* p)              { return __hip_atomic_load(p, __ATOMIC_RELAXED, __HIP_MEMORY_SCOPE_AGENT); }
__device__ __forceinline__ unsigned xb_add(unsigned* p, unsigned v) { return __hip_atomic_fetch_add(p, v, __ATOMIC_RELAXED, __HIP_MEMORY_SCOPE_AGENT); }
__device__ __forceinline__ unsigned xb_xcc_id() { return (unsigned)__builtin_amdgcn_s_getreg((3 << 11) | 20) & 0xFu; }
#define XB_SPIN(cond, bar) do { unsigned _sp = 0; while (cond) { __builtin_amdgcn_s_sleep(1); \
    if ((++_sp & 255u) == 0u) { if (xb_ld(&(bar)[XB_TMO])) break; if (_sp > XB_SPIN_CAP) { atomicAdd(&(bar)[XB_TMO], 1u); break; } } } } while (0)
struct XcdBarrier { unsigned* bar; unsigned x; volatile LAS unsigned* st; };
__device__ __forceinline__ XcdBarrier xcd_barrier_post(unsigned* bar, volatile LAS unsigned* st, int tid) {
    XcdBarrier b; b.bar = bar; b.x = xb_xcc_id(); b.st = st;
    if (tid == 0) (void)xb_add(&bar[XB_XCNT(b.x)], 1u);
    return b;
}
__device__ __forceinline__ void xcd_barrier_complete(unsigned* bar, unsigned x, unsigned& nloc, unsigned& nx) {
    const unsigned G = gridDim.x * gridDim.y * gridDim.z;
    unsigned sum, cnt, mine, sp = 0u;
    for (;;) {
        sum = 0u; cnt = 0u; mine = 0u;
#pragma unroll
        for (unsigned j = 0; j < 16; ++j) { const unsigned c = xb_ld(&bar[XB_XCNT(j)]); sum += c; cnt += (c > 0u) ? 1u : 0u; mine = (j == x) ? c : mine; }
        if (sum == G) break;
        __builtin_amdgcn_s_sleep(1);
        if ((++sp & 255u) == 0u) { if (xb_ld(&bar[XB_TMO])) break; if (sp > XB_SPIN_CAP) { atomicAdd(&bar[XB_TMO], 1u); break; } }
    }
    nloc = mine > 0u ? mine : 1u; nx = cnt > 0u ? cnt : 1u;
}
__device__ __forceinline__ void xcd_barrier(const XcdBarrier& b, int tid) {
    asm volatile("s_waitcnt vmcnt(0)" ::: "memory");
    __syncthreads();
    if (tid == 0) {
        unsigned* bar = b.bar;
        __builtin_amdgcn_s_waitcnt(0);
        unsigned nloc = b.st[0], nx = b.st[1];
        if (nloc == 0u) { xcd_barrier_complete(bar, b.x, nloc, nx); b.st[0] = nloc; b.st[1] = nx; }
        const unsigned old = xb_add(&bar[XB_XSUB(b.x)], 1u);
        const unsigned gen = old / nloc;
        if (old + 1u == (gen + 1u) * nloc) {
            __builtin_amdgcn_fence(__ATOMIC_RELEASE, "agent");
            asm volatile("s_waitcnt vmcnt(0)" ::: "memory");
            const unsigned og = xb_add(&bar[XB_TOP], 1u);
            const unsigned tg = og / nx;
            if (og + 1u == (tg + 1u) * nx) xb_add(&bar[XB_TOPGEN], 1u);
            else XB_SPIN(xb_ld(&bar[XB_TOPGEN]) == tg, bar);
            __builtin_amdgcn_fence(__ATOMIC_ACQUIRE, "agent");
            xb_add(&bar[XB_XGEN(b.x)], 1u);
            asm volatile("s_waitcnt vmcnt(0)" ::: "memory");
        } else {
            XB_SPIN(xb_ld(&bar[XB_XGEN(b.x)]) == gen, bar);
            __builtin_amdgcn_fence(__ATOMIC_ACQUIRE, "agent");
            asm volatile("s_waitcnt vmcnt(0)" ::: "memory");
        }
    }
    __syncthreads();
}

struct Args {
    const float* in[38];
    float* out; unsigned char* ws;
    int ph_lo, ph_hi;
};
enum { I_X = 0, I_C, I_CTX, I_CCTX, I_LNG, I_LNB, I_WMOD, I_BMOD, I_WIN, I_BIN, I_MCW, I_MCB, I_WQH, I_WKH, I_HCW, I_HCB, I_FW1, I_FB1, I_FWH, I_FBH,
       I_FFREQ, I_FWOUT, I_HSKIP, I_WPA, I_WPH, I_WOUT, I_LN1G, I_LN1B, I_WR, I_BR, I_WG, I_BG, I_WU, I_BU, I_WDN, I_BDN, I_LN2G, I_LN2B };

namespace pg8 {
constexpr int BM = 256, BK = 64, HALF = 128, HTB = HALF * BK * 2, STAGE_BYTES = 8 * HTB, NXCD = 8, WGM = 8;
__host__ __device__ __forceinline__ int lds_byte(int r, int c) { const int st = (r >> 4) * 2 + (c >> 5), rr = r & 15, cc = c & 31, ob = rr * 64 + cc * 2; return st * 1024 + (ob ^ (((ob >> 9) & 1) << 5)); }
__host__ __device__ __forceinline__ void stage_rc(int b, int& R, int& C) { const int st = b / 1024, sb = b % 1024, swz = sb ^ (((sb >> 9) & 1) << 5); R = (st >> 1) * 16 + swz / 64; C = (st & 1) * 32 + (swz % 64) / 2; }
__host__ __device__ __forceinline__ int perm32(int rho) { const int n = rho >> 4, i = rho & 15; return 8 * (i >> 2) + 4 * n + (i & 3); }
struct Unit { int pm, pn, ex; };
__device__ __forceinline__ void decode_tile(int L, int nM, int nN, int& pm, int& pn) {
    const int nwg = nM * nN; int wgid = L;
    { const int q = nwg / NXCD, r = nwg % NXCD, xcd = wgid % NXCD, off = wgid / NXCD; wgid = (xcd < r ? xcd * (q + 1) : r * (q + 1) + (xcd - r) * q) + off; }
    const int nig = WGM * nN, gid = wgid / nig, fm = gid * WGM, gsz = (nM - fm) < WGM ? (nM - fm) : WGM;
    pm = fm + ((wgid % nig) % gsz); pn = (wgid % nig) / gsz;
}
__device__ __forceinline__ unsigned cvt_pk_bf16(float lo, float hi) { unsigned r; asm volatile("v_cvt_pk_bf16_f32 %0, %1, %2" : "=v"(r) : "v"(lo), "v"(hi)); return r; }

typedef int i32x8 __attribute__((ext_vector_type(8)));
template <class Epi, class Sched, bool F8 = false>
__device__ __forceinline__ void gemm_phase(const int tid, LAS unsigned char* lds, const int nt, const int pitchA, const int pitchB, const Sched& S, const Epi& E, const int wscale = 0x7F7F7F7F, const int ascale = 0x7F7F7F7F) {
    const int wid = __builtin_amdgcn_readfirstlane(tid >> 6), lane = tid & 63, wr = wid >> 2, wc = wid & 3, fr = lane & 15, fq = lane >> 4;
    int RA[2], CA[2]; unsigned voffB[2];
#pragma unroll
    for (int i = 0; i < 2; ++i) { int R, C; stage_rc(tid * 16 + i * 8192, R, C); const int Rb = Epi::PERM ? ((R & ~31) + perm32(R & 31)) : R;
        RA[i] = R; CA[i] = C; voffB[i] = (unsigned)(Rb * pitchB + C * 2); }
    const size_t kstep = (size_t)(BK * 2);
    const size_t hstepB = (size_t)HALF * pitchB;
    const unsigned ldsw = (unsigned)wid * 1024u;
    const int aoff = lds_byte(wr * 64 + fr, fq * 8), boff = lds_byte(wc * 32 + fr, fq * 8);
#define PG8_SA(b, h) (((b) * 2 + (h)) * HTB)
#define PG8_SB(b, h) ((4 + (b) * 2 + (h)) * HTB)
#define PG8_STAGE(bufoff, gbase, v0, v1) do { \
        __builtin_amdgcn_global_load_lds((const unsigned*)((const char*)(gbase) + (v0)), (LAS unsigned*)(lds + (bufoff) + ldsw), 16, 0, 0); \
        __builtin_amdgcn_global_load_lds((const unsigned*)((const char*)(gbase) + (v1)), (LAS unsigned*)(lds + (bufoff) + ldsw + 8192), 16, 0, 0); } while (0)
#define PG8_LD8(off) __builtin_bit_cast(i32x8, __builtin_shufflevector(*(const LAS u32x4*)(lds + (off)), *(const LAS u32x4*)(lds + (off) + 1024), 0, 1, 2, 3, 4, 5, 6, 7))
#define PG8_LDA(dst, b, h) do { _Pragma("unroll") for (int m = 0; m < 4; ++m) { if (F8) dst##8[m] = PG8_LD8(PG8_SA(b, h) + aoff + m * 2048); else { _Pragma("unroll") for (int k = 0; k < 2; ++k) dst[m][k] = *(const LAS bf16x8*)(lds + PG8_SA(b, h) + aoff + m * 2048 + k * 1024); } } } while (0)
#define PG8_LDB(dst, b, h) do { _Pragma("unroll") for (int n = 0; n < 2; ++n) { if (F8) dst##8[n] = PG8_LD8(PG8_SB(b, h) + boff + n * 2048); else { _Pragma("unroll") for (int k = 0; k < 2; ++k) dst[n][k] = *(const LAS bf16x8*)(lds + PG8_SB(b, h) + boff + n * 2048 + k * 1024); } } } while (0)
#define PG8_CAT(x) __builtin_shufflevector(__builtin_bit_cast(u32x4, x[0]), __builtin_bit_cast(u32x4, x[1]), 0, 1, 2, 3, 4, 5, 6, 7)
#define PG8_MMA(ai, bj, At, Bt) do { __builtin_amdgcn_s_setprio(1); _Pragma("unroll") for (int m = 0; m < 4; ++m) _Pragma("unroll") for (int n = 0; n < 2; ++n) { \
        if (F8) { asm volatile("v_mfma_scale_f32_16x16x128_f8f6f4 %0, %1, %2, %0, %3, %4 op_sel_hi:[0,0,0]" : "+v"(acc[ai][bj][m][n]) : "v"(Bt##8[n]), "v"(At##8[m]), "v"(wscale), "v"(ascale)); } \
        else { _Pragma("unroll") for (int k = 0; k < 2; ++k) acc[ai][bj][m][n] = __builtin_amdgcn_mfma_f32_16x16x32_bf16(Bt[n][k], At[m][k], acc[ai][bj][m][n], 0, 0, 0); } } __builtin_amdgcn_s_setprio(0); } while (0)
#define PG8_WAIT_V(n) asm volatile("s_waitcnt vmcnt(" #n ")" ::: "memory")
#define PG8_WAIT_L(n) asm volatile("s_waitcnt lgkmcnt(" #n ")" ::: "memory")
#define PG8_BAR __builtin_amdgcn_s_barrier()
#define PG8_SCHED __builtin_amdgcn_sched_barrier(0)
#define PG8_AOFF(u, o00, o01, o10, o11) do { \
        if (Sched::GATHER) { o00 = (unsigned)(S.a_row(u, RA[0]) * pitchA + CA[0] * 2); o01 = (unsigned)(S.a_row(u, RA[1]) * pitchA + CA[1] * 2); \
                             o10 = (unsigned)(S.a_row(u, RA[0] + HALF) * pitchA + CA[0] * 2); o11 = (unsigned)(S.a_row(u, RA[1] + HALF) * pitchA + CA[1] * 2); } \
        else { o00 = (unsigned)(RA[0] * pitchA + CA[0] * 2); o01 = (unsigned)(RA[1] * pitchA + CA[1] * 2); o10 = (unsigned)((RA[0] + HALF) * pitchA + CA[0] * 2); o11 = (unsigned)((RA[1] + HALF) * pitchA + CA[1] * 2); } } while (0)
    Unit cur, nxt; int ui = 0;
    if (!S.next(0, cur)) return;
    f32x4 acc[2][2][4][2];
#pragma unroll
    for (int a = 0; a < 2; ++a)
#pragma unroll
        for (int b = 0; b < 2; ++b)
#pragma unroll
            for (int m = 0; m < 4; ++m)
#pragma unroll
                for (int n = 0; n < 2; ++n) acc[a][b][m][n] = (f32x4){0.f, 0.f, 0.f, 0.f};
    bf16x8 At[4][2], B0[2][2], B1[2][2]; i32x8 At8[4], B08[2], B18[2];
    const char* cA = S.a_base(cur); const char* cB = S.b_base(cur);
    unsigned c00, c01, c10, c11; PG8_AOFF(cur, c00, c01, c10, c11);
    const unsigned vb0 = voffB[0], vb1 = voffB[1];
    PG8_STAGE(PG8_SB(0, 0), cB, vb0, vb1); PG8_STAGE(PG8_SA(0, 0), cA, c00, c01); PG8_STAGE(PG8_SB(0, 1), cB + hstepB, vb0, vb1); PG8_STAGE(PG8_SA(0, 1), cA, c10, c11);
    if (wr == 1) PG8_BAR;
    PG8_WAIT_V(4); PG8_BAR;
    PG8_STAGE(PG8_SB(1, 0), cB + kstep, vb0, vb1); PG8_STAGE(PG8_SA(1, 0), cA + kstep, c00, c01); PG8_STAGE(PG8_SB(1, 1), cB + hstepB + kstep, vb0, vb1);
    PG8_WAIT_V(6); PG8_BAR;
    for (;;) {
        const bool has_next = S.next(ui + 1, nxt);
        const char* nA = has_next ? S.a_base(nxt) : cA; const char* nB = has_next ? S.b_base(nxt) : cB;
        unsigned n00 = c00, n01 = c01, n10 = c10, n11 = c11;
        if (has_next) PG8_AOFF(nxt, n00, n01, n10, n11);
        for (int t = 0; t < nt; t += 2) {
            const bool last = (t == nt - 2);
            const char* a1 = cA + (size_t)(t + 1) * kstep;
            const char* a2 = last ? nA : cA + (size_t)(t + 2) * kstep; const char* b2 = last ? nB : cB + (size_t)(t + 2) * kstep;
            const char* a3 = a2 + kstep; const char* b3 = b2 + kstep;
            const unsigned x00 = last ? n00 : c00, x01 = last ? n01 : c01, x10 = last ? n10 : c10, x11 = last ? n11 : c11;
            PG8_LDB(B0, 0, 0); PG8_SCHED; PG8_LDA(At, 0, 0); PG8_STAGE(PG8_SA(1, 1), a1, c10, c11);
            PG8_WAIT_L(8); PG8_BAR; PG8_WAIT_L(0); PG8_MMA(0, 0, At, B0); PG8_BAR; PG8_SCHED;
            PG8_LDB(B1, 0, 1); PG8_STAGE(PG8_SB(0, 0), b2, vb0, vb1);
            PG8_BAR; PG8_WAIT_L(0); PG8_MMA(0, 1, At, B1); PG8_BAR;
            PG8_LDA(At, 0, 1); PG8_STAGE(PG8_SA(0, 0), a2, x00, x01);
            PG8_BAR; PG8_WAIT_L(0); PG8_MMA(1, 0, At, B0); PG8_BAR; PG8_SCHED;
            PG8_STAGE(PG8_SB(0, 1), b2 + hstepB, vb0, vb1);
            PG8_WAIT_V(6); PG8_BAR; PG8_MMA(1, 1, At, B1); PG8_BAR;
            PG8_LDB(B0, 1, 0); PG8_SCHED; PG8_LDA(At, 1, 0); PG8_STAGE(PG8_SA(0, 1), a2, x10, x11);
            PG8_WAIT_L(8); PG8_BAR; PG8_WAIT_L(0); PG8_MMA(0, 0, At, B0); PG8_BAR; PG8_SCHED;
            PG8_LDB(B1, 1, 1); PG8_STAGE(PG8_SB(1, 0), b3, vb0, vb1);
            PG8_BAR; PG8_WAIT_L(0); PG8_MMA(0, 1, At, B1); PG8_BAR;
            PG8_LDA(At, 1, 1); PG8_STAGE(PG8_SA(1, 0), a3, x00, x01);
            PG8_BAR; PG8_WAIT_L(0); PG8_MMA(1, 0, At, B0); PG8_BAR; PG8_SCHED;
            PG8_STAGE(PG8_SB(1, 1), b3 + hstepB, vb0, vb1);
            PG8_WAIT_V(6); PG8_BAR; PG8_MMA(1, 1, At, B1); PG8_BAR;
        }
        if (F8) asm volatile("s_nop 15\n\ts_nop 15" ::: "memory");
        E(acc, cur, wr, wc, fr, fq);
        if (!has_next) break;
#pragma unroll
        for (int a = 0; a < 2; ++a)
#pragma unroll
            for (int b = 0; b < 2; ++b)
#pragma unroll
                for (int m = 0; m < 4; ++m)
#pragma unroll
                    for (int n = 0; n < 2; ++n) acc[a][b][m][n] = (f32x4){0.f, 0.f, 0.f, 0.f};
        cur = nxt; cA = nA; cB = nB; c00 = n00; c01 = n01; c10 = n10; c11 = n11; ++ui;
    }
    PG8_WAIT_V(0);
    if (wr == 0) PG8_BAR;
    PG8_BAR;
#undef PG8_SA
#undef PG8_SB
#undef PG8_STAGE
#undef PG8_LDA
#undef PG8_LDB
#undef PG8_MMA
#undef PG8_WAIT_V
#undef PG8_WAIT_L
#undef PG8_BAR
#undef PG8_SCHED
#undef PG8_AOFF
#undef PG8_CAT
#undef PG8_LD8
}
}
using pg8::Unit;

typedef const float* cfp_t;
typedef __attribute__((address_space(4))) const cfp_t* KargP;
__device__ __forceinline__ KargP karg_opaque(KargP p) { asm volatile("" : "+s"(p)); return p; }
struct Frame {
    LAS unsigned char* lds;
    volatile LAS unsigned* MISC;
    unsigned* ctl;
    int tid, lane, wave, wave0, G, bid;
    KargP in;
    float* out; unsigned char* ws;
};
#define WSP(T, off) ((T*)(F.ws + (off)))

__device__ __forceinline__ void transpose_item(const float* src, size_t ld, int nvalid, float scale, bf16_t* dst, int K, LAS float* scr, int lane) {
    { float tv[32]; const int j = lane & 31;
#pragma unroll
      for (int i = 0; i < 32; ++i) tv[i] = (j < nvalid) ? src[(size_t)(2 * i + (lane >> 5)) * ld + j] : 0.f;
#pragma unroll
      for (int i = 0; i < 32; ++i) scr[(2 * i + (lane >> 5)) * 33 + j] = tv[i] * scale; }
    LDS_WAIT(); asm volatile("" ::: "memory");
    const int c = lane & 7;
#pragma unroll
    for (int j = 0; j < 4; ++j) { const int n = (lane >> 3) + 8 * j; const LAS float* s = scr + (8 * c) * 33 + n;
        u32x4 o; o.x = pk2(s[0 * 33], s[1 * 33]); o.y = pk2(s[2 * 33], s[3 * 33]); o.z = pk2(s[4 * 33], s[5 * 33]); o.w = pk2(s[6 * 33], s[7 * 33]);
        *(u32x4*)(dst + (size_t)n * K + 8 * c) = o; }
    LDS_WAIT(); asm volatile("" ::: "memory");
}
struct CvItem { const float* src; unsigned char* dst; float scale; int rstep; };
__device__ __forceinline__ CvItem cv_decode(KargP in, unsigned char* ws, int it) {
    CvItem c;
    if (it < NEXP * 256) { const int e = it >> 8, q = it & 255, up = q & 1, g = (q >> 1) & 7, kb = q >> 4;
        c.src = (up ? in[I_WU] : in[I_WG]) + (size_t)e * DM * DM + (size_t)(128 * kb) * DM + 256 * g;
        c.dst = ws + WS_WGU + ((size_t)e * 4096 + 512 * g + up * 128) * DM + 128 * kb; c.scale = 32.f; c.rstep = 256; }
    else { const int r2 = it - NEXP * 256; const int e = r2 >> 7, q = r2 & 127, g = q & 7, kb = q >> 3;
        c.src = in[I_WDN] + (size_t)e * DM * DM + (size_t)(128 * kb) * DM + 256 * g;
        c.dst = ws + WS_WD + ((size_t)e * 2048 + 256 * g) * DM + 128 * kb; c.scale = 64.f; c.rstep = 128; }
    return c;
}
constexpr int CV_E8X = 8, CV_P0N = 3;
__device__ __forceinline__ int cv_map(int i) { constexpr int n1 = CV_P0N * 256; return i < n1 ? CV_E8X * 256 + i : NEXP * 256 + CV_E8X * 128 + (i - n1); }
#define CV_LOAD(v, c) do { _Pragma("unroll") for (int i_ = 0; i_ < 16; ++i_) v[i_] = __builtin_nontemporal_load((const f32x4*)((c).src + (size_t)(16 * w + i_) * DM + 4 * lane)); } while (0)
#define CV_PROC(v, c) do { \
        _Pragma("unroll") for (int j_ = 0; j_ < 4; ++j_) { u32x4 o_; const float s_ = (c).scale; \
            o_.x = pk4_fp8(v[0][j_] * s_, v[1][j_] * s_, v[2][j_] * s_, v[3][j_] * s_);     o_.y = pk4_fp8(v[4][j_] * s_, v[5][j_] * s_, v[6][j_] * s_, v[7][j_] * s_); \
            o_.z = pk4_fp8(v[8][j_] * s_, v[9][j_] * s_, v[10][j_] * s_, v[11][j_] * s_);   o_.w = pk4_fp8(v[12][j_] * s_, v[13][j_] * s_, v[14][j_] * s_, v[15][j_] * s_); \
            *(LAS u32x4*)(tile + (4 * lane + j_) * 144 + 16 * w) = o_; } \
        __syncthreads(); \
        _Pragma("unroll") for (int q_ = 0; q_ < 4; ++q_) { const int idx_ = tid + 512 * q_, row_ = idx_ >> 3, piece_ = idx_ & 7; \
            *(u32x4*)((c).dst + (size_t)((row_ >> 7) * (c).rstep + (row_ & 127)) * DM + 16 * piece_) = *(const LAS u32x4*)(tile + row_ * 144 + 16 * piece_); } \
        __syncthreads(); } while (0)
__device__ __forceinline__ void convert_moe_weights(KargP in, unsigned char* ws, LAS unsigned char* tile, int tid, int bid, int G) {
    const int w = tid >> 6, lane = tid & 63;
    constexpr int NIT = CV_P0N * (256 + 128);
    f32x4 va[16], vb[16];
    int it = bid;
    if (it >= NIT) return;
    CvItem ca = cv_decode(in, ws, cv_map(it)), cb = ca;
    CV_LOAD(va, ca);
    for (;;) {
        const bool hb = it + G < NIT;
        if (hb) { cb = cv_decode(in, ws, cv_map(it + G)); CV_LOAD(vb, cb); }
        CV_PROC(va, ca);
        if (!hb) break;
        it += G;
        const bool ha = it + G < NIT;
        if (ha) { ca = cv_decode(in, ws, cv_map(it + G)); CV_LOAD(va, ca); }
        CV_PROC(vb, cb);
        if (!ha) break;
        it += G;
    }
}
#undef CV_LOAD
#undef CV_PROC
__device__ __forceinline__ void transpose_item_f8(const float* src, size_t ld, float scale, unsigned char* dst, int K, LAS float* scr, int lane) {
    { float tv[32]; const int j = lane & 31;
#pragma unroll
      for (int i = 0; i < 32; ++i) tv[i] = src[(size_t)(2 * i + (lane >> 5)) * ld + j];
#pragma unroll
      for (int i = 0; i < 32; ++i) scr[(2 * i + (lane >> 5)) * 33 + j] = tv[i] * scale; }
    LDS_WAIT(); asm volatile("" ::: "memory");
    const int c = lane & 3;
#pragma unroll
    for (int j = 0; j < 2; ++j) { const int n = (lane >> 2) + 16 * j; const LAS float* s = scr + (16 * c) * 33 + n;
        u32x4 o; o.x = pk4_fp8(s[0 * 33], s[1 * 33], s[2 * 33], s[3 * 33]); o.y = pk4_fp8(s[4 * 33], s[5 * 33], s[6 * 33], s[7 * 33]);
        o.z = pk4_fp8(s[8 * 33], s[9 * 33], s[10 * 33], s[11 * 33]); o.w = pk4_fp8(s[12 * 33], s[13 * 33], s[14 * 33], s[15 * 33]);
        *(u32x4*)(dst + (size_t)n * K + 16 * c) = o; }
    LDS_WAIT(); asm volatile("" ::: "memory");
}
__device__ __forceinline__ void p0_phase(Frame& F) {
    const KargP in = karg_opaque(F.in);
    LAS float* scr = (LAS float*)(F.lds + F.wave * 16384);
    const int gw = F.bid * NWAVES + F.wave, NGW = F.G * NWAVES;
    constexpr int IT_WIN = 32 * (WIN_ROWS / 32);
    constexpr int IT_WQK = 4 * 64;
    constexpr int IT_WPA2 = 32 * 64;
    constexpr int IT_WPH = 16 * 64;
    constexpr int IT_WOUT = 32 * 64;
    constexpr int NITEMS = IT_WIN + IT_WQK + IT_WPA2 + IT_WPH + IT_WOUT;
    for (int it = gw; it < NITEMS; it += NGW) {
        int r = it;
        if (r < IT_WIN) { const int g = r % (WIN_ROWS / 32), kb = r / (WIN_ROWS / 32); const int n0 = 32 * g; int sc, nv = 32;
            if (n0 < 2048) sc = n0; else if (n0 < 3072) sc = 2064 + (n0 - 2048); else if (n0 < 7168) sc = 6160 + (n0 - 3072); else if (n0 < 7200) { sc = 2048; nv = 16; } else if (n0 < WIN_HY0) { sc = 0; nv = 0; } else sc = 3088 + (n0 - WIN_HY0);
            if (n0 < 2048 || (n0 >= 7168 && n0 < WIN_HY0)) transpose_item(in[I_WIN] + (size_t)(64 * kb) * N_IN + sc, N_IN, nv, 1.f, WSP(bf16_t, WS_WIN) + (size_t)n0 * DM + 64 * kb, DM, scr, F.lane);
            if (n0 >= 1024 && !(n0 >= 7168 && n0 < WIN_HY0)) transpose_item_f8(in[I_WIN] + (size_t)(64 * kb) * N_IN + sc, N_IN, 32.f, WSP(unsigned char, WS_WIN8) + (size_t)n0 * DM + 64 * kb, DM, scr, F.lane);
            continue; } r -= IT_WIN;
        if (r < IT_WQK) { const int g = r % 64, kb = r / 64; const int n0 = 32 * g, h = n0 / 512, j = (n0 % 512) / 256, e0 = n0 % 256;
            const float* src = (j ? in[I_WKH] : in[I_WQH]) + (size_t)h * 65536 + (size_t)(64 * kb) * 256 + e0;
            transpose_item(src, 256, 32, j ? 0.0625f : 1.f, WSP(bf16_t, WS_WQK) + (size_t)n0 * 256 + 64 * kb, 256, scr, F.lane); continue; } r -= IT_WQK;
        if (r < IT_WPA2) { const int g = r % 64, kb = r / 64; const int n0 = 32 * g, k0 = 64 * kb;
            transpose_item_f8(in[I_WPA] + (size_t)(k0 % 1024) * DM + n0, DM, 32.f, WSP(unsigned char, WS_WPA2) + (size_t)n0 * 2048 + k0, 2048, scr, F.lane); continue; } r -= IT_WPA2;
        if (r < IT_WPH) { const int g = r % 64, kb = r / 64; const int n0 = 32 * g, k0 = 64 * kb;
            transpose_item_f8(in[I_WPH] + (size_t)k0 * DM + n0, DM, 32.f, WSP(unsigned char, WS_WPH) + (size_t)n0 * 1024 + k0, 1024, scr, F.lane); continue; } r -= IT_WPH;
        if (r < IT_WOUT) { const int g = r % 64, kb = r / 64; const int n0 = 32 * g, k0 = 64 * kb;
            transpose_item_f8(in[I_WOUT] + (size_t)k0 * DM + n0, DM, 64.f, WSP(unsigned char, WS_WOUT) + (size_t)n0 * 2048 + k0, 2048, scr, F.lane); continue; } r -= IT_WOUT;
        (void)r;
    }
    __syncthreads();
    convert_moe_weights(in, F.ws, (LAS unsigned char*)F.lds, F.tid, F.bid, F.G);
    for (int i = F.bid * NTHR + F.tid; i < WIN_ROWS; i += F.G * NTHR) { int sc = -1;
        if (i < 2048) sc = i; else if (i < 3072) sc = 2064 + (i - 2048); else if (i < 7168) sc = 6160 + (i - 3072); else if (i < 7184) sc = 2048 + (i - 7168); else if (i < WIN_HY0) sc = -1; else sc = 3088 + (i - WIN_HY0);
        WSP(float, WS_BINP)[i] = sc >= 0 ? in[I_BIN][sc] : 0.f; }
    for (int it = F.bid + F.G * F.wave; it < 32 * 48; it += F.G * NWAVES) {
        const int ks = it / 48, cg = it % 48; const int col = cg * 256 + F.lane * 4, k0 = ks * 64;
#pragma unroll
        for (int v = 0; v < 9; ++v) { const float cv = (v < 8) ? in[I_C][v * DM + k0 + F.lane] : in[I_CCTX][k0 + F.lane]; scr[v * 64 + F.lane] = cv * sigmoidf_(cv); }
        LDS_WAIT(); asm volatile("" ::: "memory");
        f32x4 a[9];
#pragma unroll
        for (int v = 0; v < 9; ++v) a[v] = (f32x4){0.f, 0.f, 0.f, 0.f};
#pragma unroll 1
        for (int kb = 0; kb < 64; kb += 16) {
            f32x4 w[16];
#pragma unroll
            for (int i = 0; i < 16; ++i) w[i] = *(const f32x4*)(in[I_WMOD] + (size_t)(k0 + kb + i) * 12288 + col);
#pragma unroll
            for (int v = 0; v < 9; ++v)
#pragma unroll
                for (int q = 0; q < 4; ++q) { const f32x4 s4 = *(const LAS f32x4*)(scr + v * 64 + kb + 4 * q);
                    a[v] += w[4 * q] * s4.x; a[v] += w[4 * q + 1] * s4.y; a[v] += w[4 * q + 2] * s4.z; a[v] += w[4 * q + 3] * s4.w; }
        }
#pragma unroll
        for (int v = 0; v < 9; ++v) *(f32x4*)(WSP(float, WS_MODP) + ((size_t)ks * 9 + v) * 12288 + col) = a[v];
        LDS_WAIT(); asm volatile("" ::: "memory");
    }
    for (int j = gw; j < SEQ; j += NGW) {
        const int l = F.lane;
        float zv = 0.f;
        if (l == 0) zv = (float)j / (float)(SEQ - 1);
        else if (l < 33) { const int bi = (l - 1) & 15; const float f = 1e-4f + (float)bi * ((15.0f - 1e-4f) / 15.0f); const float ang = 6.283185307179586f * (float)j * f / (float)SEQ; zv = (l < 17) ? cosf(ang) : -sinf(ang); }
        float pre = in[I_FB1][l];
        for (int i = 0; i < 33; ++i) pre += __shfl(zv, i) * in[I_FW1][i * 64 + l];
        float a = sinf(in[I_FFREQ][l] * pre);
        pre = in[I_FBH][l];
        for (int i = 0; i < 64; ++i) pre += __shfl(a, i) * in[I_FWH][i * 64 + l];
        float a2 = sinf(in[I_FFREQ][64 + l] * pre);
        pre = in[I_FBH][64 + l];
        for (int i = 0; i < 64; ++i) pre += __shfl(a2, i) * in[I_FWH][4096 + i * 64 + l];
        WSP(float, WS_A3)[j * 64 + l] = sinf(in[I_FFREQ][128 + l] * pre);
    }
}

__device__ __forceinline__ void p0b_phase(Frame& F) {
    const KargP in = karg_opaque(F.in);
    for (int i = F.bid * NTHR + F.tid; i < 9 * 12288; i += F.G * NTHR) { const int col = i % 12288; float s = in[I_BMOD][col];
        for (int ks = 0; ks < 32; ++ks) s += WSP(float, WS_MODP)[(size_t)ks * 9 * 12288 + i];
        WSP(float, WS_MOD)[i] = s; }
    LAS float* wl = (LAS float*)F.lds;
    for (int un = F.bid; un < 256; un += F.G) {
        const int ct = un >> 2, pg = un & 3;
        __syncthreads();
        for (int q = 0; q < 8; ++q) { const int idx = F.tid + 512 * q, i = idx >> 6, cc = idx & 63; wl[cc * 68 + i] = in[I_FWOUT][(size_t)i * 4096 + ct * 64 + cc]; }
        __syncthreads();
        const int j = pg * 512 + F.wave * 64 + F.lane;
        f32x4 ar[16];
#pragma unroll
        for (int q = 0; q < 16; ++q) ar[q] = *(const f32x4*)(WSP(float, WS_A3) + j * 64 + 4 * q);
        const float tj = (float)j / (float)(SEQ - 1);
        const float mind = -3.0701134573253944f, maxd = -15.350567286626972f;
        const int cbase = (ct * 64) & 1023;
#pragma unroll 1
        for (int cc = 0; cc < 64; ++cc) {
            f32x4 s = (f32x4){0.f, 0.f, 0.f, 0.f};
#pragma unroll
            for (int q = 0; q < 16; ++q) s += ar[q] * *(const LAS f32x4*)(wl + cc * 68 + 4 * q);
            const float delta = fabsf(mind + (float)(cbase + cc) * ((maxd - mind) / 1023.0f));
            const float v = ((s.x + s.y) + (s.z + s.w)) * __expf(-tj * delta);
            WSP(float, WS_HTAPS)[(size_t)(ct * 64 + cc) * SEQ + j] = v;
        }
    }
}

__device__ __forceinline__ f32x2 cmul(f32x2 a, f32x2 b) { return (f32x2){a.x * b.x - a.y * b.y, a.x * b.y + a.y * b.x}; }
__device__ __forceinline__ f32x2 cmulc(f32x2 a, f32x2 b) { return (f32x2){a.x * b.x + a.y * b.y, a.y * b.x - a.x * b.y}; }
__device__ __forceinline__ f32x2 cmulp(f32x2 a, f32x2 w, f32x2 iw) { return __builtin_elementwise_fma(a.yy, iw, a.xx * w); }
__device__ __forceinline__ f32x2 rot_i(f32x2 w) { return w.yx * (f32x2){-1.f, 1.f}; }
__device__ __forceinline__ f32x2 cmulq(f32x2 a, f32x2 b) { return cmulp(a, b, rot_i(b)); }
template <bool INV> __device__ __forceinline__ void dft4(f32x2& a, f32x2& b, f32x2& c, f32x2& d) {
    const f32x2 s0 = a + c, s1 = a - c, s2 = b + d, s3 = b - d;
    const f32x2 pm = (f32x2){1.f, -1.f}, mp = (f32x2){-1.f, 1.f};
    a = s0 + s2; c = s0 - s2;
    if (!INV) { b = __builtin_elementwise_fma(s3.yx, pm, s1); d = __builtin_elementwise_fma(s3.yx, mp, s1); }
    else      { b = __builtin_elementwise_fma(s3.yx, mp, s1); d = __builtin_elementwise_fma(s3.yx, pm, s1); }
}
template <bool INV> __device__ __forceinline__ void dft16(f32x2 (&v)[16]) {
#pragma unroll
    for (int n0 = 0; n0 < 4; ++n0) dft4<INV>(v[n0], v[4 + n0], v[8 + n0], v[12 + n0]);
    const float c1 = 0.9238795325112867f, s1 = 0.3826834323650898f, r2 = 0.7071067811865476f;
    const float cs[10] = {1.f, c1, r2, s1, 0.f, -s1, -r2, -c1, -1.f, -c1};
    const float sn[10] = {0.f, s1, r2, c1, 1.f, c1, r2, s1, 0.f, -s1};
#pragma unroll
    for (int k0 = 1; k0 < 4; ++k0)
#pragma unroll
        for (int n0 = 1; n0 < 4; ++n0) { const int m = n0 * k0; const f32x2 w = (f32x2){cs[m], INV ? sn[m] : -sn[m]}; v[4 * k0 + n0] = cmulp(v[4 * k0 + n0], w, (f32x2){-w.y, w.x}); }
#pragma unroll
    for (int k0 = 0; k0 < 4; ++k0) dft4<INV>(v[4 * k0], v[4 * k0 + 1], v[4 * k0 + 2], v[4 * k0 + 3]);
#pragma unroll
    for (int a = 0; a < 4; ++a)
#pragma unroll
        for (int b = a + 1; b < 4; ++b) { const f32x2 t = v[4 * a + b]; v[4 * a + b] = v[4 * b + a]; v[4 * b + a] = t; }
}
__device__ __forceinline__ int fphys(int i) { return i + (i >> 4); }
constexpr int FFT_BUF_BYTES = (4096 + 256) * 8;
struct FftTw { f32x2 wA, wB; };
__device__ __forceinline__ FftTw fft_tw(int ht) { FftTw t; float s, c; sincospif(-(float)ht / 2048.0f, &s, &c); t.wA = (f32x2){c, s}; sincospif(-(float)(ht & 15) / 128.0f, &s, &c); t.wB = (f32x2){c, s}; return t; }
template <bool CONJ> __device__ __forceinline__ void tw_apply(f32x2 (&v)[16], f32x2 w1) {
    if (CONJ) w1 = rot_i(w1).yx;
    const f32x2 w2 = cmulq(w1, w1), w3 = cmulq(w2, w1), w4 = cmulq(w2, w2), w5 = cmulq(w4, w1), w6 = cmulq(w4, w2), w7 = cmulq(w4, w3), w8 = cmulq(w4, w4);
    v[1] = cmulq(v[1], w1); v[2] = cmulq(v[2], w2); v[3] = cmulq(v[3], w3); v[4] = cmulq(v[4], w4); v[5] = cmulq(v[5], w5); v[6] = cmulq(v[6], w6); v[7] = cmulq(v[7], w7); v[8] = cmulq(v[8], w8);
    const f32x2 i8 = rot_i(w8);
    v[9] = cmulq(v[9], cmulp(w1, w8, i8)); v[10] = cmulq(v[10], cmulp(w2, w8, i8)); v[11] = cmulq(v[11], cmulp(w3, w8, i8)); v[12] = cmulq(v[12], cmulp(w4, w8, i8));
    v[13] = cmulq(v[13], cmulp(w5, w8, i8)); v[14] = cmulq(v[14], cmulp(w6, w8, i8)); v[15] = cmulq(v[15], cmulp(w7, w8, i8));
}
struct NoHook { template <int SET> __device__ __forceinline__ void act() {} };
struct NoPf { __device__ __forceinline__ void operator()() const {} };
template <int A0, int A1, class HK, class PF> __device__ __forceinline__ void fft_fwd(f32x2 (&v)[16], LAS f32x2* buf, int ht, const FftTw& tw_, HK& hk, const PF& pf) {
    FftTw tw = tw_; asm volatile("" : "+v"(ht), "+v"(tw.wA.x), "+v"(tw.wA.y), "+v"(tw.wB.x), "+v"(tw.wB.y));
    dft16<false>(v);
    tw_apply<false>(v, tw.wA);
#pragma unroll
    for (int k = 0; k < 16; ++k) buf[fphys(256 * k + ht)] = v[k];
    __syncthreads(); if (A0 >= 0) hk.template act<(A0 > 0)>();
    const int ka = ht >> 4, s = ht & 15;
#pragma unroll
    for (int b = 0; b < 16; ++b) v[b] = buf[fphys(256 * ka + 16 * b + s)];
    dft16<false>(v);
    tw_apply<false>(v, tw.wB);
#pragma unroll
    for (int k = 0; k < 16; ++k) buf[fphys(256 * ka + 16 * k + s)] = v[k];
    pf();
    __syncthreads(); if (A1 >= 0) hk.template act<(A1 > 0)>();
#pragma unroll
    for (int q = 0; q < 16; ++q) v[q] = buf[fphys(16 * ht + q)];
    dft16<false>(v);
}
template <int A0, int A1, int A2, class HK> __device__ __forceinline__ void fft_inv(f32x2 (&v)[16], LAS f32x2* buf, int ht, const FftTw& tw_, HK& hk) {
    FftTw tw = tw_; asm volatile("" : "+v"(ht), "+v"(tw.wA.x), "+v"(tw.wA.y), "+v"(tw.wB.x), "+v"(tw.wB.y));
    dft16<true>(v);
#pragma unroll
    for (int q = 0; q < 16; ++q) buf[fphys(16 * ht + q)] = v[q];
    __syncthreads(); if (A0 >= 0) hk.template act<(A0 > 0)>();
    const int ka = ht >> 4, s = ht & 15;
#pragma unroll
    for (int k = 0; k < 16; ++k) v[k] = buf[fphys(256 * ka + 16 * k + s)];
    tw_apply<true>(v, tw.wB);
    dft16<true>(v);
#pragma unroll
    for (int b = 0; b < 16; ++b) buf[fphys(256 * ka + 16 * b + s)] = v[b];
    __syncthreads(); if (A1 >= 0) hk.template act<(A1 > 0)>();
#pragma unroll
    for (int k = 0; k < 16; ++k) v[k] = buf[fphys(256 * k + ht)];
    tw_apply<true>(v, tw.wA);
    dft16<true>(v);
    __syncthreads(); if (A2 >= 0) hk.template act<(A2 > 0)>();
}

__device__ __forceinline__ void p1_phase(Frame& F) {
    const KargP in = karg_opaque(F.in);
    const int gw = F.bid * NWAVES + F.wave, NGW = F.G * NWAVES;
    const float* mod = WSP(float, WS_MOD);
    {
        f32x4 pg[8], pb[8];
#pragma unroll
        for (int j = 0; j < 8; ++j) { pg[j] = *(const f32x4*)(in[I_LNG] + F.lane * 4 + 256 * j); pb[j] = *(const f32x4*)(in[I_LNB] + F.lane * 4 + 256 * j); }
#pragma unroll 1
        for (int grp = gw; grp < MALL / 8; grp += NGW) {
            const int row0 = grp * 8; const bool lat = row0 < MTOK;
            const float* xb = lat ? in[I_X] + (size_t)row0 * DM : in[I_CTX] + (size_t)(row0 - MTOK) * DM;
            const float* mv = mod + (size_t)(lat ? row0 / SEQ : 8) * 12288;
            f32x4 psh[8], psc[8];
#pragma unroll
            for (int j = 0; j < 8; ++j) { psh[j] = *(const f32x4*)(mv + F.lane * 4 + 256 * j); psc[j] = *(const f32x4*)(mv + 2048 + F.lane * 4 + 256 * j) + 1.0f; }
            f32x4 v[8], vn[8];
#pragma unroll
            for (int j = 0; j < 8; ++j) v[j] = *(const f32x4*)(xb + F.lane * 4 + 256 * j);
#pragma unroll 1
            for (int ri = 0; ri < 8; ++ri) {
                const float* xn = xb + (size_t)(ri < 7 ? ri + 1 : ri) * DM;
#pragma unroll
                for (int j = 0; j < 8; ++j) vn[j] = *(const f32x4*)(xn + F.lane * 4 + 256 * j);
                float s = 0.f;
#pragma unroll
                for (int j = 0; j < 8; ++j) s += (v[j].x + v[j].y) + (v[j].z + v[j].w);
                const float mean = wave_sum(s) * (1.f / DM); float s2 = 0.f;
#pragma unroll
                for (int j = 0; j < 8; ++j) { v[j] = v[j] - mean; s2 += (v[j].x * v[j].x + v[j].y * v[j].y) + (v[j].z * v[j].z + v[j].w * v[j].w); }
                const float rstd = 1.f / sqrtf(wave_sum(s2) * (1.f / DM) + LN_EPS);
                const int row = row0 + ri;
                if (lat && F.lane == 0) { WSP(float, WS_STATS)[row * 2] = mean; WSP(float, WS_STATS)[row * 2 + 1] = rstd; }
                bf16_t* orow = WSP(bf16_t, WS_HX) + (size_t)row * DM;
#pragma unroll
                for (int j = 0; j < 8; ++j) { const f32x4 y = (v[j] * rstd * pg[j] + pb[j]) * psc[j] + psh[j];
                    u32x2 o; o.x = pk2(y.x, y.y); o.y = pk2(y.z, y.w); *(u32x2*)(orow + F.lane * 4 + 256 * j) = o;
                    if (lat) *(unsigned*)(WSP(unsigned char, WS_HX8) + (size_t)row * DM + F.lane * 4 + 256 * j) = pk4_fp8(y.x, y.y, y.z, y.w); }
#pragma unroll
                for (int j = 0; j < 8; ++j) v[j] = vn[j];
            }
        }
    }
    const int hb = F.tid >> 8, ht = F.tid & 255;
    LAS f32x2* buf = (LAS f32x2*)(F.lds + hb * FFT_BUF_BYTES);
    const FftTw tw = fft_tw(ht);
    const float* htaps = WSP(float, WS_HTAPS);
    for (int u0 = F.bid * 2; u0 < 2048; u0 += F.G * 2) {
        const int un = u0 + hb, c = un >> 1, n = un & 1;
        const float* hf = htaps + (size_t)((n * 2 + 0) * 1024 + c) * SEQ, * hbk = htaps + (size_t)((n * 2 + 1) * 1024 + c) * SEQ;
        f32x2 v[16];
#pragma unroll
        for (int a = 0; a < 16; ++a) { const int i = 256 * a + ht; float x;
            if (a < 8) x = hf[i]; else if (i == 2048) x = 0.f; else x = hbk[4096 - i];
            v[a] = (f32x2){x * (1.0f / 4096.0f), 0.f}; }
        { NoHook nh; fft_fwd<-1, -1>(v, buf, ht, tw, nh, NoPf{}); }
        unsigned* Hd = WSP(unsigned, WS_H) + (size_t)un * 4096;
#pragma unroll
        for (int ks = 0; ks < 16; ++ks) Hd[ks * 256 + ht] = pk2(v[ks].x, v[ks].y);
        __syncthreads();
    }
}

template <bool F8> struct SchedZ {
    static constexpr bool GATHER = false;
    int G, c; const char* hx; const char* win;
    static constexpr size_t P = F8 ? DM : 2 * DM;
    __device__ __forceinline__ bool next(int i, Unit& u) const {
        int L = i * G + c;
        if (!F8) {
            if (L < 320) { int pn; pg8::decode_tile(L, 64, 5, u.pm, pn); u.pn = pn < 4 ? pn : 28; u.ex = 0; return true; } L -= 320;
            if (L < 72) { int pm, pn; pg8::decode_tile(L, 8, 9, pm, pn); u.pm = 64 + pm; u.pn = pn < 8 ? pn : 28; u.ex = 0; return true; }
            return false;
        } else {
            if (L < 1536) { int pn; pg8::decode_tile(L, 64, 24, u.pm, pn); u.pn = 4 + pn; u.ex = 0; return true; } L -= 1536;
            if (L < 768) { pg8::decode_tile(L, 12, 64, u.pm, u.pn); u.ex = 1; return true; }
            return false;
        }
    }
    __device__ __forceinline__ const char* a_base(const Unit& u) const { return u.ex ? win + (size_t)(WIN_HY0 + 256 * u.pm) * P : hx + (size_t)(256 * u.pm) * P; }
    __device__ __forceinline__ const char* b_base(const Unit& u) const { return u.ex ? hx + (size_t)(256 * u.pn) * P : win + (size_t)(256 * u.pn) * P; }
    __device__ __forceinline__ int a_row(const Unit&, int R) const { return R; }
};
struct EpiZ {
    static constexpr bool PERM = true;
    bf16_t* Z; bf16_t* ZT; const float* bias;
    __device__ __forceinline__ void operator()(const f32x4 (&acc)[2][2][4][2], const Unit& u, int wr, int wc, int fr, int fq) const {
        if (u.ex == 0) {
            const int row0 = u.pm * 256 + wr * 64 + fr, col0 = u.pn * 256 + wc * 32 + 8 * fq;
            f32x4 bv[2][2];
#pragma unroll
            for (int bj = 0; bj < 2; ++bj)
#pragma unroll
                for (int n = 0; n < 2; ++n) bv[bj][n] = *(const f32x4*)(bias + col0 + bj * 128 + 4 * n);
#pragma unroll
            for (int ai = 0; ai < 2; ++ai)
#pragma unroll
                for (int m = 0; m < 4; ++m) { bf16_t* rowp = Z + (size_t)(row0 + ai * 128 + m * 16) * ZN + col0;
#pragma unroll
                    for (int bj = 0; bj < 2; ++bj) { const f32x4 v0 = acc[ai][bj][m][0] + bv[bj][0], v1 = acc[ai][bj][m][1] + bv[bj][1];
                        u32x4 w; w.x = pg8::cvt_pk_bf16(v0[0], v0[1]); w.y = pg8::cvt_pk_bf16(v0[2], v0[3]); w.z = pg8::cvt_pk_bf16(v1[0], v1[1]); w.w = pg8::cvt_pk_bf16(v1[2], v1[3]);
                        *(u32x4*)(rowp + bj * 128) = w; } }
        } else {
            const int ch0 = u.pm * 256 + wr * 64 + fr, b = u.pn >> 3, t0 = (u.pn & 7) * 256 + wc * 32 + 8 * fq;
            float bbv[8];
#pragma unroll
            for (int r = 0; r < 8; ++r) bbv[r] = bias[WIN_HY0 + ch0 + (r >> 2) * 128 + (r & 3) * 16];
#pragma unroll
            for (int ai = 0; ai < 2; ++ai)
#pragma unroll
                for (int m = 0; m < 4; ++m) { const int ch = ch0 + ai * 128 + m * 16; const float bb = bbv[ai * 4 + m];
                    bf16_t* rowp = ZT + ((size_t)b * 3072 + ch) * SEQ + t0;
#pragma unroll
                    for (int bj = 0; bj < 2; ++bj) { const f32x4 v0 = acc[ai][bj][m][0] + bb, v1 = acc[ai][bj][m][1] + bb;
                        u32x4 w; w.x = pg8::cvt_pk_bf16(v0[0], v0[1]); w.y = pg8::cvt_pk_bf16(v0[2], v0[3]); w.z = pg8::cvt_pk_bf16(v1[0], v1[1]); w.w = pg8::cvt_pk_bf16(v1[2], v1[3]);
                        *(u32x4*)(rowp + bj * 128) = w; } }
        }
    }
};

__device__ __forceinline__ void p3_phase(Frame& F) {
    const KargP in = karg_opaque(F.in);
    const bf16_t* Z = WSP(bf16_t, WS_Z); bf16_t* U = WSP(bf16_t, WS_U);
    const float* cw = in[I_MCW]; const float* cb = in[I_MCB];
    const int c0 = (F.tid & 127) * 8;
    f32x4 w0[9], w1[9];
#pragma unroll
    for (int q = 0; q < 9; ++q) { w0[q] = *(const f32x4*)(cw + q * MW + c0); w1[q] = *(const f32x4*)(cw + q * MW + c0 + 4); }
    const f32x4 b0 = *(const f32x4*)(cb + c0), b1 = *(const f32x4*)(cb + c0 + 4);
#pragma unroll 1
    for (int it = F.bid * NTHR + F.tid; it < MALL * 128; it += F.G * NTHR) {
        const int row = it >> 7;
        const bool lat = row < MTOK;
        int base, y, x, H, Wd;
        if (lat) { const int t = row & (SEQ - 1); base = row - t; y = t >> 6; x = t & 63; H = 32; Wd = 64; }
        else { const int t = (row - MTOK) & (CTX - 1); base = row - t; y = 0; x = t; H = 1; Wd = CTX; }
        u32x4 zz[9]; bool ok[9];
#pragma unroll
        for (int q = 0; q < 9; ++q) { const int yy = y + q / 3 - 1, xx = x + q % 3 - 1; ok[q] = yy >= 0 && yy < H && xx >= 0 && xx < Wd;
            const int srow = ok[q] ? base + yy * Wd + xx : row;
            zz[q] = *(const u32x4*)(Z + (size_t)srow * ZN + ZC_QK + c0); }
        f32x4 a0 = b0, a1 = b1;
#pragma unroll
        for (int q = 0; q < 9; ++q) { const float m = ok[q] ? 1.f : 0.f;
            a0 += (f32x4){bflo(zz[q].x), bfhi(zz[q].x), bflo(zz[q].y), bfhi(zz[q].y)} * w0[q] * m;
            a1 += (f32x4){bflo(zz[q].z), bfhi(zz[q].z), bflo(zz[q].w), bfhi(zz[q].w)} * w1[q] * m; }
        float a[8] = {a0.x, a0.y, a0.z, a0.w, a1.x, a1.y, a1.z, a1.w};
#pragma unroll
        for (int j = 0; j < 8; ++j) a[j] = a[j] * sigmoid_fast(a[j]);
        u32x4 o; o.x = pk2(a[0], a[1]); o.y = pk2(a[2], a[3]); o.z = pk2(a[4], a[5]); o.w = pk2(a[6], a[7]);
        *(u32x4*)(U + (size_t)row * MW + c0) = o;
    }
}

struct SchedQK {
    static constexpr bool GATHER = false;
    int G, c; const char* u; const char* w;
    __device__ __forceinline__ bool next(int i, Unit& un) const { const int L = i * G + c; if (L >= 72 * 8) return false; pg8::decode_tile(L, 72, 8, un.pm, un.pn); un.ex = 0; return true; }
    __device__ __forceinline__ const char* a_base(const Unit& un) const { return u + ((size_t)(256 * un.pm) * MW + (un.pn >> 1) * 256) * 2; }
    __device__ __forceinline__ const char* b_base(const Unit& un) const { return w + (size_t)(256 * un.pn) * 256 * 2; }
    __device__ __forceinline__ int a_row(const Unit&, int R) const { return R; }
};
struct EpiQK {
    static constexpr bool PERM = true;
    bf16_t* O;
    __device__ __forceinline__ void operator()(const f32x4 (&acc)[2][2][4][2], const Unit& u, int wr, int wc, int fr, int fq) const {
        const int row0 = u.pm * 256 + wr * 64 + fr, col0 = u.pn * 256 + wc * 32 + 8 * fq;
#pragma unroll
        for (int ai = 0; ai < 2; ++ai)
#pragma unroll
            for (int m = 0; m < 4; ++m) { bf16_t* rowp = O + (size_t)(row0 + ai * 128 + m * 16) * 2048 + col0;
#pragma unroll
                for (int bj = 0; bj < 2; ++bj) { const f32x4 v0 = acc[ai][bj][m][0], v1 = acc[ai][bj][m][1];
                    u32x4 w; w.x = pg8::cvt_pk_bf16(v0[0], v0[1]); w.y = pg8::cvt_pk_bf16(v0[2], v0[3]); w.z = pg8::cvt_pk_bf16(v1[0], v1[1]); w.w = pg8::cvt_pk_bf16(v1[2], v1[3]);
                    *(u32x4*)(rowp + bj * 128) = w; } }
    }
};

constexpr int ML_QS = 264, ML_VS = 72, ML_PS = 72;
constexpr int ML_Q = 0, ML_K = ML_Q + 64 * ML_QS * 2, ML_V = ML_K + 64 * ML_QS * 2, ML_C = ML_V + 64 * ML_VS * 2, ML_P = ML_C + 80 * ML_QS * 2, ML_VT = ML_P + 64 * ML_PS * 2, ML_SC = ML_VT + 80 * ML_VS * 2;
constexpr int ML_SA = ML_SC, ML_SDEN = ML_SC + 4096, ML_END = ML_SC + 4096 + 256;
static_assert(ML_END <= MISC_OFF, "mlstm LDS");
__device__ __forceinline__ bf16x8 lds_frag(const LAS bf16_t* p) { return *(const LAS bf16x8*)p; }
__device__ __forceinline__ void mlstm_unit(Frame& F, int un) {
    const int vs = un & 3, dir = (un >> 2) & 1, h = (un >> 3) & 3, b = un >> 5;
    const bf16_t* Z = WSP(bf16_t, WS_Z); const bf16_t* QK = WSP(bf16_t, WS_QKB); unsigned char* AM = WSP(unsigned char, WS_AM);
    LAS unsigned char* lds = F.lds;
    LAS bf16_t* Qs = (LAS bf16_t*)(lds + ML_Q); LAS bf16_t* Ks = (LAS bf16_t*)(lds + ML_K); LAS bf16_t* Vs = (LAS bf16_t*)(lds + ML_V);
    LAS bf16_t* Cs = (LAS bf16_t*)(lds + ML_C); LAS bf16_t* Ps = (LAS bf16_t*)(lds + ML_P); LAS bf16_t* VT = (LAS bf16_t*)(lds + ML_VT);
    LAS float* sDEN = (LAS float*)(lds + ML_SDEN);
    LAS float* sc0 = (LAS float*)(lds + ML_SA);
    const int tid = F.tid, lane = F.lane, w = F.wave, l15 = lane & 15, g4 = lane >> 4;
    __syncthreads();
    for (int i = tid; i < 80 * ML_QS / 2; i += NTHR) ((LAS unsigned*)Cs)[i] = 0u;
    if (tid < 64) { Vs[tid * ML_VS + 64] = (bf16_t)0x3F80; for (int j = 65; j < ML_VS; ++j) Vs[tid * ML_VS + j] = 0; }
    for (int i = tid; i < 16 * ML_VS; i += NTHR) VT[64 * ML_VS + i] = (i < 64) ? (bf16_t)0x3F80 : (bf16_t)0;
    f32x4 cacc[2][5];
#pragma unroll
    for (int a = 0; a < 2; ++a)
#pragma unroll
        for (int c = 0; c < 5; ++c) cacc[a][c] = (f32x4){0.f, 0.f, 0.f, 0.f};
    float m_run = 0.f;
    u32x4 pq[4], pk[4], pv; unsigned pgate = 0u, pgate2 = 0u;
#define ML_ROW0(st) ((st) < 4 ? (MTOK + b * CTX + 64 * (dir ? 3 - (st) : (st))) : (b * SEQ + 64 * (dir ? 35 - (st) : (st) - 4)))
#define ML_LOAD(st) do { const int r0_ = ML_ROW0(st); \
        _Pragma("unroll") for (int q_ = 0; q_ < 4; ++q_) { const int p_ = tid + 512 * q_, rr_ = p_ >> 5, cc_ = (p_ & 31) * 8; \
            pq[q_] = *(const u32x4*)(QK + (size_t)(r0_ + rr_) * 2048 + h * 512 + cc_); pk[q_] = *(const u32x4*)(QK + (size_t)(r0_ + rr_) * 2048 + h * 512 + 256 + cc_); } \
        { const int rr_ = tid >> 3, cc_ = (tid & 7) * 8; pv = *(const u32x4*)(Z + (size_t)(r0_ + rr_) * ZN + ZC_V + h * 256 + vs * 64 + cc_); } \
        if (tid < 64) { const bf16_t* gp_ = Z + (size_t)(r0_ + tid) * ZN + ZC_GT + dir * 8 + h; pgate = gp_[0]; pgate2 = gp_[4]; } } while (0)
#define ML_STORE() do { \
        _Pragma("unroll") for (int q_ = 0; q_ < 4; ++q_) { const int p_ = tid + 512 * q_, rr_ = p_ >> 5, cc_ = (p_ & 31) * 8; \
            *(LAS u32x4*)(Qs + rr_ * ML_QS + cc_) = pq[q_]; *(LAS u32x4*)(Ks + rr_ * ML_QS + cc_) = pk[q_]; } \
        { const int rr_ = tid >> 3, cc_ = (tid & 7) * 8; *(LAS u32x4*)(Vs + rr_ * ML_VS + cc_) = pv; \
          VT[(cc_ + 0) * ML_VS + rr_] = (bf16_t)(pv.x & 0xffffu); VT[(cc_ + 1) * ML_VS + rr_] = (bf16_t)(pv.x >> 16); VT[(cc_ + 2) * ML_VS + rr_] = (bf16_t)(pv.y & 0xffffu); VT[(cc_ + 3) * ML_VS + rr_] = (bf16_t)(pv.y >> 16); \
          VT[(cc_ + 4) * ML_VS + rr_] = (bf16_t)(pv.z & 0xffffu); VT[(cc_ + 5) * ML_VS + rr_] = (bf16_t)(pv.z >> 16); VT[(cc_ + 6) * ML_VS + rr_] = (bf16_t)(pv.w & 0xffffu); VT[(cc_ + 7) * ML_VS + rr_] = (bf16_t)(pv.w >> 16); } } while (0)
#define ML_SCALARS(stp) do { LAS float* sb_ = sc0 + ((stp) & 1) * 512; \
              \
            float li = bf2f(pgate), zf = bf2f(pgate2); \
            if (dir) { li = __shfl(li, 63 - lane); zf = __shfl(zf, 63 - lane); } \
            const float lf = fminf(zf, 0.f) - log1pf(__expf(-fabsf(zf))); \
            const float bcs = wave_scan_sum(lf); \
            const float a = li - bcs; \
            const float am = wave_scan_max(a); \
            const float inter = bcs + m_run; \
            const float mt = fmaxf(inter, bcs + am); \
            const float b_end = lane_bcast(bcs, 63); \
            const float gg = b_end - bcs + li; \
            const float gm = lane_bcast(wave_scan_max(gg), 63); \
            const float m_new = fmaxf(b_end + m_run, gm); \
            const int pos_ = dir ? 63 - lane : lane; \
            sb_[pos_] = a; sb_[64 + pos_] = bcs - mt; sb_[128 + pos_] = __expf(inter - mt); sb_[192 + pos_] = __expf(gg - m_new); sb_[256 + pos_] = __expf(-mt); \
            if (lane == 0) sb_[320] = __expf(b_end + m_run - m_new); \
            m_run = m_new; } while (0)
    ML_LOAD(0);
    __syncthreads();
    if (w == 0) ML_SCALARS(0);
    const int tt = w & 3; const int nv = (w < 4) ? 3 : 2;
#pragma unroll 1
    for (int st = 0; st < 36; ++st) {
        ML_STORE();
        LAS float* sA = sc0 + (st & 1) * 512; LAS float* sU = sA + 64; LAS float* sSI = sA + 128; LAS float* sWG = sA + 192; LAS float* sEM = sA + 256; LAS float* sMI = sA + 320;
        const int row0 = ML_ROW0(st);
        if (st + 1 < 36) ML_LOAD(st + 1);
        __syncthreads();
        {
            f32x4 sacc[2] = {(f32x4){0.f, 0.f, 0.f, 0.f}, (f32x4){0.f, 0.f, 0.f, 0.f}};
#pragma unroll
            for (int ks = 0; ks < 8; ++ks) {
                const bf16x8 qf = lds_frag(Qs + (16 * tt + l15) * ML_QS + 32 * ks + 8 * g4);
#pragma unroll
                for (int j = 0; j < 2; ++j) { const int stl = 2 * (w >> 2) + j;
                    const bf16x8 kf = lds_frag(Ks + (16 * stl + l15) * ML_QS + 32 * ks + 8 * g4);
                    sacc[j] = __builtin_amdgcn_mfma_f32_16x16x32_bf16(kf, qf, sacc[j], 0, 0, 0); }
            }
            const int t = 16 * tt + l15; const float ut = sU[t];
#pragma unroll
            for (int j = 0; j < 2; ++j) { const int s0 = 16 * (2 * (w >> 2) + j) + 4 * g4;
                const f32x4 av = *(const LAS f32x4*)(sA + s0);
                float pvv[4];
#pragma unroll
                for (int r = 0; r < 4; ++r) { const int s = s0 + r; const bool ok = dir ? (s >= t) : (s <= t); pvv[r] = ok ? sacc[j][r] * __expf(ut + av[r]) : 0.f; }
                u32x2 o; o.x = pk2(pvv[0], pvv[1]); o.y = pk2(pvv[2], pvv[3]);
                *(LAS u32x2*)(Ps + t * ML_PS + s0) = o; }
        }
        __syncthreads();
        unsigned og[2][4];
        if (st >= 4) {
#pragma unroll
            for (int j = 0; j < 2; ++j) { const int vt_ = (w < 4) ? j : 2 + j;
#pragma unroll
                for (int r = 0; r < 4; ++r) og[j][r] = Z[(size_t)(row0 + 16 * tt + 4 * g4 + r) * ZN + ZC_O + h * 256 + vs * 64 + 16 * vt_ + l15]; } }
        f32x4 nacc[3], iacc[3];
#pragma unroll
        for (int j = 0; j < 3; ++j) { nacc[j] = (f32x4){0.f, 0.f, 0.f, 0.f}; iacc[j] = (f32x4){0.f, 0.f, 0.f, 0.f}; }
#pragma unroll
        for (int ks = 0; ks < 8; ++ks) {
            const bf16x8 qf = lds_frag(Qs + (16 * tt + l15) * ML_QS + 32 * ks + 8 * g4);
#pragma unroll
            for (int j = 0; j < 3; ++j) if (j < nv) { const int vt = (w < 4) ? (j == 2 ? 4 : j) : 2 + j;
                const bf16x8 cf = lds_frag(Cs + (16 * vt + l15) * ML_QS + 32 * ks + 8 * g4);
                iacc[j] = __builtin_amdgcn_mfma_f32_16x16x32_bf16(qf, cf, iacc[j], 0, 0, 0); }
        }
#pragma unroll
        for (int ks = 0; ks < 2; ++ks) {
            const bf16x8 pf = lds_frag(Ps + (16 * tt + l15) * ML_PS + 32 * ks + 8 * g4);
#pragma unroll
            for (int j = 0; j < 3; ++j) if (j < nv) { const int vt = (w < 4) ? (j == 2 ? 4 : j) : 2 + j;
                const bf16x8 vf = lds_frag(VT + (16 * vt + l15) * ML_VS + 32 * ks + 8 * g4);
                nacc[j] = __builtin_amdgcn_mfma_f32_16x16x32_bf16(pf, vf, nacc[j], 0, 0, 0); }
        }
        const int t0 = 16 * tt + 4 * g4;
        {
            const f32x4 si = *(const LAS f32x4*)(sSI + t0);
#pragma unroll
            for (int j = 0; j < 3; ++j) if (j < nv) nacc[j] = nacc[j] + iacc[j] * si;
            if (w < 4 && l15 == 0) *(LAS f32x4*)(sDEN + t0) = nacc[2];
        }
        {
            const float decay = sMI[0];
#pragma unroll
            for (int a = 0; a < 2; ++a)
#pragma unroll
                for (int c = 0; c < 5; ++c) cacc[a][c] = cacc[a][c] * decay;
#pragma unroll
            for (int ks = 0; ks < 2; ++ks) {
                float wg[8];
#pragma unroll
                for (int e = 0; e < 8; ++e) wg[e] = sWG[32 * ks + 8 * g4 + e];
                bf16x8 kf[2];
#pragma unroll
                for (int a = 0; a < 2; ++a) { float x[8];
#pragma unroll
                    for (int e = 0; e < 8; ++e) x[e] = bf2f((unsigned)Ks[(32 * ks + 8 * g4 + e) * ML_QS + 16 * (2 * w + a) + l15]) * wg[e];
                    u32x4 o; o.x = pk2(x[0], x[1]); o.y = pk2(x[2], x[3]); o.z = pk2(x[4], x[5]); o.w = pk2(x[6], x[7]);
                    kf[a] = __builtin_bit_cast(bf16x8, o); }
#pragma unroll
                for (int c = 0; c < 5; ++c) {
                    const bf16x8 vf = lds_frag(VT + (16 * c + l15) * ML_VS + 32 * ks + 8 * g4);
#pragma unroll
                    for (int a = 0; a < 2; ++a) cacc[a][c] = __builtin_amdgcn_mfma_f32_16x16x32_bf16(kf[a], vf, cacc[a][c], 0, 0, 0);
                }
            }
        }
        __syncthreads();
        if (w == 0 && st + 1 < 36) ML_SCALARS(st + 1);
        if (st >= 4) {
            const f32x4 dn = *(const LAS f32x4*)(sDEN + t0), em = *(const LAS f32x4*)(sEM + t0);
#pragma unroll
            for (int j = 0; j < 2; ++j) { const int vt = (w < 4) ? j : 2 + j; const int col = h * 256 + vs * 64 + 16 * vt + l15;
#pragma unroll
                for (int r = 0; r < 4; ++r) { const int row = row0 + t0 + r;
                    const float hv = nacc[j][r] * __builtin_amdgcn_rcpf(fmaxf(fabsf(dn[r]), em[r]));
                    const float o = __builtin_amdgcn_rcpf(1.0f + __expf(-bf2f(og[j][r])));
                    AM[(size_t)row * 2048 + dir * 1024 + col] = (unsigned char)(pk4_fp8(fminf(fmaxf(o * hv, -448.f), 448.f), 0.f, 0.f, 0.f) & 0xffu); } }
        }
#pragma unroll
        for (int a = 0; a < 2; ++a)
#pragma unroll
            for (int c = 0; c < 5; ++c) { u32x2 o; o.x = pk2(cacc[a][c][0], cacc[a][c][1]); o.y = pk2(cacc[a][c][2], cacc[a][c][3]);
                *(LAS u32x2*)(Cs + (16 * c + l15) * ML_QS + 16 * (2 * w + a) + 4 * g4) = o; }
    }
    __syncthreads();
#undef ML_LOAD
#undef ML_STORE
#undef ML_ROW0
#undef ML_SCALARS
}

constexpr int CVH_E0 = 11;
constexpr int CVH_NITEMS = (NEXP - CVH_E0) * 768;
constexpr int CVH_KG_BYTES = 1040, CVH_TILE_BYTES = 16 * CVH_KG_BYTES;
struct CvHook {
    KargP in; unsigned char* ws; LAS unsigned char* tiles; int tid, bid, G, kmax; int s;
    f32x4 v[2][8];
    __device__ __forceinline__ void decode(int h, const float*& src, unsigned char*& dst, int& rstep) const {
        const int e = CVH_E0 + h / 768, q = h % 768;
        if (q < 512) { const int up = q & 1, g = (q >> 1) & 7, kb = q >> 4;
            src = (up ? in[I_WU] : in[I_WG]) + (size_t)e * DM * DM + (size_t)(64 * kb) * DM + 256 * g;
            dst = ws + WS_WGU + ((size_t)e * 4096 + 512 * g + up * 128) * DM + 64 * kb; rstep = 256; }
        else { const int q2 = q - 512, g = q2 & 7, kb = q2 >> 3;
            src = in[I_WDN] + (size_t)e * DM * DM + (size_t)(64 * kb) * DM + 256 * g;
            dst = ws + WS_WD + ((size_t)e * 2048 + 256 * g) * DM + 64 * kb; rstep = 128; }
    }
    __device__ __forceinline__ int item(int k) const { return (k < kmax ? k : kmax) * G + bid; }
    template <int SET> __device__ __forceinline__ void request(int k) {
        const float* src; unsigned char* dst; int rs; decode(item(k), src, dst, rs);
        const int w = tid >> 6, lane = tid & 63;
#pragma unroll
        for (int i = 0; i < 8; ++i) v[SET][i] = __builtin_nontemporal_load((const f32x4*)(src + (size_t)(8 * w + i) * DM + 4 * lane));
    }
    template <int SET> __device__ __forceinline__ void act() {
        const int k = s; s = k + 1;
        const int w = tid >> 6, lane = tid & 63;
        {
            const float sc = (item(k - 2) % 768) < 512 ? 32.f : 64.f;
            LAS unsigned char* t = tiles + SET * CVH_TILE_BYTES;
#pragma unroll
            for (int g = 0; g < 2; ++g) { u32x4 o;
                o.x = pk4_fp8(v[SET][4 * g][0] * sc, v[SET][4 * g + 1][0] * sc, v[SET][4 * g + 2][0] * sc, v[SET][4 * g + 3][0] * sc); o.y = pk4_fp8(v[SET][4 * g][1] * sc, v[SET][4 * g + 1][1] * sc, v[SET][4 * g + 2][1] * sc, v[SET][4 * g + 3][1] * sc);
                o.z = pk4_fp8(v[SET][4 * g][2] * sc, v[SET][4 * g + 1][2] * sc, v[SET][4 * g + 2][2] * sc, v[SET][4 * g + 3][2] * sc); o.w = pk4_fp8(v[SET][4 * g][3] * sc, v[SET][4 * g + 1][3] * sc, v[SET][4 * g + 2][3] * sc, v[SET][4 * g + 3][3] * sc);
                *(LAS u32x4*)(t + (2 * w + g) * CVH_KG_BYTES + 16 * lane) = o; }
        }
        request<SET>(k);
        {
            const float* src; unsigned char* dst; int rs; decode(item(k >= 3 ? k - 3 : 0), src, dst, rs);
            if (k < 3) { dst = ws + WS_DUMMY; rs = 128; }
            const LAS unsigned char* t = tiles + (1 - SET) * CVH_TILE_BYTES;
#pragma unroll
            for (int q = 0; q < 2; ++q) { const int idx = tid + 512 * q, row = idx >> 2, piece = idx & 3;
                const LAS unsigned char* tp = t + (4 * piece) * CVH_KG_BYTES + 4 * row;
                u32x4 o; o.x = *(const LAS unsigned*)(tp); o.y = *(const LAS unsigned*)(tp + CVH_KG_BYTES); o.z = *(const LAS unsigned*)(tp + 2 * CVH_KG_BYTES); o.w = *(const LAS unsigned*)(tp + 3 * CVH_KG_BYTES);
                *(u32x4*)(dst + (size_t)((row >> 7) * rs + (row & 127)) * DM + 16 * piece) = o; }
        }
    }
};
struct HPf {
    const unsigned* Hd; int ht; unsigned (&h)[16];
    __device__ __forceinline__ void operator()() const {
#pragma unroll
        for (int ks = 0; ks < 16; ++ks) h[ks] = Hd[ks * 256 + ht];
    }
};

constexpr int HY_RAW = 2 * FFT_BUF_BYTES, HY_OUT = HY_RAW + 16384, HY_CVT = HY_OUT + 32768, HY_COEF = HY_CVT + 2 * CVH_TILE_BYTES, HY_END = HY_COEF + 512;
static_assert(HY_END <= MISC_OFF, "hyena LDS");
__device__ __forceinline__ void hy_conv_to_buf(const LAS bf16_t* raw, LAS f32x2* buf, const LAS float* cf, int kind, int ht) {
    float w9[9]; const float bias = cf[27 + kind];
#pragma unroll
    for (int q = 0; q < 9; ++q) w9[q] = cf[9 * kind + q];
    asm volatile("" : "+v"(ht));
    const int t0 = 8 * ht, y = t0 >> 6, x0 = t0 & 63;
    float acc[2][8];
#pragma unroll
    for (int bb = 0; bb < 2; ++bb)
#pragma unroll
        for (int i = 0; i < 8; ++i) acc[bb][i] = bias;
#pragma unroll
    for (int dy = -1; dy <= 1; ++dy) {
        const int yy = y + dy;
        if (yy >= 0 && yy < 32) {
#pragma unroll
            for (int bb = 0; bb < 2; ++bb) {
                const LAS bf16_t* base = raw + bb * 2048 + t0 + 64 * dy;
                const u32x4 mid = *(const LAS u32x4*)base;
                float vals[10];
                vals[0] = (x0 > 0) ? bf2f((unsigned)base[-1]) : 0.f; vals[9] = (x0 + 8 < 64) ? bf2f((unsigned)base[8]) : 0.f;
                vals[1] = bflo(mid.x); vals[2] = bfhi(mid.x); vals[3] = bflo(mid.y); vals[4] = bfhi(mid.y); vals[5] = bflo(mid.z); vals[6] = bfhi(mid.z); vals[7] = bflo(mid.w); vals[8] = bfhi(mid.w);
                const float wl = w9[(dy + 1) * 3], wm = w9[(dy + 1) * 3 + 1], wr_ = w9[(dy + 1) * 3 + 2];
#pragma unroll
                for (int i = 0; i < 8; ++i) acc[bb][i] += wl * vals[i] + wm * vals[i + 1] + wr_ * vals[i + 2];
            }
        }
    }
#pragma unroll
    for (int i = 0; i < 8; ++i) buf[fphys(t0 + i)] = (f32x2){acc[0][i], acc[1][i]};
}
__device__ __forceinline__ float hy_coef_load(KargP in, int c, int ht) {
    const int i = ht & 31;
    if (i < 27) { const int kind = i / 9, q = i % 9; const int ch = (kind == 0 ? 2048 : kind == 1 ? 0 : 1024) + c; return in[I_HCW][q * 3072 + ch]; }
    if (i < 30) { const int kind = i - 27; return in[I_HCB][(kind == 0 ? 2048 : kind == 1 ? 0 : 1024) + c]; }
    return in[I_HSKIP][(i - 30) * 1024 + c];
}
__device__ __forceinline__ void hyena_unit(Frame& F, int un, CvHook& hk) {
    const KargP in = karg_opaque(F.in);
    const int cg = un >> 2, bp = un & 3, c0 = cg * 8, b0 = bp * 2;
    int tid_ = F.tid; asm volatile("" : "+v"(tid_));
    const int hb = tid_ >> 8, ht = tid_ & 255;
    LAS f32x2* buf = (LAS f32x2*)(F.lds + hb * FFT_BUF_BYTES);
    LAS bf16_t* raw = (LAS bf16_t*)(F.lds + HY_RAW + hb * 8192);
    LAS unsigned char* outT = (LAS unsigned char*)(F.lds + HY_OUT);
    const bf16_t* ZT = WSP(bf16_t, WS_ZT); const unsigned* H = WSP(unsigned, WS_H);
    const FftTw tw = fft_tw(ht);
    __syncthreads();
#define HY_FETCH(dst, kind, ch) do { _Pragma("unroll") for (int bb = 0; bb < 2; ++bb) dst[bb] = *(const u32x4*)(ZT + ((size_t)(b0 + bb) * 3072 + (kind) * 1024 + (ch)) * SEQ + ht * 8); } while (0)
#define HY_PUT(srcv) do { _Pragma("unroll") for (int bb = 0; bb < 2; ++bb) *(LAS u32x4*)(raw + bb * 2048 + ht * 8) = srcv[bb]; } while (0)
    u32x4 rv[2], rn[2];
    HY_FETCH(rv, 2, c0 + hb);
    LAS float* coef = (LAS float*)(F.lds + HY_COEF) + hb * 64;
    if (ht < 32) coef[ht] = hy_coef_load(in, c0 + hb, ht);
    float cpre = 0.f;
#pragma unroll 1
    for (int i = 0; i < 4; ++i) {
        const int cl = 2 * i + hb, c = c0 + cl;
        const LAS float* cf = coef + (i & 1) * 32;
        { int hto = ht; asm volatile("" : "+v"(hto));
          if (i < 3 && hto < 32) cpre = hy_coef_load(in, c + 2, hto); }
        HY_PUT(rv);
        HY_FETCH(rn, 0, c);
        __syncthreads();
        f32x2 vin[8], v[16]; unsigned hpre[16];
        hy_conv_to_buf(raw, buf, cf, 0, ht);
        __syncthreads();
#pragma unroll
        for (int a = 0; a < 8; ++a) { vin[a] = buf[fphys(256 * a + ht)]; v[a] = vin[a]; v[8 + a] = (f32x2){0.f, 0.f}; }
        fft_fwd<-1, -1>(v, buf, ht, tw, hk, HPf{H + (size_t)(c * 2 + 0) * 4096, ht, hpre});
#pragma unroll
        for (int ks = 0; ks < 16; ++ks) v[ks] = cmulq(v[ks], (f32x2){bflo(hpre[ks]), bfhi(hpre[ks])});
        fft_inv<0, 1, 0>(v, buf, ht, tw, hk);
        HY_PUT(rn);
        HY_FETCH(rv, 1, c);
        __syncthreads(); hk.act<1>();
        hy_conv_to_buf(raw, buf, cf, 1, ht);
        __syncthreads();
        { const float sk = cf[30];
#pragma unroll
          for (int a = 0; a < 8; ++a) { const f32x2 g = buf[fphys(256 * a + ht)]; vin[a] = g * (v[a] + vin[a] * sk); } }
#pragma unroll
        for (int a = 0; a < 8; ++a) { v[a] = vin[a]; v[8 + a] = (f32x2){0.f, 0.f}; }
        fft_fwd<-1, -1>(v, buf, ht, tw, hk, HPf{H + (size_t)(c * 2 + 1) * 4096, ht, hpre});
#pragma unroll
        for (int ks = 0; ks < 16; ++ks) v[ks] = cmulq(v[ks], (f32x2){bflo(hpre[ks]), bfhi(hpre[ks])});
        fft_inv<0, 1, 0>(v, buf, ht, tw, hk);
        HY_PUT(rv);
        if (i < 3) HY_FETCH(rv, 2, c + 2);
        __syncthreads(); hk.act<1>();
        hy_conv_to_buf(raw, buf, cf, 2, ht);
        __syncthreads();
        { const float sk = cf[31];
#pragma unroll
          for (int a = 0; a < 8; ++a) { const f32x2 g = buf[fphys(256 * a + ht)]; const f32x2 o = g * (v[a] + vin[a] * sk); const int t = 256 * a + ht;
              const unsigned pk_ = pk4_fp8(fminf(fmaxf(o.x, -448.f), 448.f), fminf(fmaxf(o.y, -448.f), 448.f), 0.f, 0.f);
              outT[(0 * 2048 + t) * 8 + cl] = (unsigned char)(pk_ & 0xffu); outT[(1 * 2048 + t) * 8 + cl] = (unsigned char)((pk_ >> 8) & 0xffu); } }
        if (i < 3 && ht < 32) coef[((i + 1) & 1) * 32 + ht] = cpre;
        __syncthreads();
    }
#undef HY_FETCH
#undef HY_PUT
    unsigned char* HH = WSP(unsigned char, WS_HH);
    int tido = F.tid; asm volatile("" : "+v"(tido));
#pragma unroll
    for (int q = 0; q < 8; ++q) { const int r = tido + 512 * q, bb = r >> 11, t = r & 2047;
        *(u32x2*)(HH + ((size_t)(b0 + bb) * SEQ + t) * HW + c0) = *(const LAS u32x2*)(outT + r * 8); }
    __syncthreads();
}

struct SchedP {
    static constexpr bool GATHER = false;
    int G, c; const char* a; const char* b; size_t astep, bstep;
    __device__ __forceinline__ bool next(int i, Unit& u) const { const int L = i * G + c; if (L >= 512) return false; pg8::decode_tile(L, 64, 8, u.pm, u.pn); u.ex = 0; return true; }
    __device__ __forceinline__ const char* a_base(const Unit& u) const { return a + (size_t)u.pm * astep; }
    __device__ __forceinline__ const char* b_base(const Unit& u) const { return b + (size_t)u.pn * bstep; }
    __device__ __forceinline__ int a_row(const Unit&, int R) const { return R; }
};
struct EpiMA {
    static constexpr bool PERM = true;
    bf16_t* T; const bf16_t* Z;
    __device__ __forceinline__ void operator()(const f32x4 (&acc)[2][2][4][2], const Unit& u, int wr, int wc, int fr, int fq) const {
        const int row0 = u.pm * 256 + wr * 64 + fr, col0 = u.pn * 256 + wc * 32 + 8 * fq;
#pragma unroll
        for (int ai = 0; ai < 2; ++ai)
#pragma unroll
            for (int bj = 0; bj < 2; ++bj) { const int c = col0 + bj * 128;
                u32x4 gz[4];
#pragma unroll
                for (int m = 0; m < 4; ++m) gz[m] = *(const u32x4*)(Z + (size_t)(row0 + ai * 128 + m * 16) * ZN + ZC_GA + c);
#pragma unroll
                for (int m = 0; m < 4; ++m) { const size_t row = row0 + ai * 128 + m * 16;
                    const f32x4 g0 = (f32x4){sigmoid_fast(bflo(gz[m].x)), sigmoid_fast(bfhi(gz[m].x)), sigmoid_fast(bflo(gz[m].y)), sigmoid_fast(bfhi(gz[m].y))};
                    const f32x4 g1 = (f32x4){sigmoid_fast(bflo(gz[m].z)), sigmoid_fast(bfhi(gz[m].z)), sigmoid_fast(bflo(gz[m].w)), sigmoid_fast(bfhi(gz[m].w))};
                    const f32x4 t0 = acc[ai][bj][m][0] * g0, t1 = acc[ai][bj][m][1] * g1;
                    u32x4 w; w.x = pg8::cvt_pk_bf16(t0[0], t0[1]); w.y = pg8::cvt_pk_bf16(t0[2], t0[3]); w.z = pg8::cvt_pk_bf16(t1[0], t1[1]); w.w = pg8::cvt_pk_bf16(t1[2], t1[3]);
                    *(u32x4*)(T + row * DM + c) = w; }
                asm volatile("" ::: "memory"); }
    }
};
struct EpiMB {
    static constexpr bool PERM = true;
    const bf16_t* T; const bf16_t* Z; unsigned char* MX;
    __device__ __forceinline__ void operator()(const f32x4 (&acc)[2][2][4][2], const Unit& u, int wr, int wc, int fr, int fq) const {
        const int row0 = u.pm * 256 + wr * 64 + fr, col0 = u.pn * 256 + wc * 32 + 8 * fq;
#pragma unroll
        for (int ai = 0; ai < 2; ++ai)
#pragma unroll
            for (int bj = 0; bj < 2; ++bj) { const int c = col0 + bj * 128;
                u32x4 gz[4], tv[4];
#pragma unroll
                for (int m = 0; m < 4; ++m) { const size_t row = row0 + ai * 128 + m * 16; gz[m] = *(const u32x4*)(Z + row * ZN + ZC_GH + c); tv[m] = *(const u32x4*)(T + row * DM + c); }
#pragma unroll
                for (int m = 0; m < 4; ++m) { const size_t row = row0 + ai * 128 + m * 16;
                    const f32x4 t0 = (f32x4){bflo(tv[m].x), bfhi(tv[m].x), bflo(tv[m].y), bfhi(tv[m].y)}, t1 = (f32x4){bflo(tv[m].z), bfhi(tv[m].z), bflo(tv[m].w), bfhi(tv[m].w)};
                    const f32x4 g0 = (f32x4){sigmoid_fast(bflo(gz[m].x)), sigmoid_fast(bfhi(gz[m].x)), sigmoid_fast(bflo(gz[m].y)), sigmoid_fast(bfhi(gz[m].y))};
                    const f32x4 g1 = (f32x4){sigmoid_fast(bflo(gz[m].z)), sigmoid_fast(bfhi(gz[m].z)), sigmoid_fast(bflo(gz[m].w)), sigmoid_fast(bfhi(gz[m].w))};
                    const f32x4 v0 = t0 + acc[ai][bj][m][0] * g0, v1 = t1 + acc[ai][bj][m][1] * g1;
                    const f32x4 c0 = __builtin_elementwise_min(__builtin_elementwise_max(v0, (f32x4){-448.f, -448.f, -448.f, -448.f}), (f32x4){448.f, 448.f, 448.f, 448.f});
                    const f32x4 c1 = __builtin_elementwise_min(__builtin_elementwise_max(v1, (f32x4){-448.f, -448.f, -448.f, -448.f}), (f32x4){448.f, 448.f, 448.f, 448.f});
                    u32x2 w; w.x = pk4_fp8(c0[0], c0[1], c0[2], c0[3]); w.y = pk4_fp8(c1[0], c1[1], c1[2], c1[3]);
                    *(u32x2*)(MX + row * DM + c) = w; }
                asm volatile("" ::: "memory"); }
    }
};
struct EpiWO {
    static constexpr bool PERM = true;
    bf16_t* R1; const float* x; const float* stats; const float* lng; const float* lnb; const float* mod;
    __device__ __forceinline__ void operator()(const f32x4 (&acc)[2][2][4][2], const Unit& u, int wr, int wc, int fr, int fq) const {
        const int row0 = u.pm * 256 + wr * 64 + fr, col0 = u.pn * 256 + wc * 32 + 8 * fq;
        const float* g1p = mod + (size_t)(u.pm >> 3) * 12288 + 4096;
#pragma unroll
        for (int bj = 0; bj < 2; ++bj) { const int c = col0 + bj * 128;
            const f32x4 ga = *(const f32x4*)(lng + c), gb = *(const f32x4*)(lng + c + 4), ba = *(const f32x4*)(lnb + c), bb = *(const f32x4*)(lnb + c + 4), g1a = *(const f32x4*)(g1p + c), g1b = *(const f32x4*)(g1p + c + 4);
#pragma unroll
            for (int ai = 0; ai < 2; ++ai)
#pragma unroll
                for (int mh = 0; mh < 2; ++mh) {
                    f32x4 xa[2], xb[2]; f32x2 st[2];
#pragma unroll
                    for (int q = 0; q < 2; ++q) { const size_t row = row0 + ai * 128 + (2 * mh + q) * 16; xa[q] = *(const f32x4*)(x + row * DM + c); xb[q] = *(const f32x4*)(x + row * DM + c + 4); st[q] = *(const f32x2*)(stats + row * 2); }
#pragma unroll
                    for (int q = 0; q < 2; ++q) { const int m = 2 * mh + q; const size_t row = row0 + ai * 128 + m * 16; const float mean = st[q].x, rstd = st[q].y;
                        const f32x4 v0 = ((xa[q] - mean) * rstd * ga + ba) * DN_ALPHA + g1a * acc[ai][bj][m][0], v1 = ((xb[q] - mean) * rstd * gb + bb) * DN_ALPHA + g1b * acc[ai][bj][m][1];
                        u32x4 w; w.x = pg8::cvt_pk_bf16(v0[0], v0[1]); w.y = pg8::cvt_pk_bf16(v0[2], v0[3]); w.z = pg8::cvt_pk_bf16(v1[0], v1[1]); w.w = pg8::cvt_pk_bf16(v1[2], v1[3]);
                        *(u32x4*)(R1 + row * DM + c) = w; }
                    asm volatile("" ::: "memory"); } }
    }
};

struct CwItem { const float* src; unsigned char* dst; float scale; };
__device__ __forceinline__ CwItem cw_decode(KargP in, unsigned char* ws, int it) {
    CwItem c;
    if (it < NEXP * 2048) { const int e = it >> 11, q = it & 2047, g = q & 127, kb = q >> 7; const int n0 = 32 * g, tile = n0 >> 8, within = n0 & 255;
        c.src = (within < 128 ? in[I_WG] : in[I_WU]) + (size_t)e * DM * DM + (size_t)(128 * kb) * DM + tile * 128 + (within & 127);
        c.dst = ws + WS_WGU + ((size_t)e * 4096 + n0) * DM + 128 * kb; c.scale = 32.f; }
    else { const int r2 = it - NEXP * 2048; const int e = r2 >> 10, q = r2 & 1023, g = q & 63, kb = q >> 6;
        c.src = in[I_WDN] + (size_t)e * DM * DM + (size_t)(128 * kb) * DM + 32 * g;
        c.dst = ws + WS_WD + ((size_t)e * 2048 + 32 * g) * DM + 128 * kb; c.scale = 64.f; }
    return c;
}
constexpr int CV_E8 = 8;
__device__ __forceinline__ int cw_map(int i) { return i < CV_E8 * 2048 ? i : NEXP * 2048 + (i - CV_E8 * 2048); }
__device__ __forceinline__ void convert_moe_wave(KargP in, unsigned char* ws, LAS unsigned char* tile, int lane, int cw, int ncw) {
    constexpr int NIT = CV_E8 * (2048 + 1024);
    const int kq = lane >> 3, nq = lane & 7;
#define CW_LOAD(v, c) do { _Pragma("unroll") for (int i_ = 0; i_ < 16; ++i_) v[i_] = __builtin_nontemporal_load((const f32x4*)((c).src + (size_t)(16 * kq + i_) * DM + 4 * nq)); } while (0)
#define CW_PROC(v, c) do { \
        _Pragma("unroll") for (int j_ = 0; j_ < 4; ++j_) { u32x4 o_; const float s_ = (c).scale; \
            o_.x = pk4_fp8(v[0][j_] * s_, v[1][j_] * s_, v[2][j_] * s_, v[3][j_] * s_);     o_.y = pk4_fp8(v[4][j_] * s_, v[5][j_] * s_, v[6][j_] * s_, v[7][j_] * s_); \
            o_.z = pk4_fp8(v[8][j_] * s_, v[9][j_] * s_, v[10][j_] * s_, v[11][j_] * s_);   o_.w = pk4_fp8(v[12][j_] * s_, v[13][j_] * s_, v[14][j_] * s_, v[15][j_] * s_); \
            *(LAS u32x4*)(tile + (4 * nq + j_) * 144 + 16 * kq) = o_; } \
        asm volatile("s_waitcnt lgkmcnt(0)" ::: "memory"); \
        _Pragma("unroll") for (int q_ = 0; q_ < 4; ++q_) { const int idx_ = lane + 64 * q_, row_ = idx_ >> 3, piece_ = idx_ & 7; \
            *(u32x4*)((c).dst + (size_t)row_ * DM + 16 * piece_) = *(const LAS u32x4*)(tile + row_ * 144 + 16 * piece_); } \
        asm volatile("s_waitcnt lgkmcnt(0)" ::: "memory"); } while (0)
    f32x4 va[16], vb[16];
    int it = cw;
    if (it >= NIT) return;
    CwItem ca = cw_decode(in, ws, cw_map(it)), cb = ca;
    CW_LOAD(va, ca);
    for (;;) {
        const bool hb = it + ncw < NIT;
        if (hb) { cb = cw_decode(in, ws, cw_map(it + ncw)); CW_LOAD(vb, cb); }
        CW_PROC(va, ca);
        if (!hb) break;
        it += ncw;
        const bool ha = it + ncw < NIT;
        if (ha) { ca = cw_decode(in, ws, cw_map(it + ncw)); CW_LOAD(va, ca); }
        CW_PROC(vb, cb);
        if (!ha) break;
        it += ncw;
    }
#undef CW_LOAD
#undef CW_PROC
}

__device__ __forceinline__ void sw_bar4(volatile LAS unsigned* cnt, unsigned& target, int lane) {
    asm volatile("s_waitcnt lgkmcnt(0)" ::: "memory");
    target += 4u;
    if (lane == 0) __hip_atomic_fetch_add((LAS unsigned*)cnt, 1u, __ATOMIC_RELAXED, __HIP_MEMORY_SCOPE_WORKGROUP);
    for (unsigned sp_ = 0; __hip_atomic_load((LAS unsigned*)cnt, __ATOMIC_RELAXED, __HIP_MEMORY_SCOPE_WORKGROUP) < target && sp_ < (1u << 24); ++sp_) __builtin_amdgcn_s_sleep(0);
    asm volatile("" ::: "memory");
}
__device__ __forceinline__ void p8_phase(Frame& F) {
    const KargP in = karg_opaque(F.in);
    const int lane = F.lane, l15 = lane & 15, g4 = lane >> 4;
    if (F.wave >= 4) {
        convert_moe_wave(in, F.ws, (LAS unsigned char*)(F.lds + 4 * 20480 + (F.wave - 4) * 4608), lane, F.bid * 4 + (F.wave - 4), F.G * 4);
        return; }
    const bf16_t* R1 = WSP(bf16_t, WS_R1); unsigned char* TOK = WSP(unsigned char, WS_TOK); const float* mod = WSP(float, WS_MOD);
    LAS float* pA = (LAS float*)(F.lds + F.wave * 20480);
    LAS float* pB = pA + 2048;
    LAS float* lg = pA + 4096;
    LAS int* te = (LAS int*)(lg + 576); LAS float* tw = (LAS float*)(te + 64);
    const float* wr = in[I_WR];
    LAS float* wl = (LAS float*)(F.lds + 4 * 20480 + 4 * 4608);
    unsigned rbt = 0u;
#pragma unroll 1
    for (int tile = F.bid + F.G * F.wave; tile < MTOK / 16; tile += F.G * 4) {
        const int bsel = (tile * 16) / SEQ; const float* mv = mod + (size_t)bsel * 12288;
#pragma unroll
        for (int j = 0; j < 8; ++j) { const int c = lane * 4 + 256 * j;
            const f32x4 g = *(const f32x4*)(in[I_LN1G] + c), bb = *(const f32x4*)(in[I_LN1B] + c), sh = *(const f32x4*)(mv + 6144 + c), sc = *(const f32x4*)(mv + 8192 + c) + 1.0f;
            *(LAS f32x4*)(pA + c) = g * sc; *(LAS f32x4*)(pB + c) = bb * sc + sh; }
        LDS_WAIT(); asm volatile("" ::: "memory");
        float my_mean = 0.f, my_rstd = 0.f;
        {
            const bf16_t* xb = R1 + (size_t)tile * 16 * DM + lane * 4;
            f32x4 v[8]; u32x2 vn[8];
#pragma unroll
            for (int j = 0; j < 8; ++j) { const u32x2 t_ = *(const u32x2*)(xb + 256 * j); v[j] = (f32x4){bflo(t_.x), bfhi(t_.x), bflo(t_.y), bfhi(t_.y)}; }
#pragma unroll 1
            for (int rr = 0; rr < 16; ++rr) {
                const bf16_t* xn = xb + (size_t)(rr < 15 ? rr + 1 : rr) * DM;
#pragma unroll
                for (int j = 0; j < 8; ++j) vn[j] = *(const u32x2*)(xn + 256 * j);
                float s = 0.f;
#pragma unroll
                for (int j = 0; j < 8; ++j) s += (v[j].x + v[j].y) + (v[j].z + v[j].w);
                const float mean = wave_sum(s) * (1.f / DM); float s2 = 0.f;
#pragma unroll
                for (int j = 0; j < 8; ++j) { v[j] = v[j] - mean; s2 += (v[j].x * v[j].x + v[j].y * v[j].y) + (v[j].z * v[j].z + v[j].w * v[j].w); }
                const float rstd = 1.f / sqrtf(wave_sum(s2) * (1.f / DM) + LN_EPS);
                if (l15 == rr) { my_mean = mean; my_rstd = rstd; }
                unsigned char* orow = TOK + (size_t)(tile * 16 + rr) * DM;
#pragma unroll
                for (int j = 0; j < 8; ++j) { const int c = lane * 4 + 256 * j;
                    const f32x4 y = v[j] * rstd * *(const LAS f32x4*)(pA + c) + *(const LAS f32x4*)(pB + c);
                    *(unsigned*)(orow + c) = pk4_fp8(y.x, y.y, y.z, y.w); }
#pragma unroll
                for (int j = 0; j < 8; ++j) v[j] = (f32x4){bflo(vn[j].x), bfhi(vn[j].x), bflo(vn[j].y), bfhi(vn[j].y)};
            }
        }
        f32x4 acc0 = (f32x4){0.f, 0.f, 0.f, 0.f}, acc1 = (f32x4){0.f, 0.f, 0.f, 0.f};
        const bf16_t* rowp = R1 + (size_t)(tile * 16 + l15) * DM + 512 * g4;
        const float ra = my_rstd, rm = -my_mean * my_rstd;
        const int rt = F.tid;
        float wst[32]; u32x4 ar[8];
#define RT_WLOAD(c) do { int rt_ = rt; asm volatile("" : "+v"(rt_)); const float* wb_ = wr + (size_t)(64 * (c) + (rt_ >> 5)) * 32 + (rt_ & 31); \
            _Pragma("unroll") for (int q_ = 0; q_ < 32; ++q_) wst[q_] = wb_[(512 * (q_ >> 3) + 8 * (q_ & 7)) * 32]; } while (0)
        RT_WLOAD(0);
#pragma unroll
        for (int q = 0; q < 8; ++q) ar[q] = *(const u32x4*)(rowp + 8 * q);
#pragma unroll 1
        for (int c = 0; c < 8; ++c) {
            { int rt_ = rt; asm volatile("" : "+v"(rt_)); LAS float* wd_ = wl + (rt_ & 31) * 68 + (rt_ >> 5);
#pragma unroll
              for (int q = 0; q < 32; ++q) wd_[(q >> 3) * 32 * 68 + 8 * (q & 7)] = wst[q]; }
            sw_bar4(F.MISC + 16, rbt, lane);
            if (c < 7) RT_WLOAD(c + 1);
            const LAS float* w0p = wl + (g4 * 32 + l15) * 68; const LAS float* w1p = w0p + 16 * 68;
            const bf16_t* rown = rowp + 64 * (c < 7 ? c + 1 : c);
#pragma unroll
            for (int i = 0; i < 16; ++i) {
                const f32x4 av = *(const LAS f32x4*)(pA + 512 * g4 + 64 * c + 4 * i), bv = *(const LAS f32x4*)(pB + 512 * g4 + 64 * c + 4 * i);
                const f32x4 w0 = *(const LAS f32x4*)(w0p + 4 * i), w1 = *(const LAS f32x4*)(w1p + 4 * i);
                const unsigned lo = (i & 1) ? ar[i >> 1].z : ar[i >> 1].x, hi = (i & 1) ? ar[i >> 1].w : ar[i >> 1].y;
                const f32x4 tk = ((f32x4){bflo(lo), bfhi(lo), bflo(hi), bfhi(hi)} * ra + rm) * av + bv;
#pragma unroll
                for (int j = 0; j < 4; ++j) { acc0 = __builtin_amdgcn_mfma_f32_16x16x4f32(tk[j], w0[j], acc0, 0, 0, 0); acc1 = __builtin_amdgcn_mfma_f32_16x16x4f32(tk[j], w1[j], acc1, 0, 0, 0); }
                if (i == 7) {
#pragma unroll
                    for (int q = 0; q < 4; ++q) ar[q] = *(const u32x4*)(rown + 8 * q); }
            }
#pragma unroll
            for (int q = 4; q < 8; ++q) ar[q] = *(const u32x4*)(rown + 8 * q);
            sw_bar4(F.MISC + 16, rbt, lane);
        }
#undef RT_WLOAD
        { const float b0 = in[I_BR][l15], b1 = in[I_BR][16 + l15];
#pragma unroll
          for (int r = 0; r < 4; ++r) { lg[(4 * g4 + r) * 33 + l15] = acc0[r] + b0; lg[(4 * g4 + r) * 33 + 16 + l15] = acc1[r] + b1; } }
        LDS_WAIT(); asm volatile("" ::: "memory");
        if (lane < 16) {
            unsigned chosen = 0u; float lv[4]; int le[4];
            for (int k = 0; k < 4; ++k) { float best = -3.4e38f; int be = 0;
                for (int e = 0; e < 32; ++e) { const float v = lg[lane * 33 + e]; if (!((chosen >> e) & 1u) && v > best) { best = v; be = e; } }
                chosen |= 1u << be; lv[k] = best; le[k] = be; }
            float ex[4], sum = 0.f;
            for (int k = 0; k < 4; ++k) { ex[k] = __expf(lv[k] - lv[0]); sum += ex[k]; }
            for (int k = 0; k < 4; ++k) { te[lane * 4 + k] = le[k]; tw[lane * 4 + k] = ex[k] / sum; }
        }
        LDS_WAIT(); asm volatile("" ::: "memory");
        { const int e = te[lane]; const float wv = tw[lane]; const int token = tile * 16 + (lane >> 2);
          const int pos = (int)__hip_atomic_fetch_add(F.ctl + CW_CNT + 64 * e, 1u, __ATOMIC_RELAXED, __HIP_MEMORY_SCOPE_AGENT);
          WSP(int, WS_TOPE)[token * 4 + (lane & 3)] = e; WSP(int, WS_TOPP)[token * 4 + (lane & 3)] = pos; WSP(float, WS_TOPW)[token * 4 + (lane & 3)] = wv;
          WSP(int, WS_RTOK)[e * POSCAP + pos] = token; }
        LDS_WAIT(); asm volatile("" ::: "memory");
    }
}

constexpr int MOE_TBL = 131072;
__device__ __forceinline__ void moe_table(Frame& F) {
    LAS int* tst = (LAS int*)(F.lds + MOE_TBL); LAS int* cn = (LAS int*)(F.lds + MOE_TBL + 256);
    __syncthreads();
    if (F.tid < 64) {
        const int e = F.tid & 31; const int c = (int)__hip_atomic_load(F.ctl + CW_CNT + 64 * e, __ATOMIC_RELAXED, __HIP_MEMORY_SCOPE_AGENT);
        int inc = (c + 255) >> 8;
#pragma unroll
        for (int o = 1; o < 32; o <<= 1) { const int t = __shfl_up(inc, o); if ((F.tid & 31) >= o) inc += t; }
        if (F.tid < 32) { cn[e] = c; tst[e] = inc - ((c + 255) >> 8); if (e == 31) tst[NEXP] = inc; } }
    __syncthreads();
}
constexpr int MOE_UL = MOE_TBL + 512;
__device__ __forceinline__ void moe_unit_list(Frame& F, int NT) {
    const LAS int* tst = (const LAS int*)(F.lds + MOE_TBL); LAS int* ul = (LAS int*)(F.lds + MOE_UL);
    if (F.tid < 64) {
        const int nwg = tst[NEXP] * NT; const int L = F.tid * F.G + F.bid;
        int pm = -1, pn = 0, e = 0;
        if (L < nwg) {
            int wg; { const int q = nwg / 8, r = nwg % 8, xcd = L % 8, off = L / 8; wg = (xcd < r ? xcd * (q + 1) : r * (q + 1) + (xcd - r) * q) + off; }
            for (int k = 1; k < NEXP; ++k) if (wg >= tst[k] * NT) e = k;
            const int ts = tst[e], ne = tst[e + 1] - ts, rem = wg - ts * NT;
            pm = ts + rem % ne; pn = rem / ne; }
        ul[F.tid * 4 + 0] = pm; ul[F.tid * 4 + 1] = pn; ul[F.tid * 4 + 2] = e; ul[F.tid * 4 + 3] = 0;
    }
    __syncthreads();
}
constexpr int MOE_ROWS = MOE_UL + 1024, MOE_ROWS_MAX = 18;
constexpr int MOE_BIAS = MOE_ROWS + MOE_ROWS_MAX * 512;
static_assert(MOE_BIAS + MOE_ROWS_MAX * 1024 <= MISC_OFF, "MoE LDS tables");
__device__ __forceinline__ void moe_row_table(Frame& F, const int* rtok) {
    const LAS int* tst = (const LAS int*)(F.lds + MOE_TBL); const LAS int* cn = (const LAS int*)(F.lds + MOE_TBL + 256); const LAS int* ul = (const LAS int*)(F.lds + MOE_UL);
    LAS unsigned short* rows = (LAS unsigned short*)(F.lds + MOE_ROWS);
    for (int idx = F.tid; idx < MOE_ROWS_MAX * 256; idx += NTHR) { const int i = idx >> 8, r = idx & 255; const int pm = ul[i * 4];
        if (pm >= 0) { const int e = ul[i * 4 + 2]; int pos = (pm - tst[e]) * 256 + r; const int cnt = cn[e]; pos = pos < cnt ? pos : cnt - 1; rows[idx] = (unsigned short)rtok[e * POSCAP + pos]; } }
    __syncthreads();
}
__device__ __forceinline__ void moe_bias_table(Frame& F, const float* b0, const float* b1, bool gu) {
    const LAS int* ul = (const LAS int*)(F.lds + MOE_UL); LAS float* bt = (LAS float*)(F.lds + MOE_BIAS);
    for (int idx = F.tid; idx < MOE_ROWS_MAX * 256; idx += NTHR) { const int i = idx >> 8, j = idx & 255; const int pm = ul[i * 4];
        if (pm >= 0) { const int pn = ul[i * 4 + 1], e = ul[i * 4 + 2];
            bt[idx] = gu ? (j < 128 ? b0[(size_t)e * DM + pn * 128 + j] : b1[(size_t)e * DM + pn * 128 + j - 128]) : b0[(size_t)e * DM + pn * 256 + j]; } }
    __syncthreads();
}
template <bool GU> struct SchedMoE {
    static constexpr bool GATHER = GU;
    int G, c, NT; const LAS int* tst; const LAS int* cn; const int* rtok; const char* a; const char* b; const LAS int* ul;
    __device__ __forceinline__ bool next(int i, Unit& u) const {
        if (i >= MOE_ROWS_MAX) return false;
        const int pm = __builtin_amdgcn_readfirstlane(ul[i * 4 + 0]); if (pm < 0) return false;
        u.pm = pm; u.pn = __builtin_amdgcn_readfirstlane(ul[i * 4 + 1]); u.ex = i; return true;
    }
    __device__ __forceinline__ const char* a_base(const Unit& u) const { return GU ? a : a + (size_t)u.pm * 256 * DM; }
    __device__ __forceinline__ int expert(const Unit& u) const { return __builtin_amdgcn_readfirstlane(ul[u.ex * 4 + 2]); }
    __device__ __forceinline__ const char* b_base(const Unit& u) const { return b + ((size_t)expert(u) * (GU ? 4096 : 2048) + 256 * u.pn) * DM; }
    __device__ __forceinline__ int a_row(const Unit& u, int R) const { return (int)((const LAS unsigned short*)((const LAS char*)ul + (MOE_ROWS - MOE_UL)))[u.ex * 256 + R]; }
};
struct EpiGU {
    static constexpr bool PERM = true;
    unsigned char* ACT; const float* bg; const float* bu; const LAS int* ul;
    __device__ __forceinline__ void operator()(const f32x4 (&acc)[2][2][4][2], const Unit& u, int wr, int wc, int fr, int fq) const {
        const int row0 = u.pm * 256 + wr * 64 + fr, col0 = u.pn * 128 + wc * 32 + 8 * fq;
        const LAS float* bt = (const LAS float*)((const LAS char*)ul + (MOE_BIAS - MOE_UL)) + u.ex * 256 + wc * 32 + 8 * fq;
        const f32x4 g0 = *(const LAS f32x4*)bt, g1 = *(const LAS f32x4*)(bt + 4), u0 = *(const LAS f32x4*)(bt + 128), u1 = *(const LAS f32x4*)(bt + 132);
#pragma unroll
        for (int ai = 0; ai < 2; ++ai)
#pragma unroll
            for (int m = 0; m < 4; ++m) { const size_t row = row0 + ai * 128 + m * 16;
                float o[8];
#pragma unroll
                for (int n = 0; n < 2; ++n)
#pragma unroll
                    for (int j = 0; j < 4; ++j) { const float gv = fminf(acc[ai][0][m][n][j] + (n ? g1[j] : g0[j]), 7.0f);
                        const float uv = fminf(fmaxf(acc[ai][1][m][n][j] + (n ? u1[j] : u0[j]), -7.0f), 7.0f);
                        o[n * 4 + j] = 4.0f * gv * sigmoid_fast(1.702f * gv) * (uv + 1.0f); }
                u32x2 w; w.x = pk4_fp8(o[0], o[1], o[2], o[3]); w.y = pk4_fp8(o[4], o[5], o[6], o[7]);
                *(u32x2*)(ACT + row * DM + col0) = w; }
    }
};
struct EpiDN {
    static constexpr bool PERM = true;
    unsigned char* YR; const LAS int* ul;
    __device__ __forceinline__ void operator()(const f32x4 (&acc)[2][2][4][2], const Unit& u, int wr, int wc, int fr, int fq) const {
        const int r0 = wr * 64 + fr, col0 = u.pn * 256 + wc * 32 + 8 * fq;
        const LAS float* bp = (const LAS float*)((const LAS char*)ul + (MOE_BIAS - MOE_UL)) + u.ex * 256 + wc * 32 + 8 * fq;
        unsigned char* base = YR + ((size_t)u.pm * 256 + r0) * DM + col0;
#pragma unroll
        for (int bj = 0; bj < 2; ++bj) {
            const f32x4 bv0 = *(const LAS f32x4*)(bp + bj * 128), bv1 = *(const LAS f32x4*)(bp + bj * 128 + 4);
#pragma unroll
            for (int ai = 0; ai < 2; ++ai)
#pragma unroll
                for (int m = 0; m < 4; ++m) {
                    const f32x4 lim = (f32x4){448.f, 448.f, 448.f, 448.f};
                    const f32x4 v0 = __builtin_elementwise_min(__builtin_elementwise_max((acc[ai][bj][m][0] + bv0) * 16.0f, -lim), lim), v1 = __builtin_elementwise_min(__builtin_elementwise_max((acc[ai][bj][m][1] + bv1) * 16.0f, -lim), lim);
                    u32x2 w; w.x = pk4_fp8(v0[0], v0[1], v0[2], v0[3]); w.y = pk4_fp8(v1[0], v1[1], v1[2], v1[3]);
                    *(u32x2*)(base + (size_t)(ai * 128 + m * 16) * DM + bj * 128) = w; }
        }
    }
};

__device__ __forceinline__ void p11_phase(Frame& F) {
    const KargP in = karg_opaque(F.in);
    const int gw = F.bid * NWAVES + F.wave, NGW = F.G * NWAVES, lane = F.lane;
    const LAS int* tst = (const LAS int*)(F.lds + MOE_TBL);
    const bf16_t* R1 = WSP(bf16_t, WS_R1); const unsigned char* YR = WSP(unsigned char, WS_YR); const float* mod = WSP(float, WS_MOD);
    LAS float* pl = (LAS float*)F.lds;
    for (int i = F.tid; i < 2048; i += NTHR) { pl[i] = in[I_LN1G][i]; pl[2048 + i] = in[I_LN1B][i]; pl[4096 + i] = in[I_LN2G][i]; pl[6144 + i] = in[I_LN2B][i]; }
    for (int i = F.tid; i < 8 * 2048; i += NTHR) pl[8192 + i] = mod[(size_t)(i >> 11) * 12288 + 10240 + (i & 2047)];
    __syncthreads();
    LAS int* sd = (LAS int*)(F.lds + 98304 + F.wave * 512); LAS float* sw = (LAS float*)(F.lds + 98304 + F.wave * 512 + 256);
#pragma unroll 1
    for (int rb = gw * 8; rb < MTOK; rb += NGW * 8) {
        const int li = lane & 31;
        { const int ve = WSP(int, WS_TOPE)[rb * 4 + li], vp = WSP(int, WS_TOPP)[rb * 4 + li]; const float vw = WSP(float, WS_TOPW)[rb * 4 + li];
          if (lane < 32) { sd[li] = tst[ve] * 256 + vp; sw[li] = vw; } }
        const LAS float* g2p = pl + 8192 + (rb / SEQ) * 2048;
        LDS_WAIT(); asm volatile("" ::: "memory");
#pragma unroll 1
        for (int ri = 0; ri < 8; ++ri) {
            const int row = rb + ri;
            int dest[4]; float wk[4];
#pragma unroll
            for (int k = 0; k < 4; ++k) { dest[k] = __builtin_amdgcn_readfirstlane(sd[ri * 4 + k]); wk[k] = __builtin_bit_cast(float, __builtin_amdgcn_readfirstlane(__builtin_bit_cast(int, sw[ri * 4 + k]))); }
            const bf16_t* xr = R1 + (size_t)row * DM + lane * 4;
            f32x4 v[8]; unsigned yy[4][8]; u32x2 vr[8];
#pragma unroll
            for (int j = 0; j < 8; ++j) vr[j] = *(const u32x2*)(xr + 256 * j);
#pragma unroll
            for (int k = 0; k < 4; ++k) { const unsigned char* yp = YR + (size_t)dest[k] * DM + lane * 4;
#pragma unroll
                for (int j = 0; j < 8; ++j) yy[k][j] = *(const unsigned*)(yp + 256 * j); }
            float s = 0.f;
#pragma unroll
            for (int j = 0; j < 8; ++j) { v[j] = (f32x4){bflo(vr[j].x), bfhi(vr[j].x), bflo(vr[j].y), bfhi(vr[j].y)}; s += (v[j].x + v[j].y) + (v[j].z + v[j].w); }
            float mean = wave_sum(s) * (1.f / DM); float s2 = 0.f;
#pragma unroll
            for (int j = 0; j < 8; ++j) { v[j] = v[j] - mean; s2 += (v[j].x * v[j].x + v[j].y * v[j].y) + (v[j].z * v[j].z + v[j].w * v[j].w); }
            float rstd = 1.f / sqrtf(wave_sum(s2) * (1.f / DM) + LN_EPS);
            s = 0.f;
#pragma unroll
            for (int j = 0; j < 8; ++j) { const int c = lane * 4 + 256 * j;
                const f32x4 g = *(const LAS f32x4*)(pl + c), bb = *(const LAS f32x4*)(pl + 2048 + c), g2v = *(const LAS f32x4*)(g2p + c);
                f32x4 y = (f32x4){0.f, 0.f, 0.f, 0.f};
#pragma unroll
                for (int k = 0; k < 4; ++k) { const f32x2 lo = __builtin_amdgcn_cvt_pk_f32_fp8((int)yy[k][j], false), hi = __builtin_amdgcn_cvt_pk_f32_fp8((int)yy[k][j], true); y += (f32x4){lo.x, lo.y, hi.x, hi.y} * (wk[k] * 0.0625f); }
                v[j] = (v[j] * rstd * g + bb) * DN_ALPHA + g2v * y;
                s += (v[j].x + v[j].y) + (v[j].z + v[j].w); __builtin_amdgcn_sched_barrier(0); }
            mean = wave_sum(s) * (1.f / DM); s2 = 0.f;
#pragma unroll
            for (int j = 0; j < 8; ++j) { v[j] = v[j] - mean; s2 += (v[j].x * v[j].x + v[j].y * v[j].y) + (v[j].z * v[j].z + v[j].w * v[j].w); }
            rstd = 1.f / sqrtf(wave_sum(s2) * (1.f / DM) + LN_EPS);
            float* orow = F.out + (size_t)row * DM;
#pragma unroll
            for (int j = 0; j < 8; ++j) { const int c = lane * 4 + 256 * j;
                const f32x4 g = *(const LAS f32x4*)(pl + 4096 + c), bb = *(const LAS f32x4*)(pl + 6144 + c);
                *(f32x4*)(orow + c) = v[j] * rstd * g + bb; }
        }
        LDS_WAIT(); asm volatile("" ::: "memory");
    }
}

constexpr int NPHASE = 13;
__global__ void __launch_bounds__(NTHR, 2) mk_fwd(Args args) {
    extern __shared__ __attribute__((aligned(16))) unsigned char lds_raw[];
    Frame F;
    F.lds = (LAS unsigned char*)lds_raw;
    F.MISC = (volatile LAS unsigned*)(F.lds + MISC_OFF);
    F.tid = threadIdx.x; F.lane = F.tid & 63; F.wave = __builtin_amdgcn_readfirstlane(F.tid >> 6); F.wave0 = F.wave;
    F.G = gridDim.x; F.bid = blockIdx.x;
    F.in = (KargP)__builtin_amdgcn_kernarg_segment_ptr(); F.out = args.out; F.ws = args.ws; F.ctl = (unsigned*)(args.ws + WS_CTL);
    for (int u = F.tid; u < (LDS_BYTES - MISC_OFF) / 4; u += NTHR) ((LAS unsigned*)(F.lds + MISC_OFF))[u] = 0u;
    __syncthreads();
    XcdBarrier bar; bar.bar = F.ctl + CW_BAR; bar.x = 0; bar.st = nullptr;
    if (MK_LAUNCHES == 1) bar = xcd_barrier_post(F.ctl + CW_BAR, F.MISC + 8, F.tid);
    const int lo = args.ph_lo, hi = args.ph_hi;
    unsigned long long tph_ = (PROBE_PH >= 0) ? __builtin_amdgcn_s_memrealtime() : 0ull;
#ifndef PH_MASK
#define PH_MASK 0xFFFF
#endif
#define TID_NOW(var) int var; { unsigned z_ = 0u; asm volatile("" : "+s"(z_)); var = (F.wave0 << 6) | (int)__builtin_amdgcn_mbcnt_hi(~0u, __builtin_amdgcn_mbcnt_lo(~0u, z_)); }
#define RELOAD() do { const KargP k_ = karg_opaque(F.in); F.out = (float*)k_[38]; F.ws = (unsigned char*)k_[39]; F.ctl = (unsigned*)F.ws; TID_NOW(t_); asm volatile("" : "+v"(t_)); F.tid = t_; F.lane = t_ & 63; F.wave = __builtin_amdgcn_readfirstlane(t_ >> 6); } while (0)
#define IN(k) (((PH_MASK >> (k)) & 1) && lo <= (k) && (k) < hi)
#define SEAM(k) do { if (IN(k) && IN((k) + 1)) { TID_NOW(ts_); xcd_barrier(bar, ts_); } \
        if (PROBE_PH >= 0) { const unsigned long long t1_ = __builtin_amdgcn_s_memrealtime(); \
            if (PROBE_PH == (k)) { while (__builtin_amdgcn_s_memrealtime() - t1_ < t1_ - tph_) __builtin_amdgcn_s_sleep(8); } \
            tph_ = __builtin_amdgcn_s_memrealtime(); } } while (0)
#ifndef DUP_MASK
#define DUP_MASK 0
#endif
#define REP(k) for (int rep_ = 0; rep_ < (((DUP_MASK >> (k)) & 1) ? 2 : 1); ++rep_)
    if (IN(0)) REP(0) p0_phase(F);
    SEAM(0);
    RELOAD();
    if (IN(1)) REP(1) p0b_phase(F);
    SEAM(1);
    RELOAD();
    if (IN(2)) REP(2) p1_phase(F);
    SEAM(2);
    RELOAD();
    if (IN(3)) REP(3) {
        EpiZ E{WSP(bf16_t, WS_Z), WSP(bf16_t, WS_ZT), WSP(float, WS_BINP)};
        { SchedZ<false> S{F.G, F.bid, (const char*)WSP(bf16_t, WS_HX), (const char*)WSP(bf16_t, WS_WIN)};
          pg8::gemm_phase<EpiZ, SchedZ<false>>(F.tid, F.lds, DM / 64, DM * 2, DM * 2, S, E); }
        { SchedZ<true> S{F.G, F.G - 1 - F.bid, (const char*)WSP(unsigned char, WS_HX8), (const char*)WSP(unsigned char, WS_WIN8)};
          pg8::gemm_phase<EpiZ, SchedZ<true>, true>(F.tid, F.lds, DM / 128, DM, DM, S, E, 0x7A7A7A7A, 0x7F7F7F7F); }
    }
    SEAM(3);
    RELOAD();
    if (IN(4)) REP(4) p3_phase(F);
    SEAM(4);
    RELOAD();
    if (IN(5)) REP(5) {
        SchedQK S{F.G, F.bid, (const char*)WSP(bf16_t, WS_U), (const char*)WSP(bf16_t, WS_WQK)};
        EpiQK E{WSP(bf16_t, WS_QKB)};
        pg8::gemm_phase<EpiQK, SchedQK>(F.tid, F.lds, 256 / 64, MW * 2, 256 * 2, S, E);
    }
    SEAM(5);
    RELOAD();
    if (IN(6)) REP(6) {
#ifndef DUP_ML
#define DUP_ML 1
#endif
#ifndef DUP_HY
#define DUP_HY 1
#endif
        for (int un = F.bid; un < 256 * DUP_ML; un += F.G) mlstm_unit(F, un & 255);
        RELOAD();
        { CvHook hk; hk.in = karg_opaque(F.in); hk.ws = F.ws; hk.tiles = (LAS unsigned char*)(F.lds + HY_CVT); hk.tid = F.tid; hk.bid = F.bid; hk.G = F.G; hk.kmax = (CVH_NITEMS - 1 - F.bid) / F.G; hk.s = 2; hk.request<0>(0); hk.request<1>(1);
          for (int un = F.bid; un < 512 * DUP_HY; un += F.G) hyena_unit(F, un & 511, hk);
          while (hk.s <= hk.kmax + 3) { __syncthreads(); if (hk.s & 1) hk.act<1>(); else hk.act<0>(); }
          __syncthreads(); }
    }
    SEAM(6);
    RELOAD();
    if (IN(7)) REP(7) {
        { SchedP S{F.G, F.bid, (const char*)WSP(unsigned char, WS_AM), (const char*)WSP(unsigned char, WS_WPA2), (size_t)256 * 2048, (size_t)256 * 2048};
          EpiMA E{WSP(bf16_t, WS_T), WSP(bf16_t, WS_Z)};
          pg8::gemm_phase<EpiMA, SchedP, true>(F.tid, F.lds, 2048 / 128, 2048, 2048, S, E, 0x7A7A7A7A, 0x7F7F7F7F); }
        VM_WAIT(); __syncthreads();
        { SchedP S{F.G, F.bid, (const char*)WSP(unsigned char, WS_HH), (const char*)WSP(unsigned char, WS_WPH), (size_t)256 * 1024, (size_t)256 * 1024};
          EpiMB E{WSP(bf16_t, WS_T), WSP(bf16_t, WS_Z), WSP(unsigned char, WS_MX)};
          pg8::gemm_phase<EpiMB, SchedP, true>(F.tid, F.lds, 1024 / 128, 1024, 1024, S, E, 0x7A7A7A7A, 0x7F7F7F7F); }
    }
    SEAM(7);
    RELOAD();
    if (IN(8)) REP(8) {
        SchedP S{F.G, F.bid, (const char*)WSP(unsigned char, WS_MX), (const char*)WSP(unsigned char, WS_WOUT), (size_t)256 * 2048, (size_t)256 * 2048};
        const KargP in = karg_opaque(F.in); EpiWO E{WSP(bf16_t, WS_R1), in[I_X], WSP(float, WS_STATS), in[I_LNG], in[I_LNB], WSP(float, WS_MOD)};
        pg8::gemm_phase<EpiWO, SchedP, true>(F.tid, F.lds, 2048 / 128, 2048, 2048, S, E, 0x79797979, 0x7F7F7F7F);
    }
    SEAM(8);
    RELOAD();
    if (IN(9)) p8_phase(F);
    SEAM(9);
    RELOAD();
    if (IN(10)) REP(10) {
        moe_table(F);
        moe_unit_list(F, 16); moe_row_table(F, WSP(int, WS_RTOK)); { const KargP in_ = karg_opaque(F.in); moe_bias_table(F, in_[I_BG], in_[I_BU], true); }
        SchedMoE<true> S{F.G, F.bid, 16, (const LAS int*)(F.lds + MOE_TBL), (const LAS int*)(F.lds + MOE_TBL + 256), WSP(int, WS_RTOK), (const char*)WSP(bf16_t, WS_TOK), (const char*)WSP(bf16_t, WS_WGU), (const LAS int*)(F.lds + MOE_UL)};
        const KargP in = karg_opaque(F.in); EpiGU E{WSP(unsigned char, WS_ACT), in[I_BG], in[I_BU], (const LAS int*)(F.lds + MOE_UL)};
        pg8::gemm_phase<EpiGU, SchedMoE<true>, true>(F.tid, F.lds, DM / 128, DM, DM, S, E, 0x7A7A7A7A, 0x7F7F7F7F);
    }
    SEAM(10);
    RELOAD();
    if (IN(11)) REP(11) {
        moe_table(F);
        moe_unit_list(F, 8); { const KargP in_ = karg_opaque(F.in); moe_bias_table(F, in_[I_BDN], in_[I_BDN], false); }
        SchedMoE<false> S{F.G, F.bid, 8, (const LAS int*)(F.lds + MOE_TBL), (const LAS int*)(F.lds + MOE_TBL + 256), WSP(int, WS_RTOK), (const char*)WSP(bf16_t, WS_ACT), (const char*)WSP(bf16_t, WS_WD), (const LAS int*)(F.lds + MOE_UL)};
        const KargP in = karg_opaque(F.in); EpiDN E{WSP(unsigned char, WS_YR), (const LAS int*)(F.lds + MOE_UL)};
        pg8::gemm_phase<EpiDN, SchedMoE<false>, true>(F.tid, F.lds, DM / 128, DM, DM, S, E, 0x79797979, 0x7D7D7D7D);
    }
    SEAM(11);
    RELOAD();
    if (IN(12)) REP(12) { moe_table(F); p11_phase(F); }
#undef IN
#undef SEAM
}

extern "C" void kernel_launch(void* const* d_in, const int* in_sizes, int n_in, void* d_out, int out_size, void* d_ws, size_t ws_size, hipStream_t stream) {
    static int grid = 0;
    if (grid == 0) {
        if (n_in != 38 || out_size != MTOK * DM || ws_size < WS_END) { fprintf(stderr, "kernel_launch: unexpected shapes: n_in %d out %d ws %zu (need %zu)\n", n_in, out_size, ws_size, (size_t)WS_END); grid = -1; return; }
        int dev = 0, cus = 0, per_cu = 0;
        if (hipGetDevice(&dev) != hipSuccess || hipDeviceGetAttribute(&cus, hipDeviceAttributeMultiprocessorCount, dev) != hipSuccess) { grid = -1; return; }
        if (hipFuncSetAttribute((const void*)mk_fwd, hipFuncAttributeMaxDynamicSharedMemorySize, LDS_BYTES) != hipSuccess) { fprintf(stderr, "kernel_launch: hipFuncSetAttribute failed\n"); grid = -1; return; }
        if (hipOccupancyMaxActiveBlocksPerMultiprocessor(&per_cu, (const void*)mk_fwd, NTHR, LDS_BYTES) != hipSuccess || per_cu < 1) fprintf(stderr, "kernel_launch: occupancy query says %d\n", per_cu);
        (void)hipGetLastError();
        grid = cus;
    }
    if (grid < 0) return;
    (void)hipMemsetAsync((char*)d_ws + WS_CTL, 0, CTL_ZERO_BYTES, stream);
    Args a{};
    for (int i = 0; i < 38; ++i) a.in[i] = (const float*)d_in[i];
    a.out = (float*)d_out; a.ws = (unsigned char*)d_ws;
#if MK_LAUNCHES == 1
    a.ph_lo = 0; a.ph_hi = NPHASE;
    hipLaunchKernelGGL(mk_fwd, dim3(grid), dim3(NTHR), LDS_BYTES, stream, a);
#else
    for (int p = 0; p < NPHASE; ++p) { a.ph_lo = p; a.ph_hi = p + 1; hipLaunchKernelGGL(mk_fwd, dim3(grid), dim3(NTHR), LDS_BYTES, stream, a); }
#endif
}
```

```cpp
#include <hip/hip_runtime.h>
#include <cstdio>
#include <cstdint>

#define GAS __attribute__((address_space(1)))
#define LAS __attribute__((address_space(3)))
typedef unsigned short bf16_t;
typedef short bf16x8 __attribute__((ext_vector_type(8)));
typedef float f32x4 __attribute__((ext_vector_type(4)));
typedef float f32x2 __attribute__((ext_vector_type(2)));
typedef unsigned u32x4 __attribute__((ext_vector_type(4)));
typedef unsigned u32x2 __attribute__((ext_vector_type(2)));

#ifndef PROBE_PH
#define PROBE_PH -1
#endif
#ifndef MK_LAUNCHES
#define MK_LAUNCHES 1
#endif

constexpr int DM = 2048, NB = 8, SEQ = 2048, CTX = 256, GW = 64;
constexpr int MTOK = NB * SEQ;
constexpr int MCTX = NB * CTX;
constexpr int MALL = MTOK + MCTX;
constexpr int NH = 4, HD = 256, MW = 1024, HW = 1024;
constexpr int N_IN = 10256;
constexpr int NEXP = 32, TOPK = 4;
constexpr float LN_EPS = 1e-5f;
constexpr float DN_ALPHA = 1.189207115002721f;
constexpr int ZN = 7424, ZC_QK = 0, ZC_V = 1024, ZC_O = 2048, ZC_GA = 3072, ZC_GH = 5120, ZC_GT = 7168;
constexpr int WIN_ROWS = 10496, WIN_HY0 = 7424;
constexpr int MAXTILES = 288;
constexpr int POSCAP = 16384;

constexpr size_t MiB = 1u << 20;
constexpr size_t WS_CTL = 0;
constexpr size_t WS_MODP = 1203 * MiB;
constexpr size_t WS_MOD = 9 * MiB;
constexpr size_t WS_BINP = 10 * MiB;
constexpr size_t WS_A3 = 10 * MiB + 64 * 1024;
constexpr size_t WS_STATS = 11 * MiB;
constexpr size_t WS_TOPE = 11 * MiB + 256 * 1024;
constexpr size_t WS_TOPP = 11 * MiB + 512 * 1024;
constexpr size_t WS_TOPW = 11 * MiB + 768 * 1024;
constexpr size_t WS_RTOK = 12 * MiB;
constexpr size_t WS_RW = 14 * MiB;
constexpr size_t WS_WQK = 16 * MiB;
constexpr size_t WS_WPH = 17 * MiB;
constexpr size_t WS_WPA2 = 21 * MiB;
constexpr size_t WS_WOUT = 29 * MiB;
constexpr size_t WS_WIN = 37 * MiB;
constexpr size_t WS_WGU = 78 * MiB;
constexpr size_t WS_WD = 590 * MiB;
constexpr size_t WS_RA = 846 * MiB;
constexpr size_t WS_Z = WS_RA, WS_ZT = WS_RA + 261 * MiB, WS_ACT = WS_RA;
constexpr size_t WS_RB = 1203 * MiB;
constexpr size_t WS_HX = WS_RB, WS_U = WS_RB + 72 * MiB, WS_QKB = WS_RB + 108 * MiB, WS_AM = WS_RB + 180 * MiB, WS_HH = WS_RB + 244 * MiB, WS_MX = WS_RB + 276 * MiB, WS_YR = WS_RB;
constexpr size_t WS_RC = 1543 * MiB;
constexpr size_t WS_HTAPS = WS_RC, WS_H = WS_RC + 32 * MiB, WS_T = WS_RC;
constexpr size_t WS_R1 = 1671 * MiB;
constexpr size_t WS_TOK = 1799 * MiB;
constexpr size_t WS_HX8 = WS_RC + 96 * MiB;
constexpr size_t WS_WIN8 = 1863 * MiB;
constexpr size_t WS_DUMMY = 1884 * MiB;
constexpr size_t WS_END = 1890 * MiB;
constexpr int CW_TMO = 0, CW_BAR = 4096, CW_CNT = 16384;
constexpr size_t CTL_ZERO_BYTES = 1 * MiB;

constexpr int LDS_BYTES = 160 * 1024 - 2048;
constexpr int MISC_OFF = LDS_BYTES - 1024;
constexpr int NWAVES = 8, NTHR = 512;

#define LDS_WAIT() asm volatile("s_waitcnt lgkmcnt(0)" ::: "memory")
#define VM_WAIT() asm volatile("s_waitcnt vmcnt(0)" ::: "memory")
__device__ __forceinline__ unsigned f2bf(float f) { unsigned u = __builtin_bit_cast(unsigned, f); return (u + 0x7fffu + ((u >> 16) & 1u)) >> 16; }
__device__ __forceinline__ unsigned pk2(float lo, float hi) { unsigned r; asm("v_cvt_pk_bf16_f32 %0, %1, %2" : "=v"(r) : "v"(lo), "v"(hi)); return r; }
__device__ __forceinline__ unsigned pk4_fp8(float a, float b, float c, float d) { int w = 0; w = __builtin_amdgcn_cvt_pk_fp8_f32(a, b, w, false); w = __builtin_amdgcn_cvt_pk_fp8_f32(c, d, w, true); return (unsigned)w; }
__device__ __forceinline__ float bf2f(unsigned b) { return __builtin_bit_cast(float, b << 16); }
__device__ __forceinline__ float bflo(unsigned w) { return __builtin_bit_cast(float, w << 16); }
__device__ __forceinline__ float bfhi(unsigned w) { return __builtin_bit_cast(float, w & 0xffff0000u); }
__device__ __forceinline__ float sigmoidf_(float x) { return 1.0f / (1.0f + __expf(-x)); }
__device__ __forceinline__ float sigmoid_fast(float x) { return __builtin_amdgcn_rcpf(1.0f + __expf(-x)); }
__device__ __forceinline__ float wave_sum(float v) {
#pragma unroll
    for (int o = 1; o < 64; o <<= 1) v += __shfl_xor(v, o);
    return v;
}

#define DPP_STEP_(OP, x, ctrl, rmask, bmask, ident) { const float t_ = __builtin_bit_cast(float, __builtin_amdgcn_update_dpp(__builtin_bit_cast(int, ident), __builtin_bit_cast(int, x), ctrl, rmask, bmask, false)); x = OP(x, t_); }
__device__ __forceinline__ float scan_add_(float a, float b) { return a + b; }
__device__ __forceinline__ float wave_scan_sum(float v) {
    float x = v; const float z = 0.f;
    { const float t1 = __builtin_bit_cast(float, __builtin_amdgcn_update_dpp(0, __builtin_bit_cast(int, v), 0x111, 0xf, 0xf, false));
      const float t2 = __builtin_bit_cast(float, __builtin_amdgcn_update_dpp(0, __builtin_bit_cast(int, v), 0x112, 0xf, 0xf, false));
      const float t3 = __builtin_bit_cast(float, __builtin_amdgcn_update_dpp(0, __builtin_bit_cast(int, v), 0x113, 0xf, 0xf, false));
      x = (v + t1) + (t2 + t3); }
    DPP_STEP_(scan_add_, x, 0x114, 0xf, 0xe, z)
    DPP_STEP_(scan_add_, x, 0x118, 0xf, 0xc, z)
    DPP_STEP_(scan_add_, x, 0x142, 0xa, 0xf, z)
    DPP_STEP_(scan_add_, x, 0x143, 0xc, 0xf, z)
    return x;
}
__device__ __forceinline__ float wave_scan_max(float v) {
    float x = v; const float ninf = -__builtin_inff(); const int ni = __builtin_bit_cast(int, ninf);
    { const float t1 = __builtin_bit_cast(float, __builtin_amdgcn_update_dpp(ni, __builtin_bit_cast(int, v), 0x111, 0xf, 0xf, false));
      const float t2 = __builtin_bit_cast(float, __builtin_amdgcn_update_dpp(ni, __builtin_bit_cast(int, v), 0x112, 0xf, 0xf, false));
      const float t3 = __builtin_bit_cast(float, __builtin_amdgcn_update_dpp(ni, __builtin_bit_cast(int, v), 0x113, 0xf, 0xf, false));
      x = fmaxf(fmaxf(v, t1), fmaxf(t2, t3)); }
    DPP_STEP_(fmaxf, x, 0x114, 0xf, 0xe, ninf)
    DPP_STEP_(fmaxf, x, 0x118, 0xf, 0xc, ninf)
    DPP_STEP_(fmaxf, x, 0x142, 0xa, 0xf, ninf)
    DPP_STEP_(fmaxf, x, 0x143, 0xc, 0xf, ninf)
    return x;
}
__device__ __forceinline__ float lane_bcast(float v, int l) { return __builtin_bit_cast(float, __builtin_amdgcn_readlane(__builtin_bit_cast(int, v), l)); }
#define XB_TMO      128
#define XB_XCNT(j)  (256  + 64 * (j))
#define XB_XSUB(j)  (1280 + 64 * (j))
#define XB_XGEN(j)  (2304 + 64 * (j))
#define XB_TOP      3328
#define XB_TOPGEN   3392
#define XCD_BAR_WORDS 3456
#define XB_SPIN_CAP (1u << 22)
__device__ __forceinline__ unsigned xb_ld(unsigned* p)              { return __hip_atomic_load(p, __ATOMIC_RELAXED, __HIP_MEMORY_SCOPE_AGENT); }
__device__ __forceinline__ unsigned xb_add(unsigned* p, unsigned v) { return __hip_atomic_fetch_add(p, v, __ATOMIC_RELAXED, __HIP_MEMORY_SCOPE_AGENT); }
__device__ __forceinline__ unsigned xb_xcc_id() { return (unsigned)__builtin_amdgcn_s_getreg((3 << 11) | 20) & 0xFu; }
#define XB_SPIN(cond, bar) do { unsigned _sp = 0; while (cond) { __builtin_amdgcn_s_sleep(1); \
    if ((++_sp & 255u) == 0u) { if (xb_ld(&(bar)[XB_TMO])) break; if (_sp > XB_SPIN_CAP) { atomicAdd(&(bar)[XB_TMO], 1u); break; } } } } while (0)
struct XcdBarrier { unsigned* bar; unsigned x; volatile LAS unsigned* st; };
__device__ __forceinline__ XcdBarrier xcd_barrier_post(unsigned* bar, volatile LAS unsigned* st, int tid) {
    XcdBarrier b; b.bar = bar; b.x = xb_xcc_id(); b.st = st;
    if (tid == 0) (void)xb_add(&bar[XB_XCNT(b.x)], 1u);
    return b;
}
__device__ __forceinline__ void xcd_barrier_complete(unsigned* bar, unsigned x, unsigned& nloc, unsigned& nx) {
    const unsigned G = gridDim.x * gridDim.y * gridDim.z;
    unsigned sum, cnt, mine, sp = 0u;
    for (;;) {
        sum = 0u; cnt = 0u; mine = 0u;
#pragma unroll
        for (unsigned j = 0; j < 16; ++j) { const unsigned c = xb_ld(&bar[XB_XCNT(j)]); sum += c; cnt += (c > 0u) ? 1u : 0u; mine = (j == x) ? c : mine; }
        if (sum == G) break;
        __builtin_amdgcn_s_sleep(1);
        if ((++sp & 255u) == 0u) { if (xb_ld(&bar[XB_TMO])) break; if (sp > XB_SPIN_CAP) { atomicAdd(&bar[XB_TMO], 1u); break; } }
    }
    nloc = mine > 0u ? mine : 1u; nx = cnt > 0u ? cnt : 1u;
}
__device__ __forceinline__ void xcd_barrier(const XcdBarrier& b, int tid) {
    asm volatile("s_waitcnt vmcnt(0)" ::: "memory");
    __syncthreads();
    if (tid == 0) {
        unsigned* bar = b.bar;
        __builtin_amdgcn_s_waitcnt(0);
        unsigned nloc = b.st[0], nx = b.st[1];
        if (nloc == 0u) { xcd_barrier_complete(bar, b.x, nloc, nx); b.st[0] = nloc; b.st[1] = nx; }
        const unsigned old = xb_add(&bar[XB_XSUB(b.x)], 1u);
        const unsigned gen = old / nloc;
        if (old + 1u == (gen + 1u) * nloc) {
            __builtin_amdgcn_fence(__ATOMIC_RELEASE, "agent");
            asm volatile("s_waitcnt vmcnt(0)" ::: "memory");
            const unsigned og = xb_add(&bar[XB_TOP], 1u);
            const unsigned tg = og / nx;
            if (og + 1u == (tg + 1u) * nx) xb_add(&bar[XB_TOPGEN], 1u);
            else XB_SPIN(xb_ld(&bar[XB_TOPGEN]) == tg, bar);
            __builtin_amdgcn_fence(__ATOMIC_ACQUIRE, "agent");
            xb_add(&bar[XB_XGEN(b.x)], 1u);
            asm volatile("s_waitcnt vmcnt(0)" ::: "memory");
        } else {
            XB_SPIN(xb_ld(&bar[XB_XGEN(b.x)]) == gen, bar);
            __builtin_amdgcn_fence(__ATOMIC_ACQUIRE, "agent");
            asm volatile("s_waitcnt vmcnt(0)" ::: "memory");
        }
    }
    __syncthreads();
}

struct Args {
    const float* in[38];
    float* out; unsigned char* ws;
    int ph_lo, ph_hi;
};
enum { I_X = 0, I_C, I_CTX, I_CCTX, I_LNG, I_LNB, I_WMOD, I_BMOD, I_WIN, I_BIN, I_MCW, I_MCB, I_WQH, I_WKH, I_HCW, I_HCB, I_FW1, I_FB1, I_FWH, I_FBH,
       I_FFREQ, I_FWOUT, I_HSKIP, I_WPA, I_WPH, I_WOUT, I_LN1G, I_LN1B, I_WR, I_BR, I_WG, I_BG, I_WU, I_BU, I_WDN, I_BDN, I_LN2G, I_LN2B };

namespace pg8 {
constexpr int BM = 256, BK = 64, HALF = 128, HTB = HALF * BK * 2, STAGE_BYTES = 8 * HTB, NXCD = 8, WGM = 8;
__host__ __device__ __forceinline__ int lds_byte(int r, int c) { const int st = (r >> 4) * 2 + (c >> 5), rr = r & 15, cc = c & 31, ob = rr * 64 + cc * 2; return st * 1024 + (ob ^ (((ob >> 9) & 1) << 5)); }
__host__ __device__ __forceinline__ void stage_rc(int b, int& R, int& C) { const int st = b / 1024, sb = b % 1024, swz = sb ^ (((sb >> 9) & 1) << 5); R = (st >> 1) * 16 + swz / 64; C = (st & 1) * 32 + (swz % 64) / 2; }
__host__ __device__ __forceinline__ int perm32(int rho) { const int n = rho >> 4, i = rho & 15; return 8 * (i >> 2) + 4 * n + (i & 3); }
struct Unit { int pm, pn, ex; };
__device__ __forceinline__ void decode_tile(int L, int nM, int nN, int& pm, int& pn) {
    const int nwg = nM * nN; int wgid = L;
    { const int q = nwg / NXCD, r = nwg % NXCD, xcd = wgid % NXCD, off = wgid / NXCD; wgid = (xcd < r ? xcd * (q + 1) : r * (q + 1) + (xcd - r) * q) + off; }
    const int nig = WGM * nN, gid = wgid / nig, fm = gid * WGM, gsz = (nM - fm) < WGM ? (nM - fm) : WGM;
    pm = fm + ((wgid % nig) % gsz); pn = (wgid % nig) / gsz;
}
__device__ __forceinline__ unsigned cvt_pk_bf16(float lo, float hi) { unsigned r; asm volatile("v_cvt_pk_bf16_f32 %0, %1, %2" : "=v"(r) : "v"(lo), "v"(hi)); return r; }

typedef int i32x8 __attribute__((ext_vector_type(8)));
template <class Epi, class Sched, bool F8 = false>
__device__ __forceinline__ void gemm_phase(const int tid, LAS unsigned char* lds, const int nt, const int pitchA, const int pitchB, const Sched& S, const Epi& E, const int wscale = 0x7F7F7F7F, const int ascale = 0x7F7F7F7F) {
    const int wid = __builtin_amdgcn_readfirstlane(tid >> 6), lane = tid & 63, wr = wid >> 2, wc = wid & 3, fr = lane & 15, fq = lane >> 4;
    int RA[2], CA[2]; unsigned voffB[2];
#pragma unroll
    for (int i = 0; i < 2; ++i) { int R, C; stage_rc(tid * 16 + i * 8192, R, C); const int Rb = Epi::PERM ? ((R & ~31) + perm32(R & 31)) : R;
        RA[i] = R; CA[i] = C; voffB[i] = (unsigned)(Rb * pitchB + C * 2); }
    const size_t kstep = (size_t)(BK * 2);
    const size_t hstepB = (size_t)HALF * pitchB;
    const unsigned ldsw = (unsigned)wid * 1024u;
    const int aoff = lds_byte(wr * 64 + fr, fq * 8), boff = lds_byte(wc * 32 + fr, fq * 8);
#define PG8_SA(b, h) (((b) * 2 + (h)) * HTB)
#define PG8_SB(b, h) ((4 + (b) * 2 + (h)) * HTB)
#define PG8_STAGE(bufoff, gbase, v0, v1) do { \
        __builtin_amdgcn_global_load_lds((const unsigned*)((const char*)(gbase) + (v0)), (LAS unsigned*)(lds + (bufoff) + ldsw), 16, 0, 0); \
        __builtin_amdgcn_global_load_lds((const unsigned*)((const char*)(gbase) + (v1)), (LAS unsigned*)(lds + (bufoff) + ldsw + 8192), 16, 0, 0); } while (0)
#define PG8_LD8(off) __builtin_bit_cast(i32x8, __builtin_shufflevector(*(const LAS u32x4*)(lds + (off)), *(const LAS u32x4*)(lds + (off) + 1024), 0, 1, 2, 3, 4, 5, 6, 7))
#define PG8_LDA(dst, b, h) do { _Pragma("unroll") for (int m = 0; m < 4; ++m) { if (F8) dst##8[m] = PG8_LD8(PG8_SA(b, h) + aoff + m * 2048); else { _Pragma("unroll") for (int k = 0; k < 2; ++k) dst[m][k] = *(const LAS bf16x8*)(lds + PG8_SA(b, h) + aoff + m * 2048 + k * 1024); } } } while (0)
#define PG8_LDB(dst, b, h) do { _Pragma("unroll") for (int n = 0; n < 2; ++n) { if (F8) dst##8[n] = PG8_LD8(PG8_SB(b, h) + boff + n * 2048); else { _Pragma("unroll") for (int k = 0; k < 2; ++k) dst[n][k] = *(const LAS bf16x8*)(lds + PG8_SB(b, h) + boff + n * 2048 + k * 1024); } } } while (0)
#define PG8_CAT(x) __builtin_shufflevector(__builtin_bit_cast(u32x4, x[0]), __builtin_bit_cast(u32x4, x[1]), 0, 1, 2, 3, 4, 5, 6, 7)
#define PG8_MMA(ai, bj, At, Bt) do { __builtin_amdgcn_s_setprio(1); _Pragma("unroll") for (int m = 0; m < 4; ++m) _Pragma("unroll") for (int n = 0; n < 2; ++n) { \
        if (F8) { asm volatile("v_mfma_scale_f32_16x16x128_f8f6f4 %0, %1, %2, %0, %3, %4 op_sel_hi:[0,0,0]" : "+v"(acc[ai][bj][m][n]) : "v"(Bt##8[n]), "v"(At##8[m]), "v"(wscale), "v"(ascale)); } \
        else { _Pragma("unroll") for (int k = 0; k < 2; ++k) acc[ai][bj][m][n] = __builtin_amdgcn_mfma_f32_16x16x32_bf16(Bt[n][k], At[m][k], acc[ai][bj][m][n], 0, 0, 0); } } __builtin_amdgcn_s_setprio(0); } while (0)
#define PG8_WAIT_V(n) asm volatile("s_waitcnt vmcnt(" #n ")" ::: "memory")
#define PG8_WAIT_L(n) asm volatile("s_waitcnt lgkmcnt(" #n ")" ::: "memory")
#define PG8_BAR __builtin_amdgcn_s_barrier()
#define PG8_SCHED __builtin_amdgcn_sched_barrier(0)
#define PG8_AOFF(u, o00, o01, o10, o11) do { \
        if (Sched::GATHER) { o00 = (unsigned)(S.a_row(u, RA[0]) * pitchA + CA[0] * 2); o01 = (unsigned)(S.a_row(u, RA[1]) * pitchA + CA[1] * 2); \
                             o10 = (unsigned)(S.a_row(u, RA[0] + HALF) * pitchA + CA[0] * 2); o11 = (unsigned)(S.a_row(u, RA[1] + HALF) * pitchA + CA[1] * 2); } \
        else { o00 = (unsigned)(RA[0] * pitchA + CA[0] * 2); o01 = (unsigned)(RA[1] * pitchA + CA[1] * 2); o10 = (unsigned)((RA[0] + HALF) * pitchA + CA[0] * 2); o11 = (unsigned)((RA[1] + HALF) * pitchA + CA[1] * 2); } } while (0)
    Unit cur, nxt; int ui = 0;
    if (!S.next(0, cur)) return;
    f32x4 acc[2][2][4][2];
#pragma unroll
    for (int a = 0; a < 2; ++a)
#pragma unroll
        for (int b = 0; b < 2; ++b)
#pragma unroll
            for (int m = 0; m < 4; ++m)
#pragma unroll
                for (int n = 0; n < 2; ++n) acc[a][b][m][n] = (f32x4){0.f, 0.f, 0.f, 0.f};
    bf16x8 At[4][2], B0[2][2], B1[2][2]; i32x8 At8[4], B08[2], B18[2];
    const char* cA = S.a_base(cur); const char* cB = S.b_base(cur);
    unsigned c00, c01, c10, c11; PG8_AOFF(cur, c00, c01, c10, c11);
    const unsigned vb0 = voffB[0], vb1 = voffB[1];
    PG8_STAGE(PG8_SB(0, 0), cB, vb0, vb1); PG8_STAGE(PG8_SA(0, 0), cA, c00, c01); PG8_STAGE(PG8_SB(0, 1), cB + hstepB, vb0, vb1); PG8_STAGE(PG8_SA(0, 1), cA, c10, c11);
    if (wr == 1) PG8_BAR;
    PG8_WAIT_V(4); PG8_BAR;
    PG8_STAGE(PG8_SB(1, 0), cB + kstep, vb0, vb1); PG8_STAGE(PG8_SA(1, 0), cA + kstep, c00, c01); PG8_STAGE(PG8_SB(1, 1), cB + hstepB + kstep, vb0, vb1);
    PG8_WAIT_V(6); PG8_BAR;
    for (;;) {
        const bool has_next = S.next(ui + 1, nxt);
        const char* nA = has_next ? S.a_base(nxt) : cA; const char* nB = has_next ? S.b_base(nxt) : cB;
        unsigned n00 = c00, n01 = c01, n10 = c10, n11 = c11;
        if (has_next) PG8_AOFF(nxt, n00, n01, n10, n11);
        for (int t = 0; t < nt; t += 2) {
            const bool last = (t == nt - 2);
            const char* a1 = cA + (size_t)(t + 1) * kstep;
            const char* a2 = last ? nA : cA + (size_t)(t + 2) * kstep; const char* b2 = last ? nB : cB + (size_t)(t + 2) * kstep;
            const char* a3 = a2 + kstep; const char* b3 = b2 + kstep;
            const unsigned x00 = last ? n00 : c00, x01 = last ? n01 : c01, x10 = last ? n10 : c10, x11 = last ? n11 : c11;
            PG8_LDB(B0, 0, 0); PG8_SCHED; PG8_LDA(At, 0, 0); PG8_STAGE(PG8_SA(1, 1), a1, c10, c11);
            PG8_WAIT_L(8); PG8_BAR; PG8_WAIT_L(0); PG8_MMA(0, 0, At, B0); PG8_BAR; PG8_SCHED;
            PG8_LDB(B1, 0, 1); PG8_STAGE(PG8_SB(0, 0), b2, vb0, vb1);
            PG8_BAR; PG8_WAIT_L(0); PG8_MMA(0, 1, At, B1); PG8_BAR;
            PG8_LDA(At, 0, 1); PG8_STAGE(PG8_SA(0, 0), a2, x00, x01);
            PG8_BAR; PG8_WAIT_L(0); PG8_MMA(1, 0, At, B0); PG8_BAR; PG8_SCHED;
            PG8_STAGE(PG8_SB(0, 1), b2 + hstepB, vb0, vb1);
            PG8_WAIT_V(6); PG8_BAR; PG8_MMA(1, 1, At, B1); PG8_BAR;
            PG8_LDB(B0, 1, 0); PG8_SCHED; PG8_LDA(At, 1, 0); PG8_STAGE(PG8_SA(0, 1), a2, x10, x11);
            PG8_WAIT_L(8); PG8_BAR; PG8_WAIT_L(0); PG8_MMA(0, 0, At, B0); PG8_BAR; PG8_SCHED;
            PG8_LDB(B1, 1, 1); PG8_STAGE(PG8_SB(1, 0), b3, vb0, vb1);
            PG8_BAR; PG8_WAIT_L(0); PG8_MMA(0, 1, At, B1); PG8_BAR;
            PG8_LDA(At, 1, 1); PG8_STAGE(PG8_SA(1, 0), a3, x00, x01);
            PG8_BAR; PG8_WAIT_L(0); PG8_MMA(1, 0, At, B0); PG8_BAR; PG8_SCHED;
            PG8_STAGE(PG8_SB(1, 1), b3 + hstepB, vb0, vb1);
            PG8_WAIT_V(6); PG8_BAR; PG8_MMA(1, 1, At, B1); PG8_BAR;
        }
        if (F8) asm volatile("s_nop 15\n\ts_nop 15" ::: "memory");
        E(acc, cur, wr, wc, fr, fq);
        if (!has_next) break;
#pragma unroll
        for (int a = 0; a < 2; ++a)
#pragma unroll
            for (int b = 0; b < 2; ++b)
#pragma unroll
                for (int m = 0; m < 4; ++m)
#pragma unroll
                    for (int n = 0; n < 2; ++n) acc[a][b][m][n] = (f32x4){0.f, 0.f, 0.f, 0.f};
        cur = nxt; cA = nA; cB = nB; c00 = n00; c01 = n01; c10 = n10; c11 = n11; ++ui;
    }
    PG8_WAIT_V(0);
    if (wr == 0) PG8_BAR;
    PG8_BAR;
#undef PG8_SA
#undef PG8_SB
#undef PG8_STAGE
#undef PG8_LDA
#undef PG8_LDB
#undef PG8_MMA
#undef PG8_WAIT_V
#undef PG8_WAIT_L
#undef PG8_BAR
#undef PG8_SCHED
#undef PG8_AOFF
#undef PG8_CAT
#undef PG8_LD8
}
}
using pg8::Unit;

typedef const float* cfp_t;
typedef __attribute__((address_space(4))) const cfp_t* KargP;
__device__ __forceinline__ KargP karg_opaque(KargP p) { asm volatile("" : "+s"(p)); return p; }
struct Frame {
    LAS unsigned char* lds;
    volatile LAS unsigned* MISC;
    unsigned* ctl;
    int tid, lane, wave, wave0, G, bid;
    KargP in;
    float* out; unsigned char* ws;
};
#define WSP(T, off) ((T*)(F.ws + (off)))

__device__ __forceinline__ void transpose_item(const float* src, size_t ld, int nvalid, float scale, bf16_t* dst, int K, LAS float* scr, int lane) {
    { float tv[32]; const int j = lane & 31;
#pragma unroll
      for (int i = 0; i < 32; ++i) tv[i] = (j < nvalid) ? src[(size_t)(2 * i + (lane >> 5)) * ld + j] : 0.f;
#pragma unroll
      for (int i = 0; i < 32; ++i) scr[(2 * i + (lane >> 5)) * 33 + j] = tv[i] * scale; }
    LDS_WAIT(); asm volatile("" ::: "memory");
    const int c = lane & 7;
#pragma unroll
    for (int j = 0; j < 4; ++j) { const int n = (lane >> 3) + 8 * j; const LAS float* s = scr + (8 * c) * 33 + n;
        u32x4 o; o.x = pk2(s[0 * 33], s[1 * 33]); o.y = pk2(s[2 * 33], s[3 * 33]); o.z = pk2(s[4 * 33], s[5 * 33]); o.w = pk2(s[6 * 33], s[7 * 33]);
        *(u32x4*)(dst + (size_t)n * K + 8 * c) = o; }
    LDS_WAIT(); asm volatile("" ::: "memory");
}
struct CvItem { const float* src; unsigned char* dst; float scale; int rstep; };
__device__ __forceinline__ CvItem cv_decode(KargP in, unsigned char* ws, int it) {
    CvItem c;
    if (it < NEXP * 256) { const int e = it >> 8, q = it & 255, up = q & 1, g = (q >> 1) & 7, kb = q >> 4;
        c.src = (up ? in[I_WU] : in[I_WG]) + (size_t)e * DM * DM + (size_t)(128 * kb) * DM + 256 * g;
        c.dst = ws + WS_WGU + ((size_t)e * 4096 + 512 * g + up * 128) * DM + 128 * kb; c.scale = 32.f; c.rstep = 256; }
    else { const int r2 = it - NEXP * 256; const int e = r2 >> 7, q = r2 & 127, g = q & 7, kb = q >> 3;
        c.src = in[I_WDN] + (size_t)e * DM * DM + (size_t)(128 * kb) * DM + 256 * g;
        c.dst = ws + WS_WD + ((size_t)e * 2048 + 256 * g) * DM + 128 * kb; c.scale = 64.f; c.rstep = 128; }
    return c;
}
constexpr int CV_E8X = 8, CV_P0N = 3;
__device__ __forceinline__ int cv_map(int i) { constexpr int n1 = CV_P0N * 256; return i < n1 ? CV_E8X * 256 + i : NEXP * 256 + CV_E8X * 128 + (i - n1); }
#define CV_LOAD(v, c) do { _Pragma("unroll") for (int i_ = 0; i_ < 16; ++i_) v[i_] = __builtin_nontemporal_load((const f32x4*)((c).src + (size_t)(16 * w + i_) * DM + 4 * lane)); } while (0)
#define CV_PROC(v, c) do { \
        _Pragma("unroll") for (int j_ = 0; j_ < 4; ++j_) { u32x4 o_; const float s_ = (c).scale; \
            o_.x = pk4_fp8(v[0][j_] * s_, v[1][j_] * s_, v[2][j_] * s_, v[3][j_] * s_);     o_.y = pk4_fp8(v[4][j_] * s_, v[5][j_] * s_, v[6][j_] * s_, v[7][j_] * s_); \
            o_.z = pk4_fp8(v[8][j_] * s_, v[9][j_] * s_, v[10][j_] * s_, v[11][j_] * s_);   o_.w = pk4_fp8(v[12][j_] * s_, v[13][j_] * s_, v[14][j_] * s_, v[15][j_] * s_); \
            *(LAS u32x4*)(tile + (4 * lane + j_) * 144 + 16 * w) = o_; } \
        __syncthreads(); \
        _Pragma("unroll") for (int q_ = 0; q_ < 4; ++q_) { const int idx_ = tid + 512 * q_, row_ = idx_ >> 3, piece_ = idx_ & 7; \
            *(u32x4*)((c).dst + (size_t)((row_ >> 7) * (c).rstep + (row_ & 127)) * DM + 16 * piece_) = *(const LAS u32x4*)(tile + row_ * 144 + 16 * piece_); } \
        __syncthreads(); } while (0)
__device__ __forceinline__ void convert_moe_weights(KargP in, unsigned char* ws, LAS unsigned char* tile, int tid, int bid, int G) {
    const int w = tid >> 6, lane = tid & 63;
    constexpr int NIT = CV_P0N * (256 + 128);
    f32x4 va[16], vb[16];
    int it = bid;
    if (it >= NIT) return;
    CvItem ca = cv_decode(in, ws, cv_map(it)), cb = ca;
    CV_LOAD(va, ca);
    for (;;) {
        const bool hb = it + G < NIT;
        if (hb) { cb = cv_decode(in, ws, cv_map(it + G)); CV_LOAD(vb, cb); }
        CV_PROC(va, ca);
        if (!hb) break;
        it += G;
        const bool ha = it + G < NIT;
        if (ha) { ca = cv_decode(in, ws, cv_map(it + G)); CV_LOAD(va, ca); }
        CV_PROC(vb, cb);
        if (!ha) break;
        it += G;
    }
}
#undef CV_LOAD
#undef CV_PROC
__device__ __forceinline__ void transpose_item_f8(const float* src, size_t ld, float scale, unsigned char* dst, int K, LAS float* scr, int lane) {
    { float tv[32]; const int j = lane & 31;
#pragma unroll
      for (int i = 0; i < 32; ++i) tv[i] = src[(size_t)(2 * i + (lane >> 5)) * ld + j];
#pragma unroll
      for (int i = 0; i < 32; ++i) scr[(2 * i + (lane >> 5)) * 33 + j] = tv[i] * scale; }
    LDS_WAIT(); asm volatile("" ::: "memory");
    const int c = lane & 3;
#pragma unroll
    for (int j = 0; j < 2; ++j) { const int n = (lane >> 2) + 16 * j; const LAS float* s = scr + (16 * c) * 33 + n;
        u32x4 o; o.x = pk4_fp8(s[0 * 33], s[1 * 33], s[2 * 33], s[3 * 33]); o.y = pk4_fp8(s[4 * 33], s[5 * 33], s[6 * 33], s[7 * 33]);
        o.z = pk4_fp8(s[8 * 33], s[9 * 33], s[10 * 33], s[11 * 33]); o.w = pk4_fp8(s[12 * 33], s[13 * 33], s[14 * 33], s[15 * 33]);
        *(u32x4*)(dst + (size_t)n * K + 16 * c) = o; }
    LDS_WAIT(); asm volatile("" ::: "memory");
}
__device__ __forceinline__ void p0_phase(Frame& F) {
    const KargP in = karg_opaque(F.in);
    LAS float* scr = (LAS float*)(F.lds + F.wave * 16384);
    const int gw = F.bid * NWAVES + F.wave, NGW = F.G * NWAVES;
    constexpr int IT_WIN = 32 * (WIN_ROWS / 32);
    constexpr int IT_WQK = 4 * 64;
    constexpr int IT_WPA2 = 32 * 64;
    constexpr int IT_WPH = 16 * 64;
    constexpr int IT_WOUT = 32 * 64;
    constexpr int NITEMS = IT_WIN + IT_WQK + IT_WPA2 + IT_WPH + IT_WOUT;
    for (int it = gw; it < NITEMS; it += NGW) {
        int r = it;
        if (r < IT_WIN) { const int g = r % (WIN_ROWS / 32), kb = r / (WIN_ROWS / 32); const int n0 = 32 * g; int sc, nv = 32;
            if (n0 < 2048) sc = n0; else if (n0 < 3072) sc = 2064 + (n0 - 2048); else if (n0 < 7168) sc = 6160 + (n0 - 3072); else if (n0 < 7200) { sc = 2048; nv = 16; } else if (n0 < WIN_HY0) { sc = 0; nv = 0; } else sc = 3088 + (n0 - WIN_HY0);
            if (n0 < 2048 || (n0 >= 7168 && n0 < WIN_HY0)) transpose_item(in[I_WIN] + (size_t)(64 * kb) * N_IN + sc, N_IN, nv, 1.f, WSP(bf16_t, WS_WIN) + (size_t)n0 * DM + 64 * kb, DM, scr, F.lane);
            if (n0 >= 1024 && !(n0 >= 7168 && n0 < WIN_HY0)) transpose_item_f8(in[I_WIN] + (size_t)(64 * kb) * N_IN + sc, N_IN, 32.f, WSP(unsigned char, WS_WIN8) + (size_t)n0 * DM + 64 * kb, DM, scr, F.lane);
            continue; } r -= IT_WIN;
        if (r < IT_WQK) { const int g = r % 64, kb = r / 64; const int n0 = 32 * g, h = n0 / 512, j = (n0 % 512) / 256, e0 = n0 % 256;
            const float* src = (j ? in[I_WKH] : in[I_WQH]) + (size_t)h * 65536 + (size_t)(64 * kb) * 256 + e0;
            transpose_item(src, 256, 32, j ? 0.0625f : 1.f, WSP(bf16_t, WS_WQK) + (size_t)n0 * 256 + 64 * kb, 256, scr, F.lane); continue; } r -= IT_WQK;
        if (r < IT_WPA2) { const int g = r % 64, kb = r / 64; const int n0 = 32 * g, k0 = 64 * kb;
            transpose_item_f8(in[I_WPA] + (size_t)(k0 % 1024) * DM + n0, DM, 32.f, WSP(unsigned char, WS_WPA2) + (size_t)n0 * 2048 + k0, 2048, scr, F.lane); continue; } r -= IT_WPA2;
        if (r < IT_WPH) { const int g = r % 64, kb = r / 64; const int n0 = 32 * g, k0 = 64 * kb;
            transpose_item_f8(in[I_WPH] + (size_t)k0 * DM + n0, DM, 32.f, WSP(unsigned char, WS_WPH) + (size_t)n0 * 1024 + k0, 1024, scr, F.lane); continue; } r -= IT_WPH;
        if (r < IT_WOUT) { const int g = r % 64, kb = r / 64; const int n0 = 32 * g, k0 = 64 * kb;
            transpose_item_f8(in[I_WOUT] + (size_t)k0 * DM + n0, DM, 64.f, WSP(unsigned char, WS_WOUT) + (size_t)n0 * 2048 + k0, 2048, scr, F.lane); continue; } r -= IT_WOUT;
        (void)r;
    }
    __syncthreads();
    convert_moe_weights(in, F.ws, (LAS unsigned char*)F.lds, F.tid, F.bid, F.G);
    for (int i = F.bid * NTHR + F.tid; i < WIN_ROWS; i += F.G * NTHR) { int sc = -1;
        if (i < 2048) sc = i; else if (i < 3072) sc = 2064 + (i - 2048); else if (i < 7168) sc = 6160 + (i - 3072); else if (i < 7184) sc = 2048 + (i - 7168); else if (i < WIN_HY0) sc = -1; else sc = 3088 + (i - WIN_HY0);
        WSP(float, WS_BINP)[i] = sc >= 0 ? in[I_BIN][sc] : 0.f; }
    for (int it = F.bid + F.G * F.wave; it < 32 * 48; it += F.G * NWAVES) {
        const int ks = it / 48, cg = it % 48; const int col = cg * 256 + F.lane * 4, k0 = ks * 64;
#pragma unroll
        for (int v = 0; v < 9; ++v) { const float cv = (v < 8) ? in[I_C][v * DM + k0 + F.lane] : in[I_CCTX][k0 + F.lane]; scr[v * 64 + F.lane] = cv * sigmoidf_(cv); }
        LDS_WAIT(); asm volatile("" ::: "memory");
        f32x4 a[9];
#pragma unroll
        for (int v = 0; v < 9; ++v) a[v] = (f32x4){0.f, 0.f, 0.f, 0.f};
#pragma unroll 1
        for (int kb = 0; kb < 64; kb += 16) {
            f32x4 w[16];
#pragma unroll
            for (int i = 0; i < 16; ++i) w[i] = *(const f32x4*)(in[I_WMOD] + (size_t)(k0 + kb + i) * 12288 + col);
#pragma unroll
            for (int v = 0; v < 9; ++v)
#pragma unroll
                for (int q = 0; q < 4; ++q) { const f32x4 s4 = *(const LAS f32x4*)(scr + v * 64 + kb + 4 * q);
                    a[v] += w[4 * q] * s4.x; a[v] += w[4 * q + 1] * s4.y; a[v] += w[4 * q + 2] * s4.z; a[v] += w[4 * q + 3] * s4.w; }
        }
#pragma unroll
        for (int v = 0; v < 9; ++v) *(f32x4*)(WSP(float, WS_MODP) + ((size_t)ks * 9 + v) * 12288 + col) = a[v];
        LDS_WAIT(); asm volatile("" ::: "memory");
    }
    for (int j = gw; j < SEQ; j += NGW) {
        const int l = F.lane;
        float zv = 0.f;
        if (l == 0) zv = (float)j / (float)(SEQ - 1);
        else if (l < 33) { const int bi = (l - 1) & 15; const float f = 1e-4f + (float)bi * ((15.0f - 1e-4f) / 15.0f); const float ang = 6.283185307179586f * (float)j * f / (float)SEQ; zv = (l < 17) ? cosf(ang) : -sinf(ang); }
        float pre = in[I_FB1][l];
        for (int i = 0; i < 33; ++i) pre += __shfl(zv, i) * in[I_FW1][i * 64 + l];
        float a = sinf(in[I_FFREQ][l] * pre);
        pre = in[I_FBH][l];
        for (int i = 0; i < 64; ++i) pre += __shfl(a, i) * in[I_FWH][i * 64 + l];
        float a2 = sinf(in[I_FFREQ][64 + l] * pre);
        pre = in[I_FBH][64 + l];
        for (int i = 0; i < 64; ++i) pre += __shfl(a2, i) * in[I_FWH][4096 + i * 64 + l];
        WSP(float, WS_A3)[j * 64 + l] = sinf(in[I_FFREQ][128 + l] * pre);
    }
}

__device__ __forceinline__ void p0b_phase(Frame& F) {
    const KargP in = karg_opaque(F.in);
    for (int i = F.bid * NTHR + F.tid; i < 9 * 12288; i += F.G * NTHR) { const int col = i % 12288; float s = in[I_BMOD][col];
        for (int ks = 0; ks < 32; ++ks) s += WSP(float, WS_MODP)[(size_t)ks * 9 * 12288 + i];
        WSP(float, WS_MOD)[i] = s; }
    LAS float* wl = (LAS float*)F.lds;
    for (int un = F.bid; un < 256; un += F.G) {
        const int ct = un >> 2, pg = un & 3;
        __syncthreads();
        for (int q = 0; q < 8; ++q) { const int idx = F.tid + 512 * q, i = idx >> 6, cc = idx & 63; wl[cc * 68 + i] = in[I_FWOUT][(size_t)i * 4096 + ct * 64 + cc]; }
        __syncthreads();
        const int l15 = F.lane & 15, g4 = F.lane >> 4, j0 = pg * 512 + F.wave * 64;
#define HT_SPLIT(x0, x1, hi, lo) do { u32x4 h_, l_; \
            h_.x = pk2((x0).x, (x0).y); h_.y = pk2((x0).z, (x0).w); h_.z = pk2((x1).x, (x1).y); h_.w = pk2((x1).z, (x1).w); \
            l_.x = pk2((x0).x - bflo(h_.x), (x0).y - bfhi(h_.x)); l_.y = pk2((x0).z - bflo(h_.y), (x0).w - bfhi(h_.y)); \
            l_.z = pk2((x1).x - bflo(h_.z), (x1).y - bfhi(h_.z)); l_.w = pk2((x1).z - bflo(h_.w), (x1).w - bfhi(h_.w)); \
            hi = __builtin_bit_cast(bf16x8, h_); lo = __builtin_bit_cast(bf16x8, l_); } while (0)
        bf16x8 ah[4][2], al[4][2], bh[4][2], bl[4][2];
#pragma unroll
        for (int mt = 0; mt < 4; ++mt)
#pragma unroll
            for (int ks = 0; ks < 2; ++ks) { const float* p = WSP(float, WS_A3) + (size_t)(j0 + 16 * mt + l15) * 64 + 32 * ks + 8 * g4;
                const f32x4 x0 = *(const f32x4*)p, x1 = *(const f32x4*)(p + 4); HT_SPLIT(x0, x1, ah[mt][ks], al[mt][ks]); }
#pragma unroll
        for (int nt = 0; nt < 4; ++nt)
#pragma unroll
            for (int ks = 0; ks < 2; ++ks) { const LAS float* p = wl + (16 * nt + l15) * 68 + 32 * ks + 8 * g4;
                const f32x4 x0 = *(const LAS f32x4*)p, x1 = *(const LAS f32x4*)(p + 4); HT_SPLIT(x0, x1, bh[nt][ks], bl[nt][ks]); }
#undef HT_SPLIT
        const float mind = -3.0701134573253944f, maxd = -15.350567286626972f;
        const int cbase = (ct * 64) & 1023;
#pragma unroll
        for (int nt = 0; nt < 4; ++nt) {
            const int cc = 16 * nt + l15;
            const float delta = fabsf(mind + (float)(cbase + cc) * ((maxd - mind) / 1023.0f));
            float* colp = WSP(float, WS_HTAPS) + (size_t)(ct * 64 + cc) * SEQ;
#pragma unroll
            for (int mt = 0; mt < 4; ++mt) {
                f32x4 acc = (f32x4){0.f, 0.f, 0.f, 0.f};
#pragma unroll
                for (int ks = 0; ks < 2; ++ks) {
                    acc = __builtin_amdgcn_mfma_f32_16x16x32_bf16(ah[mt][ks], bh[nt][ks], acc, 0, 0, 0);
                    acc = __builtin_amdgcn_mfma_f32_16x16x32_bf16(ah[mt][ks], bl[nt][ks], acc, 0, 0, 0);
                    acc = __builtin_amdgcn_mfma_f32_16x16x32_bf16(al[mt][ks], bh[nt][ks], acc, 0, 0, 0); }
                const int j = j0 + 16 * mt + 4 * g4;
                f32x4 o;
#pragma unroll
                for (int r = 0; r < 4; ++r) o[r] = acc[r] * __expf(-((float)(j + r) / (float)(SEQ - 1)) * delta);
                *(f32x4*)(colp + j) = o;
            }
        }
    }
}

__device__ __forceinline__ f32x2 cmul(f32x2 a, f32x2 b) { return (f32x2){a.x * b.x - a.y * b.y, a.x * b.y + a.y * b.x}; }
__device__ __forceinline__ f32x2 cmulc(f32x2 a, f32x2 b) { return (f32x2){a.x * b.x + a.y * b.y, a.y * b.x - a.x * b.y}; }
__device__ __forceinline__ f32x2 cmulp(f32x2 a, f32x2 w, f32x2 iw) { return __builtin_elementwise_fma(a.yy, iw, a.xx * w); }
__device__ __forceinline__ f32x2 rot_i(f32x2 w) { return w.yx * (f32x2){-1.f, 1.f}; }
__device__ __forceinline__ f32x2 cmulq(f32x2 a, f32x2 b) { return cmulp(a, b, rot_i(b)); }
template <bool INV> __device__ __forceinline__ void dft4(f32x2& a, f32x2& b, f32x2& c, f32x2& d) {
    const f32x2 s0 = a + c, s1 = a - c, s2 = b + d, s3 = b - d;
    const f32x2 pm = (f32x2){1.f, -1.f}, mp = (f32x2){-1.f, 1.f};
    a = s0 + s2; c = s0 - s2;
    if (!INV) { b = __builtin_elementwise_fma(s3.yx, pm, s1); d = __builtin_elementwise_fma(s3.yx, mp, s1); }
    else      { b = __builtin_elementwise_fma(s3.yx, mp, s1); d = __builtin_elementwise_fma(s3.yx, pm, s1); }
}
template <bool INV> __device__ __forceinline__ void dft16(f32x2 (&v)[16]) {
#pragma unroll
    for (int n0 = 0; n0 < 4; ++n0) dft4<INV>(v[n0], v[4 + n0], v[8 + n0], v[12 + n0]);
    const float c1 = 0.9238795325112867f, s1 = 0.3826834323650898f, r2 = 0.7071067811865476f;
    const float cs[10] = {1.f, c1, r2, s1, 0.f, -s1, -r2, -c1, -1.f, -c1};
    const float sn[10] = {0.f, s1, r2, c1, 1.f, c1, r2, s1, 0.f, -s1};
#pragma unroll
    for (int k0 = 1; k0 < 4; ++k0)
#pragma unroll
        for (int n0 = 1; n0 < 4; ++n0) { const int m = n0 * k0; const f32x2 w = (f32x2){cs[m], INV ? sn[m] : -sn[m]}; v[4 * k0 + n0] = cmulp(v[4 * k0 + n0], w, (f32x2){-w.y, w.x}); }
#pragma unroll
    for (int k0 = 0; k0 < 4; ++k0) dft4<INV>(v[4 * k0], v[4 * k0 + 1], v[4 * k0 + 2], v[4 * k0 + 3]);
#pragma unroll
    for (int a = 0; a < 4; ++a)
#pragma unroll
        for (int b = a + 1; b < 4; ++b) { const f32x2 t = v[4 * a + b]; v[4 * a + b] = v[4 * b + a]; v[4 * b + a] = t; }
}
__device__ __forceinline__ int fphys(int i) { return i + (i >> 4); }
constexpr int FFT_BUF_BYTES = (4096 + 256) * 8;
struct FftTw { f32x2 wA, wB; };
__device__ __forceinline__ FftTw fft_tw(int ht) { FftTw t; float s, c; sincospif(-(float)ht / 2048.0f, &s, &c); t.wA = (f32x2){c, s}; sincospif(-(float)(ht & 15) / 128.0f, &s, &c); t.wB = (f32x2){c, s}; return t; }
template <bool CONJ> __device__ __forceinline__ void tw_apply(f32x2 (&v)[16], f32x2 w1) {
    if (CONJ) w1 = rot_i(w1).yx;
    const f32x2 w2 = cmulq(w1, w1), w3 = cmulq(w2, w1), w4 = cmulq(w2, w2), w5 = cmulq(w4, w1), w6 = cmulq(w4, w2), w7 = cmulq(w4, w3), w8 = cmulq(w4, w4);
    v[1] = cmulq(v[1], w1); v[2] = cmulq(v[2], w2); v[3] = cmulq(v[3], w3); v[4] = cmulq(v[4], w4); v[5] = cmulq(v[5], w5); v[6] = cmulq(v[6], w6); v[7] = cmulq(v[7], w7); v[8] = cmulq(v[8], w8);
    const f32x2 i8 = rot_i(w8);
    v[9] = cmulq(v[9], cmulp(w1, w8, i8)); v[10] = cmulq(v[10], cmulp(w2, w8, i8)); v[11] = cmulq(v[11], cmulp(w3, w8, i8)); v[12] = cmulq(v[12], cmulp(w4, w8, i8));
    v[13] = cmulq(v[13], cmulp(w5, w8, i8)); v[14] = cmulq(v[14], cmulp(w6, w8, i8)); v[15] = cmulq(v[15], cmulp(w7, w8, i8));
}
struct NoHook { template <int SET> __device__ __forceinline__ void act() {} };
struct NoPf { __device__ __forceinline__ void operator()() const {} };
template <int A0, int A1, class HK, class PF> __device__ __forceinline__ void fft_fwd(f32x2 (&v)[16], LAS f32x2* buf, int ht, const FftTw& tw_, HK& hk, const PF& pf) {
    FftTw tw = tw_; asm volatile("" : "+v"(ht), "+v"(tw.wA.x), "+v"(tw.wA.y), "+v"(tw.wB.x), "+v"(tw.wB.y));
    dft16<false>(v);
    tw_apply<false>(v, tw.wA);
#pragma unroll
    for (int k = 0; k < 16; ++k) buf[fphys(256 * k + ht)] = v[k];
    __syncthreads(); if (A0 >= 0) hk.template act<(A0 > 0)>();
    const int ka = ht >> 4, s = ht & 15;
#pragma unroll
    for (int b = 0; b < 16; ++b) v[b] = buf[fphys(256 * ka + 16 * b + s)];
    dft16<false>(v);
    tw_apply<false>(v, tw.wB);
#pragma unroll
    for (int k = 0; k < 16; ++k) buf[fphys(256 * ka + 16 * k + s)] = v[k];
    pf();
    __syncthreads(); if (A1 >= 0) hk.template act<(A1 > 0)>();
#pragma unroll
    for (int q = 0; q < 16; ++q) v[q] = buf[fphys(16 * ht + q)];
    dft16<false>(v);
}
template <int A0, int A1, int A2, class HK> __device__ __forceinline__ void fft_inv(f32x2 (&v)[16], LAS f32x2* buf, int ht, const FftTw& tw_, HK& hk) {
    FftTw tw = tw_; asm volatile("" : "+v"(ht), "+v"(tw.wA.x), "+v"(tw.wA.y), "+v"(tw.wB.x), "+v"(tw.wB.y));
    dft16<true>(v);
#pragma unroll
    for (int q = 0; q < 16; ++q) buf[fphys(16 * ht + q)] = v[q];
    __syncthreads(); if (A0 >= 0) hk.template act<(A0 > 0)>();
    const int ka = ht >> 4, s = ht & 15;
#pragma unroll
    for (int k = 0; k < 16; ++k) v[k] = buf[fphys(256 * ka + 16 * k + s)];
    tw_apply<true>(v, tw.wB);
    dft16<true>(v);
#pragma unroll
    for (int b = 0; b < 16; ++b) buf[fphys(256 * ka + 16 * b + s)] = v[b];
    __syncthreads(); if (A1 >= 0) hk.template act<(A1 > 0)>();
#pragma unroll
    for (int k = 0; k < 16; ++k) v[k] = buf[fphys(256 * k + ht)];
    tw_apply<true>(v, tw.wA);
    dft16<true>(v);
    __syncthreads(); if (A2 >= 0) hk.template act<(A2 > 0)>();
}

__device__ __forceinline__ void p1_phase(Frame& F) {
    const KargP in = karg_opaque(F.in);
    const int gw = F.bid * NWAVES + F.wave, NGW = F.G * NWAVES;
    const float* mod = WSP(float, WS_MOD);
    {
        f32x4 pg[8], pb[8];
#pragma unroll
        for (int j = 0; j < 8; ++j) { pg[j] = *(const f32x4*)(in[I_LNG] + F.lane * 4 + 256 * j); pb[j] = *(const f32x4*)(in[I_LNB] + F.lane * 4 + 256 * j); }
#pragma unroll 1
        for (int grp = gw; grp < MALL / 8; grp += NGW) {
            const int row0 = grp * 8; const bool lat = row0 < MTOK;
            const float* xb = lat ? in[I_X] + (size_t)row0 * DM : in[I_CTX] + (size_t)(row0 - MTOK) * DM;
            const float* mv = mod + (size_t)(lat ? row0 / SEQ : 8) * 12288;
            f32x4 psh[8], psc[8];
#pragma unroll
            for (int j = 0; j < 8; ++j) { psh[j] = *(const f32x4*)(mv + F.lane * 4 + 256 * j); psc[j] = *(const f32x4*)(mv + 2048 + F.lane * 4 + 256 * j) + 1.0f; }
            f32x4 v[8], vn[8];
#pragma unroll
            for (int j = 0; j < 8; ++j) v[j] = *(const f32x4*)(xb + F.lane * 4 + 256 * j);
#pragma unroll 1
            for (int ri = 0; ri < 8; ++ri) {
                const float* xn = xb + (size_t)(ri < 7 ? ri + 1 : ri) * DM;
#pragma unroll
                for (int j = 0; j < 8; ++j) vn[j] = *(const f32x4*)(xn + F.lane * 4 + 256 * j);
                float s = 0.f;
#pragma unroll
                for (int j = 0; j < 8; ++j) s += (v[j].x + v[j].y) + (v[j].z + v[j].w);
                const float mean = wave_sum(s) * (1.f / DM); float s2 = 0.f;
#pragma unroll
                for (int j = 0; j < 8; ++j) { v[j] = v[j] - mean; s2 += (v[j].x * v[j].x + v[j].y * v[j].y) + (v[j].z * v[j].z + v[j].w * v[j].w); }
                const float rstd = 1.f / sqrtf(wave_sum(s2) * (1.f / DM) + LN_EPS);
                const int row = row0 + ri;
                if (lat && F.lane == 0) { WSP(float, WS_STATS)[row * 2] = mean; WSP(float, WS_STATS)[row * 2 + 1] = rstd; }
                bf16_t* orow = WSP(bf16_t, WS_HX) + (size_t)row * DM;
#pragma unroll
                for (int j = 0; j < 8; ++j) { const f32x4 y = (v[j] * rstd * pg[j] + pb[j]) * psc[j] + psh[j];
                    u32x2 o; o.x = pk2(y.x, y.y); o.y = pk2(y.z, y.w); *(u32x2*)(orow + F.lane * 4 + 256 * j) = o;
                    if (lat) *(unsigned*)(WSP(unsigned char, WS_HX8) + (size_t)row * DM + F.lane * 4 + 256 * j) = pk4_fp8(y.x, y.y, y.z, y.w); }
#pragma unroll
                for (int j = 0; j < 8; ++j) v[j] = vn[j];
            }
        }
    }
    const int hb = F.tid >> 8, ht = F.tid & 255;
    LAS f32x2* buf = (LAS f32x2*)(F.lds + hb * FFT_BUF_BYTES);
    const FftTw tw = fft_tw(ht);
    const float* htaps = WSP(float, WS_HTAPS);
    for (int u0 = F.bid * 2; u0 < 2048; u0 += F.G * 2) {
        const int un = u0 + hb, c = un >> 1, n = un & 1;
        const float* hf = htaps + (size_t)((n * 2 + 0) * 1024 + c) * SEQ, * hbk = htaps + (size_t)((n * 2 + 1) * 1024 + c) * SEQ;
        f32x2 v[16];
#pragma unroll
        for (int a = 0; a < 16; ++a) { const int i = 256 * a + ht; float x;
            if (a < 8) x = hf[i]; else if (i == 2048) x = 0.f; else x = hbk[4096 - i];
            v[a] = (f32x2){x * (1.0f / 4096.0f), 0.f}; }
        { NoHook nh; fft_fwd<-1, -1>(v, buf, ht, tw, nh, NoPf{}); }
        unsigned* Hd = WSP(unsigned, WS_H) + (size_t)un * 4096;
#pragma unroll
        for (int ks = 0; ks < 16; ++ks) Hd[ks * 256 + ht] = pk2(v[ks].x, v[ks].y);
        __syncthreads();
    }
}

template <bool F8> struct SchedZ {
    static constexpr bool GATHER = false;
    int G, c; const char* hx; const char* win;
    static constexpr size_t P = F8 ? DM : 2 * DM;
    __device__ __forceinline__ bool next(int i, Unit& u) const {
        int L = i * G + c;
        if (!F8) {
            if (L < 320) { int pn; pg8::decode_tile(L, 64, 5, u.pm, pn); u.pn = pn < 4 ? pn : 28; u.ex = 0; return true; } L -= 320;
            if (L < 72) { int pm, pn; pg8::decode_tile(L, 8, 9, pm, pn); u.pm = 64 + pm; u.pn = pn < 8 ? pn : 28; u.ex = 0; return true; }
            return false;
        } else {
            if (L < 1536) { int pn; pg8::decode_tile(L, 64, 24, u.pm, pn); u.pn = 4 + pn; u.ex = 0; return true; } L -= 1536;
            if (L < 768) { pg8::decode_tile(L, 12, 64, u.pm, u.pn); u.ex = 1; return true; }
            return false;
        }
    }
    __device__ __forceinline__ const char* a_base(const Unit& u) const { return u.ex ? win + (size_t)(WIN_HY0 + 256 * u.pm) * P : hx + (size_t)(256 * u.pm) * P; }
    __device__ __forceinline__ const char* b_base(const Unit& u) const { return u.ex ? hx + (size_t)(256 * u.pn) * P : win + (size_t)(256 * u.pn) * P; }
    __device__ __forceinline__ int a_row(const Unit&, int R) const { return R; }
};
struct EpiZ {
    static constexpr bool PERM = true;
    bf16_t* Z; bf16_t* ZT; const float* bias;
    __device__ __forceinline__ void operator()(const f32x4 (&acc)[2][2][4][2], const Unit& u, int wr, int wc, int fr, int fq) const {
        if (u.ex == 0) {
            const int row0 = u.pm * 256 + wr * 64 + fr, col0 = u.pn * 256 + wc * 32 + 8 * fq;
            f32x4 bv[2][2];
#pragma unroll
            for (int bj = 0; bj < 2; ++bj)
#pragma unroll
                for (int n = 0; n < 2; ++n) bv[bj][n] = *(const f32x4*)(bias + col0 + bj * 128 + 4 * n);
#pragma unroll
            for (int ai = 0; ai < 2; ++ai)
#pragma unroll
                for (int m = 0; m < 4; ++m) { bf16_t* rowp = Z + (size_t)(row0 + ai * 128 + m * 16) * ZN + col0;
#pragma unroll
                    for (int bj = 0; bj < 2; ++bj) { const f32x4 v0 = acc[ai][bj][m][0] + bv[bj][0], v1 = acc[ai][bj][m][1] + bv[bj][1];
                        u32x4 w; w.x = pg8::cvt_pk_bf16(v0[0], v0[1]); w.y = pg8::cvt_pk_bf16(v0[2], v0[3]); w.z = pg8::cvt_pk_bf16(v1[0], v1[1]); w.w = pg8::cvt_pk_bf16(v1[2], v1[3]);
                        *(u32x4*)(rowp + bj * 128) = w; } }
        } else {
            const int ch0 = u.pm * 256 + wr * 64 + fr, b = u.pn >> 3, t0 = (u.pn & 7) * 256 + wc * 32 + 8 * fq;
            float bbv[8];
#pragma unroll
            for (int r = 0; r < 8; ++r) bbv[r] = bias[WIN_HY0 + ch0 + (r >> 2) * 128 + (r & 3) * 16];
#pragma unroll
            for (int ai = 0; ai < 2; ++ai)
#pragma unroll
                for (int m = 0; m < 4; ++m) { const int ch = ch0 + ai * 128 + m * 16; const float bb = bbv[ai * 4 + m];
                    bf16_t* rowp = ZT + ((size_t)b * 3072 + ch) * SEQ + t0;
#pragma unroll
                    for (int bj = 0; bj < 2; ++bj) { const f32x4 v0 = acc[ai][bj][m][0] + bb, v1 = acc[ai][bj][m][1] + bb;
                        u32x4 w; w.x = pg8::cvt_pk_bf16(v0[0], v0[1]); w.y = pg8::cvt_pk_bf16(v0[2], v0[3]); w.z = pg8::cvt_pk_bf16(v1[0], v1[1]); w.w = pg8::cvt_pk_bf16(v1[2], v1[3]);
                        *(u32x4*)(rowp + bj * 128) = w; } }
        }
    }
};

__device__ __forceinline__ void p3_phase(Frame& F) {
    const KargP in = karg_opaque(F.in);
    const bf16_t* Z = WSP(bf16_t, WS_Z); bf16_t* U = WSP(bf16_t, WS_U);
    const float* cw = in[I_MCW]; const float* cb = in[I_MCB];
    const int c0 = (F.tid & 127) * 8;
    f32x4 w0[9], w1[9];
#pragma unroll
    for (int q = 0; q < 9; ++q) { w0[q] = *(const f32x4*)(cw + q * MW + c0); w1[q] = *(const f32x4*)(cw + q * MW + c0 + 4); }
    const f32x4 b0 = *(const f32x4*)(cb + c0), b1 = *(const f32x4*)(cb + c0 + 4);
#pragma unroll 1
    for (int it = F.bid * NTHR + F.tid; it < MALL * 128; it += F.G * NTHR) {
        const int row = it >> 7;
        const bool lat = row < MTOK;
        int base, y, x, H, Wd;
        if (lat) { const int t = row & (SEQ - 1); base = row - t; y = t >> 6; x = t & 63; H = 32; Wd = 64; }
        else { const int t = (row - MTOK) & (CTX - 1); base = row - t; y = 0; x = t; H = 1; Wd = CTX; }
        u32x4 zz[9]; bool ok[9];
#pragma unroll
        for (int q = 0; q < 9; ++q) { const int yy = y + q / 3 - 1, xx = x + q % 3 - 1; ok[q] = yy >= 0 && yy < H && xx >= 0 && xx < Wd;
            const int srow = ok[q] ? base + yy * Wd + xx : row;
            zz[q] = *(const u32x4*)(Z + (size_t)srow * ZN + ZC_QK + c0); }
        f32x4 a0 = b0, a1 = b1;
#pragma unroll
        for (int q = 0; q < 9; ++q) { const float m = ok[q] ? 1.f : 0.f;
            a0 += (f32x4){bflo(zz[q].x), bfhi(zz[q].x), bflo(zz[q].y), bfhi(zz[q].y)} * w0[q] * m;
            a1 += (f32x4){bflo(zz[q].z), bfhi(zz[q].z), bflo(zz[q].w), bfhi(zz[q].w)} * w1[q] * m; }
        float a[8] = {a0.x, a0.y, a0.z, a0.w, a1.x, a1.y, a1.z, a1.w};
#pragma unroll
        for (int j = 0; j < 8; ++j) a[j] = a[j] * sigmoid_fast(a[j]);
        u32x4 o; o.x = pk2(a[0], a[1]); o.y = pk2(a[2], a[3]); o.z = pk2(a[4], a[5]); o.w = pk2(a[6], a[7]);
        *(u32x4*)(U + (size_t)row * MW + c0) = o;
    }
}

struct SchedQK {
    static constexpr bool GATHER = false;
    int G, c; const char* u; const char* w;
    __device__ __forceinline__ bool next(int i, Unit& un) const { const int L = i * G + c; if (L >= 72 * 8) return false; pg8::decode_tile(L, 72, 8, un.pm, un.pn); un.ex = 0; return true; }
    __device__ __forceinline__ const char* a_base(const Unit& un) const { return u + ((size_t)(256 * un.pm) * MW + (un.pn >> 1) * 256) * 2; }
    __device__ __forceinline__ const char* b_base(const Unit& un) const { return w + (size_t)(256 * un.pn) * 256 * 2; }
    __device__ __forceinline__ int a_row(const Unit&, int R) const { return R; }
};
struct EpiQK {
    static constexpr bool PERM = true;
    bf16_t* O;
    __device__ __forceinline__ void operator()(const f32x4 (&acc)[2][2][4][2], const Unit& u, int wr, int wc, int fr, int fq) const {
        const int row0 = u.pm * 256 + wr * 64 + fr, col0 = u.pn * 256 + wc * 32 + 8 * fq;
#pragma unroll
        for (int ai = 0; ai < 2; ++ai)
#pragma unroll
            for (int m = 0; m < 4; ++m) { bf16_t* rowp = O + (size_t)(row0 + ai * 128 + m * 16) * 2048 + col0;
#pragma unroll
                for (int bj = 0; bj < 2; ++bj) { const f32x4 v0 = acc[ai][bj][m][0], v1 = acc[ai][bj][m][1];
                    u32x4 w; w.x = pg8::cvt_pk_bf16(v0[0], v0[1]); w.y = pg8::cvt_pk_bf16(v0[2], v0[3]); w.z = pg8::cvt_pk_bf16(v1[0], v1[1]); w.w = pg8::cvt_pk_bf16(v1[2], v1[3]);
                    *(u32x4*)(rowp + bj * 128) = w; } }
    }
};

constexpr int ML_QS = 264, ML_VS = 72, ML_PS = 72;
constexpr int ML_Q = 0, ML_K = ML_Q + 64 * ML_QS * 2, ML_V = ML_K + 64 * ML_QS * 2, ML_C = ML_V + 64 * ML_VS * 2, ML_P = ML_C + 80 * ML_QS * 2, ML_VT = ML_P + 64 * ML_PS * 2, ML_SC = ML_VT + 80 * ML_VS * 2;
constexpr int ML_SA = ML_SC, ML_SDEN = ML_SC + 4096, ML_END = ML_SC + 4096 + 256;
static_assert(ML_END <= MISC_OFF, "mlstm LDS");
__device__ __forceinline__ bf16x8 lds_frag(const LAS bf16_t* p) { return *(const LAS bf16x8*)p; }
__device__ __forceinline__ void mlstm_unit(Frame& F, int un) {
    const int vs = un & 3, dir = (un >> 2) & 1, h = (un >> 3) & 3, b = un >> 5;
    const bf16_t* Z = WSP(bf16_t, WS_Z); const bf16_t* QK = WSP(bf16_t, WS_QKB); unsigned char* AM = WSP(unsigned char, WS_AM);
    LAS unsigned char* lds = F.lds;
    LAS bf16_t* Qs = (LAS bf16_t*)(lds + ML_Q); LAS bf16_t* Ks = (LAS bf16_t*)(lds + ML_K); LAS bf16_t* Vs = (LAS bf16_t*)(lds + ML_V);
    LAS bf16_t* Cs = (LAS bf16_t*)(lds + ML_C); LAS bf16_t* Ps = (LAS bf16_t*)(lds + ML_P); LAS bf16_t* VT = (LAS bf16_t*)(lds + ML_VT);
    LAS float* sDEN = (LAS float*)(lds + ML_SDEN);
    LAS float* sc0 = (LAS float*)(lds + ML_SA);
    const int tid = F.tid, lane = F.lane, w = F.wave, l15 = lane & 15, g4 = lane >> 4;
    __syncthreads();
    for (int i = tid; i < 80 * ML_QS / 2; i += NTHR) ((LAS unsigned*)Cs)[i] = 0u;
    if (tid < 64) { Vs[tid * ML_VS + 64] = (bf16_t)0x3F80; for (int j = 65; j < ML_VS; ++j) Vs[tid * ML_VS + j] = 0; }
    for (int i = tid; i < 16 * ML_VS; i += NTHR) VT[64 * ML_VS + i] = (i < 64) ? (bf16_t)0x3F80 : (bf16_t)0;
    f32x4 cacc[2][5];
#pragma unroll
    for (int a = 0; a < 2; ++a)
#pragma unroll
        for (int c = 0; c < 5; ++c) cacc[a][c] = (f32x4){0.f, 0.f, 0.f, 0.f};
    float m_run = 0.f;
    u32x4 pq[4], pk[4], pv; unsigned pgate = 0u, pgate2 = 0u;
#define ML_ROW0(st) ((st) < 4 ? (MTOK + b * CTX + 64 * (dir ? 3 - (st) : (st))) : (b * SEQ + 64 * (dir ? 35 - (st) : (st) - 4)))
#define ML_LOAD(st) do { const int r0_ = ML_ROW0(st); \
        _Pragma("unroll") for (int q_ = 0; q_ < 4; ++q_) { const int p_ = tid + 512 * q_, rr_ = p_ >> 5, cc_ = (p_ & 31) * 8; \
            pq[q_] = *(const u32x4*)(QK + (size_t)(r0_ + rr_) * 2048 + h * 512 + cc_); pk[q_] = *(const u32x4*)(QK + (size_t)(r0_ + rr_) * 2048 + h * 512 + 256 + cc_); } \
        { const int rr_ = tid >> 3, cc_ = (tid & 7) * 8; pv = *(const u32x4*)(Z + (size_t)(r0_ + rr_) * ZN + ZC_V + h * 256 + vs * 64 + cc_); } \
        if (tid < 64) { const bf16_t* gp_ = Z + (size_t)(r0_ + tid) * ZN + ZC_GT + dir * 8 + h; pgate = gp_[0]; pgate2 = gp_[4]; } } while (0)
#define ML_STORE() do { \
        _Pragma("unroll") for (int q_ = 0; q_ < 4; ++q_) { const int p_ = tid + 512 * q_, rr_ = p_ >> 5, cc_ = (p_ & 31) * 8; \
            *(LAS u32x4*)(Qs + rr_ * ML_QS + cc_) = pq[q_]; *(LAS u32x4*)(Ks + rr_ * ML_QS + cc_) = pk[q_]; } \
        { const int rr_ = tid >> 3, cc_ = (tid & 7) * 8; *(LAS u32x4*)(Vs + rr_ * ML_VS + cc_) = pv; \
          VT[(cc_ + 0) * ML_VS + rr_] = (bf16_t)(pv.x & 0xffffu); VT[(cc_ + 1) * ML_VS + rr_] = (bf16_t)(pv.x >> 16); VT[(cc_ + 2) * ML_VS + rr_] = (bf16_t)(pv.y & 0xffffu); VT[(cc_ + 3) * ML_VS + rr_] = (bf16_t)(pv.y >> 16); \
          VT[(cc_ + 4) * ML_VS + rr_] = (bf16_t)(pv.z & 0xffffu); VT[(cc_ + 5) * ML_VS + rr_] = (bf16_t)(pv.z >> 16); VT[(cc_ + 6) * ML_VS + rr_] = (bf16_t)(pv.w & 0xffffu); VT[(cc_ + 7) * ML_VS + rr_] = (bf16_t)(pv.w >> 16); } } while (0)
#define ML_SCALARS(stp) do { LAS float* sb_ = sc0 + ((stp) & 1) * 512; \
              \
            float li = bf2f(pgate), zf = bf2f(pgate2); \
            if (dir) { li = __shfl(li, 63 - lane); zf = __shfl(zf, 63 - lane); } \
            const float lf = fminf(zf, 0.f) - log1pf(__expf(-fabsf(zf))); \
            const float bcs = wave_scan_sum(lf); \
            const float a = li - bcs; \
            const float am = wave_scan_max(a); \
            const float inter = bcs + m_run; \
            const float mt = fmaxf(inter, bcs + am); \
            const float b_end = lane_bcast(bcs, 63); \
            const float gg = b_end - bcs + li; \
            const float gm = lane_bcast(wave_scan_max(gg), 63); \
            const float m_new = fmaxf(b_end + m_run, gm); \
            const int pos_ = dir ? 63 - lane : lane; \
            sb_[pos_] = a; sb_[64 + pos_] = bcs - mt; sb_[128 + pos_] = __expf(inter - mt); sb_[192 + pos_] = __expf(gg - m_new); sb_[256 + pos_] = __expf(-mt); \
            if (lane == 0) sb_[320] = __expf(b_end + m_run - m_new); \
            m_run = m_new; } while (0)
    ML_LOAD(0);
    __syncthreads();
    if (w == 0) ML_SCALARS(0);
    const int tt = w & 3; const int nv = (w < 4) ? 3 : 2;
#pragma unroll 1
    for (int st = 0; st < 36; ++st) {
        ML_STORE();
        LAS float* sA = sc0 + (st & 1) * 512; LAS float* sU = sA + 64; LAS float* sSI = sA + 128; LAS float* sWG = sA + 192; LAS float* sEM = sA + 256; LAS float* sMI = sA + 320;
        const int row0 = ML_ROW0(st);
        if (st + 1 < 36) ML_LOAD(st + 1);
        __syncthreads();
        unsigned og[2][4];
        f32x4 nacc[3], iacc[3];
#pragma unroll
        for (int j = 0; j < 3; ++j) { nacc[j] = (f32x4){0.f, 0.f, 0.f, 0.f}; iacc[j] = (f32x4){0.f, 0.f, 0.f, 0.f}; }
        const int t0 = 16 * tt + 4 * g4;
        if (st >= 4) {
        {
            f32x4 sacc[2] = {(f32x4){0.f, 0.f, 0.f, 0.f}, (f32x4){0.f, 0.f, 0.f, 0.f}};
#pragma unroll
            for (int ks = 0; ks < 8; ++ks) {
                const bf16x8 qf = lds_frag(Qs + (16 * tt + l15) * ML_QS + 32 * ks + 8 * g4);
#pragma unroll
                for (int j = 0; j < 2; ++j) { const int stl = 2 * (w >> 2) + j;
                    const bf16x8 kf = lds_frag(Ks + (16 * stl + l15) * ML_QS + 32 * ks + 8 * g4);
                    sacc[j] = __builtin_amdgcn_mfma_f32_16x16x32_bf16(kf, qf, sacc[j], 0, 0, 0); }
            }
            const int t = 16 * tt + l15; const float ut = sU[t];
#pragma unroll
            for (int j = 0; j < 2; ++j) { const int s0 = 16 * (2 * (w >> 2) + j) + 4 * g4;
                const f32x4 av = *(const LAS f32x4*)(sA + s0);
                float pvv[4];
#pragma unroll
                for (int r = 0; r < 4; ++r) { const int s = s0 + r; const bool ok = dir ? (s >= t) : (s <= t); pvv[r] = ok ? sacc[j][r] * __expf(ut + av[r]) : 0.f; }
                u32x2 o; o.x = pk2(pvv[0], pvv[1]); o.y = pk2(pvv[2], pvv[3]);
                *(LAS u32x2*)(Ps + t * ML_PS + s0) = o; }
        }
        __syncthreads();
        {
#pragma unroll
            for (int j = 0; j < 2; ++j) { const int vt_ = (w < 4) ? j : 2 + j;
#pragma unroll
                for (int r = 0; r < 4; ++r) og[j][r] = Z[(size_t)(row0 + 16 * tt + 4 * g4 + r) * ZN + ZC_O + h * 256 + vs * 64 + 16 * vt_ + l15]; } }
#pragma unroll
        for (int ks = 0; ks < 8; ++ks) {
            const bf16x8 qf = lds_frag(Qs + (16 * tt + l15) * ML_QS + 32 * ks + 8 * g4);
#pragma unroll
            for (int j = 0; j < 3; ++j) if (j < nv) { const int vt = (w < 4) ? (j == 2 ? 4 : j) : 2 + j;
                const bf16x8 cf = lds_frag(Cs + (16 * vt + l15) * ML_QS + 32 * ks + 8 * g4);
                iacc[j] = __builtin_amdgcn_mfma_f32_16x16x32_bf16(qf, cf, iacc[j], 0, 0, 0); }
        }
#pragma unroll
        for (int ks = 0; ks < 2; ++ks) {
            const bf16x8 pf = lds_frag(Ps + (16 * tt + l15) * ML_PS + 32 * ks + 8 * g4);
#pragma unroll
            for (int j = 0; j < 3; ++j) if (j < nv) { const int vt = (w < 4) ? (j == 2 ? 4 : j) : 2 + j;
                const bf16x8 vf = lds_frag(VT + (16 * vt + l15) * ML_VS + 32 * ks + 8 * g4);
                nacc[j] = __builtin_amdgcn_mfma_f32_16x16x32_bf16(pf, vf, nacc[j], 0, 0, 0); }
        }
        {
            const f32x4 si = *(const LAS f32x4*)(sSI + t0);
#pragma unroll
            for (int j = 0; j < 3; ++j) if (j < nv) nacc[j] = nacc[j] + iacc[j] * si;
            if (w < 4 && l15 == 0) *(LAS f32x4*)(sDEN + t0) = nacc[2];
        }
        }
        {
            const float decay = sMI[0];
#pragma unroll
            for (int a = 0; a < 2; ++a)
#pragma unroll
                for (int c = 0; c < 5; ++c) cacc[a][c] = cacc[a][c] * decay;
#pragma unroll
            for (int ks = 0; ks < 2; ++ks) {
                float wg[8];
#pragma unroll
                for (int e = 0; e < 8; ++e) wg[e] = sWG[32 * ks + 8 * g4 + e];
                bf16x8 kf[2];
#pragma unroll
                for (int a = 0; a < 2; ++a) { float x[8];
#pragma unroll
                    for (int e = 0; e < 8; ++e) x[e] = bf2f((unsigned)Ks[(32 * ks + 8 * g4 + e) * ML_QS + 16 * (2 * w + a) + l15]) * wg[e];
                    u32x4 o; o.x = pk2(x[0], x[1]); o.y = pk2(x[2], x[3]); o.z = pk2(x[4], x[5]); o.w = pk2(x[6], x[7]);
                    kf[a] = __builtin_bit_cast(bf16x8, o); }
#pragma unroll
                for (int c = 0; c < 5; ++c) {
                    const bf16x8 vf = lds_frag(VT + (16 * c + l15) * ML_VS + 32 * ks + 8 * g4);
#pragma unroll
                    for (int a = 0; a < 2; ++a) cacc[a][c] = __builtin_amdgcn_mfma_f32_16x16x32_bf16(kf[a], vf, cacc[a][c], 0, 0, 0);
                }
            }
        }
        __syncthreads();
        if (w == 0 && st + 1 < 36) ML_SCALARS(st + 1);
        if (st >= 4) {
            const f32x4 dn = *(const LAS f32x4*)(sDEN + t0), em = *(const LAS f32x4*)(sEM + t0);
#pragma unroll
            for (int j = 0; j < 2; ++j) { const int vt = (w < 4) ? j : 2 + j; const int col = h * 256 + vs * 64 + 16 * vt + l15;
#pragma unroll
                for (int r = 0; r < 4; ++r) { const int row = row0 + t0 + r;
                    const float hv = nacc[j][r] * __builtin_amdgcn_rcpf(fmaxf(fabsf(dn[r]), em[r]));
                    const float o = __builtin_amdgcn_rcpf(1.0f + __expf(-bf2f(og[j][r])));
                    AM[(size_t)row * 2048 + dir * 1024 + col] = (unsigned char)(pk4_fp8(fminf(fmaxf(o * hv, -448.f), 448.f), 0.f, 0.f, 0.f) & 0xffu); } }
        }
#pragma unroll
        for (int a = 0; a < 2; ++a)
#pragma unroll
            for (int c = 0; c < 5; ++c) { u32x2 o; o.x = pk2(cacc[a][c][0], cacc[a][c][1]); o.y = pk2(cacc[a][c][2], cacc[a][c][3]);
                *(LAS u32x2*)(Cs + (16 * c + l15) * ML_QS + 16 * (2 * w + a) + 4 * g4) = o; }
    }
    __syncthreads();
#undef ML_LOAD
#undef ML_STORE
#undef ML_ROW0
#undef ML_SCALARS
}

constexpr int CVH_E0 = 11;
constexpr int CVH_NITEMS = (NEXP - CVH_E0) * 768;
constexpr int CVH_KG_BYTES = 1040, CVH_TILE_BYTES = 16 * CVH_KG_BYTES;
struct CvHook {
    KargP in; unsigned char* ws; LAS unsigned char* tiles; int tid, bid, G, kmax; int s;
    f32x4 v[2][8];
    __device__ __forceinline__ void decode(int h, const float*& src, unsigned char*& dst, int& rstep) const {
        const int e = CVH_E0 + h / 768, q = h % 768;
        if (q < 512) { const int up = q & 1, g = (q >> 1) & 7, kb = q >> 4;
            src = (up ? in[I_WU] : in[I_WG]) + (size_t)e * DM * DM + (size_t)(64 * kb) * DM + 256 * g;
            dst = ws + WS_WGU + ((size_t)e * 4096 + 512 * g + up * 128) * DM + 64 * kb; rstep = 256; }
        else { const int q2 = q - 512, g = q2 & 7, kb = q2 >> 3;
            src = in[I_WDN] + (size_t)e * DM * DM + (size_t)(64 * kb) * DM + 256 * g;
            dst = ws + WS_WD + ((size_t)e * 2048 + 256 * g) * DM + 64 * kb; rstep = 128; }
    }
    __device__ __forceinline__ int item(int k) const { return (k < kmax ? k : kmax) * G + bid; }
    template <int SET> __device__ __forceinline__ void request(int k) {
        const float* src; unsigned char* dst; int rs; decode(item(k), src, dst, rs);
        const int w = tid >> 6, lane = tid & 63;
#pragma unroll
        for (int i = 0; i < 8; ++i) v[SET][i] = __builtin_nontemporal_load((const f32x4*)(src + (size_t)(8 * w + i) * DM + 4 * lane));
    }
    template <int SET> __device__ __forceinline__ void act() {
        const int k = s; s = k + 1;
        const int w = tid >> 6, lane = tid & 63;
        {
            const float sc = (item(k - 2) % 768) < 512 ? 32.f : 64.f;
            LAS unsigned char* t = tiles + SET * CVH_TILE_BYTES;
#pragma unroll
            for (int g = 0; g < 2; ++g) { u32x4 o;
                o.x = pk4_fp8(v[SET][4 * g][0] * sc, v[SET][4 * g + 1][0] * sc, v[SET][4 * g + 2][0] * sc, v[SET][4 * g + 3][0] * sc); o.y = pk4_fp8(v[SET][4 * g][1] * sc, v[SET][4 * g + 1][1] * sc, v[SET][4 * g + 2][1] * sc, v[SET][4 * g + 3][1] * sc);
                o.z = pk4_fp8(v[SET][4 * g][2] * sc, v[SET][4 * g + 1][2] * sc, v[SET][4 * g + 2][2] * sc, v[SET][4 * g + 3][2] * sc); o.w = pk4_fp8(v[SET][4 * g][3] * sc, v[SET][4 * g + 1][3] * sc, v[SET][4 * g + 2][3] * sc, v[SET][4 * g + 3][3] * sc);
                *(LAS u32x4*)(t + (2 * w + g) * CVH_KG_BYTES + 16 * lane) = o; }
        }
        request<SET>(k);
        {
            const float* src; unsigned char* dst; int rs; decode(item(k >= 3 ? k - 3 : 0), src, dst, rs);
            if (k < 3) { dst = ws + WS_DUMMY; rs = 128; }
            const LAS unsigned char* t = tiles + (1 - SET) * CVH_TILE_BYTES;
#pragma unroll
            for (int q = 0; q < 2; ++q) { const int idx = tid + 512 * q, row = idx >> 2, piece = idx & 3;
                const LAS unsigned char* tp = t + (4 * piece) * CVH_KG_BYTES + 4 * row;
                u32x4 o; o.x = *(const LAS unsigned*)(tp); o.y = *(const LAS unsigned*)(tp + CVH_KG_BYTES); o.z = *(const LAS unsigned*)(tp + 2 * CVH_KG_BYTES); o.w = *(const LAS unsigned*)(tp + 3 * CVH_KG_BYTES);
                *(u32x4*)(dst + (size_t)((row >> 7) * rs + (row & 127)) * DM + 16 * piece) = o; }
        }
    }
};
struct HPf {
    const unsigned* Hd; int ht; unsigned (&h)[16];
    __device__ __forceinline__ void operator()() const {
#pragma unroll
        for (int ks = 0; ks < 16; ++ks) h[ks] = Hd[ks * 256 + ht];
    }
};

constexpr int HY_RAW = 2 * FFT_BUF_BYTES, HY_OUT = HY_RAW + 16384, HY_CVT = HY_OUT + 32768, HY_COEF = HY_CVT + 2 * CVH_TILE_BYTES, HY_END = HY_COEF + 512;
static_assert(HY_END <= MISC_OFF, "hyena LDS");
__device__ __forceinline__ void hy_conv_to_buf(const LAS bf16_t* raw, LAS f32x2* buf, const LAS float* cf, int kind, int ht) {
    float w9[9]; const float bias = cf[27 + kind];
#pragma unroll
    for (int q = 0; q < 9; ++q) w9[q] = cf[9 * kind + q];
    asm volatile("" : "+v"(ht));
    const int t0 = 8 * ht, y = t0 >> 6, x0 = t0 & 63;
    float acc[2][8];
#pragma unroll
    for (int bb = 0; bb < 2; ++bb)
#pragma unroll
        for (int i = 0; i < 8; ++i) acc[bb][i] = bias;
#pragma unroll
    for (int dy = -1; dy <= 1; ++dy) {
        const int yy = y + dy;
        if (yy >= 0 && yy < 32) {
#pragma unroll
            for (int bb = 0; bb < 2; ++bb) {
                const LAS bf16_t* base = raw + bb * 2048 + t0 + 64 * dy;
                const u32x4 mid = *(const LAS u32x4*)base;
                float vals[10];
                vals[0] = (x0 > 0) ? bf2f((unsigned)base[-1]) : 0.f; vals[9] = (x0 + 8 < 64) ? bf2f((unsigned)base[8]) : 0.f;
                vals[1] = bflo(mid.x); vals[2] = bfhi(mid.x); vals[3] = bflo(mid.y); vals[4] = bfhi(mid.y); vals[5] = bflo(mid.z); vals[6] = bfhi(mid.z); vals[7] = bflo(mid.w); vals[8] = bfhi(mid.w);
                const float wl = w9[(dy + 1) * 3], wm = w9[(dy + 1) * 3 + 1], wr_ = w9[(dy + 1) * 3 + 2];
#pragma unroll
                for (int i = 0; i < 8; ++i) acc[bb][i] += wl * vals[i] + wm * vals[i + 1] + wr_ * vals[i + 2];
            }
        }
    }
#pragma unroll
    for (int i = 0; i < 8; ++i) buf[fphys(t0 + i)] = (f32x2){acc[0][i], acc[1][i]};
}
__device__ __forceinline__ float hy_coef_load(KargP in, int c, int ht) {
    const int i = ht & 31;
    if (i < 27) { const int kind = i / 9, q = i % 9; const int ch = (kind == 0 ? 2048 : kind == 1 ? 0 : 1024) + c; return in[I_HCW][q * 3072 + ch]; }
    if (i < 30) { const int kind = i - 27; return in[I_HCB][(kind == 0 ? 2048 : kind == 1 ? 0 : 1024) + c]; }
    return in[I_HSKIP][(i - 30) * 1024 + c];
}
__device__ __forceinline__ void hyena_unit(Frame& F, int un, CvHook& hk) {
    const KargP in = karg_opaque(F.in);
    const int cg = un >> 2, bp = un & 3, c0 = cg * 8, b0 = bp * 2;
    int tid_ = F.tid; asm volatile("" : "+v"(tid_));
    const int hb = tid_ >> 8, ht = tid_ & 255;
    LAS f32x2* buf = (LAS f32x2*)(F.lds + hb * FFT_BUF_BYTES);
    LAS bf16_t* raw = (LAS bf16_t*)(F.lds + HY_RAW + hb * 8192);
    LAS unsigned char* outT = (LAS unsigned char*)(F.lds + HY_OUT);
    const bf16_t* ZT = WSP(bf16_t, WS_ZT); const unsigned* H = WSP(unsigned, WS_H);
    const FftTw tw = fft_tw(ht);
    __syncthreads();
#define HY_FETCH(dst, kind, ch) do { _Pragma("unroll") for (int bb = 0; bb < 2; ++bb) dst[bb] = *(const u32x4*)(ZT + ((size_t)(b0 + bb) * 3072 + (kind) * 1024 + (ch)) * SEQ + ht * 8); } while (0)
#define HY_PUT(srcv) do { _Pragma("unroll") for (int bb = 0; bb < 2; ++bb) *(LAS u32x4*)(raw + bb * 2048 + ht * 8) = srcv[bb]; } while (0)
    u32x4 rv[2], rn[2];
    HY_FETCH(rv, 2, c0 + hb);
    LAS float* coef = (LAS float*)(F.lds + HY_COEF) + hb * 64;
    if (ht < 32) coef[ht] = hy_coef_load(in, c0 + hb, ht);
    float cpre = 0.f;
#pragma unroll 1
    for (int i = 0; i < 4; ++i) {
        const int cl = 2 * i + hb, c = c0 + cl;
        const LAS float* cf = coef + (i & 1) * 32;
        { int hto = ht; asm volatile("" : "+v"(hto));
          if (i < 3 && hto < 32) cpre = hy_coef_load(in, c + 2, hto); }
        HY_PUT(rv);
        HY_FETCH(rn, 0, c);
        __syncthreads();
        f32x2 vin[8], v[16]; unsigned hpre[16];
        hy_conv_to_buf(raw, buf, cf, 0, ht);
        __syncthreads();
#pragma unroll
        for (int a = 0; a < 8; ++a) { vin[a] = buf[fphys(256 * a + ht)]; v[a] = vin[a]; v[8 + a] = (f32x2){0.f, 0.f}; }
        fft_fwd<-1, -1>(v, buf, ht, tw, hk, HPf{H + (size_t)(c * 2 + 0) * 4096, ht, hpre});
#pragma unroll
        for (int ks = 0; ks < 16; ++ks) v[ks] = cmulq(v[ks], (f32x2){bflo(hpre[ks]), bfhi(hpre[ks])});
        fft_inv<0, 1, 0>(v, buf, ht, tw, hk);
        HY_PUT(rn);
        HY_FETCH(rv, 1, c);
        __syncthreads(); hk.act<1>();
        hy_conv_to_buf(raw, buf, cf, 1, ht);
        __syncthreads();
        { const float sk = cf[30];
#pragma unroll
          for (int a = 0; a < 8; ++a) { const f32x2 g = buf[fphys(256 * a + ht)]; vin[a] = g * (v[a] + vin[a] * sk); } }
#pragma unroll
        for (int a = 0; a < 8; ++a) { v[a] = vin[a]; v[8 + a] = (f32x2){0.f, 0.f}; }
        fft_fwd<-1, -1>(v, buf, ht, tw, hk, HPf{H + (size_t)(c * 2 + 1) * 4096, ht, hpre});
#pragma unroll
        for (int ks = 0; ks < 16; ++ks) v[ks] = cmulq(v[ks], (f32x2){bflo(hpre[ks]), bfhi(hpre[ks])});
        fft_inv<0, 1, 0>(v, buf, ht, tw, hk);
        HY_PUT(rv);
        if (i < 3) HY_FETCH(rv, 2, c + 2);
        __syncthreads(); hk.act<1>();
        hy_conv_to_buf(raw, buf, cf, 2, ht);
        __syncthreads();
        { const float sk = cf[31];
#pragma unroll
          for (int a = 0; a < 8; ++a) { const f32x2 g = buf[fphys(256 * a + ht)]; const f32x2 o = g * (v[a] + vin[a] * sk); const int t = 256 * a + ht;
              const unsigned pk_ = pk4_fp8(fminf(fmaxf(o.x, -448.f), 448.f), fminf(fmaxf(o.y, -448.f), 448.f), 0.f, 0.f);
              outT[(0 * 2048 + t) * 8 + cl] = (unsigned char)(pk_ & 0xffu); outT[(1 * 2048 + t) * 8 + cl] = (unsigned char)((pk_ >> 8) & 0xffu); } }
        if (i < 3 && ht < 32) coef[((i + 1) & 1) * 32 + ht] = cpre;
        __syncthreads();
    }
#undef HY_FETCH
#undef HY_PUT
    unsigned char* HH = WSP(unsigned char, WS_HH);
    int tido = F.tid; asm volatile("" : "+v"(tido));
#pragma unroll
    for (int q = 0; q < 8; ++q) { const int r = tido + 512 * q, bb = r >> 11, t = r & 2047;
        *(u32x2*)(HH + ((size_t)(b0 + bb) * SEQ + t) * HW + c0) = *(const LAS u32x2*)(outT + r * 8); }
    __syncthreads();
}

struct SchedP {
    static constexpr bool GATHER = false;
    int G, c; const char* a; const char* b; size_t astep, bstep;
    __device__ __forceinline__ bool next(int i, Unit& u) const { const int L = i * G + c; if (L >= 512) return false; pg8::decode_tile(L, 64, 8, u.pm, u.pn); u.ex = 0; return true; }
    __device__ __forceinline__ const char* a_base(const Unit& u) const { return a + (size_t)u.pm * astep; }
    __device__ __forceinline__ const char* b_base(const Unit& u) const { return b + (size_t)u.pn * bstep; }
    __device__ __forceinline__ int a_row(const Unit&, int R) const { return R; }
};
struct EpiMA {
    static constexpr bool PERM = true;
    bf16_t* T; const bf16_t* Z;
    __device__ __forceinline__ void operator()(const f32x4 (&acc)[2][2][4][2], const Unit& u, int wr, int wc, int fr, int fq) const {
        const int row0 = u.pm * 256 + wr * 64 + fr, col0 = u.pn * 256 + wc * 32 + 8 * fq;
#pragma unroll
        for (int ai = 0; ai < 2; ++ai)
#pragma unroll
            for (int bj = 0; bj < 2; ++bj) { const int c = col0 + bj * 128;
                u32x4 gz[4];
#pragma unroll
                for (int m = 0; m < 4; ++m) gz[m] = *(const u32x4*)(Z + (size_t)(row0 + ai * 128 + m * 16) * ZN + ZC_GA + c);
#pragma unroll
                for (int m = 0; m < 4; ++m) { const size_t row = row0 + ai * 128 + m * 16;
                    const f32x4 g0 = (f32x4){sigmoid_fast(bflo(gz[m].x)), sigmoid_fast(bfhi(gz[m].x)), sigmoid_fast(bflo(gz[m].y)), sigmoid_fast(bfhi(gz[m].y))};
                    const f32x4 g1 = (f32x4){sigmoid_fast(bflo(gz[m].z)), sigmoid_fast(bfhi(gz[m].z)), sigmoid_fast(bflo(gz[m].w)), sigmoid_fast(bfhi(gz[m].w))};
                    const f32x4 t0 = acc[ai][bj][m][0] * g0, t1 = acc[ai][bj][m][1] * g1;
                    u32x4 w; w.x = pg8::cvt_pk_bf16(t0[0], t0[1]); w.y = pg8::cvt_pk_bf16(t0[2], t0[3]); w.z = pg8::cvt_pk_bf16(t1[0], t1[1]); w.w = pg8::cvt_pk_bf16(t1[2], t1[3]);
                    *(u32x4*)(T + row * DM + c) = w; }
                asm volatile("" ::: "memory"); }
    }
};
struct EpiMB {
    static constexpr bool PERM = true;
    const bf16_t* T; const bf16_t* Z; unsigned char* MX;
    __device__ __forceinline__ void operator()(const f32x4 (&acc)[2][2][4][2], const Unit& u, int wr, int wc, int fr, int fq) const {
        const int row0 = u.pm * 256 + wr * 64 + fr, col0 = u.pn * 256 + wc * 32 + 8 * fq;
#pragma unroll
        for (int ai = 0; ai < 2; ++ai)
#pragma unroll
            for (int bj = 0; bj < 2; ++bj) { const int c = col0 + bj * 128;
                u32x4 gz[4], tv[4];
#pragma unroll
                for (int m = 0; m < 4; ++m) { const size_t row = row0 + ai * 128 + m * 16; gz[m] = *(const u32x4*)(Z + row * ZN + ZC_GH + c); tv[m] = *(const u32x4*)(T + row * DM + c); }
#pragma unroll
                for (int m = 0; m < 4; ++m) { const size_t row = row0 + ai * 128 + m * 16;
                    const f32x4 t0 = (f32x4){bflo(tv[m].x), bfhi(tv[m].x), bflo(tv[m].y), bfhi(tv[m].y)}, t1 = (f32x4){bflo(tv[m].z), bfhi(tv[m].z), bflo(tv[m].w), bfhi(tv[m].w)};
                    const f32x4 g0 = (f32x4){sigmoid_fast(bflo(gz[m].x)), sigmoid_fast(bfhi(gz[m].x)), sigmoid_fast(bflo(gz[m].y)), sigmoid_fast(bfhi(gz[m].y))};
                    const f32x4 g1 = (f32x4){sigmoid_fast(bflo(gz[m].z)), sigmoid_fast(bfhi(gz[m].z)), sigmoid_fast(bflo(gz[m].w)), sigmoid_fast(bfhi(gz[m].w))};
                    const f32x4 v0 = t0 + acc[ai][bj][m][0] * g0, v1 = t1 + acc[ai][bj][m][1] * g1;
                    const f32x4 c0 = __builtin_elementwise_min(__builtin_elementwise_max(v0, (f32x4){-448.f, -448.f, -448.f, -448.f}), (f32x4){448.f, 448.f, 448.f, 448.f});
                    const f32x4 c1 = __builtin_elementwise_min(__builtin_elementwise_max(v1, (f32x4){-448.f, -448.f, -448.f, -448.f}), (f32x4){448.f, 448.f, 448.f, 448.f});
                    u32x2 w; w.x = pk4_fp8(c0[0], c0[1], c0[2], c0[3]); w.y = pk4_fp8(c1[0], c1[1], c1[2], c1[3]);
                    *(u32x2*)(MX + row * DM + c) = w; }
                asm volatile("" ::: "memory"); }
    }
};
struct EpiWO {
    static constexpr bool PERM = true;
    bf16_t* R1; const float* x; const float* stats; const float* lng; const float* lnb; const float* mod;
    __device__ __forceinline__ void operator()(const f32x4 (&acc)[2][2][4][2], const Unit& u, int wr, int wc, int fr, int fq) const {
        const int row0 = u.pm * 256 + wr * 64 + fr, col0 = u.pn * 256 + wc * 32 + 8 * fq;
        const float* g1p = mod + (size_t)(u.pm >> 3) * 12288 + 4096;
#pragma unroll
        for (int bj = 0; bj < 2; ++bj) { const int c = col0 + bj * 128;
            const f32x4 ga = *(const f32x4*)(lng + c), gb = *(const f32x4*)(lng + c + 4), ba = *(const f32x4*)(lnb + c), bb = *(const f32x4*)(lnb + c + 4), g1a = *(const f32x4*)(g1p + c), g1b = *(const f32x4*)(g1p + c + 4);
#pragma unroll
            for (int ai = 0; ai < 2; ++ai)
#pragma unroll
                for (int mh = 0; mh < 2; ++mh) {
                    f32x4 xa[2], xb[2]; f32x2 st[2];
#pragma unroll
                    for (int q = 0; q < 2; ++q) { const size_t row = row0 + ai * 128 + (2 * mh + q) * 16; xa[q] = *(const f32x4*)(x + row * DM + c); xb[q] = *(const f32x4*)(x + row * DM + c + 4); st[q] = *(const f32x2*)(stats + row * 2); }
#pragma unroll
                    for (int q = 0; q < 2; ++q) { const int m = 2 * mh + q; const size_t row = row0 + ai * 128 + m * 16; const float mean = st[q].x, rstd = st[q].y;
                        const f32x4 v0 = ((xa[q] - mean) * rstd * ga + ba) * DN_ALPHA + g1a * acc[ai][bj][m][0], v1 = ((xb[q] - mean) * rstd * gb + bb) * DN_ALPHA + g1b * acc[ai][bj][m][1];
                        u32x4 w; w.x = pg8::cvt_pk_bf16(v0[0], v0[1]); w.y = pg8::cvt_pk_bf16(v0[2], v0[3]); w.z = pg8::cvt_pk_bf16(v1[0], v1[1]); w.w = pg8::cvt_pk_bf16(v1[2], v1[3]);
                        *(u32x4*)(R1 + row * DM + c) = w; }
                    asm volatile("" ::: "memory"); } }
    }
};

struct CwItem { const float* src; unsigned char* dst; float scale; };
__device__ __forceinline__ CwItem cw_decode(KargP in, unsigned char* ws, int it) {
    CwItem c;
    if (it < NEXP * 2048) { const int e = it >> 11, q = it & 2047, g = q & 127, kb = q >> 7; const int n0 = 32 * g, tile = n0 >> 8, within = n0 & 255;
        c.src = (within < 128 ? in[I_WG] : in[I_WU]) + (size_t)e * DM * DM + (size_t)(128 * kb) * DM + tile * 128 + (within & 127);
        c.dst = ws + WS_WGU + ((size_t)e * 4096 + n0) * DM + 128 * kb; c.scale = 32.f; }
    else { const int r2 = it - NEXP * 2048; const int e = r2 >> 10, q = r2 & 1023, g = q & 63, kb = q >> 6;
        c.src = in[I_WDN] + (size_t)e * DM * DM + (size_t)(128 * kb) * DM + 32 * g;
        c.dst = ws + WS_WD + ((size_t)e * 2048 + 32 * g) * DM + 128 * kb; c.scale = 64.f; }
    return c;
}
constexpr int CV_E8 = 8;
__device__ __forceinline__ int cw_map(int i) { return i < CV_E8 * 2048 ? i : NEXP * 2048 + (i - CV_E8 * 2048); }
__device__ __forceinline__ void convert_moe_wave(KargP in, unsigned char* ws, LAS unsigned char* tile, int lane, int cw, int ncw) {
    constexpr int NIT = CV_E8 * (2048 + 1024);
    const int kq = lane >> 3, nq = lane & 7;
#define CW_LOAD(v, c) do { _Pragma("unroll") for (int i_ = 0; i_ < 16; ++i_) v[i_] = __builtin_nontemporal_load((const f32x4*)((c).src + (size_t)(16 * kq + i_) * DM + 4 * nq)); } while (0)
#define CW_PROC(v, c) do { \
        _Pragma("unroll") for (int j_ = 0; j_ < 4; ++j_) { u32x4 o_; const float s_ = (c).scale; \
            o_.x = pk4_fp8(v[0][j_] * s_, v[1][j_] * s_, v[2][j_] * s_, v[3][j_] * s_);     o_.y = pk4_fp8(v[4][j_] * s_, v[5][j_] * s_, v[6][j_] * s_, v[7][j_] * s_); \
            o_.z = pk4_fp8(v[8][j_] * s_, v[9][j_] * s_, v[10][j_] * s_, v[11][j_] * s_);   o_.w = pk4_fp8(v[12][j_] * s_, v[13][j_] * s_, v[14][j_] * s_, v[15][j_] * s_); \
            *(LAS u32x4*)(tile + (4 * nq + j_) * 144 + 16 * kq) = o_; } \
        asm volatile("s_waitcnt lgkmcnt(0)" ::: "memory"); \
        _Pragma("unroll") for (int q_ = 0; q_ < 4; ++q_) { const int idx_ = lane + 64 * q_, row_ = idx_ >> 3, piece_ = idx_ & 7; \
            *(u32x4*)((c).dst + (size_t)row_ * DM + 16 * piece_) = *(const LAS u32x4*)(tile + row_ * 144 + 16 * piece_); } \
        asm volatile("s_waitcnt lgkmcnt(0)" ::: "memory"); } while (0)
    f32x4 va[16], vb[16];
    int it = cw;
    if (it >= NIT) return;
    CwItem ca = cw_decode(in, ws, cw_map(it)), cb = ca;
    CW_LOAD(va, ca);
    for (;;) {
        const bool hb = it + ncw < NIT;
        if (hb) { cb = cw_decode(in, ws, cw_map(it + ncw)); CW_LOAD(vb, cb); }
        CW_PROC(va, ca);
        if (!hb) break;
        it += ncw;
        const bool ha = it + ncw < NIT;
        if (ha) { ca = cw_decode(in, ws, cw_map(it + ncw)); CW_LOAD(va, ca); }
        CW_PROC(vb, cb);
        if (!ha) break;
        it += ncw;
    }
#undef CW_LOAD
#undef CW_PROC
}

__device__ __forceinline__ void sw_bar4(volatile LAS unsigned* cnt, unsigned& target, int lane) {
    asm volatile("s_waitcnt lgkmcnt(0)" ::: "memory");
    target += 4u;
    if (lane == 0) __hip_atomic_fetch_add((LAS unsigned*)cnt, 1u, __ATOMIC_RELAXED, __HIP_MEMORY_SCOPE_WORKGROUP);
    for (unsigned sp_ = 0; __hip_atomic_load((LAS unsigned*)cnt, __ATOMIC_RELAXED, __HIP_MEMORY_SCOPE_WORKGROUP) < target && sp_ < (1u << 24); ++sp_) __builtin_amdgcn_s_sleep(0);
    asm volatile("" ::: "memory");
}
__device__ __forceinline__ void p8_phase(Frame& F) {
    const KargP in = karg_opaque(F.in);
    const int lane = F.lane, l15 = lane & 15, g4 = lane >> 4;
    if (F.wave >= 4) {
        convert_moe_wave(in, F.ws, (LAS unsigned char*)(F.lds + 4 * 20480 + (F.wave - 4) * 4608), lane, F.bid * 4 + (F.wave - 4), F.G * 4);
        return; }
    const bf16_t* R1 = WSP(bf16_t, WS_R1); unsigned char* TOK = WSP(unsigned char, WS_TOK); const float* mod = WSP(float, WS_MOD);
    LAS float* pA = (LAS float*)(F.lds + F.wave * 20480);
    LAS float* pB = pA + 2048;
    LAS float* lg = pA + 4096;
    LAS int* te = (LAS int*)(lg + 576); LAS float* tw = (LAS float*)(te + 64);
    const float* wr = in[I_WR];
    LAS float* wl = (LAS float*)(F.lds + 4 * 20480 + 4 * 4608);
    unsigned rbt = 0u;
#pragma unroll 1
    for (int tile = F.bid + F.G * F.wave; tile < MTOK / 16; tile += F.G * 4) {
        const int bsel = (tile * 16) / SEQ; const float* mv = mod + (size_t)bsel * 12288;
#pragma unroll
        for (int j = 0; j < 8; ++j) { const int c = lane * 4 + 256 * j;
            const f32x4 g = *(const f32x4*)(in[I_LN1G] + c), bb = *(const f32x4*)(in[I_LN1B] + c), sh = *(const f32x4*)(mv + 6144 + c), sc = *(const f32x4*)(mv + 8192 + c) + 1.0f;
            *(LAS f32x4*)(pA + c) = g * sc; *(LAS f32x4*)(pB + c) = bb * sc + sh; }
        LDS_WAIT(); asm volatile("" ::: "memory");
        float my_mean = 0.f, my_rstd = 0.f;
        {
            const bf16_t* xb = R1 + (size_t)tile * 16 * DM + lane * 4;
            f32x4 v[8]; u32x2 vn[8];
#pragma unroll
            for (int j = 0; j < 8; ++j) { const u32x2 t_ = *(const u32x2*)(xb + 256 * j); v[j] = (f32x4){bflo(t_.x), bfhi(t_.x), bflo(t_.y), bfhi(t_.y)}; }
#pragma unroll 1
            for (int rr = 0; rr < 16; ++rr) {
                const bf16_t* xn = xb + (size_t)(rr < 15 ? rr + 1 : rr) * DM;
#pragma unroll
                for (int j = 0; j < 8; ++j) vn[j] = *(const u32x2*)(xn + 256 * j);
                float s = 0.f;
#pragma unroll
                for (int j = 0; j < 8; ++j) s += (v[j].x + v[j].y) + (v[j].z + v[j].w);
                const float mean = wave_sum(s) * (1.f / DM); float s2 = 0.f;
#pragma unroll
                for (int j = 0; j < 8; ++j) { v[j] = v[j] - mean; s2 += (v[j].x * v[j].x + v[j].y * v[j].y) + (v[j].z * v[j].z + v[j].w * v[j].w); }
                const float rstd = 1.f / sqrtf(wave_sum(s2) * (1.f / DM) + LN_EPS);
                if (l15 == rr) { my_mean = mean; my_rstd = rstd; }
                unsigned char* orow = TOK + (size_t)(tile * 16 + rr) * DM;
#pragma unroll
                for (int j = 0; j < 8; ++j) { const int c = lane * 4 + 256 * j;
                    const f32x4 y = v[j] * rstd * *(const LAS f32x4*)(pA + c) + *(const LAS f32x4*)(pB + c);
                    *(unsigned*)(orow + c) = pk4_fp8(y.x, y.y, y.z, y.w); }
#pragma unroll
                for (int j = 0; j < 8; ++j) v[j] = (f32x4){bflo(vn[j].x), bfhi(vn[j].x), bflo(vn[j].y), bfhi(vn[j].y)};
            }
        }
        f32x4 acc0 = (f32x4){0.f, 0.f, 0.f, 0.f}, acc1 = (f32x4){0.f, 0.f, 0.f, 0.f};
        const bf16_t* rowp = R1 + (size_t)(tile * 16 + l15) * DM + 512 * g4;
        const float ra = my_rstd, rm = -my_mean * my_rstd;
        const int rt = F.tid;
        float wst[32]; u32x4 ar[8];
#define RT_WLOAD(c) do { int rt_ = rt; asm volatile("" : "+v"(rt_)); const float* wb_ = wr + (size_t)(64 * (c) + (rt_ >> 5)) * 32 + (rt_ & 31); \
            _Pragma("unroll") for (int q_ = 0; q_ < 32; ++q_) wst[q_] = wb_[(512 * (q_ >> 3) + 8 * (q_ & 7)) * 32]; } while (0)
        RT_WLOAD(0);
#pragma unroll
        for (int q = 0; q < 8; ++q) ar[q] = *(const u32x4*)(rowp + 8 * q);
#pragma unroll 1
        for (int c = 0; c < 8; ++c) {
            { int rt_ = rt; asm volatile("" : "+v"(rt_)); LAS float* wd_ = wl + (rt_ & 31) * 68 + (rt_ >> 5);
#pragma unroll
              for (int q = 0; q < 32; ++q) wd_[(q >> 3) * 32 * 68 + 8 * (q & 7)] = wst[q]; }
            sw_bar4(F.MISC + 16, rbt, lane);
            if (c < 7) RT_WLOAD(c + 1);
            const LAS float* w0p = wl + (g4 * 32 + l15) * 68; const LAS float* w1p = w0p + 16 * 68;
            const bf16_t* rown = rowp + 64 * (c < 7 ? c + 1 : c);
#pragma unroll
            for (int i = 0; i < 16; ++i) {
                const f32x4 av = *(const LAS f32x4*)(pA + 512 * g4 + 64 * c + 4 * i), bv = *(const LAS f32x4*)(pB + 512 * g4 + 64 * c + 4 * i);
                const f32x4 w0 = *(const LAS f32x4*)(w0p + 4 * i), w1 = *(const LAS f32x4*)(w1p + 4 * i);
                const unsigned lo = (i & 1) ? ar[i >> 1].z : ar[i >> 1].x, hi = (i & 1) ? ar[i >> 1].w : ar[i >> 1].y;
                const f32x4 tk = ((f32x4){bflo(lo), bfhi(lo), bflo(hi), bfhi(hi)} * ra + rm) * av + bv;
#pragma unroll
                for (int j = 0; j < 4; ++j) { acc0 = __builtin_amdgcn_mfma_f32_16x16x4f32(tk[j], w0[j], acc0, 0, 0, 0); acc1 = __builtin_amdgcn_mfma_f32_16x16x4f32(tk[j], w1[j], acc1, 0, 0, 0); }
                if (i == 7) {
#pragma unroll
                    for (int q = 0; q < 4; ++q) ar[q] = *(const u32x4*)(rown + 8 * q); }
            }
#pragma unroll
            for (int q = 4; q < 8; ++q) ar[q] = *(const u32x4*)(rown + 8 * q);
            sw_bar4(F.MISC + 16, rbt, lane);
        }
#undef RT_WLOAD
        { const float b0 = in[I_BR][l15], b1 = in[I_BR][16 + l15];
#pragma unroll
          for (int r = 0; r < 4; ++r) { lg[(4 * g4 + r) * 33 + l15] = acc0[r] + b0; lg[(4 * g4 + r) * 33 + 16 + l15] = acc1[r] + b1; } }
        LDS_WAIT(); asm volatile("" ::: "memory");
        if (lane < 16) {
            unsigned chosen = 0u; float lv[4]; int le[4];
            for (int k = 0; k < 4; ++k) { float best = -3.4e38f; int be = 0;
                for (int e = 0; e < 32; ++e) { const float v = lg[lane * 33 + e]; if (!((chosen >> e) & 1u) && v > best) { best = v; be = e; } }
                chosen |= 1u << be; lv[k] = best; le[k] = be; }
            float ex[4], sum = 0.f;
            for (int k = 0; k < 4; ++k) { ex[k] = __expf(lv[k] - lv[0]); sum += ex[k]; }
            for (int k = 0; k < 4; ++k) { te[lane * 4 + k] = le[k]; tw[lane * 4 + k] = ex[k] / sum; }
        }
        LDS_WAIT(); asm volatile("" ::: "memory");
        { const int e = te[lane]; const float wv = tw[lane]; const int token = tile * 16 + (lane >> 2);
          const int pos = (int)__hip_atomic_fetch_add(F.ctl + CW_CNT + 64 * e, 1u, __ATOMIC_RELAXED, __HIP_MEMORY_SCOPE_AGENT);
          WSP(int, WS_TOPE)[token * 4 + (lane & 3)] = e; WSP(int, WS_TOPP)[token * 4 + (lane & 3)] = pos; WSP(float, WS_TOPW)[token * 4 + (lane & 3)] = wv;
          WSP(int, WS_RTOK)[e * POSCAP + pos] = token; }
        LDS_WAIT(); asm volatile("" ::: "memory");
    }
}

constexpr int MOE_TBL = 131072;
__device__ __forceinline__ void moe_table(Frame& F) {
    LAS int* tst = (LAS int*)(F.lds + MOE_TBL); LAS int* cn = (LAS int*)(F.lds + MOE_TBL + 256);
    __syncthreads();
    if (F.tid < 64) {
        const int e = F.tid & 31; const int c = (int)__hip_atomic_load(F.ctl + CW_CNT + 64 * e, __ATOMIC_RELAXED, __HIP_MEMORY_SCOPE_AGENT);
        int inc = (c + 255) >> 8;
#pragma unroll
        for (int o = 1; o < 32; o <<= 1) { const int t = __shfl_up(inc, o); if ((F.tid & 31) >= o) inc += t; }
        if (F.tid < 32) { cn[e] = c; tst[e] = inc - ((c + 255) >> 8); if (e == 31) tst[NEXP] = inc; } }
    __syncthreads();
}
constexpr int MOE_UL = MOE_TBL + 512;
__device__ __forceinline__ void moe_unit_list(Frame& F, int NT) {
    const LAS int* tst = (const LAS int*)(F.lds + MOE_TBL); LAS int* ul = (LAS int*)(F.lds + MOE_UL);
    if (F.tid < 64) {
        const int nwg = tst[NEXP] * NT; const int L = F.tid * F.G + F.bid;
        int pm = -1, pn = 0, e = 0;
        if (L < nwg) {
            int wg; { const int q = nwg / 8, r = nwg % 8, xcd = L % 8, off = L / 8; wg = (xcd < r ? xcd * (q + 1) : r * (q + 1) + (xcd - r) * q) + off; }
            for (int k = 1; k < NEXP; ++k) if (wg >= tst[k] * NT) e = k;
            const int ts = tst[e], ne = tst[e + 1] - ts, rem = wg - ts * NT;
            pm = ts + rem % ne; pn = rem / ne; }
        ul[F.tid * 4 + 0] = pm; ul[F.tid * 4 + 1] = pn; ul[F.tid * 4 + 2] = e; ul[F.tid * 4 + 3] = 0;
    }
    __syncthreads();
}
constexpr int MOE_ROWS = MOE_UL + 1024, MOE_ROWS_MAX = 18;
constexpr int MOE_BIAS = MOE_ROWS + MOE_ROWS_MAX * 512;
static_assert(MOE_BIAS + MOE_ROWS_MAX * 1024 <= MISC_OFF, "MoE LDS tables");
__device__ __forceinline__ void moe_row_table(Frame& F, const int* rtok) {
    const LAS int* tst = (const LAS int*)(F.lds + MOE_TBL); const LAS int* cn = (const LAS int*)(F.lds + MOE_TBL + 256); const LAS int* ul = (const LAS int*)(F.lds + MOE_UL);
    LAS unsigned short* rows = (LAS unsigned short*)(F.lds + MOE_ROWS);
    for (int idx = F.tid; idx < MOE_ROWS_MAX * 256; idx += NTHR) { const int i = idx >> 8, r = idx & 255; const int pm = ul[i * 4];
        if (pm >= 0) { const int e = ul[i * 4 + 2]; int pos = (pm - tst[e]) * 256 + r; const int cnt = cn[e]; pos = pos < cnt ? pos : cnt - 1; rows[idx] = (unsigned short)rtok[e * POSCAP + pos]; } }
    __syncthreads();
}
__device__ __forceinline__ void moe_bias_table(Frame& F, const float* b0, const float* b1, bool gu) {
    const LAS int* ul = (const LAS int*)(F.lds + MOE_UL); LAS float* bt = (LAS float*)(F.lds + MOE_BIAS);
    for (int idx = F.tid; idx < MOE_ROWS_MAX * 256; idx += NTHR) { const int i = idx >> 8, j = idx & 255; const int pm = ul[i * 4];
        if (pm >= 0) { const int pn = ul[i * 4 + 1], e = ul[i * 4 + 2];
            bt[idx] = gu ? (j < 128 ? b0[(size_t)e * DM + pn * 128 + j] : b1[(size_t)e * DM + pn * 128 + j - 128]) : b0[(size_t)e * DM + pn * 256 + j]; } }
    __syncthreads();
}
template <bool GU> struct SchedMoE {
    static constexpr bool GATHER = GU;
    int G, c, NT; const LAS int* tst; const LAS int* cn; const int* rtok; const char* a; const char* b; const LAS int* ul;
    __device__ __forceinline__ bool next(int i, Unit& u) const {
        if (i >= MOE_ROWS_MAX) return false;
        const int pm = __builtin_amdgcn_readfirstlane(ul[i * 4 + 0]); if (pm < 0) return false;
        u.pm = pm; u.pn = __builtin_amdgcn_readfirstlane(ul[i * 4 + 1]); u.ex = i; return true;
    }
    __device__ __forceinline__ const char* a_base(const Unit& u) const { return GU ? a : a + (size_t)u.pm * 256 * DM; }
    __device__ __forceinline__ int expert(const Unit& u) const { return __builtin_amdgcn_readfirstlane(ul[u.ex * 4 + 2]); }
    __device__ __forceinline__ const char* b_base(const Unit& u) const { return b + ((size_t)expert(u) * (GU ? 4096 : 2048) + 256 * u.pn) * DM; }
    __device__ __forceinline__ int a_row(const Unit& u, int R) const { return (int)((const LAS unsigned short*)((const LAS char*)ul + (MOE_ROWS - MOE_UL)))[u.ex * 256 + R]; }
};
struct EpiGU {
    static constexpr bool PERM = true;
    unsigned char* ACT; const float* bg; const float* bu; const LAS int* ul;
    __device__ __forceinline__ void operator()(const f32x4 (&acc)[2][2][4][2], const Unit& u, int wr, int wc, int fr, int fq) const {
        const int row0 = u.pm * 256 + wr * 64 + fr, col0 = u.pn * 128 + wc * 32 + 8 * fq;
        const LAS float* bt = (const LAS float*)((const LAS char*)ul + (MOE_BIAS - MOE_UL)) + u.ex * 256 + wc * 32 + 8 * fq;
        const f32x4 g0 = *(const LAS f32x4*)bt, g1 = *(const LAS f32x4*)(bt + 4), u0 = *(const LAS f32x4*)(bt + 128), u1 = *(const LAS f32x4*)(bt + 132);
#pragma unroll
        for (int ai = 0; ai < 2; ++ai)
#pragma unroll
            for (int m = 0; m < 4; ++m) { const size_t row = row0 + ai * 128 + m * 16;
                float o[8];
#pragma unroll
                for (int n = 0; n < 2; ++n)
#pragma unroll
                    for (int j = 0; j < 4; ++j) { const float gv = fminf(acc[ai][0][m][n][j] + (n ? g1[j] : g0[j]), 7.0f);
                        const float uv = fminf(fmaxf(acc[ai][1][m][n][j] + (n ? u1[j] : u0[j]), -7.0f), 7.0f);
                        o[n * 4 + j] = 4.0f * gv * sigmoid_fast(1.702f * gv) * (uv + 1.0f); }
                u32x2 w; w.x = pk4_fp8(o[0], o[1], o[2], o[3]); w.y = pk4_fp8(o[4], o[5], o[6], o[7]);
                *(u32x2*)(ACT + row * DM + col0) = w; }
    }
};
struct EpiDN {
    static constexpr bool PERM = true;
    unsigned char* YR; const LAS int* ul;
    __device__ __forceinline__ void operator()(const f32x4 (&acc)[2][2][4][2], const Unit& u, int wr, int wc, int fr, int fq) const {
        const int r0 = wr * 64 + fr, col0 = u.pn * 256 + wc * 32 + 8 * fq;
        const LAS float* bp = (const LAS float*)((const LAS char*)ul + (MOE_BIAS - MOE_UL)) + u.ex * 256 + wc * 32 + 8 * fq;
        unsigned char* base = YR + ((size_t)u.pm * 256 + r0) * DM + col0;
#pragma unroll
        for (int bj = 0; bj < 2; ++bj) {
            const f32x4 bv0 = *(const LAS f32x4*)(bp + bj * 128), bv1 = *(const LAS f32x4*)(bp + bj * 128 + 4);
#pragma unroll
            for (int ai = 0; ai < 2; ++ai)
#pragma unroll
                for (int m = 0; m < 4; ++m) {
                    const f32x4 lim = (f32x4){448.f, 448.f, 448.f, 448.f};
                    const f32x4 v0 = __builtin_elementwise_min(__builtin_elementwise_max((acc[ai][bj][m][0] + bv0) * 16.0f, -lim), lim), v1 = __builtin_elementwise_min(__builtin_elementwise_max((acc[ai][bj][m][1] + bv1) * 16.0f, -lim), lim);
                    u32x2 w; w.x = pk4_fp8(v0[0], v0[1], v0[2], v0[3]); w.y = pk4_fp8(v1[0], v1[1], v1[2], v1[3]);
                    *(u32x2*)(base + (size_t)(ai * 128 + m * 16) * DM + bj * 128) = w; }
        }
    }
};

__device__ __forceinline__ void p11_phase(Frame& F) {
    const KargP in = karg_opaque(F.in);
    const int gw = F.bid * NWAVES + F.wave, NGW = F.G * NWAVES, lane = F.lane;
    const LAS int* tst = (const LAS int*)(F.lds + MOE_TBL);
    const bf16_t* R1 = WSP(bf16_t, WS_R1); const unsigned char* YR = WSP(unsigned char, WS_YR); const float* mod = WSP(float, WS_MOD);
    LAS float* pl = (LAS float*)F.lds;
    for (int i = F.tid; i < 2048; i += NTHR) { pl[i] = in[I_LN1G][i]; pl[2048 + i] = in[I_LN1B][i]; pl[4096 + i] = in[I_LN2G][i]; pl[6144 + i] = in[I_LN2B][i]; }
    for (int i = F.tid; i < 8 * 2048; i += NTHR) pl[8192 + i] = mod[(size_t)(i >> 11) * 12288 + 10240 + (i & 2047)];
    __syncthreads();
    LAS int* sd = (LAS int*)(F.lds + 98304 + F.wave * 512); LAS float* sw = (LAS float*)(F.lds + 98304 + F.wave * 512 + 256);
#pragma unroll 1
    for (int rb = gw * 8; rb < MTOK; rb += NGW * 8) {
        const int li = lane & 31;
        { const int ve = WSP(int, WS_TOPE)[rb * 4 + li], vp = WSP(int, WS_TOPP)[rb * 4 + li]; const float vw = WSP(float, WS_TOPW)[rb * 4 + li];
          if (lane < 32) { sd[li] = tst[ve] * 256 + vp; sw[li] = vw; } }
        const LAS float* g2p = pl + 8192 + (rb / SEQ) * 2048;
        LDS_WAIT(); asm volatile("" ::: "memory");
#pragma unroll 1
        for (int ri = 0; ri < 8; ++ri) {
            const int row = rb + ri;
            int dest[4]; float wk[4];
#pragma unroll
            for (int k = 0; k < 4; ++k) { dest[k] = __builtin_amdgcn_readfirstlane(sd[ri * 4 + k]); wk[k] = __builtin_bit_cast(float, __builtin_amdgcn_readfirstlane(__builtin_bit_cast(int, sw[ri * 4 + k]))); }
            const bf16_t* xr = R1 + (size_t)row * DM + lane * 4;
            f32x4 v[8]; unsigned yy[4][8]; u32x2 vr[8];
#pragma unroll
            for (int j = 0; j < 8; ++j) vr[j] = *(const u32x2*)(xr + 256 * j);
#pragma unroll
            for (int k = 0; k < 4; ++k) { const unsigned char* yp = YR + (size_t)dest[k] * DM + lane * 4;
#pragma unroll
                for (int j = 0; j < 8; ++j) yy[k][j] = *(const unsigned*)(yp + 256 * j); }
            float s = 0.f;
#pragma unroll
            for (int j = 0; j < 8; ++j) { v[j] = (f32x4){bflo(vr[j].x), bfhi(vr[j].x), bflo(vr[j].y), bfhi(vr[j].y)}; s += (v[j].x + v[j].y) + (v[j].z + v[j].w); }
            float mean = wave_sum(s) * (1.f / DM); float s2 = 0.f;
#pragma unroll
            for (int j = 0; j < 8; ++j) { v[j] = v[j] - mean; s2 += (v[j].x * v[j].x + v[j].y * v[j].y) + (v[j].z * v[j].z + v[j].w * v[j].w); }
            float rstd = 1.f / sqrtf(wave_sum(s2) * (1.f / DM) + LN_EPS);
            s = 0.f;
#pragma unroll
            for (int j = 0; j < 8; ++j) { const int c = lane * 4 + 256 * j;
                const f32x4 g = *(const LAS f32x4*)(pl + c), bb = *(const LAS f32x4*)(pl + 2048 + c), g2v = *(const LAS f32x4*)(g2p + c);
                f32x4 y = (f32x4){0.f, 0.f, 0.f, 0.f};
#pragma unroll
                for (int k = 0; k < 4; ++k) { const f32x2 lo = __builtin_amdgcn_cvt_pk_f32_fp8((int)yy[k][j], false), hi = __builtin_amdgcn_cvt_pk_f32_fp8((int)yy[k][j], true); y += (f32x4){lo.x, lo.y, hi.x, hi.y} * (wk[k] * 0.0625f); }
                v[j] = (v[j] * rstd * g + bb) * DN_ALPHA + g2v * y;
                s += (v[j].x + v[j].y) + (v[j].z + v[j].w); __builtin_amdgcn_sched_barrier(0); }
            mean = wave_sum(s) * (1.f / DM); s2 = 0.f;
#pragma unroll
            for (int j = 0; j < 8; ++j) { v[j] = v[j] - mean; s2 += (v[j].x * v[j].x + v[j].y * v[j].y) + (v[j].z * v[j].z + v[j].w * v[j].w); }
            rstd = 1.f / sqrtf(wave_sum(s2) * (1.f / DM) + LN_EPS);
            float* orow = F.out + (size_t)row * DM;
#pragma unroll
            for (int j = 0; j < 8; ++j) { const int c = lane * 4 + 256 * j;
                const f32x4 g = *(const LAS f32x4*)(pl + 4096 + c), bb = *(const LAS f32x4*)(pl + 6144 + c);
                *(f32x4*)(orow + c) = v[j] * rstd * g + bb; }
        }
        LDS_WAIT(); asm volatile("" ::: "memory");
    }
}

constexpr int NPHASE = 13;
__global__ void __launch_bounds__(NTHR, 2) mk_fwd(Args args) {
    extern __shared__ __attribute__((aligned(16))) unsigned char lds_raw[];
    Frame F;
    F.lds = (LAS unsigned char*)lds_raw;
    F.MISC = (volatile LAS unsigned*)(F.lds + MISC_OFF);
    F.tid = threadIdx.x; F.lane = F.tid & 63; F.wave = __builtin_amdgcn_readfirstlane(F.tid >> 6); F.wave0 = F.wave;
    F.G = gridDim.x; F.bid = blockIdx.x;
    F.in = (KargP)__builtin_amdgcn_kernarg_segment_ptr(); F.out = args.out; F.ws = args.ws; F.ctl = (unsigned*)(args.ws + WS_CTL);
    for (int u = F.tid; u < (LDS_BYTES - MISC_OFF) / 4; u += NTHR) ((LAS unsigned*)(F.lds + MISC_OFF))[u] = 0u;
    __syncthreads();
    XcdBarrier bar; bar.bar = F.ctl + CW_BAR; bar.x = 0; bar.st = nullptr;
    if (MK_LAUNCHES == 1) bar = xcd_barrier_post(F.ctl + CW_BAR, F.MISC + 8, F.tid);
    const int lo = args.ph_lo, hi = args.ph_hi;
    unsigned long long tph_ = (PROBE_PH >= 0) ? __builtin_amdgcn_s_memrealtime() : 0ull;
#ifndef PH_MASK
#define PH_MASK 0xFFFF
#endif
#define TID_NOW(var) int var; { unsigned z_ = 0u; asm volatile("" : "+s"(z_)); var = (F.wave0 << 6) | (int)__builtin_amdgcn_mbcnt_hi(~0u, __builtin_amdgcn_mbcnt_lo(~0u, z_)); }
#define RELOAD() do { const KargP k_ = karg_opaque(F.in); F.out = (float*)k_[38]; F.ws = (unsigned char*)k_[39]; F.ctl = (unsigned*)F.ws; TID_NOW(t_); asm volatile("" : "+v"(t_)); F.tid = t_; F.lane = t_ & 63; F.wave = __builtin_amdgcn_readfirstlane(t_ >> 6); } while (0)
#define IN(k) (((PH_MASK >> (k)) & 1) && lo <= (k) && (k) < hi)
#define SEAM(k) do { if (IN(k) && IN((k) + 1)) { TID_NOW(ts_); xcd_barrier(bar, ts_); } \
        if (PROBE_PH >= 0) { const unsigned long long t1_ = __builtin_amdgcn_s_memrealtime(); \
            if (PROBE_PH == (k)) { while (__builtin_amdgcn_s_memrealtime() - t1_ < t1_ - tph_) __builtin_amdgcn_s_sleep(8); } \
            tph_ = __builtin_amdgcn_s_memrealtime(); } } while (0)
#ifndef DUP_MASK
#define DUP_MASK 0
#endif
#define REP(k) for (int rep_ = 0; rep_ < (((DUP_MASK >> (k)) & 1) ? 2 : 1); ++rep_)
    if (IN(0)) REP(0) p0_phase(F);
    SEAM(0);
    RELOAD();
    if (IN(1)) REP(1) p0b_phase(F);
    SEAM(1);
    RELOAD();
    if (IN(2)) REP(2) p1_phase(F);
    SEAM(2);
    RELOAD();
    if (IN(3)) REP(3) {
        EpiZ E{WSP(bf16_t, WS_Z), WSP(bf16_t, WS_ZT), WSP(float, WS_BINP)};
        { SchedZ<false> S{F.G, F.bid, (const char*)WSP(bf16_t, WS_HX), (const char*)WSP(bf16_t, WS_WIN)};
          pg8::gemm_phase<EpiZ, SchedZ<false>>(F.tid, F.lds, DM / 64, DM * 2, DM * 2, S, E); }
        { SchedZ<true> S{F.G, F.G - 1 - F.bid, (const char*)WSP(unsigned char, WS_HX8), (const char*)WSP(unsigned char, WS_WIN8)};
          pg8::gemm_phase<EpiZ, SchedZ<true>, true>(F.tid, F.lds, DM / 128, DM, DM, S, E, 0x7A7A7A7A, 0x7F7F7F7F); }
    }
    SEAM(3);
    RELOAD();
    if (IN(4)) REP(4) p3_phase(F);
    SEAM(4);
    RELOAD();
    if (IN(5)) REP(5) {
        SchedQK S{F.G, F.bid, (const char*)WSP(bf16_t, WS_U), (const char*)WSP(bf16_t, WS_WQK)};
        EpiQK E{WSP(bf16_t, WS_QKB)};
        pg8::gemm_phase<EpiQK, SchedQK>(F.tid, F.lds, 256 / 64, MW * 2, 256 * 2, S, E);
    }
    SEAM(5);
    RELOAD();
    if (IN(6)) REP(6) {
#ifndef DUP_ML
#define DUP_ML 1
#endif
#ifndef DUP_HY
#define DUP_HY 1
#endif
        for (int un = F.bid; un < 256 * DUP_ML; un += F.G) mlstm_unit(F, un & 255);
        RELOAD();
        { CvHook hk; hk.in = karg_opaque(F.in); hk.ws = F.ws; hk.tiles = (LAS unsigned char*)(F.lds + HY_CVT); hk.tid = F.tid; hk.bid = F.bid; hk.G = F.G; hk.kmax = (CVH_NITEMS - 1 - F.bid) / F.G; hk.s = 2; hk.request<0>(0); hk.request<1>(1);
          for (int un = F.bid; un < 512 * DUP_HY; un += F.G) hyena_unit(F, un & 511, hk);
          while (hk.s <= hk.kmax + 3) { __syncthreads(); if (hk.s & 1) hk.act<1>(); else hk.act<0>(); }
          __syncthreads(); }
    }
    SEAM(6);
    RELOAD();
    if (IN(7)) REP(7) {
        { SchedP S{F.G, F.bid, (const char*)WSP(unsigned char, WS_AM), (const char*)WSP(unsigned char, WS_WPA2), (size_t)256 * 2048, (size_t)256 * 2048};
          EpiMA E{WSP(bf16_t, WS_T), WSP(bf16_t, WS_Z)};
          pg8::gemm_phase<EpiMA, SchedP, true>(F.tid, F.lds, 2048 / 128, 2048, 2048, S, E, 0x7A7A7A7A, 0x7F7F7F7F); }
        VM_WAIT(); __syncthreads();
        { SchedP S{F.G, F.bid, (const char*)WSP(unsigned char, WS_HH), (const char*)WSP(unsigned char, WS_WPH), (size_t)256 * 1024, (size_t)256 * 1024};
          EpiMB E{WSP(bf16_t, WS_T), WSP(bf16_t, WS_Z), WSP(unsigned char, WS_MX)};
          pg8::gemm_phase<EpiMB, SchedP, true>(F.tid, F.lds, 1024 / 128, 1024, 1024, S, E, 0x7A7A7A7A, 0x7F7F7F7F); }
    }
    SEAM(7);
    RELOAD();
    if (IN(8)) REP(8) {
        SchedP S{F.G, F.bid, (const char*)WSP(unsigned char, WS_MX), (const char*)WSP(unsigned char, WS_WOUT), (size_t)256 * 2048, (size_t)256 * 2048};
        const KargP in = karg_opaque(F.in); EpiWO E{WSP(bf16_t, WS_R1), in[I_X], WSP(float, WS_STATS), in[I_LNG], in[I_LNB], WSP(float, WS_MOD)};
        pg8::gemm_phase<EpiWO, SchedP, true>(F.tid, F.lds, 2048 / 128, 2048, 2048, S, E, 0x79797979, 0x7F7F7F7F);
    }
    SEAM(8);
    RELOAD();
    if (IN(9)) p8_phase(F);
    SEAM(9);
    RELOAD();
    if (IN(10)) REP(10) {
        moe_table(F);
        moe_unit_list(F, 16); moe_row_table(F, WSP(int, WS_RTOK)); { const KargP in_ = karg_opaque(F.in); moe_bias_table(F, in_[I_BG], in_[I_BU], true); }
        SchedMoE<true> S{F.G, F.bid, 16, (const LAS int*)(F.lds + MOE_TBL), (const LAS int*)(F.lds + MOE_TBL + 256), WSP(int, WS_RTOK), (const char*)WSP(bf16_t, WS_TOK), (const char*)WSP(bf16_t, WS_WGU), (const LAS int*)(F.lds + MOE_UL)};
        const KargP in = karg_opaque(F.in); EpiGU E{WSP(unsigned char, WS_ACT), in[I_BG], in[I_BU], (const LAS int*)(F.lds + MOE_UL)};
        pg8::gemm_phase<EpiGU, SchedMoE<true>, true>(F.tid, F.lds, DM / 128, DM, DM, S, E, 0x7A7A7A7A, 0x7F7F7F7F);
    }
    SEAM(10);
    RELOAD();
    if (IN(11)) REP(11) {
        moe_table(F);
        moe_unit_list(F, 8); { const KargP in_ = karg_opaque(F.in); moe_bias_table(F, in_[I_BDN], in_[I_BDN], false); }
        SchedMoE<false> S{F.G, F.bid, 8, (const LAS int*)(F.lds + MOE_TBL), (const LAS int*)(F.lds + MOE_TBL + 256), WSP(int, WS_RTOK), (const char*)WSP(bf16_t, WS_ACT), (const char*)WSP(bf16_t, WS_WD), (const LAS int*)(F.lds + MOE_UL)};
        const KargP in = karg_opaque(F.in); EpiDN E{WSP(unsigned char, WS_YR), (const LAS int*)(F.lds + MOE_UL)};
        pg8::gemm_phase<EpiDN, SchedMoE<false>, true>(F.tid, F.lds, DM / 128, DM, DM, S, E, 0x79797979, 0x7D7D7D7D);
    }
    SEAM(11);
    RELOAD();
    if (IN(12)) REP(12) { moe_table(F); p11_phase(F); }
#undef IN
#undef SEAM
}

extern "C" void kernel_launch(void* const* d_in, const int* in_sizes, int n_in, void* d_out, int out_size, void* d_ws, size_t ws_size, hipStream_t stream) {
    static int grid = 0;
    if (grid == 0) {
        if (n_in != 38 || out_size != MTOK * DM || ws_size < WS_END) { fprintf(stderr, "kernel_launch: unexpected shapes: n_in %d out %d ws %zu (need %zu)\n", n_in, out_size, ws_size, (size_t)WS_END); grid = -1; return; }
        int dev = 0, cus = 0, per_cu = 0;
        if (hipGetDevice(&dev) != hipSuccess || hipDeviceGetAttribute(&cus, hipDeviceAttributeMultiprocessorCount, dev) != hipSuccess) { grid = -1; return; }
        if (hipFuncSetAttribute((const void*)mk_fwd, hipFuncAttributeMaxDynamicSharedMemorySize, LDS_BYTES) != hipSuccess) { fprintf(stderr, "kernel_launch: hipFuncSetAttribute failed\n"); grid = -1; return; }
        if (hipOccupancyMaxActiveBlocksPerMultiprocessor(&per_cu, (const void*)mk_fwd, NTHR, LDS_BYTES) != hipSuccess || per_cu < 1) fprintf(stderr, "kernel_launch: occupancy query says %d\n", per_cu);
        (void)hipGetLastError();
        grid = cus;
    }
    if (grid < 0) return;
    (void)hipMemsetAsync((char*)d_ws + WS_CTL, 0, CTL_ZERO_BYTES, stream);
    Args a{};
    for (int i = 0; i < 38; ++i) a.in[i] = (const float*)d_in[i];
    a.out = (float*)d_out; a.ws = (unsigned char*)d_ws;
#if MK_LAUNCHES == 1
    a.ph_lo = 0; a.ph_hi = NPHASE;
    hipLaunchKernelGGL(mk_fwd, dim3(grid), dim3(NTHR), LDS_BYTES, stream, a);
#else
    for (int p = 0; p < NPHASE; ++p) { a.ph_lo = p; a.ph_hi = p + 1; hipLaunchKernelGGL(mk_fwd, dim3(grid), dim3(NTHR), LDS_BYTES, stream, a); }
#endif
}
```

```cpp
#include <hip/hip_runtime.h>
#include <cstdio>
#include <cstdint>

#define GAS __attribute__((address_space(1)))
#define LAS __attribute__((address_space(3)))
typedef unsigned short bf16_t;
typedef short bf16x8 __attribute__((ext_vector_type(8)));
typedef float f32x4 __attribute__((ext_vector_type(4)));
typedef float f32x2 __attribute__((ext_vector_type(2)));
typedef unsigned u32x4 __attribute__((ext_vector_type(4)));
typedef unsigned u32x2 __attribute__((ext_vector_type(2)));

#ifndef PROBE_PH
#define PROBE_PH -1
#endif
#ifndef MK_LAUNCHES
#define MK_LAUNCHES 1
#endif

constexpr int DM = 2048, NB = 8, SEQ = 2048, CTX = 256, GW = 64;
constexpr int MTOK = NB * SEQ;
constexpr int MCTX = NB * CTX;
constexpr int MALL = MTOK + MCTX;
constexpr int NH = 4, HD = 256, MW = 1024, HW = 1024;
constexpr int N_IN = 10256;
constexpr int NEXP = 32, TOPK = 4;
constexpr float LN_EPS = 1e-5f;
constexpr float DN_ALPHA = 1.189207115002721f;
constexpr int ZN = 7424, ZC_QK = 0, ZC_V = 1024, ZC_O = 2048, ZC_GA = 3072, ZC_GH = 5120, ZC_GT = 7168;
constexpr int WIN_ROWS = 10496, WIN_HY0 = 7424;
constexpr int MAXTILES = 288;
constexpr int POSCAP = 16384;

constexpr size_t MiB = 1u << 20;
constexpr size_t WS_CTL = 0;
constexpr size_t WS_MODP = 1203 * MiB;
constexpr size_t WS_MOD = 9 * MiB;
constexpr size_t WS_BINP = 10 * MiB;
constexpr size_t WS_A3 = 10 * MiB + 64 * 1024;
constexpr size_t WS_STATS = 11 * MiB;
constexpr size_t WS_TOPE = 11 * MiB + 256 * 1024;
constexpr size_t WS_TOPP = 11 * MiB + 512 * 1024;
constexpr size_t WS_TOPW = 11 * MiB + 768 * 1024;
constexpr size_t WS_RTOK = 12 * MiB;
constexpr size_t WS_RW = 14 * MiB;
constexpr size_t WS_WQK = 16 * MiB;
constexpr size_t WS_WPH = 17 * MiB;
constexpr size_t WS_WPA2 = 21 * MiB;
constexpr size_t WS_WOUT = 29 * MiB;
constexpr size_t WS_WIN = 37 * MiB;
constexpr size_t WS_WGU = 78 * MiB;
constexpr size_t WS_WD = 590 * MiB;
constexpr size_t WS_RA = 846 * MiB;
constexpr size_t WS_Z = WS_RA, WS_ZT = WS_RA + 261 * MiB, WS_ACT = WS_RA;
constexpr size_t WS_RB = 1203 * MiB;
constexpr size_t WS_HX = WS_RB, WS_U = WS_RB + 72 * MiB, WS_QKB = WS_RB + 108 * MiB, WS_AM = WS_RB + 180 * MiB, WS_HH = WS_RB + 244 * MiB, WS_MX = WS_RB + 276 * MiB, WS_YR = WS_RB;
constexpr size_t WS_RC = 1543 * MiB;
constexpr size_t WS_HTAPS = WS_RC, WS_H = WS_RC + 32 * MiB, WS_T = WS_RC;
constexpr size_t WS_R1 = 1671 * MiB;
constexpr size_t WS_TOK = 1799 * MiB;
constexpr size_t WS_HX8 = WS_RC + 96 * MiB;
constexpr size_t WS_WIN8 = 1863 * MiB;
constexpr size_t WS_DUMMY = 1884 * MiB;
constexpr size_t WS_END = 1890 * MiB;
constexpr int CW_TMO = 0, CW_BAR = 4096, CW_CNT = 16384;
constexpr size_t CTL_ZERO_BYTES = 1 * MiB;

constexpr int LDS_BYTES = 160 * 1024 - 2048;
constexpr int MISC_OFF = LDS_BYTES - 1024;
constexpr int NWAVES = 8, NTHR = 512;

#define LDS_WAIT() asm volatile("s_waitcnt lgkmcnt(0)" ::: "memory")
#define VM_WAIT() asm volatile("s_waitcnt vmcnt(0)" ::: "memory")
__device__ __forceinline__ unsigned f2bf(float f) { unsigned u = __builtin_bit_cast(unsigned, f); return (u + 0x7fffu + ((u >> 16) & 1u)) >> 16; }
__device__ __forceinline__ unsigned pk2(float lo, float hi) { unsigned r; asm("v_cvt_pk_bf16_f32 %0, %1, %2" : "=v"(r) : "v"(lo), "v"(hi)); return r; }
__device__ __forceinline__ unsigned pk4_fp8(float a, float b, float c, float d) { int w = 0; w = __builtin_amdgcn_cvt_pk_fp8_f32(a, b, w, false); w = __builtin_amdgcn_cvt_pk_fp8_f32(c, d, w, true); return (unsigned)w; }
__device__ __forceinline__ float bf2f(unsigned b) { return __builtin_bit_cast(float, b << 16); }
__device__ __forceinline__ float bflo(unsigned w) { return __builtin_bit_cast(float, w << 16); }
__device__ __forceinline__ float bfhi(unsigned w) { return __builtin_bit_cast(float, w & 0xffff0000u); }
__device__ __forceinline__ float sigmoidf_(float x) { return 1.0f / (1.0f + __expf(-x)); }
__device__ __forceinline__ float sigmoid_fast(float x) { return __builtin_amdgcn_rcpf(1.0f + __expf(-x)); }
__device__ __forceinline__ float wave_sum(float v) {
#pragma unroll
    for (int o = 1; o < 64; o <<= 1) v += __shfl_xor(v, o);
    return v;
}

#define DPP_STEP_(OP, x, ctrl, rmask, bmask, ident) { const float t_ = __builtin_bit_cast(float, __builtin_amdgcn_update_dpp(__builtin_bit_cast(int, ident), __builtin_bit_cast(int, x), ctrl, rmask, bmask, false)); x = OP(x, t_); }
__device__ __forceinline__ float scan_add_(float a, float b) { return a + b; }
__device__ __forceinline__ float wave_scan_sum(float v) {
    float x = v; const float z = 0.f;
    { const float t1 = __builtin_bit_cast(float, __builtin_amdgcn_update_dpp(0, __builtin_bit_cast(int, v), 0x111, 0xf, 0xf, false));
      const float t2 = __builtin_bit_cast(float, __builtin_amdgcn_update_dpp(0, __builtin_bit_cast(int, v), 0x112, 0xf, 0xf, false));
      const float t3 = __builtin_bit_cast(float, __builtin_amdgcn_update_dpp(0, __builtin_bit_cast(int, v), 0x113, 0xf, 0xf, false));
      x = (v + t1) + (t2 + t3); }
    DPP_STEP_(scan_add_, x, 0x114, 0xf, 0xe, z)
    DPP_STEP_(scan_add_, x, 0x118, 0xf, 0xc, z)
    DPP_STEP_(scan_add_, x, 0x142, 0xa, 0xf, z)
    DPP_STEP_(scan_add_, x, 0x143, 0xc, 0xf, z)
    return x;
}
__device__ __forceinline__ float wave_scan_max(float v) {
    float x = v; const float ninf = -__builtin_inff(); const int ni = __builtin_bit_cast(int, ninf);
    { const float t1 = __builtin_bit_cast(float, __builtin_amdgcn_update_dpp(ni, __builtin_bit_cast(int, v), 0x111, 0xf, 0xf, false));
      const float t2 = __builtin_bit_cast(float, __builtin_amdgcn_update_dpp(ni, __builtin_bit_cast(int, v), 0x112, 0xf, 0xf, false));
      const float t3 = __builtin_bit_cast(float, __builtin_amdgcn_update_dpp(ni, __builtin_bit_cast(int, v), 0x113, 0xf, 0xf, false));
      x = fmaxf(fmaxf(v, t1), fmaxf(t2, t3)); }
    DPP_STEP_(fmaxf, x, 0x114, 0xf, 0xe, ninf)
    DPP_STEP_(fmaxf, x, 0x118, 0xf, 0xc, ninf)
    DPP_STEP_(fmaxf, x, 0x142, 0xa, 0xf, ninf)
    DPP_STEP_(fmaxf, x, 0x143, 0xc, 0xf, ninf)
    return x;
}
__device__ __forceinline__ float lane_bcast(float v, int l) { return __builtin_bit_cast(float, __builtin_amdgcn_readlane(__builtin_bit_cast(int, v), l)); }
#define XB_TMO      128
#define XB_XCNT(j)  (256  + 64 * (j))
#define XB_XSUB(j)  (1280 + 64 * (j))
#define XB_XGEN(j)  (2304 + 64 * (j))
#define XB_TOP      3328
#define XB_TOPGEN   3392
#define XCD_BAR_WORDS 3456
#define XB_SPIN_CAP (1u << 22)
__device__ __forceinline__ unsigned xb_ld(unsigned* p)              { return __hip_atomic_load(p, __ATOMIC_RELAXED, __HIP_MEMORY_SCOPE_AGENT); }
__device__ __forceinline__ unsigned xb_add(unsigned* p, unsigned v) { return __hip_atomic_fetch_add(p, v, __ATOMIC_RELAXED, __HIP_MEMORY_SCOPE_AGENT); }
__device__ __forceinline__ unsigned xb_xcc_id() { return (unsigned)__builtin_amdgcn_s_getreg((3 << 11) | 20) & 0xFu; }
#define XB_SPIN(cond, bar) do { unsigned _sp = 0; while (cond) { __builtin_amdgcn_s_sleep(1); \
    if ((++_sp & 255u) == 0u) { if (xb_ld(&(bar)[XB_TMO])) break; if (_sp > XB_SPIN_CAP) { atomicAdd(&(bar)[XB_TMO], 1u); break; } } } } while (0)
struct XcdBarrier { unsigned* bar; unsigned x; volatile LAS unsigned* st; };
__device__ __forceinline__ XcdBarrier xcd_barrier_post(unsigned* bar, volatile LAS unsigned* st, int tid) {
    XcdBarrier b; b.bar = bar; b.x = xb_xcc_id(); b.st = st;
    if (tid == 0) (void)xb_add(&bar[XB_XCNT(b.x)], 1u);
    return b;
}
__device__ __forceinline__ void xcd_barrier_complete(unsigned* bar, unsigned x, unsigned& nloc, unsigned& nx) {
    const unsigned G = gridDim.x * gridDim.y * gridDim.z;
    unsigned sum, cnt, mine, sp = 0u;
    for (;;) {
        sum = 0u; cnt = 0u; mine = 0u;
#pragma unroll
        for (unsigned j = 0; j < 16; ++j) { const unsigned c = xb_ld(&bar[XB_XCNT(j)]); sum += c; cnt += (c > 0u) ? 1u : 0u; mine = (j == x) ? c : mine; }
        if (sum == G) break;
        __builtin_amdgcn_s_sleep(1);
        if ((++sp & 255u) == 0u) { if (xb_ld(&bar[XB_TMO])) break; if (sp > XB_SPIN_CAP) { atomicAdd(&bar[XB_TMO], 1u); break; } }
    }
    nloc = mine > 0u ? mine : 1u; nx = cnt > 0u ? cnt : 1u;
}
__device__ __forceinline__ void xcd_barrier(const XcdBarrier& b, int tid) {
    asm volatile("s_waitcnt vmcnt(0)" ::: "memory");
    __syncthreads();
    if (tid == 0) {
        unsigned* bar = b.bar;
        __builtin_amdgcn_s_waitcnt(0);
        unsigned nloc = b.st[0], nx = b.st[1];
        if (nloc == 0u) { xcd_barrier_complete(bar, b.x, nloc, nx); b.st[0] = nloc; b.st[1] = nx; }
        const unsigned old = xb_add(&bar[XB_XSUB(b.x)], 1u);
        const unsigned gen = old / nloc;
        if (old + 1u == (gen + 1u) * nloc) {
            __builtin_amdgcn_fence(__ATOMIC_RELEASE, "agent");
            asm volatile("s_waitcnt vmcnt(0)" ::: "memory");
            const unsigned og = xb_add(&bar[XB_TOP], 1u);
            const unsigned tg = og / nx;
            if (og + 1u == (tg + 1u) * nx) xb_add(&bar[XB_TOPGEN], 1u);
            else XB_SPIN(xb_ld(&bar[XB_TOPGEN]) == tg, bar);
            __builtin_amdgcn_fence(__ATOMIC_ACQUIRE, "agent");
            xb_add(&bar[XB_XGEN(b.x)], 1u);
            asm volatile("s_waitcnt vmcnt(0)" ::: "memory");
        } else {
            XB_SPIN(xb_ld(&bar[XB_XGEN(b.x)]) == gen, bar);
            __builtin_amdgcn_fence(__ATOMIC_ACQUIRE, "agent");
            asm volatile("s_waitcnt vmcnt(0)" ::: "memory");
        }
    }
    __syncthreads();
}

struct Args {
    const float* in[38];
    float* out; unsigned char* ws;
    int ph_lo, ph_hi;
};
enum { I_X = 0, I_C, I_CTX, I_CCTX, I_LNG, I_LNB, I_WMOD, I_BMOD, I_WIN, I_BIN, I_MCW, I_MCB, I_WQH, I_WKH, I_HCW, I_HCB, I_FW1, I_FB1, I_FWH, I_FBH,
       I_FFREQ, I_FWOUT, I_HSKIP, I_WPA, I_WPH, I_WOUT, I_LN1G, I_LN1B, I_WR, I_BR, I_WG, I_BG, I_WU, I_BU, I_WDN, I_BDN, I_LN2G, I_LN2B };

namespace pg8 {
constexpr int BM = 256, BK = 64, HALF = 128, HTB = HALF * BK * 2, STAGE_BYTES = 8 * HTB, NXCD = 8, WGM = 8;
__host__ __device__ __forceinline__ int lds_byte(int r, int c) { const int st = (r >> 4) * 2 + (c >> 5), rr = r & 15, cc = c & 31, ob = rr * 64 + cc * 2; return st * 1024 + (ob ^ (((ob >> 9) & 1) << 5)); }
__host__ __device__ __forceinline__ void stage_rc(int b, int& R, int& C) { const int st = b / 1024, sb = b % 1024, swz = sb ^ (((sb >> 9) & 1) << 5); R = (st >> 1) * 16 + swz / 64; C = (st & 1) * 32 + (swz % 64) / 2; }
__host__ __device__ __forceinline__ int perm32(int rho) { const int n = rho >> 4, i = rho & 15; return 8 * (i >> 2) + 4 * n + (i & 3); }
struct Unit { int pm, pn, ex; };
__device__ __forceinline__ void decode_tile(int L, int nM, int nN, int& pm, int& pn) {
    const int nwg = nM * nN; int wgid = L;
    { const int q = nwg / NXCD, r = nwg % NXCD, xcd = wgid % NXCD, off = wgid / NXCD; wgid = (xcd < r ? xcd * (q + 1) : r * (q + 1) + (xcd - r) * q) + off; }
    const int nig = WGM * nN, gid = wgid / nig, fm = gid * WGM, gsz = (nM - fm) < WGM ? (nM - fm) : WGM;
    pm = fm + ((wgid % nig) % gsz); pn = (wgid % nig) / gsz;
}
__device__ __forceinline__ unsigned cvt_pk_bf16(float lo, float hi) { unsigned r; asm volatile("v_cvt_pk_bf16_f32 %0, %1, %2" : "=v"(r) : "v"(lo), "v"(hi)); return r; }

typedef int i32x8 __attribute__((ext_vector_type(8)));
template <class Epi, class Sched, bool F8 = false>
__device__ __forceinline__ void gemm_phase(const int tid, LAS unsigned char* lds, const int nt, const int pitchA, const int pitchB, const Sched& S, const Epi& E, const int wscale = 0x7F7F7F7F, const int ascale = 0x7F7F7F7F) {
    const int wid = __builtin_amdgcn_readfirstlane(tid >> 6), lane = tid & 63, wr = wid >> 2, wc = wid & 3, fr = lane & 15, fq = lane >> 4;
    int RA[2], CA[2]; unsigned voffB[2];
#pragma unroll
    for (int i = 0; i < 2; ++i) { int R, C; stage_rc(tid * 16 + i * 8192, R, C); const int Rb = Epi::PERM ? ((R & ~31) + perm32(R & 31)) : R;
        RA[i] = R; CA[i] = C; voffB[i] = (unsigned)(Rb * pitchB + C * 2); }
    const size_t kstep = (size_t)(BK * 2);
    const size_t hstepB = (size_t)HALF * pitchB;
    const unsigned ldsw = (unsigned)wid * 1024u;
    const int aoff = lds_byte(wr * 64 + fr, fq * 8), boff = lds_byte(wc * 32 + fr, fq * 8);
#define PG8_SA(b, h) (((b) * 2 + (h)) * HTB)
#define PG8_SB(b, h) ((4 + (b) * 2 + (h)) * HTB)
#define PG8_STAGE(bufoff, gbase, v0, v1) do { \
        __builtin_amdgcn_global_load_lds((const unsigned*)((const char*)(gbase) + (v0)), (LAS unsigned*)(lds + (bufoff) + ldsw), 16, 0, 0); \
        __builtin_amdgcn_global_load_lds((const unsigned*)((const char*)(gbase) + (v1)), (LAS unsigned*)(lds + (bufoff) + ldsw + 8192), 16, 0, 0); } while (0)
#define PG8_LD8(off) __builtin_bit_cast(i32x8, __builtin_shufflevector(*(const LAS u32x4*)(lds + (off)), *(const LAS u32x4*)(lds + (off) + 1024), 0, 1, 2, 3, 4, 5, 6, 7))
#define PG8_LDA(dst, b, h) do { _Pragma("unroll") for (int m = 0; m < 4; ++m) { if (F8) dst##8[m] = PG8_LD8(PG8_SA(b, h) + aoff + m * 2048); else { _Pragma("unroll") for (int k = 0; k < 2; ++k) dst[m][k] = *(const LAS bf16x8*)(lds + PG8_SA(b, h) + aoff + m * 2048 + k * 1024); } } } while (0)
#define PG8_LDB(dst, b, h) do { _Pragma("unroll") for (int n = 0; n < 2; ++n) { if (F8) dst##8[n] = PG8_LD8(PG8_SB(b, h) + boff + n * 2048); else { _Pragma("unroll") for (int k = 0; k < 2; ++k) dst[n][k] = *(const LAS bf16x8*)(lds + PG8_SB(b, h) + boff + n * 2048 + k * 1024); } } } while (0)
#define PG8_CAT(x) __builtin_shufflevector(__builtin_bit_cast(u32x4, x[0]), __builtin_bit_cast(u32x4, x[1]), 0, 1, 2, 3, 4, 5, 6, 7)
#define PG8_MMA(ai, bj, At, Bt) do { __builtin_amdgcn_s_setprio(1); _Pragma("unroll") for (int m = 0; m < 4; ++m) _Pragma("unroll") for (int n = 0; n < 2; ++n) { \
        if (F8) { asm volatile("v_mfma_scale_f32_16x16x128_f8f6f4 %0, %1, %2, %0, %3, %4 op_sel_hi:[0,0,0]" : "+v"(acc[ai][bj][m][n]) : "v"(Bt##8[n]), "v"(At##8[m]), "v"(wscale), "v"(ascale)); } \
        else { _Pragma("unroll") for (int k = 0; k < 2; ++k) acc[ai][bj][m][n] = __builtin_amdgcn_mfma_f32_16x16x32_bf16(Bt[n][k], At[m][k], acc[ai][bj][m][n], 0, 0, 0); } } __builtin_amdgcn_s_setprio(0); } while (0)
#define PG8_WAIT_V(n) asm volatile("s_waitcnt vmcnt(" #n ")" ::: "memory")
#define PG8_WAIT_L(n) asm volatile("s_waitcnt lgkmcnt(" #n ")" ::: "memory")
#define PG8_BAR __builtin_amdgcn_s_barrier()
#define PG8_SCHED __builtin_amdgcn_sched_barrier(0)
#define PG8_AOFF(u, o00, o01, o10, o11) do { \
        if (Sched::GATHER) { o00 = (unsigned)(S.a_row(u, RA[0]) * pitchA + CA[0] * 2); o01 = (unsigned)(S.a_row(u, RA[1]) * pitchA + CA[1] * 2); \
                             o10 = (unsigned)(S.a_row(u, RA[0] + HALF) * pitchA + CA[0] * 2); o11 = (unsigned)(S.a_row(u, RA[1] + HALF) * pitchA + CA[1] * 2); } \
        else { o00 = (unsigned)(RA[0] * pitchA + CA[0] * 2); o01 = (unsigned)(RA[1] * pitchA + CA[1] * 2); o10 = (unsigned)((RA[0] + HALF) * pitchA + CA[0] * 2); o11 = (unsigned)((RA[1] + HALF) * pitchA + CA[1] * 2); } } while (0)
    Unit cur, nxt; int ui = 0;
    if (!S.next(0, cur)) return;
    f32x4 acc[2][2][4][2];
#pragma unroll
    for (int a = 0; a < 2; ++a)
#pragma unroll
        for (int b = 0; b < 2; ++b)
#pragma unroll
            for (int m = 0; m < 4; ++m)
#pragma unroll
                for (int n = 0; n < 2; ++n) acc[a][b][m][n] = (f32x4){0.f, 0.f, 0.f, 0.f};
    bf16x8 At[4][2], B0[2][2], B1[2][2]; i32x8 At8[4], B08[2], B18[2];
    const char* cA = S.a_base(cur); const char* cB = S.b_base(cur);
    unsigned c00, c01, c10, c11; PG8_AOFF(cur, c00, c01, c10, c11);
    const unsigned vb0 = voffB[0], vb1 = voffB[1];
    PG8_STAGE(PG8_SB(0, 0), cB, vb0, vb1); PG8_STAGE(PG8_SA(0, 0), cA, c00, c01); PG8_STAGE(PG8_SB(0, 1), cB + hstepB, vb0, vb1); PG8_STAGE(PG8_SA(0, 1), cA, c10, c11);
    if (wr == 1) PG8_BAR;
    PG8_WAIT_V(4); PG8_BAR;
    PG8_STAGE(PG8_SB(1, 0), cB + kstep, vb0, vb1); PG8_STAGE(PG8_SA(1, 0), cA + kstep, c00, c01); PG8_STAGE(PG8_SB(1, 1), cB + hstepB + kstep, vb0, vb1);
    PG8_WAIT_V(6); PG8_BAR;
    for (;;) {
        const bool has_next = S.next(ui + 1, nxt);
        const char* nA = has_next ? S.a_base(nxt) : cA; const char* nB = has_next ? S.b_base(nxt) : cB;
        unsigned n00 = c00, n01 = c01, n10 = c10, n11 = c11;
        if (has_next) PG8_AOFF(nxt, n00, n01, n10, n11);
        for (int t = 0; t < nt; t += 2) {
            const bool last = (t == nt - 2);
            const char* a1 = cA + (size_t)(t + 1) * kstep;
            const char* a2 = last ? nA : cA + (size_t)(t + 2) * kstep; const char* b2 = last ? nB : cB + (size_t)(t + 2) * kstep;
            const char* a3 = a2 + kstep; const char* b3 = b2 + kstep;
            const unsigned x00 = last ? n00 : c00, x01 = last ? n01 : c01, x10 = last ? n10 : c10, x11 = last ? n11 : c11;
            PG8_LDB(B0, 0, 0); PG8_SCHED; PG8_LDA(At, 0, 0); PG8_STAGE(PG8_SA(1, 1), a1, c10, c11);
            PG8_WAIT_L(8); PG8_BAR; PG8_WAIT_L(0); PG8_MMA(0, 0, At, B0); PG8_BAR; PG8_SCHED;
            PG8_LDB(B1, 0, 1); PG8_STAGE(PG8_SB(0, 0), b2, vb0, vb1);
            PG8_BAR; PG8_WAIT_L(0); PG8_MMA(0, 1, At, B1); PG8_BAR;
            PG8_LDA(At, 0, 1); PG8_STAGE(PG8_SA(0, 0), a2, x00, x01);
            PG8_BAR; PG8_WAIT_L(0); PG8_MMA(1, 0, At, B0); PG8_BAR; PG8_SCHED;
            PG8_STAGE(PG8_SB(0, 1), b2 + hstepB, vb0, vb1);
            PG8_WAIT_V(6); PG8_BAR; PG8_MMA(1, 1, At, B1); PG8_BAR;
            PG8_LDB(B0, 1, 0); PG8_SCHED; PG8_LDA(At, 1, 0); PG8_STAGE(PG8_SA(0, 1), a2, x10, x11);
            PG8_WAIT_L(8); PG8_BAR; PG8_WAIT_L(0); PG8_MMA(0, 0, At, B0); PG8_BAR; PG8_SCHED;
            PG8_LDB(B1, 1, 1); PG8_STAGE(PG8_SB(1, 0), b3, vb0, vb1);
            PG8_BAR; PG8_WAIT_L(0); PG8_MMA(0, 1, At, B1); PG8_BAR;
            PG8_LDA(At, 1, 1); PG8_STAGE(PG8_SA(1, 0), a3, x00, x01);
            PG8_BAR; PG8_WAIT_L(0); PG8_MMA(1, 0, At, B0); PG8_BAR; PG8_SCHED;
            PG8_STAGE(PG8_SB(1, 1), b3 + hstepB, vb0, vb1);
            PG8_WAIT_V(6); PG8_BAR; PG8_MMA(1, 1, At, B1); PG8_BAR;
        }
        if (F8) asm volatile("s_nop 15\n\ts_nop 15" ::: "memory");
        E(acc, cur, wr, wc, fr, fq);
        if (!has_next) break;
#pragma unroll
        for (int a = 0; a < 2; ++a)
#pragma unroll
            for (int b = 0; b < 2; ++b)
#pragma unroll
                for (int m = 0; m < 4; ++m)
#pragma unroll
                    for (int n = 0; n < 2; ++n) acc[a][b][m][n] = (f32x4){0.f, 0.f, 0.f, 0.f};
        cur = nxt; cA = nA; cB = nB; c00 = n00; c01 = n01; c10 = n10; c11 = n11; ++ui;
    }
    PG8_WAIT_V(0);
    if (wr == 0) PG8_BAR;
    PG8_BAR;
#undef PG8_SA
#undef PG8_SB
#undef PG8_STAGE
#undef PG8_LDA
#undef PG8_LDB
#undef PG8_MMA
#undef PG8_WAIT_V
#undef PG8_WAIT_L
#undef PG8_BAR
#undef PG8_SCHED
#undef PG8_AOFF
#undef PG8_CAT
#undef PG8_LD8
}
}
using pg8::Unit;

typedef const float* cfp_t;
typedef __attribute__((address_space(4))) const cfp_t* KargP;
__device__ __forceinline__ KargP karg_opaque(KargP p) { asm volatile("" : "+s"(p)); return p; }
struct Frame {
    LAS unsigned char* lds;
    volatile LAS unsigned* MISC;
    unsigned* ctl;
    int tid, lane, wave, wave0, G, bid;
    KargP in;
    float* out; unsigned char* ws;
};
#define WSP(T, off) ((T*)(F.ws + (off)))

__device__ __forceinline__ void transpose_item(const float* src, size_t ld, int nvalid, float scale, bf16_t* dst, int K, LAS float* scr, int lane) {
    { float tv[32]; const int j = lane & 31;
#pragma unroll
      for (int i = 0; i < 32; ++i) tv[i] = (j < nvalid) ? src[(size_t)(2 * i + (lane >> 5)) * ld + j] : 0.f;
#pragma unroll
      for (int i = 0; i < 32; ++i) scr[(2 * i + (lane >> 5)) * 33 + j] = tv[i] * scale; }
    LDS_WAIT(); asm volatile("" ::: "memory");
    const int c = lane & 7;
#pragma unroll
    for (int j = 0; j < 4; ++j) { const int n = (lane >> 3) + 8 * j; const LAS float* s = scr + (8 * c) * 33 + n;
        u32x4 o; o.x = pk2(s[0 * 33], s[1 * 33]); o.y = pk2(s[2 * 33], s[3 * 33]); o.z = pk2(s[4 * 33], s[5 * 33]); o.w = pk2(s[6 * 33], s[7 * 33]);
        *(u32x4*)(dst + (size_t)n * K + 8 * c) = o; }
    LDS_WAIT(); asm volatile("" ::: "memory");
}
struct CvItem { const float* src; unsigned char* dst; float scale; int rstep; };
__device__ __forceinline__ CvItem cv_decode(KargP in, unsigned char* ws, int it) {
    CvItem c;
    if (it < NEXP * 256) { const int e = it >> 8, q = it & 255, up = q & 1, g = (q >> 1) & 7, kb = q >> 4;
        c.src = (up ? in[I_WU] : in[I_WG]) + (size_t)e * DM * DM + (size_t)(128 * kb) * DM + 256 * g;
        c.dst = ws + WS_WGU + ((size_t)e * 4096 + 512 * g + up * 128) * DM + 128 * kb; c.scale = 32.f; c.rstep = 256; }
    else { const int r2 = it - NEXP * 256; const int e = r2 >> 7, q = r2 & 127, g = q & 7, kb = q >> 3;
        c.src = in[I_WDN] + (size_t)e * DM * DM + (size_t)(128 * kb) * DM + 256 * g;
        c.dst = ws + WS_WD + ((size_t)e * 2048 + 256 * g) * DM + 128 * kb; c.scale = 64.f; c.rstep = 128; }
    return c;
}
constexpr int CV_E8X = 8, CV_P0N = 3;
__device__ __forceinline__ int cv_map(int i) { constexpr int n1 = CV_P0N * 256; return i < n1 ? CV_E8X * 256 + i : NEXP * 256 + CV_E8X * 128 + (i - n1); }
#define CV_LOAD(v, c) do { _Pragma("unroll") for (int i_ = 0; i_ < 16; ++i_) v[i_] = __builtin_nontemporal_load((const f32x4*)((c).src + (size_t)(16 * w + i_) * DM + 4 * lane)); } while (0)
#define CV_PROC(v, c) do { \
        _Pragma("unroll") for (int j_ = 0; j_ < 4; ++j_) { u32x4 o_; const float s_ = (c).scale; \
            o_.x = pk4_fp8(v[0][j_] * s_, v[1][j_] * s_, v[2][j_] * s_, v[3][j_] * s_);     o_.y = pk4_fp8(v[4][j_] * s_, v[5][j_] * s_, v[6][j_] * s_, v[7][j_] * s_); \
            o_.z = pk4_fp8(v[8][j_] * s_, v[9][j_] * s_, v[10][j_] * s_, v[11][j_] * s_);   o_.w = pk4_fp8(v[12][j_] * s_, v[13][j_] * s_, v[14][j_] * s_, v[15][j_] * s_); \
            *(LAS u32x4*)(tile + (4 * lane + j_) * 144 + 16 * w) = o_; } \
        __syncthreads(); \
        _Pragma("unroll") for (int q_ = 0; q_ < 4; ++q_) { const int idx_ = tid + 512 * q_, row_ = idx_ >> 3, piece_ = idx_ & 7; \
            *(u32x4*)((c).dst + (size_t)((row_ >> 7) * (c).rstep + (row_ & 127)) * DM + 16 * piece_) = *(const LAS u32x4*)(tile + row_ * 144 + 16 * piece_); } \
        __syncthreads(); } while (0)
__device__ __forceinline__ void convert_moe_weights(KargP in, unsigned char* ws, LAS unsigned char* tile, int tid, int bid, int G) {
    const int w = tid >> 6, lane = tid & 63;
    constexpr int NIT = CV_P0N * (256 + 128);
    f32x4 va[16], vb[16];
    int it = bid;
    if (it >= NIT) return;
    CvItem ca = cv_decode(in, ws, cv_map(it)), cb = ca;
    CV_LOAD(va, ca);
    for (;;) {
        const bool hb = it + G < NIT;
        if (hb) { cb = cv_decode(in, ws, cv_map(it + G)); CV_LOAD(vb, cb); }
        CV_PROC(va, ca);
        if (!hb) break;
        it += G;
        const bool ha = it + G < NIT;
        if (ha) { ca = cv_decode(in, ws, cv_map(it + G)); CV_LOAD(va, ca); }
        CV_PROC(vb, cb);
        if (!ha) break;
        it += G;
    }
}
#undef CV_LOAD
#undef CV_PROC
__device__ __forceinline__ void transpose_item_f8(const float* src, size_t ld, float scale, unsigned char* dst, int K, LAS float* scr, int lane) {
    { float tv[32]; const int j = lane & 31;
#pragma unroll
      for (int i = 0; i < 32; ++i) tv[i] = src[(size_t)(2 * i + (lane >> 5)) * ld + j];
#pragma unroll
      for (int i = 0; i < 32; ++i) scr[(2 * i + (lane >> 5)) * 33 + j] = tv[i] * scale; }
    LDS_WAIT(); asm volatile("" ::: "memory");
    const int c = lane & 3;
#pragma unroll
    for (int j = 0; j < 2; ++j) { const int n = (lane >> 2) + 16 * j; const LAS float* s = scr + (16 * c) * 33 + n;
        u32x4 o; o.x = pk4_fp8(s[0 * 33], s[1 * 33], s[2 * 33], s[3 * 33]); o.y = pk4_fp8(s[4 * 33], s[5 * 33], s[6 * 33], s[7 * 33]);
        o.z = pk4_fp8(s[8 * 33], s[9 * 33], s[10 * 33], s[11 * 33]); o.w = pk4_fp8(s[12 * 33], s[13 * 33], s[14 * 33], s[15 * 33]);
        *(u32x4*)(dst + (size_t)n * K + 16 * c) = o; }
    LDS_WAIT(); asm volatile("" ::: "memory");
}
__device__ __forceinline__ void p0_phase(Frame& F) {
    const KargP in = karg_opaque(F.in);
    LAS float* scr = (LAS float*)(F.lds + F.wave * 16384);
    const int gw = F.bid * NWAVES + F.wave, NGW = F.G * NWAVES;
    constexpr int IT_WIN = 32 * (WIN_ROWS / 32);
    constexpr int IT_WQK = 4 * 64;
    constexpr int IT_WPA2 = 32 * 64;
    constexpr int IT_WPH = 16 * 64;
    constexpr int IT_WOUT = 32 * 64;
    constexpr int NITEMS = IT_WIN + IT_WQK + IT_WPA2 + IT_WPH + IT_WOUT;
    for (int it = gw; it < NITEMS; it += NGW) {
        int r = it;
        if (r < IT_WIN) { const int g = r % (WIN_ROWS / 32), kb = r / (WIN_ROWS / 32); const int n0 = 32 * g; int sc, nv = 32;
            if (n0 < 2048) sc = n0; else if (n0 < 3072) sc = 2064 + (n0 - 2048); else if (n0 < 7168) sc = 6160 + (n0 - 3072); else if (n0 < 7200) { sc = 2048; nv = 16; } else if (n0 < WIN_HY0) { sc = 0; nv = 0; } else sc = 3088 + (n0 - WIN_HY0);
            if (n0 < 2048 || (n0 >= 7168 && n0 < WIN_HY0)) transpose_item(in[I_WIN] + (size_t)(64 * kb) * N_IN + sc, N_IN, nv, 1.f, WSP(bf16_t, WS_WIN) + (size_t)n0 * DM + 64 * kb, DM, scr, F.lane);
            if (n0 >= 1024 && !(n0 >= 7168 && n0 < WIN_HY0)) transpose_item_f8(in[I_WIN] + (size_t)(64 * kb) * N_IN + sc, N_IN, 32.f, WSP(unsigned char, WS_WIN8) + (size_t)n0 * DM + 64 * kb, DM, scr, F.lane);
            continue; } r -= IT_WIN;
        if (r < IT_WQK) { const int g = r % 64, kb = r / 64; const int n0 = 32 * g, h = n0 / 512, j = (n0 % 512) / 256, e0 = n0 % 256;
            const float* src = (j ? in[I_WKH] : in[I_WQH]) + (size_t)h * 65536 + (size_t)(64 * kb) * 256 + e0;
            transpose_item(src, 256, 32, j ? 0.0625f : 1.f, WSP(bf16_t, WS_WQK) + (size_t)n0 * 256 + 64 * kb, 256, scr, F.lane); continue; } r -= IT_WQK;
        if (r < IT_WPA2) { const int g = r % 64, kb = r / 64; const int n0 = 32 * g, k0 = 64 * kb;
            transpose_item_f8(in[I_WPA] + (size_t)(k0 % 1024) * DM + n0, DM, 32.f, WSP(unsigned char, WS_WPA2) + (size_t)n0 * 2048 + k0, 2048, scr, F.lane); continue; } r -= IT_WPA2;
        if (r < IT_WPH) { const int g = r % 64, kb = r / 64; const int n0 = 32 * g, k0 = 64 * kb;
            transpose_item_f8(in[I_WPH] + (size_t)k0 * DM + n0, DM, 32.f, WSP(unsigned char, WS_WPH) + (size_t)n0 * 1024 + k0, 1024, scr, F.lane); continue; } r -= IT_WPH;
        if (r < IT_WOUT) { const int g = r % 64, kb = r / 64; const int n0 = 32 * g, k0 = 64 * kb;
            transpose_item_f8(in[I_WOUT] + (size_t)k0 * DM + n0, DM, 64.f, WSP(unsigned char, WS_WOUT) + (size_t)n0 * 2048 + k0, 2048, scr, F.lane); continue; } r -= IT_WOUT;
        (void)r;
    }
    __syncthreads();
    convert_moe_weights(in, F.ws, (LAS unsigned char*)F.lds, F.tid, F.bid, F.G);
    for (int i = F.bid * NTHR + F.tid; i < WIN_ROWS; i += F.G * NTHR) { int sc = -1;
        if (i < 2048) sc = i; else if (i < 3072) sc = 2064 + (i - 2048); else if (i < 7168) sc = 6160 + (i - 3072); else if (i < 7184) sc = 2048 + (i - 7168); else if (i < WIN_HY0) sc = -1; else sc = 3088 + (i - WIN_HY0);
        WSP(float, WS_BINP)[i] = sc >= 0 ? in[I_BIN][sc] : 0.f; }
    for (int it = F.bid + F.G * F.wave; it < 32 * 48; it += F.G * NWAVES) {
        const int ks = it / 48, cg = it % 48; const int col = cg * 256 + F.lane * 4, k0 = ks * 64;
#pragma unroll
        for (int v = 0; v < 9; ++v) { const float cv = (v < 8) ? in[I_C][v * DM + k0 + F.lane] : in[I_CCTX][k0 + F.lane]; scr[v * 64 + F.lane] = cv * sigmoidf_(cv); }
        LDS_WAIT(); asm volatile("" ::: "memory");
        f32x4 a[9];
#pragma unroll
        for (int v = 0; v < 9; ++v) a[v] = (f32x4){0.f, 0.f, 0.f, 0.f};
#pragma unroll 1
        for (int kb = 0; kb < 64; kb += 16) {
            f32x4 w[16];
#pragma unroll
            for (int i = 0; i < 16; ++i) w[i] = *(const f32x4*)(in[I_WMOD] + (size_t)(k0 + kb + i) * 12288 + col);
#pragma unroll
            for (int v = 0; v < 9; ++v)
#pragma unroll
                for (int q = 0; q < 4; ++q) { const f32x4 s4 = *(const LAS f32x4*)(scr + v * 64 + kb + 4 * q);
                    a[v] += w[4 * q] * s4.x; a[v] += w[4 * q + 1] * s4.y; a[v] += w[4 * q + 2] * s4.z; a[v] += w[4 * q + 3] * s4.w; }
        }
#pragma unroll
        for (int v = 0; v < 9; ++v) *(f32x4*)(WSP(float, WS_MODP) + ((size_t)ks * 9 + v) * 12288 + col) = a[v];
        LDS_WAIT(); asm volatile("" ::: "memory");
    }
    for (int j = gw; j < SEQ; j += NGW) {
        const int l = F.lane;
        float zv = 0.f;
        if (l == 0) zv = (float)j / (float)(SEQ - 1);
        else if (l < 33) { const int bi = (l - 1) & 15; const float f = 1e-4f + (float)bi * ((15.0f - 1e-4f) / 15.0f); const float ang = 6.283185307179586f * (float)j * f / (float)SEQ; zv = (l < 17) ? cosf(ang) : -sinf(ang); }
        float pre = in[I_FB1][l];
        for (int i = 0; i < 33; ++i) pre += __shfl(zv, i) * in[I_FW1][i * 64 + l];
        float a = sinf(in[I_FFREQ][l] * pre);
        pre = in[I_FBH][l];
        for (int i = 0; i < 64; ++i) pre += __shfl(a, i) * in[I_FWH][i * 64 + l];
        float a2 = sinf(in[I_FFREQ][64 + l] * pre);
        pre = in[I_FBH][64 + l];
        for (int i = 0; i < 64; ++i) pre += __shfl(a2, i) * in[I_FWH][4096 + i * 64 + l];
        WSP(float, WS_A3)[j * 64 + l] = sinf(in[I_FFREQ][128 + l] * pre);
    }
}

__device__ __forceinline__ void p0b_phase(Frame& F) {
    const KargP in = karg_opaque(F.in);
    for (int i = F.bid * NTHR + F.tid; i < 9 * 12288; i += F.G * NTHR) { const int col = i % 12288; float s = in[I_BMOD][col];
        for (int ks = 0; ks < 32; ++ks) s += WSP(float, WS_MODP)[(size_t)ks * 9 * 12288 + i];
        WSP(float, WS_MOD)[i] = s; }
    LAS float* wl = (LAS float*)F.lds;
    for (int un = F.bid; un < 256; un += F.G) {
        const int ct = un >> 2, pg = un & 3;
        __syncthreads();
        for (int q = 0; q < 8; ++q) { const int idx = F.tid + 512 * q, i = idx >> 6, cc = idx & 63; wl[cc * 68 + i] = in[I_FWOUT][(size_t)i * 4096 + ct * 64 + cc]; }
        __syncthreads();
        const int l15 = F.lane & 15, g4 = F.lane >> 4, j0 = pg * 512 + F.wave * 64;
#define HT_SPLIT(x0, x1, hi, lo) do { u32x4 h_, l_; \
            h_.x = pk2((x0).x, (x0).y); h_.y = pk2((x0).z, (x0).w); h_.z = pk2((x1).x, (x1).y); h_.w = pk2((x1).z, (x1).w); \
            l_.x = pk2((x0).x - bflo(h_.x), (x0).y - bfhi(h_.x)); l_.y = pk2((x0).z - bflo(h_.y), (x0).w - bfhi(h_.y)); \
            l_.z = pk2((x1).x - bflo(h_.z), (x1).y - bfhi(h_.z)); l_.w = pk2((x1).z - bflo(h_.w), (x1).w - bfhi(h_.w)); \
            hi = __builtin_bit_cast(bf16x8, h_); lo = __builtin_bit_cast(bf16x8, l_); } while (0)
        bf16x8 ah[4][2], al[4][2], bh[4][2], bl[4][2];
#pragma unroll
        for (int mt = 0; mt < 4; ++mt)
#pragma unroll
            for (int ks = 0; ks < 2; ++ks) { const float* p = WSP(float, WS_A3) + (size_t)(j0 + 16 * mt + l15) * 64 + 32 * ks + 8 * g4;
                const f32x4 x0 = *(const f32x4*)p, x1 = *(const f32x4*)(p + 4); HT_SPLIT(x0, x1, ah[mt][ks], al[mt][ks]); }
#pragma unroll
        for (int nt = 0; nt < 4; ++nt)
#pragma unroll
            for (int ks = 0; ks < 2; ++ks) { const LAS float* p = wl + (16 * nt + l15) * 68 + 32 * ks + 8 * g4;
                const f32x4 x0 = *(const LAS f32x4*)p, x1 = *(const LAS f32x4*)(p + 4); HT_SPLIT(x0, x1, bh[nt][ks], bl[nt][ks]); }
#undef HT_SPLIT
        const float mind = -3.0701134573253944f, maxd = -15.350567286626972f;
        const int cbase = (ct * 64) & 1023;
#pragma unroll
        for (int nt = 0; nt < 4; ++nt) {
            const int cc = 16 * nt + l15;
            const float delta = fabsf(mind + (float)(cbase + cc) * ((maxd - mind) / 1023.0f));
            float* colp = WSP(float, WS_HTAPS) + (size_t)(ct * 64 + cc) * SEQ;
#pragma unroll
            for (int mt = 0; mt < 4; ++mt) {
                f32x4 acc = (f32x4){0.f, 0.f, 0.f, 0.f};
#pragma unroll
                for (int ks = 0; ks < 2; ++ks) {
                    acc = __builtin_amdgcn_mfma_f32_16x16x32_bf16(ah[mt][ks], bh[nt][ks], acc, 0, 0, 0);
                    acc = __builtin_amdgcn_mfma_f32_16x16x32_bf16(ah[mt][ks], bl[nt][ks], acc, 0, 0, 0);
                    acc = __builtin_amdgcn_mfma_f32_16x16x32_bf16(al[mt][ks], bh[nt][ks], acc, 0, 0, 0); }
                const int j = j0 + 16 * mt + 4 * g4;
                f32x4 o;
#pragma unroll
                for (int r = 0; r < 4; ++r) o[r] = acc[r] * __expf(-((float)(j + r) / (float)(SEQ - 1)) * delta);
                *(f32x4*)(colp + j) = o;
            }
        }
    }
}

__device__ __forceinline__ f32x2 cmul(f32x2 a, f32x2 b) { return (f32x2){a.x * b.x - a.y * b.y, a.x * b.y + a.y * b.x}; }
__device__ __forceinline__ f32x2 cmulc(f32x2 a, f32x2 b) { return (f32x2){a.x * b.x + a.y * b.y, a.y * b.x - a.x * b.y}; }
__device__ __forceinline__ f32x2 cmulp(f32x2 a, f32x2 w, f32x2 iw) { return __builtin_elementwise_fma(a.yy, iw, a.xx * w); }
__device__ __forceinline__ f32x2 rot_i(f32x2 w) { return w.yx * (f32x2){-1.f, 1.f}; }
__device__ __forceinline__ f32x2 cmulq(f32x2 a, f32x2 b) { return cmulp(a, b, rot_i(b)); }
template <bool INV> __device__ __forceinline__ void dft4(f32x2& a, f32x2& b, f32x2& c, f32x2& d) {
    const f32x2 s0 = a + c, s1 = a - c, s2 = b + d, s3 = b - d;
    const f32x2 pm = (f32x2){1.f, -1.f}, mp = (f32x2){-1.f, 1.f};
    a = s0 + s2; c = s0 - s2;
    if (!INV) { b = __builtin_elementwise_fma(s3.yx, pm, s1); d = __builtin_elementwise_fma(s3.yx, mp, s1); }
    else      { b = __builtin_elementwise_fma(s3.yx, mp, s1); d = __builtin_elementwise_fma(s3.yx, pm, s1); }
}
template <bool INV> __device__ __forceinline__ void dft16(f32x2 (&v)[16]) {
#pragma unroll
    for (int n0 = 0; n0 < 4; ++n0) dft4<INV>(v[n0], v[4 + n0], v[8 + n0], v[12 + n0]);
    const float c1 = 0.9238795325112867f, s1 = 0.3826834323650898f, r2 = 0.7071067811865476f;
    const float cs[10] = {1.f, c1, r2, s1, 0.f, -s1, -r2, -c1, -1.f, -c1};
    const float sn[10] = {0.f, s1, r2, c1, 1.f, c1, r2, s1, 0.f, -s1};
#pragma unroll
    for (int k0 = 1; k0 < 4; ++k0)
#pragma unroll
        for (int n0 = 1; n0 < 4; ++n0) { const int m = n0 * k0; const f32x2 w = (f32x2){cs[m], INV ? sn[m] : -sn[m]}; v[4 * k0 + n0] = cmulp(v[4 * k0 + n0], w, (f32x2){-w.y, w.x}); }
#pragma unroll
    for (int k0 = 0; k0 < 4; ++k0) dft4<INV>(v[4 * k0], v[4 * k0 + 1], v[4 * k0 + 2], v[4 * k0 + 3]);
#pragma unroll
    for (int a = 0; a < 4; ++a)
#pragma unroll
        for (int b = a + 1; b < 4; ++b) { const f32x2 t = v[4 * a + b]; v[4 * a + b] = v[4 * b + a]; v[4 * b + a] = t; }
}
__device__ __forceinline__ int fphys(int i) { return i + (i >> 4); }
constexpr int FFT_BUF_BYTES = (4096 + 256) * 8;
struct FftTw { f32x2 wA, wB; };
__device__ __forceinline__ FftTw fft_tw(int ht) { FftTw t; float s, c; sincospif(-(float)ht / 2048.0f, &s, &c); t.wA = (f32x2){c, s}; sincospif(-(float)(ht & 15) / 128.0f, &s, &c); t.wB = (f32x2){c, s}; return t; }
template <bool CONJ> __device__ __forceinline__ void tw_apply(f32x2 (&v)[16], f32x2 w1) {
    if (CONJ) w1 = rot_i(w1).yx;
    const f32x2 w2 = cmulq(w1, w1), w3 = cmulq(w2, w1), w4 = cmulq(w2, w2), w5 = cmulq(w4, w1), w6 = cmulq(w4, w2), w7 = cmulq(w4, w3), w8 = cmulq(w4, w4);
    v[1] = cmulq(v[1], w1); v[2] = cmulq(v[2], w2); v[3] = cmulq(v[3], w3); v[4] = cmulq(v[4], w4); v[5] = cmulq(v[5], w5); v[6] = cmulq(v[6], w6); v[7] = cmulq(v[7], w7); v[8] = cmulq(v[8], w8);
    const f32x2 i8 = rot_i(w8);
    v[9] = cmulq(v[9], cmulp(w1, w8, i8)); v[10] = cmulq(v[10], cmulp(w2, w8, i8)); v[11] = cmulq(v[11], cmulp(w3, w8, i8)); v[12] = cmulq(v[12], cmulp(w4, w8, i8));
    v[13] = cmulq(v[13], cmulp(w5, w8, i8)); v[14] = cmulq(v[14], cmulp(w6, w8, i8)); v[15] = cmulq(v[15], cmulp(w7, w8, i8));
}
struct NoHook { template <int SET> __device__ __forceinline__ void act() {} };
struct NoPf { __device__ __forceinline__ void operator()() const {} };
template <int A0, int A1, class HK, class PF> __device__ __forceinline__ void fft_fwd(f32x2 (&v)[16], LAS f32x2* buf, int ht, const FftTw& tw_, HK& hk, const PF& pf) {
    FftTw tw = tw_; asm volatile("" : "+v"(ht), "+v"(tw.wA.x), "+v"(tw.wA.y), "+v"(tw.wB.x), "+v"(tw.wB.y));
    dft16<false>(v);
    tw_apply<false>(v, tw.wA);
#pragma unroll
    for (int k = 0; k < 16; ++k) buf[fphys(256 * k + ht)] = v[k];
    __syncthreads(); if (A0 >= 0) hk.template act<(A0 > 0)>();
    const int ka = ht >> 4, s = ht & 15;
#pragma unroll
    for (int b = 0; b < 16; ++b) v[b] = buf[fphys(256 * ka + 16 * b + s)];
    dft16<false>(v);
    tw_apply<false>(v, tw.wB);
#pragma unroll
    for (int k = 0; k < 16; ++k) buf[fphys(256 * ka + 16 * k + s)] = v[k];
    pf();
    __syncthreads(); if (A1 >= 0) hk.template act<(A1 > 0)>();
#pragma unroll
    for (int q = 0; q < 16; ++q) v[q] = buf[fphys(16 * ht + q)];
    dft16<false>(v);
}
template <int A0, int A1, int A2, class HK> __device__ __forceinline__ void fft_inv(f32x2 (&v)[16], LAS f32x2* buf, int ht, const FftTw& tw_, HK& hk) {
    FftTw tw = tw_; asm volatile("" : "+v"(ht), "+v"(tw.wA.x), "+v"(tw.wA.y), "+v"(tw.wB.x), "+v"(tw.wB.y));
    dft16<true>(v);
#pragma unroll
    for (int q = 0; q < 16; ++q) buf[fphys(16 * ht + q)] = v[q];
    __syncthreads(); if (A0 >= 0) hk.template act<(A0 > 0)>();
    const int ka = ht >> 4, s = ht & 15;
#pragma unroll
    for (int k = 0; k < 16; ++k) v[k] = buf[fphys(256 * ka + 16 * k + s)];
    tw_apply<true>(v, tw.wB);
    dft16<true>(v);
#pragma unroll
    for (int b = 0; b < 16; ++b) buf[fphys(256 * ka + 16 * b + s)] = v[b];
    __syncthreads(); if (A1 >= 0) hk.template act<(A1 > 0)>();
#pragma unroll
    for (int k = 0; k < 16; ++k) v[k] = buf[fphys(256 * k + ht)];
    tw_apply<true>(v, tw.wA);
    dft16<true>(v);
    __syncthreads(); if (A2 >= 0) hk.template act<(A2 > 0)>();
}

__device__ __forceinline__ void p1_phase(Frame& F) {
    const KargP in = karg_opaque(F.in);
    const int gw = F.bid * NWAVES + F.wave, NGW = F.G * NWAVES;
    const float* mod = WSP(float, WS_MOD);
    {
        f32x4 pg[8], pb[8];
#pragma unroll
        for (int j = 0; j < 8; ++j) { pg[j] = *(const f32x4*)(in[I_LNG] + F.lane * 4 + 256 * j); pb[j] = *(const f32x4*)(in[I_LNB] + F.lane * 4 + 256 * j); }
#pragma unroll 1
        for (int grp = gw; grp < MALL / 8; grp += NGW) {
            const int row0 = grp * 8; const bool lat = row0 < MTOK;
            const float* xb = lat ? in[I_X] + (size_t)row0 * DM : in[I_CTX] + (size_t)(row0 - MTOK) * DM;
            const float* mv = mod + (size_t)(lat ? row0 / SEQ : 8) * 12288;
            f32x4 psh[8], psc[8];
#pragma unroll
            for (int j = 0; j < 8; ++j) { psh[j] = *(const f32x4*)(mv + F.lane * 4 + 256 * j); psc[j] = *(const f32x4*)(mv + 2048 + F.lane * 4 + 256 * j) + 1.0f; }
            f32x4 v[8], vn[8];
#pragma unroll
            for (int j = 0; j < 8; ++j) v[j] = *(const f32x4*)(xb + F.lane * 4 + 256 * j);
#pragma unroll 1
            for (int ri = 0; ri < 8; ++ri) {
                const float* xn = xb + (size_t)(ri < 7 ? ri + 1 : ri) * DM;
#pragma unroll
                for (int j = 0; j < 8; ++j) vn[j] = *(const f32x4*)(xn + F.lane * 4 + 256 * j);
                float s = 0.f;
#pragma unroll
                for (int j = 0; j < 8; ++j) s += (v[j].x + v[j].y) + (v[j].z + v[j].w);
                const float mean = wave_sum(s) * (1.f / DM); float s2 = 0.f;
#pragma unroll
                for (int j = 0; j < 8; ++j) { v[j] = v[j] - mean; s2 += (v[j].x * v[j].x + v[j].y * v[j].y) + (v[j].z * v[j].z + v[j].w * v[j].w); }
                const float rstd = 1.f / sqrtf(wave_sum(s2) * (1.f / DM) + LN_EPS);
                const int row = row0 + ri;
                if (lat && F.lane == 0) { WSP(float, WS_STATS)[row * 2] = mean; WSP(float, WS_STATS)[row * 2 + 1] = rstd; }
                bf16_t* orow = WSP(bf16_t, WS_HX) + (size_t)row * DM;
#pragma unroll
                for (int j = 0; j < 8; ++j) { const f32x4 y = (v[j] * rstd * pg[j] + pb[j]) * psc[j] + psh[j];
                    u32x2 o; o.x = pk2(y.x, y.y); o.y = pk2(y.z, y.w); *(u32x2*)(orow + F.lane * 4 + 256 * j) = o;
                    if (lat) *(unsigned*)(WSP(unsigned char, WS_HX8) + (size_t)row * DM + F.lane * 4 + 256 * j) = pk4_fp8(y.x, y.y, y.z, y.w); }
#pragma unroll
                for (int j = 0; j < 8; ++j) v[j] = vn[j];
            }
        }
    }
    const int hb = F.tid >> 8, ht = F.tid & 255;
    LAS f32x2* buf = (LAS f32x2*)(F.lds + hb * FFT_BUF_BYTES);
    const FftTw tw = fft_tw(ht);
    const float* htaps = WSP(float, WS_HTAPS);
    for (int u0 = F.bid * 2; u0 < 2048; u0 += F.G * 2) {
        const int un = u0 + hb, c = un >> 1, n = un & 1;
        const float* hf = htaps + (size_t)((n * 2 + 0) * 1024 + c) * SEQ, * hbk = htaps + (size_t)((n * 2 + 1) * 1024 + c) * SEQ;
        f32x2 v[16];
#pragma unroll
        for (int a = 0; a < 16; ++a) { const int i = 256 * a + ht; float x;
            if (a < 8) x = hf[i]; else if (i == 2048) x = 0.f; else x = hbk[4096 - i];
            v[a] = (f32x2){x * (1.0f / 4096.0f), 0.f}; }
        { NoHook nh; fft_fwd<-1, -1>(v, buf, ht, tw, nh, NoPf{}); }
        unsigned* Hd = WSP(unsigned, WS_H) + (size_t)un * 4096;
#pragma unroll
        for (int ks = 0; ks < 16; ++ks) Hd[ks * 256 + ht] = pk2(v[ks].x, v[ks].y);
        __syncthreads();
    }
}

template <bool F8> struct SchedZ {
    static constexpr bool GATHER = false;
    int G, c; const char* hx; const char* win;
    static constexpr size_t P = F8 ? DM : 2 * DM;
    __device__ __forceinline__ bool next(int i, Unit& u) const {
        int L = i * G + c;
        if (!F8) {
            if (L < 320) { int pn; pg8::decode_tile(L, 64, 5, u.pm, pn); u.pn = pn < 4 ? pn : 28; u.ex = 0; return true; } L -= 320;
            if (L < 72) { int pm, pn; pg8::decode_tile(L, 8, 9, pm, pn); u.pm = 64 + pm; u.pn = pn < 8 ? pn : 28; u.ex = 0; return true; }
            return false;
        } else {
            if (L < 1536) { int pn; pg8::decode_tile(L, 64, 24, u.pm, pn); u.pn = 4 + pn; u.ex = 0; return true; } L -= 1536;
            if (L < 768) { pg8::decode_tile(L, 12, 64, u.pm, u.pn); u.ex = 1; return true; }
            return false;
        }
    }
    __device__ __forceinline__ const char* a_base(const Unit& u) const { return u.ex ? win + (size_t)(WIN_HY0 + 256 * u.pm) * P : hx + (size_t)(256 * u.pm) * P; }
    __device__ __forceinline__ const char* b_base(const Unit& u) const { return u.ex ? hx + (size_t)(256 * u.pn) * P : win + (size_t)(256 * u.pn) * P; }
    __device__ __forceinline__ int a_row(const Unit&, int R) const { return R; }
};
struct EpiZ {
    static constexpr bool PERM = true;
    bf16_t* Z; bf16_t* ZT; const float* bias;
    __device__ __forceinline__ void operator()(const f32x4 (&acc)[2][2][4][2], const Unit& u, int wr, int wc, int fr, int fq) const {
        if (u.ex == 0) {
            const int row0 = u.pm * 256 + wr * 64 + fr, col0 = u.pn * 256 + wc * 32 + 8 * fq;
            f32x4 bv[2][2];
#pragma unroll
            for (int bj = 0; bj < 2; ++bj)
#pragma unroll
                for (int n = 0; n < 2; ++n) bv[bj][n] = *(const f32x4*)(bias + col0 + bj * 128 + 4 * n);
#pragma unroll
            for (int ai = 0; ai < 2; ++ai)
#pragma unroll
                for (int m = 0; m < 4; ++m) { bf16_t* rowp = Z + (size_t)(row0 + ai * 128 + m * 16) * ZN + col0;
#pragma unroll
                    for (int bj = 0; bj < 2; ++bj) { const f32x4 v0 = acc[ai][bj][m][0] + bv[bj][0], v1 = acc[ai][bj][m][1] + bv[bj][1];
                        u32x4 w; w.x = pg8::cvt_pk_bf16(v0[0], v0[1]); w.y = pg8::cvt_pk_bf16(v0[2], v0[3]); w.z = pg8::cvt_pk_bf16(v1[0], v1[1]); w.w = pg8::cvt_pk_bf16(v1[2], v1[3]);
                        *(u32x4*)(rowp + bj * 128) = w; } }
        } else {
            const int ch0 = u.pm * 256 + wr * 64 + fr, b = u.pn >> 3, t0 = (u.pn & 7) * 256 + wc * 32 + 8 * fq;
            float bbv[8];
#pragma unroll
            for (int r = 0; r < 8; ++r) bbv[r] = bias[WIN_HY0 + ch0 + (r >> 2) * 128 + (r & 3) * 16];
#pragma unroll
            for (int ai = 0; ai < 2; ++ai)
#pragma unroll
                for (int m = 0; m < 4; ++m) { const int ch = ch0 + ai * 128 + m * 16; const float bb = bbv[ai * 4 + m];
                    bf16_t* rowp = ZT + ((size_t)b * 3072 + ch) * SEQ + t0;
#pragma unroll
                    for (int bj = 0; bj < 2; ++bj) { const f32x4 v0 = acc[ai][bj][m][0] + bb, v1 = acc[ai][bj][m][1] + bb;
                        u32x4 w; w.x = pg8::cvt_pk_bf16(v0[0], v0[1]); w.y = pg8::cvt_pk_bf16(v0[2], v0[3]); w.z = pg8::cvt_pk_bf16(v1[0], v1[1]); w.w = pg8::cvt_pk_bf16(v1[2], v1[3]);
                        *(u32x4*)(rowp + bj * 128) = w; } }
        }
    }
};

__device__ __forceinline__ void p3_phase(Frame& F) {
    const KargP in = karg_opaque(F.in);
    const bf16_t* Z = WSP(bf16_t, WS_Z); bf16_t* U = WSP(bf16_t, WS_U);
    const float* cw = in[I_MCW]; const float* cb = in[I_MCB];
    const int c0 = (F.tid & 127) * 8;
    f32x4 w0[9], w1[9];
#pragma unroll
    for (int q = 0; q < 9; ++q) { w0[q] = *(const f32x4*)(cw + q * MW + c0); w1[q] = *(const f32x4*)(cw + q * MW + c0 + 4); }
    const f32x4 b0 = *(const f32x4*)(cb + c0), b1 = *(const f32x4*)(cb + c0 + 4);
#pragma unroll 1
    for (int it = F.bid * NTHR + F.tid; it < MALL * 128; it += F.G * NTHR) {
        const int row = it >> 7;
        const bool lat = row < MTOK;
        int base, y, x, H, Wd;
        if (lat) { const int t = row & (SEQ - 1); base = row - t; y = t >> 6; x = t & 63; H = 32; Wd = 64; }
        else { const int t = (row - MTOK) & (CTX - 1); base = row - t; y = 0; x = t; H = 1; Wd = CTX; }
        u32x4 zz[9]; bool ok[9];
#pragma unroll
        for (int q = 0; q < 9; ++q) { const int yy = y + q / 3 - 1, xx = x + q % 3 - 1; ok[q] = yy >= 0 && yy < H && xx >= 0 && xx < Wd;
            const int srow = ok[q] ? base + yy * Wd + xx : row;
            zz[q] = *(const u32x4*)(Z + (size_t)srow * ZN + ZC_QK + c0); }
        f32x4 a0 = b0, a1 = b1;
#pragma unroll
        for (int q = 0; q < 9; ++q) { const float m = ok[q] ? 1.f : 0.f;
            a0 += (f32x4){bflo(zz[q].x), bfhi(zz[q].x), bflo(zz[q].y), bfhi(zz[q].y)} * w0[q] * m;
            a1 += (f32x4){bflo(zz[q].z), bfhi(zz[q].z), bflo(zz[q].w), bfhi(zz[q].w)} * w1[q] * m; }
        float a[8] = {a0.x, a0.y, a0.z, a0.w, a1.x, a1.y, a1.z, a1.w};
#pragma unroll
        for (int j = 0; j < 8; ++j) a[j] = a[j] * sigmoid_fast(a[j]);
        u32x4 o; o.x = pk2(a[0], a[1]); o.y = pk2(a[2], a[3]); o.z = pk2(a[4], a[5]); o.w = pk2(a[6], a[7]);
        *(u32x4*)(U + (size_t)row * MW + c0) = o;
    }
}

struct SchedQK {
    static constexpr bool GATHER = false;
    int G, c; const char* u; const char* w;
    __device__ __forceinline__ bool next(int i, Unit& un) const { const int L = i * G + c; if (L >= 72 * 8) return false; pg8::decode_tile(L, 72, 8, un.pm, un.pn); un.ex = 0; return true; }
    __device__ __forceinline__ const char* a_base(const Unit& un) const { return u + ((size_t)(256 * un.pm) * MW + (un.pn >> 1) * 256) * 2; }
    __device__ __forceinline__ const char* b_base(const Unit& un) const { return w + (size_t)(256 * un.pn) * 256 * 2; }
    __device__ __forceinline__ int a_row(const Unit&, int R) const { return R; }
};
struct EpiQK {
    static constexpr bool PERM = true;
    bf16_t* O;
    __device__ __forceinline__ void operator()(const f32x4 (&acc)[2][2][4][2], const Unit& u, int wr, int wc, int fr, int fq) const {
        const int row0 = u.pm * 256 + wr * 64 + fr, col0 = u.pn * 256 + wc * 32 + 8 * fq;
#pragma unroll
        for (int ai = 0; ai < 2; ++ai)
#pragma unroll
            for (int m = 0; m < 4; ++m) { bf16_t* rowp = O + (size_t)(row0 + ai * 128 + m * 16) * 2048 + col0;
#pragma unroll
                for (int bj = 0; bj < 2; ++bj) { const f32x4 v0 = acc[ai][bj][m][0], v1 = acc[ai][bj][m][1];
                    u32x4 w; w.x = pg8::cvt_pk_bf16(v0[0], v0[1]); w.y = pg8::cvt_pk_bf16(v0[2], v0[3]); w.z = pg8::cvt_pk_bf16(v1[0], v1[1]); w.w = pg8::cvt_pk_bf16(v1[2], v1[3]);
                    *(u32x4*)(rowp + bj * 128) = w; } }
    }
};

constexpr int ML_QS = 264, ML_VS = 72, ML_PS = 72;
constexpr int ML_Q = 0, ML_K = ML_Q + 64 * ML_QS * 2, ML_V = ML_K + 64 * ML_QS * 2, ML_C = ML_V + 64 * ML_VS * 2, ML_P = ML_C + 80 * ML_QS * 2, ML_VT = ML_P + 64 * ML_PS * 2, ML_SC = ML_VT + 80 * ML_VS * 2;
constexpr int ML_SA = ML_SC, ML_SDEN = ML_SC + 4096, ML_END = ML_SC + 4096 + 256;
static_assert(ML_END <= MISC_OFF, "mlstm LDS");
__device__ __forceinline__ bf16x8 lds_frag(const LAS bf16_t* p) { return *(const LAS bf16x8*)p; }
__device__ __forceinline__ void mlstm_unit(Frame& F, int un) {
    const int vs = un & 3, dir = (un >> 2) & 1, h = (un >> 3) & 3, b = un >> 5;
    const bf16_t* Z = WSP(bf16_t, WS_Z); const bf16_t* QK = WSP(bf16_t, WS_QKB); unsigned char* AM = WSP(unsigned char, WS_AM);
    LAS unsigned char* lds = F.lds;
    LAS bf16_t* Qs = (LAS bf16_t*)(lds + ML_Q); LAS bf16_t* Ks = (LAS bf16_t*)(lds + ML_K); LAS bf16_t* Vs = (LAS bf16_t*)(lds + ML_V);
    LAS bf16_t* Cs = (LAS bf16_t*)(lds + ML_C); LAS bf16_t* Ps = (LAS bf16_t*)(lds + ML_P); LAS bf16_t* VT = (LAS bf16_t*)(lds + ML_VT);
    LAS float* sDEN = (LAS float*)(lds + ML_SDEN);
    LAS float* sc0 = (LAS float*)(lds + ML_SA);
    const int tid = F.tid, lane = F.lane, w = F.wave, l15 = lane & 15, g4 = lane >> 4;
    __syncthreads();
    for (int i = tid; i < 80 * ML_QS / 2; i += NTHR) ((LAS unsigned*)Cs)[i] = 0u;
    if (tid < 64) { Vs[tid * ML_VS + 64] = (bf16_t)0x3F80; for (int j = 65; j < ML_VS; ++j) Vs[tid * ML_VS + j] = 0; }
    for (int i = tid; i < 16 * ML_VS; i += NTHR) VT[64 * ML_VS + i] = (i < 64) ? (bf16_t)0x3F80 : (bf16_t)0;
    f32x4 cacc[2][5];
#pragma unroll
    for (int a = 0; a < 2; ++a)
#pragma unroll
        for (int c = 0; c < 5; ++c) cacc[a][c] = (f32x4){0.f, 0.f, 0.f, 0.f};
    float m_run = 0.f;
    u32x4 pq[4], pk[4], pv; unsigned pgate = 0u, pgate2 = 0u;
#define ML_ROW0(st) ((st) < 4 ? (MTOK + b * CTX + 64 * (dir ? 3 - (st) : (st))) : (b * SEQ + 64 * (dir ? 35 - (st) : (st) - 4)))
#define ML_LOAD(st) do { const int r0_ = ML_ROW0(st); \
        _Pragma("unroll") for (int q_ = 0; q_ < 4; ++q_) { const int p_ = tid + 512 * q_, rr_ = p_ >> 5, cc_ = (p_ & 31) * 8; \
            pq[q_] = *(const u32x4*)(QK + (size_t)(r0_ + rr_) * 2048 + h * 512 + cc_); pk[q_] = *(const u32x4*)(QK + (size_t)(r0_ + rr_) * 2048 + h * 512 + 256 + cc_); } \
        { const int rr_ = tid >> 3, cc_ = (tid & 7) * 8; pv = *(const u32x4*)(Z + (size_t)(r0_ + rr_) * ZN + ZC_V + h * 256 + vs * 64 + cc_); } \
        if (tid < 64) { const bf16_t* gp_ = Z + (size_t)(r0_ + tid) * ZN + ZC_GT + dir * 8 + h; pgate = gp_[0]; pgate2 = gp_[4]; } } while (0)
#define ML_STORE() do { \
        _Pragma("unroll") for (int q_ = 0; q_ < 4; ++q_) { const int p_ = tid + 512 * q_, rr_ = p_ >> 5, cc_ = (p_ & 31) * 8; \
            *(LAS u32x4*)(Qs + rr_ * ML_QS + cc_) = pq[q_]; *(LAS u32x4*)(Ks + rr_ * ML_QS + cc_) = pk[q_]; } \
        { const int rr_ = tid >> 3, cc_ = (tid & 7) * 8; *(LAS u32x4*)(Vs + rr_ * ML_VS + cc_) = pv; \
          VT[(cc_ + 0) * ML_VS + rr_] = (bf16_t)(pv.x & 0xffffu); VT[(cc_ + 1) * ML_VS + rr_] = (bf16_t)(pv.x >> 16); VT[(cc_ + 2) * ML_VS + rr_] = (bf16_t)(pv.y & 0xffffu); VT[(cc_ + 3) * ML_VS + rr_] = (bf16_t)(pv.y >> 16); \
          VT[(cc_ + 4) * ML_VS + rr_] = (bf16_t)(pv.z & 0xffffu); VT[(cc_ + 5) * ML_VS + rr_] = (bf16_t)(pv.z >> 16); VT[(cc_ + 6) * ML_VS + rr_] = (bf16_t)(pv.w & 0xffffu); VT[(cc_ + 7) * ML_VS + rr_] = (bf16_t)(pv.w >> 16); } } while (0)
#define ML_SCALARS(stp) do { LAS float* sb_ = sc0 + ((stp) & 1) * 512; \
              \
            float li = bf2f(pgate), zf = bf2f(pgate2); \
            if (dir) { li = __shfl(li, 63 - lane); zf = __shfl(zf, 63 - lane); } \
            const float lf = fminf(zf, 0.f) - log1pf(__expf(-fabsf(zf))); \
            const float bcs = wave_scan_sum(lf); \
            const float a = li - bcs; \
            const float am = wave_scan_max(a); \
            const float inter = bcs + m_run; \
            const float mt = fmaxf(inter, bcs + am); \
            const float b_end = lane_bcast(bcs, 63); \
            const float gg = b_end - bcs + li; \
            const float gm = lane_bcast(wave_scan_max(gg), 63); \
            const float m_new = fmaxf(b_end + m_run, gm); \
            const int pos_ = dir ? 63 - lane : lane; \
            sb_[pos_] = a; sb_[64 + pos_] = bcs - mt; sb_[128 + pos_] = __expf(inter - mt); sb_[192 + pos_] = __expf(gg - m_new); sb_[256 + pos_] = __expf(-mt); \
            if (lane == 0) sb_[320] = __expf(b_end + m_run - m_new); \
            m_run = m_new; } while (0)
    ML_LOAD(0);
    __syncthreads();
    if (w == 0) ML_SCALARS(0);
    const int tt = w & 3; const int nv = (w < 4) ? 3 : 2;
#pragma unroll 1
    for (int st = 0; st < 36; ++st) {
        ML_STORE();
        LAS float* sA = sc0 + (st & 1) * 512; LAS float* sU = sA + 64; LAS float* sSI = sA + 128; LAS float* sWG = sA + 192; LAS float* sEM = sA + 256; LAS float* sMI = sA + 320;
        const int row0 = ML_ROW0(st);
        if (st + 1 < 36) ML_LOAD(st + 1);
        __syncthreads();
        unsigned og[2][4];
        f32x4 nacc[3], iacc[3];
#pragma unroll
        for (int j = 0; j < 3; ++j) { nacc[j] = (f32x4){0.f, 0.f, 0.f, 0.f}; iacc[j] = (f32x4){0.f, 0.f, 0.f, 0.f}; }
        const int t0 = 16 * tt + 4 * g4;
        if (st >= 4) {
        {
            f32x4 sacc[2] = {(f32x4){0.f, 0.f, 0.f, 0.f}, (f32x4){0.f, 0.f, 0.f, 0.f}};
#pragma unroll
            for (int ks = 0; ks < 8; ++ks) {
                const bf16x8 qf = lds_frag(Qs + (16 * tt + l15) * ML_QS + 32 * ks + 8 * g4);
#pragma unroll
                for (int j = 0; j < 2; ++j) { const int stl = 2 * (w >> 2) + j;
                    const bf16x8 kf = lds_frag(Ks + (16 * stl + l15) * ML_QS + 32 * ks + 8 * g4);
                    sacc[j] = __builtin_amdgcn_mfma_f32_16x16x32_bf16(kf, qf, sacc[j], 0, 0, 0); }
            }
            const int t = 16 * tt + l15; const float ut = sU[t];
#pragma unroll
            for (int j = 0; j < 2; ++j) { const int s0 = 16 * (2 * (w >> 2) + j) + 4 * g4;
                const f32x4 av = *(const LAS f32x4*)(sA + s0);
                float pvv[4];
#pragma unroll
                for (int r = 0; r < 4; ++r) { const int s = s0 + r; const bool ok = dir ? (s >= t) : (s <= t); pvv[r] = ok ? sacc[j][r] * __expf(ut + av[r]) : 0.f; }
                u32x2 o; o.x = pk2(pvv[0], pvv[1]); o.y = pk2(pvv[2], pvv[3]);
                *(LAS u32x2*)(Ps + t * ML_PS + s0) = o; }
        }
        __syncthreads();
        {
#pragma unroll
            for (int j = 0; j < 2; ++j) { const int vt_ = (w < 4) ? j : 2 + j;
#pragma unroll
                for (int r = 0; r < 4; ++r) og[j][r] = Z[(size_t)(row0 + 16 * tt + 4 * g4 + r) * ZN + ZC_O + h * 256 + vs * 64 + 16 * vt_ + l15]; } }
#pragma unroll
        for (int ks = 0; ks < 8; ++ks) {
            const bf16x8 qf = lds_frag(Qs + (16 * tt + l15) * ML_QS + 32 * ks + 8 * g4);
#pragma unroll
            for (int j = 0; j < 3; ++j) if (j < nv) { const int vt = (w < 4) ? (j == 2 ? 4 : j) : 2 + j;
                const bf16x8 cf = lds_frag(Cs + (16 * vt + l15) * ML_QS + 32 * ks + 8 * g4);
                iacc[j] = __builtin_amdgcn_mfma_f32_16x16x32_bf16(qf, cf, iacc[j], 0, 0, 0); }
        }
#pragma unroll
        for (int ks = 0; ks < 2; ++ks) {
            const bf16x8 pf = lds_frag(Ps + (16 * tt + l15) * ML_PS + 32 * ks + 8 * g4);
#pragma unroll
            for (int j = 0; j < 3; ++j) if (j < nv) { const int vt = (w < 4) ? (j == 2 ? 4 : j) : 2 + j;
                const bf16x8 vf = lds_frag(VT + (16 * vt + l15) * ML_VS + 32 * ks + 8 * g4);
                nacc[j] = __builtin_amdgcn_mfma_f32_16x16x32_bf16(pf, vf, nacc[j], 0, 0, 0); }
        }
        {
            const f32x4 si = *(const LAS f32x4*)(sSI + t0);
#pragma unroll
            for (int j = 0; j < 3; ++j) if (j < nv) nacc[j] = nacc[j] + iacc[j] * si;
            if (w < 4 && l15 == 0) *(LAS f32x4*)(sDEN + t0) = nacc[2];
        }
        }
        {
            const float decay = sMI[0];
#pragma unroll
            for (int a = 0; a < 2; ++a)
#pragma unroll
                for (int c = 0; c < 5; ++c) cacc[a][c] = cacc[a][c] * decay;
#pragma unroll
            for (int ks = 0; ks < 2; ++ks) {
                float wg[8];
#pragma unroll
                for (int e = 0; e < 8; ++e) wg[e] = sWG[32 * ks + 8 * g4 + e];
                bf16x8 kf[2];
#pragma unroll
                for (int a = 0; a < 2; ++a) { float x[8];
                    typedef short s16x4_t __attribute__((ext_vector_type(4)));
                    const LAS bf16_t* kp = Ks + (32 * ks + 8 * g4 + (l15 >> 2)) * ML_QS + 16 * (2 * w + a) + 4 * (l15 & 3);
                    const s16x4_t k0 = __builtin_amdgcn_ds_read_tr16_b64_v4i16((LAS s16x4_t*)kp), k1 = __builtin_amdgcn_ds_read_tr16_b64_v4i16((LAS s16x4_t*)(kp + 4 * ML_QS));
#pragma unroll
                    for (int e = 0; e < 4; ++e) { x[e] = bf2f((unsigned)(unsigned short)k0[e]) * wg[e]; x[4 + e] = bf2f((unsigned)(unsigned short)k1[e]) * wg[4 + e]; }
                    u32x4 o; o.x = pk2(x[0], x[1]); o.y = pk2(x[2], x[3]); o.z = pk2(x[4], x[5]); o.w = pk2(x[6], x[7]);
                    kf[a] = __builtin_bit_cast(bf16x8, o); }
#pragma unroll
                for (int c = 0; c < 5; ++c) {
                    const bf16x8 vf = lds_frag(VT + (16 * c + l15) * ML_VS + 32 * ks + 8 * g4);
#pragma unroll
                    for (int a = 0; a < 2; ++a) cacc[a][c] = __builtin_amdgcn_mfma_f32_16x16x32_bf16(kf[a], vf, cacc[a][c], 0, 0, 0);
                }
            }
        }
        __syncthreads();
        if (w == 0 && st + 1 < 36) ML_SCALARS(st + 1);
        if (st >= 4) {
            const f32x4 dn = *(const LAS f32x4*)(sDEN + t0), em = *(const LAS f32x4*)(sEM + t0);
#pragma unroll
            for (int j = 0; j < 2; ++j) { const int vt = (w < 4) ? j : 2 + j; const int col = h * 256 + vs * 64 + 16 * vt + l15;
#pragma unroll
                for (int r = 0; r < 4; ++r) { const int row = row0 + t0 + r;
                    const float hv = nacc[j][r] * __builtin_amdgcn_rcpf(fmaxf(fabsf(dn[r]), em[r]));
                    const float o = __builtin_amdgcn_rcpf(1.0f + __expf(-bf2f(og[j][r])));
                    AM[(size_t)row * 2048 + dir * 1024 + col] = (unsigned char)(pk4_fp8(fminf(fmaxf(o * hv, -448.f), 448.f), 0.f, 0.f, 0.f) & 0xffu); } }
        }
#pragma unroll
        for (int a = 0; a < 2; ++a)
#pragma unroll
            for (int c = 0; c < 5; ++c) { u32x2 o; o.x = pk2(cacc[a][c][0], cacc[a][c][1]); o.y = pk2(cacc[a][c][2], cacc[a][c][3]);
                *(LAS u32x2*)(Cs + (16 * c + l15) * ML_QS + 16 * (2 * w + a) + 4 * g4) = o; }
    }
    __syncthreads();
#undef ML_LOAD
#undef ML_STORE
#undef ML_ROW0
#undef ML_SCALARS
}

constexpr int CVH_E0 = 11;
constexpr int CVH_NITEMS = (NEXP - CVH_E0) * 768;
constexpr int CVH_KG_BYTES = 1040, CVH_TILE_BYTES = 16 * CVH_KG_BYTES;
struct CvHook {
    KargP in; unsigned char* ws; LAS unsigned char* tiles; int tid, bid, G, kmax; int s;
    f32x4 v[2][8];
    __device__ __forceinline__ void decode(int h, const float*& src, unsigned char*& dst, int& rstep) const {
        const int e = CVH_E0 + h / 768, q = h % 768;
        if (q < 512) { const int up = q & 1, g = (q >> 1) & 7, kb = q >> 4;
            src = (up ? in[I_WU] : in[I_WG]) + (size_t)e * DM * DM + (size_t)(64 * kb) * DM + 256 * g;
            dst = ws + WS_WGU + ((size_t)e * 4096 + 512 * g + up * 128) * DM + 64 * kb; rstep = 256; }
        else { const int q2 = q - 512, g = q2 & 7, kb = q2 >> 3;
            src = in[I_WDN] + (size_t)e * DM * DM + (size_t)(64 * kb) * DM + 256 * g;
            dst = ws + WS_WD + ((size_t)e * 2048 + 256 * g) * DM + 64 * kb; rstep = 128; }
    }
    __device__ __forceinline__ int item(int k) const { return (k < kmax ? k : kmax) * G + bid; }
    template <int SET> __device__ __forceinline__ void request(int k) {
        const float* src; unsigned char* dst; int rs; decode(item(k), src, dst, rs);
        const int w = tid >> 6, lane = tid & 63;
#pragma unroll
        for (int i = 0; i < 8; ++i) v[SET][i] = __builtin_nontemporal_load((const f32x4*)(src + (size_t)(8 * w + i) * DM + 4 * lane));
    }
    template <int SET> __device__ __forceinline__ void act() {
        const int k = s; s = k + 1;
        const int w = tid >> 6, lane = tid & 63;
        {
            const float sc = (item(k - 2) % 768) < 512 ? 32.f : 64.f;
            LAS unsigned char* t = tiles + SET * CVH_TILE_BYTES;
#pragma unroll
            for (int g = 0; g < 2; ++g) { u32x4 o;
                o.x = pk4_fp8(v[SET][4 * g][0] * sc, v[SET][4 * g + 1][0] * sc, v[SET][4 * g + 2][0] * sc, v[SET][4 * g + 3][0] * sc); o.y = pk4_fp8(v[SET][4 * g][1] * sc, v[SET][4 * g + 1][1] * sc, v[SET][4 * g + 2][1] * sc, v[SET][4 * g + 3][1] * sc);
                o.z = pk4_fp8(v[SET][4 * g][2] * sc, v[SET][4 * g + 1][2] * sc, v[SET][4 * g + 2][2] * sc, v[SET][4 * g + 3][2] * sc); o.w = pk4_fp8(v[SET][4 * g][3] * sc, v[SET][4 * g + 1][3] * sc, v[SET][4 * g + 2][3] * sc, v[SET][4 * g + 3][3] * sc);
                *(LAS u32x4*)(t + (2 * w + g) * CVH_KG_BYTES + 16 * lane) = o; }
        }
        request<SET>(k);
        {
            const float* src; unsigned char* dst; int rs; decode(item(k >= 3 ? k - 3 : 0), src, dst, rs);
            if (k < 3) { dst = ws + WS_DUMMY; rs = 128; }
            const LAS unsigned char* t = tiles + (1 - SET) * CVH_TILE_BYTES;
#pragma unroll
            for (int q = 0; q < 2; ++q) { const int idx = tid + 512 * q, row = idx >> 2, piece = idx & 3;
                const LAS unsigned char* tp = t + (4 * piece) * CVH_KG_BYTES + 4 * row;
                u32x4 o; o.x = *(const LAS unsigned*)(tp); o.y = *(const LAS unsigned*)(tp + CVH_KG_BYTES); o.z = *(const LAS unsigned*)(tp + 2 * CVH_KG_BYTES); o.w = *(const LAS unsigned*)(tp + 3 * CVH_KG_BYTES);
                *(u32x4*)(dst + (size_t)((row >> 7) * rs + (row & 127)) * DM + 16 * piece) = o; }
        }
    }
};
struct HPf {
    const unsigned* Hd; int ht; unsigned (&h)[16];
    __device__ __forceinline__ void operator()() const {
#pragma unroll
        for (int ks = 0; ks < 16; ++ks) h[ks] = Hd[ks * 256 + ht];
    }
};

constexpr int HY_RAW = 2 * FFT_BUF_BYTES, HY_OUT = HY_RAW + 16384, HY_CVT = HY_OUT + 32768, HY_COEF = HY_CVT + 2 * CVH_TILE_BYTES, HY_END = HY_COEF + 512;
static_assert(HY_END <= MISC_OFF, "hyena LDS");
__device__ __forceinline__ void hy_conv_to_buf(const LAS bf16_t* raw, LAS f32x2* buf, const LAS float* cf, int kind, int ht) {
    float w9[9]; const float bias = cf[27 + kind];
#pragma unroll
    for (int q = 0; q < 9; ++q) w9[q] = cf[9 * kind + q];
    asm volatile("" : "+v"(ht));
    const int t0 = 8 * ht, y = t0 >> 6, x0 = t0 & 63;
    float acc[2][8];
#pragma unroll
    for (int bb = 0; bb < 2; ++bb)
#pragma unroll
        for (int i = 0; i < 8; ++i) acc[bb][i] = bias;
#pragma unroll
    for (int dy = -1; dy <= 1; ++dy) {
        const int yy = y + dy;
        if (yy >= 0 && yy < 32) {
#pragma unroll
            for (int bb = 0; bb < 2; ++bb) {
                const LAS bf16_t* base = raw + bb * 2048 + t0 + 64 * dy;
                const u32x4 mid = *(const LAS u32x4*)base;
                float vals[10];
                vals[0] = (x0 > 0) ? bf2f((unsigned)base[-1]) : 0.f; vals[9] = (x0 + 8 < 64) ? bf2f((unsigned)base[8]) : 0.f;
                vals[1] = bflo(mid.x); vals[2] = bfhi(mid.x); vals[3] = bflo(mid.y); vals[4] = bfhi(mid.y); vals[5] = bflo(mid.z); vals[6] = bfhi(mid.z); vals[7] = bflo(mid.w); vals[8] = bfhi(mid.w);
                const float wl = w9[(dy + 1) * 3], wm = w9[(dy + 1) * 3 + 1], wr_ = w9[(dy + 1) * 3 + 2];
#pragma unroll
                for (int i = 0; i < 8; ++i) acc[bb][i] += wl * vals[i] + wm * vals[i + 1] + wr_ * vals[i + 2];
            }
        }
    }
#pragma unroll
    for (int i = 0; i < 8; ++i) buf[fphys(t0 + i)] = (f32x2){acc[0][i], acc[1][i]};
}
__device__ __forceinline__ float hy_coef_load(KargP in, int c, int ht) {
    const int i = ht & 31;
    if (i < 27) { const int kind = i / 9, q = i % 9; const int ch = (kind == 0 ? 2048 : kind == 1 ? 0 : 1024) + c; return in[I_HCW][q * 3072 + ch]; }
    if (i < 30) { const int kind = i - 27; return in[I_HCB][(kind == 0 ? 2048 : kind == 1 ? 0 : 1024) + c]; }
    return in[I_HSKIP][(i - 30) * 1024 + c];
}
__device__ __forceinline__ void hyena_unit(Frame& F, int un, CvHook& hk) {
    const KargP in = karg_opaque(F.in);
    const int cg = un >> 2, bp = un & 3, c0 = cg * 8, b0 = bp * 2;
    int tid_ = F.tid; asm volatile("" : "+v"(tid_));
    const int hb = tid_ >> 8, ht = tid_ & 255;
    LAS f32x2* buf = (LAS f32x2*)(F.lds + hb * FFT_BUF_BYTES);
    LAS bf16_t* raw = (LAS bf16_t*)(F.lds + HY_RAW + hb * 8192);
    LAS unsigned char* outT = (LAS unsigned char*)(F.lds + HY_OUT);
    const bf16_t* ZT = WSP(bf16_t, WS_ZT); const unsigned* H = WSP(unsigned, WS_H);
    const FftTw tw = fft_tw(ht);
    __syncthreads();
#define HY_FETCH(dst, kind, ch) do { _Pragma("unroll") for (int bb = 0; bb < 2; ++bb) dst[bb] = *(const u32x4*)(ZT + ((size_t)(b0 + bb) * 3072 + (kind) * 1024 + (ch)) * SEQ + ht * 8); } while (0)
#define HY_PUT(srcv) do { _Pragma("unroll") for (int bb = 0; bb < 2; ++bb) *(LAS u32x4*)(raw + bb * 2048 + ht * 8) = srcv[bb]; } while (0)
    u32x4 rv[2], rn[2];
    HY_FETCH(rv, 2, c0 + hb);
    LAS float* coef = (LAS float*)(F.lds + HY_COEF) + hb * 64;
    if (ht < 32) coef[ht] = hy_coef_load(in, c0 + hb, ht);
    float cpre = 0.f;
#pragma unroll 1
    for (int i = 0; i < 4; ++i) {
        const int cl = 2 * i + hb, c = c0 + cl;
        const LAS float* cf = coef + (i & 1) * 32;
        { int hto = ht; asm volatile("" : "+v"(hto));
          if (i < 3 && hto < 32) cpre = hy_coef_load(in, c + 2, hto); }
        HY_PUT(rv);
        HY_FETCH(rn, 0, c);
        __syncthreads();
        f32x2 vin[8], v[16]; unsigned hpre[16];
        hy_conv_to_buf(raw, buf, cf, 0, ht);
        __syncthreads();
#pragma unroll
        for (int a = 0; a < 8; ++a) { vin[a] = buf[fphys(256 * a + ht)]; v[a] = vin[a]; v[8 + a] = (f32x2){0.f, 0.f}; }
        fft_fwd<-1, -1>(v, buf, ht, tw, hk, HPf{H + (size_t)(c * 2 + 0) * 4096, ht, hpre});
#pragma unroll
        for (int ks = 0; ks < 16; ++ks) v[ks] = cmulq(v[ks], (f32x2){bflo(hpre[ks]), bfhi(hpre[ks])});
        fft_inv<0, 1, 0>(v, buf, ht, tw, hk);
        HY_PUT(rn);
        HY_FETCH(rv, 1, c);
        __syncthreads(); hk.act<1>();
        hy_conv_to_buf(raw, buf, cf, 1, ht);
        __syncthreads();
        { const float sk = cf[30];
#pragma unroll
          for (int a = 0; a < 8; ++a) { const f32x2 g = buf[fphys(256 * a + ht)]; vin[a] = g * (v[a] + vin[a] * sk); } }
#pragma unroll
        for (int a = 0; a < 8; ++a) { v[a] = vin[a]; v[8 + a] = (f32x2){0.f, 0.f}; }
        fft_fwd<-1, -1>(v, buf, ht, tw, hk, HPf{H + (size_t)(c * 2 + 1) * 4096, ht, hpre});
#pragma unroll
        for (int ks = 0; ks < 16; ++ks) v[ks] = cmulq(v[ks], (f32x2){bflo(hpre[ks]), bfhi(hpre[ks])});
        fft_inv<0, 1, 0>(v, buf, ht, tw, hk);
        HY_PUT(rv);
        if (i < 3) HY_FETCH(rv, 2, c + 2);
        __syncthreads(); hk.act<1>();
        hy_conv_to_buf(raw, buf, cf, 2, ht);
        __syncthreads();
        { const float sk = cf[31];
#pragma unroll
          for (int a = 0; a < 8; ++a) { const f32x2 g = buf[fphys(256 * a + ht)]; const f32x2 o = g * (v[a] + vin[a] * sk); const int t = 256 * a + ht;
              const unsigned pk_ = pk4_fp8(fminf(fmaxf(o.x, -448.f), 448.f), fminf(fmaxf(o.y, -448.f), 448.f), 0.f, 0.f);
              outT[(0 * 2048 + t) * 8 + cl] = (unsigned char)(pk_ & 0xffu); outT[(1 * 2048 + t) * 8 + cl] = (unsigned char)((pk_ >> 8) & 0xffu); } }
        if (i < 3 && ht < 32) coef[((i + 1) & 1) * 32 + ht] = cpre;
        __syncthreads();
    }
#undef HY_FETCH
#undef HY_PUT
    unsigned char* HH = WSP(unsigned char, WS_HH);
    int tido = F.tid; asm volatile("" : "+v"(tido));
#pragma unroll
    for (int q = 0; q < 8; ++q) { const int r = tido + 512 * q, bb = r >> 11, t = r & 2047;
        *(u32x2*)(HH + ((size_t)(b0 + bb) * SEQ + t) * HW + c0) = *(const LAS u32x2*)(outT + r * 8); }
    __syncthreads();
}

struct SchedP {
    static constexpr bool GATHER = false;
    int G, c; const char* a; const char* b; size_t astep, bstep;
    __device__ __forceinline__ bool next(int i, Unit& u) const { const int L = i * G + c; if (L >= 512) return false; pg8::decode_tile(L, 64, 8, u.pm, u.pn); u.ex = 0; return true; }
    __device__ __forceinline__ const char* a_base(const Unit& u) const { return a + (size_t)u.pm * astep; }
    __device__ __forceinline__ const char* b_base(const Unit& u) const { return b + (size_t)u.pn * bstep; }
    __device__ __forceinline__ int a_row(const Unit&, int R) const { return R; }
};
struct EpiMA {
    static constexpr bool PERM = true;
    bf16_t* T; const bf16_t* Z;
    __device__ __forceinline__ void operator()(const f32x4 (&acc)[2][2][4][2], const Unit& u, int wr, int wc, int fr, int fq) const {
        const int row0 = u.pm * 256 + wr * 64 + fr, col0 = u.pn * 256 + wc * 32 + 8 * fq;
#pragma unroll
        for (int ai = 0; ai < 2; ++ai)
#pragma unroll
            for (int bj = 0; bj < 2; ++bj) { const int c = col0 + bj * 128;
                u32x4 gz[4];
#pragma unroll
                for (int m = 0; m < 4; ++m) gz[m] = *(const u32x4*)(Z + (size_t)(row0 + ai * 128 + m * 16) * ZN + ZC_GA + c);
#pragma unroll
                for (int m = 0; m < 4; ++m) { const size_t row = row0 + ai * 128 + m * 16;
                    const f32x4 g0 = (f32x4){sigmoid_fast(bflo(gz[m].x)), sigmoid_fast(bfhi(gz[m].x)), sigmoid_fast(bflo(gz[m].y)), sigmoid_fast(bfhi(gz[m].y))};
                    const f32x4 g1 = (f32x4){sigmoid_fast(bflo(gz[m].z)), sigmoid_fast(bfhi(gz[m].z)), sigmoid_fast(bflo(gz[m].w)), sigmoid_fast(bfhi(gz[m].w))};
                    const f32x4 t0 = acc[ai][bj][m][0] * g0, t1 = acc[ai][bj][m][1] * g1;
                    u32x4 w; w.x = pg8::cvt_pk_bf16(t0[0], t0[1]); w.y = pg8::cvt_pk_bf16(t0[2], t0[3]); w.z = pg8::cvt_pk_bf16(t1[0], t1[1]); w.w = pg8::cvt_pk_bf16(t1[2], t1[3]);
                    *(u32x4*)(T + row * DM + c) = w; }
                asm volatile("" ::: "memory"); }
    }
};
struct EpiMB {
    static constexpr bool PERM = true;
    const bf16_t* T; const bf16_t* Z; unsigned char* MX;
    __device__ __forceinline__ void operator()(const f32x4 (&acc)[2][2][4][2], const Unit& u, int wr, int wc, int fr, int fq) const {
        const int row0 = u.pm * 256 + wr * 64 + fr, col0 = u.pn * 256 + wc * 32 + 8 * fq;
#pragma unroll
        for (int ai = 0; ai < 2; ++ai)
#pragma unroll
            for (int bj = 0; bj < 2; ++bj) { const int c = col0 + bj * 128;
                u32x4 gz[4], tv[4];
#pragma unroll
                for (int m = 0; m < 4; ++m) { const size_t row = row0 + ai * 128 + m * 16; gz[m] = *(const u32x4*)(Z + row * ZN + ZC_GH + c); tv[m] = *(const u32x4*)(T + row * DM + c); }
#pragma unroll
                for (int m = 0; m < 4; ++m) { const size_t row = row0 + ai * 128 + m * 16;
                    const f32x4 t0 = (f32x4){bflo(tv[m].x), bfhi(tv[m].x), bflo(tv[m].y), bfhi(tv[m].y)}, t1 = (f32x4){bflo(tv[m].z), bfhi(tv[m].z), bflo(tv[m].w), bfhi(tv[m].w)};
                    const f32x4 g0 = (f32x4){sigmoid_fast(bflo(gz[m].x)), sigmoid_fast(bfhi(gz[m].x)), sigmoid_fast(bflo(gz[m].y)), sigmoid_fast(bfhi(gz[m].y))};
                    const f32x4 g1 = (f32x4){sigmoid_fast(bflo(gz[m].z)), sigmoid_fast(bfhi(gz[m].z)), sigmoid_fast(bflo(gz[m].w)), sigmoid_fast(bfhi(gz[m].w))};
                    const f32x4 v0 = t0 + acc[ai][bj][m][0] * g0, v1 = t1 + acc[ai][bj][m][1] * g1;
                    const f32x4 c0 = __builtin_elementwise_min(__builtin_elementwise_max(v0, (f32x4){-448.f, -448.f, -448.f, -448.f}), (f32x4){448.f, 448.f, 448.f, 448.f});
                    const f32x4 c1 = __builtin_elementwise_min(__builtin_elementwise_max(v1, (f32x4){-448.f, -448.f, -448.f, -448.f}), (f32x4){448.f, 448.f, 448.f, 448.f});
                    u32x2 w; w.x = pk4_fp8(c0[0], c0[1], c0[2], c0[3]); w.y = pk4_fp8(c1[0], c1[1], c1[2], c1[3]);
                    *(u32x2*)(MX + row * DM + c) = w; }
                asm volatile("" ::: "memory"); }
    }
};
struct EpiWO {
    static constexpr bool PERM = true;
    bf16_t* R1; const float* x; const float* stats; const float* lng; const float* lnb; const float* mod;
    __device__ __forceinline__ void operator()(const f32x4 (&acc)[2][2][4][2], const Unit& u, int wr, int wc, int fr, int fq) const {
        const int row0 = u.pm * 256 + wr * 64 + fr, col0 = u.pn * 256 + wc * 32 + 8 * fq;
        const float* g1p = mod + (size_t)(u.pm >> 3) * 12288 + 4096;
#pragma unroll
        for (int bj = 0; bj < 2; ++bj) { const int c = col0 + bj * 128;
            const f32x4 ga = *(const f32x4*)(lng + c), gb = *(const f32x4*)(lng + c + 4), ba = *(const f32x4*)(lnb + c), bb = *(const f32x4*)(lnb + c + 4), g1a = *(const f32x4*)(g1p + c), g1b = *(const f32x4*)(g1p + c + 4);
#pragma unroll
            for (int ai = 0; ai < 2; ++ai)
#pragma unroll
                for (int mh = 0; mh < 2; ++mh) {
                    f32x4 xa[2], xb[2]; f32x2 st[2];
#pragma unroll
                    for (int q = 0; q < 2; ++q) { const size_t row = row0 + ai * 128 + (2 * mh + q) * 16; xa[q] = *(const f32x4*)(x + row * DM + c); xb[q] = *(const f32x4*)(x + row * DM + c + 4); st[q] = *(const f32x2*)(stats + row * 2); }
#pragma unroll
                    for (int q = 0; q < 2; ++q) { const int m = 2 * mh + q; const size_t row = row0 + ai * 128 + m * 16; const float mean = st[q].x, rstd = st[q].y;
                        const f32x4 v0 = ((xa[q] - mean) * rstd * ga + ba) * DN_ALPHA + g1a * acc[ai][bj][m][0], v1 = ((xb[q] - mean) * rstd * gb + bb) * DN_ALPHA + g1b * acc[ai][bj][m][1];
                        u32x4 w; w.x = pg8::cvt_pk_bf16(v0[0], v0[1]); w.y = pg8::cvt_pk_bf16(v0[2], v0[3]); w.z = pg8::cvt_pk_bf16(v1[0], v1[1]); w.w = pg8::cvt_pk_bf16(v1[2], v1[3]);
                        *(u32x4*)(R1 + row * DM + c) = w; }
                    asm volatile("" ::: "memory"); } }
    }
};

struct CwItem { const float* src; unsigned char* dst; float scale; };
__device__ __forceinline__ CwItem cw_decode(KargP in, unsigned char* ws, int it) {
    CwItem c;
    if (it < NEXP * 2048) { const int e = it >> 11, q = it & 2047, g = q & 127, kb = q >> 7; const int n0 = 32 * g, tile = n0 >> 8, within = n0 & 255;
        c.src = (within < 128 ? in[I_WG] : in[I_WU]) + (size_t)e * DM * DM + (size_t)(128 * kb) * DM + tile * 128 + (within & 127);
        c.dst = ws + WS_WGU + ((size_t)e * 4096 + n0) * DM + 128 * kb; c.scale = 32.f; }
    else { const int r2 = it - NEXP * 2048; const int e = r2 >> 10, q = r2 & 1023, g = q & 63, kb = q >> 6;
        c.src = in[I_WDN] + (size_t)e * DM * DM + (size_t)(128 * kb) * DM + 32 * g;
        c.dst = ws + WS_WD + ((size_t)e * 2048 + 32 * g) * DM + 128 * kb; c.scale = 64.f; }
    return c;
}
constexpr int CV_E8 = 8;
__device__ __forceinline__ int cw_map(int i) { return i < CV_E8 * 2048 ? i : NEXP * 2048 + (i - CV_E8 * 2048); }
__device__ __forceinline__ void convert_moe_wave(KargP in, unsigned char* ws, LAS unsigned char* tile, int lane, int cw, int ncw) {
    constexpr int NIT = CV_E8 * (2048 + 1024);
    const int kq = lane >> 3, nq = lane & 7;
#define CW_LOAD(v, c) do { _Pragma("unroll") for (int i_ = 0; i_ < 16; ++i_) v[i_] = __builtin_nontemporal_load((const f32x4*)((c).src + (size_t)(16 * kq + i_) * DM + 4 * nq)); } while (0)
#define CW_PROC(v, c) do { \
        _Pragma("unroll") for (int j_ = 0; j_ < 4; ++j_) { u32x4 o_; const float s_ = (c).scale; \
            o_.x = pk4_fp8(v[0][j_] * s_, v[1][j_] * s_, v[2][j_] * s_, v[3][j_] * s_);     o_.y = pk4_fp8(v[4][j_] * s_, v[5][j_] * s_, v[6][j_] * s_, v[7][j_] * s_); \
            o_.z = pk4_fp8(v[8][j_] * s_, v[9][j_] * s_, v[10][j_] * s_, v[11][j_] * s_);   o_.w = pk4_fp8(v[12][j_] * s_, v[13][j_] * s_, v[14][j_] * s_, v[15][j_] * s_); \
            *(LAS u32x4*)(tile + (4 * nq + j_) * 144 + 16 * kq) = o_; } \
        asm volatile("s_waitcnt lgkmcnt(0)" ::: "memory"); \
        _Pragma("unroll") for (int q_ = 0; q_ < 4; ++q_) { const int idx_ = lane + 64 * q_, row_ = idx_ >> 3, piece_ = idx_ & 7; \
            *(u32x4*)((c).dst + (size_t)row_ * DM + 16 * piece_) = *(const LAS u32x4*)(tile + row_ * 144 + 16 * piece_); } \
        asm volatile("s_waitcnt lgkmcnt(0)" ::: "memory"); } while (0)
    f32x4 va[16], vb[16];
    int it = cw;
    if (it >= NIT) return;
    CwItem ca = cw_decode(in, ws, cw_map(it)), cb = ca;
    CW_LOAD(va, ca);
    for (;;) {
        const bool hb = it + ncw < NIT;
        if (hb) { cb = cw_decode(in, ws, cw_map(it + ncw)); CW_LOAD(vb, cb); }
        CW_PROC(va, ca);
        if (!hb) break;
        it += ncw;
        const bool ha = it + ncw < NIT;
        if (ha) { ca = cw_decode(in, ws, cw_map(it + ncw)); CW_LOAD(va, ca); }
        CW_PROC(vb, cb);
        if (!ha) break;
        it += ncw;
    }
#undef CW_LOAD
#undef CW_PROC
}

__device__ __forceinline__ void sw_bar4(volatile LAS unsigned* cnt, unsigned& target, int lane) {
    asm volatile("s_waitcnt lgkmcnt(0)" ::: "memory");
    target += 4u;
    if (lane == 0) __hip_atomic_fetch_add((LAS unsigned*)cnt, 1u, __ATOMIC_RELAXED, __HIP_MEMORY_SCOPE_WORKGROUP);
    for (unsigned sp_ = 0; __hip_atomic_load((LAS unsigned*)cnt, __ATOMIC_RELAXED, __HIP_MEMORY_SCOPE_WORKGROUP) < target && sp_ < (1u << 24); ++sp_) __builtin_amdgcn_s_sleep(0);
    asm volatile("" ::: "memory");
}
__device__ __forceinline__ void p8_phase(Frame& F) {
    const KargP in = karg_opaque(F.in);
    const int lane = F.lane, l15 = lane & 15, g4 = lane >> 4;
    if (F.wave >= 4) {
        convert_moe_wave(in, F.ws, (LAS unsigned char*)(F.lds + 4 * 20480 + (F.wave - 4) * 4608), lane, F.bid * 4 + (F.wave - 4), F.G * 4);
        return; }
    const bf16_t* R1 = WSP(bf16_t, WS_R1); unsigned char* TOK = WSP(unsigned char, WS_TOK); const float* mod = WSP(float, WS_MOD);
    LAS float* pA = (LAS float*)(F.lds + F.wave * 20480);
    LAS float* pB = pA + 2048;
    LAS float* lg = pA + 4096;
    LAS int* te = (LAS int*)(lg + 576); LAS float* tw = (LAS float*)(te + 64);
    const float* wr = in[I_WR];
    LAS float* wl = (LAS float*)(F.lds + 4 * 20480 + 4 * 4608);
    unsigned rbt = 0u;
#pragma unroll 1
    for (int tile = F.bid + F.G * F.wave; tile < MTOK / 16; tile += F.G * 4) {
        const int bsel = (tile * 16) / SEQ; const float* mv = mod + (size_t)bsel * 12288;
#pragma unroll
        for (int j = 0; j < 8; ++j) { const int c = lane * 4 + 256 * j;
            const f32x4 g = *(const f32x4*)(in[I_LN1G] + c), bb = *(const f32x4*)(in[I_LN1B] + c), sh = *(const f32x4*)(mv + 6144 + c), sc = *(const f32x4*)(mv + 8192 + c) + 1.0f;
            *(LAS f32x4*)(pA + c) = g * sc; *(LAS f32x4*)(pB + c) = bb * sc + sh; }
        LDS_WAIT(); asm volatile("" ::: "memory");
        float my_mean = 0.f, my_rstd = 0.f;
        {
            const bf16_t* xb = R1 + (size_t)tile * 16 * DM + lane * 4;
            f32x4 v[8]; u32x2 vn[8];
#pragma unroll
            for (int j = 0; j < 8; ++j) { const u32x2 t_ = *(const u32x2*)(xb + 256 * j); v[j] = (f32x4){bflo(t_.x), bfhi(t_.x), bflo(t_.y), bfhi(t_.y)}; }
#pragma unroll 1
            for (int rr = 0; rr < 16; ++rr) {
                const bf16_t* xn = xb + (size_t)(rr < 15 ? rr + 1 : rr) * DM;
#pragma unroll
                for (int j = 0; j < 8; ++j) vn[j] = *(const u32x2*)(xn + 256 * j);
                float s = 0.f;
#pragma unroll
                for (int j = 0; j < 8; ++j) s += (v[j].x + v[j].y) + (v[j].z + v[j].w);
                const float mean = wave_sum(s) * (1.f / DM); float s2 = 0.f;
#pragma unroll
                for (int j = 0; j < 8; ++j) { v[j] = v[j] - mean; s2 += (v[j].x * v[j].x + v[j].y * v[j].y) + (v[j].z * v[j].z + v[j].w * v[j].w); }
                const float rstd = 1.f / sqrtf(wave_sum(s2) * (1.f / DM) + LN_EPS);
                if (l15 == rr) { my_mean = mean; my_rstd = rstd; }
                unsigned char* orow = TOK + (size_t)(tile * 16 + rr) * DM;
#pragma unroll
                for (int j = 0; j < 8; ++j) { const int c = lane * 4 + 256 * j;
                    const f32x4 y = v[j] * rstd * *(const LAS f32x4*)(pA + c) + *(const LAS f32x4*)(pB + c);
                    *(unsigned*)(orow + c) = pk4_fp8(y.x, y.y, y.z, y.w); }
#pragma unroll
                for (int j = 0; j < 8; ++j) v[j] = (f32x4){bflo(vn[j].x), bfhi(vn[j].x), bflo(vn[j].y), bfhi(vn[j].y)};
            }
        }
        f32x4 acc0 = (f32x4){0.f, 0.f, 0.f, 0.f}, acc1 = (f32x4){0.f, 0.f, 0.f, 0.f};
        const bf16_t* rowp = R1 + (size_t)(tile * 16 + l15) * DM + 512 * g4;
        const float ra = my_rstd, rm = -my_mean * my_rstd;
        const int rt = F.tid;
        float wst[32]; u32x4 ar[8];
#define RT_WLOAD(c) do { int rt_ = rt; asm volatile("" : "+v"(rt_)); const float* wb_ = wr + (size_t)(64 * (c) + (rt_ >> 5)) * 32 + (rt_ & 31); \
            _Pragma("unroll") for (int q_ = 0; q_ < 32; ++q_) wst[q_] = wb_[(512 * (q_ >> 3) + 8 * (q_ & 7)) * 32]; } while (0)
        RT_WLOAD(0);
#pragma unroll
        for (int q = 0; q < 8; ++q) ar[q] = *(const u32x4*)(rowp + 8 * q);
#pragma unroll 1
        for (int c = 0; c < 8; ++c) {
            { int rt_ = rt; asm volatile("" : "+v"(rt_)); LAS float* wd_ = wl + (rt_ & 31) * 68 + (rt_ >> 5);
#pragma unroll
              for (int q = 0; q < 32; ++q) wd_[(q >> 3) * 32 * 68 + 8 * (q & 7)] = wst[q]; }
            sw_bar4(F.MISC + 16, rbt, lane);
            if (c < 7) RT_WLOAD(c + 1);
            const LAS float* w0p = wl + (g4 * 32 + l15) * 68; const LAS float* w1p = w0p + 16 * 68;
            const bf16_t* rown = rowp + 64 * (c < 7 ? c + 1 : c);
#pragma unroll
            for (int i = 0; i < 16; ++i) {
                const f32x4 av = *(const LAS f32x4*)(pA + 512 * g4 + 64 * c + 4 * i), bv = *(const LAS f32x4*)(pB + 512 * g4 + 64 * c + 4 * i);
                const f32x4 w0 = *(const LAS f32x4*)(w0p + 4 * i), w1 = *(const LAS f32x4*)(w1p + 4 * i);
                const unsigned lo = (i & 1) ? ar[i >> 1].z : ar[i >> 1].x, hi = (i & 1) ? ar[i >> 1].w : ar[i >> 1].y;
                const f32x4 tk = ((f32x4){bflo(lo), bfhi(lo), bflo(hi), bfhi(hi)} * ra + rm) * av + bv;
#pragma unroll
                for (int j = 0; j < 4; ++j) { acc0 = __builtin_amdgcn_mfma_f32_16x16x4f32(tk[j], w0[j], acc0, 0, 0, 0); acc1 = __builtin_amdgcn_mfma_f32_16x16x4f32(tk[j], w1[j], acc1, 0, 0, 0); }
                if (i == 7) {
#pragma unroll
                    for (int q = 0; q < 4; ++q) ar[q] = *(const u32x4*)(rown + 8 * q); }
            }
#pragma unroll
            for (int q = 4; q < 8; ++q) ar[q] = *(const u32x4*)(rown + 8 * q);
            sw_bar4(F.MISC + 16, rbt, lane);
        }
#undef RT_WLOAD
        { const float b0 = in[I_BR][l15], b1 = in[I_BR][16 + l15];
#pragma unroll
          for (int r = 0; r < 4; ++r) { lg[(4 * g4 + r) * 33 + l15] = acc0[r] + b0; lg[(4 * g4 + r) * 33 + 16 + l15] = acc1[r] + b1; } }
        LDS_WAIT(); asm volatile("" ::: "memory");
        if (lane < 16) {
            unsigned chosen = 0u; float lv[4]; int le[4];
            for (int k = 0; k < 4; ++k) { float best = -3.4e38f; int be = 0;
                for (int e = 0; e < 32; ++e) { const float v = lg[lane * 33 + e]; if (!((chosen >> e) & 1u) && v > best) { best = v; be = e; } }
                chosen |= 1u << be; lv[k] = best; le[k] = be; }
            float ex[4], sum = 0.f;
            for (int k = 0; k < 4; ++k) { ex[k] = __expf(lv[k] - lv[0]); sum += ex[k]; }
            for (int k = 0; k < 4; ++k) { te[lane * 4 + k] = le[k]; tw[lane * 4 + k] = ex[k] / sum; }
        }
        LDS_WAIT(); asm volatile("" ::: "memory");
        { const int e = te[lane]; const float wv = tw[lane]; const int token = tile * 16 + (lane >> 2);
          const int pos = (int)__hip_atomic_fetch_add(F.ctl + CW_CNT + 64 * e, 1u, __ATOMIC_RELAXED, __HIP_MEMORY_SCOPE_AGENT);
          WSP(int, WS_TOPE)[token * 4 + (lane & 3)] = e; WSP(int, WS_TOPP)[token * 4 + (lane & 3)] = pos; WSP(float, WS_TOPW)[token * 4 + (lane & 3)] = wv;
          WSP(int, WS_RTOK)[e * POSCAP + pos] = token; }
        LDS_WAIT(); asm volatile("" ::: "memory");
    }
}

constexpr int MOE_TBL = 131072;
__device__ __forceinline__ void moe_table(Frame& F) {
    LAS int* tst = (LAS int*)(F.lds + MOE_TBL); LAS int* cn = (LAS int*)(F.lds + MOE_TBL + 256);
    __syncthreads();
    if (F.tid < 64) {
        const int e = F.tid & 31; const int c = (int)__hip_atomic_load(F.ctl + CW_CNT + 64 * e, __ATOMIC_RELAXED, __HIP_MEMORY_SCOPE_AGENT);
        int inc = (c + 255) >> 8;
#pragma unroll
        for (int o = 1; o < 32; o <<= 1) { const int t = __shfl_up(inc, o); if ((F.tid & 31) >= o) inc += t; }
        if (F.tid < 32) { cn[e] = c; tst[e] = inc - ((c + 255) >> 8); if (e == 31) tst[NEXP] = inc; } }
    __syncthreads();
}
constexpr int MOE_UL = MOE_TBL + 512;
__device__ __forceinline__ void moe_unit_list(Frame& F, int NT) {
    const LAS int* tst = (const LAS int*)(F.lds + MOE_TBL); LAS int* ul = (LAS int*)(F.lds + MOE_UL);
    if (F.tid < 64) {
        const int nwg = tst[NEXP] * NT; const int L = F.tid * F.G + F.bid;
        int pm = -1, pn = 0, e = 0;
        if (L < nwg) {
            int wg; { const int q = nwg / 8, r = nwg % 8, xcd = L % 8, off = L / 8; wg = (xcd < r ? xcd * (q + 1) : r * (q + 1) + (xcd - r) * q) + off; }
            for (int k = 1; k < NEXP; ++k) if (wg >= tst[k] * NT) e = k;
            const int ts = tst[e], ne = tst[e + 1] - ts, rem = wg - ts * NT;
            pm = ts + rem % ne; pn = rem / ne; }
        ul[F.tid * 4 + 0] = pm; ul[F.tid * 4 + 1] = pn; ul[F.tid * 4 + 2] = e; ul[F.tid * 4 + 3] = 0;
    }
    __syncthreads();
}
constexpr int MOE_ROWS = MOE_UL + 1024, MOE_ROWS_MAX = 18;
constexpr int MOE_BIAS = MOE_ROWS + MOE_ROWS_MAX * 512;
static_assert(MOE_BIAS + MOE_ROWS_MAX * 1024 <= MISC_OFF, "MoE LDS tables");
__device__ __forceinline__ void moe_row_table(Frame& F, const int* rtok) {
    const LAS int* tst = (const LAS int*)(F.lds + MOE_TBL); const LAS int* cn = (const LAS int*)(F.lds + MOE_TBL + 256); const LAS int* ul = (const LAS int*)(F.lds + MOE_UL);
    LAS unsigned short* rows = (LAS unsigned short*)(F.lds + MOE_ROWS);
    for (int idx = F.tid; idx < MOE_ROWS_MAX * 256; idx += NTHR) { const int i = idx >> 8, r = idx & 255; const int pm = ul[i * 4];
        if (pm >= 0) { const int e = ul[i * 4 + 2]; int pos = (pm - tst[e]) * 256 + r; const int cnt = cn[e]; pos = pos < cnt ? pos : cnt - 1; rows[idx] = (unsigned short)rtok[e * POSCAP + pos]; } }
    __syncthreads();
}
__device__ __forceinline__ void moe_bias_table(Frame& F, const float* b0, const float* b1, bool gu) {
    const LAS int* ul = (const LAS int*)(F.lds + MOE_UL); LAS float* bt = (LAS float*)(F.lds + MOE_BIAS);
    for (int idx = F.tid; idx < MOE_ROWS_MAX * 256; idx += NTHR) { const int i = idx >> 8, j = idx & 255; const int pm = ul[i * 4];
        if (pm >= 0) { const int pn = ul[i * 4 + 1], e = ul[i * 4 + 2];
            bt[idx] = gu ? (j < 128 ? b0[(size_t)e * DM + pn * 128 + j] : b1[(size_t)e * DM + pn * 128 + j - 128]) : b0[(size_t)e * DM + pn * 256 + j]; } }
    __syncthreads();
}
template <bool GU> struct SchedMoE {
    static constexpr bool GATHER = GU;
    int G, c, NT; const LAS int* tst; const LAS int* cn; const int* rtok; const char* a; const char* b; const LAS int* ul;
    __device__ __forceinline__ bool next(int i, Unit& u) const {
        if (i >= MOE_ROWS_MAX) return false;
        const int pm = __builtin_amdgcn_readfirstlane(ul[i * 4 + 0]); if (pm < 0) return false;
        u.pm = pm; u.pn = __builtin_amdgcn_readfirstlane(ul[i * 4 + 1]); u.ex = i; return true;
    }
    __device__ __forceinline__ const char* a_base(const Unit& u) const { return GU ? a : a + (size_t)u.pm * 256 * DM; }
    __device__ __forceinline__ int expert(const Unit& u) const { return __builtin_amdgcn_readfirstlane(ul[u.ex * 4 + 2]); }
    __device__ __forceinline__ const char* b_base(const Unit& u) const { return b + ((size_t)expert(u) * (GU ? 4096 : 2048) + 256 * u.pn) * DM; }
    __device__ __forceinline__ int a_row(const Unit& u, int R) const { return (int)((const LAS unsigned short*)((const LAS char*)ul + (MOE_ROWS - MOE_UL)))[u.ex * 256 + R]; }
};
struct EpiGU {
    static constexpr bool PERM = true;
    unsigned char* ACT; const float* bg; const float* bu; const LAS int* ul;
    __device__ __forceinline__ void operator()(const f32x4 (&acc)[2][2][4][2], const Unit& u, int wr, int wc, int fr, int fq) const {
        const int row0 = u.pm * 256 + wr * 64 + fr, col0 = u.pn * 128 + wc * 32 + 8 * fq;
        const LAS float* bt = (const LAS float*)((const LAS char*)ul + (MOE_BIAS - MOE_UL)) + u.ex * 256 + wc * 32 + 8 * fq;
        const f32x4 g0 = *(const LAS f32x4*)bt, g1 = *(const LAS f32x4*)(bt + 4), u0 = *(const LAS f32x4*)(bt + 128), u1 = *(const LAS f32x4*)(bt + 132);
#pragma unroll
        for (int ai = 0; ai < 2; ++ai)
#pragma unroll
            for (int m = 0; m < 4; ++m) { const size_t row = row0 + ai * 128 + m * 16;
                float o[8];
#pragma unroll
                for (int n = 0; n < 2; ++n)
#pragma unroll
                    for (int j = 0; j < 4; ++j) { const float gv = fminf(acc[ai][0][m][n][j] + (n ? g1[j] : g0[j]), 7.0f);
                        const float uv = fminf(fmaxf(acc[ai][1][m][n][j] + (n ? u1[j] : u0[j]), -7.0f), 7.0f);
                        o[n * 4 + j] = 4.0f * gv * sigmoid_fast(1.702f * gv) * (uv + 1.0f); }
                u32x2 w; w.x = pk4_fp8(o[0], o[1], o[2], o[3]); w.y = pk4_fp8(o[4], o[5], o[6], o[7]);
                *(u32x2*)(ACT + row * DM + col0) = w; }
    }
};
struct EpiDN {
    static constexpr bool PERM = true;
    unsigned char* YR; const LAS int* ul;
    __device__ __forceinline__ void operator()(const f32x4 (&acc)[2][2][4][2], const Unit& u, int wr, int wc, int fr, int fq) const {
        const int r0 = wr * 64 + fr, col0 = u.pn * 256 + wc * 32 + 8 * fq;
        const LAS float* bp = (const LAS float*)((const LAS char*)ul + (MOE_BIAS - MOE_UL)) + u.ex * 256 + wc * 32 + 8 * fq;
        unsigned char* base = YR + ((size_t)u.pm * 256 + r0) * DM + col0;
#pragma unroll
        for (int bj = 0; bj < 2; ++bj) {
            const f32x4 bv0 = *(const LAS f32x4*)(bp + bj * 128), bv1 = *(const LAS f32x4*)(bp + bj * 128 + 4);
#pragma unroll
            for (int ai = 0; ai < 2; ++ai)
#pragma unroll
                for (int m = 0; m < 4; ++m) {
                    const f32x4 lim = (f32x4){448.f, 448.f, 448.f, 448.f};
                    const f32x4 v0 = __builtin_elementwise_min(__builtin_elementwise_max((acc[ai][bj][m][0] + bv0) * 16.0f, -lim), lim), v1 = __builtin_elementwise_min(__builtin_elementwise_max((acc[ai][bj][m][1] + bv1) * 16.0f, -lim), lim);
                    u32x2 w; w.x = pk4_fp8(v0[0], v0[1], v0[2], v0[3]); w.y = pk4_fp8(v1[0], v1[1], v1[2], v1[3]);
                    *(u32x2*)(base + (size_t)(ai * 128 + m * 16) * DM + bj * 128) = w; }
        }
    }
};

__device__ __forceinline__ void p11_phase(Frame& F) {
    const KargP in = karg_opaque(F.in);
    const int gw = F.bid * NWAVES + F.wave, NGW = F.G * NWAVES, lane = F.lane;
    const LAS int* tst = (const LAS int*)(F.lds + MOE_TBL);
    const bf16_t* R1 = WSP(bf16_t, WS_R1); const unsigned char* YR = WSP(unsigned char, WS_YR); const float* mod = WSP(float, WS_MOD);
    LAS float* pl = (LAS float*)F.lds;
    for (int i = F.tid; i < 2048; i += NTHR) { pl[i] = in[I_LN1G][i]; pl[2048 + i] = in[I_LN1B][i]; pl[4096 + i] = in[I_LN2G][i]; pl[6144 + i] = in[I_LN2B][i]; }
    for (int i = F.tid; i < 8 * 2048; i += NTHR) pl[8192 + i] = mod[(size_t)(i >> 11) * 12288 + 10240 + (i & 2047)];
    __syncthreads();
    LAS int* sd = (LAS int*)(F.lds + 98304 + F.wave * 512); LAS float* sw = (LAS float*)(F.lds + 98304 + F.wave * 512 + 256);
#pragma unroll 1
    for (int rb = gw * 8; rb < MTOK; rb += NGW * 8) {
        const int li = lane & 31;
        { const int ve = WSP(int, WS_TOPE)[rb * 4 + li], vp = WSP(int, WS_TOPP)[rb * 4 + li]; const float vw = WSP(float, WS_TOPW)[rb * 4 + li];
          if (lane < 32) { sd[li] = tst[ve] * 256 + vp; sw[li] = vw; } }
        const LAS float* g2p = pl + 8192 + (rb / SEQ) * 2048;
        LDS_WAIT(); asm volatile("" ::: "memory");
#pragma unroll 1
        for (int ri = 0; ri < 8; ++ri) {
            const int row = rb + ri;
            int dest[4]; float wk[4];
#pragma unroll
            for (int k = 0; k < 4; ++k) { dest[k] = __builtin_amdgcn_readfirstlane(sd[ri * 4 + k]); wk[k] = __builtin_bit_cast(float, __builtin_amdgcn_readfirstlane(__builtin_bit_cast(int, sw[ri * 4 + k]))); }
            const bf16_t* xr = R1 + (size_t)row * DM + lane * 4;
            f32x4 v[8]; unsigned yy[4][8]; u32x2 vr[8];
#pragma unroll
            for (int j = 0; j < 8; ++j) vr[j] = *(const u32x2*)(xr + 256 * j);
#pragma unroll
            for (int k = 0; k < 4; ++k) { const unsigned char* yp = YR + (size_t)dest[k] * DM + lane * 4;
#pragma unroll
                for (int j = 0; j < 8; ++j) yy[k][j] = *(const unsigned*)(yp + 256 * j); }
            float s = 0.f;
#pragma unroll
            for (int j = 0; j < 8; ++j) { v[j] = (f32x4){bflo(vr[j].x), bfhi(vr[j].x), bflo(vr[j].y), bfhi(vr[j].y)}; s += (v[j].x + v[j].y) + (v[j].z + v[j].w); }
            float mean = wave_sum(s) * (1.f / DM); float s2 = 0.f;
#pragma unroll
            for (int j = 0; j < 8; ++j) { v[j] = v[j] - mean; s2 += (v[j].x * v[j].x + v[j].y * v[j].y) + (v[j].z * v[j].z + v[j].w * v[j].w); }
            float rstd = 1.f / sqrtf(wave_sum(s2) * (1.f / DM) + LN_EPS);
            s = 0.f;
#pragma unroll
            for (int j = 0; j < 8; ++j) { const int c = lane * 4 + 256 * j;
                const f32x4 g = *(const LAS f32x4*)(pl + c), bb = *(const LAS f32x4*)(pl + 2048 + c), g2v = *(const LAS f32x4*)(g2p + c);
                f32x4 y = (f32x4){0.f, 0.f, 0.f, 0.f};
#pragma unroll
                for (int k = 0; k < 4; ++k) { const f32x2 lo = __builtin_amdgcn_cvt_pk_f32_fp8((int)yy[k][j], false), hi = __builtin_amdgcn_cvt_pk_f32_fp8((int)yy[k][j], true); y += (f32x4){lo.x, lo.y, hi.x, hi.y} * (wk[k] * 0.0625f); }
                v[j] = (v[j] * rstd * g + bb) * DN_ALPHA + g2v * y;
                s += (v[j].x + v[j].y) + (v[j].z + v[j].w); __builtin_amdgcn_sched_barrier(0); }
            mean = wave_sum(s) * (1.f / DM); s2 = 0.f;
#pragma unroll
            for (int j = 0; j < 8; ++j) { v[j] = v[j] - mean; s2 += (v[j].x * v[j].x + v[j].y * v[j].y) + (v[j].z * v[j].z + v[j].w * v[j].w); }
            rstd = 1.f / sqrtf(wave_sum(s2) * (1.f / DM) + LN_EPS);
            float* orow = F.out + (size_t)row * DM;
#pragma unroll
            for (int j = 0; j < 8; ++j) { const int c = lane * 4 + 256 * j;
                const f32x4 g = *(const LAS f32x4*)(pl + 4096 + c), bb = *(const LAS f32x4*)(pl + 6144 + c);
                *(f32x4*)(orow + c) = v[j] * rstd * g + bb; }
        }
        LDS_WAIT(); asm volatile("" ::: "memory");
    }
}

constexpr int NPHASE = 13;
__global__ void __launch_bounds__(NTHR, 2) mk_fwd(Args args) {
    extern __shared__ __attribute__((aligned(16))) unsigned char lds_raw[];
    Frame F;
    F.lds = (LAS unsigned char*)lds_raw;
    F.MISC = (volatile LAS unsigned*)(F.lds + MISC_OFF);
    F.tid = threadIdx.x; F.lane = F.tid & 63; F.wave = __builtin_amdgcn_readfirstlane(F.tid >> 6); F.wave0 = F.wave;
    F.G = gridDim.x; F.bid = blockIdx.x;
    F.in = (KargP)__builtin_amdgcn_kernarg_segment_ptr(); F.out = args.out; F.ws = args.ws; F.ctl = (unsigned*)(args.ws + WS_CTL);
    for (int u = F.tid; u < (LDS_BYTES - MISC_OFF) / 4; u += NTHR) ((LAS unsigned*)(F.lds + MISC_OFF))[u] = 0u;
    __syncthreads();
    XcdBarrier bar; bar.bar = F.ctl + CW_BAR; bar.x = 0; bar.st = nullptr;
    if (MK_LAUNCHES == 1) bar = xcd_barrier_post(F.ctl + CW_BAR, F.MISC + 8, F.tid);
    const int lo = args.ph_lo, hi = args.ph_hi;
    unsigned long long tph_ = (PROBE_PH >= 0) ? __builtin_amdgcn_s_memrealtime() : 0ull;
#ifndef PH_MASK
#define PH_MASK 0xFFFF
#endif
#define TID_NOW(var) int var; { unsigned z_ = 0u; asm volatile("" : "+s"(z_)); var = (F.wave0 << 6) | (int)__builtin_amdgcn_mbcnt_hi(~0u, __builtin_amdgcn_mbcnt_lo(~0u, z_)); }
#define RELOAD() do { const KargP k_ = karg_opaque(F.in); F.out = (float*)k_[38]; F.ws = (unsigned char*)k_[39]; F.ctl = (unsigned*)F.ws; TID_NOW(t_); asm volatile("" : "+v"(t_)); F.tid = t_; F.lane = t_ & 63; F.wave = __builtin_amdgcn_readfirstlane(t_ >> 6); } while (0)
#define IN(k) (((PH_MASK >> (k)) & 1) && lo <= (k) && (k) < hi)
#define SEAM(k) do { if (IN(k) && IN((k) + 1)) { TID_NOW(ts_); xcd_barrier(bar, ts_); } \
        if (PROBE_PH >= 0) { const unsigned long long t1_ = __builtin_amdgcn_s_memrealtime(); \
            if (PROBE_PH == (k)) { while (__builtin_amdgcn_s_memrealtime() - t1_ < t1_ - tph_) __builtin_amdgcn_s_sleep(8); } \
            tph_ = __builtin_amdgcn_s_memrealtime(); } } while (0)
#ifndef DUP_MASK
#define DUP_MASK 0
#endif
#define REP(k) for (int rep_ = 0; rep_ < (((DUP_MASK >> (k)) & 1) ? 2 : 1); ++rep_)
    if (IN(0)) REP(0) p0_phase(F);
    SEAM(0);
    RELOAD();
    if (IN(1)) REP(1) p0b_phase(F);
    SEAM(1);
    RELOAD();
    if (IN(2)) REP(2) p1_phase(F);
    SEAM(2);
    RELOAD();
    if (IN(3)) REP(3) {
        EpiZ E{WSP(bf16_t, WS_Z), WSP(bf16_t, WS_ZT), WSP(float, WS_BINP)};
        { SchedZ<false> S{F.G, F.bid, (const char*)WSP(bf16_t, WS_HX), (const char*)WSP(bf16_t, WS_WIN)};
          pg8::gemm_phase<EpiZ, SchedZ<false>>(F.tid, F.lds, DM / 64, DM * 2, DM * 2, S, E); }
        { SchedZ<true> S{F.G, F.G - 1 - F.bid, (const char*)WSP(unsigned char, WS_HX8), (const char*)WSP(unsigned char, WS_WIN8)};
          pg8::gemm_phase<EpiZ, SchedZ<true>, true>(F.tid, F.lds, DM / 128, DM, DM, S, E, 0x7A7A7A7A, 0x7F7F7F7F); }
    }
    SEAM(3);
    RELOAD();
    if (IN(4)) REP(4) p3_phase(F);
    SEAM(4);
    RELOAD();
    if (IN(5)) REP(5) {
        SchedQK S{F.G, F.bid, (const char*)WSP(bf16_t, WS_U), (const char*)WSP(bf16_t, WS_WQK)};
        EpiQK E{WSP(bf16_t, WS_QKB)};
        pg8::gemm_phase<EpiQK, SchedQK>(F.tid, F.lds, 256 / 64, MW * 2, 256 * 2, S, E);
    }
    SEAM(5);
    RELOAD();
    if (IN(6)) REP(6) {
#ifndef DUP_ML
#define DUP_ML 1
#endif
#ifndef DUP_HY
#define DUP_HY 1
#endif
        for (int un = F.bid; un < 256 * DUP_ML; un += F.G) mlstm_unit(F, un & 255);
        RELOAD();
        { CvHook hk; hk.in = karg_opaque(F.in); hk.ws = F.ws; hk.tiles = (LAS unsigned char*)(F.lds + HY_CVT); hk.tid = F.tid; hk.bid = F.bid; hk.G = F.G; hk.kmax = (CVH_NITEMS - 1 - F.bid) / F.G; hk.s = 2; hk.request<0>(0); hk.request<1>(1);
          for (int un = F.bid; un < 512 * DUP_HY; un += F.G) hyena_unit(F, un & 511, hk);
          while (hk.s <= hk.kmax + 3) { __syncthreads(); if (hk.s & 1) hk.act<1>(); else hk.act<0>(); }
          __syncthreads(); }
    }
    SEAM(6);
    RELOAD();
    if (IN(7)) REP(7) {
        { SchedP S{F.G, F.bid, (const char*)WSP(unsigned char, WS_AM), (const char*)WSP(unsigned char, WS_WPA2), (size_t)256 * 2048, (size_t)256 * 2048};
          EpiMA E{WSP(bf16_t, WS_T), WSP(bf16_t, WS_Z)};
          pg8::gemm_phase<EpiMA, SchedP, true>(F.tid, F.lds, 2048 / 128, 2048, 2048, S, E, 0x7A7A7A7A, 0x7F7F7F7F); }
        VM_WAIT(); __syncthreads();
        { SchedP S{F.G, F.bid, (const char*)WSP(unsigned char, WS_HH), (const char*)WSP(unsigned char, WS_WPH), (size_t)256 * 1024, (size_t)256 * 1024};
          EpiMB E{WSP(bf16_t, WS_T), WSP(bf16_t, WS_Z), WSP(unsigned char, WS_MX)};
          pg8::gemm_phase<EpiMB, SchedP, true>(F.tid, F.lds, 1024 / 128, 1024, 1024, S, E, 0x7A7A7A7A, 0x7F7F7F7F); }
    }
    SEAM(7);
    RELOAD();
    if (IN(8)) REP(8) {
        SchedP S{F.G, F.bid, (const char*)WSP(unsigned char, WS_MX), (const char*)WSP(unsigned char, WS_WOUT), (size_t)256 * 2048, (size_t)256 * 2048};
        const KargP in = karg_opaque(F.in); EpiWO E{WSP(bf16_t, WS_R1), in[I_X], WSP(float, WS_STATS), in[I_LNG], in[I_LNB], WSP(float, WS_MOD)};
        pg8::gemm_phase<EpiWO, SchedP, true>(F.tid, F.lds, 2048 / 128, 2048, 2048, S, E, 0x79797979, 0x7F7F7F7F);
    }
    SEAM(8);
    RELOAD();
    if (IN(9)) p8_phase(F);
    SEAM(9);
    RELOAD();
    if (IN(10)) REP(10) {
        moe_table(F);
        moe_unit_list(F, 16); moe_row_table(F, WSP(int, WS_RTOK)); { const KargP in_ = karg_opaque(F.in); moe_bias_table(F, in_[I_BG], in_[I_BU], true); }
        SchedMoE<true> S{F.G, F.bid, 16, (const LAS int*)(F.lds + MOE_TBL), (const LAS int*)(F.lds + MOE_TBL + 256), WSP(int, WS_RTOK), (const char*)WSP(bf16_t, WS_TOK), (const char*)WSP(bf16_t, WS_WGU), (const LAS int*)(F.lds + MOE_UL)};
        const KargP in = karg_opaque(F.in); EpiGU E{WSP(unsigned char, WS_ACT), in[I_BG], in[I_BU], (const LAS int*)(F.lds + MOE_UL)};
        pg8::gemm_phase<EpiGU, SchedMoE<true>, true>(F.tid, F.lds, DM / 128, DM, DM, S, E, 0x7A7A7A7A, 0x7F7F7F7F);
    }
    SEAM(10);
    RELOAD();
    if (IN(11)) REP(11) {
        moe_table(F);
        moe_unit_list(F, 8); { const KargP in_ = karg_opaque(F.in); moe_bias_table(F, in_[I_BDN], in_[I_BDN], false); }
        SchedMoE<false> S{F.G, F.bid, 8, (const LAS int*)(F.lds + MOE_TBL), (const LAS int*)(F.lds + MOE_TBL + 256), WSP(int, WS_RTOK), (const char*)WSP(bf16_t, WS_ACT), (const char*)WSP(bf16_t, WS_WD), (const LAS int*)(F.lds + MOE_UL)};
        const KargP in = karg_opaque(F.in); EpiDN E{WSP(unsigned char, WS_YR), (const LAS int*)(F.lds + MOE_UL)};
        pg8::gemm_phase<EpiDN, SchedMoE<false>, true>(F.tid, F.lds, DM / 128, DM, DM, S, E, 0x79797979, 0x7D7D7D7D);
    }
    SEAM(11);
    RELOAD();
    if (IN(12)) REP(12) { moe_table(F); p11_phase(F); }
#undef IN
#undef SEAM
}

extern "C" void kernel_launch(void* const* d_in, const int* in_sizes, int n_in, void* d_out, int out_size, void* d_ws, size_t ws_size, hipStream_t stream) {
    static int grid = 0;
    if (grid == 0) {
        if (n_in != 38 || out_size != MTOK * DM || ws_size < WS_END) { fprintf(stderr, "kernel_launch: unexpected shapes: n_in %d out %d ws %zu (need %zu)\n", n_in, out_size, ws_size, (size_t)WS_END); grid = -1; return; }
        int dev = 0, cus = 0, per_cu = 0;
        if (hipGetDevice(&dev) != hipSuccess || hipDeviceGetAttribute(&cus, hipDeviceAttributeMultiprocessorCount, dev) != hipSuccess) { grid = -1; return; }
        if (hipFuncSetAttribute((const void*)mk_fwd, hipFuncAttributeMaxDynamicSharedMemorySize, LDS_BYTES) != hipSuccess) { fprintf(stderr, "kernel_launch: hipFuncSetAttribute failed\n"); grid = -1; return; }
        if (hipOccupancyMaxActiveBlocksPerMultiprocessor(&per_cu, (const void*)mk_fwd, NTHR, LDS_BYTES) != hipSuccess || per_cu < 1) fprintf(stderr, "kernel_launch: occupancy query says %d\n", per_cu);
        (void)hipGetLastError();
        grid = cus;
    }
    if (grid < 0) return;
    (void)hipMemsetAsync((char*)d_ws + WS_CTL, 0, CTL_ZERO_BYTES, stream);
    Args a{};
    for (int i = 0; i < 38; ++i) a.in[i] = (const float*)d_in[i];
    a.out = (float*)d_out; a.ws = (unsigned char*)d_ws;
#if MK_LAUNCHES == 1
    a.ph_lo = 0; a.ph_hi = NPHASE;
    hipLaunchKernelGGL(mk_fwd, dim3(grid), dim3(NTHR), LDS_BYTES, stream, a);
#else
    for (int p = 0; p < NPHASE; ++p) { a.ph_lo = p; a.ph_hi = p + 1; hipLaunchKernelGGL(mk_fwd, dim3(grid), dim3(NTHR), LDS_BYTES, stream, a); }
#endif
}
```
